# Optimizing an MI355X kernel written in HIP

```python
import math
import jax, jax.numpy as jnp
from jax import lax
import numpy as np

D_MODEL = 1024
BATCH = 8
SEQ = 4096
DEPTH = 1

HEAD_DIM = 64
N_HEADS = D_MODEL // HEAD_DIM
N_HEADS_MOBA = N_HEADS // 2
N_HEADS_DIL = N_HEADS - N_HEADS_MOBA
MOBA_BLOCK = 256
MOBA_TOPK = 3
Q_BLOCK = 128
DILATED_BRANCHES = ((128, 1), (512, 4), (2048, 16))
D_FF = ((8 * D_MODEL // 3 + 255) // 256) * 256
ROPE_THETA = 10000.0
RMS_EPS = 1e-6
NEG_INF = -1e30
ATTN_SCALE = 1.0 / math.sqrt(HEAD_DIM)

kernel_name = "hybrid_moba_dilated_parallel_heads"


def rmsnorm(x, g):
    xf = x.astype(jnp.float32)
    y = xf * lax.rsqrt(jnp.mean(xf * xf, axis=-1, keepdims=True) + RMS_EPS)
    return (y * g.astype(jnp.float32)).astype(x.dtype)


def rope(t):
    S, D = t.shape[1], t.shape[3]
    inv_freq = ROPE_THETA ** (-jnp.arange(0, D, 2, dtype=jnp.float32) / D)
    ang = jnp.arange(S, dtype=jnp.float32)[:, None] * inv_freq[None, :]
    cos = jnp.concatenate([jnp.cos(ang), jnp.cos(ang)], -1)[None, :, None, :]
    sin = jnp.concatenate([jnp.sin(ang), jnp.sin(ang)], -1)[None, :, None, :]
    tf = t.astype(jnp.float32)
    t1, t2 = tf[..., : D // 2], tf[..., D // 2:]
    rot = jnp.concatenate([-t2, t1], -1)
    return (tf * cos + rot * sin).astype(t.dtype)


def moba_attention(q, k, v):
    B, S, H, D = q.shape
    s_pad = -(-S // MOBA_BLOCK) * MOBA_BLOCK
    pad = ((0, 0), (0, s_pad - S), (0, 0), (0, 0))
    q, k, v = (jnp.pad(t, pad) for t in (q, k, v))
    nb = s_pad // MOBA_BLOCK
    nc = s_pad // Q_BLOCK
    k_sel = min(MOBA_TOPK, nb)
    kb = k.reshape(B, nb, MOBA_BLOCK, H, D).transpose(0, 3, 1, 2, 4)
    vb = v.reshape(B, nb, MOBA_BLOCK, H, D).transpose(0, 3, 1, 2, 4)
    k_mean = jnp.mean(kb.astype(jnp.float32), axis=3)
    q_blocks = q.reshape(B, nc, Q_BLOCK, H, D).transpose(0, 1, 3, 2, 4)
    head_idx = jnp.arange(H)[:, None, None]
    q_local = jnp.arange(Q_BLOCK)
    k_local = jnp.arange(MOBA_BLOCK)
    blk_ids = jnp.arange(nb)

    def one_query_block(i):
        b = i // nc
        c = i % nc
        qc = q_blocks[b, c]
        kbh = kb[b]
        vbh = vb[b]
        own = (c * Q_BLOCK) // MOBA_BLOCK
        gate = jnp.einsum('hqd,hnd->hqn', qc.astype(jnp.float32), k_mean[b])
        gate = jnp.where(blk_ids[None, None, :] < own, gate, NEG_INF)
        _, sel = lax.top_k(gate, k_sel)
        valid = sel < own
        ks = kbh[head_idx, sel]
        vs = vbh[head_idx, sel]
        s_sel = jnp.einsum('hqd,hqkld->hqkl', qc, ks).astype(jnp.float32) * ATTN_SCALE
        s_sel = jnp.where(valid[..., None], s_sel, NEG_INF)
        s_sel = s_sel.reshape(H, Q_BLOCK, k_sel * MOBA_BLOCK)
        k_own = lax.dynamic_index_in_dim(kbh, own, axis=1, keepdims=False)
        v_own = lax.dynamic_index_in_dim(vbh, own, axis=1, keepdims=False)
        s_own = jnp.einsum('hqd,hld->hql', qc, k_own).astype(jnp.float32) * ATTN_SCALE
        q_pos = c * Q_BLOCK + q_local
        k_pos = own * MOBA_BLOCK + k_local
        s_own = jnp.where(k_pos[None, None, :] <= q_pos[None, :, None], s_own, NEG_INF)
        p = jax.nn.softmax(jnp.concatenate([s_sel, s_own], axis=-1), axis=-1).astype(v.dtype)
        p_sel = p[..., : k_sel * MOBA_BLOCK].reshape(H, Q_BLOCK, k_sel, MOBA_BLOCK)
        p_own = p[..., k_sel * MOBA_BLOCK:]
        return (jnp.einsum('hqkl,hqkld->qhd', p_sel, vs)
                + jnp.einsum('hql,hld->qhd', p_own, v_own))

    out = lax.map(one_query_block, jnp.arange(B * nc))
    return out.reshape(B, s_pad, H, D)[:, :S]


def dilated_branch(q, k, v, window, dilation):
    B, S, H, D = q.shape
    L = window // dilation
    s_pad = -(-S // window) * window
    n_sub = s_pad // dilation
    nb = n_sub // L
    pad = ((0, 0), (0, s_pad - S), (0, 0), (0, 0))

    def to_blocks(t):
        t = jnp.pad(t, pad).reshape(B, n_sub, dilation, H, D).transpose(0, 2, 1, 3, 4)
        return t.reshape(B, dilation, nb, L, H, D)

    def with_prev(t):
        prev = jnp.pad(t, ((0, 0), (0, 0), (1, 0), (0, 0), (0, 0), (0, 0)))[:, :, :-1]
        return jnp.concatenate([prev, t], axis=3)

    qb = to_blocks(q)
    kk = with_prev(to_blocks(k))
    vv = with_prev(to_blocks(v))
    logits = jnp.einsum('brnqhd,brnkhd->brnhqk', qb, kk).astype(jnp.float32) * ATTN_SCALE
    qi = jnp.arange(L)[:, None] + L
    kj = jnp.arange(2 * L)[None, :]
    rel = qi - kj
    band = (rel >= 0) & (rel <= L)
    exists = (jnp.arange(nb)[:, None, None] > 0) | (kj[None] >= L)
    mask = band[None] & exists
    logits = jnp.where(mask[None, None, :, None], logits, NEG_INF)
    lse = jax.nn.logsumexp(logits, axis=-1)
    p = jnp.exp(logits - lse[..., None]).astype(v.dtype)
    o = jnp.einsum('brnhqk,brnkhd->brnqhd', p, vv)
    o = o.reshape(B, dilation, n_sub, H, D).transpose(0, 2, 1, 3, 4).reshape(B, s_pad, H, D)
    lse = lse.transpose(0, 1, 2, 4, 3).reshape(B, dilation, n_sub, H)
    lse = lse.transpose(0, 2, 1, 3).reshape(B, s_pad, H)
    return o[:, :S], lse[:, :S]


def dilated_mixture(q, k, v):
    outs, lses = [], []
    for window, dilation in DILATED_BRANCHES:
        o, lse = dilated_branch(q, k, v, window, dilation)
        outs.append(o)
        lses.append(lse)
    alpha = jax.nn.softmax(jnp.stack(lses, axis=0), axis=0)
    out = jnp.sum(alpha[..., None] * jnp.stack(outs, axis=0).astype(jnp.float32), axis=0)
    return out.astype(q.dtype)


def setup_inputs(seed: int = 0) -> dict:
    key = jax.random.key(seed)
    ks = jax.random.split(key, 12)
    f32 = jnp.float32
    x = jax.random.normal(ks[0], (BATCH, SEQ, D_MODEL), f32)
    attn_norm = 1.0 + 0.02 * jax.random.normal(ks[1], (D_MODEL,), f32)
    w_in = jax.random.normal(ks[2], (D_MODEL, 3 * D_MODEL), f32) * D_MODEL ** -0.5
    moba_out_norm = 1.0 + 0.02 * jax.random.normal(ks[3], (N_HEADS_MOBA * HEAD_DIM,), f32)
    dil_out_norm = 1.0 + 0.02 * jax.random.normal(ks[4], (N_HEADS_DIL * HEAD_DIM,), f32)
    w_out = jax.random.normal(ks[5], (D_MODEL, D_MODEL), f32) * D_MODEL ** -0.5
    ffn_norm = 1.0 + 0.02 * jax.random.normal(ks[6], (D_MODEL,), f32)
    w_gate = jax.random.normal(ks[7], (D_MODEL, D_FF), f32) * D_MODEL ** -0.5
    w_up = jax.random.normal(ks[8], (D_MODEL, D_FF), f32) * D_MODEL ** -0.5
    w_down = jax.random.normal(ks[9], (D_FF, D_MODEL), f32) * D_FF ** -0.5
    final_norm = 1.0 + 0.02 * jax.random.normal(ks[10], (D_MODEL,), f32)
    return {"x": x, "attn_norm": attn_norm, "w_in": w_in,
            "moba_out_norm": moba_out_norm, "dil_out_norm": dil_out_norm,
            "w_out": w_out, "ffn_norm": ffn_norm, "w_gate": w_gate,
            "w_up": w_up, "w_down": w_down, "final_norm": final_norm}


def reference(x, attn_norm, w_in, moba_out_norm, dil_out_norm, w_out,
              ffn_norm, w_gate, w_up, w_down, final_norm):
    B, S, _ = x.shape
    for _layer in range(DEPTH):
        h = rmsnorm(x, attn_norm)
        qkv = jnp.einsum('bsd,de->bse', h, w_in).reshape(B, S, 3, N_HEADS, HEAD_DIM)
        q = rope(qkv[:, :, 0])
        k = rope(qkv[:, :, 1])
        v = qkv[:, :, 2]
        a = N_HEADS_MOBA
        o_moba = moba_attention(q[:, :, :a], k[:, :, :a], v[:, :, :a])
        o_dil = dilated_mixture(q[:, :, a:], k[:, :, a:], v[:, :, a:])
        o_moba = rmsnorm(o_moba.reshape(B, S, -1), moba_out_norm)
        o_dil = rmsnorm(o_dil.reshape(B, S, -1), dil_out_norm)
        mixed = jnp.concatenate([o_moba, o_dil], axis=-1)
        x = x + jnp.einsum('bse,ed->bsd', mixed, w_out)
        h = rmsnorm(x, ffn_norm)
        g = jnp.einsum('bsd,df->bsf', h, w_gate)
        u = jnp.einsum('bsd,df->bsf', h, w_up)
        x = x + jnp.einsum('bsf,fd->bsd', jax.nn.silu(g) * u, w_down)
    return rmsnorm(x, final_norm)
```

```cpp
#include <hip/hip_runtime.h>
#include <cstdio>
#include <cstdint>
namespace pg8 {
#define PG8_LAS __attribute__((address_space(3)))
typedef unsigned short bf16_t;
typedef short bf16x8 __attribute__((ext_vector_type(8)));
typedef float f32x4 __attribute__((ext_vector_type(4)));
typedef unsigned u32x4 __attribute__((ext_vector_type(4)));
constexpr int BM = 256, BK = 64, HALF = 128, HTB = HALF * BK * 2  , STAGE_BYTES = 8 * HTB, NXCD = 8, WGM = 8;

__host__ __device__ __forceinline__ int lds_byte(int r, int c) { const int st = (r >> 4) * 2 + (c >> 5), rr = r & 15, cc = c & 31, ob = rr * 64 + cc * 2; return st * 1024 + (ob ^ (((ob >> 9) & 1) << 5)); }
__host__ __device__ __forceinline__ void stage_rc(int b, int& R, int& C) { const int st = b / 1024, sb = b % 1024, swz = sb ^ (((sb >> 9) & 1) << 5); R = (st >> 1) * 16 + swz / 64; C = (st & 1) * 32 + (swz % 64) / 2; }
__host__ __device__ __forceinline__ int perm32(int rho) { const int n = rho >> 4, i = rho & 15; return 8 * (i >> 2) + 4 * n + (i & 3); }

struct Unit { int pm, pn; };
struct Gemm { const bf16_t* A; const bf16_t* Bt; int M, N, K; };

struct StaticOrder {
    int nM, nN, nwg, G, c;
    __host__ __device__ void init(int M, int N, int G_, int c_) { nM = M / BM; nN = N / BM; nwg = nM * nN; G = G_; c = c_; }
    __host__ __device__ bool next(int i, Unit& u) const {
        const long L = (long)i * G + c; if (L >= nwg) return false;
        int wgid = (int)L; { const int q = nwg / NXCD, r = nwg % NXCD, xcd = wgid % NXCD, off = wgid / NXCD; wgid = (xcd < r ? xcd * (q + 1) : r * (q + 1) + (xcd - r) * q) + off; }
        const int nig = WGM * nN, gid = wgid / nig, fm = gid * WGM, gsz = (nM - fm) < WGM ? (nM - fm) : WGM;
        u.pm = fm + ((wgid % nig) % gsz); u.pn = (wgid % nig) / gsz; return true;
    }
    __device__ __forceinline__ void a_ready(const Unit&) const {}
    __device__ __forceinline__ void done(const Unit&) const {}
};


__device__ __forceinline__ unsigned cvt_pk_bf16(float lo, float hi) { unsigned r; asm volatile("v_cvt_pk_bf16_f32 %0, %1, %2" : "=v"(r) : "v"(lo), "v"(hi)); return r; }
__device__ __forceinline__ u32x4 pack8(const f32x4 a, const f32x4 b) { u32x4 w; w.x = cvt_pk_bf16(a[0], a[1]); w.y = cvt_pk_bf16(a[2], a[3]); w.z = cvt_pk_bf16(b[0], b[1]); w.w = cvt_pk_bf16(b[2], b[3]); return w; }
__device__ __forceinline__ float sum4(const f32x4 a) { return (a[0] + a[1]) + (a[2] + a[3]); }
__device__ __forceinline__ float sq4(const f32x4 a) { return (a[0] * a[0] + a[1] * a[1]) + (a[2] * a[2] + a[3] * a[3]); }
constexpr float RMS_EPS_F = 1e-6f;
typedef float f32x2 __attribute__((ext_vector_type(2)));

struct EpiQKV {
    static constexpr bool PERM = true, AFTER_DRAIN = false, HAS_MID = false;
    bf16_t* Q; size_t part_stride; const float* rope; float* kpart; float qscale;
    __device__ __forceinline__ void operator()(const f32x4 (&acc)[2][2][4][2], const Unit& u, int wr, int wc, int fr, int fq) const {
        const int part = u.pn >> 2, head = (u.pn & 3) * 4 + wc;
        bf16_t* base = Q + (size_t)part * part_stride + head * 64 + 8 * fq;
        const float sc = part == 0 ? qscale : 1.f;
        const bool rot = part != 2, km = (part == 1) && (head < 8);
        const int row0 = u.pm * BM + wr * 64 + fr;
        f32x4 ks[2][2];
#pragma unroll
        for (int a = 0; a < 2; ++a)
#pragma unroll
            for (int b = 0; b < 2; ++b) ks[a][b] = (f32x4){0.f, 0.f, 0.f, 0.f};
#pragma unroll
        for (int ai = 0; ai < 2; ++ai)
#pragma unroll
            for (int m = 0; m < 4; ++m) {
                int row = row0 + ai * HALF + m * 16; asm volatile("" : "+v"(row));
                const int s = row & 4095;
                const f32x4* rp = (const f32x4*)(rope + ((size_t)s * 32 + 8 * fq) * 2);
                f32x4 t0 = rp[0], t1 = rp[1], t2 = rp[2], t3 = rp[3];
                if (!rot) { t0 = t1 = t2 = t3 = (f32x4){1.f, 0.f, 1.f, 0.f}; }
                f32x4 o1[2], o2[2];
#pragma unroll
                for (int n = 0; n < 2; ++n) {
                    const f32x4 cv = n == 0 ? (f32x4){t0[0], t0[2], t1[0], t1[2]} : (f32x4){t2[0], t2[2], t3[0], t3[2]};
                    const f32x4 sv = n == 0 ? (f32x4){t0[1], t0[3], t1[1], t1[3]} : (f32x4){t2[1], t2[3], t3[1], t3[3]};
                    const f32x4 x1 = acc[ai][0][m][n], x2 = acc[ai][1][m][n];
                    o1[n] = x1 * cv - x2 * sv; o2[n] = x2 * cv + x1 * sv;
                    ks[0][n] += o1[n]; ks[1][n] += o2[n];
                    o1[n] = o1[n] * sc; o2[n] = o2[n] * sc;
                }
                bf16_t* rowp = base + (size_t)row * 1024;
                *(u32x4*)(rowp) = pack8(o1[0], o1[1]); *(u32x4*)(rowp + 32) = pack8(o2[0], o2[1]);
            }
        if (km) {
#pragma unroll
            for (int bj = 0; bj < 2; ++bj)
#pragma unroll
                for (int n = 0; n < 2; ++n) { f32x4 v = ks[bj][n];
#pragma unroll
                    for (int o = 1; o < 16; o <<= 1) { v[0] += __shfl_xor(v[0], o); v[1] += __shfl_xor(v[1], o); v[2] += __shfl_xor(v[2], o); v[3] += __shfl_xor(v[3], o); }
                    if (fr == 0) *(f32x4*)(kpart + (size_t)(u.pm * 2 + wr) * 512 + head * 64 + 32 * bj + 8 * fq + 4 * n) = v; }
        }
    }
};

struct EpiWo {
    static constexpr bool PERM = true, AFTER_DRAIN = false, HAS_MID = true;
    const float* x; float* x1; bf16_t* xn; const float* ssq_att; float* ssq1;
    __device__ __forceinline__ void rstds(int row, float& rm, float& rd) const {
        const f32x4* p = (const f32x4*)(ssq_att + (size_t)row * 16);
        const f32x4 a = p[0], b = p[1], c = p[2], d = p[3];
        rm = __builtin_amdgcn_rsqf((sum4(a) + sum4(b)) * (1.f / 512.f) + RMS_EPS_F);
        rd = __builtin_amdgcn_rsqf((sum4(c) + sum4(d)) * (1.f / 512.f) + RMS_EPS_F);
    }
    __device__ __forceinline__ void mid(f32x4 (&acc)[2][2][4][2], const Unit& u, int wr, int fr) const {
        const int row0 = u.pm * BM + wr * 64 + fr;
#pragma unroll
        for (int ai = 0; ai < 2; ++ai)
#pragma unroll
            for (int m = 0; m < 4; ++m) { int row = row0 + ai * HALF + m * 16; asm volatile("" : "+v"(row)); float rm, rd; rstds(row, rm, rd); const float f = rm / rd;
#pragma unroll
                for (int bj = 0; bj < 2; ++bj)
#pragma unroll
                    for (int n = 0; n < 2; ++n) acc[ai][bj][m][n] = acc[ai][bj][m][n] * f;
                asm volatile("" ::: "memory"); }
    }
    __device__ __forceinline__ void operator()(const f32x4 (&acc)[2][2][4][2], const Unit& u, int wr, int wc, int fr, int fq) const {
        const int row0 = u.pm * BM + wr * 64 + fr, col0 = u.pn * BM + wc * 32 + 8 * fq;
#pragma unroll
        for (int ai = 0; ai < 2; ++ai)
#pragma unroll
            for (int m = 0; m < 4; ++m) { int row = row0 + ai * HALF + m * 16; asm volatile("" : "+v"(row)); float rm, rd; rstds(row, rm, rd); float s = 0.f;
#pragma unroll
                for (int bj = 0; bj < 2; ++bj) { const size_t off = (size_t)row * 1024 + col0 + bj * HALF;
                    const f32x4 xa = *(const f32x4*)(x + off), xb = *(const f32x4*)(x + off + 4);
                    const f32x4 v0 = xa + acc[ai][bj][m][0] * rd, v1 = xb + acc[ai][bj][m][1] * rd;
                    *(f32x4*)(x1 + off) = v0; *(f32x4*)(x1 + off + 4) = v1; *(u32x4*)(xn + off) = pack8(v0, v1); s += sq4(v0) + sq4(v1); }
                s += __shfl_xor(s, 16); s += __shfl_xor(s, 32);
                if (fq == 0) ssq1[(size_t)row * 16 + u.pn * 4 + wc] = s;
                asm volatile("" ::: "memory"); }
    }
};

struct EpiGU {
    static constexpr bool PERM = true, AFTER_DRAIN = false, HAS_MID = false;
    const float* ssq1; bf16_t* H;
    __device__ __forceinline__ void operator()(const f32x4 (&acc)[2][2][4][2], const Unit& u, int wr, int wc, int fr, int fq) const {
        const int row0 = u.pm * BM + wr * 64 + fr, col0 = u.pn * HALF + wc * 32 + 8 * fq;
#pragma unroll
        for (int ai = 0; ai < 2; ++ai)
#pragma unroll
            for (int m = 0; m < 4; ++m) { int row = row0 + ai * HALF + m * 16; asm volatile("" : "+v"(row));
                const f32x4* p = (const f32x4*)(ssq1 + (size_t)row * 16);
                const f32x4 a = p[0], b = p[1], c = p[2], d = p[3];
                const float rstd = __builtin_amdgcn_rsqf(((sum4(a) + sum4(b)) + (sum4(c) + sum4(d))) * (1.f / 1024.f) + RMS_EPS_F);
                f32x4 h[2];
#pragma unroll
                for (int n = 0; n < 2; ++n) { const f32x4 g = acc[ai][0][m][n] * rstd, uu = acc[ai][1][m][n] * rstd;
#pragma unroll
                    for (int i = 0; i < 4; ++i) h[n][i] = g[i] * __builtin_amdgcn_rcpf(1.f + __builtin_amdgcn_exp2f(g[i] * -1.4426950408889634f)) * uu[i]; }
                *(u32x4*)(H + (size_t)row * 2816 + col0) = pack8(h[0], h[1]); }
    }
};

struct EpiDown {
    static constexpr bool PERM = true, AFTER_DRAIN = false, HAS_MID = false;
    float* xio; float* ssq2;
    __device__ __forceinline__ void operator()(const f32x4 (&acc)[2][2][4][2], const Unit& u, int wr, int wc, int fr, int fq) const {
        const int row0 = u.pm * BM + wr * 64 + fr, col0 = u.pn * BM + wc * 32 + 8 * fq;
#pragma unroll
        for (int ai = 0; ai < 2; ++ai)
#pragma unroll
            for (int m = 0; m < 4; ++m) { int row = row0 + ai * HALF + m * 16; asm volatile("" : "+v"(row)); float s = 0.f;
#pragma unroll
                for (int bj = 0; bj < 2; ++bj) { const size_t off = (size_t)row * 1024 + col0 + bj * HALF;
                    const f32x4 xa = *(const f32x4*)(xio + off), xb = *(const f32x4*)(xio + off + 4);
                    const f32x4 v0 = xa + acc[ai][bj][m][0], v1 = xb + acc[ai][bj][m][1];
                    *(f32x4*)(xio + off) = v0; *(f32x4*)(xio + off + 4) = v1; s += sq4(v0) + sq4(v1); }
                s += __shfl_xor(s, 16); s += __shfl_xor(s, 32);
                if (fq == 0) ssq2[(size_t)row * 16 + u.pn * 4 + wc] = s;
                asm volatile("" ::: "memory"); }
    }
};
template <class Epi, class Sched, bool ALIGN_EPI = false, bool SP2 = false>
__device__ __forceinline__ void gemm_phase(PG8_LAS unsigned char* lds, const Gemm g, const Sched& S, const Epi& E) {
    const int tid = threadIdx.x, wid = __builtin_amdgcn_readfirstlane(tid >> 6), lane = tid & 63, wr = wid >> 2, wc = wid & 3, fr = lane & 15, fq = lane >> 4;
    const int K = g.K, nt = K / BK;
    unsigned voffA[2], voffB[2];
#pragma unroll
    for (int i = 0; i < 2; ++i) { int R, C; stage_rc(tid * 16 + i * 8192, R, C); const int Rb = Epi::PERM ? ((R & ~31) + perm32(R & 31)) : R;
        voffA[i] = (unsigned)(R * K + C) * 2u; voffB[i] = (unsigned)(Rb * K + C) * 2u; }
    const size_t kstep = (size_t)(BK * 2);
    const size_t hstep = (size_t)HALF * K * 2;
    const size_t tstep = 2 * hstep;
    const unsigned ldsw = (unsigned)wid * 1024u;
    const int aoff = lds_byte(wr * 64 + fr, fq * 8), boff = lds_byte(wc * 32 + fr, fq * 8);
#define PG8_SA(b, h) (((b) * 2 + (h)) * HTB)
#define PG8_SB(b, h) ((4 + (b) * 2 + (h)) * HTB)
#define PG8_STAGE(bufoff, gbase, voff) do { _Pragma("unroll") for (int _i = 0; _i < 2; ++_i) \
        __builtin_amdgcn_global_load_lds((const unsigned*)((const char*)(gbase) + (voff)[_i]), (PG8_LAS unsigned*)(lds + (bufoff) + ldsw + _i * 8192), 16, 0, 0); } while (0)
#define PG8_LDA(dst, b, h) do { _Pragma("unroll") for (int m = 0; m < 4; ++m) _Pragma("unroll") for (int k = 0; k < 2; ++k) dst[m][k] = *(const PG8_LAS bf16x8*)(lds + PG8_SA(b, h) + aoff + m * 2048 + k * 1024); } while (0)
#define PG8_LDB(dst, b, h) do { _Pragma("unroll") for (int n = 0; n < 2; ++n) _Pragma("unroll") for (int k = 0; k < 2; ++k) dst[n][k] = *(const PG8_LAS bf16x8*)(lds + PG8_SB(b, h) + boff + n * 2048 + k * 1024); } while (0)
#define PG8_MMA(ai, bj, At, Bt) do { __builtin_amdgcn_s_setprio(1); _Pragma("unroll") for (int m = 0; m < 4; ++m) _Pragma("unroll") for (int n = 0; n < 2; ++n) _Pragma("unroll") for (int k = 0; k < 2; ++k) \
        acc[ai][bj][m][n] = __builtin_amdgcn_mfma_f32_16x16x32_bf16(Bt[n][k], At[m][k], acc[ai][bj][m][n], 0, 0, 0); __builtin_amdgcn_s_setprio(0); } while (0)
#define PG8_WAIT_V(n) asm volatile("s_waitcnt vmcnt(" #n ")" ::: "memory")
#define PG8_WAIT_L(n) asm volatile("s_waitcnt lgkmcnt(" #n ")" ::: "memory")
#define PG8_BAR __builtin_amdgcn_s_barrier()
#define PG8_SCHED __builtin_amdgcn_sched_barrier(0)
    Unit cur, nxt; int ui = 0;
    if (!S.next(0, cur)) return;
    f32x4 acc[2][2][4][2];
#pragma unroll
    for (int a = 0; a < 2; ++a)
#pragma unroll
        for (int b = 0; b < 2; ++b)
#pragma unroll
            for (int m = 0; m < 4; ++m)
#pragma unroll
                for (int n = 0; n < 2; ++n) acc[a][b][m][n] = (f32x4){0.f, 0.f, 0.f, 0.f};
    bf16x8 At[4][2], B0[2][2], B1[2][2];
    const char* cA = (const char*)g.A + (size_t)cur.pm * tstep; const char* cB = (const char*)g.Bt + (size_t)cur.pn * tstep;
    S.a_ready(cur);
    if constexpr (SP2) {
        PG8_STAGE(PG8_SB(0, 0), cB, voffB); PG8_STAGE(PG8_SB(0, 1), cB + hstep, voffB); PG8_STAGE(PG8_SA(0, 0), cA, voffA); PG8_STAGE(PG8_SA(0, 1), cA + hstep, voffA);
        if (wr == 1) PG8_BAR;
        PG8_WAIT_V(2); PG8_BAR;
        PG8_STAGE(PG8_SB(1, 0), cB + kstep, voffB); PG8_STAGE(PG8_SA(1, 0), cA + kstep, voffA); PG8_STAGE(PG8_SB(1, 1), cB + hstep + kstep, voffB);
        PG8_WAIT_V(6); PG8_BAR;
    } else {
        PG8_STAGE(PG8_SB(0, 0), cB, voffB); PG8_STAGE(PG8_SA(0, 0), cA, voffA); PG8_STAGE(PG8_SB(0, 1), cB + hstep, voffB); PG8_STAGE(PG8_SA(0, 1), cA + hstep, voffA);
        if (wr == 1) PG8_BAR;
        PG8_WAIT_V(4); PG8_BAR;
        PG8_STAGE(PG8_SB(1, 0), cB + kstep, voffB); PG8_STAGE(PG8_SA(1, 0), cA + kstep, voffA); PG8_STAGE(PG8_SB(1, 1), cB + hstep + kstep, voffB);
        PG8_WAIT_V(6); PG8_BAR;
    }
    for (;;) {
        const bool has_next = S.next(ui + 1, nxt);
        const char* nA = has_next ? (const char*)g.A + (size_t)nxt.pm * tstep : cA; const char* nB = has_next ? (const char*)g.Bt + (size_t)nxt.pn * tstep : cB;
        for (int t = 0; t < nt; t += 2) {
            if constexpr (Epi::HAS_MID) { if (t == (nt >> 1)) E.mid(acc, cur, wr, fr); }
            const bool last = (t == nt - 2);
            const char* a1 = cA + (size_t)(t + 1) * kstep;
            const char* a2 = last ? nA : cA + (size_t)(t + 2) * kstep; const char* b2 = last ? nB : cB + (size_t)(t + 2) * kstep;
            const char* a3 = a2 + kstep; const char* b3 = b2 + kstep;
            if (last && has_next) S.a_ready(nxt);
            if constexpr (SP2) {
            PG8_LDB(B0, 0, 0); PG8_LDB(B1, 0, 1); PG8_SCHED; PG8_LDA(At, 0, 0); PG8_STAGE(PG8_SA(1, 1), a1 + hstep, voffA);
            PG8_WAIT_V(8); PG8_WAIT_L(0); PG8_BAR; PG8_MMA(0, 0, At, B0); PG8_MMA(0, 1, At, B1); PG8_BAR; PG8_SCHED;
            PG8_LDA(At, 0, 1); PG8_STAGE(PG8_SB(0, 0), b2, voffB); PG8_STAGE(PG8_SB(0, 1), b2 + hstep, voffB); PG8_STAGE(PG8_SA(0, 0), a2, voffA);
            PG8_WAIT_V(8); PG8_WAIT_L(0); PG8_BAR; PG8_MMA(1, 0, At, B0); PG8_MMA(1, 1, At, B1); PG8_BAR; PG8_SCHED;
            PG8_LDB(B0, 1, 0); PG8_LDB(B1, 1, 1); PG8_SCHED; PG8_LDA(At, 1, 0); PG8_STAGE(PG8_SA(0, 1), a2 + hstep, voffA);
            PG8_WAIT_V(8); PG8_WAIT_L(0); PG8_BAR; PG8_MMA(0, 0, At, B0); PG8_MMA(0, 1, At, B1); PG8_BAR; PG8_SCHED;
            PG8_LDA(At, 1, 1); PG8_STAGE(PG8_SB(1, 0), b3, voffB); PG8_STAGE(PG8_SB(1, 1), b3 + hstep, voffB); PG8_STAGE(PG8_SA(1, 0), a3, voffA);
            PG8_WAIT_V(8); PG8_WAIT_L(0); PG8_BAR; PG8_MMA(1, 0, At, B0); PG8_MMA(1, 1, At, B1); PG8_BAR; PG8_SCHED;
            } else {
            PG8_LDB(B0, 0, 0); PG8_SCHED; PG8_LDA(At, 0, 0); PG8_STAGE(PG8_SA(1, 1), a1 + hstep, voffA);
            PG8_WAIT_L(8); PG8_BAR; PG8_WAIT_L(0); PG8_MMA(0, 0, At, B0); PG8_BAR; PG8_SCHED;
            PG8_LDB(B1, 0, 1); PG8_STAGE(PG8_SB(0, 0), b2, voffB);
            PG8_BAR; PG8_WAIT_L(0); PG8_MMA(0, 1, At, B1); PG8_BAR;
            PG8_LDA(At, 0, 1); PG8_STAGE(PG8_SA(0, 0), a2, voffA);
            PG8_BAR; PG8_WAIT_L(0); PG8_MMA(1, 0, At, B0); PG8_BAR; PG8_SCHED;
            PG8_STAGE(PG8_SB(0, 1), b2 + hstep, voffB);
            PG8_WAIT_V(6); PG8_BAR; PG8_MMA(1, 1, At, B1); PG8_BAR;
            PG8_LDB(B0, 1, 0); PG8_SCHED; PG8_LDA(At, 1, 0); PG8_STAGE(PG8_SA(0, 1), a2 + hstep, voffA);
            PG8_WAIT_L(8); PG8_BAR; PG8_WAIT_L(0); PG8_MMA(0, 0, At, B0); PG8_BAR; PG8_SCHED;
            PG8_LDB(B1, 1, 1); PG8_STAGE(PG8_SB(1, 0), b3, voffB);
            PG8_BAR; PG8_WAIT_L(0); PG8_MMA(0, 1, At, B1); PG8_BAR;
            PG8_LDA(At, 1, 1); PG8_STAGE(PG8_SA(1, 0), a3, voffA);
            PG8_BAR; PG8_WAIT_L(0); PG8_MMA(1, 0, At, B0); PG8_BAR; PG8_SCHED;
            PG8_STAGE(PG8_SB(1, 1), b3 + hstep, voffB);
            PG8_WAIT_V(6); PG8_BAR; PG8_MMA(1, 1, At, B1); PG8_BAR;
            }
        }
        if constexpr (ALIGN_EPI) { if (wr == 0) PG8_BAR; }
        if constexpr (!Epi::AFTER_DRAIN) { E(acc, cur, wr, wc, fr, fq); S.done(cur); }
        if (!has_next) break;
#pragma unroll
        for (int a = 0; a < 2; ++a)
#pragma unroll
            for (int b = 0; b < 2; ++b)
#pragma unroll
                for (int m = 0; m < 4; ++m)
#pragma unroll
                    for (int n = 0; n < 2; ++n) acc[a][b][m][n] = (f32x4){0.f, 0.f, 0.f, 0.f};
        cur = nxt; cA = nA; cB = nB; ++ui;
        if constexpr (ALIGN_EPI) { if (wr == 1) PG8_BAR; }
    }
    PG8_WAIT_V(0);
    if constexpr (!ALIGN_EPI) { if (wr == 0) PG8_BAR; }
    PG8_BAR;
    if constexpr (Epi::AFTER_DRAIN) { E.fused(acc, cur, wr, wc, fr, fq, lds, wid, lane); S.done(cur); }
#undef PG8_SA
#undef PG8_SB
#undef PG8_STAGE
#undef PG8_LDA
#undef PG8_LDB
#undef PG8_MMA
#undef PG8_WAIT_V
#undef PG8_WAIT_L
#undef PG8_BAR
#undef PG8_SCHED
}
}

constexpr int NWAVES = 8;
#ifndef MK_N_LAUNCHES
#define MK_N_LAUNCHES 7
#endif
constexpr int PER_PHASE = 7;
constexpr int N_LAUNCHES = MK_N_LAUNCHES;

constexpr int BATCH = 8, SEQ = 4096, D = 1024, NH = 16, HD = 64, FF = 2816, NHM = 8;
constexpr int M = BATCH * SEQ;
constexpr int NQKV = 3 * D, NGU = 2 * FF;
constexpr float RMS_EPS = 1e-6f;
constexpr float QSCALE = 0.125f * 1.4426950408889634f;

constexpr size_t MiB = 1u << 20;
constexpr size_t WS_CTL = 0, CTL_ZERO_BYTES = 1 * MiB;
constexpr size_t WS_ROPE = 1 * MiB;
constexpr size_t WS_WQKV = 2 * MiB, WS_WO = 8 * MiB, WS_WGU = 10 * MiB, WS_WD = 21 * MiB;
constexpr size_t WS_KPART = 27 * MiB;
constexpr size_t WS_SSQA = 28 * MiB, WS_SSQ1 = 30 * MiB, WS_SSQ2 = 32 * MiB;
constexpr size_t WS_XN = 40 * MiB;
constexpr size_t WS_QO = 104 * MiB, WS_K = 168 * MiB, WS_V = 232 * MiB;
constexpr size_t WS_H = 104 * MiB;
constexpr size_t WS_END = 296 * MiB;
constexpr int CW_TMO = 0, CW_CODE = 1;
constexpr int CW_BAR = 4096;

constexpr int RING_OFF = 0, RING_BYTES = 131072;
constexpr int LDSCTL_OFF = RING_BYTES, MISC_OFF = LDSCTL_OFF + 320;
constexpr int LDS_BYTES = 147456;
static_assert(WS_V - WS_K == WS_K - WS_QO, "Q | K | V equally spaced");
#define GAS __attribute__((address_space(1)))
#define LAS __attribute__((address_space(3)))
typedef unsigned short bf16;
typedef unsigned v4u __attribute__((ext_vector_type(4)));
typedef float f32x4 __attribute__((ext_vector_type(4)));
typedef short bf16x8 __attribute__((ext_vector_type(8)));
typedef GAS unsigned gu32;
typedef GAS unsigned long long gu64;
#define RLX_AGENT __ATOMIC_RELAXED, __HIP_MEMORY_SCOPE_AGENT
#define LDS_WAIT() asm volatile("s_waitcnt lgkmcnt(0)" ::: "memory")
#define VM_WAIT() asm volatile("s_waitcnt vmcnt(0)" ::: "memory")
__device__ __forceinline__ unsigned long long rt() { return __builtin_amdgcn_s_memrealtime(); }
__device__ __forceinline__ unsigned f2bf(float f) { unsigned u = __builtin_bit_cast(unsigned, f); return (u + 0x7fffu + ((u >> 16) & 1u)) >> 16; }
__device__ __forceinline__ unsigned pk2(float lo, float hi) { return f2bf(lo) | (f2bf(hi) << 16); }

#define XB_TMO      128
#define XB_XCNT(j)  (256  + 64 * (j))
#define XB_XSUB(j)  (1280 + 64 * (j))
#define XB_XGEN(j)  (2304 + 64 * (j))
#define XB_TOP      3328
#define XB_TOPGEN   3392
#define XCD_BAR_WORDS 3456
#define XB_SPIN_CAP (1u << 18)

__device__ __forceinline__ unsigned xb_ld(unsigned* p)              { return __hip_atomic_load(p, __ATOMIC_RELAXED, __HIP_MEMORY_SCOPE_AGENT); }
__device__ __forceinline__ unsigned xb_add(unsigned* p, unsigned v) { return __hip_atomic_fetch_add(p, v, __ATOMIC_RELAXED, __HIP_MEMORY_SCOPE_AGENT); }
__device__ __forceinline__ unsigned xb_xcc_id() { return (unsigned)__builtin_amdgcn_s_getreg((3 << 11) | 20) & 0xFu; }
#define XB_SPIN(cond, bar) do { unsigned _sp = 0; while (cond) { __builtin_amdgcn_s_sleep(1); \
    if ((++_sp & 255u) == 0u) { if (xb_ld(&(bar)[XB_TMO])) break; if (_sp > XB_SPIN_CAP) { atomicAdd(&(bar)[XB_TMO], 1u); break; } } } } while (0)

struct XcdBarrier {
    unsigned* bar; unsigned x;
    volatile LAS unsigned* st;
};

__device__ __forceinline__ XcdBarrier xcd_barrier_post(unsigned* bar, volatile LAS unsigned* st) {
    XcdBarrier b; b.bar = bar; b.x = xb_xcc_id(); b.st = st;
    if (threadIdx.x == 0) (void)xb_add(&bar[XB_XCNT(b.x)], 1u);
    return b;
}
__device__ __forceinline__ void xcd_barrier_complete(unsigned* bar, unsigned x, unsigned& nloc, unsigned& nx) {
    const unsigned G = gridDim.x * gridDim.y * gridDim.z;
    unsigned sum, cnt, mine, sp = 0u;
    for (;;) {
        sum = 0u; cnt = 0u; mine = 0u;
#pragma unroll
        for (unsigned j = 0; j < 16; ++j) { const unsigned c = xb_ld(&bar[XB_XCNT(j)]); sum += c; cnt += (c > 0u) ? 1u : 0u; mine = (j == x) ? c : mine; }
        if (sum == G) break;
        __builtin_amdgcn_s_sleep(1);
        if ((++sp & 255u) == 0u) { if (xb_ld(&bar[XB_TMO])) break; if (sp > XB_SPIN_CAP) { atomicAdd(&bar[XB_TMO], 1u); break; } }
    }
    nloc = mine > 0u ? mine : 1u; nx = cnt > 0u ? cnt : 1u;
}

__device__ __forceinline__ void xcd_barrier(const XcdBarrier& b) {
    asm volatile("s_waitcnt vmcnt(0)" ::: "memory");
    __syncthreads();
    if (threadIdx.x == 0) {
        unsigned* bar = b.bar;
        __builtin_amdgcn_s_waitcnt(0);
        unsigned nloc = b.st[0], nx = b.st[1];
        if (nloc == 0u) { xcd_barrier_complete(bar, b.x, nloc, nx); b.st[0] = nloc; b.st[1] = nx; }
        const unsigned old = xb_add(&bar[XB_XSUB(b.x)], 1u);
        const unsigned gen = old / nloc;
        if (old + 1u == (gen + 1u) * nloc) {
            __builtin_amdgcn_fence(__ATOMIC_RELEASE, "agent");
            asm volatile("s_waitcnt vmcnt(0)" ::: "memory");
            const unsigned og = xb_add(&bar[XB_TOP], 1u);
            const unsigned tg = og / nx;
            if (og + 1u == (tg + 1u) * nx) xb_add(&bar[XB_TOPGEN], 1u);
            else XB_SPIN(xb_ld(&bar[XB_TOPGEN]) == tg, bar);
            __builtin_amdgcn_fence(__ATOMIC_ACQUIRE, "agent");
            xb_add(&bar[XB_XGEN(b.x)], 1u);
            asm volatile("s_waitcnt vmcnt(0)" ::: "memory");
        } else {
            XB_SPIN(xb_ld(&bar[XB_XGEN(b.x)]) == gen, bar);
            __builtin_amdgcn_fence(__ATOMIC_ACQUIRE, "agent");
            asm volatile("s_waitcnt vmcnt(0)" ::: "memory");
        }
    }
    __syncthreads();
}


struct Frame {
    LAS unsigned char* lds;
    volatile LAS unsigned* MISC;
    gu32* ctl;
    int tid, lane, wave;
    int vcu, G;
    const float *x, *attn_norm, *w_in, *moba_norm, *dil_norm, *w_out, *ffn_norm, *w_gate, *w_up, *w_down, *final_norm;
    float* out;
    bf16 *Wqkv_t, *Wo_t, *Wgu_t, *Wd_t;
    bf16 *QO, *KB, *VB, *HB, *XN;
    float *rope, *kpart, *ssqa, *ssq1, *ssq2;
};

__device__ __forceinline__ float wave_sum(float v) {
#pragma unroll
    for (int o = 1; o < 64; o <<= 1) v += __shfl_xor(v, o);
    return v;
}
__device__ __forceinline__ int qkv_vrow(int n) { const int part = n >> 10, head = (n >> 6) & 15, d = n & 63; return 256 * (part * 4 + (head >> 2)) + 128 * (d >> 5) + 32 * (head & 3) + (d & 31); }
template <int MODE>
__device__ __forceinline__ void p0_item(const float* W, int K, int N, bf16* WT, const float* g0, const float* g1, LAS float* scr, int item, int lane) {
    const int nblk = N / 32, kb = item / nblk, nb = item % nblk, k0 = 64 * kb, n0 = 32 * nb;
#pragma unroll 8
    for (int i = 0; i < 32; ++i) { const int kk = 2 * i + (lane >> 5), k = k0 + kk; float w = W[(size_t)k * N + n0 + (lane & 31)];
        if (MODE == 1) w *= (k < 512 ? g0[k] : g1[k - 512]);
        if (MODE == 2 || MODE == 3) w *= g0[k];
        scr[kk * 33 + (lane & 31)] = w; }
    LDS_WAIT(); asm volatile("" ::: "memory");
    const int c = lane & 7;
#pragma unroll
    for (int j = 0; j < 4; ++j) { const int n = (lane >> 3) + 8 * j; const LAS float* s = scr + (8 * c) * 33 + n;
        v4u o; o.x = pk2(s[0 * 33], s[1 * 33]); o.y = pk2(s[2 * 33], s[3 * 33]); o.z = pk2(s[4 * 33], s[5 * 33]); o.w = pk2(s[6 * 33], s[7 * 33]);
        const int ns = n0 + n; int dr;
        if (MODE == 0) dr = qkv_vrow(ns); else if (MODE == 2) dr = 256 * (ns >> 7) + (ns & 127); else if (MODE == 3) dr = 256 * (ns >> 7) + 128 + (ns & 127); else dr = ns;
        *(GAS v4u*)(WT + (size_t)dr * K + k0 + 8 * c) = o; }
    LDS_WAIT(); asm volatile("" ::: "memory");
}
__device__ __forceinline__ void rms_row_to_bf16(Frame& F, const float* xrow, const float* gain, bf16* orow) {
    const GAS f32x4* xr = (const GAS f32x4*)xrow + F.lane; const GAS f32x4* gr = (const GAS f32x4*)gain + F.lane;
    f32x4 v[4]; float s = 0.f;
#pragma unroll
    for (int j = 0; j < 4; ++j) { v[j] = xr[64 * j]; s += (v[j].x * v[j].x + v[j].y * v[j].y) + (v[j].z * v[j].z + v[j].w * v[j].w); }
    const float rstd = 1.f / sqrtf(wave_sum(s) * (1.f / D) + RMS_EPS);
    GAS unsigned long long* o8 = (GAS unsigned long long*)orow + F.lane;
#pragma unroll
    for (int j = 0; j < 4; ++j) { const f32x4 g = gr[64 * j];
        o8[64 * j] = (unsigned long long)pk2(v[j].x * rstd * g.x, v[j].y * rstd * g.y) | ((unsigned long long)pk2(v[j].z * rstd * g.z, v[j].w * rstd * g.w) << 32); }
}
__device__ __forceinline__ void p0_prologue(Frame& F) {
    LAS float* scr = (LAS float*)(F.lds + RING_OFF + F.wave * 16384);
    const int gw = F.vcu * NWAVES + F.wave, NGW = F.G * NWAVES;
    constexpr int I_IN = (D / 64) * (NQKV / 32), I_O = (D / 64) * (D / 32), I_G = (D / 64) * (FF / 32), I_D = (FF / 64) * (D / 32);
    constexpr int NITEMS = I_IN + I_O + 2 * I_G + I_D;
    for (int it = gw; it < NITEMS; it += NGW) {
        int r = it;
        if (r < I_IN) { p0_item<0>(F.w_in, D, NQKV, F.Wqkv_t, nullptr, nullptr, scr, r, F.lane); continue; } r -= I_IN;
        if (r < I_O) { p0_item<1>(F.w_out, D, D, F.Wo_t, F.moba_norm, F.dil_norm, scr, r, F.lane); continue; } r -= I_O;
        if (r < I_G) { p0_item<2>(F.w_gate, D, FF, F.Wgu_t, F.ffn_norm, nullptr, scr, r, F.lane); continue; } r -= I_G;
        if (r < I_G) { p0_item<3>(F.w_up, D, FF, F.Wgu_t, F.ffn_norm, nullptr, scr, r, F.lane); continue; } r -= I_G;
        p0_item<4>(F.w_down, FF, D, F.Wd_t, nullptr, nullptr, scr, r, F.lane);
    }
    for (int e = (F.vcu * NWAVES * 64) + F.tid; e < SEQ * 32; e += F.G * NWAVES * 64) {
        const int s = e >> 5, j = e & 31;
        const float invf = __builtin_amdgcn_exp2f(-(float)j * (13.287712379549449f / 32.0f));
        double rev = (double)s * (double)invf * 0.15915494309189535; rev -= __builtin_floor(rev);
        const float r = (float)rev;
        pg8::f32x2 cs; cs.x = __builtin_amdgcn_cosf(r); cs.y = __builtin_amdgcn_sinf(r);
        *(GAS pg8::f32x2*)((pg8::f32x2*)F.rope + e) = cs;
    }
    for (int m = gw; m < M; m += NGW) rms_row_to_bf16(F, F.x + (size_t)m * D, F.attn_norm, F.XN + (size_t)m * D);
}

#define BFLO(w) __uint_as_float((w) << 16)
#define BFHI(w) __uint_as_float((w) & 0xffff0000u)
#define LOAD_ROW64(dst, ptr) do { const GAS v4u* p_ = (const GAS v4u*)(ptr); _Pragma("unroll") for (int c_ = 0; c_ < 8; ++c_) { const v4u w_ = p_[c_]; \
    dst[8 * c_ + 0] = BFLO(w_.x); dst[8 * c_ + 1] = BFHI(w_.x); dst[8 * c_ + 2] = BFLO(w_.y); dst[8 * c_ + 3] = BFHI(w_.y); dst[8 * c_ + 4] = BFLO(w_.z); dst[8 * c_ + 5] = BFHI(w_.z); dst[8 * c_ + 6] = BFLO(w_.w); dst[8 * c_ + 7] = BFHI(w_.w); } } while (0)
#define DOT8(w_, c_) (q[8 * c_] * BFLO(w_.x) + q[8 * c_ + 1] * BFHI(w_.x) + q[8 * c_ + 2] * BFLO(w_.y) + q[8 * c_ + 3] * BFHI(w_.y) + q[8 * c_ + 4] * BFLO(w_.z) + q[8 * c_ + 5] * BFHI(w_.z) + q[8 * c_ + 6] * BFLO(w_.w) + q[8 * c_ + 7] * BFHI(w_.w))
#define SIMPLE_KEY(krow) do { const GAS v4u* kp_ = (const GAS v4u*)(Kh + (size_t)(krow) * D); float sc_ = 0.f; \
    _Pragma("unroll") for (int c_ = 0; c_ < 8; ++c_) { const v4u w_ = kp_[c_]; sc_ += DOT8(w_, c_); } \
    if (sc_ > mx) { const float f_ = __builtin_amdgcn_exp2f(mx - sc_); l *= f_; _Pragma("unroll") for (int d_ = 0; d_ < 64; ++d_) o[d_] *= f_; mx = sc_; } \
    const float p_ = __builtin_amdgcn_exp2f(sc_ - mx); l += p_; const GAS v4u* vp_ = (const GAS v4u*)(Vh + (size_t)(krow) * D); \
    _Pragma("unroll") for (int c_ = 0; c_ < 8; ++c_) { const v4u w_ = vp_[c_]; o[8 * c_] += p_ * BFLO(w_.x); o[8 * c_ + 1] += p_ * BFHI(w_.x); o[8 * c_ + 2] += p_ * BFLO(w_.y); o[8 * c_ + 3] += p_ * BFHI(w_.y); \
        o[8 * c_ + 4] += p_ * BFLO(w_.z); o[8 * c_ + 5] += p_ * BFHI(w_.z); o[8 * c_ + 6] += p_ * BFLO(w_.w); o[8 * c_ + 7] += p_ * BFHI(w_.w); } } while (0)

__device__ __forceinline__ void attn_simple(Frame& F) {
    const int gt = F.vcu * (NWAVES * 64) + F.tid, NT = F.G * NWAVES * 64;
    for (int it = gt; it < BATCH * NH * SEQ; it += NT) {
        const int s = it & (SEQ - 1), bh = it >> 12, h = bh & 15, b = bh >> 4;
        const size_t row = (size_t)b * SEQ + s;
        const bf16* Kh = F.KB + (size_t)b * SEQ * D + h * HD; const bf16* Vh = F.VB + (size_t)b * SEQ * D + h * HD;
        float q[64], o[64]; LOAD_ROW64(q, F.QO + row * D + h * HD);
#pragma unroll
        for (int d = 0; d < 64; ++d) o[d] = 0.f;
        float mx = -1e30f, l = 0.f;
        if (h < NHM) {
            const int own = s >> 8;
            float g0 = -3e38f, g1 = -3e38f, g2 = -3e38f; int s0 = 0, s1 = 0, s2 = 0;
            for (int j = 0; j < own; ++j) {
                const GAS f32x4* ka = (const GAS f32x4*)(F.kpart + (size_t)((b * 16 + j) * 2) * 512 + h * 64); const GAS f32x4* kb = ka + 128;
                float g = 0.f;
#pragma unroll
                for (int c = 0; c < 16; ++c) { const f32x4 a = ka[c], bb = kb[c]; g += q[4 * c] * (a.x + bb.x) + q[4 * c + 1] * (a.y + bb.y) + q[4 * c + 2] * (a.z + bb.z) + q[4 * c + 3] * (a.w + bb.w); }
                if (g > g0) { g2 = g1; s2 = s1; g1 = g0; s1 = s0; g0 = g; s0 = j; }
                else if (g > g1) { g2 = g1; s2 = s1; g1 = g; s1 = j; }
                else if (g > g2) { g2 = g; s2 = j; }
            }
            const int nsel = own < 3 ? own : 3;
            for (int sl = 0; sl < nsel; ++sl) { const int blk = sl == 0 ? s0 : (sl == 1 ? s1 : s2);
                for (int kk = 0; kk < 256; ++kk) SIMPLE_KEY(blk * 256 + kk); }
            for (int kk = own * 256; kk <= s; ++kk) SIMPLE_KEY(kk);
        } else {
            for (int br = 0; br < 3; ++br) { const int dil = br == 0 ? 1 : (br == 1 ? 4 : 16);
                for (int mm = 0; mm <= 128; ++mm) { const int kp = s - mm * dil; if (kp < 0) break; SIMPLE_KEY(kp); } }
        }
        const float inv = 1.f / l; float ss = 0.f;
#pragma unroll
        for (int d = 0; d < 64; ++d) { o[d] *= inv; ss += o[d] * o[d]; }
        GAS v4u* op = (GAS v4u*)(F.QO + row * D + h * HD);
#pragma unroll
        for (int c = 0; c < 8; ++c) { v4u w; w.x = pk2(o[8 * c], o[8 * c + 1]); w.y = pk2(o[8 * c + 2], o[8 * c + 3]); w.z = pk2(o[8 * c + 4], o[8 * c + 5]); w.w = pk2(o[8 * c + 6], o[8 * c + 7]); op[c] = w; }
        F.ssqa[row * 16 + h] = ss;
    }
}

__device__ __forceinline__ void p6_final(Frame& F) {
    const int gw = F.vcu * NWAVES + F.wave, NGW = F.G * NWAVES;
    const GAS f32x4* gr = (const GAS f32x4*)F.final_norm + F.lane;
    for (int m = gw; m < M; m += NGW) {
        GAS f32x4* xr = (GAS f32x4*)(F.out + (size_t)m * D) + F.lane;
        const GAS f32x4* sp = (const GAS f32x4*)(F.ssq2 + (size_t)m * 16);
        const f32x4 a = sp[0], b = sp[1], c = sp[2], d = sp[3];
        const float ss = ((a.x + a.y) + (a.z + a.w)) + ((b.x + b.y) + (b.z + b.w)) + ((c.x + c.y) + (c.z + c.w)) + ((d.x + d.y) + (d.z + d.w));
        const float rstd = 1.f / sqrtf(ss * (1.f / D) + RMS_EPS);
#pragma unroll
        for (int j = 0; j < 4; ++j) { const f32x4 v = xr[64 * j], g = gr[64 * j]; xr[64 * j] = v * rstd * g; }
    }
}

struct Args { const float* in[11]; float* out; unsigned char* ws; int ph_lo, ph_hi, li, pad; };
__global__ void __launch_bounds__(NWAVES * 64, 2) mk_fwd(Args args) {
    extern __shared__ __attribute__((aligned(16))) unsigned char lds[];
    Frame F;
    F.lds = (LAS unsigned char*)lds;
    F.MISC = (volatile LAS unsigned*)(F.lds + MISC_OFF);
    F.tid = threadIdx.x; F.lane = F.tid & 63; F.wave = __builtin_amdgcn_readfirstlane(F.tid >> 6);
    F.G = gridDim.x; { const int bx = blockIdx.x; F.vcu = (F.G % 8 == 0) ? (bx % 8) * (F.G / 8) + bx / 8 : bx; }
#define GRID_BAR(seam) do { if (N_LAUNCHES == PER_PHASE) { if (F.tid == 0) __hip_atomic_store(F.ctl + CW_TMO, 0xBADBA0u | (unsigned)(seam), RLX_AGENT); } \
    else { xcd_barrier(bar); } } while (0)
    unsigned char* ws = args.ws;
    F.ctl = (gu32*)(ws + WS_CTL);
    F.x = args.in[0]; F.attn_norm = args.in[1]; F.w_in = args.in[2]; F.moba_norm = args.in[3]; F.dil_norm = args.in[4]; F.w_out = args.in[5];
    F.ffn_norm = args.in[6]; F.w_gate = args.in[7]; F.w_up = args.in[8]; F.w_down = args.in[9]; F.final_norm = args.in[10]; F.out = args.out;
    F.Wqkv_t = (bf16*)(ws + WS_WQKV); F.Wo_t = (bf16*)(ws + WS_WO); F.Wgu_t = (bf16*)(ws + WS_WGU); F.Wd_t = (bf16*)(ws + WS_WD);
    F.QO = (bf16*)(ws + WS_QO); F.KB = (bf16*)(ws + WS_K); F.VB = (bf16*)(ws + WS_V); F.HB = (bf16*)(ws + WS_H); F.XN = (bf16*)(ws + WS_XN);
    F.rope = (float*)(ws + WS_ROPE); F.kpart = (float*)(ws + WS_KPART); F.ssqa = (float*)(ws + WS_SSQA); F.ssq1 = (float*)(ws + WS_SSQ1); F.ssq2 = (float*)(ws + WS_SSQ2);
    for (int u = F.tid; u < (LDS_BYTES - LDSCTL_OFF) / 4; u += NWAVES * 64) ((LAS unsigned*)(F.lds + LDSCTL_OFF))[u] = 0u;
    __syncthreads();
    XcdBarrier bar; bar.bar = (unsigned*)(F.ctl + CW_BAR); bar.x = 0; bar.st = nullptr;
    if (N_LAUNCHES != PER_PHASE) bar = xcd_barrier_post((unsigned*)(F.ctl + CW_BAR), F.MISC + 8);
    const int lo = args.ph_lo, hi = args.ph_hi;
#define IN(k) (lo <= (k) && (k) < hi)
#define BOTH(k) (IN(k) && IN((k) + 1))

    if (IN(0)) { p0_prologue(F); if (BOTH(0)) GRID_BAR(0); }

    if (IN(1)) {
        pg8::Gemm g{F.XN, F.Wqkv_t, M, NQKV, D}; pg8::StaticOrder S; S.init(M, NQKV, F.G, (int)blockIdx.x);
        pg8::EpiQKV E{F.QO, (size_t)(WS_K - WS_QO) / 2, F.rope, F.kpart, QSCALE};
        pg8::gemm_phase<pg8::EpiQKV, pg8::StaticOrder, true, true>(F.lds + RING_OFF, g, S, E);
        if (BOTH(1)) GRID_BAR(1);
    }

    if (IN(2)) {
        attn_simple(F);
        if (BOTH(2)) GRID_BAR(2);
    }

    if (IN(3)) {
        pg8::Gemm g{F.QO, F.Wo_t, M, D, D}; pg8::StaticOrder S; S.init(M, D, F.G, (int)blockIdx.x);
        pg8::EpiWo E{F.x, F.out, F.XN, F.ssqa, F.ssq1};
        pg8::gemm_phase<pg8::EpiWo, pg8::StaticOrder, true, true>(F.lds + RING_OFF, g, S, E);
        if (BOTH(3)) GRID_BAR(3);
    }

    if (IN(4)) {
        pg8::Gemm g{F.XN, F.Wgu_t, M, NGU, D}; pg8::StaticOrder S; S.init(M, NGU, F.G, (int)blockIdx.x);
        pg8::EpiGU E{F.ssq1, F.HB};
        pg8::gemm_phase<pg8::EpiGU, pg8::StaticOrder, true, true>(F.lds + RING_OFF, g, S, E);
        if (BOTH(4)) GRID_BAR(4);
    }

    if (IN(5)) {
        pg8::Gemm g{F.HB, F.Wd_t, M, D, FF}; pg8::StaticOrder S; S.init(M, D, F.G, (int)blockIdx.x);
        pg8::EpiDown E{F.out, F.ssq2};
        pg8::gemm_phase<pg8::EpiDown, pg8::StaticOrder, true, true>(F.lds + RING_OFF, g, S, E);
        if (BOTH(5)) GRID_BAR(5);
    }

    if (IN(6)) { p6_final(F); }
#undef IN
#undef BOTH
}

extern "C" void kernel_launch(void* const* d_in, const int* in_sizes, int n_in, void* d_out, int out_size, void* d_ws, size_t ws_size, hipStream_t stream) {
    static int grid = 0;
    if (grid == 0) {
        if (n_in != 11 || in_sizes[0] != M * D || out_size != M * D || ws_size < WS_END) { fprintf(stderr, "kernel_launch: unexpected shapes (n_in %d, in0 %d, out %d, ws %zu); nothing launched\n", n_in, n_in > 0 ? in_sizes[0] : -1, out_size, ws_size); grid = -1; return; }
        int dev = 0, cus = 0, per_cu = 0;
        if (hipGetDevice(&dev) != hipSuccess || hipDeviceGetAttribute(&cus, hipDeviceAttributeMultiprocessorCount, dev) != hipSuccess) { grid = -1; return; }
        if (hipFuncSetAttribute((const void*)mk_fwd, hipFuncAttributeMaxDynamicSharedMemorySize, LDS_BYTES) != hipSuccess) { fprintf(stderr, "kernel_launch: hipFuncSetAttribute failed\n"); grid = -1; return; }
        if (hipOccupancyMaxActiveBlocksPerMultiprocessor(&per_cu, (const void*)mk_fwd, NWAVES * 64, LDS_BYTES) != hipSuccess || per_cu < 1) { fprintf(stderr, "kernel_launch: occupancy query says %d blocks per CU\n", per_cu); (void)hipGetLastError(); per_cu = 1; }
        grid = cus;
        if (grid > 256) grid = 256;
    }
    if (grid < 0) return;
    if (hipMemsetAsync((char*)d_ws + WS_CTL, 0, CTL_ZERO_BYTES, stream) != hipSuccess) { fprintf(stderr, "kernel_launch: hipMemsetAsync failed\n"); return; }
    Args a{};
    for (int i = 0; i < 11; ++i) a.in[i] = (const float*)d_in[i];
    a.out = (float*)d_out; a.ws = (unsigned char*)d_ws;
    for (int li = 0; li < N_LAUNCHES; ++li) {
        a.ph_lo = (N_LAUNCHES == PER_PHASE) ? li : 0; a.ph_hi = (N_LAUNCHES == PER_PHASE) ? li + 1 : PER_PHASE; a.li = li;
        hipLaunchKernelGGL(mk_fwd, dim3(grid), dim3(NWAVES * 64), LDS_BYTES, stream, a);
        const hipError_t le = hipPeekAtLastError();
        if (le != hipSuccess) { fprintf(stderr, "kernel_launch: launch %d failed: %s\n", li, hipGetErrorName(le)); break; }
    }
}
```

```cpp
#include <hip/hip_runtime.h>
#include <cstdio>
#include <cstdint>
namespace pg8 {
#define PG8_LAS __attribute__((address_space(3)))
typedef unsigned short bf16_t;
typedef short bf16x8 __attribute__((ext_vector_type(8)));
typedef float f32x4 __attribute__((ext_vector_type(4)));
typedef unsigned u32x4 __attribute__((ext_vector_type(4)));
typedef int i32x4 __attribute__((ext_vector_type(4)));
typedef int i32x8 __attribute__((ext_vector_type(8)));
typedef unsigned u32x2 __attribute__((ext_vector_type(2)));
constexpr int BM = 256, BK = 64, HALF = 128, HTB = HALF * BK * 2  , STAGE_BYTES = 8 * HTB, NXCD = 8, WGM = 8;

__host__ __device__ __forceinline__ int lds_byte(int r, int c) { const int st = (r >> 4) * 2 + (c >> 5), rr = r & 15, cc = c & 31, ob = rr * 64 + cc * 2; return st * 1024 + (ob ^ (((ob >> 9) & 1) << 5)); }
__host__ __device__ __forceinline__ void stage_rc(int b, int& R, int& C) { const int st = b / 1024, sb = b % 1024, swz = sb ^ (((sb >> 9) & 1) << 5); R = (st >> 1) * 16 + swz / 64; C = (st & 1) * 32 + (swz % 64) / 2; }
__host__ __device__ __forceinline__ int perm32(int rho) { const int n = rho >> 4, i = rho & 15; return 8 * (i >> 2) + 4 * n + (i & 3); }

struct Unit { int pm, pn; };
struct Gemm { const bf16_t* A; const bf16_t* Bt; int M, N, K; };

struct StaticOrder {
    int nM, nN, nwg, G, c, reps;
    __host__ __device__ void init(int M, int N, int G_, int c_, int reps_ = 1) { nM = M / BM; nN = N / BM; nwg = nM * nN; G = G_; c = c_; reps = reps_; }
    __host__ __device__ bool next(int i, Unit& u) const {
        const int rounds = (nwg + G - 1) / G; if (i >= reps * rounds) return false;
        const long L = (long)(i % rounds) * G + c; if (L >= nwg) return false;
        int wgid = (int)L; { const int q = nwg / NXCD, r = nwg % NXCD, xcd = wgid % NXCD, off = wgid / NXCD; wgid = (xcd < r ? xcd * (q + 1) : r * (q + 1) + (xcd - r) * q) + off; }
        const int nig = WGM * nN, gid = wgid / nig, fm = gid * WGM, gsz = (nM - fm) < WGM ? (nM - fm) : WGM;
        u.pm = fm + ((wgid % nig) % gsz); u.pn = (wgid % nig) / gsz; return true;
    }
    __device__ __forceinline__ void a_ready(const Unit&) const {}
    __device__ __forceinline__ void done(const Unit&) const {}
};


__device__ __forceinline__ unsigned cvt_pk_bf16(float lo, float hi) { unsigned r; asm volatile("v_cvt_pk_bf16_f32 %0, %1, %2" : "=v"(r) : "v"(lo), "v"(hi)); return r; }
__device__ __forceinline__ u32x4 pack8(const f32x4 a, const f32x4 b) { u32x4 w; w.x = cvt_pk_bf16(a[0], a[1]); w.y = cvt_pk_bf16(a[2], a[3]); w.z = cvt_pk_bf16(b[0], b[1]); w.w = cvt_pk_bf16(b[2], b[3]); return w; }
__device__ __forceinline__ float sum4(const f32x4 a) { return (a[0] + a[1]) + (a[2] + a[3]); }
__device__ __forceinline__ float sq4(const f32x4 a) { return (a[0] * a[0] + a[1] * a[1]) + (a[2] * a[2] + a[3] * a[3]); }
constexpr float RMS_EPS_F = 1e-6f;
__device__ __forceinline__ int lane_id() { int l; asm volatile("v_mbcnt_lo_u32_b32 %0, -1, 0\n\tv_mbcnt_hi_u32_b32 %0, -1, %0" : "=v"(l)); return l; }
__device__ __forceinline__ u32x2 pack8_fp8(const f32x4 a, const f32x4 b) { u32x2 w; unsigned t = 0;
    t = __builtin_amdgcn_cvt_pk_fp8_f32(a[0], a[1], t, false); t = __builtin_amdgcn_cvt_pk_fp8_f32(a[2], a[3], t, true); w.x = t; t = 0;
    t = __builtin_amdgcn_cvt_pk_fp8_f32(b[0], b[1], t, false); t = __builtin_amdgcn_cvt_pk_fp8_f32(b[2], b[3], t, true); w.y = t; return w; }
constexpr float F8_SA = 16.f, F8_SH = 8.f, F8_SW = 512.f, F8_SO = 64.f;
typedef float f32x2 __attribute__((ext_vector_type(2)));

struct EpiQKV {
    static constexpr bool PERM = true, AFTER_DRAIN = false, HAS_MID = false;
    bf16_t* Q; size_t part_stride; const float* rope; float* kpart; float qscale; int mapsel; float ascale;
    __device__ __forceinline__ void operator()(const f32x4 (&acc)[2][2][4][2], const Unit& u, int wr, int wc, int fr_, int fq_) const {
        const int ln_ = lane_id(), fr = ln_ & 15, fq = ln_ >> 4;
        const int rp = mapsel == 1 ? ((u.pn & 1) + 4 * (u.pn >> 1)) : (mapsel == 2 ? (u.pn < 4 ? (2 + (u.pn & 1) + 4 * (u.pn >> 1)) : u.pn + 4) : u.pn);
        const int part = rp >> 2, head = (rp & 3) * 4 + wc;
        bf16_t* base = Q + (size_t)part * part_stride + head * 64 + 8 * fq;
        const float sc = part == 0 ? qscale : 1.f;
        const bool rot = part != 2, km = (part == 1) && (head < 8);
        const int row0 = u.pm * BM + wr * 64 + fr;
        int rbase = row0; asm volatile("" : "+v"(rbase));
        f32x4 ks[2][2];
#pragma unroll
        for (int a = 0; a < 2; ++a)
#pragma unroll
            for (int b = 0; b < 2; ++b) ks[a][b] = (f32x4){0.f, 0.f, 0.f, 0.f};
#pragma unroll
        for (int ai = 0; ai < 2; ++ai)
#pragma unroll
            for (int m = 0; m < 4; ++m) {
                const int row = rbase + ai * HALF + m * 16;
                const int s = row & 4095;
                const f32x4* rp = (const f32x4*)(rope + ((size_t)s * 32 + 8 * fq) * 2);
                f32x4 t0 = rp[0], t1 = rp[1], t2 = rp[2], t3 = rp[3];
                if (!rot) { t0 = t1 = t2 = t3 = (f32x4){1.f, 0.f, 1.f, 0.f}; }
                f32x4 o1[2], o2[2];
#pragma unroll
                for (int n = 0; n < 2; ++n) {
                    const f32x4 cv = n == 0 ? (f32x4){t0[0], t0[2], t1[0], t1[2]} : (f32x4){t2[0], t2[2], t3[0], t3[2]};
                    const f32x4 sv = n == 0 ? (f32x4){t0[1], t0[3], t1[1], t1[3]} : (f32x4){t2[1], t2[3], t3[1], t3[3]};
                    const f32x4 x1 = acc[ai][0][m][n] * ascale, x2 = acc[ai][1][m][n] * ascale;
                    o1[n] = x1 * cv - x2 * sv; o2[n] = x2 * cv + x1 * sv;
                    ks[0][n] += o1[n]; ks[1][n] += o2[n];
                    o1[n] = o1[n] * sc; o2[n] = o2[n] * sc;
                }
                bf16_t* rowp = base + (size_t)row * 1024;
                *(u32x4*)(rowp) = pack8(o1[0], o1[1]); *(u32x4*)(rowp + 32) = pack8(o2[0], o2[1]);
            }
        if (km) {
#pragma unroll
            for (int bj = 0; bj < 2; ++bj)
#pragma unroll
                for (int n = 0; n < 2; ++n) { f32x4 v = ks[bj][n];
#pragma unroll
                    for (int o = 1; o < 16; o <<= 1) { v[0] += __shfl_xor(v[0], o); v[1] += __shfl_xor(v[1], o); v[2] += __shfl_xor(v[2], o); v[3] += __shfl_xor(v[3], o); }
                    if (fr == 0) *(f32x4*)(kpart + (size_t)(u.pm * 2 + wr) * 512 + head * 64 + 32 * bj + 8 * fq + 4 * n) = v; }
        }
    }
};

struct EpiWo {
    static constexpr bool PERM = true, AFTER_DRAIN = false, HAS_MID = true;
    const float* rn0; const float* gain0; bf16_t* xn; unsigned char* xn8; const float* ssq_att; float* ssq1;
    __device__ __forceinline__ void rstds(int row, float& rm, float& rd) const {
        const f32x4* p = (const f32x4*)(ssq_att + (size_t)row * 16);
        const f32x4 a = p[0], b = p[1], c = p[2], d = p[3];
        rm = __builtin_amdgcn_rsqf((sum4(a) + sum4(b)) * (1.f / 512.f) + RMS_EPS_F);
        rd = __builtin_amdgcn_rsqf((sum4(c) + sum4(d)) * (1.f / 512.f) + RMS_EPS_F);
    }
    static constexpr float ASCALE = 1.f / (F8_SO * F8_SW);
    __device__ __forceinline__ void mid(f32x4 (&acc)[2][2][4][2], const Unit& u, int wr, int fr_) const {
        const int fr = lane_id() & 15;
        const int row0 = u.pm * BM + wr * 64 + fr;
        int rbase = row0; asm volatile("" : "+v"(rbase));
#pragma unroll
        for (int ai = 0; ai < 2; ++ai)
#pragma unroll
            for (int m = 0; m < 4; ++m) { const int row = rbase + ai * HALF + m * 16; float rm, rd; rstds(row, rm, rd); const float f = rm / rd;
#pragma unroll
                for (int bj = 0; bj < 2; ++bj)
#pragma unroll
                    for (int n = 0; n < 2; ++n) acc[ai][bj][m][n] = acc[ai][bj][m][n] * f;
                asm volatile("" ::: "memory"); }
    }
    __device__ __forceinline__ void operator()(const f32x4 (&acc)[2][2][4][2], const Unit& u, int wr, int wc, int fr_, int fq_) const {
        const int ln_ = lane_id(), fr = ln_ & 15, fq = ln_ >> 4;
        const int row0 = u.pm * BM + wr * 64 + fr, col0 = u.pn * BM + wc * 32 + 8 * fq;
        int rbase = row0; asm volatile("" : "+v"(rbase));
        f32x4 ig[2][2];
#pragma unroll
        for (int bj = 0; bj < 2; ++bj)
#pragma unroll
            for (int n = 0; n < 2; ++n) { const f32x4 g = *(const f32x4*)(gain0 + col0 + bj * HALF + 4 * n);
                ig[bj][n] = (f32x4){__builtin_amdgcn_rcpf(g[0]), __builtin_amdgcn_rcpf(g[1]), __builtin_amdgcn_rcpf(g[2]), __builtin_amdgcn_rcpf(g[3])}; }
#pragma unroll
        for (int ai = 0; ai < 2; ++ai)
#pragma unroll
            for (int m = 0; m < 4; ++m) { const int row = rbase + ai * HALF + m * 16; float rm, rd; rstds(row, rm, rd); float s = 0.f; const float rn = rn0[row];
#pragma unroll
                for (int bj = 0; bj < 2; ++bj) { unsigned off = (unsigned)row * 1024u + col0 + bj * HALF; asm volatile("" : "+v"(off));
                    const u32x4 xw = *(const u32x4*)(xn + off);
                    const f32x4 xa = (f32x4){__uint_as_float(xw.x << 16), __uint_as_float(xw.x & 0xffff0000u), __uint_as_float(xw.y << 16), __uint_as_float(xw.y & 0xffff0000u)} * ig[bj][0] * rn;
                    const f32x4 xb = (f32x4){__uint_as_float(xw.z << 16), __uint_as_float(xw.z & 0xffff0000u), __uint_as_float(xw.w << 16), __uint_as_float(xw.w & 0xffff0000u)} * ig[bj][1] * rn;
                    const f32x4 v0 = xa + acc[ai][bj][m][0] * (rd * ASCALE), v1 = xb + acc[ai][bj][m][1] * (rd * ASCALE);
                    *(u32x4*)(xn + off) = pack8(v0, v1); *(u32x2*)(xn8 + off) = pack8_fp8(v0 * F8_SA, v1 * F8_SA); s += sq4(v0) + sq4(v1); }
                s += __shfl_xor(s, 16); s += __shfl_xor(s, 32);
                if (fq == 0) ssq1[(size_t)row * 16 + u.pn * 4 + wc] = s;
                asm volatile("" ::: "memory"); }
    }
};

struct EpiGU {
    static constexpr bool PERM = true, AFTER_DRAIN = false, HAS_MID = false;
    const float* ssq1; unsigned char* H;
    __device__ __forceinline__ void operator()(const f32x4 (&acc)[2][2][4][2], const Unit& u, int wr, int wc, int fr_, int fq_) const {
        const int ln_ = lane_id(), fr = ln_ & 15, fq = ln_ >> 4;
        const int row0 = u.pm * BM + wr * 64 + fr, col0 = u.pn * HALF + wc * 32 + 8 * fq;
        int rbase = row0; asm volatile("" : "+v"(rbase));
#pragma unroll
        for (int ai = 0; ai < 2; ++ai)
#pragma unroll
            for (int m = 0; m < 4; ++m) { const int row = rbase + ai * HALF + m * 16;
                const f32x4* p = (const f32x4*)(ssq1 + (size_t)row * 16);
                const f32x4 a = p[0], b = p[1], c = p[2], d = p[3];
                const float rstd = __builtin_amdgcn_rsqf(((sum4(a) + sum4(b)) + (sum4(c) + sum4(d))) * (1.f / 1024.f) + RMS_EPS_F) * (1.f / (F8_SA * F8_SW));
                f32x4 h[2];
#pragma unroll
                for (int n = 0; n < 2; ++n) { const f32x4 g = acc[ai][0][m][n] * rstd, uu = acc[ai][1][m][n] * rstd;
#pragma unroll
                    for (int i = 0; i < 4; ++i) h[n][i] = g[i] * __builtin_amdgcn_rcpf(1.f + __builtin_amdgcn_exp2f(g[i] * -1.4426950408889634f)) * (uu[i] * F8_SH); }
                *(u32x2*)(H + (size_t)row * 2816 + col0) = pack8_fp8(h[0], h[1]); }
    }
};

struct EpiDown {
    static constexpr bool PERM = true, AFTER_DRAIN = false, HAS_MID = false;
    const bf16_t* xn; float* out; float* ssq2;
    __device__ __forceinline__ void operator()(const f32x4 (&acc)[2][2][4][2], const Unit& u, int wr, int wc, int fr_, int fq_) const {
        const int ln_ = lane_id(), fr = ln_ & 15, fq = ln_ >> 4;
        const int row0 = u.pm * BM + wr * 64 + fr, col0 = u.pn * BM + wc * 32 + 8 * fq;
        int rbase = row0; asm volatile("" : "+v"(rbase));
#pragma unroll
        for (int ai = 0; ai < 2; ++ai)
#pragma unroll
            for (int m = 0; m < 4; ++m) { const int row = rbase + ai * HALF + m * 16; float s = 0.f;
#pragma unroll
                for (int bj = 0; bj < 2; ++bj) { const size_t off = (size_t)row * 1024 + col0 + bj * HALF;
                    const u32x4 xw = *(const u32x4*)(xn + off);
                    const f32x4 xa = {__uint_as_float(xw.x << 16), __uint_as_float(xw.x & 0xffff0000u), __uint_as_float(xw.y << 16), __uint_as_float(xw.y & 0xffff0000u)};
                    const f32x4 xb = {__uint_as_float(xw.z << 16), __uint_as_float(xw.z & 0xffff0000u), __uint_as_float(xw.w << 16), __uint_as_float(xw.w & 0xffff0000u)};
                    const f32x4 v0 = xa + acc[ai][bj][m][0] * (1.f / (F8_SH * F8_SW)), v1 = xb + acc[ai][bj][m][1] * (1.f / (F8_SH * F8_SW));
                    *(f32x4*)(out + off) = v0; *(f32x4*)(out + off + 4) = v1; s += sq4(v0) + sq4(v1); }
                s += __shfl_xor(s, 16); s += __shfl_xor(s, 32);
                if (fq == 0) ssq2[(size_t)row * 16 + u.pn * 4 + wc] = s;
                asm volatile("" ::: "memory"); }
    }
};

struct EpiDownNorm {
    static constexpr bool PERM = true, AFTER_DRAIN = false, HAS_MID = false;
    const bf16_t* xn; float* out; float* ssq2; unsigned* cnt; const float* gain;
    __device__ __forceinline__ void operator()(f32x4 (&acc)[2][2][4][2], const Unit& u, int wr, int wc, int fr_, int fq_) const {
        const int ln_ = lane_id(), fr = ln_ & 15, fq = ln_ >> 4;
        const int row0 = u.pm * BM + wr * 64 + fr, col0 = u.pn * BM + wc * 32 + 8 * fq;
        int rbase = row0; asm volatile("" : "+v"(rbase));
#pragma unroll
        for (int ai = 0; ai < 2; ++ai)
#pragma unroll
            for (int m = 0; m < 4; ++m) { const int row = rbase + ai * HALF + m * 16; float s = 0.f;
#pragma unroll
                for (int bj = 0; bj < 2; ++bj) { const size_t off = (size_t)row * 1024 + col0 + bj * HALF;
                    const u32x4 xw = *(const u32x4*)(xn + off);
                    const f32x4 xa = {__uint_as_float(xw.x << 16), __uint_as_float(xw.x & 0xffff0000u), __uint_as_float(xw.y << 16), __uint_as_float(xw.y & 0xffff0000u)};
                    const f32x4 xb = {__uint_as_float(xw.z << 16), __uint_as_float(xw.z & 0xffff0000u), __uint_as_float(xw.w << 16), __uint_as_float(xw.w & 0xffff0000u)};
                    acc[ai][bj][m][0] = acc[ai][bj][m][0] * (1.f / (F8_SH * F8_SW)) + xa; acc[ai][bj][m][1] = acc[ai][bj][m][1] * (1.f / (F8_SH * F8_SW)) + xb; s += sq4(acc[ai][bj][m][0]) + sq4(acc[ai][bj][m][1]); }
                s += __shfl_xor(s, 16); s += __shfl_xor(s, 32);
                if (fq == 0) __hip_atomic_store(ssq2 + (size_t)row * 16 + u.pn * 4 + wc, s, __ATOMIC_RELAXED, __HIP_MEMORY_SCOPE_AGENT);
                asm volatile("" ::: "memory"); }
        asm volatile("s_waitcnt vmcnt(0)" ::: "memory");
        unsigned* cw = cnt + 64 * u.pm;
        if (fr == 0 && fq == 0) __hip_atomic_fetch_add(cw, 1u, __ATOMIC_RELAXED, __HIP_MEMORY_SCOPE_AGENT);
        { unsigned sp = 0; while ((unsigned)__builtin_amdgcn_readfirstlane((int)__hip_atomic_load(cw, __ATOMIC_RELAXED, __HIP_MEMORY_SCOPE_AGENT)) < 32u) { __builtin_amdgcn_s_sleep(1); if (++sp > (1u << 22)) break; } }
        f32x4 g[2][2];
#pragma unroll
        for (int bj = 0; bj < 2; ++bj) { g[bj][0] = *(const f32x4*)(gain + col0 + bj * HALF); g[bj][1] = *(const f32x4*)(gain + col0 + bj * HALF + 4); }
#pragma unroll
        for (int ai = 0; ai < 2; ++ai)
#pragma unroll
            for (int m = 0; m < 4; ++m) { const int row = rbase + ai * HALF + m * 16;
                const unsigned long long* pp = (const unsigned long long*)(ssq2 + (size_t)row * 16 + 4 * fq);
                const unsigned long long w0 = __hip_atomic_load(pp, __ATOMIC_RELAXED, __HIP_MEMORY_SCOPE_AGENT), w1 = __hip_atomic_load(pp + 1, __ATOMIC_RELAXED, __HIP_MEMORY_SCOPE_AGENT);
                float s = (__uint_as_float((unsigned)w0) + __uint_as_float((unsigned)(w0 >> 32))) + (__uint_as_float((unsigned)w1) + __uint_as_float((unsigned)(w1 >> 32)));
                s += __shfl_xor(s, 16); s += __shfl_xor(s, 32);
                const float rstd = __builtin_amdgcn_rsqf(s * (1.f / 1024.f) + RMS_EPS_F);
#pragma unroll
                for (int bj = 0; bj < 2; ++bj) { const size_t off = (size_t)row * 1024 + col0 + bj * HALF;
                    *(f32x4*)(out + off) = acc[ai][bj][m][0] * rstd * g[bj][0]; *(f32x4*)(out + off + 4) = acc[ai][bj][m][1] * rstd * g[bj][1]; }
                asm volatile("" ::: "memory"); }
    }
};
template <class Epi, class Sched, bool ALIGN_EPI = false, bool SP2 = false, bool F8 = false>
__device__ __forceinline__ void gemm_phase(PG8_LAS unsigned char* lds, const Gemm g, const Sched& S, const Epi& E, int wave) {
    const int wid = __builtin_amdgcn_readfirstlane(wave), lane = lane_id(), tid = wid * 64 + lane, wr = wid >> 2, wc = wid & 3, fr = lane & 15, fq = lane >> 4;
    const int K = F8 ? g.K / 2 : g.K, nt = K / BK;
    unsigned voffA[2], voffB[2];
#pragma unroll
    for (int i = 0; i < 2; ++i) { int R, C; stage_rc(tid * 16 + i * 8192, R, C); const int Rb = Epi::PERM ? ((R & ~31) + perm32(R & 31)) : R;
        voffA[i] = (unsigned)(R * K + C) * 2u; voffB[i] = (unsigned)(Rb * K + C) * 2u; }
    const unsigned kstep = (unsigned)(BK * 2);
    const unsigned hstep = (unsigned)HALF * K * 2;
    const unsigned tstep = 2 * hstep;
    const unsigned ldsw = (unsigned)wid * 1024u;
    const int aoff = lds_byte(wr * 64 + fr, fq * 8), boff = lds_byte(wc * 32 + fr, fq * 8);
#define PG8_SA(b, h) (((b) * 2 + (h)) * HTB)
#define PG8_SB(b, h) ((4 + (b) * 2 + (h)) * HTB)
    const __amdgpu_buffer_rsrc_t rsA = __builtin_amdgcn_make_buffer_rsrc((void*)g.A, 0, 0x7fffffff, 0x00020000), rsB = __builtin_amdgcn_make_buffer_rsrc((void*)g.Bt, 0, 0x7fffffff, 0x00020000);
#define PG8_STAGE(bufoff, gbase, voff) do { _Pragma("unroll") for (int _i = 0; _i < 2; ++_i) \
        __builtin_amdgcn_raw_ptr_buffer_load_lds(PG8_RS_##voff, (PG8_LAS unsigned*)(lds + (bufoff) + ldsw + _i * 8192), 16, (voff)[_i], (int)(gbase), 0, 0); } while (0)
#define PG8_RS_voffA rsA
#define PG8_RS_voffB rsB
#define PG8_LD8(base, off) __builtin_shufflevector(*(const PG8_LAS i32x4*)((base) + (off)), *(const PG8_LAS i32x4*)((base) + (off) + 1024), 0, 1, 2, 3, 4, 5, 6, 7)
#define PG8_LDA(dst, b, h) do { if constexpr (F8) { _Pragma("unroll") for (int m = 0; m < 4; ++m) dst##8[m] = PG8_LD8(abase8, PG8_SA(b, h) + m * 2048); } else { \
        _Pragma("unroll") for (int m = 0; m < 4; ++m) _Pragma("unroll") for (int k = 0; k < 2; ++k) dst[m][k] = *(const PG8_LAS bf16x8*)(lds + PG8_SA(b, h) + aoff + m * 2048 + k * 1024); } } while (0)
#define PG8_LDB(dst, b, h) do { if constexpr (F8) { _Pragma("unroll") for (int n = 0; n < 2; ++n) dst##8[n] = PG8_LD8(bbase8, PG8_SB(b, h) - PG8_SB(0, 0) + n * 2048); } else { \
        _Pragma("unroll") for (int n = 0; n < 2; ++n) _Pragma("unroll") for (int k = 0; k < 2; ++k) dst[n][k] = *(const PG8_LAS bf16x8*)(lds + PG8_SB(b, h) + boff + n * 2048 + k * 1024); } } while (0)
#define PG8_MMA(ai, bj, At, Bt) do { __builtin_amdgcn_s_setprio(1); if constexpr (F8) { _Pragma("unroll") for (int m = 0; m < 4; ++m) _Pragma("unroll") for (int n = 0; n < 2; ++n) \
        acc[ai][bj][m][n] = __builtin_amdgcn_mfma_scale_f32_16x16x128_f8f6f4(Bt##8[n], At##8[m], acc[ai][bj][m][n], 0, 0, 0, 0, 0, 0); } else \
        _Pragma("unroll") for (int m = 0; m < 4; ++m) _Pragma("unroll") for (int n = 0; n < 2; ++n) _Pragma("unroll") for (int k = 0; k < 2; ++k) \
        acc[ai][bj][m][n] = __builtin_amdgcn_mfma_f32_16x16x32_bf16(Bt[n][k], At[m][k], acc[ai][bj][m][n], 0, 0, 0); __builtin_amdgcn_s_setprio(0); } while (0)
#define PG8_WAIT_V(n) asm volatile("s_waitcnt vmcnt(" #n ")" ::: "memory")
#define PG8_WAIT_L(n) asm volatile("s_waitcnt lgkmcnt(" #n ")" ::: "memory")
#define PG8_BAR __builtin_amdgcn_s_barrier()
#define PG8_SCHED __builtin_amdgcn_sched_barrier(0)
    Unit cur, nxt; int ui = 0;
    if (!S.next(0, cur)) return;
    f32x4 acc[2][2][4][2];
#pragma unroll
    for (int a = 0; a < 2; ++a)
#pragma unroll
        for (int b = 0; b < 2; ++b)
#pragma unroll
            for (int m = 0; m < 4; ++m)
#pragma unroll
                for (int n = 0; n < 2; ++n) acc[a][b][m][n] = (f32x4){0.f, 0.f, 0.f, 0.f};
    PG8_LAS unsigned char* abase8 = lds + aoff; PG8_LAS unsigned char* bbase8 = lds + PG8_SB(0, 0) + boff;
    if constexpr (F8) { asm volatile("" : "+v"(abase8)); asm volatile("" : "+v"(bbase8)); }
    bf16x8 At[4][2], B0[2][2], B1[2][2]; i32x8 At8[4], B08[2], B18[2];
    unsigned cA = (unsigned)cur.pm * tstep, cB = (unsigned)cur.pn * tstep;
    S.a_ready(cur);
    if constexpr (SP2) {
        PG8_STAGE(PG8_SB(0, 0), cB, voffB); PG8_STAGE(PG8_SB(0, 1), cB + hstep, voffB); PG8_STAGE(PG8_SA(0, 0), cA, voffA); PG8_STAGE(PG8_SA(0, 1), cA + hstep, voffA);
        if (wr == 1) PG8_BAR;
        PG8_WAIT_V(2); PG8_BAR;
        PG8_STAGE(PG8_SB(1, 0), cB + kstep, voffB); PG8_STAGE(PG8_SA(1, 0), cA + kstep, voffA); PG8_STAGE(PG8_SB(1, 1), cB + hstep + kstep, voffB);
        PG8_WAIT_V(6); PG8_BAR;
    } else {
        PG8_STAGE(PG8_SB(0, 0), cB, voffB); PG8_STAGE(PG8_SA(0, 0), cA, voffA); PG8_STAGE(PG8_SB(0, 1), cB + hstep, voffB); PG8_STAGE(PG8_SA(0, 1), cA + hstep, voffA);
        if (wr == 1) PG8_BAR;
        PG8_WAIT_V(4); PG8_BAR;
        PG8_STAGE(PG8_SB(1, 0), cB + kstep, voffB); PG8_STAGE(PG8_SA(1, 0), cA + kstep, voffA); PG8_STAGE(PG8_SB(1, 1), cB + hstep + kstep, voffB);
        PG8_WAIT_V(6); PG8_BAR;
    }
    for (;;) {
        const bool has_next = S.next(ui + 1, nxt);
        const unsigned nA = has_next ? (unsigned)nxt.pm * tstep : cA, nB = has_next ? (unsigned)nxt.pn * tstep : cB;
#pragma nounroll
        for (int t = 0; t < nt; t += 2) {
            if constexpr (Epi::HAS_MID) { if (t == (nt >> 1)) E.mid(acc, cur, wr, fr); }
            const bool last = (t == nt - 2);
            const unsigned a1 = cA + (unsigned)(t + 1) * kstep;
            const unsigned a2 = last ? nA : cA + (unsigned)(t + 2) * kstep, b2 = last ? nB : cB + (unsigned)(t + 2) * kstep;
            const unsigned a3 = a2 + kstep, b3 = b2 + kstep;
            if (last && has_next) S.a_ready(nxt);
            if constexpr (SP2) {
            PG8_LDB(B0, 0, 0); PG8_LDB(B1, 0, 1); PG8_SCHED; PG8_LDA(At, 0, 0); PG8_STAGE(PG8_SA(1, 1), a1 + hstep, voffA);
            PG8_WAIT_V(8); PG8_WAIT_L(0); PG8_BAR; PG8_MMA(0, 0, At, B0); PG8_MMA(0, 1, At, B1); PG8_BAR; PG8_SCHED;
            PG8_LDA(At, 0, 1); PG8_STAGE(PG8_SB(0, 0), b2, voffB); PG8_STAGE(PG8_SB(0, 1), b2 + hstep, voffB); PG8_STAGE(PG8_SA(0, 0), a2, voffA);
            PG8_WAIT_V(8); PG8_WAIT_L(0); PG8_BAR; PG8_MMA(1, 0, At, B0); PG8_MMA(1, 1, At, B1); PG8_BAR; PG8_SCHED;
            PG8_LDB(B0, 1, 0); PG8_LDB(B1, 1, 1); PG8_SCHED; PG8_LDA(At, 1, 0); PG8_STAGE(PG8_SA(0, 1), a2 + hstep, voffA);
            PG8_WAIT_V(8); PG8_WAIT_L(0); PG8_BAR; PG8_MMA(0, 0, At, B0); PG8_MMA(0, 1, At, B1); PG8_BAR; PG8_SCHED;
            PG8_LDA(At, 1, 1); PG8_STAGE(PG8_SB(1, 0), b3, voffB); PG8_STAGE(PG8_SB(1, 1), b3 + hstep, voffB); PG8_STAGE(PG8_SA(1, 0), a3, voffA);
            PG8_WAIT_V(8); PG8_WAIT_L(0); PG8_BAR; PG8_MMA(1, 0, At, B0); PG8_MMA(1, 1, At, B1); PG8_BAR; PG8_SCHED;
            } else {
            PG8_LDB(B0, 0, 0); PG8_SCHED; PG8_LDA(At, 0, 0); PG8_STAGE(PG8_SA(1, 1), a1 + hstep, voffA);
            PG8_WAIT_L(8); PG8_BAR; PG8_WAIT_L(0); PG8_MMA(0, 0, At, B0); PG8_BAR; PG8_SCHED;
            PG8_LDB(B1, 0, 1); PG8_STAGE(PG8_SB(0, 0), b2, voffB);
            PG8_BAR; PG8_WAIT_L(0); PG8_MMA(0, 1, At, B1); PG8_BAR;
            PG8_LDA(At, 0, 1); PG8_STAGE(PG8_SA(0, 0), a2, voffA);
            PG8_BAR; PG8_WAIT_L(0); PG8_MMA(1, 0, At, B0); PG8_BAR; PG8_SCHED;
            PG8_STAGE(PG8_SB(0, 1), b2 + hstep, voffB);
            PG8_WAIT_V(6); PG8_BAR; PG8_MMA(1, 1, At, B1); PG8_BAR;
            PG8_LDB(B0, 1, 0); PG8_SCHED; PG8_LDA(At, 1, 0); PG8_STAGE(PG8_SA(0, 1), a2 + hstep, voffA);
            PG8_WAIT_L(8); PG8_BAR; PG8_WAIT_L(0); PG8_MMA(0, 0, At, B0); PG8_BAR; PG8_SCHED;
            PG8_LDB(B1, 1, 1); PG8_STAGE(PG8_SB(1, 0), b3, voffB);
            PG8_BAR; PG8_WAIT_L(0); PG8_MMA(0, 1, At, B1); PG8_BAR;
            PG8_LDA(At, 1, 1); PG8_STAGE(PG8_SA(1, 0), a3, voffA);
            PG8_BAR; PG8_WAIT_L(0); PG8_MMA(1, 0, At, B0); PG8_BAR; PG8_SCHED;
            PG8_STAGE(PG8_SB(1, 1), b3 + hstep, voffB);
            PG8_WAIT_V(6); PG8_BAR; PG8_MMA(1, 1, At, B1); PG8_BAR;
            }
        }
        if constexpr (ALIGN_EPI) { if (wr == 0) PG8_BAR; }
        if constexpr (!Epi::AFTER_DRAIN) { E(acc, cur, wr, wc, fr, fq); S.done(cur); }
        if (!has_next) break;
#pragma unroll
        for (int a = 0; a < 2; ++a)
#pragma unroll
            for (int b = 0; b < 2; ++b)
#pragma unroll
                for (int m = 0; m < 4; ++m)
#pragma unroll
                    for (int n = 0; n < 2; ++n) acc[a][b][m][n] = (f32x4){0.f, 0.f, 0.f, 0.f};
        cur = nxt; cA = nA; cB = nB; ++ui;
        if constexpr (ALIGN_EPI) { if (wr == 1) PG8_BAR; }
    }
    PG8_WAIT_V(0);
    if constexpr (!ALIGN_EPI) { if (wr == 0) PG8_BAR; }
    PG8_BAR;
    if constexpr (Epi::AFTER_DRAIN) { E.fused(acc, cur, wr, wc, fr, fq, lds, wid, lane); S.done(cur); }
#undef PG8_SA
#undef PG8_SB
#undef PG8_STAGE
#undef PG8_RS_voffA
#undef PG8_RS_voffB
#undef PG8_LDA
#undef PG8_LDB
#undef PG8_MMA
#undef PG8_WAIT_V
#undef PG8_WAIT_L
#undef PG8_BAR
#undef PG8_SCHED
}
}

constexpr int NWAVES = 8;
#ifndef MK_N_LAUNCHES
#define MK_N_LAUNCHES 1
#endif
constexpr int PER_PHASE = 7;
constexpr int N_LAUNCHES = MK_N_LAUNCHES;

constexpr int BATCH = 8, SEQ = 4096, D = 1024, NH = 16, HD = 64, FF = 2816, NHM = 8;
constexpr int M = BATCH * SEQ;
constexpr int NQKV = 3 * D, NGU = 2 * FF;
constexpr float RMS_EPS = 1e-6f;
constexpr float QSCALE = 0.125f * 1.4426950408889634f;

constexpr size_t MiB = 1u << 20;
constexpr size_t WS_CTL = 0, CTL_ZERO_BYTES = 64 * 1024;
constexpr size_t WS_ROPE = 1 * MiB;
constexpr size_t WS_WQKV = 2 * MiB, WS_WO = 8 * MiB, WS_WGU = 10 * MiB, WS_WD = 21 * MiB;
constexpr size_t WS_KPART = 27 * MiB;
constexpr size_t WS_SSQA = 28 * MiB, WS_SSQ1 = 30 * MiB, WS_SSQ2 = 32 * MiB;
constexpr size_t WS_XN = 40 * MiB;
constexpr size_t WS_QO = 104 * MiB, WS_K = 168 * MiB, WS_V = 232 * MiB;
constexpr size_t WS_H = 104 * MiB;
#ifndef MK_REPEAT_PHASE
#define MK_REPEAT_PHASE -1
#endif
constexpr size_t WS_O = WS_QO;
constexpr size_t WS_FARO = 296 * MiB, WS_FARL = 328 * MiB;
constexpr size_t WS_XN8 = 330 * MiB;
constexpr size_t WS_O8 = 362 * MiB;
constexpr size_t WS_END = 394 * MiB;
constexpr size_t QKV8_OFF = 2 * MiB;
constexpr int CW_TMO = 0, CW_CODE = 1;
constexpr int CW_BAR = 4096;
constexpr int CW_PANEL = 8192;
constexpr int CW_FAR = 2048;

constexpr int RING_OFF = 0, RING_BYTES = 131072;
constexpr int LDSCTL_OFF = RING_BYTES, MISC_OFF = LDSCTL_OFF + 320;
constexpr int LDS_BYTES = 147456;
static_assert(WS_V - WS_K == WS_K - WS_QO, "Q | K | V equally spaced");
#define GAS __attribute__((address_space(1)))
#define LAS __attribute__((address_space(3)))
typedef unsigned short bf16;
typedef unsigned v4u __attribute__((ext_vector_type(4)));
typedef float f32x4 __attribute__((ext_vector_type(4)));
typedef short bf16x8 __attribute__((ext_vector_type(8)));
typedef GAS unsigned gu32;
typedef GAS unsigned long long gu64;
#define RLX_AGENT __ATOMIC_RELAXED, __HIP_MEMORY_SCOPE_AGENT
#define LDS_WAIT() asm volatile("s_waitcnt lgkmcnt(0)" ::: "memory")
#define VM_WAIT() asm volatile("s_waitcnt vmcnt(0)" ::: "memory")
__device__ __forceinline__ unsigned long long rt() { return __builtin_amdgcn_s_memrealtime(); }
__device__ __forceinline__ unsigned f2bf(float f) { unsigned u = __builtin_bit_cast(unsigned, f); return (u + 0x7fffu + ((u >> 16) & 1u)) >> 16; }
__device__ __forceinline__ unsigned pk2(float lo, float hi) { return f2bf(lo) | (f2bf(hi) << 16); }

#define XB_TMO      128
#define XB_XCNT(j)  (256  + 64 * (j))
#define XB_XSUB(j)  (1280 + 64 * (j))
#define XB_XGEN(j)  (2304 + 64 * (j))
#define XB_TOP      3328
#define XB_TOPGEN   3392
#define XCD_BAR_WORDS 3456
#define XB_SPIN_CAP (1u << 18)

__device__ __forceinline__ unsigned xb_ld(unsigned* p)              { return __hip_atomic_load(p, __ATOMIC_RELAXED, __HIP_MEMORY_SCOPE_AGENT); }
__device__ __forceinline__ unsigned xb_add(unsigned* p, unsigned v) { return __hip_atomic_fetch_add(p, v, __ATOMIC_RELAXED, __HIP_MEMORY_SCOPE_AGENT); }
__device__ __forceinline__ unsigned xb_xcc_id() { return (unsigned)__builtin_amdgcn_s_getreg((3 << 11) | 20) & 0xFu; }
#define XB_SPIN(cond, bar) do { unsigned _sp = 0; while (cond) { __builtin_amdgcn_s_sleep(1); \
    if ((++_sp & 255u) == 0u) { if (xb_ld(&(bar)[XB_TMO])) break; if (_sp > XB_SPIN_CAP) { atomicAdd(&(bar)[XB_TMO], 1u); break; } } } } while (0)

struct XcdBarrier {
    unsigned* bar; unsigned x;
    volatile LAS unsigned* st;
};

__device__ __forceinline__ int mk_lane() { int l; asm volatile("v_mbcnt_lo_u32_b32 %0, -1, 0\n\tv_mbcnt_hi_u32_b32 %0, -1, %0" : "=v"(l)); return l; }
__device__ __forceinline__ XcdBarrier xcd_barrier_post(unsigned* bar, volatile LAS unsigned* st, int wave) {
    XcdBarrier b; b.bar = bar; b.x = xb_xcc_id(); b.st = st;
    if (wave == 0 && mk_lane() == 0) (void)xb_add(&bar[XB_XCNT(b.x)], 1u);
    return b;
}
__device__ __forceinline__ void xcd_barrier_complete(unsigned* bar, unsigned x, unsigned& nloc, unsigned& nx) {
    const unsigned G = gridDim.x * gridDim.y * gridDim.z;
    unsigned sum, cnt, mine, sp = 0u;
    for (;;) {
        sum = 0u; cnt = 0u; mine = 0u;
#pragma unroll
        for (unsigned j = 0; j < 16; ++j) { const unsigned c = xb_ld(&bar[XB_XCNT(j)]); sum += c; cnt += (c > 0u) ? 1u : 0u; mine = (j == x) ? c : mine; }
        if (sum == G) break;
        __builtin_amdgcn_s_sleep(1);
        if ((++sp & 255u) == 0u) { if (xb_ld(&bar[XB_TMO])) break; if (sp > XB_SPIN_CAP) { atomicAdd(&bar[XB_TMO], 1u); break; } }
    }
    nloc = mine > 0u ? mine : 1u; nx = cnt > 0u ? cnt : 1u;
}

__device__ __forceinline__ void xcd_barrier(const XcdBarrier& b, int wave) {
    asm volatile("s_waitcnt vmcnt(0)" ::: "memory");
    __syncthreads();
    if (wave == 0 && mk_lane() == 0) {
        unsigned* bar = b.bar;
        __builtin_amdgcn_s_waitcnt(0);
        unsigned nloc = b.st[0], nx = b.st[1];
        if (nloc == 0u) { xcd_barrier_complete(bar, b.x, nloc, nx); b.st[0] = nloc; b.st[1] = nx; }
        const unsigned old = xb_add(&bar[XB_XSUB(b.x)], 1u);
        const unsigned gen = old / nloc;
        if (old + 1u == (gen + 1u) * nloc) {
            __builtin_amdgcn_fence(__ATOMIC_RELEASE, "agent");
            asm volatile("s_waitcnt vmcnt(0)" ::: "memory");
            const unsigned og = xb_add(&bar[XB_TOP], 1u);
            const unsigned tg = og / nx;
            if (og + 1u == (tg + 1u) * nx) xb_add(&bar[XB_TOPGEN], 1u);
            else XB_SPIN(xb_ld(&bar[XB_TOPGEN]) == tg, bar);
            __builtin_amdgcn_fence(__ATOMIC_ACQUIRE, "agent");
            xb_add(&bar[XB_XGEN(b.x)], 1u);
            asm volatile("s_waitcnt vmcnt(0)" ::: "memory");
        } else {
            XB_SPIN(xb_ld(&bar[XB_XGEN(b.x)]) == gen, bar);
            __builtin_amdgcn_fence(__ATOMIC_ACQUIRE, "agent");
            asm volatile("s_waitcnt vmcnt(0)" ::: "memory");
        }
    }
    __syncthreads();
}

#include <hip/hip_bf16.h>
#include <cmath>
namespace attn_body {
using bf16=__hip_bfloat16;
using bf16x8=__attribute__((ext_vector_type(8)))short;
using s16x4=__attribute__((ext_vector_type(4)))short;
using f32x16=__attribute__((ext_vector_type(16)))float;
using u32x4=__attribute__((ext_vector_type(4)))unsigned;
using f32x4_t=__attribute__((ext_vector_type(4)))float;
constexpr int BATCH=8,NHEAD=16,SEQ=4096,D=64,DM=NHEAD*D;
constexpr int NW=8,QBLK=32,QB=QBLK*NW,KVBLK=64,NQB=SEQ/QB;
constexpr int ATTN_PITCH=DM, ATTN_UNIT_ROWS=QB;
__device__ __forceinline__ int crow(int r,int hi){return (r&3)+8*(r>>2)+4*hi;}
#define SBAR() __builtin_amdgcn_sched_barrier(0)
__device__ __forceinline__ void cmask(f32x16&p0,f32x16&p1,int jb,int qrel,int hi){
  const float NEG=-INFINITY; int kb=64*jb+4*hi;
  #pragma unroll
  for(int r=0;r<16;++r){int kv=kb+(r&3)+8*(r>>2); if(kv>qrel)p0[r]=NEG; if(kv+32>qrel)p1[r]=NEG;}
}

__device__ __forceinline__ void dm_range(f32x16&p0,f32x16&p1,int x,unsigned bw){
  #pragma unroll
  for(int r=0;r<16;++r){ const int kp=(r&3)+8*(r>>2); if((unsigned)(x-kp)>bw)p0[r]=-1e30f; if((unsigned)(x-32-kp)>bw)p1[r]=-1e30f; } }
template<int KIND> __device__ __forceinline__ int dmode(int lo){
  if(KIND==2) return (lo+94<33||lo>128)?0:4;
  return (lo+94<0||lo>512)?0:((lo<0)?40:((lo+94<=128)?1:((lo<=128)?41:((lo+94<=512)?2:42)))); }
__device__ __forceinline__ void dm_adj128(f32x16&p0,f32x16&p1,int dqh,const f32x16&adj){
  #pragma unroll
  for(int r=0;r<16;++r){ const int kp=(r&3)+8*(r>>2); p0[r]+=(dqh-kp>128)?adj[r]:0.f; p1[r]+=(dqh-32-kp>128)?adj[r]:0.f; } }
__device__ __forceinline__ void fmask(f32x16&p0,f32x16&p1,int dq){
  #pragma unroll
  for(int r=0;r<16;++r){ const int kp=(r&3)+8*(r>>2); if((unsigned)(dq-kp-33)>95u)p0[r]=-1e30f; if((unsigned)(dq-kp-65)>95u)p1[r]=-1e30f; }
}
constexpr int NSLOT=3, SLOTB=8192;
constexpr int LDS_K=0, LDS_V=NSLOT*SLOTB, LDS_WS=2*NSLOT*SLOTB, LDS_OST=LDS_WS+NW*64*4, LDS_BYTES=LDS_OST+NW*4096;
constexpr int LDS_TAB=LDS_BYTES, TABB=4096, LDS_ALL=LDS_TAB+4*TABB;
constexpr float C2=0.125f*1.4426950408889634f;
__device__ __forceinline__ void glds16(const void*gsrc,unsigned lds_dst){unsigned keep;
  asm volatile("s_mov_b32 %0, m0\n\ts_mov_b32 m0, %2\n\ts_nop 0\n\tglobal_load_lds_dwordx4 %1, off\n\ts_mov_b32 m0, %0":"=&s"(keep):"v"(gsrc),"s"(lds_dst):"memory");}
__device__ __forceinline__ float max3f(float a,float b,float c){float r;asm("v_max3_f32 %0, %1, %2, %3":"=v"(r):"v"(a),"v"(b),"v"(c));return r;}
__device__ __forceinline__ float max2f(float a,float b){float r;asm("v_max_f32_e32 %0, %1, %2":"=v"(r):"v"(a),"v"(b));return r;}
__device__ __forceinline__ float fadd_s(float a,float b){float r;asm("v_add_f32_e32 %0, %1, %2":"=v"(r):"v"(a),"v"(b));return r;}
__device__ __forceinline__ float fsub_s(float a,float b){float r;asm("v_sub_f32_e32 %0, %1, %2":"=v"(r):"v"(a),"v"(b));return r;}
typedef float f32x2_t __attribute__((ext_vector_type(2))); typedef __bf16 bf16x2_t __attribute__((ext_vector_type(2)));
__device__ __forceinline__ unsigned cvtpk_s(float lo,float hi){f32x2_t v={lo,hi};bf16x2_t b=__builtin_convertvector(v,bf16x2_t);return __builtin_bit_cast(unsigned,b);}
#define WAIT_BAR(N) asm volatile("s_waitcnt vmcnt(" #N ") lgkmcnt(0)\n\ts_barrier":::"memory")

__device__ __forceinline__ void qkt(f32x16&p0,f32x16&p1,const char*Kslot,const bf16x8*qr,const f32x16&negm,int r32,int hi){
  const char*kb=Kslot+hi*1024+r32*16;
  #pragma unroll
  for(int d0=0;d0<4;++d0){
    const bf16x8 b0=*reinterpret_cast<const bf16x8*>(kb+d0*2048);
    const bf16x8 b1=*reinterpret_cast<const bf16x8*>(kb+d0*2048+512);
    if(d0==0){p0=__builtin_amdgcn_mfma_f32_32x32x16_bf16(b0,qr[0],negm,0,0,0);p1=__builtin_amdgcn_mfma_f32_32x32x16_bf16(b1,qr[0],negm,0,0,0);}
    else{p0=__builtin_amdgcn_mfma_f32_32x32x16_bf16(b0,qr[d0],p0,0,0,0);p1=__builtin_amdgcn_mfma_f32_32x32x16_bf16(b1,qr[d0],p1,0,0,0);}}
}
typedef __attribute__((address_space(3))) const char* lds_cptr;
typedef short v4i16_t __attribute__((ext_vector_type(4)));
__device__ __forceinline__ void kload8(bf16x8*kf,lds_cptr kp){
  kf[0]=*(const __attribute__((address_space(3))) bf16x8*)(kp);      kf[1]=*(const __attribute__((address_space(3))) bf16x8*)(kp+512);
  kf[2]=*(const __attribute__((address_space(3))) bf16x8*)(kp+2048); kf[3]=*(const __attribute__((address_space(3))) bf16x8*)(kp+2560);
  kf[4]=*(const __attribute__((address_space(3))) bf16x8*)(kp+4096); kf[5]=*(const __attribute__((address_space(3))) bf16x8*)(kp+4608);
  kf[6]=*(const __attribute__((address_space(3))) bf16x8*)(kp+6144); kf[7]=*(const __attribute__((address_space(3))) bf16x8*)(kp+6656);
}
__device__ __forceinline__ void kload2(bf16x8*kf,lds_cptr kp,int j){ kf[2*j]=*(const __attribute__((address_space(3))) bf16x8*)(kp+j*2048); kf[2*j+1]=*(const __attribute__((address_space(3))) bf16x8*)(kp+j*2048+512); }
__device__ __forceinline__ s16x4 vtr(lds_cptr p){ return __builtin_bit_cast(s16x4,__builtin_amdgcn_ds_read_tr16_b64_v4i16((__attribute__((address_space(3))) v4i16_t*)p)); }
__device__ __forceinline__ float rowmax(const f32x16&p0,const f32x16&p1){
  float a=max3f(p0[0],p0[1],p1[0]),b=max3f(p0[2],p0[3],p1[1]);a=max3f(a,p1[2],p1[3]);
  #pragma unroll
  for(int r=4;r<16;r+=4){a=max3f(a,p0[r],p0[r+1]);b=max3f(b,p0[r+2],p0[r+3]);a=max3f(a,p1[r],p1[r+1]);b=max3f(b,p1[r+2],p1[r+3]);}
  const float m=max2f(a,b);
  auto rr=__builtin_amdgcn_permlane32_swap(__float_as_uint(m),__float_as_uint(m),false,false);
  return max2f(__uint_as_float(rr[0]),__uint_as_float(rr[1]));
}
__device__ __forceinline__ void pv(f32x16*o,int vb,bf16x8 pa0,bf16x8 pa1,bf16x8 pa2,bf16x8 pa3){
  #pragma unroll
  for(int d0=0;d0<2;++d0){s16x4 lo[4],hi[4];
    #pragma unroll
    for(int ks=0;ks<4;++ks){
      asm volatile("ds_read_b64_tr_b16 %0,%1 offset:%c2":"=&v"(lo[ks]):"v"(vb),"i"(d0*4096+ks*1024):"memory");
      asm volatile("ds_read_b64_tr_b16 %0,%1 offset:%c2":"=&v"(hi[ks]):"v"(vb),"i"(d0*4096+ks*1024+512):"memory");}
    asm volatile("s_waitcnt lgkmcnt(0)":::"memory");SBAR();
    #define PK(k) (bf16x8){lo[k][0],lo[k][1],lo[k][2],lo[k][3],hi[k][0],hi[k][1],hi[k][2],hi[k][3]}
    o[d0]=__builtin_amdgcn_mfma_f32_32x32x16_bf16(pa0,PK(0),o[d0],0,0,0);
    o[d0]=__builtin_amdgcn_mfma_f32_32x32x16_bf16(pa1,PK(1),o[d0],0,0,0);
    o[d0]=__builtin_amdgcn_mfma_f32_32x32x16_bf16(pa2,PK(2),o[d0],0,0,0);
    o[d0]=__builtin_amdgcn_mfma_f32_32x32x16_bf16(pa3,PK(3),o[d0],0,0,0);
    #undef PK
  }
}

#ifndef ATTN_STORE16
#define ATTN_STORE16(p,v) asm volatile("global_store_dwordx4 %0, %1, off sc1\n\ts_nop 1"::"v"(p),"v"(v):"memory")
#endif
template<int THRL,int KIND> __device__ __forceinline__ void attn_unit(int b,int h,int qb,unsigned char*ws,char*shm,int wave){
  const bf16*Q=(const bf16*)(ws+WS_QO); const bf16*K=(const bf16*)(ws+WS_K); const bf16*V=(const bf16*)(ws+WS_V); unsigned char*O8=ws+WS_O8;
  float*ssq=(float*)(ws+WS_SSQA); const float*kpart=(const float*)(ws+WS_KPART); unsigned short*faro=(unsigned short*)(ws+WS_FARO); float*farl=(float*)(ws+WS_FARL);
  constexpr bool DIL=(KIND==1), FAR=(KIND==2); constexpr int RS=FAR?16:1;
  int tid=wave*64+mk_lane(); asm volatile("":"+v"(tid));
  const int lane=tid&63,r32=lane&31,hi=lane>>5; const int wid=__builtin_amdgcn_readfirstlane(tid>>6);
  const int rowbase=b*SEQ+(FAR?qb:0);   const int q0=FAR?0:qb*QB;
  const bf16*Qw=Q+(rowbase+(int)(q0+wid*QBLK)*RS)*DM+h*D;
  const int T0=DIL?(qb>2?4*qb-8:0):0;
  const bf16*Kh=K+(rowbase+(int)T0*KVBLK)*DM+h*D,*Vh=V+(rowbase+(int)T0*KVBLK)*DM+h*D;
  const unsigned lds0=(unsigned)(uintptr_t)shm;
  float*wsf=(float*)(shm+LDS_WS)+wid*64;
  const bf16*ksrc=Kh+(int)lane*RS*DM+wid*8;
  const bf16*vsrc=Vh+(int)(16*(wid&3)+(lane>>2))*RS*DM+(wid>>2)*32+(lane&3)*8;
  const unsigned kdst=lds0+LDS_K+wid*1024, vdst=lds0+LDS_V+wid*1024;
  #define DMA_K(t,slot) glds16(ksrc+(int)(t)*KVBLK*RS*DM,(unsigned)__builtin_amdgcn_readfirstlane(kdst+(slot)))
  #define DMA_V(t,slot) glds16(vsrc+(int)(t)*KVBLK*RS*DM,(unsigned)__builtin_amdgcn_readfirstlane(vdst+(slot)))
  const int vb0=(int)(lds0+LDS_V)+((lane>>4)&1)*32+(lane&3)*8+(4*hi+((lane&15)>>2))*64;
  const char*Kbase=shm+LDS_K; bf16x8 kf[8];
  const lds_cptr shm3=(lds_cptr)shm; const lds_cptr kp0=shm3+LDS_K+hi*1024+r32*16; const lds_cptr vp0=shm3+LDS_V+((lane>>4)&1)*32+(lane&3)*8+(4*hi+((lane&15)>>2))*64;
  const int NT=FAR?4:(q0+QB)/KVBLK-T0;
  DMA_K(0,0);DMA_V(0,0);DMA_K(1,SLOTB);
  bf16x8 qr[4];
  #pragma unroll
  for(int d0=0;d0<4;++d0)qr[d0]=*reinterpret_cast<const bf16x8*>(&Qw[(int)r32*RS*DM+d0*16+hi*8]);
  float mhat=0.f,l_reg=0.f;f32x16 o[2];o[0]=f32x16{};o[1]=f32x16{};
  const int qrel=wid*QBLK+r32;
  const lds_cptr tabp=(lds_cptr)shm+LDS_TAB+lane*64;
  unsigned selmask=1u<<qb;
  if(KIND==0){
    f32x16 g=f32x16{};
    #pragma unroll
    for(int d0=0;d0<4;++d0){ float km[8];
      if(r32<16){ const float*kp_=kpart+(unsigned)((b*16+r32)*2)*512+h*64+d0*16+hi*8;
        const f32x4_t a0=*(const f32x4_t*)kp_,a1=*(const f32x4_t*)(kp_+4),b0=*(const f32x4_t*)(kp_+512),b1=*(const f32x4_t*)(kp_+516);
        km[0]=a0[0]+b0[0];km[1]=a0[1]+b0[1];km[2]=a0[2]+b0[2];km[3]=a0[3]+b0[3];km[4]=a1[0]+b1[0];km[5]=a1[1]+b1[1];km[6]=a1[2]+b1[2];km[7]=a1[3]+b1[3]; }
      else{ _Pragma("unroll") for(int j=0;j<8;++j)km[j]=0.f; }
      u32x4 wh,wl; float rs[8];
      wh[0]=cvtpk_s(km[0],km[1]);wh[1]=cvtpk_s(km[2],km[3]);wh[2]=cvtpk_s(km[4],km[5]);wh[3]=cvtpk_s(km[6],km[7]);
      #pragma unroll
      for(int j=0;j<4;++j){ rs[2*j]=km[2*j]-__uint_as_float(wh[j]<<16); rs[2*j+1]=km[2*j+1]-__uint_as_float(wh[j]&0xffff0000u); }
      wl[0]=cvtpk_s(rs[0],rs[1]);wl[1]=cvtpk_s(rs[2],rs[3]);wl[2]=cvtpk_s(rs[4],rs[5]);wl[3]=cvtpk_s(rs[6],rs[7]);
      g=__builtin_amdgcn_mfma_f32_32x32x16_bf16(__builtin_bit_cast(bf16x8,wh),qr[d0],g,0,0,0);
      g=__builtin_amdgcn_mfma_f32_32x32x16_bf16(__builtin_bit_cast(bf16x8,wl),qr[d0],g,0,0,0); }
    float gv[16];
    #pragma unroll
    for(int r=0;r<8;++r){ const float own=g[r],oth=__shfl_xor(own,32); const int bl=(r&3)+8*(r>>2); gv[bl]=hi?oth:own; gv[bl+4]=hi?own:oth; }
    #pragma unroll
    for(int j=0;j<16;++j) if(j>=qb)gv[j]=-3e38f;
    #pragma unroll
    for(int rd=0;rd<3;++rd){ float best=-3e38f;int bi=0;
      #pragma unroll
      for(int j=0;j<16;++j){ if(gv[j]>best){best=gv[j];bi=j;} }
      if(best>-3e38f)selmask|=1u<<bi;
      #pragma unroll
      for(int j=0;j<16;++j) if(j==bi)gv[j]=-3e38f; }
  }
  const int lo0=FAR?(32*wid-63):(q0-T0*KVBLK+32*wid-63);
  #define DMODE(t) dmode<KIND>(lo0-(t)*KVBLK)
  #define CMASK(P0,P1,t) do{ if(DIL){ if(md_t>=40){ const int dqh_=q0-(T0+(t))*KVBLK+qrel-4*hi; \
        if(md_t==41){ const f32x16 adj_=*(const __attribute__((address_space(3))) f32x16*)(tabp+3*TABB); dm_adj128(P0,P1,dqh_,adj_); } \
        else dm_range(P0,P1,dqh_-((md_t==40)?0:-4096),(md_t==40)?0x7fffffffu:4608u); } } \
    else if(FAR){ if(md_t==4)fmask(P0,P1,qrel-(t)*KVBLK-4*hi); } \
    else { int jb_=(t)-(NT-4); if(jb_>=0)cmask(P0,P1,jb_,qrel,hi); } }while(0)
  #define SETC(t) f32x16 ct; const int md_t=(KIND==0)?0:DMODE(t); { if(DIL){ const int to_=(md_t==0)?0:((md_t==2||md_t==42)?2*TABB:TABB); \
      const f32x16 tb_=*(const __attribute__((address_space(3))) f32x16*)(tabp+to_); _Pragma("unroll") for(int r=0;r<16;++r)ct[r]=tb_[r]-mhat; } \
    else { const float x_=(FAR?(md_t!=0):(((selmask>>((t)>>2))&1u)!=0u))?-mhat:-1e30f; _Pragma("unroll") for(int r=0;r<16;++r)ct[r]=x_; } asm volatile("":"+v"(ct)); }
  bool resc=false;
  #define START(P0,P1) do{ const float rm=rowmax(P0,P1); resc=false; \
    if(__any(rm>(float)THRL)){ const float dl=__builtin_fmaxf(rm,0.f); mhat=fadd_s(mhat,dl); \
      _Pragma("unroll") for(int r=0;r<16;++r){P0[r]=fsub_s(P0[r],dl);P1[r]=fsub_s(P1[r],dl);} \
      const float f=__builtin_amdgcn_exp2f(-dl); l_reg*=f; if(hi==0)wsf[r32]=f; resc=true; } \
    _Pragma("unroll") for(int r=0;r<16;++r)P0[r]=__builtin_amdgcn_exp2f(P0[r]); }while(0)
  #define RESC() do{ if(resc){ asm volatile("s_waitcnt lgkmcnt(0)":::"memory"); \
      _Pragma("unroll") for(int d_=0;d_<2;++d_) _Pragma("unroll") for(int r=0;r<16;++r)o[d_][r]*=wsf[crow(r,hi)]; } }while(0)
  f32x16 pA0,pA1,pB0,pB1;
  int sl_prev=0,sl_cur=0,sl_next=SLOTB;
  #define ROT() do{sl_prev=sl_cur;sl_cur=sl_next;sl_next=(sl_next==(NSLOT-1)*SLOTB)?0:sl_next+SLOTB;}while(0)
  DMA_K(2,2*SLOTB);
  WAIT_BAR(3);
  { SETC(0); qkt(pA0,pA1,Kbase,qr,ct,r32,hi); asm volatile("s_nop 15\n\ts_nop 7":"+v"(pA0),"+v"(pA1));CMASK(pA0,pA1,0); }
  START(pA0,pA1);
  _Pragma("unroll") for(int r=0;r<16;++r)pA1[r]=__builtin_amdgcn_exp2f(pA1[r]);
  WAIT_BAR(0);
  RESC();
  DMA_K(3,0);DMA_V(1,SLOTB);
  ROT();
  kload8(kf,kp0+sl_cur);
  WAIT_BAR(2);
  s16x4 vlo[8],vhi[8]; u32x4 pw0,pw1,pw2,pw3;
  #define PKW(P,B) cvtpk_s(P[B],P[B+1])
  #define PAF(k) __builtin_bit_cast(bf16x8,pw##k)
  #define VFR(i) (bf16x8){vlo[i][0],vlo[i][1],vlo[i][2],vlo[i][3],vhi[i][0],vhi[i][1],vhi[i][2],vhi[i][3]}
  #define PIN(x) asm volatile("":"+v"(x))
  #define MX3(a,b,c) __builtin_fmaxf(__builtin_fmaxf((a),(b)),(c))
  #define GAPA(MF,A0,A1,A2,A3,W0,W1,PW) do{ MF; sacc+=A0; sacc+=A1; sacc+=A2; sacc+=A3; PIN(sacc); W0; W1; PIN(PW); SBAR(); }while(0)
  #define EX(v) __builtin_amdgcn_exp2f(v)
  #define GAPB(MF,X,B) do{ MF; X[B]=EX(X[B]); X[B+1]=EX(X[B+1]); X[B+2]=EX(X[B+2]); X[B+3]=EX(X[B+3]); PIN(X); SBAR(); }while(0)
  #define VRD(i) do{ vlo[i]=vtr(vp_+(((i)>>2)*4096+((i)&3)*1024)); vhi[i]=vtr(vp_+(((i)>>2)*4096+((i)&3)*1024+512)); }while(0)
  #define KRD(G,j) do{ if(G){ kload2(kf,kp0+sl_next,j); SBAR(); } }while(0)
  #define STEP(C0,C1,P0,P1,t,GK,GV,GL) do{ SBAR(); SETC(t); SBAR(); \
    const lds_cptr vp_=vp0+sl_prev; \
    VRD(0); SBAR(); float sacc=(P0[0]+P0[1]); \
    GAPA(C0=__builtin_amdgcn_mfma_f32_32x32x16_bf16(kf[0],qr[0],ct,0,0,0), P0[2],P0[3],P0[4],P0[5],     pw0[0]=PKW(P0,0), pw0[1]=PKW(P0,2), pw0); \
    VRD(4); SBAR(); GAPA(C1=__builtin_amdgcn_mfma_f32_32x32x16_bf16(kf[1],qr[0],ct,0,0,0), P0[6],P0[7],P0[8],P0[9],     pw0[2]=PKW(P0,4), pw0[3]=PKW(P0,6), pw0); \
    VRD(1); SBAR(); GAPA(C0=__builtin_amdgcn_mfma_f32_32x32x16_bf16(kf[2],qr[1],C0,0,0,0),   P0[10],P0[11],P0[12],P0[13], pw1[0]=PKW(P0,8), pw1[1]=PKW(P0,10), pw1); \
    VRD(5); SBAR(); GAPA(C1=__builtin_amdgcn_mfma_f32_32x32x16_bf16(kf[3],qr[1],C1,0,0,0),   P0[14],P0[15],P1[0],P1[1],   pw1[2]=PKW(P0,12),pw1[3]=PKW(P0,14), pw1); \
    VRD(2); SBAR(); GAPA(C0=__builtin_amdgcn_mfma_f32_32x32x16_bf16(kf[4],qr[2],C0,0,0,0),   P1[2],P1[3],P1[4],P1[5],     pw2[0]=PKW(P1,0), pw2[1]=PKW(P1,2), pw2); \
    VRD(6); SBAR(); GAPA(C1=__builtin_amdgcn_mfma_f32_32x32x16_bf16(kf[5],qr[2],C1,0,0,0),   P1[6],P1[7],P1[8],P1[9],     pw2[2]=PKW(P1,4), pw2[3]=PKW(P1,6), pw2); \
    VRD(3); SBAR(); GAPA(C0=__builtin_amdgcn_mfma_f32_32x32x16_bf16(kf[6],qr[3],C0,0,0,0),   P1[10],P1[11],P1[12],P1[13], pw3[0]=PKW(P1,8), pw3[1]=PKW(P1,10), pw3); \
    VRD(7); SBAR(); GAPA(C1=__builtin_amdgcn_mfma_f32_32x32x16_bf16(kf[7],qr[3],C1,0,0,0),   P1[14],P1[15],0.f,0.f,       pw3[2]=PKW(P1,12),pw3[3]=PKW(P1,14), pw3); \
    l_reg+=sacc; \
    if(GK){DMA_K((t)+3,sl_cur);} if(GV){DMA_V((t)+1,sl_next);} \
    CMASK(C0,C1,t); \
    { float a=MX3(C0[0],C0[1],C1[0]),b=MX3(C0[2],C0[3],C1[1]); a=MX3(a,C1[2],C1[3]); \
      _Pragma("unroll") for(int r=4;r<16;r+=4){a=MX3(a,C0[r],C0[r+1]);b=MX3(b,C0[r+2],C0[r+3]);a=MX3(a,C1[r],C1[r+1]);b=MX3(b,C1[r+2],C1[r+3]);} \
      float rm=__builtin_fmaxf(a,b); { auto rr=__builtin_amdgcn_permlane32_swap(__float_as_uint(rm),__float_as_uint(rm),false,false); rm=__builtin_fmaxf(__uint_as_float(rr[0]),__uint_as_float(rr[1])); } \
      resc=false; \
      if(__builtin_expect(__any(rm>(float)THRL),0)){ const float dl=__builtin_fmaxf(rm,0.f); mhat+=dl; \
        _Pragma("unroll") for(int r=0;r<16;++r){C0[r]-=dl;C1[r]-=dl;} \
        const float f=__builtin_amdgcn_exp2f(-dl); l_reg*=f; if(hi==0)wsf[r32]=f; resc=true; } } \
    SBAR(); \
    GAPB(o[0]=__builtin_amdgcn_mfma_f32_32x32x16_bf16(PAF(0),VFR(0),o[0],0,0,0), C0,0); \
    GAPB(o[1]=__builtin_amdgcn_mfma_f32_32x32x16_bf16(PAF(0),VFR(4),o[1],0,0,0), C0,4); \
    KRD(GL,0); GAPB(o[0]=__builtin_amdgcn_mfma_f32_32x32x16_bf16(PAF(1),VFR(1),o[0],0,0,0), C0,8); \
    KRD(GL,1); GAPB(o[1]=__builtin_amdgcn_mfma_f32_32x32x16_bf16(PAF(1),VFR(5),o[1],0,0,0), C0,12); \
    KRD(GL,2); GAPB(o[0]=__builtin_amdgcn_mfma_f32_32x32x16_bf16(PAF(2),VFR(2),o[0],0,0,0), C1,0); \
    KRD(GL,3); GAPB(o[1]=__builtin_amdgcn_mfma_f32_32x32x16_bf16(PAF(2),VFR(6),o[1],0,0,0), C1,4); \
    GAPB(o[0]=__builtin_amdgcn_mfma_f32_32x32x16_bf16(PAF(3),VFR(3),o[0],0,0,0), C1,8); \
    GAPB(o[1]=__builtin_amdgcn_mfma_f32_32x32x16_bf16(PAF(3),VFR(7),o[1],0,0,0), C1,12); \
    }while(0)
  int t=1;
  for(;t+5<NT;t+=2){
    STEP(pB0,pB1,pA0,pA1,t,true,true,true);     WAIT_BAR(2); RESC(); ROT();
    STEP(pA0,pA1,pB0,pB1,t+1,true,true,true);   WAIT_BAR(2); RESC(); ROT();
  }
  #define ENDW(tt) do{ if((tt)+3<NT){WAIT_BAR(2);} else if((tt)+2<NT){WAIT_BAR(1);} else {WAIT_BAR(0);} }while(0)
  for(;t+1<NT;t+=2){
    STEP(pB0,pB1,pA0,pA1,t,(t+3<NT),(t+1<NT),(t+1<NT));       ENDW(t);   RESC(); ROT();
    STEP(pA0,pA1,pB0,pB1,t+1,(t+4<NT),(t+2<NT),(t+2<NT));     ENDW(t+1); RESC(); ROT();
  }
  STEP(pB0,pB1,pA0,pA1,NT-1,false,false,false); RESC();
  { float sacc=pB0[0]+pB0[1]; _Pragma("unroll") for(int r=2;r<16;++r)sacc+=pB0[r]; _Pragma("unroll") for(int r=0;r<16;++r)sacc+=pB1[r]; l_reg+=sacc;
    pw0=(u32x4){PKW(pB0,0),PKW(pB0,2),PKW(pB0,4),PKW(pB0,6)};pw1=(u32x4){PKW(pB0,8),PKW(pB0,10),PKW(pB0,12),PKW(pB0,14)};pw2=(u32x4){PKW(pB1,0),PKW(pB1,2),PKW(pB1,4),PKW(pB1,6)};pw3=(u32x4){PKW(pB1,8),PKW(pB1,10),PKW(pB1,12),PKW(pB1,14)};
    SBAR(); pv(o,vb0+sl_cur,PAF(0),PAF(1),PAF(2),PAF(3)); }
  #undef PKW
  #undef PAF
  #undef VFR
  #undef PIN
  #undef MX3
  #undef GAPA
  #undef GAPB
  #undef EX
  #undef VRD
  #undef KRD
  #undef STEP
  #undef ENDW
  {auto rr=__builtin_amdgcn_permlane32_swap(__float_as_uint(l_reg),__float_as_uint(l_reg),false,false);l_reg=__uint_as_float(rr[0])+__uint_as_float(rr[1]);}
  int lane_e=lane; asm volatile("":"+v"(lane_e));
  u32x4 fch[4];
  if(DIL){
    const unsigned short*fp=faro+(unsigned)(rowbase+q0+wid*QBLK+(lane_e>>3))*512+(h-8)*D+(lane_e&7)*8;
    #pragma unroll
    for(int i=0;i<4;++i)fch[i]=*(const u32x4*)(fp+(unsigned)i*8*512);
    const float*lp=farl+((unsigned)(rowbase+q0+wid*QBLK+(lane_e&31))*8+(h-8))*2; const float lf_=lp[0],mf_=lp[1];
    const float M_=__builtin_fmaxf(mhat,mf_),sa_=__builtin_amdgcn_exp2f(mhat-M_),sb_=__builtin_amdgcn_exp2f(mf_-M_),rl_=__builtin_amdgcn_rcpf(l_reg*sa_+lf_*sb_);
    if(hi==0){wsf[32+r32]=sa_*rl_;wsf[r32]=sb_*rl_;} }
  else if(hi==0)wsf[32+r32]=FAR?1.f:__builtin_amdgcn_rcpf(l_reg);
  asm volatile("s_waitcnt lgkmcnt(0)":::"memory");
  float rli[16];
  #pragma unroll
  for(int r=0;r<16;++r)rli[r]=wsf[32+crow(r,hi)];
  constexpr int OP=FAR?512:DM;
  bf16*Ow=(bf16*)faro+(rowbase+(int)wid*QBLK*RS)*OP+(h-8)*D;
  unsigned char*O8w=O8+(rowbase+q0+wid*QBLK)*DM+h*D;
  if(FAR&&hi==0){ float*lp=farl+((unsigned)(rowbase+(int)qrel*RS)*8+(h-8))*2; __hip_atomic_store((unsigned long long*)lp,((unsigned long long)__float_as_uint(mhat)<<32)|__float_as_uint(l_reg),__ATOMIC_RELAXED,__HIP_MEMORY_SCOPE_AGENT); }
  { bf16*stg=(bf16*)(shm+LDS_OST)+wid*2048;
    #pragma unroll
    for(int r=0;r<16;++r){const int orow=crow(r,hi);
      #pragma unroll
      for(int d0=0;d0<2;++d0)stg[orow*64+d0*32+r32]=__float2bfloat16(o[d0][r]*rli[r]);}
    asm volatile("s_waitcnt lgkmcnt(0)":::"memory");
    #pragma unroll
    for(int i=0;i<4;++i){const int row=i*8+(lane_e>>3),ch=lane_e&7; u32x4 v=*(const u32x4*)(stg+row*64+ch*8);
      if(DIL){ const float fb_=wsf[row];
        #pragma unroll
        for(int j=0;j<4;++j){ const float a_=__uint_as_float(v[j]<<16)+__uint_as_float(fch[i][j]<<16)*fb_, b_=__uint_as_float(v[j]&0xffff0000u)+__uint_as_float(fch[i][j]&0xffff0000u)*fb_; v[j]=cvtpk_s(a_,b_); } }
      if(FAR){ ATTN_STORE16(Ow+(int)row*RS*OP+ch*8,v); }
      else { unsigned w0_=0,w1_=0;
        w0_=__builtin_amdgcn_cvt_pk_fp8_f32(__uint_as_float(v[0]<<16)*64.f,__uint_as_float(v[0]&0xffff0000u)*64.f,w0_,false); w0_=__builtin_amdgcn_cvt_pk_fp8_f32(__uint_as_float(v[1]<<16)*64.f,__uint_as_float(v[1]&0xffff0000u)*64.f,w0_,true);
        w1_=__builtin_amdgcn_cvt_pk_fp8_f32(__uint_as_float(v[2]<<16)*64.f,__uint_as_float(v[2]&0xffff0000u)*64.f,w1_,false); w1_=__builtin_amdgcn_cvt_pk_fp8_f32(__uint_as_float(v[3]<<16)*64.f,__uint_as_float(v[3]&0xffff0000u)*64.f,w1_,true);
        *(unsigned long long*)(O8w+(int)row*DM+ch*8)=((unsigned long long)w1_<<32)|w0_; }
      float sq=0.f;
      #pragma unroll
      for(int j=0;j<4;++j){ const float a_=__uint_as_float(v[j]<<16), b_=__uint_as_float(v[j]&0xffff0000u); sq+=a_*a_+b_*b_; }
      sq+=__shfl_xor(sq,1); sq+=__shfl_xor(sq,2); sq+=__shfl_xor(sq,4);
      if(!FAR&&ch==0)ssq[(unsigned)(rowbase+q0+wid*QBLK+row)*16+h]=sq; } }
  asm volatile("s_waitcnt lgkmcnt(0)\n\ts_barrier":::"memory");
  #undef DMA_K
  #undef DMA_V
  #undef CMASK
  #undef START
  #undef RESC
  #undef ROT
}
constexpr int ATTN_LDS_BYTES=LDS_BYTES;
__device__ __forceinline__ void attn_tables(char*lds,int wave){
  float*tb=(float*)(lds+LDS_TAB);
  for(int e=wave*64+mk_lane();e<64*16;e+=512){ const int ln=e>>4,r=e&15,r32=ln&31,hi=ln>>5; const int z4=r32&3,z16=((r32&15)-4*hi)&15;
    const bool in4=(z4==(r&3)),in16=(z16==((r&3)+8*((r>>2)&1)));
    tb[e]=-1e30f; tb[1024+e]=in16?1.5849625007f:(in4?1.f:0.f); tb[2048+e]=in16?1.f:(in4?0.f:-1e30f); tb[3072+e]=in16?(1.f-1.5849625007f):(in4?-1.f:-1e30f); }
  __syncthreads();
}
template<int THRL=8> __device__ __forceinline__ void attn_phase(char*lds,unsigned char*ws,unsigned*cnt,int vcu,int G,int wave){
  const int g=vcu>>2,b=g>>3,hm=g&7,c=vcu&3;
  attn_tables(lds,wave);
  for(int i=0;i<(MK_REPEAT_PHASE==22?8:4);++i) attn_unit<THRL,2>(b,8+hm,4*c+(i&3),ws,lds,wave);
  asm volatile("s_waitcnt vmcnt(0)":::"memory"); __syncthreads();
  if(wave==0&&mk_lane()==0) __hip_atomic_fetch_add(cnt,1u,__ATOMIC_RELAXED,__HIP_MEMORY_SCOPE_AGENT);
  for(int ii=0;ii<(MK_REPEAT_PHASE==20?8:4);++ii){ const int i=ii&3; const int qb=(i==0)?15-c:(i==1)?8+c:(i==2)?7-c:c; attn_unit<THRL,0>(b,hm,qb,ws,lds,wave); }
  if(wave==0&&mk_lane()==0){ unsigned sp=0; while(__hip_atomic_load(cnt,__ATOMIC_RELAXED,__HIP_MEMORY_SCOPE_AGENT)<(unsigned)G){ __builtin_amdgcn_s_sleep(2); if(++sp>(1u<<22))break; }
    __builtin_amdgcn_fence(__ATOMIC_ACQUIRE,"agent"); asm volatile("s_waitcnt vmcnt(0)":::"memory"); }
  __syncthreads();
  for(int ii=0;ii<(MK_REPEAT_PHASE==21?8:4);++ii){ const int i=ii&3; const int qb=(i==0)?15-c:(i==1)?8+c:(i==2)?7-c:c; attn_unit<THRL,1>(b,8+hm,qb,ws,lds,wave); }
}
#undef SBAR
#undef WAIT_BAR
}

struct Frame {
    LAS unsigned char* lds;
    volatile LAS unsigned* MISC;
    gu32* ctl;
    int wave;
    int vcu, G;
    const float *x, *attn_norm, *w_in, *moba_norm, *dil_norm, *w_out, *ffn_norm, *w_gate, *w_up, *w_down, *final_norm;
    float* out;
    bf16 *Wqkv_t, *Wo_t, *Wgu_t, *Wd_t;
    bf16 *QO, *KB, *VB, *XN, *OB; unsigned char *HB, *XN8;
    float *rope, *kpart, *ssqa, *ssq1, *ssq2;
};

__device__ __forceinline__ float wave_sum(float v) {
#pragma unroll
    for (int o = 1; o < 64; o <<= 1) v += __shfl_xor(v, o);
    return v;
}
__device__ __forceinline__ int qkv_vrow(int n) { const int part = n >> 10, head = (n >> 6) & 15, d = n & 63; return 256 * (part * 4 + (head >> 2)) + 128 * (d >> 5) + 32 * (head & 3) + (d & 31); }
template <int MODE>
__device__ __forceinline__ void p0_item(const float* W, int K, int N, bf16* WT, const float* g0, const float* g1, LAS float* scr, int item, int lane) {
    const int nblk = N / 32, kb = item / nblk, nb = item % nblk, k0 = 64 * kb, n0 = 32 * nb;
#pragma unroll 8
    for (int i = 0; i < 32; ++i) { const int kk = 2 * i + (lane >> 5), k = k0 + kk; float w = W[(size_t)k * N + n0 + (lane & 31)];
        if (MODE == 1) w *= (k < 512 ? g0[k] : g1[k - 512]);
        if (MODE == 2 || MODE == 3) w *= g0[k];
        scr[kk * 33 + (lane & 31)] = w; }
    LDS_WAIT(); asm volatile("" ::: "memory");
    const int c = lane & 7;
#pragma unroll
    for (int j = 0; j < 4; ++j) { const int n = (lane >> 3) + 8 * j; const LAS float* s = scr + (8 * c) * 33 + n;
        const int ns = n0 + n; int dr;
        if (MODE == 0) dr = qkv_vrow(ns); else if (MODE == 2) dr = 256 * (ns >> 7) + (ns & 127); else if (MODE == 3) dr = 256 * (ns >> 7) + 128 + (ns & 127); else dr = ns;
        bool f8 = MODE >= 1; size_t base8 = 0;
        if (MODE == 0) {
            const int pn = dr >> 8, lo = dr & 255; f8 = !(pn < 8 && (pn & 3) < 2);
            dr = (f8 ? (pn < 8 ? ((pn & 1) + 2 * (pn >> 2)) : pn - 4) : ((pn & 1) + 2 * (pn >> 2))) * 256 + lo; base8 = (size_t)QKV8_OFF; }
        if (f8) {
            const pg8::f32x4 a = {s[0 * 33], s[1 * 33], s[2 * 33], s[3 * 33]}, b = {s[4 * 33], s[5 * 33], s[6 * 33], s[7 * 33]};
            *(GAS pg8::u32x2*)((unsigned char*)WT + base8 + (size_t)dr * K + k0 + 8 * c) = pg8::pack8_fp8(a * pg8::F8_SW, b * pg8::F8_SW);
        } else {
            v4u o; o.x = pk2(s[0 * 33], s[1 * 33]); o.y = pk2(s[2 * 33], s[3 * 33]); o.z = pk2(s[4 * 33], s[5 * 33]); o.w = pk2(s[6 * 33], s[7 * 33]);
            *(GAS v4u*)(WT + (size_t)dr * K + k0 + 8 * c) = o; } }
    LDS_WAIT(); asm volatile("" ::: "memory");
}
template <int R>
__device__ __forceinline__ void rms_rows_to_bf16(Frame& F, const float* xrow, const float* gain, bf16* orow, unsigned char* orow8, float* rn) {
    const GAS f32x4* xr = (const GAS f32x4*)xrow + mk_lane(); const GAS f32x4* gr = (const GAS f32x4*)gain + mk_lane();
    f32x4 v[R][4]; float s[R];
#pragma unroll
    for (int r = 0; r < R; ++r)
#pragma unroll
        for (int j = 0; j < 4; ++j) v[r][j] = xr[r * 256 + 64 * j];
#pragma unroll
    for (int r = 0; r < R; ++r) { s[r] = 0.f;
#pragma unroll
        for (int j = 0; j < 4; ++j) s[r] += (v[r][j].x * v[r][j].x + v[r][j].y * v[r][j].y) + (v[r][j].z * v[r][j].z + v[r][j].w * v[r][j].w); }
#pragma unroll
    for (int o = 1; o < 64; o <<= 1)
#pragma unroll
        for (int r = 0; r < R; ++r) s[r] += __shfl_xor(s[r], o);
    const int ln_ = mk_lane(); GAS unsigned long long* o8 = (GAS unsigned long long*)orow + ln_; GAS unsigned* q8 = (GAS unsigned*)orow8 + ln_;
#pragma unroll
    for (int r = 0; r < R; ++r) { const float rms = sqrtf(s[r] * (1.f / D) + RMS_EPS), rstd = 1.f / rms; if (ln_ == 0) rn[r] = rms;
#pragma unroll
        for (int j = 0; j < 4; ++j) { const f32x4 g = gr[64 * j];
            const f32x4 y = v[r][j] * rstd * g;
            o8[r * 256 + 64 * j] = (unsigned long long)pk2(y.x, y.y) | ((unsigned long long)pk2(y.z, y.w) << 32);
            unsigned t = 0; t = __builtin_amdgcn_cvt_pk_fp8_f32(y.x * pg8::F8_SA, y.y * pg8::F8_SA, t, false); t = __builtin_amdgcn_cvt_pk_fp8_f32(y.z * pg8::F8_SA, y.w * pg8::F8_SA, t, true); q8[r * 256 + 64 * j] = t; } }
}
__device__ __forceinline__ void p0_prologue(Frame& F) {
    LAS float* scr = (LAS float*)(F.lds + RING_OFF + F.wave * 16384);
    const int gw = F.vcu * NWAVES + F.wave, NGW = F.G * NWAVES;
    constexpr int I_IN = (D / 64) * (NQKV / 32), I_O = (D / 64) * (D / 32), I_G = (D / 64) * (FF / 32), I_D = (FF / 64) * (D / 32);
    constexpr int NITEMS = I_IN + I_O + 2 * I_G + I_D;
    for (int it = gw; it < NITEMS; it += NGW) {
        int r = it;
        if (r < I_IN) { p0_item<0>(F.w_in, D, NQKV, F.Wqkv_t, nullptr, nullptr, scr, r, mk_lane()); continue; } r -= I_IN;
        if (r < I_O) { p0_item<1>(F.w_out, D, D, F.Wo_t, F.moba_norm, F.dil_norm, scr, r, mk_lane()); continue; } r -= I_O;
        if (r < I_G) { p0_item<2>(F.w_gate, D, FF, F.Wgu_t, F.ffn_norm, nullptr, scr, r, mk_lane()); continue; } r -= I_G;
        if (r < I_G) { p0_item<3>(F.w_up, D, FF, F.Wgu_t, F.ffn_norm, nullptr, scr, r, mk_lane()); continue; } r -= I_G;
        p0_item<4>(F.w_down, FF, D, F.Wd_t, nullptr, nullptr, scr, r, mk_lane());
    }
    for (int e = (F.vcu * NWAVES * 64) + F.wave * 64 + mk_lane(); e < SEQ * 32; e += F.G * NWAVES * 64) {
        const int s = e >> 5, j = e & 31;
        const float invf = __builtin_amdgcn_exp2f(-(float)j * (13.287712379549449f / 32.0f));
        double rev = (double)s * (double)invf * 0.15915494309189535; rev -= __builtin_floor(rev);
        const float r = (float)rev;
        pg8::f32x2 cs; cs.x = __builtin_amdgcn_cosf(r); cs.y = __builtin_amdgcn_sinf(r);
        *(GAS pg8::f32x2*)((pg8::f32x2*)F.rope + e) = cs;
    }
    for (int m = 4 * gw; m < M; m += 4 * NGW) rms_rows_to_bf16<4>(F, F.x + (size_t)m * D, F.attn_norm, F.XN + (size_t)m * D, F.XN8 + (size_t)m * D, (float*)(F.kpart + 131072) + m);
}

__device__ __forceinline__ void p6_final(Frame& F) {
    const int gw = F.vcu * NWAVES + F.wave, NGW = F.G * NWAVES;
    const GAS f32x4* gr = (const GAS f32x4*)F.final_norm + mk_lane();
    for (int m = gw; m < M; m += NGW) {
        GAS f32x4* xr = (GAS f32x4*)(F.out + (size_t)m * D) + mk_lane();
        const GAS f32x4* sp = (const GAS f32x4*)(F.ssq2 + (size_t)m * 16);
        const f32x4 a = sp[0], b = sp[1], c = sp[2], d = sp[3];
        const float ss = ((a.x + a.y) + (a.z + a.w)) + ((b.x + b.y) + (b.z + b.w)) + ((c.x + c.y) + (c.z + c.w)) + ((d.x + d.y) + (d.z + d.w));
        const float rstd = 1.f / sqrtf(ss * (1.f / D) + RMS_EPS);
#pragma unroll
        for (int j = 0; j < 4; ++j) { const f32x4 v = xr[64 * j], g = gr[64 * j]; xr[64 * j] = v * rstd * g; }
    }
}

struct Args { const float* in[11]; float* out; unsigned char* ws; int ph_lo, ph_hi, li, pad; };
__global__ void __launch_bounds__(NWAVES * 64, 2) mk_fwd(Args args) {
    extern __shared__ __attribute__((aligned(16))) unsigned char lds[];
    Frame F;
    F.lds = (LAS unsigned char*)lds;
    F.MISC = (volatile LAS unsigned*)(F.lds + MISC_OFF);
    F.wave = __builtin_amdgcn_readfirstlane((int)(threadIdx.x >> 6));
    F.G = gridDim.x; { const int bx = blockIdx.x; F.vcu = (F.G % 8 == 0) ? (bx % 8) * (F.G / 8) + bx / 8 : bx; }
#define GRID_BAR(seam) do { if (N_LAUNCHES == PER_PHASE) { if ((F.wave == 0 && mk_lane() == 0)) __hip_atomic_store(F.ctl + CW_TMO, 0xBADBA0u | (unsigned)(seam), RLX_AGENT); } \
    else { xcd_barrier(bar, F.wave); if (MK_REPEAT_PHASE == 30) xcd_barrier(bar, F.wave); } } while (0)
    unsigned char* ws = args.ws;
    F.ctl = (gu32*)(ws + WS_CTL);
    F.x = args.in[0]; F.attn_norm = args.in[1]; F.w_in = args.in[2]; F.moba_norm = args.in[3]; F.dil_norm = args.in[4]; F.w_out = args.in[5];
    F.ffn_norm = args.in[6]; F.w_gate = args.in[7]; F.w_up = args.in[8]; F.w_down = args.in[9]; F.final_norm = args.in[10]; F.out = args.out;
    F.Wqkv_t = (bf16*)(ws + WS_WQKV); F.Wo_t = (bf16*)(ws + WS_WO); F.Wgu_t = (bf16*)(ws + WS_WGU); F.Wd_t = (bf16*)(ws + WS_WD);
    F.QO = (bf16*)(ws + WS_QO); F.KB = (bf16*)(ws + WS_K); F.VB = (bf16*)(ws + WS_V); F.HB = ws + WS_H; F.XN8 = ws + WS_XN8; F.XN = (bf16*)(ws + WS_XN); F.OB = (bf16*)(ws + WS_O);
    F.rope = (float*)(ws + WS_ROPE); F.kpart = (float*)(ws + WS_KPART); F.ssqa = (float*)(ws + WS_SSQA); F.ssq1 = (float*)(ws + WS_SSQ1); F.ssq2 = (float*)(ws + WS_SSQ2);
    for (int u = F.wave * 64 + mk_lane(); u < (LDS_BYTES - LDSCTL_OFF) / 4; u += NWAVES * 64) ((LAS unsigned*)(F.lds + LDSCTL_OFF))[u] = 0u;
    __syncthreads();
    XcdBarrier bar; bar.bar = (unsigned*)(F.ctl + CW_BAR); bar.x = 0; bar.st = nullptr;
    if (N_LAUNCHES != PER_PHASE) bar = xcd_barrier_post((unsigned*)(F.ctl + CW_BAR), F.MISC + 8, F.wave);
    const int lo = args.ph_lo, hi = args.ph_hi;
#define IN(k) (lo <= (k) && (k) < hi)
#define BOTH(k) (IN(k) && IN((k) + 1))

    if (IN(0)) { for (int rp = 0; rp < (MK_REPEAT_PHASE == 0 ? 2 : 1); ++rp) p0_prologue(F); if (BOTH(0)) GRID_BAR(0); }

    if (IN(1)) {
        { pg8::Gemm g{F.XN, F.Wqkv_t, M, 1024, D}; pg8::StaticOrder S; S.init(M, 1024, F.G, (int)blockIdx.x, MK_REPEAT_PHASE == 1 ? 2 : 1);
          pg8::EpiQKV E{F.QO, (size_t)(WS_K - WS_QO) / 2, F.rope, F.kpart, QSCALE, 1, 1.f};
          pg8::gemm_phase<pg8::EpiQKV, pg8::StaticOrder, true, true>(F.lds + RING_OFF, g, S, E, F.wave); }
        { pg8::Gemm g{(const bf16*)F.XN8, (const bf16*)((const unsigned char*)F.Wqkv_t + QKV8_OFF), M, 2048, D}; pg8::StaticOrder S; S.init(M, 2048, F.G, (int)blockIdx.x, MK_REPEAT_PHASE == 1 ? 2 : 1);
          pg8::EpiQKV E{F.QO, (size_t)(WS_K - WS_QO) / 2, F.rope, F.kpart, QSCALE, 2, 1.f / (pg8::F8_SA * pg8::F8_SW)};
          pg8::gemm_phase<pg8::EpiQKV, pg8::StaticOrder, true, true, true>(F.lds + RING_OFF, g, S, E, F.wave); }
        if (BOTH(1)) GRID_BAR(1);
    }

    if (IN(2)) {
        if (F.G == 256) {
            for (int rp = 0; rp < (MK_REPEAT_PHASE == 2 ? 2 : 1); ++rp) attn_body::attn_phase<8>((char*)lds + RING_OFF, ws, (unsigned*)(F.ctl + CW_FAR), F.vcu, F.G, F.wave);
        }
        if (BOTH(2)) GRID_BAR(2);
    }

    if (IN(3)) {
        pg8::Gemm g{(const bf16*)(ws + WS_O8), F.Wo_t, M, D, D};   pg8::StaticOrder S; S.init(M, D, F.G, (int)blockIdx.x, MK_REPEAT_PHASE == 3 ? 2 : 1);
        pg8::EpiWo E{F.kpart + 131072, F.attn_norm, F.XN, F.XN8, F.ssqa, F.ssq1};
        pg8::gemm_phase<pg8::EpiWo, pg8::StaticOrder, true, true, true>(F.lds + RING_OFF, g, S, E, F.wave);
        if (BOTH(3)) GRID_BAR(3);
    }

    if (IN(4)) {
        pg8::Gemm g{(const bf16*)F.XN8, F.Wgu_t, M, NGU, D}; pg8::StaticOrder S; S.init(M, NGU, F.G, (int)blockIdx.x, MK_REPEAT_PHASE == 4 ? 2 : 1);
        pg8::EpiGU E{F.ssq1, F.HB};
        pg8::gemm_phase<pg8::EpiGU, pg8::StaticOrder, true, true, true>(F.lds + RING_OFF, g, S, E, F.wave);
        if (BOTH(4)) GRID_BAR(4);
    }

    if (IN(5)) {
        pg8::Gemm g{(const bf16*)F.HB, F.Wd_t, M, D, FF};   pg8::StaticOrder S; S.init(M, D, F.G, (int)blockIdx.x, MK_REPEAT_PHASE == 5 ? 2 : 1);
#if defined(MK_SPLIT_FINAL)
        pg8::EpiDown E{F.XN, F.out, F.ssq2};
        pg8::gemm_phase<pg8::EpiDown, pg8::StaticOrder, true, true, true>(F.lds + RING_OFF, g, S, E, F.wave);
        if (BOTH(5)) GRID_BAR(5);
#else
        if (F.G == 256) { pg8::EpiDownNorm E{F.XN, F.out, F.ssq2, (unsigned*)(F.ctl + CW_PANEL), F.final_norm};
            pg8::gemm_phase<pg8::EpiDownNorm, pg8::StaticOrder, true, true, true>(F.lds + RING_OFF, g, S, E, F.wave); }
        else { pg8::EpiDown E{F.XN, F.out, F.ssq2}; pg8::gemm_phase<pg8::EpiDown, pg8::StaticOrder, true, true, true>(F.lds + RING_OFF, g, S, E, F.wave); GRID_BAR(5); p6_final(F); }
#endif
    }

#if defined(MK_SPLIT_FINAL)
    if (IN(6)) { p6_final(F); }
#endif
#undef IN
#undef BOTH
}

extern "C" void kernel_launch(void* const* d_in, const int* in_sizes, int n_in, void* d_out, int out_size, void* d_ws, size_t ws_size, hipStream_t stream) {
    static int grid = 0;
    if (grid == 0) {
        if (n_in != 11 || in_sizes[0] != M * D || out_size != M * D || ws_size < WS_END) { fprintf(stderr, "kernel_launch: unexpected shapes (n_in %d, in0 %d, out %d, ws %zu); nothing launched\n", n_in, n_in > 0 ? in_sizes[0] : -1, out_size, ws_size); grid = -1; return; }
        int dev = 0, cus = 0, per_cu = 0;
        if (hipGetDevice(&dev) != hipSuccess || hipDeviceGetAttribute(&cus, hipDeviceAttributeMultiprocessorCount, dev) != hipSuccess) { grid = -1; return; }
        if (hipFuncSetAttribute((const void*)mk_fwd, hipFuncAttributeMaxDynamicSharedMemorySize, LDS_BYTES) != hipSuccess) { fprintf(stderr, "kernel_launch: hipFuncSetAttribute failed\n"); grid = -1; return; }
        if (hipOccupancyMaxActiveBlocksPerMultiprocessor(&per_cu, (const void*)mk_fwd, NWAVES * 64, LDS_BYTES) != hipSuccess || per_cu < 1) { fprintf(stderr, "kernel_launch: occupancy query says %d blocks per CU\n", per_cu); (void)hipGetLastError(); per_cu = 1; }
        grid = cus;
        if (grid > 256) grid = 256;
    }
    if (grid < 0) return;
    if (hipMemsetAsync((char*)d_ws + WS_CTL, 0, CTL_ZERO_BYTES, stream) != hipSuccess) { fprintf(stderr, "kernel_launch: hipMemsetAsync failed\n"); return; }
    Args a{};
    for (int i = 0; i < 11; ++i) a.in[i] = (const float*)d_in[i];
    a.out = (float*)d_out; a.ws = (unsigned char*)d_ws;
    for (int li = 0; li < N_LAUNCHES; ++li) {
        a.ph_lo = (N_LAUNCHES == PER_PHASE) ? li : 0; a.ph_hi = (N_LAUNCHES == PER_PHASE) ? li + 1 : PER_PHASE; a.li = li;
        hipLaunchKernelGGL(mk_fwd, dim3(grid), dim3(NWAVES * 64), LDS_BYTES, stream, a);
        const hipError_t le = hipPeekAtLastError();
        if (le != hipSuccess) { fprintf(stderr, "kernel_launch: launch %d failed: %s\n", li, hipGetErrorName(le)); break; }
    }
}
```

```cpp
#include <hip/hip_runtime.h>
#include <cstdio>
#include <cstdint>
namespace pg8 {
#define PG8_LAS __attribute__((address_space(3)))
typedef unsigned short bf16_t;
typedef short bf16x8 __attribute__((ext_vector_type(8)));
typedef float f32x4 __attribute__((ext_vector_type(4)));
typedef unsigned u32x4 __attribute__((ext_vector_type(4)));
typedef int i32x4 __attribute__((ext_vector_type(4)));
typedef int i32x8 __attribute__((ext_vector_type(8)));
typedef unsigned u32x2 __attribute__((ext_vector_type(2)));
constexpr int BM = 256, BK = 64, HALF = 128, HTB = HALF * BK * 2  , STAGE_BYTES = 8 * HTB, NXCD = 8, WGM = 8;

__host__ __device__ __forceinline__ int lds_byte(int r, int c) { const int st = (r >> 4) * 2 + (c >> 5), rr = r & 15, cc = c & 31, ob = rr * 64 + cc * 2; return st * 1024 + (ob ^ (((ob >> 9) & 1) << 5)); }
__host__ __device__ __forceinline__ void stage_rc(int b, int& R, int& C) { const int st = b / 1024, sb = b % 1024, swz = sb ^ (((sb >> 9) & 1) << 5); R = (st >> 1) * 16 + swz / 64; C = (st & 1) * 32 + (swz % 64) / 2; }
__host__ __device__ __forceinline__ int perm32(int rho) { const int n = rho >> 4, i = rho & 15; return 8 * (i >> 2) + 4 * n + (i & 3); }

struct Unit { int pm, pn; };
struct Gemm { const bf16_t* A; const bf16_t* Bt; int M, N, K; };

struct StaticOrder {
    int nM, nN, nwg, G, c, reps;
    __host__ __device__ void init(int M, int N, int G_, int c_, int reps_ = 1) { nM = M / BM; nN = N / BM; nwg = nM * nN; G = G_; c = c_; reps = reps_; }
    __host__ __device__ bool next(int i, Unit& u) const {
        const int rounds = (nwg + G - 1) / G; if (i >= reps * rounds) return false;
        const long L = (long)(i % rounds) * G + c; if (L >= nwg) return false;
        int wgid = (int)L; { const int q = nwg / NXCD, r = nwg % NXCD, xcd = wgid % NXCD, off = wgid / NXCD; wgid = (xcd < r ? xcd * (q + 1) : r * (q + 1) + (xcd - r) * q) + off; }
        const int nig = WGM * nN, gid = wgid / nig, fm = gid * WGM, gsz = (nM - fm) < WGM ? (nM - fm) : WGM;
        u.pm = fm + ((wgid % nig) % gsz); u.pn = (wgid % nig) / gsz; return true;
    }
    __device__ __forceinline__ void a_ready(const Unit&) const {}
    __device__ __forceinline__ void done(const Unit&) const {}
};


__device__ __forceinline__ unsigned cvt_pk_bf16(float lo, float hi) { unsigned r; asm volatile("v_cvt_pk_bf16_f32 %0, %1, %2" : "=v"(r) : "v"(lo), "v"(hi)); return r; }
__device__ __forceinline__ u32x4 pack8(const f32x4 a, const f32x4 b) { u32x4 w; w.x = cvt_pk_bf16(a[0], a[1]); w.y = cvt_pk_bf16(a[2], a[3]); w.z = cvt_pk_bf16(b[0], b[1]); w.w = cvt_pk_bf16(b[2], b[3]); return w; }
__device__ __forceinline__ float sum4(const f32x4 a) { return (a[0] + a[1]) + (a[2] + a[3]); }
__device__ __forceinline__ float sq4(const f32x4 a) { return (a[0] * a[0] + a[1] * a[1]) + (a[2] * a[2] + a[3] * a[3]); }
constexpr float RMS_EPS_F = 1e-6f;
__device__ __forceinline__ int lane_id() { int l; asm volatile("v_mbcnt_lo_u32_b32 %0, -1, 0\n\tv_mbcnt_hi_u32_b32 %0, -1, %0" : "=v"(l)); return l; }
__device__ __forceinline__ u32x2 pack8_fp8(const f32x4 a, const f32x4 b) { u32x2 w; unsigned t = 0;
    t = __builtin_amdgcn_cvt_pk_fp8_f32(a[0], a[1], t, false); t = __builtin_amdgcn_cvt_pk_fp8_f32(a[2], a[3], t, true); w.x = t; t = 0;
    t = __builtin_amdgcn_cvt_pk_fp8_f32(b[0], b[1], t, false); t = __builtin_amdgcn_cvt_pk_fp8_f32(b[2], b[3], t, true); w.y = t; return w; }
constexpr float F8_SA = 16.f, F8_SH = 8.f, F8_SW = 512.f, F8_SO = 64.f;
typedef float f32x2 __attribute__((ext_vector_type(2)));

struct EpiQKV {
    static constexpr bool PERM = true, AFTER_DRAIN = false, HAS_MID = false;
    bf16_t* Q; size_t part_stride; const float* rope; float* kpart; float qscale; int mapsel; float ascale;
    __device__ __forceinline__ void operator()(const f32x4 (&acc)[2][2][4][2], const Unit& u, int wr, int wc, int fr_, int fq_) const {
        const int ln_ = lane_id(), fr = ln_ & 15, fq = ln_ >> 4;
        const int rp = mapsel == 1 ? ((u.pn & 1) + 4 * (u.pn >> 1)) : (mapsel == 2 ? (u.pn < 4 ? (2 + (u.pn & 1) + 4 * (u.pn >> 1)) : u.pn + 4) : u.pn);
        const int part = rp >> 2, head = (rp & 3) * 4 + wc;
        bf16_t* base = Q + (size_t)part * part_stride + head * 64 + 8 * fq;
        const float sc = part == 0 ? qscale : 1.f;
        const bool rot = part != 2, km = (part == 1) && (head < 8);
        const int row0 = u.pm * BM + wr * 64 + fr;
        int rbase = row0; asm volatile("" : "+v"(rbase));
        f32x4 ks[2][2];
#pragma unroll
        for (int a = 0; a < 2; ++a)
#pragma unroll
            for (int b = 0; b < 2; ++b) ks[a][b] = (f32x4){0.f, 0.f, 0.f, 0.f};
#pragma unroll
        for (int ai = 0; ai < 2; ++ai)
#pragma unroll
            for (int m = 0; m < 4; ++m) {
                const int row = rbase + ai * HALF + m * 16;
                const int s = row & 4095;
                const f32x4* rp = (const f32x4*)(rope + ((size_t)s * 32 + 8 * fq) * 2);
                f32x4 t0 = rp[0], t1 = rp[1], t2 = rp[2], t3 = rp[3];
                if (!rot) { t0 = t1 = t2 = t3 = (f32x4){1.f, 0.f, 1.f, 0.f}; }
                f32x4 o1[2], o2[2];
#pragma unroll
                for (int n = 0; n < 2; ++n) {
                    const f32x4 cv = n == 0 ? (f32x4){t0[0], t0[2], t1[0], t1[2]} : (f32x4){t2[0], t2[2], t3[0], t3[2]};
                    const f32x4 sv = n == 0 ? (f32x4){t0[1], t0[3], t1[1], t1[3]} : (f32x4){t2[1], t2[3], t3[1], t3[3]};
                    const f32x4 x1 = acc[ai][0][m][n] * ascale, x2 = acc[ai][1][m][n] * ascale;
                    o1[n] = x1 * cv - x2 * sv; o2[n] = x2 * cv + x1 * sv;
                    ks[0][n] += o1[n]; ks[1][n] += o2[n];
                    o1[n] = o1[n] * sc; o2[n] = o2[n] * sc;
                }
                bf16_t* rowp = base + (size_t)row * 1024;
                *(u32x4*)(rowp) = pack8(o1[0], o1[1]); *(u32x4*)(rowp + 32) = pack8(o2[0], o2[1]);
            }
        if (km) {
#pragma unroll
            for (int bj = 0; bj < 2; ++bj)
#pragma unroll
                for (int n = 0; n < 2; ++n) { f32x4 v = ks[bj][n];
#pragma unroll
                    for (int o = 1; o < 16; o <<= 1) { v[0] += __shfl_xor(v[0], o); v[1] += __shfl_xor(v[1], o); v[2] += __shfl_xor(v[2], o); v[3] += __shfl_xor(v[3], o); }
                    if (fr == 0) *(f32x4*)(kpart + (size_t)(u.pm * 2 + wr) * 512 + head * 64 + 32 * bj + 8 * fq + 4 * n) = v; }
        }
    }
};

struct EpiWo {
    static constexpr bool PERM = true, AFTER_DRAIN = false, HAS_MID = true;
    const float* rn0; const float* gain0; bf16_t* xn; unsigned char* xn8; const float* ssq_att; float* ssq1;
    __device__ __forceinline__ void rstds(int row, float& rm, float& rd) const {
        const f32x4* p = (const f32x4*)(ssq_att + (size_t)row * 16);
        const f32x4 a = p[0], b = p[1], c = p[2], d = p[3];
        rm = __builtin_amdgcn_rsqf((sum4(a) + sum4(b)) * (1.f / 512.f) + RMS_EPS_F);
        rd = __builtin_amdgcn_rsqf((sum4(c) + sum4(d)) * (1.f / 512.f) + RMS_EPS_F);
    }
    static constexpr float ASCALE = 1.f / (F8_SO * F8_SW);
    __device__ __forceinline__ void mid(f32x4 (&acc)[2][2][4][2], const Unit& u, int wr, int fr_) const {
        const int fr = lane_id() & 15;
        const int row0 = u.pm * BM + wr * 64 + fr;
        int rbase = row0; asm volatile("" : "+v"(rbase));
#pragma unroll
        for (int ai = 0; ai < 2; ++ai)
#pragma unroll
            for (int m = 0; m < 4; ++m) { const int row = rbase + ai * HALF + m * 16; float rm, rd; rstds(row, rm, rd); const float f = rm / rd;
#pragma unroll
                for (int bj = 0; bj < 2; ++bj)
#pragma unroll
                    for (int n = 0; n < 2; ++n) acc[ai][bj][m][n] = acc[ai][bj][m][n] * f;
                asm volatile("" ::: "memory"); }
    }
    __device__ __forceinline__ void operator()(const f32x4 (&acc)[2][2][4][2], const Unit& u, int wr, int wc, int fr_, int fq_) const {
        const int ln_ = lane_id(), fr = ln_ & 15, fq = ln_ >> 4;
        const int row0 = u.pm * BM + wr * 64 + fr, col0 = u.pn * BM + wc * 32 + 8 * fq;
        int rbase = row0; asm volatile("" : "+v"(rbase));
        f32x4 ig[2][2];
#pragma unroll
        for (int bj = 0; bj < 2; ++bj)
#pragma unroll
            for (int n = 0; n < 2; ++n) { const f32x4 g = *(const f32x4*)(gain0 + col0 + bj * HALF + 4 * n);
                ig[bj][n] = (f32x4){__builtin_amdgcn_rcpf(g[0]), __builtin_amdgcn_rcpf(g[1]), __builtin_amdgcn_rcpf(g[2]), __builtin_amdgcn_rcpf(g[3])}; }
#pragma unroll
        for (int ai = 0; ai < 2; ++ai)
#pragma unroll
            for (int m = 0; m < 4; ++m) { const int row = rbase + ai * HALF + m * 16; float rm, rd; rstds(row, rm, rd); float s = 0.f; const float rn = rn0[row];
#pragma unroll
                for (int bj = 0; bj < 2; ++bj) { unsigned off = (unsigned)row * 1024u + col0 + bj * HALF; asm volatile("" : "+v"(off));
                    const u32x4 xw = *(const u32x4*)(xn + off);
                    const f32x4 xa = (f32x4){__uint_as_float(xw.x << 16), __uint_as_float(xw.x & 0xffff0000u), __uint_as_float(xw.y << 16), __uint_as_float(xw.y & 0xffff0000u)} * ig[bj][0] * rn;
                    const f32x4 xb = (f32x4){__uint_as_float(xw.z << 16), __uint_as_float(xw.z & 0xffff0000u), __uint_as_float(xw.w << 16), __uint_as_float(xw.w & 0xffff0000u)} * ig[bj][1] * rn;
                    const f32x4 v0 = xa + acc[ai][bj][m][0] * (rd * ASCALE), v1 = xb + acc[ai][bj][m][1] * (rd * ASCALE);
                    *(u32x4*)(xn + off) = pack8(v0, v1); *(u32x2*)(xn8 + off) = pack8_fp8(v0 * F8_SA, v1 * F8_SA); s += sq4(v0) + sq4(v1); }
                s += __shfl_xor(s, 16); s += __shfl_xor(s, 32);
                if (fq == 0) ssq1[(size_t)row * 16 + u.pn * 4 + wc] = s;
                asm volatile("" ::: "memory"); }
    }
};

struct EpiGU {
    static constexpr bool PERM = true, AFTER_DRAIN = false, HAS_MID = false;
    const float* ssq1; unsigned char* H;
    __device__ __forceinline__ void operator()(const f32x4 (&acc)[2][2][4][2], const Unit& u, int wr, int wc, int fr_, int fq_) const {
        const int ln_ = lane_id(), fr = ln_ & 15, fq = ln_ >> 4;
        const int row0 = u.pm * BM + wr * 64 + fr, col0 = u.pn * HALF + wc * 32 + 8 * fq;
        int rbase = row0; asm volatile("" : "+v"(rbase));
#pragma unroll
        for (int ai = 0; ai < 2; ++ai)
#pragma unroll
            for (int m = 0; m < 4; ++m) { const int row = rbase + ai * HALF + m * 16;
                const f32x4* p = (const f32x4*)(ssq1 + (size_t)row * 16);
                const f32x4 a = p[0], b = p[1], c = p[2], d = p[3];
                const float rstd = __builtin_amdgcn_rsqf(((sum4(a) + sum4(b)) + (sum4(c) + sum4(d))) * (1.f / 1024.f) + RMS_EPS_F) * (1.f / (F8_SA * F8_SW));
                f32x4 h[2];
#pragma unroll
                for (int n = 0; n < 2; ++n) { const f32x4 g = acc[ai][0][m][n] * rstd, uu = acc[ai][1][m][n] * rstd;
#pragma unroll
                    for (int i = 0; i < 4; ++i) h[n][i] = g[i] * __builtin_amdgcn_rcpf(1.f + __builtin_amdgcn_exp2f(g[i] * -1.4426950408889634f)) * (uu[i] * F8_SH); }
                *(u32x2*)(H + (size_t)row * 2816 + col0) = pack8_fp8(h[0], h[1]); }
    }
};

struct EpiDown {
    static constexpr bool PERM = true, AFTER_DRAIN = false, HAS_MID = false;
    const bf16_t* xn; float* out; float* ssq2;
    __device__ __forceinline__ void operator()(const f32x4 (&acc)[2][2][4][2], const Unit& u, int wr, int wc, int fr_, int fq_) const {
        const int ln_ = lane_id(), fr = ln_ & 15, fq = ln_ >> 4;
        const int row0 = u.pm * BM + wr * 64 + fr, col0 = u.pn * BM + wc * 32 + 8 * fq;
        int rbase = row0; asm volatile("" : "+v"(rbase));
#pragma unroll
        for (int ai = 0; ai < 2; ++ai)
#pragma unroll
            for (int m = 0; m < 4; ++m) { const int row = rbase + ai * HALF + m * 16; float s = 0.f;
#pragma unroll
                for (int bj = 0; bj < 2; ++bj) { const size_t off = (size_t)row * 1024 + col0 + bj * HALF;
                    const u32x4 xw = *(const u32x4*)(xn + off);
                    const f32x4 xa = {__uint_as_float(xw.x << 16), __uint_as_float(xw.x & 0xffff0000u), __uint_as_float(xw.y << 16), __uint_as_float(xw.y & 0xffff0000u)};
                    const f32x4 xb = {__uint_as_float(xw.z << 16), __uint_as_float(xw.z & 0xffff0000u), __uint_as_float(xw.w << 16), __uint_as_float(xw.w & 0xffff0000u)};
                    const f32x4 v0 = xa + acc[ai][bj][m][0] * (1.f / (F8_SH * F8_SW)), v1 = xb + acc[ai][bj][m][1] * (1.f / (F8_SH * F8_SW));
                    *(f32x4*)(out + off) = v0; *(f32x4*)(out + off + 4) = v1; s += sq4(v0) + sq4(v1); }
                s += __shfl_xor(s, 16); s += __shfl_xor(s, 32);
                if (fq == 0) ssq2[(size_t)row * 16 + u.pn * 4 + wc] = s;
                asm volatile("" ::: "memory"); }
    }
};

struct EpiDownNorm {
    static constexpr bool PERM = true, AFTER_DRAIN = false, HAS_MID = false;
    const bf16_t* xn; float* out; float* ssq2; unsigned* cnt; const float* gain;
    __device__ __forceinline__ void operator()(f32x4 (&acc)[2][2][4][2], const Unit& u, int wr, int wc, int fr_, int fq_) const {
        const int ln_ = lane_id(), fr = ln_ & 15, fq = ln_ >> 4;
        const int row0 = u.pm * BM + wr * 64 + fr, col0 = u.pn * BM + wc * 32 + 8 * fq;
        int rbase = row0; asm volatile("" : "+v"(rbase));
#pragma unroll
        for (int ai = 0; ai < 2; ++ai)
#pragma unroll
            for (int m = 0; m < 4; ++m) { const int row = rbase + ai * HALF + m * 16; float s = 0.f;
#pragma unroll
                for (int bj = 0; bj < 2; ++bj) { const size_t off = (size_t)row * 1024 + col0 + bj * HALF;
                    const u32x4 xw = *(const u32x4*)(xn + off);
                    const f32x4 xa = {__uint_as_float(xw.x << 16), __uint_as_float(xw.x & 0xffff0000u), __uint_as_float(xw.y << 16), __uint_as_float(xw.y & 0xffff0000u)};
                    const f32x4 xb = {__uint_as_float(xw.z << 16), __uint_as_float(xw.z & 0xffff0000u), __uint_as_float(xw.w << 16), __uint_as_float(xw.w & 0xffff0000u)};
                    acc[ai][bj][m][0] = acc[ai][bj][m][0] * (1.f / (F8_SH * F8_SW)) + xa; acc[ai][bj][m][1] = acc[ai][bj][m][1] * (1.f / (F8_SH * F8_SW)) + xb; s += sq4(acc[ai][bj][m][0]) + sq4(acc[ai][bj][m][1]); }
                s += __shfl_xor(s, 16); s += __shfl_xor(s, 32);
                if (fq == 0) __hip_atomic_store(ssq2 + (size_t)row * 16 + u.pn * 4 + wc, s, __ATOMIC_RELAXED, __HIP_MEMORY_SCOPE_AGENT);
                asm volatile("" ::: "memory"); }
        asm volatile("s_waitcnt vmcnt(0)" ::: "memory");
        unsigned* cw = cnt + 64 * u.pm;
        if (fr == 0 && fq == 0) __hip_atomic_fetch_add(cw, 1u, __ATOMIC_RELAXED, __HIP_MEMORY_SCOPE_AGENT);
        { unsigned sp = 0; while ((unsigned)__builtin_amdgcn_readfirstlane((int)__hip_atomic_load(cw, __ATOMIC_RELAXED, __HIP_MEMORY_SCOPE_AGENT)) < 32u) { __builtin_amdgcn_s_sleep(1); if (++sp > (1u << 22)) break; } }
        f32x4 g[2][2];
#pragma unroll
        for (int bj = 0; bj < 2; ++bj) { g[bj][0] = *(const f32x4*)(gain + col0 + bj * HALF); g[bj][1] = *(const f32x4*)(gain + col0 + bj * HALF + 4); }
#pragma unroll
        for (int ai = 0; ai < 2; ++ai)
#pragma unroll
            for (int m = 0; m < 4; ++m) { const int row = rbase + ai * HALF + m * 16;
                const unsigned long long* pp = (const unsigned long long*)(ssq2 + (size_t)row * 16 + 4 * fq);
                const unsigned long long w0 = __hip_atomic_load(pp, __ATOMIC_RELAXED, __HIP_MEMORY_SCOPE_AGENT), w1 = __hip_atomic_load(pp + 1, __ATOMIC_RELAXED, __HIP_MEMORY_SCOPE_AGENT);
                float s = (__uint_as_float((unsigned)w0) + __uint_as_float((unsigned)(w0 >> 32))) + (__uint_as_float((unsigned)w1) + __uint_as_float((unsigned)(w1 >> 32)));
                s += __shfl_xor(s, 16); s += __shfl_xor(s, 32);
                const float rstd = __builtin_amdgcn_rsqf(s * (1.f / 1024.f) + RMS_EPS_F);
#pragma unroll
                for (int bj = 0; bj < 2; ++bj) { const size_t off = (size_t)row * 1024 + col0 + bj * HALF;
                    *(f32x4*)(out + off) = acc[ai][bj][m][0] * rstd * g[bj][0]; *(f32x4*)(out + off + 4) = acc[ai][bj][m][1] * rstd * g[bj][1]; }
                asm volatile("" ::: "memory"); }
    }
};
template <class Epi, class Sched, bool ALIGN_EPI = false, bool SP2 = false, bool F8 = false>
__device__ __forceinline__ void gemm_phase(PG8_LAS unsigned char* lds, const Gemm g, const Sched& S, const Epi& E, int wave) {
    const int wid = __builtin_amdgcn_readfirstlane(wave), lane = lane_id(), tid = wid * 64 + lane, wr = wid >> 2, wc = wid & 3, fr = lane & 15, fq = lane >> 4;
    const int K = F8 ? g.K / 2 : g.K, nt = K / BK;
    unsigned voffA[2], voffB[2];
#pragma unroll
    for (int i = 0; i < 2; ++i) { int R, C; stage_rc(tid * 16 + i * 8192, R, C); const int Rb = Epi::PERM ? ((R & ~31) + perm32(R & 31)) : R;
        voffA[i] = (unsigned)(R * K + C) * 2u; voffB[i] = (unsigned)(Rb * K + C) * 2u; }
    const unsigned kstep = (unsigned)(BK * 2);
    const unsigned hstep = (unsigned)HALF * K * 2;
    const unsigned tstep = 2 * hstep;
    const unsigned ldsw = (unsigned)wid * 1024u;
    const int aoff = lds_byte(wr * 64 + fr, fq * 8), boff = lds_byte(wc * 32 + fr, fq * 8);
#define PG8_SA(b, h) (((b) * 2 + (h)) * HTB)
#define PG8_SB(b, h) ((4 + (b) * 2 + (h)) * HTB)
    const __amdgpu_buffer_rsrc_t rsA = __builtin_amdgcn_make_buffer_rsrc((void*)g.A, 0, 0x7fffffff, 0x00020000), rsB = __builtin_amdgcn_make_buffer_rsrc((void*)g.Bt, 0, 0x7fffffff, 0x00020000);
#define PG8_STAGE(bufoff, gbase, voff) do { _Pragma("unroll") for (int _i = 0; _i < 2; ++_i) \
        __builtin_amdgcn_raw_ptr_buffer_load_lds(PG8_RS_##voff, (PG8_LAS unsigned*)(lds + (bufoff) + ldsw + _i * 8192), 16, (voff)[_i], (int)(gbase), 0, 0); } while (0)
#define PG8_RS_voffA rsA
#define PG8_RS_voffB rsB
#define PG8_LD8(base, off) __builtin_shufflevector(*(const PG8_LAS i32x4*)((base) + (off)), *(const PG8_LAS i32x4*)((base) + (off) + 1024), 0, 1, 2, 3, 4, 5, 6, 7)
#define PG8_LDA(dst, b, h) do { if constexpr (F8) { _Pragma("unroll") for (int m = 0; m < 4; ++m) dst##8[m] = PG8_LD8(abase8, PG8_SA(b, h) + m * 2048); } else { \
        _Pragma("unroll") for (int m = 0; m < 4; ++m) _Pragma("unroll") for (int k = 0; k < 2; ++k) dst[m][k] = *(const PG8_LAS bf16x8*)(lds + PG8_SA(b, h) + aoff + m * 2048 + k * 1024); } } while (0)
#define PG8_LDB(dst, b, h) do { if constexpr (F8) { _Pragma("unroll") for (int n = 0; n < 2; ++n) dst##8[n] = PG8_LD8(bbase8, PG8_SB(b, h) - PG8_SB(0, 0) + n * 2048); } else { \
        _Pragma("unroll") for (int n = 0; n < 2; ++n) _Pragma("unroll") for (int k = 0; k < 2; ++k) dst[n][k] = *(const PG8_LAS bf16x8*)(lds + PG8_SB(b, h) + boff + n * 2048 + k * 1024); } } while (0)
#define PG8_MMA(ai, bj, At, Bt) do { __builtin_amdgcn_s_setprio(1); if constexpr (F8) { _Pragma("unroll") for (int m = 0; m < 4; ++m) _Pragma("unroll") for (int n = 0; n < 2; ++n) \
        acc[ai][bj][m][n] = __builtin_amdgcn_mfma_scale_f32_16x16x128_f8f6f4(Bt##8[n], At##8[m], acc[ai][bj][m][n], 0, 0, 0, 0, 0, 0); } else \
        _Pragma("unroll") for (int m = 0; m < 4; ++m) _Pragma("unroll") for (int n = 0; n < 2; ++n) _Pragma("unroll") for (int k = 0; k < 2; ++k) \
        acc[ai][bj][m][n] = __builtin_amdgcn_mfma_f32_16x16x32_bf16(Bt[n][k], At[m][k], acc[ai][bj][m][n], 0, 0, 0); __builtin_amdgcn_s_setprio(0); } while (0)
#define PG8_WAIT_V(n) asm volatile("s_waitcnt vmcnt(" #n ")" ::: "memory")
#define PG8_WAIT_L(n) asm volatile("s_waitcnt lgkmcnt(" #n ")" ::: "memory")
#define PG8_BAR __builtin_amdgcn_s_barrier()
#define PG8_SCHED __builtin_amdgcn_sched_barrier(0)
    Unit cur, nxt; int ui = 0;
    if (!S.next(0, cur)) return;
    f32x4 acc[2][2][4][2];
#pragma unroll
    for (int a = 0; a < 2; ++a)
#pragma unroll
        for (int b = 0; b < 2; ++b)
#pragma unroll
            for (int m = 0; m < 4; ++m)
#pragma unroll
                for (int n = 0; n < 2; ++n) acc[a][b][m][n] = (f32x4){0.f, 0.f, 0.f, 0.f};
    PG8_LAS unsigned char* abase8 = lds + aoff; PG8_LAS unsigned char* bbase8 = lds + PG8_SB(0, 0) + boff;
    if constexpr (F8) { asm volatile("" : "+v"(abase8)); asm volatile("" : "+v"(bbase8)); }
    bf16x8 At[4][2], B0[2][2], B1[2][2]; i32x8 At8[4], B08[2], B18[2];
    unsigned cA = (unsigned)cur.pm * tstep, cB = (unsigned)cur.pn * tstep;
    S.a_ready(cur);
    if constexpr (SP2) {
        PG8_STAGE(PG8_SB(0, 0), cB, voffB); PG8_STAGE(PG8_SB(0, 1), cB + hstep, voffB); PG8_STAGE(PG8_SA(0, 0), cA, voffA); PG8_STAGE(PG8_SA(0, 1), cA + hstep, voffA);
        if (wr == 1) PG8_BAR;
        PG8_WAIT_V(2); PG8_BAR;
        PG8_STAGE(PG8_SB(1, 0), cB + kstep, voffB); PG8_STAGE(PG8_SA(1, 0), cA + kstep, voffA); PG8_STAGE(PG8_SB(1, 1), cB + hstep + kstep, voffB);
        PG8_WAIT_V(6); PG8_BAR;
    } else {
        PG8_STAGE(PG8_SB(0, 0), cB, voffB); PG8_STAGE(PG8_SA(0, 0), cA, voffA); PG8_STAGE(PG8_SB(0, 1), cB + hstep, voffB); PG8_STAGE(PG8_SA(0, 1), cA + hstep, voffA);
        if (wr == 1) PG8_BAR;
        PG8_WAIT_V(4); PG8_BAR;
        PG8_STAGE(PG8_SB(1, 0), cB + kstep, voffB); PG8_STAGE(PG8_SA(1, 0), cA + kstep, voffA); PG8_STAGE(PG8_SB(1, 1), cB + hstep + kstep, voffB);
        PG8_WAIT_V(6); PG8_BAR;
    }
    for (;;) {
        const bool has_next = S.next(ui + 1, nxt);
        const unsigned nA = has_next ? (unsigned)nxt.pm * tstep : cA, nB = has_next ? (unsigned)nxt.pn * tstep : cB;
#pragma nounroll
        for (int t = 0; t < nt; t += 2) {
            if constexpr (Epi::HAS_MID) { if (t == (nt >> 1)) E.mid(acc, cur, wr, fr); }
            const bool last = (t == nt - 2);
            const unsigned a1 = cA + (unsigned)(t + 1) * kstep;
            const unsigned a2 = last ? nA : cA + (unsigned)(t + 2) * kstep, b2 = last ? nB : cB + (unsigned)(t + 2) * kstep;
            const unsigned a3 = a2 + kstep, b3 = b2 + kstep;
            if (last && has_next) S.a_ready(nxt);
            if constexpr (SP2) {
            PG8_LDB(B0, 0, 0); PG8_LDB(B1, 0, 1); PG8_SCHED; PG8_LDA(At, 0, 0); PG8_STAGE(PG8_SA(1, 1), a1 + hstep, voffA);
            PG8_WAIT_V(8); PG8_WAIT_L(0); PG8_BAR; PG8_MMA(0, 0, At, B0); PG8_MMA(0, 1, At, B1); PG8_BAR; PG8_SCHED;
            PG8_LDA(At, 0, 1); PG8_STAGE(PG8_SB(0, 0), b2, voffB); PG8_STAGE(PG8_SB(0, 1), b2 + hstep, voffB); PG8_STAGE(PG8_SA(0, 0), a2, voffA);
            PG8_WAIT_V(8); PG8_WAIT_L(0); PG8_BAR; PG8_MMA(1, 0, At, B0); PG8_MMA(1, 1, At, B1); PG8_BAR; PG8_SCHED;
            PG8_LDB(B0, 1, 0); PG8_LDB(B1, 1, 1); PG8_SCHED; PG8_LDA(At, 1, 0); PG8_STAGE(PG8_SA(0, 1), a2 + hstep, voffA);
            PG8_WAIT_V(8); PG8_WAIT_L(0); PG8_BAR; PG8_MMA(0, 0, At, B0); PG8_MMA(0, 1, At, B1); PG8_BAR; PG8_SCHED;
            PG8_LDA(At, 1, 1); PG8_STAGE(PG8_SB(1, 0), b3, voffB); PG8_STAGE(PG8_SB(1, 1), b3 + hstep, voffB); PG8_STAGE(PG8_SA(1, 0), a3, voffA);
            PG8_WAIT_V(8); PG8_WAIT_L(0); PG8_BAR; PG8_MMA(1, 0, At, B0); PG8_MMA(1, 1, At, B1); PG8_BAR; PG8_SCHED;
            } else {
            PG8_LDB(B0, 0, 0); PG8_SCHED; PG8_LDA(At, 0, 0); PG8_STAGE(PG8_SA(1, 1), a1 + hstep, voffA);
            PG8_WAIT_L(8); PG8_BAR; PG8_WAIT_L(0); PG8_MMA(0, 0, At, B0); PG8_BAR; PG8_SCHED;
            PG8_LDB(B1, 0, 1); PG8_STAGE(PG8_SB(0, 0), b2, voffB);
            PG8_BAR; PG8_WAIT_L(0); PG8_MMA(0, 1, At, B1); PG8_BAR;
            PG8_LDA(At, 0, 1); PG8_STAGE(PG8_SA(0, 0), a2, voffA);
            PG8_BAR; PG8_WAIT_L(0); PG8_MMA(1, 0, At, B0); PG8_BAR; PG8_SCHED;
            PG8_STAGE(PG8_SB(0, 1), b2 + hstep, voffB);
            PG8_WAIT_V(6); PG8_BAR; PG8_MMA(1, 1, At, B1); PG8_BAR;
            PG8_LDB(B0, 1, 0); PG8_SCHED; PG8_LDA(At, 1, 0); PG8_STAGE(PG8_SA(0, 1), a2 + hstep, voffA);
            PG8_WAIT_L(8); PG8_BAR; PG8_WAIT_L(0); PG8_MMA(0, 0, At, B0); PG8_BAR; PG8_SCHED;
            PG8_LDB(B1, 1, 1); PG8_STAGE(PG8_SB(1, 0), b3, voffB);
            PG8_BAR; PG8_WAIT_L(0); PG8_MMA(0, 1, At, B1); PG8_BAR;
            PG8_LDA(At, 1, 1); PG8_STAGE(PG8_SA(1, 0), a3, voffA);
            PG8_BAR; PG8_WAIT_L(0); PG8_MMA(1, 0, At, B0); PG8_BAR; PG8_SCHED;
            PG8_STAGE(PG8_SB(1, 1), b3 + hstep, voffB);
            PG8_WAIT_V(6); PG8_BAR; PG8_MMA(1, 1, At, B1); PG8_BAR;
            }
        }
        if constexpr (ALIGN_EPI) { if (wr == 0) PG8_BAR; }
        if constexpr (!Epi::AFTER_DRAIN) { E(acc, cur, wr, wc, fr, fq); S.done(cur); }
        if (!has_next) break;
#pragma unroll
        for (int a = 0; a < 2; ++a)
#pragma unroll
            for (int b = 0; b < 2; ++b)
#pragma unroll
                for (int m = 0; m < 4; ++m)
#pragma unroll
                    for (int n = 0; n < 2; ++n) acc[a][b][m][n] = (f32x4){0.f, 0.f, 0.f, 0.f};
        cur = nxt; cA = nA; cB = nB; ++ui;
        if constexpr (ALIGN_EPI) { if (wr == 1) PG8_BAR; }
    }
    PG8_WAIT_V(0);
    if constexpr (!ALIGN_EPI) { if (wr == 0) PG8_BAR; }
    PG8_BAR;
    if constexpr (Epi::AFTER_DRAIN) { E.fused(acc, cur, wr, wc, fr, fq, lds, wid, lane); S.done(cur); }
#undef PG8_SA
#undef PG8_SB
#undef PG8_STAGE
#undef PG8_RS_voffA
#undef PG8_RS_voffB
#undef PG8_LDA
#undef PG8_LDB
#undef PG8_MMA
#undef PG8_WAIT_V
#undef PG8_WAIT_L
#undef PG8_BAR
#undef PG8_SCHED
}
}

constexpr int NWAVES = 8;
#ifndef MK_N_LAUNCHES
#define MK_N_LAUNCHES 1
#endif
constexpr int PER_PHASE = 7;
constexpr int N_LAUNCHES = MK_N_LAUNCHES;

constexpr int BATCH = 8, SEQ = 4096, D = 1024, NH = 16, HD = 64, FF = 2816, NHM = 8;
constexpr int M = BATCH * SEQ;
constexpr int NQKV = 3 * D, NGU = 2 * FF;
constexpr float RMS_EPS = 1e-6f;
constexpr float QSCALE = 0.125f * 1.4426950408889634f;

constexpr size_t MiB = 1u << 20;
constexpr size_t WS_CTL = 0, CTL_ZERO_BYTES = 64 * 1024;
constexpr size_t WS_ROPE = 1 * MiB;
constexpr size_t WS_WQKV = 2 * MiB, WS_WO = 8 * MiB, WS_WGU = 10 * MiB, WS_WD = 21 * MiB;
constexpr size_t WS_KPART = 27 * MiB;
constexpr size_t WS_SSQA = 28 * MiB, WS_SSQ1 = 30 * MiB, WS_SSQ2 = 32 * MiB;
constexpr size_t WS_XN = 40 * MiB;
constexpr size_t WS_QO = 104 * MiB, WS_K = 168 * MiB, WS_V = 232 * MiB;
constexpr size_t WS_H = 104 * MiB;
#ifndef MK_REPEAT_PHASE
#define MK_REPEAT_PHASE -1
#endif
constexpr size_t WS_O = WS_QO;
constexpr size_t WS_FARO = 296 * MiB, WS_FARL = 328 * MiB;
constexpr size_t WS_XN8 = 330 * MiB;
constexpr size_t WS_O8 = 362 * MiB;
constexpr size_t WS_END = 394 * MiB;
constexpr size_t QKV8_OFF = 2 * MiB;
constexpr int CW_TMO = 0, CW_CODE = 1;
constexpr int CW_BAR = 4096;
constexpr int CW_PANEL = 8192;
constexpr int CW_FAR = 2048;

constexpr int RING_OFF = 0, RING_BYTES = 131072;
constexpr int LDSCTL_OFF = RING_BYTES, MISC_OFF = LDSCTL_OFF + 320;
constexpr int LDS_BYTES = 147456;
static_assert(WS_V - WS_K == WS_K - WS_QO, "Q | K | V equally spaced");
#define GAS __attribute__((address_space(1)))
#define LAS __attribute__((address_space(3)))
typedef unsigned short bf16;
typedef unsigned v4u __attribute__((ext_vector_type(4)));
typedef float f32x4 __attribute__((ext_vector_type(4)));
typedef short bf16x8 __attribute__((ext_vector_type(8)));
typedef GAS unsigned gu32;
typedef GAS unsigned long long gu64;
#define RLX_AGENT __ATOMIC_RELAXED, __HIP_MEMORY_SCOPE_AGENT
#define LDS_WAIT() asm volatile("s_waitcnt lgkmcnt(0)" ::: "memory")
#define VM_WAIT() asm volatile("s_waitcnt vmcnt(0)" ::: "memory")
__device__ __forceinline__ unsigned long long rt() { return __builtin_amdgcn_s_memrealtime(); }
__device__ __forceinline__ unsigned f2bf(float f) { unsigned u = __builtin_bit_cast(unsigned, f); return (u + 0x7fffu + ((u >> 16) & 1u)) >> 16; }
__device__ __forceinline__ unsigned pk2(float lo, float hi) { return f2bf(lo) | (f2bf(hi) << 16); }

#define XB_TMO      128
#define XB_XCNT(j)  (256  + 64 * (j))
#define XB_XSUB(j)  (1280 + 64 * (j))
#define XB_XGEN(j)  (2304 + 64 * (j))
#define XB_TOP      3328
#define XB_TOPGEN   3392
#define XCD_BAR_WORDS 3456
#define XB_SPIN_CAP (1u << 18)

__device__ __forceinline__ unsigned xb_ld(unsigned* p)              { return __hip_atomic_load(p, __ATOMIC_RELAXED, __HIP_MEMORY_SCOPE_AGENT); }
__device__ __forceinline__ unsigned xb_add(unsigned* p, unsigned v) { return __hip_atomic_fetch_add(p, v, __ATOMIC_RELAXED, __HIP_MEMORY_SCOPE_AGENT); }
__device__ __forceinline__ unsigned xb_xcc_id() { return (unsigned)__builtin_amdgcn_s_getreg((3 << 11) | 20) & 0xFu; }
#define XB_SPIN(cond, bar) do { unsigned _sp = 0; while (cond) { __builtin_amdgcn_s_sleep(1); \
    if ((++_sp & 255u) == 0u) { if (xb_ld(&(bar)[XB_TMO])) break; if (_sp > XB_SPIN_CAP) { atomicAdd(&(bar)[XB_TMO], 1u); break; } } } } while (0)

struct XcdBarrier {
    unsigned* bar; unsigned x;
    volatile LAS unsigned* st;
};

__device__ __forceinline__ int mk_lane() { int l; asm volatile("v_mbcnt_lo_u32_b32 %0, -1, 0\n\tv_mbcnt_hi_u32_b32 %0, -1, %0" : "=v"(l)); return l; }
__device__ __forceinline__ XcdBarrier xcd_barrier_post(unsigned* bar, volatile LAS unsigned* st, int wave) {
    XcdBarrier b; b.bar = bar; b.x = xb_xcc_id(); b.st = st;
    if (wave == 0 && mk_lane() == 0) (void)xb_add(&bar[XB_XCNT(b.x)], 1u);
    return b;
}
__device__ __forceinline__ void xcd_barrier_complete(unsigned* bar, unsigned x, unsigned& nloc, unsigned& nx) {
    const unsigned G = gridDim.x * gridDim.y * gridDim.z;
    unsigned sum, cnt, mine, sp = 0u;
    for (;;) {
        sum = 0u; cnt = 0u; mine = 0u;
#pragma unroll
        for (unsigned j = 0; j < 16; ++j) { const unsigned c = xb_ld(&bar[XB_XCNT(j)]); sum += c; cnt += (c > 0u) ? 1u : 0u; mine = (j == x) ? c : mine; }
        if (sum == G) break;
        __builtin_amdgcn_s_sleep(1);
        if ((++sp & 255u) == 0u) { if (xb_ld(&bar[XB_TMO])) break; if (sp > XB_SPIN_CAP) { atomicAdd(&bar[XB_TMO], 1u); break; } }
    }
    nloc = mine > 0u ? mine : 1u; nx = cnt > 0u ? cnt : 1u;
}

__device__ __forceinline__ void xcd_barrier(const XcdBarrier& b, int wave) {
    asm volatile("s_waitcnt vmcnt(0)" ::: "memory");
    __syncthreads();
    if (wave == 0 && mk_lane() == 0) {
        unsigned* bar = b.bar;
        __builtin_amdgcn_s_waitcnt(0);
        unsigned nloc = b.st[0], nx = b.st[1];
        if (nloc == 0u) { xcd_barrier_complete(bar, b.x, nloc, nx); b.st[0] = nloc; b.st[1] = nx; }
        const unsigned old = xb_add(&bar[XB_XSUB(b.x)], 1u);
        const unsigned gen = old / nloc;
        if (old + 1u == (gen + 1u) * nloc) {
            __builtin_amdgcn_fence(__ATOMIC_RELEASE, "agent");
            asm volatile("s_waitcnt vmcnt(0)" ::: "memory");
            const unsigned og = xb_add(&bar[XB_TOP], 1u);
            const unsigned tg = og / nx;
            if (og + 1u == (tg + 1u) * nx) xb_add(&bar[XB_TOPGEN], 1u);
            else XB_SPIN(xb_ld(&bar[XB_TOPGEN]) == tg, bar);
            __builtin_amdgcn_fence(__ATOMIC_ACQUIRE, "agent");
            xb_add(&bar[XB_XGEN(b.x)], 1u);
            asm volatile("s_waitcnt vmcnt(0)" ::: "memory");
        } else {
            XB_SPIN(xb_ld(&bar[XB_XGEN(b.x)]) == gen, bar);
            __builtin_amdgcn_fence(__ATOMIC_ACQUIRE, "agent");
            asm volatile("s_waitcnt vmcnt(0)" ::: "memory");
        }
    }
    __syncthreads();
}

#include <hip/hip_bf16.h>
#include <cmath>
namespace attn_body {
using bf16=__hip_bfloat16;
using bf16x8=__attribute__((ext_vector_type(8)))short;
using s16x4=__attribute__((ext_vector_type(4)))short;
using f32x16=__attribute__((ext_vector_type(16)))float;
using u32x4=__attribute__((ext_vector_type(4)))unsigned;
using f32x4_t=__attribute__((ext_vector_type(4)))float;
constexpr int BATCH=8,NHEAD=16,SEQ=4096,D=64,DM=NHEAD*D;
constexpr int NW=8,QBLK=32,QB=QBLK*NW,KVBLK=64,NQB=SEQ/QB;
constexpr int ATTN_PITCH=DM, ATTN_UNIT_ROWS=QB;
__device__ __forceinline__ int crow(int r,int hi){return (r&3)+8*(r>>2)+4*hi;}
#define SBAR() __builtin_amdgcn_sched_barrier(0)
__device__ __forceinline__ void cmask(f32x16&p0,f32x16&p1,int jb,int qrel,int hi){
  const float NEG=-INFINITY; int kb=64*jb+4*hi;
  #pragma unroll
  for(int r=0;r<16;++r){int kv=kb+(r&3)+8*(r>>2); if(kv>qrel)p0[r]=NEG; if(kv+32>qrel)p1[r]=NEG;}
}

__device__ __forceinline__ void dm_range(f32x16&p0,f32x16&p1,int x,unsigned bw){
  #pragma unroll
  for(int r=0;r<16;++r){ const int kp=(r&3)+8*(r>>2); if((unsigned)(x-kp)>bw)p0[r]=-1e30f; if((unsigned)(x-32-kp)>bw)p1[r]=-1e30f; } }
template<int KIND> __device__ __forceinline__ int dmode(int lo){
  if(KIND==2) return (lo+94<33||lo>128)?0:4;
  return (lo+94<0||lo>512)?0:((lo<0)?40:((lo+94<=128)?1:((lo<=128)?41:((lo+94<=512)?2:42)))); }
__device__ __forceinline__ void dm_adj128(f32x16&p0,f32x16&p1,int dqh,const f32x16&adj){
  #pragma unroll
  for(int r=0;r<16;++r){ const int kp=(r&3)+8*(r>>2); p0[r]+=(dqh-kp>128)?adj[r]:0.f; p1[r]+=(dqh-32-kp>128)?adj[r]:0.f; } }
__device__ __forceinline__ void fmask(f32x16&p0,f32x16&p1,int dq){
  #pragma unroll
  for(int r=0;r<16;++r){ const int kp=(r&3)+8*(r>>2); if((unsigned)(dq-kp-33)>95u)p0[r]=-1e30f; if((unsigned)(dq-kp-65)>95u)p1[r]=-1e30f; }
}
constexpr int NSLOT=3, SLOTB=8192;
constexpr int LDS_K=0, LDS_V=NSLOT*SLOTB, LDS_WS=2*NSLOT*SLOTB, LDS_OST=LDS_WS+NW*64*4, LDS_BYTES=LDS_OST+NW*4096;
constexpr int LDS_TAB=LDS_BYTES, TABB=4096, LDS_ALL=LDS_TAB+4*TABB;
constexpr float C2=0.125f*1.4426950408889634f;
__device__ __forceinline__ void glds16(const void*gsrc,unsigned lds_dst){unsigned keep;
  asm volatile("s_mov_b32 %0, m0\n\ts_mov_b32 m0, %2\n\ts_nop 0\n\tglobal_load_lds_dwordx4 %1, off\n\ts_mov_b32 m0, %0":"=&s"(keep):"v"(gsrc),"s"(lds_dst):"memory");}
__device__ __forceinline__ float max3f(float a,float b,float c){float r;asm("v_max3_f32 %0, %1, %2, %3":"=v"(r):"v"(a),"v"(b),"v"(c));return r;}
__device__ __forceinline__ float max2f(float a,float b){float r;asm("v_max_f32_e32 %0, %1, %2":"=v"(r):"v"(a),"v"(b));return r;}
__device__ __forceinline__ float fadd_s(float a,float b){float r;asm("v_add_f32_e32 %0, %1, %2":"=v"(r):"v"(a),"v"(b));return r;}
__device__ __forceinline__ float fsub_s(float a,float b){float r;asm("v_sub_f32_e32 %0, %1, %2":"=v"(r):"v"(a),"v"(b));return r;}
typedef float f32x2_t __attribute__((ext_vector_type(2))); typedef __bf16 bf16x2_t __attribute__((ext_vector_type(2)));
__device__ __forceinline__ unsigned cvtpk_s(float lo,float hi){f32x2_t v={lo,hi};bf16x2_t b=__builtin_convertvector(v,bf16x2_t);return __builtin_bit_cast(unsigned,b);}
#define WAIT_BAR(N) asm volatile("s_waitcnt vmcnt(" #N ") lgkmcnt(0)\n\ts_barrier":::"memory")

__device__ __forceinline__ void qkt(f32x16&p0,f32x16&p1,const char*Kslot,const bf16x8*qr,const f32x16&negm,int r32,int hi){
  const char*kb=Kslot+hi*1024+r32*16;
  #pragma unroll
  for(int d0=0;d0<4;++d0){
    const bf16x8 b0=*reinterpret_cast<const bf16x8*>(kb+d0*2048);
    const bf16x8 b1=*reinterpret_cast<const bf16x8*>(kb+d0*2048+512);
    if(d0==0){p0=__builtin_amdgcn_mfma_f32_32x32x16_bf16(b0,qr[0],negm,0,0,0);p1=__builtin_amdgcn_mfma_f32_32x32x16_bf16(b1,qr[0],negm,0,0,0);}
    else{p0=__builtin_amdgcn_mfma_f32_32x32x16_bf16(b0,qr[d0],p0,0,0,0);p1=__builtin_amdgcn_mfma_f32_32x32x16_bf16(b1,qr[d0],p1,0,0,0);}}
}
typedef __attribute__((address_space(3))) const char* lds_cptr;
typedef short v4i16_t __attribute__((ext_vector_type(4)));
__device__ __forceinline__ void kload8(bf16x8*kf,lds_cptr kp){
  kf[0]=*(const __attribute__((address_space(3))) bf16x8*)(kp);      kf[1]=*(const __attribute__((address_space(3))) bf16x8*)(kp+512);
  kf[2]=*(const __attribute__((address_space(3))) bf16x8*)(kp+2048); kf[3]=*(const __attribute__((address_space(3))) bf16x8*)(kp+2560);
  kf[4]=*(const __attribute__((address_space(3))) bf16x8*)(kp+4096); kf[5]=*(const __attribute__((address_space(3))) bf16x8*)(kp+4608);
  kf[6]=*(const __attribute__((address_space(3))) bf16x8*)(kp+6144); kf[7]=*(const __attribute__((address_space(3))) bf16x8*)(kp+6656);
}
__device__ __forceinline__ void kload2(bf16x8*kf,lds_cptr kp,int j){ kf[2*j]=*(const __attribute__((address_space(3))) bf16x8*)(kp+j*2048); kf[2*j+1]=*(const __attribute__((address_space(3))) bf16x8*)(kp+j*2048+512); }
__device__ __forceinline__ s16x4 vtr(lds_cptr p){ return __builtin_bit_cast(s16x4,__builtin_amdgcn_ds_read_tr16_b64_v4i16((__attribute__((address_space(3))) v4i16_t*)p)); }
__device__ __forceinline__ float rowmax(const f32x16&p0,const f32x16&p1){
  float a=max3f(p0[0],p0[1],p1[0]),b=max3f(p0[2],p0[3],p1[1]);a=max3f(a,p1[2],p1[3]);
  #pragma unroll
  for(int r=4;r<16;r+=4){a=max3f(a,p0[r],p0[r+1]);b=max3f(b,p0[r+2],p0[r+3]);a=max3f(a,p1[r],p1[r+1]);b=max3f(b,p1[r+2],p1[r+3]);}
  const float m=max2f(a,b);
  auto rr=__builtin_amdgcn_permlane32_swap(__float_as_uint(m),__float_as_uint(m),false,false);
  return max2f(__uint_as_float(rr[0]),__uint_as_float(rr[1]));
}
__device__ __forceinline__ void pv(f32x16*o,int vb,bf16x8 pa0,bf16x8 pa1,bf16x8 pa2,bf16x8 pa3){
  #pragma unroll
  for(int d0=0;d0<2;++d0){s16x4 lo[4],hi[4];
    #pragma unroll
    for(int ks=0;ks<4;++ks){
      asm volatile("ds_read_b64_tr_b16 %0,%1 offset:%c2":"=&v"(lo[ks]):"v"(vb),"i"(d0*4096+ks*1024):"memory");
      asm volatile("ds_read_b64_tr_b16 %0,%1 offset:%c2":"=&v"(hi[ks]):"v"(vb),"i"(d0*4096+ks*1024+512):"memory");}
    asm volatile("s_waitcnt lgkmcnt(0)":::"memory");SBAR();
    #define PK(k) (bf16x8){lo[k][0],lo[k][1],lo[k][2],lo[k][3],hi[k][0],hi[k][1],hi[k][2],hi[k][3]}
    o[d0]=__builtin_amdgcn_mfma_f32_32x32x16_bf16(pa0,PK(0),o[d0],0,0,0);
    o[d0]=__builtin_amdgcn_mfma_f32_32x32x16_bf16(pa1,PK(1),o[d0],0,0,0);
    o[d0]=__builtin_amdgcn_mfma_f32_32x32x16_bf16(pa2,PK(2),o[d0],0,0,0);
    o[d0]=__builtin_amdgcn_mfma_f32_32x32x16_bf16(pa3,PK(3),o[d0],0,0,0);
    #undef PK
  }
}

#ifndef ATTN_STORE16
#define ATTN_STORE16(p,v) asm volatile("global_store_dwordx4 %0, %1, off sc1\n\ts_nop 1"::"v"(p),"v"(v):"memory")
#endif
template<int THRL,int KIND> __device__ __forceinline__ void attn_unit(int b,int h,int qb,unsigned char*ws,char*shm,int wave,bf16x8 (&qr)[4],bool pre,bool has_next,int nkind,int nb,int nh,int nqb){
  const bf16*Q=(const bf16*)(ws+WS_QO); const bf16*K=(const bf16*)(ws+WS_K); const bf16*V=(const bf16*)(ws+WS_V); unsigned char*O8=ws+WS_O8;
  float*ssq=(float*)(ws+WS_SSQA); const float*kpart=(const float*)(ws+WS_KPART); unsigned short*faro=(unsigned short*)(ws+WS_FARO); float*farl=(float*)(ws+WS_FARL);
  constexpr bool DIL=(KIND==1), FAR=(KIND==2); constexpr int RS=FAR?16:1;
  int tid=wave*64+mk_lane(); asm volatile("":"+v"(tid));
  const int lane=tid&63,r32=lane&31,hi=lane>>5; const int wid=__builtin_amdgcn_readfirstlane(tid>>6);
  const int rowbase=b*SEQ+(FAR?qb:0);   const int q0=FAR?0:qb*QB;
  const bf16*Qw=Q+(rowbase+(int)(q0+wid*QBLK)*RS)*DM+h*D;
  const int T0=DIL?(qb>2?4*qb-8:0):0;
  const bf16*Kh=K+(rowbase+(int)T0*KVBLK)*DM+h*D,*Vh=V+(rowbase+(int)T0*KVBLK)*DM+h*D;
  const unsigned lds0=(unsigned)(uintptr_t)shm;
  float*wsf=(float*)(shm+LDS_WS)+wid*64;
  const bf16*ksrc=Kh+(int)lane*RS*DM+wid*8;
  const bf16*vsrc=Vh+(int)(16*(wid&3)+(lane>>2))*RS*DM+(wid>>2)*32+(lane&3)*8;
  const unsigned kdst=lds0+LDS_K+wid*1024, vdst=lds0+LDS_V+wid*1024;
  #define DMA_K(t,slot) glds16(ksrc+(int)(t)*KVBLK*RS*DM,(unsigned)__builtin_amdgcn_readfirstlane(kdst+(slot)))
  #define DMA_V(t,slot) glds16(vsrc+(int)(t)*KVBLK*RS*DM,(unsigned)__builtin_amdgcn_readfirstlane(vdst+(slot)))
  const int vb0=(int)(lds0+LDS_V)+((lane>>4)&1)*32+(lane&3)*8+(4*hi+((lane&15)>>2))*64;
  const char*Kbase=shm+LDS_K; bf16x8 kf[8];
  const lds_cptr shm3=(lds_cptr)shm; const lds_cptr kp0=shm3+LDS_K+hi*1024+r32*16; const lds_cptr vp0=shm3+LDS_V+((lane>>4)&1)*32+(lane&3)*8+(4*hi+((lane&15)>>2))*64;
  const int NT=FAR?4:(q0+QB)/KVBLK-T0;
  if(!pre)DMA_K(0,0); DMA_V(0,0); if(!pre)DMA_K(1,SLOTB);
  #pragma unroll
  for(int d0=0;d0<4;++d0)if(!pre)qr[d0]=*reinterpret_cast<const bf16x8*>(&Qw[(int)r32*RS*DM+d0*16+hi*8]);
  float mhat=0.f,l_reg=0.f;f32x16 o[2];o[0]=f32x16{};o[1]=f32x16{};
  const int qrel=wid*QBLK+r32;
  const lds_cptr tabp=(lds_cptr)shm+LDS_TAB+lane*64;
  unsigned selmask=1u<<qb;
  if(KIND==0){
    f32x16 g=f32x16{};
    #pragma unroll
    for(int d0=0;d0<4;++d0){ float km[8];
      if(r32<16){ const float*kp_=kpart+(unsigned)((b*16+r32)*2)*512+h*64+d0*16+hi*8;
        const f32x4_t a0=*(const f32x4_t*)kp_,a1=*(const f32x4_t*)(kp_+4),b0=*(const f32x4_t*)(kp_+512),b1=*(const f32x4_t*)(kp_+516);
        km[0]=a0[0]+b0[0];km[1]=a0[1]+b0[1];km[2]=a0[2]+b0[2];km[3]=a0[3]+b0[3];km[4]=a1[0]+b1[0];km[5]=a1[1]+b1[1];km[6]=a1[2]+b1[2];km[7]=a1[3]+b1[3]; }
      else{ _Pragma("unroll") for(int j=0;j<8;++j)km[j]=0.f; }
      u32x4 wh,wl; float rs[8];
      wh[0]=cvtpk_s(km[0],km[1]);wh[1]=cvtpk_s(km[2],km[3]);wh[2]=cvtpk_s(km[4],km[5]);wh[3]=cvtpk_s(km[6],km[7]);
      #pragma unroll
      for(int j=0;j<4;++j){ rs[2*j]=km[2*j]-__uint_as_float(wh[j]<<16); rs[2*j+1]=km[2*j+1]-__uint_as_float(wh[j]&0xffff0000u); }
      wl[0]=cvtpk_s(rs[0],rs[1]);wl[1]=cvtpk_s(rs[2],rs[3]);wl[2]=cvtpk_s(rs[4],rs[5]);wl[3]=cvtpk_s(rs[6],rs[7]);
      g=__builtin_amdgcn_mfma_f32_32x32x16_bf16(__builtin_bit_cast(bf16x8,wh),qr[d0],g,0,0,0);
      g=__builtin_amdgcn_mfma_f32_32x32x16_bf16(__builtin_bit_cast(bf16x8,wl),qr[d0],g,0,0,0); }
    float gv[16];
    #pragma unroll
    for(int r=0;r<8;++r){ const float own=g[r],oth=__shfl_xor(own,32); const int bl=(r&3)+8*(r>>2); gv[bl]=hi?oth:own; gv[bl+4]=hi?own:oth; }
    #pragma unroll
    for(int j=0;j<16;++j) if(j>=qb)gv[j]=-3e38f;
    #pragma unroll
    for(int rd=0;rd<3;++rd){ float best=-3e38f;int bi=0;
      #pragma unroll
      for(int j=0;j<16;++j){ if(gv[j]>best){best=gv[j];bi=j;} }
      if(best>-3e38f)selmask|=1u<<bi;
      #pragma unroll
      for(int j=0;j<16;++j) if(j==bi)gv[j]=-3e38f; }
  }
  const int lo0=FAR?(32*wid-63):(q0-T0*KVBLK+32*wid-63);
  #define DMODE(t) dmode<KIND>(lo0-(t)*KVBLK)
  #define CMASK(P0,P1,t) do{ if(DIL){ if(md_t>=40){ const int dqh_=q0-(T0+(t))*KVBLK+qrel-4*hi; \
        if(md_t==41){ const f32x16 adj_=*(const __attribute__((address_space(3))) f32x16*)(tabp+3*TABB); dm_adj128(P0,P1,dqh_,adj_); } \
        else dm_range(P0,P1,dqh_-((md_t==40)?0:-4096),(md_t==40)?0x7fffffffu:4608u); } } \
    else if(FAR){ if(md_t==4)fmask(P0,P1,qrel-(t)*KVBLK-4*hi); } \
    else { int jb_=(t)-(NT-4); if(jb_>=0)cmask(P0,P1,jb_,qrel,hi); } }while(0)
  #define SETC(t) f32x16 ct; const int md_t=(KIND==0)?0:DMODE(t); { if(DIL){ const int to_=(md_t==0)?0:((md_t==2||md_t==42)?2*TABB:TABB); \
      const f32x16 tb_=*(const __attribute__((address_space(3))) f32x16*)(tabp+to_); _Pragma("unroll") for(int r=0;r<16;++r)ct[r]=tb_[r]-mhat; } \
    else { const float x_=(FAR?(md_t!=0):(((selmask>>((t)>>2))&1u)!=0u))?-mhat:-1e30f; _Pragma("unroll") for(int r=0;r<16;++r)ct[r]=x_; } asm volatile("":"+v"(ct)); }
  bool resc=false;
  #define START(P0,P1) do{ const float rm=rowmax(P0,P1); resc=false; \
    if(__any(rm>(float)THRL)){ const float dl=__builtin_fmaxf(rm,0.f); mhat=fadd_s(mhat,dl); \
      _Pragma("unroll") for(int r=0;r<16;++r){P0[r]=fsub_s(P0[r],dl);P1[r]=fsub_s(P1[r],dl);} \
      const float f=__builtin_amdgcn_exp2f(-dl); l_reg*=f; if(hi==0)wsf[r32]=f; resc=true; } \
    _Pragma("unroll") for(int r=0;r<16;++r)P0[r]=__builtin_amdgcn_exp2f(P0[r]); }while(0)
  #define RESC() do{ if(resc){ asm volatile("s_waitcnt lgkmcnt(0)":::"memory"); \
      _Pragma("unroll") for(int d_=0;d_<2;++d_) _Pragma("unroll") for(int r=0;r<16;++r)o[d_][r]*=wsf[crow(r,hi)]; } }while(0)
  f32x16 pA0,pA1,pB0,pB1;
  int sl_prev=0,sl_cur=0,sl_next=SLOTB;
  #define ROT() do{sl_prev=sl_cur;sl_cur=sl_next;sl_next=(sl_next==(NSLOT-1)*SLOTB)?0:sl_next+SLOTB;}while(0)
  if(!pre){ DMA_K(2,2*SLOTB);
    WAIT_BAR(3); }
  else { WAIT_BAR(1); }
  if(0)WAIT_BAR(3);
  { SETC(0); qkt(pA0,pA1,Kbase,qr,ct,r32,hi); asm volatile("s_nop 15\n\ts_nop 7":"+v"(pA0),"+v"(pA1));CMASK(pA0,pA1,0); }
  START(pA0,pA1);
  _Pragma("unroll") for(int r=0;r<16;++r)pA1[r]=__builtin_amdgcn_exp2f(pA1[r]);
  WAIT_BAR(0);
  RESC();
  DMA_K(3,0);DMA_V(1,SLOTB);
  ROT();
  kload8(kf,kp0+sl_cur);
  WAIT_BAR(2);
  s16x4 vlo[8],vhi[8]; u32x4 pw0,pw1,pw2,pw3;
  #define PKW(P,B) cvtpk_s(P[B],P[B+1])
  #define PAF(k) __builtin_bit_cast(bf16x8,pw##k)
  #define VFR(i) (bf16x8){vlo[i][0],vlo[i][1],vlo[i][2],vlo[i][3],vhi[i][0],vhi[i][1],vhi[i][2],vhi[i][3]}
  #define PIN(x) asm volatile("":"+v"(x))
  #define MX3(a,b,c) __builtin_fmaxf(__builtin_fmaxf((a),(b)),(c))
  #define GAPA(MF,A0,A1,A2,A3,W0,W1,PW) do{ MF; sacc+=A0; sacc+=A1; sacc+=A2; sacc+=A3; PIN(sacc); W0; W1; PIN(PW); SBAR(); }while(0)
  #define EX(v) __builtin_amdgcn_exp2f(v)
  #define GAPB(MF,X,B) do{ MF; X[B]=EX(X[B]); X[B+1]=EX(X[B+1]); X[B+2]=EX(X[B+2]); X[B+3]=EX(X[B+3]); PIN(X); SBAR(); }while(0)
  #define VRD(i) do{ vlo[i]=vtr(vp_+(((i)>>2)*4096+((i)&3)*1024)); vhi[i]=vtr(vp_+(((i)>>2)*4096+((i)&3)*1024+512)); }while(0)
  #define KRD(G,j) do{ if(G){ kload2(kf,kp0+sl_next,j); SBAR(); } }while(0)
  #define STEP(C0,C1,P0,P1,t,GK,GV,GL) do{ SBAR(); SETC(t); SBAR(); \
    const lds_cptr vp_=vp0+sl_prev; \
    VRD(0); SBAR(); float sacc=(P0[0]+P0[1]); \
    GAPA(C0=__builtin_amdgcn_mfma_f32_32x32x16_bf16(kf[0],qr[0],ct,0,0,0), P0[2],P0[3],P0[4],P0[5],     pw0[0]=PKW(P0,0), pw0[1]=PKW(P0,2), pw0); \
    VRD(4); SBAR(); GAPA(C1=__builtin_amdgcn_mfma_f32_32x32x16_bf16(kf[1],qr[0],ct,0,0,0), P0[6],P0[7],P0[8],P0[9],     pw0[2]=PKW(P0,4), pw0[3]=PKW(P0,6), pw0); \
    VRD(1); SBAR(); GAPA(C0=__builtin_amdgcn_mfma_f32_32x32x16_bf16(kf[2],qr[1],C0,0,0,0),   P0[10],P0[11],P0[12],P0[13], pw1[0]=PKW(P0,8), pw1[1]=PKW(P0,10), pw1); \
    VRD(5); SBAR(); GAPA(C1=__builtin_amdgcn_mfma_f32_32x32x16_bf16(kf[3],qr[1],C1,0,0,0),   P0[14],P0[15],P1[0],P1[1],   pw1[2]=PKW(P0,12),pw1[3]=PKW(P0,14), pw1); \
    VRD(2); SBAR(); GAPA(C0=__builtin_amdgcn_mfma_f32_32x32x16_bf16(kf[4],qr[2],C0,0,0,0),   P1[2],P1[3],P1[4],P1[5],     pw2[0]=PKW(P1,0), pw2[1]=PKW(P1,2), pw2); \
    VRD(6); SBAR(); GAPA(C1=__builtin_amdgcn_mfma_f32_32x32x16_bf16(kf[5],qr[2],C1,0,0,0),   P1[6],P1[7],P1[8],P1[9],     pw2[2]=PKW(P1,4), pw2[3]=PKW(P1,6), pw2); \
    VRD(3); SBAR(); GAPA(C0=__builtin_amdgcn_mfma_f32_32x32x16_bf16(kf[6],qr[3],C0,0,0,0),   P1[10],P1[11],P1[12],P1[13], pw3[0]=PKW(P1,8), pw3[1]=PKW(P1,10), pw3); \
    VRD(7); SBAR(); GAPA(C1=__builtin_amdgcn_mfma_f32_32x32x16_bf16(kf[7],qr[3],C1,0,0,0),   P1[14],P1[15],0.f,0.f,       pw3[2]=PKW(P1,12),pw3[3]=PKW(P1,14), pw3); \
    l_reg+=sacc; \
    if(GK){DMA_K((t)+3,sl_cur);} if(GV){DMA_V((t)+1,sl_next);} \
    CMASK(C0,C1,t); \
    { float a=MX3(C0[0],C0[1],C1[0]),b=MX3(C0[2],C0[3],C1[1]); a=MX3(a,C1[2],C1[3]); \
      _Pragma("unroll") for(int r=4;r<16;r+=4){a=MX3(a,C0[r],C0[r+1]);b=MX3(b,C0[r+2],C0[r+3]);a=MX3(a,C1[r],C1[r+1]);b=MX3(b,C1[r+2],C1[r+3]);} \
      float rm=__builtin_fmaxf(a,b); { auto rr=__builtin_amdgcn_permlane32_swap(__float_as_uint(rm),__float_as_uint(rm),false,false); rm=__builtin_fmaxf(__uint_as_float(rr[0]),__uint_as_float(rr[1])); } \
      resc=false; \
      if(__builtin_expect(__any(rm>(float)THRL),0)){ const float dl=__builtin_fmaxf(rm,0.f); mhat+=dl; \
        _Pragma("unroll") for(int r=0;r<16;++r){C0[r]-=dl;C1[r]-=dl;} \
        const float f=__builtin_amdgcn_exp2f(-dl); l_reg*=f; if(hi==0)wsf[r32]=f; resc=true; } } \
    SBAR(); \
    GAPB(o[0]=__builtin_amdgcn_mfma_f32_32x32x16_bf16(PAF(0),VFR(0),o[0],0,0,0), C0,0); \
    GAPB(o[1]=__builtin_amdgcn_mfma_f32_32x32x16_bf16(PAF(0),VFR(4),o[1],0,0,0), C0,4); \
    KRD(GL,0); GAPB(o[0]=__builtin_amdgcn_mfma_f32_32x32x16_bf16(PAF(1),VFR(1),o[0],0,0,0), C0,8); \
    KRD(GL,1); GAPB(o[1]=__builtin_amdgcn_mfma_f32_32x32x16_bf16(PAF(1),VFR(5),o[1],0,0,0), C0,12); \
    KRD(GL,2); GAPB(o[0]=__builtin_amdgcn_mfma_f32_32x32x16_bf16(PAF(2),VFR(2),o[0],0,0,0), C1,0); \
    KRD(GL,3); GAPB(o[1]=__builtin_amdgcn_mfma_f32_32x32x16_bf16(PAF(2),VFR(6),o[1],0,0,0), C1,4); \
    GAPB(o[0]=__builtin_amdgcn_mfma_f32_32x32x16_bf16(PAF(3),VFR(3),o[0],0,0,0), C1,8); \
    GAPB(o[1]=__builtin_amdgcn_mfma_f32_32x32x16_bf16(PAF(3),VFR(7),o[1],0,0,0), C1,12); \
    }while(0)
  int t=1;
  for(;t+5<NT;t+=2){
    STEP(pB0,pB1,pA0,pA1,t,true,true,true);     WAIT_BAR(2); RESC(); ROT();
    STEP(pA0,pA1,pB0,pB1,t+1,true,true,true);   WAIT_BAR(2); RESC(); ROT();
  }
  #define ENDW(tt) do{ if((tt)+3<NT){WAIT_BAR(2);} else if((tt)+2<NT){WAIT_BAR(1);} else {WAIT_BAR(0);} }while(0)
  for(;t+1<NT;t+=2){
    STEP(pB0,pB1,pA0,pA1,t,(t+3<NT),(t+1<NT),(t+1<NT));       ENDW(t);   RESC(); ROT();
    STEP(pA0,pA1,pB0,pB1,t+1,(t+4<NT),(t+2<NT),(t+2<NT));     ENDW(t+1); RESC(); ROT();
  }
  if(has_next){
    const int nRS=(nkind==2)?16:1, nrowbase=nb*SEQ+((nkind==2)?nqb:0), nT0=(nkind==1)?(nqb>2?4*nqb-8:0):0;
    const bf16*nks=K+(nrowbase+(int)nT0*KVBLK)*DM+nh*D+(int)lane*nRS*DM+wid*8;
    glds16(nks,(unsigned)__builtin_amdgcn_readfirstlane(kdst)); glds16(nks+(int)KVBLK*nRS*DM,(unsigned)__builtin_amdgcn_readfirstlane(kdst+SLOTB)); glds16(nks+(int)2*KVBLK*nRS*DM,(unsigned)__builtin_amdgcn_readfirstlane(kdst+2*SLOTB)); }
  STEP(pB0,pB1,pA0,pA1,NT-1,false,false,false); RESC();
  if(has_next){
    const int nRS=(nkind==2)?16:1, nrowbase=nb*SEQ+((nkind==2)?nqb:0), nq0=(nkind==2)?0:nqb*QB; const bf16*nQw=Q+(nrowbase+(int)(nq0+wid*QBLK)*nRS)*DM+nh*D;
    #pragma unroll
    for(int d0=0;d0<4;++d0)qr[d0]=*reinterpret_cast<const bf16x8*>(&nQw[(int)r32*nRS*DM+d0*16+hi*8]); }
  { float sacc=pB0[0]+pB0[1]; _Pragma("unroll") for(int r=2;r<16;++r)sacc+=pB0[r]; _Pragma("unroll") for(int r=0;r<16;++r)sacc+=pB1[r]; l_reg+=sacc;
    pw0=(u32x4){PKW(pB0,0),PKW(pB0,2),PKW(pB0,4),PKW(pB0,6)};pw1=(u32x4){PKW(pB0,8),PKW(pB0,10),PKW(pB0,12),PKW(pB0,14)};pw2=(u32x4){PKW(pB1,0),PKW(pB1,2),PKW(pB1,4),PKW(pB1,6)};pw3=(u32x4){PKW(pB1,8),PKW(pB1,10),PKW(pB1,12),PKW(pB1,14)};
    SBAR(); pv(o,vb0+sl_cur,PAF(0),PAF(1),PAF(2),PAF(3)); }
  #undef PKW
  #undef PAF
  #undef VFR
  #undef PIN
  #undef MX3
  #undef GAPA
  #undef GAPB
  #undef EX
  #undef VRD
  #undef KRD
  #undef STEP
  #undef ENDW
  {auto rr=__builtin_amdgcn_permlane32_swap(__float_as_uint(l_reg),__float_as_uint(l_reg),false,false);l_reg=__uint_as_float(rr[0])+__uint_as_float(rr[1]);}
  int lane_e=lane; asm volatile("":"+v"(lane_e));
  u32x4 fch[4];
  if(DIL){
    const unsigned short*fp=faro+(unsigned)(rowbase+q0+wid*QBLK+(lane_e>>3))*512+(h-8)*D+(lane_e&7)*8;
    #pragma unroll
    for(int i=0;i<4;++i)fch[i]=*(const u32x4*)(fp+(unsigned)i*8*512);
    const float*lp=farl+((unsigned)(rowbase+q0+wid*QBLK+(lane_e&31))*8+(h-8))*2; const float lf_=lp[0],mf_=lp[1];
    const float M_=__builtin_fmaxf(mhat,mf_),sa_=__builtin_amdgcn_exp2f(mhat-M_),sb_=__builtin_amdgcn_exp2f(mf_-M_),rl_=__builtin_amdgcn_rcpf(l_reg*sa_+lf_*sb_);
    if(hi==0){wsf[32+r32]=sa_*rl_;wsf[r32]=sb_*rl_;} }
  else if(hi==0)wsf[32+r32]=FAR?1.f:__builtin_amdgcn_rcpf(l_reg);
  asm volatile("s_waitcnt lgkmcnt(0)":::"memory");
  float rli[16];
  #pragma unroll
  for(int r=0;r<16;++r)rli[r]=wsf[32+crow(r,hi)];
  constexpr int OP=FAR?512:DM;
  bf16*Ow=(bf16*)faro+(rowbase+(int)wid*QBLK*RS)*OP+(h-8)*D;
  unsigned char*O8w=O8+(rowbase+q0+wid*QBLK)*DM+h*D;
  if(FAR&&hi==0){ float*lp=farl+((unsigned)(rowbase+(int)qrel*RS)*8+(h-8))*2; __hip_atomic_store((unsigned long long*)lp,((unsigned long long)__float_as_uint(mhat)<<32)|__float_as_uint(l_reg),__ATOMIC_RELAXED,__HIP_MEMORY_SCOPE_AGENT); }
  { bf16*stg=(bf16*)(shm+LDS_OST)+wid*2048;
    #pragma unroll
    for(int r=0;r<16;++r){const int orow=crow(r,hi);
      #pragma unroll
      for(int d0=0;d0<2;++d0)stg[orow*64+d0*32+r32]=__float2bfloat16(o[d0][r]*rli[r]);}
    asm volatile("s_waitcnt lgkmcnt(0)":::"memory");
    #pragma unroll
    for(int i=0;i<4;++i){const int row=i*8+(lane_e>>3),ch=lane_e&7; u32x4 v=*(const u32x4*)(stg+row*64+ch*8);
      if(DIL){ const float fb_=wsf[row];
        #pragma unroll
        for(int j=0;j<4;++j){ const float a_=__uint_as_float(v[j]<<16)+__uint_as_float(fch[i][j]<<16)*fb_, b_=__uint_as_float(v[j]&0xffff0000u)+__uint_as_float(fch[i][j]&0xffff0000u)*fb_; v[j]=cvtpk_s(a_,b_); } }
      if(FAR){ ATTN_STORE16(Ow+(int)row*RS*OP+ch*8,v); }
      else { unsigned w0_=0,w1_=0;
        w0_=__builtin_amdgcn_cvt_pk_fp8_f32(__uint_as_float(v[0]<<16)*64.f,__uint_as_float(v[0]&0xffff0000u)*64.f,w0_,false); w0_=__builtin_amdgcn_cvt_pk_fp8_f32(__uint_as_float(v[1]<<16)*64.f,__uint_as_float(v[1]&0xffff0000u)*64.f,w0_,true);
        w1_=__builtin_amdgcn_cvt_pk_fp8_f32(__uint_as_float(v[2]<<16)*64.f,__uint_as_float(v[2]&0xffff0000u)*64.f,w1_,false); w1_=__builtin_amdgcn_cvt_pk_fp8_f32(__uint_as_float(v[3]<<16)*64.f,__uint_as_float(v[3]&0xffff0000u)*64.f,w1_,true);
        *(unsigned long long*)(O8w+(int)row*DM+ch*8)=((unsigned long long)w1_<<32)|w0_; }
      float sq=0.f;
      #pragma unroll
      for(int j=0;j<4;++j){ const float a_=__uint_as_float(v[j]<<16), b_=__uint_as_float(v[j]&0xffff0000u); sq+=a_*a_+b_*b_; }
      sq+=__shfl_xor(sq,1); sq+=__shfl_xor(sq,2); sq+=__shfl_xor(sq,4);
      if(!FAR&&ch==0)ssq[(unsigned)(rowbase+q0+wid*QBLK+row)*16+h]=sq; } }
  asm volatile("s_waitcnt lgkmcnt(0)\n\ts_barrier":::"memory");
  #undef DMA_K
  #undef DMA_V
  #undef CMASK
  #undef START
  #undef RESC
  #undef ROT
}
constexpr int ATTN_LDS_BYTES=LDS_BYTES;
__device__ __forceinline__ void attn_tables(char*lds,int wave){
  float*tb=(float*)(lds+LDS_TAB);
  for(int e=wave*64+mk_lane();e<64*16;e+=512){ const int ln=e>>4,r=e&15,r32=ln&31,hi=ln>>5; const int z4=r32&3,z16=((r32&15)-4*hi)&15;
    const bool in4=(z4==(r&3)),in16=(z16==((r&3)+8*((r>>2)&1)));
    tb[e]=-1e30f; tb[1024+e]=in16?1.5849625007f:(in4?1.f:0.f); tb[2048+e]=in16?1.f:(in4?0.f:-1e30f); tb[3072+e]=in16?(1.f-1.5849625007f):(in4?-1.f:-1e30f); }
  __syncthreads();
}
template<int THRL=8> __device__ __forceinline__ void attn_phase(char*lds,unsigned char*ws,unsigned*cnt,int vcu,int G,int wave){
  const int g=vcu>>2,b=g>>3,hm=g&7,c=vcu&3;
  attn_tables(lds,wave);
  bf16x8 qr[4];
  { const int n_=(MK_REPEAT_PHASE==22?8:4); for(int i=0;i<n_;++i) attn_unit<THRL,2>(b,8+hm,4*c+(i&3),ws,lds,wave,qr,i>0,true,(i+1<n_)?2:0,b,(i+1<n_)?8+hm:hm,(i+1<n_)?4*c+((i+1)&3):15-c); }
  asm volatile("s_waitcnt vmcnt(0)":::"memory"); __syncthreads();
  if(wave==0&&mk_lane()==0) __hip_atomic_fetch_add(cnt,1u,__ATOMIC_RELAXED,__HIP_MEMORY_SCOPE_AGENT);
  #define QBSEL(i_) ((((i_)&3)==0)?15-c:((((i_)&3)==1)?8+c:((((i_)&3)==2)?7-c:c)))
  { const int n_=(MK_REPEAT_PHASE==20?8:4); for(int ii=0;ii<n_;++ii) attn_unit<THRL,0>(b,hm,QBSEL(ii),ws,lds,wave,qr,true,true,(ii+1<n_)?0:1,b,(ii+1<n_)?hm:8+hm,QBSEL(ii+1)); }
  if(wave==0&&mk_lane()==0){ unsigned sp=0; while(__hip_atomic_load(cnt,__ATOMIC_RELAXED,__HIP_MEMORY_SCOPE_AGENT)<(unsigned)G){ __builtin_amdgcn_s_sleep(2); if(++sp>(1u<<22))break; }
    __builtin_amdgcn_fence(__ATOMIC_ACQUIRE,"agent"); asm volatile("s_waitcnt vmcnt(0)":::"memory"); }
  __syncthreads();
  { const int n_=(MK_REPEAT_PHASE==21?8:4); for(int ii=0;ii<n_;++ii) attn_unit<THRL,1>(b,8+hm,QBSEL(ii),ws,lds,wave,qr,true,ii+1<n_,1,b,8+hm,QBSEL(ii+1)); }
  #undef QBSEL
}
#undef SBAR
#undef WAIT_BAR
}

struct Frame {
    LAS unsigned char* lds;
    volatile LAS unsigned* MISC;
    gu32* ctl;
    int wave;
    int vcu, G;
    const float *x, *attn_norm, *w_in, *moba_norm, *dil_norm, *w_out, *ffn_norm, *w_gate, *w_up, *w_down, *final_norm;
    float* out;
    bf16 *Wqkv_t, *Wo_t, *Wgu_t, *Wd_t;
    bf16 *QO, *KB, *VB, *XN, *OB; unsigned char *HB, *XN8;
    float *rope, *kpart, *ssqa, *ssq1, *ssq2;
};

__device__ __forceinline__ float wave_sum(float v) {
#pragma unroll
    for (int o = 1; o < 64; o <<= 1) v += __shfl_xor(v, o);
    return v;
}
__device__ __forceinline__ int qkv_vrow(int n) { const int part = n >> 10, head = (n >> 6) & 15, d = n & 63; return 256 * (part * 4 + (head >> 2)) + 128 * (d >> 5) + 32 * (head & 3) + (d & 31); }
template <int MODE>
__device__ __forceinline__ void p0_item(const float* W, int K, int N, bf16* WT, const float* g0, const float* g1, LAS float* scr, int item, int lane) {
    const int nblk = N / 32, kb = item / nblk, nb = item % nblk, k0 = 64 * kb, n0 = 32 * nb;
#pragma unroll 8
    for (int i = 0; i < 32; ++i) { const int kk = 2 * i + (lane >> 5), k = k0 + kk; float w = W[(size_t)k * N + n0 + (lane & 31)];
        if (MODE == 1) w *= (k < 512 ? g0[k] : g1[k - 512]);
        if (MODE == 2 || MODE == 3) w *= g0[k];
        scr[kk * 33 + (lane & 31)] = w; }
    LDS_WAIT(); asm volatile("" ::: "memory");
    const int c = lane & 7;
#pragma unroll
    for (int j = 0; j < 4; ++j) { const int n = (lane >> 3) + 8 * j; const LAS float* s = scr + (8 * c) * 33 + n;
        const int ns = n0 + n; int dr;
        if (MODE == 0) dr = qkv_vrow(ns); else if (MODE == 2) dr = 256 * (ns >> 7) + (ns & 127); else if (MODE == 3) dr = 256 * (ns >> 7) + 128 + (ns & 127); else dr = ns;
        bool f8 = MODE >= 1; size_t base8 = 0;
        if (MODE == 0) {
            const int pn = dr >> 8, lo = dr & 255; f8 = !(pn < 8 && (pn & 3) < 2);
            dr = (f8 ? (pn < 8 ? ((pn & 1) + 2 * (pn >> 2)) : pn - 4) : ((pn & 1) + 2 * (pn >> 2))) * 256 + lo; base8 = (size_t)QKV8_OFF; }
        if (f8) {
            const pg8::f32x4 a = {s[0 * 33], s[1 * 33], s[2 * 33], s[3 * 33]}, b = {s[4 * 33], s[5 * 33], s[6 * 33], s[7 * 33]};
            *(GAS pg8::u32x2*)((unsigned char*)WT + base8 + (size_t)dr * K + k0 + 8 * c) = pg8::pack8_fp8(a * pg8::F8_SW, b * pg8::F8_SW);
        } else {
            v4u o; o.x = pk2(s[0 * 33], s[1 * 33]); o.y = pk2(s[2 * 33], s[3 * 33]); o.z = pk2(s[4 * 33], s[5 * 33]); o.w = pk2(s[6 * 33], s[7 * 33]);
            *(GAS v4u*)(WT + (size_t)dr * K + k0 + 8 * c) = o; } }
    LDS_WAIT(); asm volatile("" ::: "memory");
}
template <int R>
__device__ __forceinline__ void rms_rows_to_bf16(Frame& F, const float* xrow, const float* gain, bf16* orow, unsigned char* orow8, float* rn) {
    const GAS f32x4* xr = (const GAS f32x4*)xrow + mk_lane(); const GAS f32x4* gr = (const GAS f32x4*)gain + mk_lane();
    f32x4 v[R][4]; float s[R];
#pragma unroll
    for (int r = 0; r < R; ++r)
#pragma unroll
        for (int j = 0; j < 4; ++j) v[r][j] = xr[r * 256 + 64 * j];
#pragma unroll
    for (int r = 0; r < R; ++r) { s[r] = 0.f;
#pragma unroll
        for (int j = 0; j < 4; ++j) s[r] += (v[r][j].x * v[r][j].x + v[r][j].y * v[r][j].y) + (v[r][j].z * v[r][j].z + v[r][j].w * v[r][j].w); }
#pragma unroll
    for (int o = 1; o < 64; o <<= 1)
#pragma unroll
        for (int r = 0; r < R; ++r) s[r] += __shfl_xor(s[r], o);
    const int ln_ = mk_lane(); GAS unsigned long long* o8 = (GAS unsigned long long*)orow + ln_; GAS unsigned* q8 = (GAS unsigned*)orow8 + ln_;
#pragma unroll
    for (int r = 0; r < R; ++r) { const float rms = sqrtf(s[r] * (1.f / D) + RMS_EPS), rstd = 1.f / rms; if (ln_ == 0) rn[r] = rms;
#pragma unroll
        for (int j = 0; j < 4; ++j) { const f32x4 g = gr[64 * j];
            const f32x4 y = v[r][j] * rstd * g;
            o8[r * 256 + 64 * j] = (unsigned long long)pk2(y.x, y.y) | ((unsigned long long)pk2(y.z, y.w) << 32);
            unsigned t = 0; t = __builtin_amdgcn_cvt_pk_fp8_f32(y.x * pg8::F8_SA, y.y * pg8::F8_SA, t, false); t = __builtin_amdgcn_cvt_pk_fp8_f32(y.z * pg8::F8_SA, y.w * pg8::F8_SA, t, true); q8[r * 256 + 64 * j] = t; } }
}
__device__ __forceinline__ void p0_prologue(Frame& F) {
    LAS float* scr = (LAS float*)(F.lds + RING_OFF + F.wave * 16384);
    const int gw = F.vcu * NWAVES + F.wave, NGW = F.G * NWAVES;
    constexpr int I_IN = (D / 64) * (NQKV / 32), I_O = (D / 64) * (D / 32), I_G = (D / 64) * (FF / 32), I_D = (FF / 64) * (D / 32);
    constexpr int NITEMS = I_IN + I_O + 2 * I_G + I_D;
    for (int it = gw; it < NITEMS; it += NGW) {
        int r = it;
        if (r < I_IN) { p0_item<0>(F.w_in, D, NQKV, F.Wqkv_t, nullptr, nullptr, scr, r, mk_lane()); continue; } r -= I_IN;
        if (r < I_O) { p0_item<1>(F.w_out, D, D, F.Wo_t, F.moba_norm, F.dil_norm, scr, r, mk_lane()); continue; } r -= I_O;
        if (r < I_G) { p0_item<2>(F.w_gate, D, FF, F.Wgu_t, F.ffn_norm, nullptr, scr, r, mk_lane()); continue; } r -= I_G;
        if (r < I_G) { p0_item<3>(F.w_up, D, FF, F.Wgu_t, F.ffn_norm, nullptr, scr, r, mk_lane()); continue; } r -= I_G;
        p0_item<4>(F.w_down, FF, D, F.Wd_t, nullptr, nullptr, scr, r, mk_lane());
    }
    for (int e = (F.vcu * NWAVES * 64) + F.wave * 64 + mk_lane(); e < SEQ * 32; e += F.G * NWAVES * 64) {
        const int s = e >> 5, j = e & 31;
        const float invf = __builtin_amdgcn_exp2f(-(float)j * (13.287712379549449f / 32.0f));
        double rev = (double)s * (double)invf * 0.15915494309189535; rev -= __builtin_floor(rev);
        const float r = (float)rev;
        pg8::f32x2 cs; cs.x = __builtin_amdgcn_cosf(r); cs.y = __builtin_amdgcn_sinf(r);
        *(GAS pg8::f32x2*)((pg8::f32x2*)F.rope + e) = cs;
    }
    for (int m = 4 * gw; m < M; m += 4 * NGW) rms_rows_to_bf16<4>(F, F.x + (size_t)m * D, F.attn_norm, F.XN + (size_t)m * D, F.XN8 + (size_t)m * D, (float*)(F.kpart + 131072) + m);
}

__device__ __forceinline__ void p6_final(Frame& F) {
    const int gw = F.vcu * NWAVES + F.wave, NGW = F.G * NWAVES;
    const GAS f32x4* gr = (const GAS f32x4*)F.final_norm + mk_lane();
    for (int m = gw; m < M; m += NGW) {
        GAS f32x4* xr = (GAS f32x4*)(F.out + (size_t)m * D) + mk_lane();
        const GAS f32x4* sp = (const GAS f32x4*)(F.ssq2 + (size_t)m * 16);
        const f32x4 a = sp[0], b = sp[1], c = sp[2], d = sp[3];
        const float ss = ((a.x + a.y) + (a.z + a.w)) + ((b.x + b.y) + (b.z + b.w)) + ((c.x + c.y) + (c.z + c.w)) + ((d.x + d.y) + (d.z + d.w));
        const float rstd = 1.f / sqrtf(ss * (1.f / D) + RMS_EPS);
#pragma unroll
        for (int j = 0; j < 4; ++j) { const f32x4 v = xr[64 * j], g = gr[64 * j]; xr[64 * j] = v * rstd * g; }
    }
}

struct Args { const float* in[11]; float* out; unsigned char* ws; int ph_lo, ph_hi, li, pad; };
__global__ void __launch_bounds__(NWAVES * 64, 2) mk_fwd(Args args) {
    extern __shared__ __attribute__((aligned(16))) unsigned char lds[];
    Frame F;
    F.lds = (LAS unsigned char*)lds;
    F.MISC = (volatile LAS unsigned*)(F.lds + MISC_OFF);
    F.wave = __builtin_amdgcn_readfirstlane((int)(threadIdx.x >> 6));
    F.G = gridDim.x; { const int bx = blockIdx.x; F.vcu = (F.G % 8 == 0) ? (bx % 8) * (F.G / 8) + bx / 8 : bx; }
#define GRID_BAR(seam) do { if (N_LAUNCHES == PER_PHASE) { if ((F.wave == 0 && mk_lane() == 0)) __hip_atomic_store(F.ctl + CW_TMO, 0xBADBA0u | (unsigned)(seam), RLX_AGENT); } \
    else { xcd_barrier(bar, F.wave); if (MK_REPEAT_PHASE == 30) xcd_barrier(bar, F.wave); } } while (0)
    unsigned char* ws = args.ws;
    F.ctl = (gu32*)(ws + WS_CTL);
    F.x = args.in[0]; F.attn_norm = args.in[1]; F.w_in = args.in[2]; F.moba_norm = args.in[3]; F.dil_norm = args.in[4]; F.w_out = args.in[5];
    F.ffn_norm = args.in[6]; F.w_gate = args.in[7]; F.w_up = args.in[8]; F.w_down = args.in[9]; F.final_norm = args.in[10]; F.out = args.out;
    F.Wqkv_t = (bf16*)(ws + WS_WQKV); F.Wo_t = (bf16*)(ws + WS_WO); F.Wgu_t = (bf16*)(ws + WS_WGU); F.Wd_t = (bf16*)(ws + WS_WD);
    F.QO = (bf16*)(ws + WS_QO); F.KB = (bf16*)(ws + WS_K); F.VB = (bf16*)(ws + WS_V); F.HB = ws + WS_H; F.XN8 = ws + WS_XN8; F.XN = (bf16*)(ws + WS_XN); F.OB = (bf16*)(ws + WS_O);
    F.rope = (float*)(ws + WS_ROPE); F.kpart = (float*)(ws + WS_KPART); F.ssqa = (float*)(ws + WS_SSQA); F.ssq1 = (float*)(ws + WS_SSQ1); F.ssq2 = (float*)(ws + WS_SSQ2);
    for (int u = F.wave * 64 + mk_lane(); u < (LDS_BYTES - LDSCTL_OFF) / 4; u += NWAVES * 64) ((LAS unsigned*)(F.lds + LDSCTL_OFF))[u] = 0u;
    __syncthreads();
    XcdBarrier bar; bar.bar = (unsigned*)(F.ctl + CW_BAR); bar.x = 0; bar.st = nullptr;
    if (N_LAUNCHES != PER_PHASE) bar = xcd_barrier_post((unsigned*)(F.ctl + CW_BAR), F.MISC + 8, F.wave);
    const int lo = args.ph_lo, hi = args.ph_hi;
#define IN(k) (lo <= (k) && (k) < hi)
#define BOTH(k) (IN(k) && IN((k) + 1))

    if (IN(0)) { for (int rp = 0; rp < (MK_REPEAT_PHASE == 0 ? 2 : 1); ++rp) p0_prologue(F); if (BOTH(0)) GRID_BAR(0); }

    if (IN(1)) {
        { pg8::Gemm g{F.XN, F.Wqkv_t, M, 1024, D}; pg8::StaticOrder S; S.init(M, 1024, F.G, (int)blockIdx.x, MK_REPEAT_PHASE == 1 ? 2 : 1);
          pg8::EpiQKV E{F.QO, (size_t)(WS_K - WS_QO) / 2, F.rope, F.kpart, QSCALE, 1, 1.f};
          pg8::gemm_phase<pg8::EpiQKV, pg8::StaticOrder, true, true>(F.lds + RING_OFF, g, S, E, F.wave); }
        { pg8::Gemm g{(const bf16*)F.XN8, (const bf16*)((const unsigned char*)F.Wqkv_t + QKV8_OFF), M, 2048, D}; pg8::StaticOrder S; S.init(M, 2048, F.G, (int)blockIdx.x, MK_REPEAT_PHASE == 1 ? 2 : 1);
          pg8::EpiQKV E{F.QO, (size_t)(WS_K - WS_QO) / 2, F.rope, F.kpart, QSCALE, 2, 1.f / (pg8::F8_SA * pg8::F8_SW)};
          pg8::gemm_phase<pg8::EpiQKV, pg8::StaticOrder, true, true, true>(F.lds + RING_OFF, g, S, E, F.wave); }
        if (BOTH(1)) GRID_BAR(1);
    }

    if (IN(2)) {
        if (F.G == 256) {
            for (int rp = 0; rp < (MK_REPEAT_PHASE == 2 ? 2 : 1); ++rp) attn_body::attn_phase<8>((char*)lds + RING_OFF, ws, (unsigned*)(F.ctl + CW_FAR), F.vcu, F.G, F.wave);
        }
        if (BOTH(2)) GRID_BAR(2);
    }

    if (IN(3)) {
        pg8::Gemm g{(const bf16*)(ws + WS_O8), F.Wo_t, M, D, D};   pg8::StaticOrder S; S.init(M, D, F.G, (int)blockIdx.x, MK_REPEAT_PHASE == 3 ? 2 : 1);
        pg8::EpiWo E{F.kpart + 131072, F.attn_norm, F.XN, F.XN8, F.ssqa, F.ssq1};
        pg8::gemm_phase<pg8::EpiWo, pg8::StaticOrder, true, true, true>(F.lds + RING_OFF, g, S, E, F.wave);
        if (BOTH(3)) GRID_BAR(3);
    }

    if (IN(4)) {
        pg8::Gemm g{(const bf16*)F.XN8, F.Wgu_t, M, NGU, D}; pg8::StaticOrder S; S.init(M, NGU, F.G, (int)blockIdx.x, MK_REPEAT_PHASE == 4 ? 2 : 1);
        pg8::EpiGU E{F.ssq1, F.HB};
        pg8::gemm_phase<pg8::EpiGU, pg8::StaticOrder, true, true, true>(F.lds + RING_OFF, g, S, E, F.wave);
        if (BOTH(4)) GRID_BAR(4);
    }

    if (IN(5)) {
        pg8::Gemm g{(const bf16*)F.HB, F.Wd_t, M, D, FF};   pg8::StaticOrder S; S.init(M, D, F.G, (int)blockIdx.x, MK_REPEAT_PHASE == 5 ? 2 : 1);
#if defined(MK_SPLIT_FINAL)
        pg8::EpiDown E{F.XN, F.out, F.ssq2};
        pg8::gemm_phase<pg8::EpiDown, pg8::StaticOrder, true, true, true>(F.lds + RING_OFF, g, S, E, F.wave);
        if (BOTH(5)) GRID_BAR(5);
#else
        if (F.G == 256) { pg8::EpiDownNorm E{F.XN, F.out, F.ssq2, (unsigned*)(F.ctl + CW_PANEL), F.final_norm};
            pg8::gemm_phase<pg8::EpiDownNorm, pg8::StaticOrder, true, true, true>(F.lds + RING_OFF, g, S, E, F.wave); }
        else { pg8::EpiDown E{F.XN, F.out, F.ssq2}; pg8::gemm_phase<pg8::EpiDown, pg8::StaticOrder, true, true, true>(F.lds + RING_OFF, g, S, E, F.wave); GRID_BAR(5); p6_final(F); }
#endif
    }

#if defined(MK_SPLIT_FINAL)
    if (IN(6)) { p6_final(F); }
#endif
#undef IN
#undef BOTH
}

extern "C" void kernel_launch(void* const* d_in, const int* in_sizes, int n_in, void* d_out, int out_size, void* d_ws, size_t ws_size, hipStream_t stream) {
    static int grid = 0;
    if (grid == 0) {
        if (n_in != 11 || in_sizes[0] != M * D || out_size != M * D || ws_size < WS_END) { fprintf(stderr, "kernel_launch: unexpected shapes (n_in %d, in0 %d, out %d, ws %zu); nothing launched\n", n_in, n_in > 0 ? in_sizes[0] : -1, out_size, ws_size); grid = -1; return; }
        int dev = 0, cus = 0, per_cu = 0;
        if (hipGetDevice(&dev) != hipSuccess || hipDeviceGetAttribute(&cus, hipDeviceAttributeMultiprocessorCount, dev) != hipSuccess) { grid = -1; return; }
        if (hipFuncSetAttribute((const void*)mk_fwd, hipFuncAttributeMaxDynamicSharedMemorySize, LDS_BYTES) != hipSuccess) { fprintf(stderr, "kernel_launch: hipFuncSetAttribute failed\n"); grid = -1; return; }
        if (hipOccupancyMaxActiveBlocksPerMultiprocessor(&per_cu, (const void*)mk_fwd, NWAVES * 64, LDS_BYTES) != hipSuccess || per_cu < 1) { fprintf(stderr, "kernel_launch: occupancy query says %d blocks per CU\n", per_cu); (void)hipGetLastError(); per_cu = 1; }
        grid = cus;
        if (grid > 256) grid = 256;
    }
    if (grid < 0) return;
    if (hipMemsetAsync((char*)d_ws + WS_CTL, 0, CTL_ZERO_BYTES, stream) != hipSuccess) { fprintf(stderr, "kernel_launch: hipMemsetAsync failed\n"); return; }
    Args a{};
    for (int i = 0; i < 11; ++i) a.in[i] = (const float*)d_in[i];
    a.out = (float*)d_out; a.ws = (unsigned char*)d_ws;
    for (int li = 0; li < N_LAUNCHES; ++li) {
        a.ph_lo = (N_LAUNCHES == PER_PHASE) ? li : 0; a.ph_hi = (N_LAUNCHES == PER_PHASE) ? li + 1 : PER_PHASE; a.li = li;
        hipLaunchKernelGGL(mk_fwd, dim3(grid), dim3(NWAVES * 64), LDS_BYTES, stream, a);
        const hipError_t le = hipPeekAtLastError();
        if (le != hipSuccess) { fprintf(stderr, "kernel_launch: launch %d failed: %s\n", li, hipGetErrorName(le)); break; }
    }
}
```

```cpp
#include <hip/hip_runtime.h>
#include <cstdio>
#include <cstdint>
namespace pg8 {
#define PG8_LAS __attribute__((address_space(3)))
typedef unsigned short bf16_t;
typedef short bf16x8 __attribute__((ext_vector_type(8)));
typedef float f32x4 __attribute__((ext_vector_type(4)));
typedef unsigned u32x4 __attribute__((ext_vector_type(4)));
typedef int i32x4 __attribute__((ext_vector_type(4)));
typedef int i32x8 __attribute__((ext_vector_type(8)));
typedef unsigned u32x2 __attribute__((ext_vector_type(2)));
constexpr int BM = 256, BK = 64, HALF = 128, HTB = HALF * BK * 2  , STAGE_BYTES = 8 * HTB, NXCD = 8, WGM = 8;

__host__ __device__ __forceinline__ int lds_byte(int r, int c) { const int st = (r >> 4) * 2 + (c >> 5), rr = r & 15, cc = c & 31, ob = rr * 64 + cc * 2; return st * 1024 + (ob ^ (((ob >> 9) & 1) << 5)); }
__host__ __device__ __forceinline__ void stage_rc(int b, int& R, int& C) { const int st = b / 1024, sb = b % 1024, swz = sb ^ (((sb >> 9) & 1) << 5); R = (st >> 1) * 16 + swz / 64; C = (st & 1) * 32 + (swz % 64) / 2; }
__host__ __device__ __forceinline__ int perm32(int rho) { const int n = rho >> 4, i = rho & 15; return 8 * (i >> 2) + 4 * n + (i & 3); }

struct Unit { int pm, pn; };
struct Gemm { const bf16_t* A; const bf16_t* Bt; int M, N, K; };

struct StaticOrder {
    int nM, nN, nwg, G, c, reps;
    __host__ __device__ void init(int M, int N, int G_, int c_, int reps_ = 1) { nM = M / BM; nN = N / BM; nwg = nM * nN; G = G_; c = c_; reps = reps_; }
    __host__ __device__ bool next(int i, Unit& u) const {
        const int rounds = (nwg + G - 1) / G; if (i >= reps * rounds) return false;
        const long L = (long)(i % rounds) * G + c; if (L >= nwg) return false;
        int wgid = (int)L; { const int q = nwg / NXCD, r = nwg % NXCD, xcd = wgid % NXCD, off = wgid / NXCD; wgid = (xcd < r ? xcd * (q + 1) : r * (q + 1) + (xcd - r) * q) + off; }
        const int nig = WGM * nN, gid = wgid / nig, fm = gid * WGM, gsz = (nM - fm) < WGM ? (nM - fm) : WGM;
        u.pm = fm + ((wgid % nig) % gsz); u.pn = (wgid % nig) / gsz; return true;
    }
    __device__ __forceinline__ void a_ready(const Unit&) const {}
    __device__ __forceinline__ void done(const Unit&) const {}
};


__device__ __forceinline__ unsigned cvt_pk_bf16(float lo, float hi) { unsigned r; asm volatile("v_cvt_pk_bf16_f32 %0, %1, %2" : "=v"(r) : "v"(lo), "v"(hi)); return r; }
__device__ __forceinline__ u32x4 pack8(const f32x4 a, const f32x4 b) { u32x4 w; w.x = cvt_pk_bf16(a[0], a[1]); w.y = cvt_pk_bf16(a[2], a[3]); w.z = cvt_pk_bf16(b[0], b[1]); w.w = cvt_pk_bf16(b[2], b[3]); return w; }
__device__ __forceinline__ float sum4(const f32x4 a) { return (a[0] + a[1]) + (a[2] + a[3]); }
__device__ __forceinline__ float sq4(const f32x4 a) { return (a[0] * a[0] + a[1] * a[1]) + (a[2] * a[2] + a[3] * a[3]); }
constexpr float RMS_EPS_F = 1e-6f;
__device__ __forceinline__ int lane_id() { int l; asm volatile("v_mbcnt_lo_u32_b32 %0, -1, 0\n\tv_mbcnt_hi_u32_b32 %0, -1, %0" : "=v"(l)); return l; }
__device__ __forceinline__ u32x2 pack8_fp8(const f32x4 a, const f32x4 b) { u32x2 w; unsigned t = 0;
    t = __builtin_amdgcn_cvt_pk_fp8_f32(a[0], a[1], t, false); t = __builtin_amdgcn_cvt_pk_fp8_f32(a[2], a[3], t, true); w.x = t; t = 0;
    t = __builtin_amdgcn_cvt_pk_fp8_f32(b[0], b[1], t, false); t = __builtin_amdgcn_cvt_pk_fp8_f32(b[2], b[3], t, true); w.y = t; return w; }
constexpr float F8_SA = 16.f, F8_SH = 8.f, F8_SW = 512.f, F8_SO = 64.f;
typedef float f32x2 __attribute__((ext_vector_type(2)));

struct EpiQKV {
    static constexpr bool PERM = true, AFTER_DRAIN = false, HAS_MID = false;
    bf16_t* Q; size_t part_stride; const float* rope; float* kpart; float qscale; int mapsel; float ascale;
    __device__ __forceinline__ void operator()(const f32x4 (&acc)[2][2][4][2], const Unit& u, int wr, int wc, int fr_, int fq_) const {
        const int ln_ = lane_id(), fr = ln_ & 15, fq = ln_ >> 4;
        const int rp = mapsel == 1 ? ((u.pn & 1) + 4 * (u.pn >> 1)) : (mapsel == 2 ? (u.pn < 4 ? (2 + (u.pn & 1) + 4 * (u.pn >> 1)) : u.pn + 4) : u.pn);
        const int part = rp >> 2, head = (rp & 3) * 4 + wc;
        bf16_t* base = Q + (size_t)part * part_stride + head * 64 + 8 * fq;
        const float sc = part == 0 ? qscale : 1.f;
        const bool rot = part != 2, km = (part == 1) && (head < 8);
        const int row0 = u.pm * BM + wr * 64 + fr;
        int rbase = row0; asm volatile("" : "+v"(rbase));
        f32x4 ks[2][2];
#pragma unroll
        for (int a = 0; a < 2; ++a)
#pragma unroll
            for (int b = 0; b < 2; ++b) ks[a][b] = (f32x4){0.f, 0.f, 0.f, 0.f};
#pragma unroll
        for (int ai = 0; ai < 2; ++ai)
#pragma unroll
            for (int m = 0; m < 4; ++m) {
                const int row = rbase + ai * HALF + m * 16;
                const int s = row & 4095;
                const f32x4* rp = (const f32x4*)(rope + ((size_t)s * 32 + 8 * fq) * 2);
                f32x4 t0, t1, t2, t3;
                if (rot) { t0 = rp[0]; t1 = rp[1]; t2 = rp[2]; t3 = rp[3]; } else { t0 = t1 = t2 = t3 = (f32x4){1.f, 0.f, 1.f, 0.f}; }
                f32x4 o1[2], o2[2];
#pragma unroll
                for (int n = 0; n < 2; ++n) {
                    const f32x4 cv = n == 0 ? (f32x4){t0[0], t0[2], t1[0], t1[2]} : (f32x4){t2[0], t2[2], t3[0], t3[2]};
                    const f32x4 sv = n == 0 ? (f32x4){t0[1], t0[3], t1[1], t1[3]} : (f32x4){t2[1], t2[3], t3[1], t3[3]};
                    const f32x4 x1 = acc[ai][0][m][n] * ascale, x2 = acc[ai][1][m][n] * ascale;
                    o1[n] = x1 * cv - x2 * sv; o2[n] = x2 * cv + x1 * sv;
                    if (km) { ks[0][n] += o1[n]; ks[1][n] += o2[n]; }
                    o1[n] = o1[n] * sc; o2[n] = o2[n] * sc;
                }
                bf16_t* rowp = base + (size_t)row * 1024;
                *(u32x4*)(rowp) = pack8(o1[0], o1[1]); *(u32x4*)(rowp + 32) = pack8(o2[0], o2[1]);
            }
        if (km) {
#pragma unroll
            for (int bj = 0; bj < 2; ++bj)
#pragma unroll
                for (int n = 0; n < 2; ++n) { f32x4 v = ks[bj][n];
#pragma unroll
                    for (int o = 1; o < 16; o <<= 1) { v[0] += __shfl_xor(v[0], o); v[1] += __shfl_xor(v[1], o); v[2] += __shfl_xor(v[2], o); v[3] += __shfl_xor(v[3], o); }
                    if (fr == 0) *(f32x4*)(kpart + (size_t)(u.pm * 2 + wr) * 512 + head * 64 + 32 * bj + 8 * fq + 4 * n) = v; }
        }
    }
};

struct EpiWo {
    static constexpr bool PERM = true, AFTER_DRAIN = false, HAS_MID = true;
    const float* rn0; const float* gain0; bf16_t* xn; unsigned char* xn8; const float* ssq_att; float* ssq1;
    __device__ __forceinline__ void rstds(int row, int fq, float& rm, float& rd) const {
        const float s = sum4(*(const f32x4*)(ssq_att + (size_t)row * 16 + 4 * fq));
        const float t = s + __shfl_xor(s, 16), o = __shfl_xor(t, 32);
        rm = __builtin_amdgcn_rsqf((fq < 2 ? t : o) * (1.f / 512.f) + RMS_EPS_F);
        rd = __builtin_amdgcn_rsqf((fq < 2 ? o : t) * (1.f / 512.f) + RMS_EPS_F);
    }
    static constexpr float ASCALE = 1.f / (F8_SO * F8_SW);
    __device__ __forceinline__ void mid(f32x4 (&acc)[2][2][4][2], const Unit& u, int wr, int fr_) const {
        const int ln_ = lane_id(), fr = ln_ & 15, fq = ln_ >> 4;
        const int row0 = u.pm * BM + wr * 64 + fr;
        int rbase = row0; asm volatile("" : "+v"(rbase));
#pragma unroll
        for (int ai = 0; ai < 2; ++ai)
#pragma unroll
            for (int m = 0; m < 4; ++m) { const int row = rbase + ai * HALF + m * 16; float rm, rd; rstds(row, fq, rm, rd); const float f = rm / rd;
#pragma unroll
                for (int bj = 0; bj < 2; ++bj)
#pragma unroll
                    for (int n = 0; n < 2; ++n) acc[ai][bj][m][n] = acc[ai][bj][m][n] * f;
                asm volatile("" ::: "memory"); }
    }
    __device__ __forceinline__ void operator()(const f32x4 (&acc)[2][2][4][2], const Unit& u, int wr, int wc, int fr_, int fq_) const {
        const int ln_ = lane_id(), fr = ln_ & 15, fq = ln_ >> 4;
        const int row0 = u.pm * BM + wr * 64 + fr, col0 = u.pn * BM + wc * 32 + 8 * fq;
        int rbase = row0; asm volatile("" : "+v"(rbase));
        f32x4 ig[2][2];
#pragma unroll
        for (int bj = 0; bj < 2; ++bj)
#pragma unroll
            for (int n = 0; n < 2; ++n) { const f32x4 g = *(const f32x4*)(gain0 + col0 + bj * HALF + 4 * n);
                ig[bj][n] = (f32x4){__builtin_amdgcn_rcpf(g[0]), __builtin_amdgcn_rcpf(g[1]), __builtin_amdgcn_rcpf(g[2]), __builtin_amdgcn_rcpf(g[3])}; }
#pragma unroll
        for (int ai = 0; ai < 2; ++ai)
#pragma unroll
            for (int m = 0; m < 4; ++m) { const int row = rbase + ai * HALF + m * 16; float rm, rd; rstds(row, fq, rm, rd); float s = 0.f; const float rn = rn0[row];
#pragma unroll
                for (int bj = 0; bj < 2; ++bj) { unsigned off = (unsigned)row * 1024u + col0 + bj * HALF; asm volatile("" : "+v"(off));
                    const u32x4 xw = *(const u32x4*)(xn + off);
                    const f32x4 xa = (f32x4){__uint_as_float(xw.x << 16), __uint_as_float(xw.x & 0xffff0000u), __uint_as_float(xw.y << 16), __uint_as_float(xw.y & 0xffff0000u)} * ig[bj][0] * rn;
                    const f32x4 xb = (f32x4){__uint_as_float(xw.z << 16), __uint_as_float(xw.z & 0xffff0000u), __uint_as_float(xw.w << 16), __uint_as_float(xw.w & 0xffff0000u)} * ig[bj][1] * rn;
                    const f32x4 v0 = xa + acc[ai][bj][m][0] * (rd * ASCALE), v1 = xb + acc[ai][bj][m][1] * (rd * ASCALE);
                    *(u32x4*)(xn + off) = pack8(v0, v1); *(u32x2*)(xn8 + off) = pack8_fp8(v0 * F8_SA, v1 * F8_SA); s += sq4(v0) + sq4(v1); }
                s += __shfl_xor(s, 16); s += __shfl_xor(s, 32);
                if (fq == 0) ssq1[(size_t)row * 16 + u.pn * 4 + wc] = s;
                asm volatile("" ::: "memory"); }
    }
};

struct EpiGU {
    static constexpr bool PERM = true, AFTER_DRAIN = false, HAS_MID = false;
    const float* ssq1; unsigned char* H;
    __device__ __forceinline__ void operator()(const f32x4 (&acc)[2][2][4][2], const Unit& u, int wr, int wc, int fr_, int fq_) const {
        const int ln_ = lane_id(), fr = ln_ & 15, fq = ln_ >> 4;
        const int row0 = u.pm * BM + wr * 64 + fr, col0 = u.pn * HALF + wc * 32 + 8 * fq;
        int rbase = row0; asm volatile("" : "+v"(rbase));
#pragma unroll
        for (int ai = 0; ai < 2; ++ai)
#pragma unroll
            for (int m = 0; m < 4; ++m) { const int row = rbase + ai * HALF + m * 16;
                float ss = sum4(*(const f32x4*)(ssq1 + (size_t)row * 16 + 4 * fq));
                ss += __shfl_xor(ss, 16); ss += __shfl_xor(ss, 32);
                const float rstd = __builtin_amdgcn_rsqf(ss * (1.f / 1024.f) + RMS_EPS_F) * (1.f / (F8_SA * F8_SW));
                f32x4 h[2];
                const float rs_e = rstd * -1.4426950408889634f, rs_u = rstd * (rstd * F8_SH);
#pragma unroll
                for (int n = 0; n < 2; ++n) { const f32x4 ea = acc[ai][0][m][n] * rs_e, gu = (acc[ai][0][m][n] * acc[ai][1][m][n]) * rs_u;
#pragma unroll
                    for (int i = 0; i < 4; ++i) h[n][i] = gu[i] * __builtin_amdgcn_rcpf(1.f + __builtin_amdgcn_exp2f(ea[i])); }
                *(u32x2*)(H + (size_t)row * 2816 + col0) = pack8_fp8(h[0], h[1]); }
    }
};

struct EpiDown {
    static constexpr bool PERM = true, AFTER_DRAIN = false, HAS_MID = false;
    const bf16_t* xn; float* out; float* ssq2;
    __device__ __forceinline__ void operator()(const f32x4 (&acc)[2][2][4][2], const Unit& u, int wr, int wc, int fr_, int fq_) const {
        const int ln_ = lane_id(), fr = ln_ & 15, fq = ln_ >> 4;
        const int row0 = u.pm * BM + wr * 64 + fr, col0 = u.pn * BM + wc * 32 + 8 * fq;
        int rbase = row0; asm volatile("" : "+v"(rbase));
#pragma unroll
        for (int ai = 0; ai < 2; ++ai)
#pragma unroll
            for (int m = 0; m < 4; ++m) { const int row = rbase + ai * HALF + m * 16; float s = 0.f;
#pragma unroll
                for (int bj = 0; bj < 2; ++bj) { const size_t off = (size_t)row * 1024 + col0 + bj * HALF;
                    const u32x4 xw = *(const u32x4*)(xn + off);
                    const f32x4 xa = {__uint_as_float(xw.x << 16), __uint_as_float(xw.x & 0xffff0000u), __uint_as_float(xw.y << 16), __uint_as_float(xw.y & 0xffff0000u)};
                    const f32x4 xb = {__uint_as_float(xw.z << 16), __uint_as_float(xw.z & 0xffff0000u), __uint_as_float(xw.w << 16), __uint_as_float(xw.w & 0xffff0000u)};
                    const f32x4 v0 = xa + acc[ai][bj][m][0] * (1.f / (F8_SH * F8_SW)), v1 = xb + acc[ai][bj][m][1] * (1.f / (F8_SH * F8_SW));
                    *(f32x4*)(out + off) = v0; *(f32x4*)(out + off + 4) = v1; s += sq4(v0) + sq4(v1); }
                s += __shfl_xor(s, 16); s += __shfl_xor(s, 32);
                if (fq == 0) ssq2[(size_t)row * 16 + u.pn * 4 + wc] = s;
                asm volatile("" ::: "memory"); }
    }
};

struct EpiDownNorm {
    static constexpr bool PERM = true, AFTER_DRAIN = false, HAS_MID = false;
    const bf16_t* xn; float* out; float* ssq2; unsigned* cnt; const float* gain;
    __device__ __forceinline__ void operator()(f32x4 (&acc)[2][2][4][2], const Unit& u, int wr, int wc, int fr_, int fq_) const {
        const int ln_ = lane_id(), fr = ln_ & 15, fq = ln_ >> 4;
        const int row0 = u.pm * BM + wr * 64 + fr, col0 = u.pn * BM + wc * 32 + 8 * fq;
        int rbase = row0; asm volatile("" : "+v"(rbase));
#pragma unroll
        for (int ai = 0; ai < 2; ++ai)
#pragma unroll
            for (int m = 0; m < 4; ++m) { const int row = rbase + ai * HALF + m * 16; float s = 0.f;
#pragma unroll
                for (int bj = 0; bj < 2; ++bj) { const size_t off = (size_t)row * 1024 + col0 + bj * HALF;
                    const u32x4 xw = *(const u32x4*)(xn + off);
                    const f32x4 xa = {__uint_as_float(xw.x << 16), __uint_as_float(xw.x & 0xffff0000u), __uint_as_float(xw.y << 16), __uint_as_float(xw.y & 0xffff0000u)};
                    const f32x4 xb = {__uint_as_float(xw.z << 16), __uint_as_float(xw.z & 0xffff0000u), __uint_as_float(xw.w << 16), __uint_as_float(xw.w & 0xffff0000u)};
                    acc[ai][bj][m][0] = acc[ai][bj][m][0] * (1.f / (F8_SH * F8_SW)) + xa; acc[ai][bj][m][1] = acc[ai][bj][m][1] * (1.f / (F8_SH * F8_SW)) + xb; s += sq4(acc[ai][bj][m][0]) + sq4(acc[ai][bj][m][1]); }
                s += __shfl_xor(s, 16); s += __shfl_xor(s, 32);
                if (fq == 0) __hip_atomic_store(ssq2 + (size_t)row * 16 + u.pn * 4 + wc, s, __ATOMIC_RELAXED, __HIP_MEMORY_SCOPE_AGENT);
                asm volatile("" ::: "memory"); }
        asm volatile("s_waitcnt vmcnt(0)" ::: "memory");
        unsigned* cw = cnt + 64 * u.pm;
        if (fr == 0 && fq == 0) __hip_atomic_fetch_add(cw, 1u, __ATOMIC_RELAXED, __HIP_MEMORY_SCOPE_AGENT);
        { unsigned sp = 0; while ((unsigned)__builtin_amdgcn_readfirstlane((int)__hip_atomic_load(cw, __ATOMIC_RELAXED, __HIP_MEMORY_SCOPE_AGENT)) < 32u) { __builtin_amdgcn_s_sleep(1); if (++sp > (1u << 22)) break; } }
        f32x4 g[2][2];
#pragma unroll
        for (int bj = 0; bj < 2; ++bj) { g[bj][0] = *(const f32x4*)(gain + col0 + bj * HALF); g[bj][1] = *(const f32x4*)(gain + col0 + bj * HALF + 4); }
#pragma unroll
        for (int ai = 0; ai < 2; ++ai)
#pragma unroll
            for (int m = 0; m < 4; ++m) { const int row = rbase + ai * HALF + m * 16;
                const unsigned long long* pp = (const unsigned long long*)(ssq2 + (size_t)row * 16 + 4 * fq);
                const unsigned long long w0 = __hip_atomic_load(pp, __ATOMIC_RELAXED, __HIP_MEMORY_SCOPE_AGENT), w1 = __hip_atomic_load(pp + 1, __ATOMIC_RELAXED, __HIP_MEMORY_SCOPE_AGENT);
                float s = (__uint_as_float((unsigned)w0) + __uint_as_float((unsigned)(w0 >> 32))) + (__uint_as_float((unsigned)w1) + __uint_as_float((unsigned)(w1 >> 32)));
                s += __shfl_xor(s, 16); s += __shfl_xor(s, 32);
                const float rstd = __builtin_amdgcn_rsqf(s * (1.f / 1024.f) + RMS_EPS_F);
#pragma unroll
                for (int bj = 0; bj < 2; ++bj) { const size_t off = (size_t)row * 1024 + col0 + bj * HALF;
                    *(f32x4*)(out + off) = acc[ai][bj][m][0] * rstd * g[bj][0]; *(f32x4*)(out + off + 4) = acc[ai][bj][m][1] * rstd * g[bj][1]; }
                asm volatile("" ::: "memory"); }
    }
};
template <class Epi, class Sched, bool ALIGN_EPI = false, bool SP2 = false, bool F8 = false>
__device__ __forceinline__ void gemm_phase(PG8_LAS unsigned char* lds, const Gemm g, const Sched& S, const Epi& E, int wave) {
    const int wid = __builtin_amdgcn_readfirstlane(wave), lane = lane_id(), tid = wid * 64 + lane, wr = wid >> 2, wc = wid & 3, fr = lane & 15, fq = lane >> 4;
    const int K = F8 ? g.K / 2 : g.K, nt = K / BK;
    unsigned voffA[2], voffB[2];
#pragma unroll
    for (int i = 0; i < 2; ++i) { int R, C; stage_rc(tid * 16 + i * 8192, R, C); const int Rb = Epi::PERM ? ((R & ~31) + perm32(R & 31)) : R;
        voffA[i] = (unsigned)(R * K + C) * 2u; voffB[i] = (unsigned)(Rb * K + C) * 2u; }
    const unsigned kstep = (unsigned)(BK * 2);
    const unsigned hstep = (unsigned)HALF * K * 2;
    const unsigned tstep = 2 * hstep;
    const unsigned ldsw = (unsigned)wid * 1024u;
    const int aoff = lds_byte(wr * 64 + fr, fq * 8), boff = lds_byte(wc * 32 + fr, fq * 8);
#define PG8_SA(b, h) (((b) * 2 + (h)) * HTB)
#define PG8_SB(b, h) ((4 + (b) * 2 + (h)) * HTB)
    const __amdgpu_buffer_rsrc_t rsA = __builtin_amdgcn_make_buffer_rsrc((void*)g.A, 0, 0x7fffffff, 0x00020000), rsB = __builtin_amdgcn_make_buffer_rsrc((void*)g.Bt, 0, 0x7fffffff, 0x00020000);
#define PG8_STAGE(bufoff, gbase, voff) do { _Pragma("unroll") for (int _i = 0; _i < 2; ++_i) \
        __builtin_amdgcn_raw_ptr_buffer_load_lds(PG8_RS_##voff, (PG8_LAS unsigned*)(lds + (bufoff) + ldsw + _i * 8192), 16, (voff)[_i], (int)(gbase), 0, 0); } while (0)
#define PG8_RS_voffA rsA
#define PG8_RS_voffB rsB
#define PG8_LD8(base, off) __builtin_shufflevector(*(const PG8_LAS i32x4*)((base) + (off)), *(const PG8_LAS i32x4*)((base) + (off) + 1024), 0, 1, 2, 3, 4, 5, 6, 7)
#define PG8_LDA(dst, b, h) do { if constexpr (F8) { _Pragma("unroll") for (int m = 0; m < 4; ++m) dst##8[m] = PG8_LD8(abase8, PG8_SA(b, h) + m * 2048); } else { \
        _Pragma("unroll") for (int m = 0; m < 4; ++m) _Pragma("unroll") for (int k = 0; k < 2; ++k) dst[m][k] = *(const PG8_LAS bf16x8*)(lds + PG8_SA(b, h) + aoff + m * 2048 + k * 1024); } } while (0)
#define PG8_LDB(dst, b, h) do { if constexpr (F8) { _Pragma("unroll") for (int n = 0; n < 2; ++n) dst##8[n] = PG8_LD8(bbase8, PG8_SB(b, h) - PG8_SB(0, 0) + n * 2048); } else { \
        _Pragma("unroll") for (int n = 0; n < 2; ++n) _Pragma("unroll") for (int k = 0; k < 2; ++k) dst[n][k] = *(const PG8_LAS bf16x8*)(lds + PG8_SB(b, h) + boff + n * 2048 + k * 1024); } } while (0)
#define PG8_MMA(ai, bj, At, Bt) do { __builtin_amdgcn_s_setprio(1); if constexpr (F8) { _Pragma("unroll") for (int m = 0; m < 4; ++m) _Pragma("unroll") for (int n = 0; n < 2; ++n) \
        acc[ai][bj][m][n] = __builtin_amdgcn_mfma_scale_f32_16x16x128_f8f6f4(Bt##8[n], At##8[m], acc[ai][bj][m][n], 0, 0, 0, 0, 0, 0); } else \
        _Pragma("unroll") for (int m = 0; m < 4; ++m) _Pragma("unroll") for (int n = 0; n < 2; ++n) _Pragma("unroll") for (int k = 0; k < 2; ++k) \
        acc[ai][bj][m][n] = __builtin_amdgcn_mfma_f32_16x16x32_bf16(Bt[n][k], At[m][k], acc[ai][bj][m][n], 0, 0, 0); __builtin_amdgcn_s_setprio(0); } while (0)
#define PG8_WAIT_V(n) asm volatile("s_waitcnt vmcnt(" #n ")" ::: "memory")
#define PG8_WAIT_L(n) asm volatile("s_waitcnt lgkmcnt(" #n ")" ::: "memory")
#define PG8_BAR __builtin_amdgcn_s_barrier()
#define PG8_SCHED __builtin_amdgcn_sched_barrier(0)
    Unit cur, nxt; int ui = 0;
    if (!S.next(0, cur)) return;
    f32x4 acc[2][2][4][2];
#pragma unroll
    for (int a = 0; a < 2; ++a)
#pragma unroll
        for (int b = 0; b < 2; ++b)
#pragma unroll
            for (int m = 0; m < 4; ++m)
#pragma unroll
                for (int n = 0; n < 2; ++n) acc[a][b][m][n] = (f32x4){0.f, 0.f, 0.f, 0.f};
    PG8_LAS unsigned char* abase8 = lds + aoff; PG8_LAS unsigned char* bbase8 = lds + PG8_SB(0, 0) + boff;
    if constexpr (F8) { asm volatile("" : "+v"(abase8)); asm volatile("" : "+v"(bbase8)); }
    bf16x8 At[4][2], B0[2][2], B1[2][2]; i32x8 At8[4], B08[2], B18[2];
    unsigned cA = (unsigned)cur.pm * tstep, cB = (unsigned)cur.pn * tstep;
    S.a_ready(cur);
    if constexpr (SP2) {
        PG8_STAGE(PG8_SB(0, 0), cB, voffB); PG8_STAGE(PG8_SB(0, 1), cB + hstep, voffB); PG8_STAGE(PG8_SA(0, 0), cA, voffA); PG8_STAGE(PG8_SA(0, 1), cA + hstep, voffA);
        if (wr == 1) PG8_BAR;
        PG8_WAIT_V(2); PG8_BAR;
        PG8_STAGE(PG8_SB(1, 0), cB + kstep, voffB); PG8_STAGE(PG8_SA(1, 0), cA + kstep, voffA); PG8_STAGE(PG8_SB(1, 1), cB + hstep + kstep, voffB);
        PG8_WAIT_V(6); PG8_BAR;
    } else {
        PG8_STAGE(PG8_SB(0, 0), cB, voffB); PG8_STAGE(PG8_SA(0, 0), cA, voffA); PG8_STAGE(PG8_SB(0, 1), cB + hstep, voffB); PG8_STAGE(PG8_SA(0, 1), cA + hstep, voffA);
        if (wr == 1) PG8_BAR;
        PG8_WAIT_V(4); PG8_BAR;
        PG8_STAGE(PG8_SB(1, 0), cB + kstep, voffB); PG8_STAGE(PG8_SA(1, 0), cA + kstep, voffA); PG8_STAGE(PG8_SB(1, 1), cB + hstep + kstep, voffB);
        PG8_WAIT_V(6); PG8_BAR;
    }
    for (;;) {
        const bool has_next = S.next(ui + 1, nxt);
        const unsigned nA = has_next ? (unsigned)nxt.pm * tstep : cA, nB = has_next ? (unsigned)nxt.pn * tstep : cB;
#pragma nounroll
        for (int t = 0; t < nt; t += 2) {
            if constexpr (Epi::HAS_MID) { if (t == (nt >> 1)) E.mid(acc, cur, wr, fr); }
            const bool last = (t == nt - 2);
            const unsigned a1 = cA + (unsigned)(t + 1) * kstep;
            const unsigned a2 = last ? nA : cA + (unsigned)(t + 2) * kstep, b2 = last ? nB : cB + (unsigned)(t + 2) * kstep;
            const unsigned a3 = a2 + kstep, b3 = b2 + kstep;
            if (last && has_next) S.a_ready(nxt);
            if constexpr (SP2) {
            PG8_LDB(B0, 0, 0); PG8_LDB(B1, 0, 1); PG8_SCHED; PG8_LDA(At, 0, 0); PG8_STAGE(PG8_SA(1, 1), a1 + hstep, voffA);
            PG8_WAIT_V(8); PG8_WAIT_L(0); PG8_BAR; PG8_MMA(0, 0, At, B0); PG8_MMA(0, 1, At, B1); PG8_BAR; PG8_SCHED;
            PG8_LDA(At, 0, 1); PG8_STAGE(PG8_SB(0, 0), b2, voffB); PG8_STAGE(PG8_SB(0, 1), b2 + hstep, voffB); PG8_STAGE(PG8_SA(0, 0), a2, voffA);
            PG8_WAIT_V(8); PG8_WAIT_L(0); PG8_BAR; PG8_MMA(1, 0, At, B0); PG8_MMA(1, 1, At, B1); PG8_BAR; PG8_SCHED;
            PG8_LDB(B0, 1, 0); PG8_LDB(B1, 1, 1); PG8_SCHED; PG8_LDA(At, 1, 0); PG8_STAGE(PG8_SA(0, 1), a2 + hstep, voffA);
            PG8_WAIT_V(8); PG8_WAIT_L(0); PG8_BAR; PG8_MMA(0, 0, At, B0); PG8_MMA(0, 1, At, B1); PG8_BAR; PG8_SCHED;
            PG8_LDA(At, 1, 1); PG8_STAGE(PG8_SB(1, 0), b3, voffB); PG8_STAGE(PG8_SB(1, 1), b3 + hstep, voffB); PG8_STAGE(PG8_SA(1, 0), a3, voffA);
            PG8_WAIT_V(8); PG8_WAIT_L(0); PG8_BAR; PG8_MMA(1, 0, At, B0); PG8_MMA(1, 1, At, B1); PG8_BAR; PG8_SCHED;
            } else {
            PG8_LDB(B0, 0, 0); PG8_SCHED; PG8_LDA(At, 0, 0); PG8_STAGE(PG8_SA(1, 1), a1 + hstep, voffA);
            PG8_WAIT_L(8); PG8_BAR; PG8_WAIT_L(0); PG8_MMA(0, 0, At, B0); PG8_BAR; PG8_SCHED;
            PG8_LDB(B1, 0, 1); PG8_STAGE(PG8_SB(0, 0), b2, voffB);
            PG8_BAR; PG8_WAIT_L(0); PG8_MMA(0, 1, At, B1); PG8_BAR;
            PG8_LDA(At, 0, 1); PG8_STAGE(PG8_SA(0, 0), a2, voffA);
            PG8_BAR; PG8_WAIT_L(0); PG8_MMA(1, 0, At, B0); PG8_BAR; PG8_SCHED;
            PG8_STAGE(PG8_SB(0, 1), b2 + hstep, voffB);
            PG8_WAIT_V(6); PG8_BAR; PG8_MMA(1, 1, At, B1); PG8_BAR;
            PG8_LDB(B0, 1, 0); PG8_SCHED; PG8_LDA(At, 1, 0); PG8_STAGE(PG8_SA(0, 1), a2 + hstep, voffA);
            PG8_WAIT_L(8); PG8_BAR; PG8_WAIT_L(0); PG8_MMA(0, 0, At, B0); PG8_BAR; PG8_SCHED;
            PG8_LDB(B1, 1, 1); PG8_STAGE(PG8_SB(1, 0), b3, voffB);
            PG8_BAR; PG8_WAIT_L(0); PG8_MMA(0, 1, At, B1); PG8_BAR;
            PG8_LDA(At, 1, 1); PG8_STAGE(PG8_SA(1, 0), a3, voffA);
            PG8_BAR; PG8_WAIT_L(0); PG8_MMA(1, 0, At, B0); PG8_BAR; PG8_SCHED;
            PG8_STAGE(PG8_SB(1, 1), b3 + hstep, voffB);
            PG8_WAIT_V(6); PG8_BAR; PG8_MMA(1, 1, At, B1); PG8_BAR;
            }
        }
        if constexpr (ALIGN_EPI) { if (wr == 0) PG8_BAR; }
        if constexpr (!Epi::AFTER_DRAIN) { E(acc, cur, wr, wc, fr, fq); S.done(cur); }
        if (!has_next) break;
#pragma unroll
        for (int a = 0; a < 2; ++a)
#pragma unroll
            for (int b = 0; b < 2; ++b)
#pragma unroll
                for (int m = 0; m < 4; ++m)
#pragma unroll
                    for (int n = 0; n < 2; ++n) acc[a][b][m][n] = (f32x4){0.f, 0.f, 0.f, 0.f};
        cur = nxt; cA = nA; cB = nB; ++ui;
        if constexpr (ALIGN_EPI) { if (wr == 1) PG8_BAR; }
    }
    PG8_WAIT_V(0);
    if constexpr (!ALIGN_EPI) { if (wr == 0) PG8_BAR; }
    PG8_BAR;
    if constexpr (Epi::AFTER_DRAIN) { E.fused(acc, cur, wr, wc, fr, fq, lds, wid, lane); S.done(cur); }
#undef PG8_SA
#undef PG8_SB
#undef PG8_STAGE
#undef PG8_RS_voffA
#undef PG8_RS_voffB
#undef PG8_LDA
#undef PG8_LDB
#undef PG8_MMA
#undef PG8_WAIT_V
#undef PG8_WAIT_L
#undef PG8_BAR
#undef PG8_SCHED
}
}

constexpr int NWAVES = 8;
#ifndef MK_N_LAUNCHES
#define MK_N_LAUNCHES 1
#endif
constexpr int PER_PHASE = 7;
constexpr int N_LAUNCHES = MK_N_LAUNCHES;

constexpr int BATCH = 8, SEQ = 4096, D = 1024, NH = 16, HD = 64, FF = 2816, NHM = 8;
constexpr int M = BATCH * SEQ;
constexpr int NQKV = 3 * D, NGU = 2 * FF;
constexpr float RMS_EPS = 1e-6f;
constexpr float QSCALE = 0.125f * 1.4426950408889634f;

constexpr size_t MiB = 1u << 20;
constexpr size_t WS_CTL = 0, CTL_ZERO_BYTES = 64 * 1024;
constexpr size_t WS_ROPE = 1 * MiB;
constexpr size_t WS_WQKV = 2 * MiB, WS_WO = 8 * MiB, WS_WGU = 10 * MiB, WS_WD = 21 * MiB;
constexpr size_t WS_KPART = 27 * MiB;
constexpr size_t WS_SSQA = 28 * MiB, WS_SSQ1 = 30 * MiB, WS_SSQ2 = 32 * MiB;
constexpr size_t WS_XN = 40 * MiB;
constexpr size_t WS_QO = 104 * MiB, WS_K = 168 * MiB, WS_V = 232 * MiB;
constexpr size_t WS_H = 104 * MiB;
#ifndef MK_REPEAT_PHASE
#define MK_REPEAT_PHASE -1
#endif
constexpr size_t WS_O = WS_QO;
constexpr size_t WS_FARO = 296 * MiB, WS_FARL = 328 * MiB;
constexpr size_t WS_XN8 = 330 * MiB;
constexpr size_t WS_O8 = 362 * MiB;
constexpr size_t WS_END = 394 * MiB;
constexpr size_t QKV8_OFF = 2 * MiB;
constexpr int CW_TMO = 0, CW_CODE = 1;
constexpr int CW_BAR = 4096;
constexpr int CW_PANEL = 8192;
constexpr int CW_FAR = 2048;

constexpr int RING_OFF = 0, RING_BYTES = 131072;
constexpr int LDSCTL_OFF = RING_BYTES, MISC_OFF = LDSCTL_OFF + 320;
constexpr int LDS_BYTES = 147456;
static_assert(WS_V - WS_K == WS_K - WS_QO, "Q | K | V equally spaced");
#define GAS __attribute__((address_space(1)))
#define LAS __attribute__((address_space(3)))
typedef unsigned short bf16;
typedef unsigned v4u __attribute__((ext_vector_type(4)));
typedef float f32x4 __attribute__((ext_vector_type(4)));
typedef short bf16x8 __attribute__((ext_vector_type(8)));
typedef GAS unsigned gu32;
typedef GAS unsigned long long gu64;
#define RLX_AGENT __ATOMIC_RELAXED, __HIP_MEMORY_SCOPE_AGENT
#define LDS_WAIT() asm volatile("s_waitcnt lgkmcnt(0)" ::: "memory")
#define VM_WAIT() asm volatile("s_waitcnt vmcnt(0)" ::: "memory")
__device__ __forceinline__ unsigned long long rt() { return __builtin_amdgcn_s_memrealtime(); }
__device__ __forceinline__ unsigned f2bf(float f) { unsigned u = __builtin_bit_cast(unsigned, f); return (u + 0x7fffu + ((u >> 16) & 1u)) >> 16; }
__device__ __forceinline__ unsigned pk2(float lo, float hi) { return f2bf(lo) | (f2bf(hi) << 16); }

#define XB_TMO      128
#define XB_XCNT(j)  (256  + 64 * (j))
#define XB_XSUB(j)  (1280 + 64 * (j))
#define XB_XGEN(j)  (2304 + 64 * (j))
#define XB_TOP      3328
#define XB_TOPGEN   3392
#define XCD_BAR_WORDS 3456
#define XB_SPIN_CAP (1u << 18)

__device__ __forceinline__ unsigned xb_ld(unsigned* p)              { return __hip_atomic_load(p, __ATOMIC_RELAXED, __HIP_MEMORY_SCOPE_AGENT); }
__device__ __forceinline__ unsigned xb_add(unsigned* p, unsigned v) { return __hip_atomic_fetch_add(p, v, __ATOMIC_RELAXED, __HIP_MEMORY_SCOPE_AGENT); }
__device__ __forceinline__ unsigned xb_xcc_id() { return (unsigned)__builtin_amdgcn_s_getreg((3 << 11) | 20) & 0xFu; }
#define XB_SPIN(cond, bar) do { unsigned _sp = 0; while (cond) { __builtin_amdgcn_s_sleep(1); \
    if ((++_sp & 255u) == 0u) { if (xb_ld(&(bar)[XB_TMO])) break; if (_sp > XB_SPIN_CAP) { atomicAdd(&(bar)[XB_TMO], 1u); break; } } } } while (0)

struct XcdBarrier {
    unsigned* bar; unsigned x;
    volatile LAS unsigned* st;
};

__device__ __forceinline__ int mk_lane() { int l; asm volatile("v_mbcnt_lo_u32_b32 %0, -1, 0\n\tv_mbcnt_hi_u32_b32 %0, -1, %0" : "=v"(l)); return l; }
__device__ __forceinline__ XcdBarrier xcd_barrier_post(unsigned* bar, volatile LAS unsigned* st, int wave) {
    XcdBarrier b; b.bar = bar; b.x = xb_xcc_id(); b.st = st;
    if (wave == 0 && mk_lane() == 0) (void)xb_add(&bar[XB_XCNT(b.x)], 1u);
    return b;
}
__device__ __forceinline__ void xcd_barrier_complete(unsigned* bar, unsigned x, unsigned& nloc, unsigned& nx) {
    const unsigned G = gridDim.x * gridDim.y * gridDim.z;
    unsigned sum, cnt, mine, sp = 0u;
    for (;;) {
        sum = 0u; cnt = 0u; mine = 0u;
#pragma unroll
        for (unsigned j = 0; j < 16; ++j) { const unsigned c = xb_ld(&bar[XB_XCNT(j)]); sum += c; cnt += (c > 0u) ? 1u : 0u; mine = (j == x) ? c : mine; }
        if (sum == G) break;
        __builtin_amdgcn_s_sleep(1);
        if ((++sp & 255u) == 0u) { if (xb_ld(&bar[XB_TMO])) break; if (sp > XB_SPIN_CAP) { atomicAdd(&bar[XB_TMO], 1u); break; } }
    }
    nloc = mine > 0u ? mine : 1u; nx = cnt > 0u ? cnt : 1u;
}

__device__ __forceinline__ void xcd_barrier(const XcdBarrier& b, int wave) {
    asm volatile("s_waitcnt vmcnt(0)" ::: "memory");
    __syncthreads();
    if (wave == 0 && mk_lane() == 0) {
        unsigned* bar = b.bar;
        __builtin_amdgcn_s_waitcnt(0);
        unsigned nloc = b.st[0], nx = b.st[1];
        if (nloc == 0u) { xcd_barrier_complete(bar, b.x, nloc, nx); b.st[0] = nloc; b.st[1] = nx; }
        const unsigned old = xb_add(&bar[XB_XSUB(b.x)], 1u);
        const unsigned gen = old / nloc;
        if (old + 1u == (gen + 1u) * nloc) {
            __builtin_amdgcn_fence(__ATOMIC_RELEASE, "agent");
            asm volatile("s_waitcnt vmcnt(0)" ::: "memory");
            const unsigned og = xb_add(&bar[XB_TOP], 1u);
            const unsigned tg = og / nx;
            if (og + 1u == (tg + 1u) * nx) xb_add(&bar[XB_TOPGEN], 1u);
            else XB_SPIN(xb_ld(&bar[XB_TOPGEN]) == tg, bar);
            __builtin_amdgcn_fence(__ATOMIC_ACQUIRE, "agent");
            xb_add(&bar[XB_XGEN(b.x)], 1u);
            asm volatile("s_waitcnt vmcnt(0)" ::: "memory");
        } else {
            XB_SPIN(xb_ld(&bar[XB_XGEN(b.x)]) == gen, bar);
            __builtin_amdgcn_fence(__ATOMIC_ACQUIRE, "agent");
            asm volatile("s_waitcnt vmcnt(0)" ::: "memory");
        }
    }
    __syncthreads();
}

#include <hip/hip_bf16.h>
#include <cmath>
namespace attn_body {
using bf16=__hip_bfloat16;
using bf16x8=__attribute__((ext_vector_type(8)))short;
using s16x4=__attribute__((ext_vector_type(4)))short;
using f32x16=__attribute__((ext_vector_type(16)))float;
using u32x4=__attribute__((ext_vector_type(4)))unsigned;
using f32x4_t=__attribute__((ext_vector_type(4)))float;
constexpr int BATCH=8,NHEAD=16,SEQ=4096,D=64,DM=NHEAD*D;
constexpr int NW=8,QBLK=32,QB=QBLK*NW,KVBLK=64,NQB=SEQ/QB;
constexpr int ATTN_PITCH=DM, ATTN_UNIT_ROWS=QB;
__device__ __forceinline__ int crow(int r,int hi){return (r&3)+8*(r>>2)+4*hi;}
#define SBAR() __builtin_amdgcn_sched_barrier(0)
__device__ __forceinline__ void cmask(f32x16&p0,f32x16&p1,int jb,int qrel,int hi){
  const float NEG=-INFINITY; int kb=64*jb+4*hi;
  #pragma unroll
  for(int r=0;r<16;++r){int kv=kb+(r&3)+8*(r>>2); if(kv>qrel)p0[r]=NEG; if(kv+32>qrel)p1[r]=NEG;}
}

__device__ __forceinline__ void dm_range(f32x16&p0,f32x16&p1,int x,unsigned bw){
  #pragma unroll
  for(int r=0;r<16;++r){ const int kp=(r&3)+8*(r>>2); if((unsigned)(x-kp)>bw)p0[r]=-1e30f; if((unsigned)(x-32-kp)>bw)p1[r]=-1e30f; } }
template<int KIND> __device__ __forceinline__ int dmode(int lo){
  if(KIND==2) return (lo+94<33||lo>128)?0:4;
  return (lo+94<0||lo>512)?0:((lo<0)?40:((lo+94<=128)?1:((lo<=128)?41:((lo+94<=512)?2:42)))); }
__device__ __forceinline__ void dm_adj128(f32x16&p0,f32x16&p1,int dqh,const f32x16&adj){
  #pragma unroll
  for(int r=0;r<16;++r){ const int kp=(r&3)+8*(r>>2); p0[r]+=(dqh-kp>128)?adj[r]:0.f; p1[r]+=(dqh-32-kp>128)?adj[r]:0.f; } }
__device__ __forceinline__ void fmask(f32x16&p0,f32x16&p1,int dq){
  #pragma unroll
  for(int r=0;r<16;++r){ const int kp=(r&3)+8*(r>>2); if((unsigned)(dq-kp-33)>95u)p0[r]=-1e30f; if((unsigned)(dq-kp-65)>95u)p1[r]=-1e30f; }
}
constexpr int NSLOT=3, SLOTB=8192;
constexpr int LDS_K=0, LDS_V=NSLOT*SLOTB, LDS_WS=2*NSLOT*SLOTB, LDS_OST=LDS_WS+NW*64*4, LDS_BYTES=LDS_OST+NW*4096;
constexpr int LDS_TAB=LDS_BYTES, TABB=4096, LDS_ALL=LDS_TAB+4*TABB;
constexpr float C2=0.125f*1.4426950408889634f;
__device__ __forceinline__ void glds16(const void*gsrc,unsigned lds_dst){unsigned keep;
  asm volatile("s_mov_b32 %0, m0\n\ts_mov_b32 m0, %2\n\ts_nop 0\n\tglobal_load_lds_dwordx4 %1, off\n\ts_mov_b32 m0, %0":"=&s"(keep):"v"(gsrc),"s"(lds_dst):"memory");}
__device__ __forceinline__ float max3f(float a,float b,float c){float r;asm("v_max3_f32 %0, %1, %2, %3":"=v"(r):"v"(a),"v"(b),"v"(c));return r;}
__device__ __forceinline__ float max2f(float a,float b){float r;asm("v_max_f32_e32 %0, %1, %2":"=v"(r):"v"(a),"v"(b));return r;}
__device__ __forceinline__ float fadd_s(float a,float b){float r;asm("v_add_f32_e32 %0, %1, %2":"=v"(r):"v"(a),"v"(b));return r;}
__device__ __forceinline__ float fsub_s(float a,float b){float r;asm("v_sub_f32_e32 %0, %1, %2":"=v"(r):"v"(a),"v"(b));return r;}
typedef float f32x2_t __attribute__((ext_vector_type(2))); typedef __bf16 bf16x2_t __attribute__((ext_vector_type(2)));
__device__ __forceinline__ unsigned cvtpk_s(float lo,float hi){f32x2_t v={lo,hi};bf16x2_t b=__builtin_convertvector(v,bf16x2_t);return __builtin_bit_cast(unsigned,b);}
#define WAIT_BAR(N) asm volatile("s_waitcnt vmcnt(" #N ") lgkmcnt(0)\n\ts_barrier":::"memory")

__device__ __forceinline__ void qkt(f32x16&p0,f32x16&p1,const char*Kslot,const bf16x8*qr,const f32x16&negm,int r32,int hi){
  const char*kb=Kslot+hi*1024+r32*16;
  #pragma unroll
  for(int d0=0;d0<4;++d0){
    const bf16x8 b0=*reinterpret_cast<const bf16x8*>(kb+d0*2048);
    const bf16x8 b1=*reinterpret_cast<const bf16x8*>(kb+d0*2048+512);
    if(d0==0){p0=__builtin_amdgcn_mfma_f32_32x32x16_bf16(b0,qr[0],negm,0,0,0);p1=__builtin_amdgcn_mfma_f32_32x32x16_bf16(b1,qr[0],negm,0,0,0);}
    else{p0=__builtin_amdgcn_mfma_f32_32x32x16_bf16(b0,qr[d0],p0,0,0,0);p1=__builtin_amdgcn_mfma_f32_32x32x16_bf16(b1,qr[d0],p1,0,0,0);}}
}
typedef __attribute__((address_space(3))) const char* lds_cptr;
typedef short v4i16_t __attribute__((ext_vector_type(4)));
__device__ __forceinline__ void kload8(bf16x8*kf,lds_cptr kp){
  kf[0]=*(const __attribute__((address_space(3))) bf16x8*)(kp);      kf[1]=*(const __attribute__((address_space(3))) bf16x8*)(kp+512);
  kf[2]=*(const __attribute__((address_space(3))) bf16x8*)(kp+2048); kf[3]=*(const __attribute__((address_space(3))) bf16x8*)(kp+2560);
  kf[4]=*(const __attribute__((address_space(3))) bf16x8*)(kp+4096); kf[5]=*(const __attribute__((address_space(3))) bf16x8*)(kp+4608);
  kf[6]=*(const __attribute__((address_space(3))) bf16x8*)(kp+6144); kf[7]=*(const __attribute__((address_space(3))) bf16x8*)(kp+6656);
}
__device__ __forceinline__ void kload2(bf16x8*kf,lds_cptr kp,int j){ kf[2*j]=*(const __attribute__((address_space(3))) bf16x8*)(kp+j*2048); kf[2*j+1]=*(const __attribute__((address_space(3))) bf16x8*)(kp+j*2048+512); }
__device__ __forceinline__ s16x4 vtr(lds_cptr p){ return __builtin_bit_cast(s16x4,__builtin_amdgcn_ds_read_tr16_b64_v4i16((__attribute__((address_space(3))) v4i16_t*)p)); }
__device__ __forceinline__ float rowmax(const f32x16&p0,const f32x16&p1){
  float a=max3f(p0[0],p0[1],p1[0]),b=max3f(p0[2],p0[3],p1[1]);a=max3f(a,p1[2],p1[3]);
  #pragma unroll
  for(int r=4;r<16;r+=4){a=max3f(a,p0[r],p0[r+1]);b=max3f(b,p0[r+2],p0[r+3]);a=max3f(a,p1[r],p1[r+1]);b=max3f(b,p1[r+2],p1[r+3]);}
  const float m=max2f(a,b);
  auto rr=__builtin_amdgcn_permlane32_swap(__float_as_uint(m),__float_as_uint(m),false,false);
  return max2f(__uint_as_float(rr[0]),__uint_as_float(rr[1]));
}
__device__ __forceinline__ void pv(f32x16*o,int vb,bf16x8 pa0,bf16x8 pa1,bf16x8 pa2,bf16x8 pa3){
  #pragma unroll
  for(int d0=0;d0<2;++d0){s16x4 lo[4],hi[4];
    #pragma unroll
    for(int ks=0;ks<4;++ks){
      asm volatile("ds_read_b64_tr_b16 %0,%1 offset:%c2":"=&v"(lo[ks]):"v"(vb),"i"(d0*4096+ks*1024):"memory");
      asm volatile("ds_read_b64_tr_b16 %0,%1 offset:%c2":"=&v"(hi[ks]):"v"(vb),"i"(d0*4096+ks*1024+512):"memory");}
    asm volatile("s_waitcnt lgkmcnt(0)":::"memory");SBAR();
    #define PK(k) (bf16x8){lo[k][0],lo[k][1],lo[k][2],lo[k][3],hi[k][0],hi[k][1],hi[k][2],hi[k][3]}
    o[d0]=__builtin_amdgcn_mfma_f32_32x32x16_bf16(pa0,PK(0),o[d0],0,0,0);
    o[d0]=__builtin_amdgcn_mfma_f32_32x32x16_bf16(pa1,PK(1),o[d0],0,0,0);
    o[d0]=__builtin_amdgcn_mfma_f32_32x32x16_bf16(pa2,PK(2),o[d0],0,0,0);
    o[d0]=__builtin_amdgcn_mfma_f32_32x32x16_bf16(pa3,PK(3),o[d0],0,0,0);
    #undef PK
  }
}

#ifndef ATTN_STORE16
#define ATTN_STORE16(p,v) asm volatile("global_store_dwordx4 %0, %1, off sc1\n\ts_nop 1"::"v"(p),"v"(v):"memory")
#endif
template<int THRL,int KIND> __device__ __forceinline__ void attn_unit(int b,int h,int qb,unsigned char*ws,char*shm,int wave,bf16x8 (&qr)[4],bool pre,bool has_next,int nkind,int nb,int nh,int nqb){
  const bf16*Q=(const bf16*)(ws+WS_QO); const bf16*K=(const bf16*)(ws+WS_K); const bf16*V=(const bf16*)(ws+WS_V); unsigned char*O8=ws+WS_O8;
  float*ssq=(float*)(ws+WS_SSQA); const float*kpart=(const float*)(ws+WS_KPART); unsigned short*faro=(unsigned short*)(ws+WS_FARO); float*farl=(float*)(ws+WS_FARL);
  constexpr bool DIL=(KIND==1), FAR=(KIND==2); constexpr int RS=FAR?16:1;
  int tid=wave*64+mk_lane(); asm volatile("":"+v"(tid));
  const int lane=tid&63,r32=lane&31,hi=lane>>5; const int wid=__builtin_amdgcn_readfirstlane(tid>>6);
  const int rowbase=b*SEQ+(FAR?qb:0);   const int q0=FAR?0:qb*QB;
  const bf16*Qw=Q+(rowbase+(int)(q0+wid*QBLK)*RS)*DM+h*D;
  const int T0=DIL?(qb>2?4*qb-8:0):0;
  const bf16*Kh=K+(rowbase+(int)T0*KVBLK)*DM+h*D,*Vh=V+(rowbase+(int)T0*KVBLK)*DM+h*D;
  const unsigned lds0=(unsigned)(uintptr_t)shm;
  float*wsf=(float*)(shm+LDS_WS)+wid*64;
  const bf16*ksrc=Kh+(int)lane*RS*DM+wid*8;
  const bf16*vsrc=Vh+(int)(16*(wid&3)+(lane>>2))*RS*DM+(wid>>2)*32+(lane&3)*8;
  const unsigned kdst=lds0+LDS_K+wid*1024, vdst=lds0+LDS_V+wid*1024;
  #define DMA_K(t,slot) glds16(ksrc+(int)(t)*KVBLK*RS*DM,(unsigned)__builtin_amdgcn_readfirstlane(kdst+(slot)))
  #define DMA_V(t,slot) glds16(vsrc+(int)(t)*KVBLK*RS*DM,(unsigned)__builtin_amdgcn_readfirstlane(vdst+(slot)))
  const int vb0=(int)(lds0+LDS_V)+((lane>>4)&1)*32+(lane&3)*8+(4*hi+((lane&15)>>2))*64;
  const char*Kbase=shm+LDS_K; bf16x8 kf[8];
  const lds_cptr shm3=(lds_cptr)shm; const lds_cptr kp0=shm3+LDS_K+hi*1024+r32*16; const lds_cptr vp0=shm3+LDS_V+((lane>>4)&1)*32+(lane&3)*8+(4*hi+((lane&15)>>2))*64;
  const int NT=FAR?4:(q0+QB)/KVBLK-T0;
  if(!pre)DMA_K(0,0); DMA_V(0,0); if(!pre)DMA_K(1,SLOTB);
  #pragma unroll
  for(int d0=0;d0<4;++d0)if(!pre)qr[d0]=*reinterpret_cast<const bf16x8*>(&Qw[(int)r32*RS*DM+d0*16+hi*8]);
  float mhat=0.f,l_reg=0.f;f32x16 o[2];o[0]=f32x16{};o[1]=f32x16{};
  const int qrel=wid*QBLK+r32;
  const lds_cptr tabp=(lds_cptr)shm+LDS_TAB+lane*64;
  unsigned selmask=1u<<qb;
  if(KIND==0){
    f32x16 g=f32x16{};
    #pragma unroll
    for(int d0=0;d0<4;++d0){ float km[8];
      if(r32<16){ const float*kp_=kpart+(unsigned)((b*16+r32)*2)*512+h*64+d0*16+hi*8;
        const f32x4_t a0=*(const f32x4_t*)kp_,a1=*(const f32x4_t*)(kp_+4),b0=*(const f32x4_t*)(kp_+512),b1=*(const f32x4_t*)(kp_+516);
        km[0]=a0[0]+b0[0];km[1]=a0[1]+b0[1];km[2]=a0[2]+b0[2];km[3]=a0[3]+b0[3];km[4]=a1[0]+b1[0];km[5]=a1[1]+b1[1];km[6]=a1[2]+b1[2];km[7]=a1[3]+b1[3]; }
      else{ _Pragma("unroll") for(int j=0;j<8;++j)km[j]=0.f; }
      u32x4 wh,wl; float rs[8];
      wh[0]=cvtpk_s(km[0],km[1]);wh[1]=cvtpk_s(km[2],km[3]);wh[2]=cvtpk_s(km[4],km[5]);wh[3]=cvtpk_s(km[6],km[7]);
      #pragma unroll
      for(int j=0;j<4;++j){ rs[2*j]=km[2*j]-__uint_as_float(wh[j]<<16); rs[2*j+1]=km[2*j+1]-__uint_as_float(wh[j]&0xffff0000u); }
      wl[0]=cvtpk_s(rs[0],rs[1]);wl[1]=cvtpk_s(rs[2],rs[3]);wl[2]=cvtpk_s(rs[4],rs[5]);wl[3]=cvtpk_s(rs[6],rs[7]);
      g=__builtin_amdgcn_mfma_f32_32x32x16_bf16(__builtin_bit_cast(bf16x8,wh),qr[d0],g,0,0,0);
      g=__builtin_amdgcn_mfma_f32_32x32x16_bf16(__builtin_bit_cast(bf16x8,wl),qr[d0],g,0,0,0); }
    float gv[16];
    #pragma unroll
    for(int r=0;r<8;++r){ const float own=g[r],oth=__shfl_xor(own,32); const int bl=(r&3)+8*(r>>2); gv[bl]=hi?oth:own; gv[bl+4]=hi?own:oth; }
    #pragma unroll
    for(int j=0;j<16;++j) if(j>=qb)gv[j]=-3e38f;
    #pragma unroll
    for(int rd=0;rd<3;++rd){ float best=-3e38f;int bi=0;
      #pragma unroll
      for(int j=0;j<16;++j){ if(gv[j]>best){best=gv[j];bi=j;} }
      if(best>-3e38f)selmask|=1u<<bi;
      #pragma unroll
      for(int j=0;j<16;++j) if(j==bi)gv[j]=-3e38f; }
  }
  const int lo0=FAR?(32*wid-63):(q0-T0*KVBLK+32*wid-63);
  #define DMODE(t) dmode<KIND>(lo0-(t)*KVBLK)
  #define CMASK(P0,P1,t) do{ if(DIL){ if(md_t>=40){ const int dqh_=q0-(T0+(t))*KVBLK+qrel-4*hi; \
        if(md_t==41){ const f32x16 adj_=*(const __attribute__((address_space(3))) f32x16*)(tabp+3*TABB); dm_adj128(P0,P1,dqh_,adj_); } \
        else dm_range(P0,P1,dqh_-((md_t==40)?0:-4096),(md_t==40)?0x7fffffffu:4608u); } } \
    else if(FAR){ if(md_t==4)fmask(P0,P1,qrel-(t)*KVBLK-4*hi); } \
    else { int jb_=(t)-(NT-4); if(jb_>=0)cmask(P0,P1,jb_,qrel,hi); } }while(0)
  #define SETC(t) f32x16 ct; const int md_t=(KIND==0)?0:DMODE(t); { if(DIL){ const int to_=(md_t==0)?0:((md_t==2||md_t==42)?2*TABB:TABB); \
      const f32x16 tb_=*(const __attribute__((address_space(3))) f32x16*)(tabp+to_); _Pragma("unroll") for(int r=0;r<16;++r)ct[r]=tb_[r]-mhat; } \
    else { const float x_=(FAR?(md_t!=0):(((selmask>>((t)>>2))&1u)!=0u))?-mhat:-1e30f; _Pragma("unroll") for(int r=0;r<16;++r)ct[r]=x_; } asm volatile("":"+v"(ct)); }
  bool resc=false;
  #define START(P0,P1) do{ const float rm=rowmax(P0,P1); resc=false; \
    if(__any(rm>(float)THRL)){ const float dl=__builtin_fmaxf(rm,0.f); mhat=fadd_s(mhat,dl); \
      _Pragma("unroll") for(int r=0;r<16;++r){P0[r]=fsub_s(P0[r],dl);P1[r]=fsub_s(P1[r],dl);} \
      const float f=__builtin_amdgcn_exp2f(-dl); l_reg*=f; if(hi==0)wsf[r32]=f; resc=true; } \
    _Pragma("unroll") for(int r=0;r<16;++r)P0[r]=__builtin_amdgcn_exp2f(P0[r]); }while(0)
  #define RESC() do{ if(resc){ asm volatile("s_waitcnt lgkmcnt(0)":::"memory"); \
      _Pragma("unroll") for(int d_=0;d_<2;++d_) _Pragma("unroll") for(int r=0;r<16;++r)o[d_][r]*=wsf[crow(r,hi)]; } }while(0)
  f32x16 pA0,pA1,pB0,pB1;
  int sl_prev=0,sl_cur=0,sl_next=SLOTB;
  #define ROT() do{sl_prev=sl_cur;sl_cur=sl_next;sl_next=(sl_next==(NSLOT-1)*SLOTB)?0:sl_next+SLOTB;}while(0)
  if(!pre){ DMA_K(2,2*SLOTB);
    WAIT_BAR(3); }
  else { WAIT_BAR(1); }
  if(0)WAIT_BAR(3);
  { SETC(0); qkt(pA0,pA1,Kbase,qr,ct,r32,hi); asm volatile("s_nop 15\n\ts_nop 7":"+v"(pA0),"+v"(pA1));CMASK(pA0,pA1,0); }
  START(pA0,pA1);
  _Pragma("unroll") for(int r=0;r<16;++r)pA1[r]=__builtin_amdgcn_exp2f(pA1[r]);
  WAIT_BAR(0);
  RESC();
  DMA_K(3,0);DMA_V(1,SLOTB);
  ROT();
  kload8(kf,kp0+sl_cur);
  WAIT_BAR(2);
  s16x4 vlo[8],vhi[8]; u32x4 pw0,pw1,pw2,pw3;
  #define PKW(P,B) cvtpk_s(P[B],P[B+1])
  #define PAF(k) __builtin_bit_cast(bf16x8,pw##k)
  #define VFR(i) (bf16x8){vlo[i][0],vlo[i][1],vlo[i][2],vlo[i][3],vhi[i][0],vhi[i][1],vhi[i][2],vhi[i][3]}
  #define PIN(x) asm volatile("":"+v"(x))
  #define MX3(a,b,c) __builtin_fmaxf(__builtin_fmaxf((a),(b)),(c))
  #define GAPA(MF,A0,A1,A2,A3,W0,W1,PW) do{ MF; sacc+=A0; sacc+=A1; sacc+=A2; sacc+=A3; PIN(sacc); W0; W1; PIN(PW); SBAR(); }while(0)
  #define EX(v) __builtin_amdgcn_exp2f(v)
  #define GAPB(MF,X,B) do{ MF; X[B]=EX(X[B]); X[B+1]=EX(X[B+1]); X[B+2]=EX(X[B+2]); X[B+3]=EX(X[B+3]); PIN(X); SBAR(); }while(0)
  #define VRD(i) do{ vlo[i]=vtr(vp_+(((i)>>2)*4096+((i)&3)*1024)); vhi[i]=vtr(vp_+(((i)>>2)*4096+((i)&3)*1024+512)); }while(0)
  #define KRD(G,j) do{ if(G){ kload2(kf,kp0+sl_next,j); SBAR(); } }while(0)
  #define STEP(C0,C1,P0,P1,t,GK,GV,GL) do{ SBAR(); SETC(t); SBAR(); \
    const lds_cptr vp_=vp0+sl_prev; \
    VRD(0); SBAR(); float sacc=(P0[0]+P0[1]); \
    GAPA(C0=__builtin_amdgcn_mfma_f32_32x32x16_bf16(kf[0],qr[0],ct,0,0,0), P0[2],P0[3],P0[4],P0[5],     pw0[0]=PKW(P0,0), pw0[1]=PKW(P0,2), pw0); \
    VRD(4); SBAR(); GAPA(C1=__builtin_amdgcn_mfma_f32_32x32x16_bf16(kf[1],qr[0],ct,0,0,0), P0[6],P0[7],P0[8],P0[9],     pw0[2]=PKW(P0,4), pw0[3]=PKW(P0,6), pw0); \
    VRD(1); SBAR(); GAPA(C0=__builtin_amdgcn_mfma_f32_32x32x16_bf16(kf[2],qr[1],C0,0,0,0),   P0[10],P0[11],P0[12],P0[13], pw1[0]=PKW(P0,8), pw1[1]=PKW(P0,10), pw1); \
    VRD(5); SBAR(); GAPA(C1=__builtin_amdgcn_mfma_f32_32x32x16_bf16(kf[3],qr[1],C1,0,0,0),   P0[14],P0[15],P1[0],P1[1],   pw1[2]=PKW(P0,12),pw1[3]=PKW(P0,14), pw1); \
    VRD(2); SBAR(); GAPA(C0=__builtin_amdgcn_mfma_f32_32x32x16_bf16(kf[4],qr[2],C0,0,0,0),   P1[2],P1[3],P1[4],P1[5],     pw2[0]=PKW(P1,0), pw2[1]=PKW(P1,2), pw2); \
    VRD(6); SBAR(); GAPA(C1=__builtin_amdgcn_mfma_f32_32x32x16_bf16(kf[5],qr[2],C1,0,0,0),   P1[6],P1[7],P1[8],P1[9],     pw2[2]=PKW(P1,4), pw2[3]=PKW(P1,6), pw2); \
    VRD(3); SBAR(); GAPA(C0=__builtin_amdgcn_mfma_f32_32x32x16_bf16(kf[6],qr[3],C0,0,0,0),   P1[10],P1[11],P1[12],P1[13], pw3[0]=PKW(P1,8), pw3[1]=PKW(P1,10), pw3); \
    VRD(7); SBAR(); GAPA(C1=__builtin_amdgcn_mfma_f32_32x32x16_bf16(kf[7],qr[3],C1,0,0,0),   P1[14],P1[15],0.f,0.f,       pw3[2]=PKW(P1,12),pw3[3]=PKW(P1,14), pw3); \
    l_reg+=sacc; \
    if(GK){DMA_K((t)+3,sl_cur);} if(GV){DMA_V((t)+1,sl_next);} \
    CMASK(C0,C1,t); \
    { float a=MX3(C0[0],C0[1],C1[0]),b=MX3(C0[2],C0[3],C1[1]); a=MX3(a,C1[2],C1[3]); \
      _Pragma("unroll") for(int r=4;r<16;r+=4){a=MX3(a,C0[r],C0[r+1]);b=MX3(b,C0[r+2],C0[r+3]);a=MX3(a,C1[r],C1[r+1]);b=MX3(b,C1[r+2],C1[r+3]);} \
      float rm=__builtin_fmaxf(a,b); { auto rr=__builtin_amdgcn_permlane32_swap(__float_as_uint(rm),__float_as_uint(rm),false,false); rm=__builtin_fmaxf(__uint_as_float(rr[0]),__uint_as_float(rr[1])); } \
      resc=false; \
      if(__builtin_expect(__any(rm>(float)THRL),0)){ const float dl=__builtin_fmaxf(rm,0.f); mhat+=dl; \
        _Pragma("unroll") for(int r=0;r<16;++r){C0[r]-=dl;C1[r]-=dl;} \
        const float f=__builtin_amdgcn_exp2f(-dl); l_reg*=f; if(hi==0)wsf[r32]=f; resc=true; } } \
    SBAR(); \
    GAPB(o[0]=__builtin_amdgcn_mfma_f32_32x32x16_bf16(PAF(0),VFR(0),o[0],0,0,0), C0,0); \
    GAPB(o[1]=__builtin_amdgcn_mfma_f32_32x32x16_bf16(PAF(0),VFR(4),o[1],0,0,0), C0,4); \
    KRD(GL,0); GAPB(o[0]=__builtin_amdgcn_mfma_f32_32x32x16_bf16(PAF(1),VFR(1),o[0],0,0,0), C0,8); \
    KRD(GL,1); GAPB(o[1]=__builtin_amdgcn_mfma_f32_32x32x16_bf16(PAF(1),VFR(5),o[1],0,0,0), C0,12); \
    KRD(GL,2); GAPB(o[0]=__builtin_amdgcn_mfma_f32_32x32x16_bf16(PAF(2),VFR(2),o[0],0,0,0), C1,0); \
    KRD(GL,3); GAPB(o[1]=__builtin_amdgcn_mfma_f32_32x32x16_bf16(PAF(2),VFR(6),o[1],0,0,0), C1,4); \
    GAPB(o[0]=__builtin_amdgcn_mfma_f32_32x32x16_bf16(PAF(3),VFR(3),o[0],0,0,0), C1,8); \
    GAPB(o[1]=__builtin_amdgcn_mfma_f32_32x32x16_bf16(PAF(3),VFR(7),o[1],0,0,0), C1,12); \
    }while(0)
  int t=1;
  for(;t+5<NT;t+=2){
    STEP(pB0,pB1,pA0,pA1,t,true,true,true);     WAIT_BAR(2); RESC(); ROT();
    STEP(pA0,pA1,pB0,pB1,t+1,true,true,true);   WAIT_BAR(2); RESC(); ROT();
  }
  #define ENDW(tt) do{ if((tt)+3<NT){WAIT_BAR(2);} else if((tt)+2<NT){WAIT_BAR(1);} else {WAIT_BAR(0);} }while(0)
  for(;t+1<NT;t+=2){
    STEP(pB0,pB1,pA0,pA1,t,(t+3<NT),(t+1<NT),(t+1<NT));       ENDW(t);   RESC(); ROT();
    STEP(pA0,pA1,pB0,pB1,t+1,(t+4<NT),(t+2<NT),(t+2<NT));     ENDW(t+1); RESC(); ROT();
  }
  if(has_next){
    const int nRS=(nkind==2)?16:1, nrowbase=nb*SEQ+((nkind==2)?nqb:0), nT0=(nkind==1)?(nqb>2?4*nqb-8:0):0;
    const bf16*nks=K+(nrowbase+(int)nT0*KVBLK)*DM+nh*D+(int)lane*nRS*DM+wid*8;
    glds16(nks,(unsigned)__builtin_amdgcn_readfirstlane(kdst)); glds16(nks+(int)KVBLK*nRS*DM,(unsigned)__builtin_amdgcn_readfirstlane(kdst+SLOTB)); glds16(nks+(int)2*KVBLK*nRS*DM,(unsigned)__builtin_amdgcn_readfirstlane(kdst+2*SLOTB)); }
  STEP(pB0,pB1,pA0,pA1,NT-1,false,false,false); RESC();
  if(has_next){
    const int nRS=(nkind==2)?16:1, nrowbase=nb*SEQ+((nkind==2)?nqb:0), nq0=(nkind==2)?0:nqb*QB; const bf16*nQw=Q+(nrowbase+(int)(nq0+wid*QBLK)*nRS)*DM+nh*D;
    #pragma unroll
    for(int d0=0;d0<4;++d0)qr[d0]=*reinterpret_cast<const bf16x8*>(&nQw[(int)r32*nRS*DM+d0*16+hi*8]); }
  { float sacc=pB0[0]+pB0[1]; _Pragma("unroll") for(int r=2;r<16;++r)sacc+=pB0[r]; _Pragma("unroll") for(int r=0;r<16;++r)sacc+=pB1[r]; l_reg+=sacc;
    pw0=(u32x4){PKW(pB0,0),PKW(pB0,2),PKW(pB0,4),PKW(pB0,6)};pw1=(u32x4){PKW(pB0,8),PKW(pB0,10),PKW(pB0,12),PKW(pB0,14)};pw2=(u32x4){PKW(pB1,0),PKW(pB1,2),PKW(pB1,4),PKW(pB1,6)};pw3=(u32x4){PKW(pB1,8),PKW(pB1,10),PKW(pB1,12),PKW(pB1,14)};
    SBAR(); pv(o,vb0+sl_cur,PAF(0),PAF(1),PAF(2),PAF(3)); }
  #undef PKW
  #undef PAF
  #undef VFR
  #undef PIN
  #undef MX3
  #undef GAPA
  #undef GAPB
  #undef EX
  #undef VRD
  #undef KRD
  #undef STEP
  #undef ENDW
  {auto rr=__builtin_amdgcn_permlane32_swap(__float_as_uint(l_reg),__float_as_uint(l_reg),false,false);l_reg=__uint_as_float(rr[0])+__uint_as_float(rr[1]);}
  int lane_e=lane; asm volatile("":"+v"(lane_e));
  u32x4 fch[4];
  if(DIL){
    const unsigned short*fp=faro+(unsigned)(rowbase+q0+wid*QBLK+(lane_e>>3))*512+(h-8)*D+(lane_e&7)*8;
    #pragma unroll
    for(int i=0;i<4;++i)fch[i]=*(const u32x4*)(fp+(unsigned)i*8*512);
    const float*lp=farl+((unsigned)(rowbase+q0+wid*QBLK+(lane_e&31))*8+(h-8))*2; const float lf_=lp[0],mf_=lp[1];
    const float M_=__builtin_fmaxf(mhat,mf_),sa_=__builtin_amdgcn_exp2f(mhat-M_),sb_=__builtin_amdgcn_exp2f(mf_-M_),rl_=__builtin_amdgcn_rcpf(l_reg*sa_+lf_*sb_);
    if(hi==0){wsf[32+r32]=sa_*rl_;wsf[r32]=sb_*rl_;} }
  else if(hi==0)wsf[32+r32]=FAR?1.f:__builtin_amdgcn_rcpf(l_reg);
  asm volatile("s_waitcnt lgkmcnt(0)":::"memory");
  float rli[16];
  #pragma unroll
  for(int r=0;r<16;++r)rli[r]=wsf[32+crow(r,hi)];
  constexpr int OP=FAR?512:DM;
  bf16*Ow=(bf16*)faro+(rowbase+(int)wid*QBLK*RS)*OP+(h-8)*D;
  unsigned char*O8w=O8+(rowbase+q0+wid*QBLK)*DM+h*D;
  if(FAR&&hi==0){ float*lp=farl+((unsigned)(rowbase+(int)qrel*RS)*8+(h-8))*2; __hip_atomic_store((unsigned long long*)lp,((unsigned long long)__float_as_uint(mhat)<<32)|__float_as_uint(l_reg),__ATOMIC_RELAXED,__HIP_MEMORY_SCOPE_AGENT); }
  { bf16*stg=(bf16*)(shm+LDS_OST)+wid*2048;
    #pragma unroll
    for(int r=0;r<16;++r){const int orow=crow(r,hi);
      #pragma unroll
      for(int d0=0;d0<2;++d0)stg[orow*64+d0*32+r32]=__float2bfloat16(o[d0][r]*rli[r]);}
    asm volatile("s_waitcnt lgkmcnt(0)":::"memory");
    #pragma unroll
    for(int i=0;i<4;++i){const int row=i*8+(lane_e>>3),ch=lane_e&7; u32x4 v=*(const u32x4*)(stg+row*64+ch*8);
      if(DIL){ const float fb_=wsf[row];
        #pragma unroll
        for(int j=0;j<4;++j){ const float a_=__uint_as_float(v[j]<<16)+__uint_as_float(fch[i][j]<<16)*fb_, b_=__uint_as_float(v[j]&0xffff0000u)+__uint_as_float(fch[i][j]&0xffff0000u)*fb_; v[j]=cvtpk_s(a_,b_); } }
      if(FAR){ ATTN_STORE16(Ow+(int)row*RS*OP+ch*8,v); }
      else { unsigned w0_=0,w1_=0;
        w0_=__builtin_amdgcn_cvt_pk_fp8_f32(__uint_as_float(v[0]<<16)*64.f,__uint_as_float(v[0]&0xffff0000u)*64.f,w0_,false); w0_=__builtin_amdgcn_cvt_pk_fp8_f32(__uint_as_float(v[1]<<16)*64.f,__uint_as_float(v[1]&0xffff0000u)*64.f,w0_,true);
        w1_=__builtin_amdgcn_cvt_pk_fp8_f32(__uint_as_float(v[2]<<16)*64.f,__uint_as_float(v[2]&0xffff0000u)*64.f,w1_,false); w1_=__builtin_amdgcn_cvt_pk_fp8_f32(__uint_as_float(v[3]<<16)*64.f,__uint_as_float(v[3]&0xffff0000u)*64.f,w1_,true);
        *(unsigned long long*)(O8w+(int)row*DM+ch*8)=((unsigned long long)w1_<<32)|w0_; }
      float sq=0.f;
      #pragma unroll
      for(int j=0;j<4;++j){ const float a_=__uint_as_float(v[j]<<16), b_=__uint_as_float(v[j]&0xffff0000u); sq+=a_*a_+b_*b_; }
      sq+=__shfl_xor(sq,1); sq+=__shfl_xor(sq,2); sq+=__shfl_xor(sq,4);
      if(!FAR&&ch==0)ssq[(unsigned)(rowbase+q0+wid*QBLK+row)*16+h]=sq; } }
  asm volatile("s_waitcnt lgkmcnt(0)\n\ts_barrier":::"memory");
  #undef DMA_K
  #undef DMA_V
  #undef CMASK
  #undef START
  #undef RESC
  #undef ROT
}
constexpr int ATTN_LDS_BYTES=LDS_BYTES;
__device__ __forceinline__ void attn_tables(char*lds,int wave){
  float*tb=(float*)(lds+LDS_TAB);
  for(int e=wave*64+mk_lane();e<64*16;e+=512){ const int ln=e>>4,r=e&15,r32=ln&31,hi=ln>>5; const int z4=r32&3,z16=((r32&15)-4*hi)&15;
    const bool in4=(z4==(r&3)),in16=(z16==((r&3)+8*((r>>2)&1)));
    tb[e]=-1e30f; tb[1024+e]=in16?1.5849625007f:(in4?1.f:0.f); tb[2048+e]=in16?1.f:(in4?0.f:-1e30f); tb[3072+e]=in16?(1.f-1.5849625007f):(in4?-1.f:-1e30f); }
  __syncthreads();
}
template<int THRL=8> __device__ __forceinline__ void attn_phase(char*lds,unsigned char*ws,unsigned*cnt,int vcu,int G,int wave){
  const int g=vcu>>2,b=g>>3,hm=g&7,c=vcu&3;
  attn_tables(lds,wave);
  bf16x8 qr[4];
  { const int n_=(MK_REPEAT_PHASE==22?8:4); for(int i=0;i<n_;++i) attn_unit<THRL,2>(b,8+hm,4*c+(i&3),ws,lds,wave,qr,i>0,true,(i+1<n_)?2:0,b,(i+1<n_)?8+hm:hm,(i+1<n_)?4*c+((i+1)&3):15-c); }
  asm volatile("s_waitcnt vmcnt(0)":::"memory"); __syncthreads();
  if(wave==0&&mk_lane()==0) __hip_atomic_fetch_add(cnt,1u,__ATOMIC_RELAXED,__HIP_MEMORY_SCOPE_AGENT);
  #define QBSEL(i_) ((((i_)&3)==0)?15-c:((((i_)&3)==1)?8+c:((((i_)&3)==2)?7-c:c)))
  { const int n_=(MK_REPEAT_PHASE==20?8:4); for(int ii=0;ii<n_;++ii) attn_unit<THRL,0>(b,hm,QBSEL(ii),ws,lds,wave,qr,true,true,(ii+1<n_)?0:1,b,(ii+1<n_)?hm:8+hm,QBSEL(ii+1)); }
  if(wave==0&&mk_lane()==0){ unsigned sp=0; while(__hip_atomic_load(cnt,__ATOMIC_RELAXED,__HIP_MEMORY_SCOPE_AGENT)<(unsigned)G){ __builtin_amdgcn_s_sleep(2); if(++sp>(1u<<22))break; }
    __builtin_amdgcn_fence(__ATOMIC_ACQUIRE,"agent"); asm volatile("s_waitcnt vmcnt(0)":::"memory"); }
  __syncthreads();
  { const int n_=(MK_REPEAT_PHASE==21?8:4); for(int ii=0;ii<n_;++ii) attn_unit<THRL,1>(b,8+hm,QBSEL(ii),ws,lds,wave,qr,true,ii+1<n_,1,b,8+hm,QBSEL(ii+1)); }
  #undef QBSEL
}
#undef SBAR
#undef WAIT_BAR
}

struct Frame {
    LAS unsigned char* lds;
    volatile LAS unsigned* MISC;
    gu32* ctl;
    int wave;
    int vcu, G;
    const float *x, *attn_norm, *w_in, *moba_norm, *dil_norm, *w_out, *ffn_norm, *w_gate, *w_up, *w_down, *final_norm;
    float* out;
    bf16 *Wqkv_t, *Wo_t, *Wgu_t, *Wd_t;
    bf16 *QO, *KB, *VB, *XN, *OB; unsigned char *HB, *XN8;
    float *rope, *kpart, *ssqa, *ssq1, *ssq2;
};

__device__ __forceinline__ float wave_sum(float v) {
#pragma unroll
    for (int o = 1; o < 64; o <<= 1) v += __shfl_xor(v, o);
    return v;
}
__device__ __forceinline__ int qkv_vrow(int n) { const int part = n >> 10, head = (n >> 6) & 15, d = n & 63; return 256 * (part * 4 + (head >> 2)) + 128 * (d >> 5) + 32 * (head & 3) + (d & 31); }
template <int MODE>
__device__ __forceinline__ void p0_item(const float* W, int K, int N, bf16* WT, const float* g0, const float* g1, LAS float* scr, int item, int lane) {
    const int nblk = N / 32, kb = item / nblk, nb = item % nblk, k0 = 64 * kb, n0 = 32 * nb;
#pragma unroll 8
    for (int i = 0; i < 32; ++i) { const int kk = 2 * i + (lane >> 5), k = k0 + kk; float w = W[(size_t)k * N + n0 + (lane & 31)];
        if (MODE == 1) w *= (k < 512 ? g0[k] : g1[k - 512]);
        if (MODE == 2 || MODE == 3) w *= g0[k];
        scr[kk * 33 + (lane & 31)] = w; }
    LDS_WAIT(); asm volatile("" ::: "memory");
    const int c = lane & 7;
#pragma unroll
    for (int j = 0; j < 4; ++j) { const int n = (lane >> 3) + 8 * j; const LAS float* s = scr + (8 * c) * 33 + n;
        const int ns = n0 + n; int dr;
        if (MODE == 0) dr = qkv_vrow(ns); else if (MODE == 2) dr = 256 * (ns >> 7) + (ns & 127); else if (MODE == 3) dr = 256 * (ns >> 7) + 128 + (ns & 127); else dr = ns;
        bool f8 = MODE >= 1; size_t base8 = 0;
        if (MODE == 0) {
            const int pn = dr >> 8, lo = dr & 255; f8 = !(pn < 8 && (pn & 3) < 2);
            dr = (f8 ? (pn < 8 ? ((pn & 1) + 2 * (pn >> 2)) : pn - 4) : ((pn & 1) + 2 * (pn >> 2))) * 256 + lo; base8 = (size_t)QKV8_OFF; }
        if (f8) {
            const pg8::f32x4 a = {s[0 * 33], s[1 * 33], s[2 * 33], s[3 * 33]}, b = {s[4 * 33], s[5 * 33], s[6 * 33], s[7 * 33]};
            *(GAS pg8::u32x2*)((unsigned char*)WT + base8 + (size_t)dr * K + k0 + 8 * c) = pg8::pack8_fp8(a * pg8::F8_SW, b * pg8::F8_SW);
        } else {
            v4u o; o.x = pk2(s[0 * 33], s[1 * 33]); o.y = pk2(s[2 * 33], s[3 * 33]); o.z = pk2(s[4 * 33], s[5 * 33]); o.w = pk2(s[6 * 33], s[7 * 33]);
            *(GAS v4u*)(WT + (size_t)dr * K + k0 + 8 * c) = o; } }
    LDS_WAIT(); asm volatile("" ::: "memory");
}
template <int R>
__device__ __forceinline__ void rms_rows_to_bf16(Frame& F, const float* xrow, const float* gain, bf16* orow, unsigned char* orow8, float* rn) {
    const GAS f32x4* xr = (const GAS f32x4*)xrow + mk_lane(); const GAS f32x4* gr = (const GAS f32x4*)gain + mk_lane();
    f32x4 v[R][4]; float s[R];
#pragma unroll
    for (int r = 0; r < R; ++r)
#pragma unroll
        for (int j = 0; j < 4; ++j) v[r][j] = xr[r * 256 + 64 * j];
#pragma unroll
    for (int r = 0; r < R; ++r) { s[r] = 0.f;
#pragma unroll
        for (int j = 0; j < 4; ++j) s[r] += (v[r][j].x * v[r][j].x + v[r][j].y * v[r][j].y) + (v[r][j].z * v[r][j].z + v[r][j].w * v[r][j].w); }
#pragma unroll
    for (int o = 1; o < 64; o <<= 1)
#pragma unroll
        for (int r = 0; r < R; ++r) s[r] += __shfl_xor(s[r], o);
    const int ln_ = mk_lane(); GAS unsigned long long* o8 = (GAS unsigned long long*)orow + ln_; GAS unsigned* q8 = (GAS unsigned*)orow8 + ln_;
#pragma unroll
    for (int r = 0; r < R; ++r) { const float rms = sqrtf(s[r] * (1.f / D) + RMS_EPS), rstd = 1.f / rms; if (ln_ == 0) rn[r] = rms;
#pragma unroll
        for (int j = 0; j < 4; ++j) { const f32x4 g = gr[64 * j];
            const f32x4 y = v[r][j] * rstd * g;
            o8[r * 256 + 64 * j] = (unsigned long long)pk2(y.x, y.y) | ((unsigned long long)pk2(y.z, y.w) << 32);
            unsigned t = 0; t = __builtin_amdgcn_cvt_pk_fp8_f32(y.x * pg8::F8_SA, y.y * pg8::F8_SA, t, false); t = __builtin_amdgcn_cvt_pk_fp8_f32(y.z * pg8::F8_SA, y.w * pg8::F8_SA, t, true); q8[r * 256 + 64 * j] = t; } }
}
__device__ __forceinline__ void p0_prologue(Frame& F) {
    LAS float* scr = (LAS float*)(F.lds + RING_OFF + F.wave * 16384);
    const int gw = F.vcu * NWAVES + F.wave, NGW = F.G * NWAVES;
    constexpr int I_IN = (D / 64) * (NQKV / 32), I_O = (D / 64) * (D / 32), I_G = (D / 64) * (FF / 32), I_D = (FF / 64) * (D / 32);
    constexpr int NITEMS = I_IN + I_O + 2 * I_G + I_D;
    for (int it = gw; it < NITEMS; it += NGW) {
        int r = it;
        if (r < I_IN) { p0_item<0>(F.w_in, D, NQKV, F.Wqkv_t, nullptr, nullptr, scr, r, mk_lane()); continue; } r -= I_IN;
        if (r < I_O) { p0_item<1>(F.w_out, D, D, F.Wo_t, F.moba_norm, F.dil_norm, scr, r, mk_lane()); continue; } r -= I_O;
        if (r < I_G) { p0_item<2>(F.w_gate, D, FF, F.Wgu_t, F.ffn_norm, nullptr, scr, r, mk_lane()); continue; } r -= I_G;
        if (r < I_G) { p0_item<3>(F.w_up, D, FF, F.Wgu_t, F.ffn_norm, nullptr, scr, r, mk_lane()); continue; } r -= I_G;
        p0_item<4>(F.w_down, FF, D, F.Wd_t, nullptr, nullptr, scr, r, mk_lane());
    }
    for (int e = (F.vcu * NWAVES * 64) + F.wave * 64 + mk_lane(); e < SEQ * 32; e += F.G * NWAVES * 64) {
        const int s = e >> 5, j = e & 31;
        const float invf = __builtin_amdgcn_exp2f(-(float)j * (13.287712379549449f / 32.0f));
        double rev = (double)s * (double)invf * 0.15915494309189535; rev -= __builtin_floor(rev);
        const float r = (float)rev;
        pg8::f32x2 cs; cs.x = __builtin_amdgcn_cosf(r); cs.y = __builtin_amdgcn_sinf(r);
        *(GAS pg8::f32x2*)((pg8::f32x2*)F.rope + e) = cs;
    }
    for (int m = 4 * gw; m < M; m += 4 * NGW) rms_rows_to_bf16<4>(F, F.x + (size_t)m * D, F.attn_norm, F.XN + (size_t)m * D, F.XN8 + (size_t)m * D, (float*)(F.kpart + 131072) + m);
}

__device__ __forceinline__ void p6_final(Frame& F) {
    const int gw = F.vcu * NWAVES + F.wave, NGW = F.G * NWAVES;
    const GAS f32x4* gr = (const GAS f32x4*)F.final_norm + mk_lane();
    for (int m = gw; m < M; m += NGW) {
        GAS f32x4* xr = (GAS f32x4*)(F.out + (size_t)m * D) + mk_lane();
        const GAS f32x4* sp = (const GAS f32x4*)(F.ssq2 + (size_t)m * 16);
        const f32x4 a = sp[0], b = sp[1], c = sp[2], d = sp[3];
        const float ss = ((a.x + a.y) + (a.z + a.w)) + ((b.x + b.y) + (b.z + b.w)) + ((c.x + c.y) + (c.z + c.w)) + ((d.x + d.y) + (d.z + d.w));
        const float rstd = 1.f / sqrtf(ss * (1.f / D) + RMS_EPS);
#pragma unroll
        for (int j = 0; j < 4; ++j) { const f32x4 v = xr[64 * j], g = gr[64 * j]; xr[64 * j] = v * rstd * g; }
    }
}

struct Args { const float* in[11]; float* out; unsigned char* ws; int ph_lo, ph_hi, li, pad; };
__global__ void __launch_bounds__(NWAVES * 64, 2) mk_fwd(Args args) {
    extern __shared__ __attribute__((aligned(16))) unsigned char lds[];
    Frame F;
    F.lds = (LAS unsigned char*)lds;
    F.MISC = (volatile LAS unsigned*)(F.lds + MISC_OFF);
    F.wave = __builtin_amdgcn_readfirstlane((int)(threadIdx.x >> 6));
    F.G = gridDim.x; { const int bx = blockIdx.x; F.vcu = (F.G % 8 == 0) ? (bx % 8) * (F.G / 8) + bx / 8 : bx; }
#define GRID_BAR(seam) do { if (N_LAUNCHES == PER_PHASE) { if ((F.wave == 0 && mk_lane() == 0)) __hip_atomic_store(F.ctl + CW_TMO, 0xBADBA0u | (unsigned)(seam), RLX_AGENT); } \
    else { xcd_barrier(bar, F.wave); if (MK_REPEAT_PHASE == 30) xcd_barrier(bar, F.wave); } } while (0)
    unsigned char* ws = args.ws;
    F.ctl = (gu32*)(ws + WS_CTL);
    F.x = args.in[0]; F.attn_norm = args.in[1]; F.w_in = args.in[2]; F.moba_norm = args.in[3]; F.dil_norm = args.in[4]; F.w_out = args.in[5];
    F.ffn_norm = args.in[6]; F.w_gate = args.in[7]; F.w_up = args.in[8]; F.w_down = args.in[9]; F.final_norm = args.in[10]; F.out = args.out;
    F.Wqkv_t = (bf16*)(ws + WS_WQKV); F.Wo_t = (bf16*)(ws + WS_WO); F.Wgu_t = (bf16*)(ws + WS_WGU); F.Wd_t = (bf16*)(ws + WS_WD);
    F.QO = (bf16*)(ws + WS_QO); F.KB = (bf16*)(ws + WS_K); F.VB = (bf16*)(ws + WS_V); F.HB = ws + WS_H; F.XN8 = ws + WS_XN8; F.XN = (bf16*)(ws + WS_XN); F.OB = (bf16*)(ws + WS_O);
    F.rope = (float*)(ws + WS_ROPE); F.kpart = (float*)(ws + WS_KPART); F.ssqa = (float*)(ws + WS_SSQA); F.ssq1 = (float*)(ws + WS_SSQ1); F.ssq2 = (float*)(ws + WS_SSQ2);
    for (int u = F.wave * 64 + mk_lane(); u < (LDS_BYTES - LDSCTL_OFF) / 4; u += NWAVES * 64) ((LAS unsigned*)(F.lds + LDSCTL_OFF))[u] = 0u;
    __syncthreads();
    XcdBarrier bar; bar.bar = (unsigned*)(F.ctl + CW_BAR); bar.x = 0; bar.st = nullptr;
    if (N_LAUNCHES != PER_PHASE) bar = xcd_barrier_post((unsigned*)(F.ctl + CW_BAR), F.MISC + 8, F.wave);
    const int lo = args.ph_lo, hi = args.ph_hi;
#define IN(k) (lo <= (k) && (k) < hi)
#define BOTH(k) (IN(k) && IN((k) + 1))

    if (IN(0)) { for (int rp = 0; rp < (MK_REPEAT_PHASE == 0 ? 2 : 1); ++rp) p0_prologue(F); if (BOTH(0)) GRID_BAR(0); }

    if (IN(1)) {
        { pg8::Gemm g{F.XN, F.Wqkv_t, M, 1024, D}; pg8::StaticOrder S; S.init(M, 1024, F.G, (int)blockIdx.x, MK_REPEAT_PHASE == 1 ? 2 : 1);
          pg8::EpiQKV E{F.QO, (size_t)(WS_K - WS_QO) / 2, F.rope, F.kpart, QSCALE, 1, 1.f};
          pg8::gemm_phase<pg8::EpiQKV, pg8::StaticOrder, true, true>(F.lds + RING_OFF, g, S, E, F.wave); }
        { pg8::Gemm g{(const bf16*)F.XN8, (const bf16*)((const unsigned char*)F.Wqkv_t + QKV8_OFF), M, 2048, D}; pg8::StaticOrder S; S.init(M, 2048, F.G, (int)blockIdx.x, MK_REPEAT_PHASE == 1 ? 2 : 1);
          pg8::EpiQKV E{F.QO, (size_t)(WS_K - WS_QO) / 2, F.rope, F.kpart, QSCALE, 2, 1.f / (pg8::F8_SA * pg8::F8_SW)};
          pg8::gemm_phase<pg8::EpiQKV, pg8::StaticOrder, true, true, true>(F.lds + RING_OFF, g, S, E, F.wave); }
        if (BOTH(1)) GRID_BAR(1);
    }

    if (IN(2)) {
        if (F.G == 256) {
            for (int rp = 0; rp < (MK_REPEAT_PHASE == 2 ? 2 : 1); ++rp) attn_body::attn_phase<8>((char*)lds + RING_OFF, ws, (unsigned*)(F.ctl + CW_FAR), F.vcu, F.G, F.wave);
        }
        if (BOTH(2)) GRID_BAR(2);
    }

    if (IN(3)) {
        pg8::Gemm g{(const bf16*)(ws + WS_O8), F.Wo_t, M, D, D};   pg8::StaticOrder S; S.init(M, D, F.G, (int)blockIdx.x, MK_REPEAT_PHASE == 3 ? 2 : 1);
        pg8::EpiWo E{F.kpart + 131072, F.attn_norm, F.XN, F.XN8, F.ssqa, F.ssq1};
        pg8::gemm_phase<pg8::EpiWo, pg8::StaticOrder, true, true, true>(F.lds + RING_OFF, g, S, E, F.wave);
        if (BOTH(3)) GRID_BAR(3);
    }

    if (IN(4)) {
        pg8::Gemm g{(const bf16*)F.XN8, F.Wgu_t, M, NGU, D}; pg8::StaticOrder S; S.init(M, NGU, F.G, (int)blockIdx.x, MK_REPEAT_PHASE == 4 ? 2 : 1);
        pg8::EpiGU E{F.ssq1, F.HB};
        pg8::gemm_phase<pg8::EpiGU, pg8::StaticOrder, true, true, true>(F.lds + RING_OFF, g, S, E, F.wave);
        if (BOTH(4)) GRID_BAR(4);
    }

    if (IN(5)) {
        pg8::Gemm g{(const bf16*)F.HB, F.Wd_t, M, D, FF};   pg8::StaticOrder S; S.init(M, D, F.G, (int)blockIdx.x, MK_REPEAT_PHASE == 5 ? 2 : 1);
#if defined(MK_SPLIT_FINAL)
        pg8::EpiDown E{F.XN, F.out, F.ssq2};
        pg8::gemm_phase<pg8::EpiDown, pg8::StaticOrder, true, true, true>(F.lds + RING_OFF, g, S, E, F.wave);
        if (BOTH(5)) GRID_BAR(5);
#else
        if (F.G == 256) { pg8::EpiDownNorm E{F.XN, F.out, F.ssq2, (unsigned*)(F.ctl + CW_PANEL), F.final_norm};
            pg8::gemm_phase<pg8::EpiDownNorm, pg8::StaticOrder, true, true, true>(F.lds + RING_OFF, g, S, E, F.wave); }
        else { pg8::EpiDown E{F.XN, F.out, F.ssq2}; pg8::gemm_phase<pg8::EpiDown, pg8::StaticOrder, true, true, true>(F.lds + RING_OFF, g, S, E, F.wave); GRID_BAR(5); p6_final(F); }
#endif
    }

#if defined(MK_SPLIT_FINAL)
    if (IN(6)) { p6_final(F); }
#endif
#undef IN
#undef BOTH
}

extern "C" void kernel_launch(void* const* d_in, const int* in_sizes, int n_in, void* d_out, int out_size, void* d_ws, size_t ws_size, hipStream_t stream) {
    static int grid = 0;
    if (grid == 0) {
        if (n_in != 11 || in_sizes[0] != M * D || out_size != M * D || ws_size < WS_END) { fprintf(stderr, "kernel_launch: unexpected shapes (n_in %d, in0 %d, out %d, ws %zu); nothing launched\n", n_in, n_in > 0 ? in_sizes[0] : -1, out_size, ws_size); grid = -1; return; }
        int dev = 0, cus = 0, per_cu = 0;
        if (hipGetDevice(&dev) != hipSuccess || hipDeviceGetAttribute(&cus, hipDeviceAttributeMultiprocessorCount, dev) != hipSuccess) { grid = -1; return; }
        if (hipFuncSetAttribute((const void*)mk_fwd, hipFuncAttributeMaxDynamicSharedMemorySize, LDS_BYTES) != hipSuccess) { fprintf(stderr, "kernel_launch: hipFuncSetAttribute failed\n"); grid = -1; return; }
        if (hipOccupancyMaxActiveBlocksPerMultiprocessor(&per_cu, (const void*)mk_fwd, NWAVES * 64, LDS_BYTES) != hipSuccess || per_cu < 1) { fprintf(stderr, "kernel_launch: occupancy query says %d blocks per CU\n", per_cu); (void)hipGetLastError(); per_cu = 1; }
        grid = cus;
        if (grid > 256) grid = 256;
    }
    if (grid < 0) return;
    if (hipMemsetAsync((char*)d_ws + WS_CTL, 0, CTL_ZERO_BYTES, stream) != hipSuccess) { fprintf(stderr, "kernel_launch: hipMemsetAsync failed\n"); return; }
    Args a{};
    for (int i = 0; i < 11; ++i) a.in[i] = (const float*)d_in[i];
    a.out = (float*)d_out; a.ws = (unsigned char*)d_ws;
    for (int li = 0; li < N_LAUNCHES; ++li) {
        a.ph_lo = (N_LAUNCHES == PER_PHASE) ? li : 0; a.ph_hi = (N_LAUNCHES == PER_PHASE) ? li + 1 : PER_PHASE; a.li = li;
        hipLaunchKernelGGL(mk_fwd, dim3(grid), dim3(NWAVES * 64), LDS_BYTES, stream, a);
        const hipError_t le = hipPeekAtLastError();
        if (le != hipSuccess) { fprintf(stderr, "kernel_launch: launch %d failed: %s\n", li, hipGetErrorName(le)); break; }
    }
}
```

```cpp
#include <hip/hip_runtime.h>
#include <cstdio>
#include <cstdint>
namespace pg8 {
#define PG8_LAS __attribute__((address_space(3)))
typedef unsigned short bf16_t;
typedef short bf16x8 __attribute__((ext_vector_type(8)));
typedef float f32x4 __attribute__((ext_vector_type(4)));
typedef unsigned u32x4 __attribute__((ext_vector_type(4)));
typedef int i32x4 __attribute__((ext_vector_type(4)));
typedef int i32x8 __attribute__((ext_vector_type(8)));
typedef unsigned u32x2 __attribute__((ext_vector_type(2)));
constexpr int BM = 256, BK = 64, HALF = 128, HTB = HALF * BK * 2  , STAGE_BYTES = 8 * HTB, NXCD = 8, WGM = 8;

__host__ __device__ __forceinline__ int lds_byte(int r, int c) { const int st = (r >> 4) * 2 + (c >> 5), rr = r & 15, cc = c & 31, ob = rr * 64 + cc * 2; return st * 1024 + (ob ^ (((ob >> 9) & 1) << 5)); }
__host__ __device__ __forceinline__ void stage_rc(int b, int& R, int& C) { const int st = b / 1024, sb = b % 1024, swz = sb ^ (((sb >> 9) & 1) << 5); R = (st >> 1) * 16 + swz / 64; C = (st & 1) * 32 + (swz % 64) / 2; }
__host__ __device__ __forceinline__ int perm32(int rho) { const int n = rho >> 4, i = rho & 15; return 8 * (i >> 2) + 4 * n + (i & 3); }

struct Unit { int pm, pn; };
struct Gemm { const bf16_t* A; const bf16_t* Bt; int M, N, K; };

struct StaticOrder {
    int nM, nN, nwg, G, c, reps;
    __host__ __device__ void init(int M, int N, int G_, int c_, int reps_ = 1) { nM = M / BM; nN = N / BM; nwg = nM * nN; G = G_; c = c_; reps = reps_; }
    __host__ __device__ bool next(int i, Unit& u) const {
        const int rounds = (nwg + G - 1) / G; if (i >= reps * rounds) return false;
        const long L = (long)(i % rounds) * G + c; if (L >= nwg) return false;
        int wgid = (int)L; { const int q = nwg / NXCD, r = nwg % NXCD, xcd = wgid % NXCD, off = wgid / NXCD; wgid = (xcd < r ? xcd * (q + 1) : r * (q + 1) + (xcd - r) * q) + off; }
        const int nig = WGM * nN, gid = wgid / nig, fm = gid * WGM, gsz = (nM - fm) < WGM ? (nM - fm) : WGM;
        u.pm = fm + ((wgid % nig) % gsz); u.pn = (wgid % nig) / gsz; return true;
    }
    __device__ __forceinline__ void a_ready(const Unit&) const {}
    __device__ __forceinline__ void done(const Unit&) const {}
};


__device__ __forceinline__ unsigned cvt_pk_bf16(float lo, float hi) { unsigned r; asm volatile("v_cvt_pk_bf16_f32 %0, %1, %2" : "=v"(r) : "v"(lo), "v"(hi)); return r; }
__device__ __forceinline__ u32x4 pack8(const f32x4 a, const f32x4 b) { u32x4 w; w.x = cvt_pk_bf16(a[0], a[1]); w.y = cvt_pk_bf16(a[2], a[3]); w.z = cvt_pk_bf16(b[0], b[1]); w.w = cvt_pk_bf16(b[2], b[3]); return w; }
__device__ __forceinline__ float sum4(const f32x4 a) { return (a[0] + a[1]) + (a[2] + a[3]); }
__device__ __forceinline__ float sq4(const f32x4 a) { return (a[0] * a[0] + a[1] * a[1]) + (a[2] * a[2] + a[3] * a[3]); }
constexpr float RMS_EPS_F = 1e-6f;
__device__ __forceinline__ int lane_id() { int l; asm volatile("v_mbcnt_lo_u32_b32 %0, -1, 0\n\tv_mbcnt_hi_u32_b32 %0, -1, %0" : "=v"(l)); return l; }
__device__ __forceinline__ u32x2 pack8_fp8(const f32x4 a, const f32x4 b) { u32x2 w; unsigned t = 0;
    t = __builtin_amdgcn_cvt_pk_fp8_f32(a[0], a[1], t, false); t = __builtin_amdgcn_cvt_pk_fp8_f32(a[2], a[3], t, true); w.x = t; t = 0;
    t = __builtin_amdgcn_cvt_pk_fp8_f32(b[0], b[1], t, false); t = __builtin_amdgcn_cvt_pk_fp8_f32(b[2], b[3], t, true); w.y = t; return w; }
constexpr float F8_SA = 16.f, F8_SH = 8.f, F8_SW = 512.f, F8_SO = 64.f;
typedef float f32x2 __attribute__((ext_vector_type(2)));

struct EpiQKV {
    static constexpr bool PERM = true, AFTER_DRAIN = false, HAS_MID = false;
    bf16_t* Q; size_t part_stride; const float* rope; float* kpart; float qscale; int mapsel; float ascale;
    __device__ __forceinline__ void operator()(const f32x4 (&acc)[2][2][4][2], const Unit& u, int wr, int wc, int fr_, int fq_) const {
        const int ln_ = lane_id(), fr = ln_ & 15, fq = ln_ >> 4;
        const int rp = mapsel == 1 ? ((u.pn & 1) + 4 * (u.pn >> 1)) : (mapsel == 2 ? (u.pn < 4 ? (2 + (u.pn & 1) + 4 * (u.pn >> 1)) : u.pn + 4) : u.pn);
        const int part = rp >> 2, head = (rp & 3) * 4 + wc;
        bf16_t* base = Q + (size_t)part * part_stride + head * 64 + 8 * fq;
        const float sc = part == 0 ? qscale : 1.f;
        const bool rot = part != 2, km = (part == 1) && (head < 8);
        const int row0 = u.pm * BM + wr * 64 + fr;
        int rbase = row0; asm volatile("" : "+v"(rbase));
        f32x4 ks[2][2];
#pragma unroll
        for (int a = 0; a < 2; ++a)
#pragma unroll
            for (int b = 0; b < 2; ++b) ks[a][b] = (f32x4){0.f, 0.f, 0.f, 0.f};
#pragma unroll
        for (int ai = 0; ai < 2; ++ai)
#pragma unroll
            for (int m = 0; m < 4; ++m) {
                const int row = rbase + ai * HALF + m * 16;
                const int s = row & 4095;
                const f32x4* rp = (const f32x4*)(rope + ((size_t)s * 32 + 8 * fq) * 2);
                f32x4 t0, t1, t2, t3;
                if (rot) { t0 = rp[0]; t1 = rp[1]; t2 = rp[2]; t3 = rp[3]; } else { t0 = t1 = t2 = t3 = (f32x4){1.f, 0.f, 1.f, 0.f}; }
                f32x4 o1[2], o2[2];
#pragma unroll
                for (int n = 0; n < 2; ++n) {
                    const f32x4 cv = n == 0 ? (f32x4){t0[0], t0[2], t1[0], t1[2]} : (f32x4){t2[0], t2[2], t3[0], t3[2]};
                    const f32x4 sv = n == 0 ? (f32x4){t0[1], t0[3], t1[1], t1[3]} : (f32x4){t2[1], t2[3], t3[1], t3[3]};
                    const f32x4 x1 = acc[ai][0][m][n] * ascale, x2 = acc[ai][1][m][n] * ascale;
                    o1[n] = x1 * cv - x2 * sv; o2[n] = x2 * cv + x1 * sv;
                    if (km) { ks[0][n] += o1[n]; ks[1][n] += o2[n]; }
                    o1[n] = o1[n] * sc; o2[n] = o2[n] * sc;
                }
                bf16_t* rowp = base + (size_t)row * 1024;
                *(u32x4*)(rowp) = pack8(o1[0], o1[1]); *(u32x4*)(rowp + 32) = pack8(o2[0], o2[1]);
            }
        if (km) {
#pragma unroll
            for (int bj = 0; bj < 2; ++bj)
#pragma unroll
                for (int n = 0; n < 2; ++n) { f32x4 v = ks[bj][n];
#pragma unroll
                    for (int o = 1; o < 16; o <<= 1) { v[0] += __shfl_xor(v[0], o); v[1] += __shfl_xor(v[1], o); v[2] += __shfl_xor(v[2], o); v[3] += __shfl_xor(v[3], o); }
                    if (fr == 0) *(f32x4*)(kpart + (size_t)(u.pm * 2 + wr) * 512 + head * 64 + 32 * bj + 8 * fq + 4 * n) = v; }
        }
    }
};

struct EpiWo {
    static constexpr bool PERM = true, AFTER_DRAIN = false, HAS_MID = true;
    const float* rn0; const float* gain0; bf16_t* xn; bf16_t* xo; unsigned char* xn8;
    const float* ssq_att; float* ssq1;
    __device__ __forceinline__ void rstds(int row, int fq, float& rm, float& rd) const {
        const float s = sum4(*(const f32x4*)(ssq_att + (size_t)row * 16 + 4 * fq));
        const float t = s + __shfl_xor(s, 16), o = __shfl_xor(t, 32);
        rm = __builtin_amdgcn_rsqf((fq < 2 ? t : o) * (1.f / 512.f) + RMS_EPS_F);
        rd = __builtin_amdgcn_rsqf((fq < 2 ? o : t) * (1.f / 512.f) + RMS_EPS_F);
    }
    static constexpr float ASCALE = 1.f / (F8_SO * F8_SW);
    __device__ __forceinline__ void mid(f32x4 (&acc)[2][2][4][2], const Unit& u, int wr, int fr_) const {
        const int ln_ = lane_id(), fr = ln_ & 15, fq = ln_ >> 4;
        const int row0 = u.pm * BM + wr * 64 + fr;
        int rbase = row0; asm volatile("" : "+v"(rbase));
        float f[8];
#pragma unroll
        for (int i = 0; i < 8; ++i) { float rm, rd; rstds(rbase + (i >> 2) * HALF + (i & 3) * 16, fq, rm, rd); f[i] = rm / rd; }
#pragma unroll
        for (int ai = 0; ai < 2; ++ai)
#pragma unroll
            for (int m = 0; m < 4; ++m)
#pragma unroll
                for (int bj = 0; bj < 2; ++bj)
#pragma unroll
                    for (int n = 0; n < 2; ++n) acc[ai][bj][m][n] = acc[ai][bj][m][n] * f[ai * 4 + m];
    }
    __device__ __forceinline__ void operator()(const f32x4 (&acc)[2][2][4][2], const Unit& u, int wr, int wc, int fr_, int fq_) const {
        const int ln_ = lane_id(), fr = ln_ & 15, fq = ln_ >> 4;
        const int row0 = u.pm * BM + wr * 64 + fr, col0 = u.pn * BM + wc * 32 + 8 * fq;
        int rbase = row0; asm volatile("" : "+v"(rbase));
        f32x4 ig[2][2];
#pragma unroll
        for (int bj = 0; bj < 2; ++bj)
#pragma unroll
            for (int n = 0; n < 2; ++n) { const f32x4 g = *(const f32x4*)(gain0 + col0 + bj * HALF + 4 * n);
                ig[bj][n] = (f32x4){__builtin_amdgcn_rcpf(g[0]), __builtin_amdgcn_rcpf(g[1]), __builtin_amdgcn_rcpf(g[2]), __builtin_amdgcn_rcpf(g[3])}; }
#pragma unroll
        for (int ai = 0; ai < 2; ++ai)
#pragma unroll
            for (int m = 0; m < 4; ++m) { const int row = rbase + ai * HALF + m * 16; float rm, rd; rstds(row, fq, rm, rd); float s = 0.f; const float rn = rn0[row];
#pragma unroll
                for (int bj = 0; bj < 2; ++bj) { unsigned off = (unsigned)row * 1024u + col0 + bj * HALF; asm volatile("" : "+v"(off));
                    const u32x4 xw = *(const u32x4*)(xn + off);
                    const f32x4 xa = (f32x4){__uint_as_float(xw.x << 16), __uint_as_float(xw.x & 0xffff0000u), __uint_as_float(xw.y << 16), __uint_as_float(xw.y & 0xffff0000u)} * ig[bj][0] * rn;
                    const f32x4 xb = (f32x4){__uint_as_float(xw.z << 16), __uint_as_float(xw.z & 0xffff0000u), __uint_as_float(xw.w << 16), __uint_as_float(xw.w & 0xffff0000u)} * ig[bj][1] * rn;
                    const f32x4 v0 = xa + acc[ai][bj][m][0] * (rd * ASCALE), v1 = xb + acc[ai][bj][m][1] * (rd * ASCALE);
                    *(u32x4*)(xo + off) = pack8(v0, v1); *(u32x2*)(xn8 + off) = pack8_fp8(v0 * F8_SA, v1 * F8_SA); s += sq4(v0) + sq4(v1); }
                s += __shfl_xor(s, 16); s += __shfl_xor(s, 32);
                if (fq == 0) ssq1[(size_t)row * 16 + u.pn * 4 + wc] = s;
                asm volatile("" ::: "memory"); }
    }
};

struct EpiGU {
    static constexpr bool PERM = true, AFTER_DRAIN = false, HAS_MID = false;
    const float* ssq1; unsigned char* H;
    __device__ __forceinline__ void operator()(const f32x4 (&acc)[2][2][4][2], const Unit& u, int wr, int wc, int fr_, int fq_) const {
        const int ln_ = lane_id(), fr = ln_ & 15, fq = ln_ >> 4;
        const int row0 = u.pm * BM + wr * 64 + fr, col0 = u.pn * HALF + wc * 32 + 8 * fq;
        int rbase = row0; asm volatile("" : "+v"(rbase));
#pragma unroll
        for (int ai = 0; ai < 2; ++ai)
#pragma unroll
            for (int m = 0; m < 4; ++m) { const int row = rbase + ai * HALF + m * 16;
                float ss = sum4(*(const f32x4*)(ssq1 + (size_t)row * 16 + 4 * fq));
                ss += __shfl_xor(ss, 16); ss += __shfl_xor(ss, 32);
                const float rstd = __builtin_amdgcn_rsqf(ss * (1.f / 1024.f) + RMS_EPS_F) * (1.f / (F8_SA * F8_SW));
                f32x4 h[2];
                const float rs_e = rstd * -1.4426950408889634f, rs_u = rstd * (rstd * F8_SH);
#pragma unroll
                for (int n = 0; n < 2; ++n) { const f32x4 ea = acc[ai][0][m][n] * rs_e, gu = (acc[ai][0][m][n] * acc[ai][1][m][n]) * rs_u;
#pragma unroll
                    for (int i = 0; i < 4; ++i) h[n][i] = gu[i] * __builtin_amdgcn_rcpf(1.f + __builtin_amdgcn_exp2f(ea[i])); }
                *(u32x2*)(H + (size_t)row * 2816 + col0) = pack8_fp8(h[0], h[1]); }
    }
};

struct EpiDown {
    static constexpr bool PERM = true, AFTER_DRAIN = false, HAS_MID = false;
    const bf16_t* xn; float* out; float* ssq2;
    __device__ __forceinline__ void operator()(const f32x4 (&acc)[2][2][4][2], const Unit& u, int wr, int wc, int fr_, int fq_) const {
        const int ln_ = lane_id(), fr = ln_ & 15, fq = ln_ >> 4;
        const int row0 = u.pm * BM + wr * 64 + fr, col0 = u.pn * BM + wc * 32 + 8 * fq;
        int rbase = row0; asm volatile("" : "+v"(rbase));
#pragma unroll
        for (int ai = 0; ai < 2; ++ai)
#pragma unroll
            for (int m = 0; m < 4; ++m) { const int row = rbase + ai * HALF + m * 16; float s = 0.f;
#pragma unroll
                for (int bj = 0; bj < 2; ++bj) { const size_t off = (size_t)row * 1024 + col0 + bj * HALF;
                    const u32x4 xw = *(const u32x4*)(xn + off);
                    const f32x4 xa = {__uint_as_float(xw.x << 16), __uint_as_float(xw.x & 0xffff0000u), __uint_as_float(xw.y << 16), __uint_as_float(xw.y & 0xffff0000u)};
                    const f32x4 xb = {__uint_as_float(xw.z << 16), __uint_as_float(xw.z & 0xffff0000u), __uint_as_float(xw.w << 16), __uint_as_float(xw.w & 0xffff0000u)};
                    const f32x4 v0 = xa + acc[ai][bj][m][0] * (1.f / (F8_SH * F8_SW)), v1 = xb + acc[ai][bj][m][1] * (1.f / (F8_SH * F8_SW));
                    *(f32x4*)(out + off) = v0; *(f32x4*)(out + off + 4) = v1; s += sq4(v0) + sq4(v1); }
                s += __shfl_xor(s, 16); s += __shfl_xor(s, 32);
                if (fq == 0) ssq2[(size_t)row * 16 + u.pn * 4 + wc] = s;
                asm volatile("" ::: "memory"); }
    }
};

struct EpiDownNorm {
    static constexpr bool PERM = true, AFTER_DRAIN = false, HAS_MID = false;
    const bf16_t* xn; float* out; float* ssq2; unsigned* cnt; const float* gain;
    __device__ __forceinline__ void operator()(f32x4 (&acc)[2][2][4][2], const Unit& u, int wr, int wc, int fr_, int fq_) const {
        const int ln_ = lane_id(), fr = ln_ & 15, fq = ln_ >> 4;
        const int row0 = u.pm * BM + wr * 64 + fr, col0 = u.pn * BM + wc * 32 + 8 * fq;
        int rbase = row0; asm volatile("" : "+v"(rbase));
#pragma unroll
        for (int ai = 0; ai < 2; ++ai)
#pragma unroll
            for (int m = 0; m < 4; ++m) { const int row = rbase + ai * HALF + m * 16; float s = 0.f;
#pragma unroll
                for (int bj = 0; bj < 2; ++bj) { const size_t off = (size_t)row * 1024 + col0 + bj * HALF;
                    const u32x4 xw = *(const u32x4*)(xn + off);
                    const f32x4 xa = {__uint_as_float(xw.x << 16), __uint_as_float(xw.x & 0xffff0000u), __uint_as_float(xw.y << 16), __uint_as_float(xw.y & 0xffff0000u)};
                    const f32x4 xb = {__uint_as_float(xw.z << 16), __uint_as_float(xw.z & 0xffff0000u), __uint_as_float(xw.w << 16), __uint_as_float(xw.w & 0xffff0000u)};
                    acc[ai][bj][m][0] = acc[ai][bj][m][0] * (1.f / (F8_SH * F8_SW)) + xa; acc[ai][bj][m][1] = acc[ai][bj][m][1] * (1.f / (F8_SH * F8_SW)) + xb; s += sq4(acc[ai][bj][m][0]) + sq4(acc[ai][bj][m][1]); }
                s += __shfl_xor(s, 16); s += __shfl_xor(s, 32);
                if (fq == 0) __hip_atomic_store(ssq2 + (size_t)(u.pn * 4 + wc) * 32768 + row, s, __ATOMIC_RELAXED, __HIP_MEMORY_SCOPE_AGENT);
                asm volatile("" ::: "memory"); }
        asm volatile("s_waitcnt vmcnt(0)" ::: "memory");
        unsigned* cw = cnt + 64 * u.pm;
        if (fr == 0 && fq == 0) __hip_atomic_fetch_add(cw, 1u, __ATOMIC_RELAXED, __HIP_MEMORY_SCOPE_AGENT);
        { unsigned sp = 0; while ((unsigned)__builtin_amdgcn_readfirstlane((int)__hip_atomic_load(cw, __ATOMIC_RELAXED, __HIP_MEMORY_SCOPE_AGENT)) < 32u) { __builtin_amdgcn_s_sleep(1); if (++sp > (1u << 22)) break; } }
        f32x4 g[2][2];
#pragma unroll
        for (int bj = 0; bj < 2; ++bj) { g[bj][0] = *(const f32x4*)(gain + col0 + bj * HALF); g[bj][1] = *(const f32x4*)(gain + col0 + bj * HALF + 4); }
#pragma unroll
        for (int ai = 0; ai < 2; ++ai)
#pragma unroll
            for (int m = 0; m < 4; ++m) { const int row = rbase + ai * HALF + m * 16;
                const float* pp = ssq2 + (size_t)(4 * fq) * 32768 + row;
                float s = (__hip_atomic_load(pp, __ATOMIC_RELAXED, __HIP_MEMORY_SCOPE_AGENT) + __hip_atomic_load(pp + 32768, __ATOMIC_RELAXED, __HIP_MEMORY_SCOPE_AGENT))
                        + (__hip_atomic_load(pp + 2 * 32768, __ATOMIC_RELAXED, __HIP_MEMORY_SCOPE_AGENT) + __hip_atomic_load(pp + 3 * 32768, __ATOMIC_RELAXED, __HIP_MEMORY_SCOPE_AGENT));
                s += __shfl_xor(s, 16); s += __shfl_xor(s, 32);
                const float rstd = __builtin_amdgcn_rsqf(s * (1.f / 1024.f) + RMS_EPS_F);
#pragma unroll
                for (int bj = 0; bj < 2; ++bj) { const size_t off = (size_t)row * 1024 + col0 + bj * HALF;
                    *(f32x4*)(out + off) = acc[ai][bj][m][0] * rstd * g[bj][0]; *(f32x4*)(out + off + 4) = acc[ai][bj][m][1] * rstd * g[bj][1]; }
                asm volatile("" ::: "memory"); }
    }
};
template <class Epi, class Sched, bool ALIGN_EPI = false, bool SP2 = false, bool F8 = false>
__device__ __forceinline__ void gemm_phase(PG8_LAS unsigned char* lds, const Gemm g, const Sched& S, const Epi& E, int wave) {
    const int wid = __builtin_amdgcn_readfirstlane(wave), lane = lane_id(), tid = wid * 64 + lane, wr = wid >> 2, wc = wid & 3, fr = lane & 15, fq = lane >> 4;
    const int K = F8 ? g.K / 2 : g.K, nt = K / BK;
    unsigned voffA[2], voffB[2];
#pragma unroll
    for (int i = 0; i < 2; ++i) { int R, C; stage_rc(tid * 16 + i * 8192, R, C); const int Rb = Epi::PERM ? ((R & ~31) + perm32(R & 31)) : R;
        voffA[i] = (unsigned)(R * K + C) * 2u; voffB[i] = (unsigned)(Rb * K + C) * 2u; }
    const unsigned kstep = (unsigned)(BK * 2);
    const unsigned hstep = (unsigned)HALF * K * 2;
    const unsigned tstep = 2 * hstep;
    const unsigned ldsw = (unsigned)wid * 1024u;
    const int aoff = lds_byte(wr * 64 + fr, fq * 8), boff = lds_byte(wc * 32 + fr, fq * 8);
#define PG8_SA(b, h) (((b) * 2 + (h)) * HTB)
#define PG8_SB(b, h) ((4 + (b) * 2 + (h)) * HTB)
    const __amdgpu_buffer_rsrc_t rsA = __builtin_amdgcn_make_buffer_rsrc((void*)g.A, 0, 0x7fffffff, 0x00020000), rsB = __builtin_amdgcn_make_buffer_rsrc((void*)g.Bt, 0, 0x7fffffff, 0x00020000);
#define PG8_STAGE(bufoff, gbase, voff) do { _Pragma("unroll") for (int _i = 0; _i < 2; ++_i) \
        __builtin_amdgcn_raw_ptr_buffer_load_lds(PG8_RS_##voff, (PG8_LAS unsigned*)(lds + (bufoff) + ldsw + _i * 8192), 16, (voff)[_i], (int)(gbase), 0, 0); } while (0)
#define PG8_RS_voffA rsA
#define PG8_RS_voffB rsB
#define PG8_LD8(base, off) __builtin_shufflevector(*(const PG8_LAS i32x4*)((base) + (off)), *(const PG8_LAS i32x4*)((base) + (off) + 1024), 0, 1, 2, 3, 4, 5, 6, 7)
#define PG8_LDA(dst, b, h) do { if constexpr (F8) { _Pragma("unroll") for (int m = 0; m < 4; ++m) dst##8[m] = PG8_LD8(abase8, PG8_SA(b, h) + m * 2048); } else { \
        _Pragma("unroll") for (int m = 0; m < 4; ++m) _Pragma("unroll") for (int k = 0; k < 2; ++k) dst[m][k] = *(const PG8_LAS bf16x8*)(lds + PG8_SA(b, h) + aoff + m * 2048 + k * 1024); } } while (0)
#define PG8_LDB(dst, b, h) do { if constexpr (F8) { _Pragma("unroll") for (int n = 0; n < 2; ++n) dst##8[n] = PG8_LD8(bbase8, PG8_SB(b, h) - PG8_SB(0, 0) + n * 2048); } else { \
        _Pragma("unroll") for (int n = 0; n < 2; ++n) _Pragma("unroll") for (int k = 0; k < 2; ++k) dst[n][k] = *(const PG8_LAS bf16x8*)(lds + PG8_SB(b, h) + boff + n * 2048 + k * 1024); } } while (0)
#define PG8_MMA(ai, bj, At, Bt) do { __builtin_amdgcn_s_setprio(1); if constexpr (F8) { _Pragma("unroll") for (int m = 0; m < 4; ++m) _Pragma("unroll") for (int n = 0; n < 2; ++n) \
        acc[ai][bj][m][n] = __builtin_amdgcn_mfma_scale_f32_16x16x128_f8f6f4(Bt##8[n], At##8[m], acc[ai][bj][m][n], 0, 0, 0, 0, 0, 0); } else \
        _Pragma("unroll") for (int m = 0; m < 4; ++m) _Pragma("unroll") for (int n = 0; n < 2; ++n) _Pragma("unroll") for (int k = 0; k < 2; ++k) \
        acc[ai][bj][m][n] = __builtin_amdgcn_mfma_f32_16x16x32_bf16(Bt[n][k], At[m][k], acc[ai][bj][m][n], 0, 0, 0); __builtin_amdgcn_s_setprio(0); } while (0)
#define PG8_WAIT_V(n) asm volatile("s_waitcnt vmcnt(" #n ")" ::: "memory")
#define PG8_WAIT_L(n) asm volatile("s_waitcnt lgkmcnt(" #n ")" ::: "memory")
#define PG8_BAR __builtin_amdgcn_s_barrier()
#define PG8_SCHED __builtin_amdgcn_sched_barrier(0)
    Unit cur, nxt; int ui = 0;
    if (!S.next(0, cur)) return;
    f32x4 acc[2][2][4][2];
#pragma unroll
    for (int a = 0; a < 2; ++a)
#pragma unroll
        for (int b = 0; b < 2; ++b)
#pragma unroll
            for (int m = 0; m < 4; ++m)
#pragma unroll
                for (int n = 0; n < 2; ++n) acc[a][b][m][n] = (f32x4){0.f, 0.f, 0.f, 0.f};
    PG8_LAS unsigned char* abase8 = lds + aoff; PG8_LAS unsigned char* bbase8 = lds + PG8_SB(0, 0) + boff;
    if constexpr (F8) { asm volatile("" : "+v"(abase8)); asm volatile("" : "+v"(bbase8)); }
    bf16x8 At[4][2], B0[2][2], B1[2][2]; i32x8 At8[4], B08[2], B18[2];
    unsigned cA = (unsigned)cur.pm * tstep, cB = (unsigned)cur.pn * tstep;
    S.a_ready(cur);
    if constexpr (SP2) {
        PG8_STAGE(PG8_SB(0, 0), cB, voffB); PG8_STAGE(PG8_SB(0, 1), cB + hstep, voffB); PG8_STAGE(PG8_SA(0, 0), cA, voffA); PG8_STAGE(PG8_SA(0, 1), cA + hstep, voffA);
        if (wr == 1) PG8_BAR;
        PG8_WAIT_V(2); PG8_BAR;
        PG8_STAGE(PG8_SB(1, 0), cB + kstep, voffB); PG8_STAGE(PG8_SA(1, 0), cA + kstep, voffA); PG8_STAGE(PG8_SB(1, 1), cB + hstep + kstep, voffB);
        PG8_WAIT_V(6); PG8_BAR;
    } else {
        PG8_STAGE(PG8_SB(0, 0), cB, voffB); PG8_STAGE(PG8_SA(0, 0), cA, voffA); PG8_STAGE(PG8_SB(0, 1), cB + hstep, voffB); PG8_STAGE(PG8_SA(0, 1), cA + hstep, voffA);
        if (wr == 1) PG8_BAR;
        PG8_WAIT_V(4); PG8_BAR;
        PG8_STAGE(PG8_SB(1, 0), cB + kstep, voffB); PG8_STAGE(PG8_SA(1, 0), cA + kstep, voffA); PG8_STAGE(PG8_SB(1, 1), cB + hstep + kstep, voffB);
        PG8_WAIT_V(6); PG8_BAR;
    }
    for (;;) {
        const bool has_next = S.next(ui + 1, nxt);
        const unsigned nA = has_next ? (unsigned)nxt.pm * tstep : cA, nB = has_next ? (unsigned)nxt.pn * tstep : cB;
#pragma nounroll
        for (int t = 0; t < nt; t += 2) {
            if constexpr (Epi::HAS_MID) { if (t == (nt >> 1)) E.mid(acc, cur, wr, fr); }
            const bool last = (t == nt - 2);
            const unsigned a1 = cA + (unsigned)(t + 1) * kstep;
            const unsigned a2 = last ? nA : cA + (unsigned)(t + 2) * kstep, b2 = last ? nB : cB + (unsigned)(t + 2) * kstep;
            const unsigned a3 = a2 + kstep, b3 = b2 + kstep;
            if (last && has_next) S.a_ready(nxt);
            if constexpr (SP2) {
            PG8_LDB(B0, 0, 0); PG8_LDB(B1, 0, 1); PG8_SCHED; PG8_LDA(At, 0, 0); PG8_STAGE(PG8_SA(1, 1), a1 + hstep, voffA);
            PG8_WAIT_V(8); PG8_WAIT_L(0); PG8_BAR; PG8_MMA(0, 0, At, B0); PG8_MMA(0, 1, At, B1); PG8_BAR; PG8_SCHED;
            PG8_LDA(At, 0, 1); PG8_STAGE(PG8_SB(0, 0), b2, voffB); PG8_STAGE(PG8_SB(0, 1), b2 + hstep, voffB); PG8_STAGE(PG8_SA(0, 0), a2, voffA);
            PG8_WAIT_V(8); PG8_WAIT_L(0); PG8_BAR; PG8_MMA(1, 0, At, B0); PG8_MMA(1, 1, At, B1); PG8_BAR; PG8_SCHED;
            PG8_LDB(B0, 1, 0); PG8_LDB(B1, 1, 1); PG8_SCHED; PG8_LDA(At, 1, 0); PG8_STAGE(PG8_SA(0, 1), a2 + hstep, voffA);
            PG8_WAIT_V(8); PG8_WAIT_L(0); PG8_BAR; PG8_MMA(0, 0, At, B0); PG8_MMA(0, 1, At, B1); PG8_BAR; PG8_SCHED;
            PG8_LDA(At, 1, 1); PG8_STAGE(PG8_SB(1, 0), b3, voffB); PG8_STAGE(PG8_SB(1, 1), b3 + hstep, voffB); PG8_STAGE(PG8_SA(1, 0), a3, voffA);
            PG8_WAIT_V(8); PG8_WAIT_L(0); PG8_BAR; PG8_MMA(1, 0, At, B0); PG8_MMA(1, 1, At, B1); PG8_BAR; PG8_SCHED;
            } else {
            PG8_LDB(B0, 0, 0); PG8_SCHED; PG8_LDA(At, 0, 0); PG8_STAGE(PG8_SA(1, 1), a1 + hstep, voffA);
            PG8_WAIT_L(8); PG8_BAR; PG8_WAIT_L(0); PG8_MMA(0, 0, At, B0); PG8_BAR; PG8_SCHED;
            PG8_LDB(B1, 0, 1); PG8_STAGE(PG8_SB(0, 0), b2, voffB);
            PG8_BAR; PG8_WAIT_L(0); PG8_MMA(0, 1, At, B1); PG8_BAR;
            PG8_LDA(At, 0, 1); PG8_STAGE(PG8_SA(0, 0), a2, voffA);
            PG8_BAR; PG8_WAIT_L(0); PG8_MMA(1, 0, At, B0); PG8_BAR; PG8_SCHED;
            PG8_STAGE(PG8_SB(0, 1), b2 + hstep, voffB);
            PG8_WAIT_V(6); PG8_BAR; PG8_MMA(1, 1, At, B1); PG8_BAR;
            PG8_LDB(B0, 1, 0); PG8_SCHED; PG8_LDA(At, 1, 0); PG8_STAGE(PG8_SA(0, 1), a2 + hstep, voffA);
            PG8_WAIT_L(8); PG8_BAR; PG8_WAIT_L(0); PG8_MMA(0, 0, At, B0); PG8_BAR; PG8_SCHED;
            PG8_LDB(B1, 1, 1); PG8_STAGE(PG8_SB(1, 0), b3, voffB);
            PG8_BAR; PG8_WAIT_L(0); PG8_MMA(0, 1, At, B1); PG8_BAR;
            PG8_LDA(At, 1, 1); PG8_STAGE(PG8_SA(1, 0), a3, voffA);
            PG8_BAR; PG8_WAIT_L(0); PG8_MMA(1, 0, At, B0); PG8_BAR; PG8_SCHED;
            PG8_STAGE(PG8_SB(1, 1), b3 + hstep, voffB);
            PG8_WAIT_V(6); PG8_BAR; PG8_MMA(1, 1, At, B1); PG8_BAR;
            }
        }
        if constexpr (ALIGN_EPI) { if (wr == 0) PG8_BAR; }
        if constexpr (!Epi::AFTER_DRAIN) { E(acc, cur, wr, wc, fr, fq); S.done(cur); }
        if (!has_next) break;
#pragma unroll
        for (int a = 0; a < 2; ++a)
#pragma unroll
            for (int b = 0; b < 2; ++b)
#pragma unroll
                for (int m = 0; m < 4; ++m)
#pragma unroll
                    for (int n = 0; n < 2; ++n) acc[a][b][m][n] = (f32x4){0.f, 0.f, 0.f, 0.f};
        cur = nxt; cA = nA; cB = nB; ++ui;
        if constexpr (ALIGN_EPI) { if (wr == 1) PG8_BAR; }
    }
    PG8_WAIT_V(0);
    if constexpr (!ALIGN_EPI) { if (wr == 0) PG8_BAR; }
    PG8_BAR;
    if constexpr (Epi::AFTER_DRAIN) { E.fused(acc, cur, wr, wc, fr, fq, lds, wid, lane); S.done(cur); }
#undef PG8_SA
#undef PG8_SB
#undef PG8_STAGE
#undef PG8_RS_voffA
#undef PG8_RS_voffB
#undef PG8_LDA
#undef PG8_LDB
#undef PG8_MMA
#undef PG8_WAIT_V
#undef PG8_WAIT_L
#undef PG8_BAR
#undef PG8_SCHED
}
}

constexpr int NWAVES = 8;
#ifndef MK_N_LAUNCHES
#define MK_N_LAUNCHES 1
#endif
constexpr int PER_PHASE = 7;
constexpr int N_LAUNCHES = MK_N_LAUNCHES;

constexpr int BATCH = 8, SEQ = 4096, D = 1024, NH = 16, HD = 64, FF = 2816, NHM = 8;
constexpr int M = BATCH * SEQ;
constexpr int NQKV = 3 * D, NGU = 2 * FF;
constexpr float RMS_EPS = 1e-6f;
constexpr float QSCALE = 0.125f * 1.4426950408889634f;

constexpr size_t MiB = 1u << 20;
constexpr size_t WS_CTL = 0, CTL_ZERO_BYTES = 64 * 1024;
constexpr size_t WS_ROPE = 1 * MiB;
constexpr size_t WS_WQKV = 2 * MiB, WS_WO = 8 * MiB, WS_WGU = 10 * MiB, WS_WD = 21 * MiB;
constexpr size_t WS_KPART = 27 * MiB;
constexpr size_t WS_SSQA = 28 * MiB, WS_SSQ1 = 30 * MiB, WS_SSQ2 = 32 * MiB;
constexpr size_t WS_XN = 40 * MiB;
constexpr size_t WS_QO = 104 * MiB, WS_K = 168 * MiB, WS_V = 232 * MiB;
constexpr size_t WS_H = 104 * MiB;
#ifndef MK_REPEAT_PHASE
#define MK_REPEAT_PHASE -1
#endif
constexpr size_t WS_O = WS_QO;
constexpr size_t WS_FARO = 296 * MiB, WS_FARL = 328 * MiB;
constexpr size_t WS_XN8 = 330 * MiB;
constexpr size_t WS_O8 = 362 * MiB;
constexpr size_t WS_END = (MK_REPEAT_PHASE == 3 ? 490 : 394) * MiB;
constexpr size_t QKV8_OFF = 2 * MiB;
constexpr int CW_TMO = 0, CW_CODE = 1;
constexpr int CW_BAR = 4096;
constexpr int CW_PANEL = 8192;
constexpr int CW_FAR = 2048;

constexpr int RING_OFF = 0, RING_BYTES = 131072;
constexpr int LDSCTL_OFF = RING_BYTES, MISC_OFF = LDSCTL_OFF + 320;
constexpr int LDS_BYTES = 147456;
static_assert(WS_V - WS_K == WS_K - WS_QO, "Q | K | V equally spaced");
#define GAS __attribute__((address_space(1)))
#define LAS __attribute__((address_space(3)))
typedef unsigned short bf16;
typedef unsigned v4u __attribute__((ext_vector_type(4)));
typedef float f32x4 __attribute__((ext_vector_type(4)));
typedef short bf16x8 __attribute__((ext_vector_type(8)));
typedef GAS unsigned gu32;
typedef GAS unsigned long long gu64;
#define RLX_AGENT __ATOMIC_RELAXED, __HIP_MEMORY_SCOPE_AGENT
#define LDS_WAIT() asm volatile("s_waitcnt lgkmcnt(0)" ::: "memory")
#define VM_WAIT() asm volatile("s_waitcnt vmcnt(0)" ::: "memory")
__device__ __forceinline__ unsigned long long rt() { return __builtin_amdgcn_s_memrealtime(); }
__device__ __forceinline__ unsigned f2bf(float f) { unsigned u = __builtin_bit_cast(unsigned, f); return (u + 0x7fffu + ((u >> 16) & 1u)) >> 16; }
__device__ __forceinline__ unsigned pk2(float lo, float hi) { return f2bf(lo) | (f2bf(hi) << 16); }

#define XB_TMO      128
#define XB_XCNT(j)  (256  + 64 * (j))
#define XB_XSUB(j)  (1280 + 64 * (j))
#define XB_XGEN(j)  (2304 + 64 * (j))
#define XB_TOP      3328
#define XB_TOPGEN   3392
#define XCD_BAR_WORDS 3456
#define XB_SPIN_CAP (1u << 18)

__device__ __forceinline__ unsigned xb_ld(unsigned* p)              { return __hip_atomic_load(p, __ATOMIC_RELAXED, __HIP_MEMORY_SCOPE_AGENT); }
__device__ __forceinline__ unsigned xb_add(unsigned* p, unsigned v) { return __hip_atomic_fetch_add(p, v, __ATOMIC_RELAXED, __HIP_MEMORY_SCOPE_AGENT); }
__device__ __forceinline__ unsigned xb_xcc_id() { return (unsigned)__builtin_amdgcn_s_getreg((3 << 11) | 20) & 0xFu; }
#define XB_SPIN(cond, bar) do { unsigned _sp = 0; while (cond) { __builtin_amdgcn_s_sleep(1); \
    if ((++_sp & 255u) == 0u) { if (xb_ld(&(bar)[XB_TMO])) break; if (_sp > XB_SPIN_CAP) { atomicAdd(&(bar)[XB_TMO], 1u); break; } } } } while (0)

struct XcdBarrier {
    unsigned* bar; unsigned x;
    volatile LAS unsigned* st;
};

__device__ __forceinline__ int mk_lane() { int l; asm volatile("v_mbcnt_lo_u32_b32 %0, -1, 0\n\tv_mbcnt_hi_u32_b32 %0, -1, %0" : "=v"(l)); return l; }
__device__ __forceinline__ XcdBarrier xcd_barrier_post(unsigned* bar, volatile LAS unsigned* st, int wave) {
    XcdBarrier b; b.bar = bar; b.x = xb_xcc_id(); b.st = st;
    if (wave == 0 && mk_lane() == 0) (void)xb_add(&bar[XB_XCNT(b.x)], 1u);
    return b;
}
__device__ __forceinline__ void xcd_barrier_complete(unsigned* bar, unsigned x, unsigned& nloc, unsigned& nx) {
    const unsigned G = gridDim.x * gridDim.y * gridDim.z;
    unsigned sum, cnt, mine, sp = 0u;
    for (;;) {
        sum = 0u; cnt = 0u; mine = 0u;
#pragma unroll
        for (unsigned j = 0; j < 16; ++j) { const unsigned c = xb_ld(&bar[XB_XCNT(j)]); sum += c; cnt += (c > 0u) ? 1u : 0u; mine = (j == x) ? c : mine; }
        if (sum == G) break;
        __builtin_amdgcn_s_sleep(1);
        if ((++sp & 255u) == 0u) { if (xb_ld(&bar[XB_TMO])) break; if (sp > XB_SPIN_CAP) { atomicAdd(&bar[XB_TMO], 1u); break; } }
    }
    nloc = mine > 0u ? mine : 1u; nx = cnt > 0u ? cnt : 1u;
}

__device__ __forceinline__ void xcd_barrier(const XcdBarrier& b, int wave) {
    asm volatile("s_waitcnt vmcnt(0)" ::: "memory");
    __syncthreads();
    if (wave == 0 && mk_lane() == 0) {
        unsigned* bar = b.bar;
        __builtin_amdgcn_s_waitcnt(0);
        unsigned nloc = b.st[0], nx = b.st[1];
        if (nloc == 0u) { xcd_barrier_complete(bar, b.x, nloc, nx); b.st[0] = nloc; b.st[1] = nx; }
        const unsigned old = xb_add(&bar[XB_XSUB(b.x)], 1u);
        const unsigned gen = old / nloc;
        if (old + 1u == (gen + 1u) * nloc) {
            __builtin_amdgcn_fence(__ATOMIC_RELEASE, "agent");
            asm volatile("s_waitcnt vmcnt(0)" ::: "memory");
            const unsigned og = xb_add(&bar[XB_TOP], 1u);
            const unsigned tg = og / nx;
            if (og + 1u == (tg + 1u) * nx) xb_add(&bar[XB_TOPGEN], 1u);
            else XB_SPIN(xb_ld(&bar[XB_TOPGEN]) == tg, bar);
            __builtin_amdgcn_fence(__ATOMIC_ACQUIRE, "agent");
            xb_add(&bar[XB_XGEN(b.x)], 1u);
            asm volatile("s_waitcnt vmcnt(0)" ::: "memory");
        } else {
            XB_SPIN(xb_ld(&bar[XB_XGEN(b.x)]) == gen, bar);
            __builtin_amdgcn_fence(__ATOMIC_ACQUIRE, "agent");
            asm volatile("s_waitcnt vmcnt(0)" ::: "memory");
        }
    }
    __syncthreads();
}

#include <hip/hip_bf16.h>
#include <cmath>
namespace attn_body {
using bf16=__hip_bfloat16;
using bf16x8=__attribute__((ext_vector_type(8)))short;
using s16x4=__attribute__((ext_vector_type(4)))short;
using f32x16=__attribute__((ext_vector_type(16)))float;
using u32x4=__attribute__((ext_vector_type(4)))unsigned;
using f32x4_t=__attribute__((ext_vector_type(4)))float;
constexpr int BATCH=8,NHEAD=16,SEQ=4096,D=64,DM=NHEAD*D;
constexpr int NW=8,QBLK=32,QB=QBLK*NW,KVBLK=64,NQB=SEQ/QB;
constexpr int ATTN_PITCH=DM, ATTN_UNIT_ROWS=QB;
__device__ __forceinline__ int crow(int r,int hi){return (r&3)+8*(r>>2)+4*hi;}
#define SBAR() __builtin_amdgcn_sched_barrier(0)
__device__ __forceinline__ void cmask(f32x16&p0,f32x16&p1,int jb,int qrel,int hi){
  const float NEG=-INFINITY; int kb=64*jb+4*hi;
  #pragma unroll
  for(int r=0;r<16;++r){int kv=kb+(r&3)+8*(r>>2); if(kv>qrel)p0[r]=NEG; if(kv+32>qrel)p1[r]=NEG;}
}

__device__ __forceinline__ void dm_range(f32x16&p0,f32x16&p1,int x,unsigned bw){
  #pragma unroll
  for(int r=0;r<16;++r){ const int kp=(r&3)+8*(r>>2); if((unsigned)(x-kp)>bw)p0[r]=-1e30f; if((unsigned)(x-32-kp)>bw)p1[r]=-1e30f; } }
template<int KIND> __device__ __forceinline__ int dmode(int lo){
  if(KIND==2) return (lo+94<33||lo>128)?0:4;
  return (lo+94<0||lo>512)?0:((lo<0)?40:((lo+94<=128)?1:((lo<=128)?41:((lo+94<=512)?2:42)))); }
__device__ __forceinline__ void dm_adj128(f32x16&p0,f32x16&p1,int dqh,const f32x16&adj){
  #pragma unroll
  for(int r=0;r<16;++r){ const int kp=(r&3)+8*(r>>2); p0[r]+=(dqh-kp>128)?adj[r]:0.f; p1[r]+=(dqh-32-kp>128)?adj[r]:0.f; } }
__device__ __forceinline__ void fmask(f32x16&p0,f32x16&p1,int dq){
  #pragma unroll
  for(int r=0;r<16;++r){ const int kp=(r&3)+8*(r>>2); if((unsigned)(dq-kp-33)>95u)p0[r]=-1e30f; if((unsigned)(dq-kp-65)>95u)p1[r]=-1e30f; }
}
constexpr int NSLOT=3, SLOTB=8192;
constexpr int LDS_K=0, LDS_V=NSLOT*SLOTB, LDS_WS=2*NSLOT*SLOTB, LDS_OST=LDS_WS+NW*64*4, LDS_BYTES=LDS_OST+NW*4096;
constexpr int LDS_TAB=LDS_BYTES, TABB=4096, LDS_ALL=LDS_TAB+4*TABB;
constexpr float C2=0.125f*1.4426950408889634f;
__device__ __forceinline__ void glds16(const void*gsrc,unsigned lds_dst){unsigned keep;
  asm volatile("s_mov_b32 %0, m0\n\ts_mov_b32 m0, %2\n\ts_nop 0\n\tglobal_load_lds_dwordx4 %1, off\n\ts_mov_b32 m0, %0":"=&s"(keep):"v"(gsrc),"s"(lds_dst):"memory");}
__device__ __forceinline__ float max3f(float a,float b,float c){float r;asm("v_max3_f32 %0, %1, %2, %3":"=v"(r):"v"(a),"v"(b),"v"(c));return r;}
__device__ __forceinline__ float max2f(float a,float b){float r;asm("v_max_f32_e32 %0, %1, %2":"=v"(r):"v"(a),"v"(b));return r;}
__device__ __forceinline__ float fadd_s(float a,float b){float r;asm("v_add_f32_e32 %0, %1, %2":"=v"(r):"v"(a),"v"(b));return r;}
__device__ __forceinline__ float fsub_s(float a,float b){float r;asm("v_sub_f32_e32 %0, %1, %2":"=v"(r):"v"(a),"v"(b));return r;}
typedef float f32x2_t __attribute__((ext_vector_type(2))); typedef __bf16 bf16x2_t __attribute__((ext_vector_type(2)));
__device__ __forceinline__ unsigned cvtpk_s(float lo,float hi){f32x2_t v={lo,hi};bf16x2_t b=__builtin_convertvector(v,bf16x2_t);return __builtin_bit_cast(unsigned,b);}
#define WAIT_BAR(N) asm volatile("s_waitcnt vmcnt(" #N ") lgkmcnt(0)\n\ts_barrier":::"memory")

__device__ __forceinline__ void qkt(f32x16&p0,f32x16&p1,const char*Kslot,const bf16x8*qr,const f32x16&negm,int r32,int hi){
  const char*kb=Kslot+hi*1024+r32*16;
  #pragma unroll
  for(int d0=0;d0<4;++d0){
    const bf16x8 b0=*reinterpret_cast<const bf16x8*>(kb+d0*2048);
    const bf16x8 b1=*reinterpret_cast<const bf16x8*>(kb+d0*2048+512);
    if(d0==0){p0=__builtin_amdgcn_mfma_f32_32x32x16_bf16(b0,qr[0],negm,0,0,0);p1=__builtin_amdgcn_mfma_f32_32x32x16_bf16(b1,qr[0],negm,0,0,0);}
    else{p0=__builtin_amdgcn_mfma_f32_32x32x16_bf16(b0,qr[d0],p0,0,0,0);p1=__builtin_amdgcn_mfma_f32_32x32x16_bf16(b1,qr[d0],p1,0,0,0);}}
}
typedef __attribute__((address_space(3))) const char* lds_cptr;
typedef short v4i16_t __attribute__((ext_vector_type(4)));
__device__ __forceinline__ void kload8(bf16x8*kf,lds_cptr kp){
  kf[0]=*(const __attribute__((address_space(3))) bf16x8*)(kp);      kf[1]=*(const __attribute__((address_space(3))) bf16x8*)(kp+512);
  kf[2]=*(const __attribute__((address_space(3))) bf16x8*)(kp+2048); kf[3]=*(const __attribute__((address_space(3))) bf16x8*)(kp+2560);
  kf[4]=*(const __attribute__((address_space(3))) bf16x8*)(kp+4096); kf[5]=*(const __attribute__((address_space(3))) bf16x8*)(kp+4608);
  kf[6]=*(const __attribute__((address_space(3))) bf16x8*)(kp+6144); kf[7]=*(const __attribute__((address_space(3))) bf16x8*)(kp+6656);
}
__device__ __forceinline__ void kload2(bf16x8*kf,lds_cptr kp,int j){ kf[2*j]=*(const __attribute__((address_space(3))) bf16x8*)(kp+j*2048); kf[2*j+1]=*(const __attribute__((address_space(3))) bf16x8*)(kp+j*2048+512); }
__device__ __forceinline__ s16x4 vtr(lds_cptr p){ return __builtin_bit_cast(s16x4,__builtin_amdgcn_ds_read_tr16_b64_v4i16((__attribute__((address_space(3))) v4i16_t*)p)); }
__device__ __forceinline__ float rowmax(const f32x16&p0,const f32x16&p1){
  float a=max3f(p0[0],p0[1],p1[0]),b=max3f(p0[2],p0[3],p1[1]);a=max3f(a,p1[2],p1[3]);
  #pragma unroll
  for(int r=4;r<16;r+=4){a=max3f(a,p0[r],p0[r+1]);b=max3f(b,p0[r+2],p0[r+3]);a=max3f(a,p1[r],p1[r+1]);b=max3f(b,p1[r+2],p1[r+3]);}
  const float m=max2f(a,b);
  auto rr=__builtin_amdgcn_permlane32_swap(__float_as_uint(m),__float_as_uint(m),false,false);
  return max2f(__uint_as_float(rr[0]),__uint_as_float(rr[1]));
}
__device__ __forceinline__ void pv(f32x16*o,int vb,bf16x8 pa0,bf16x8 pa1,bf16x8 pa2,bf16x8 pa3){
  #pragma unroll
  for(int d0=0;d0<2;++d0){s16x4 lo[4],hi[4];
    #pragma unroll
    for(int ks=0;ks<4;++ks){
      asm volatile("ds_read_b64_tr_b16 %0,%1 offset:%c2":"=&v"(lo[ks]):"v"(vb),"i"(d0*4096+ks*1024):"memory");
      asm volatile("ds_read_b64_tr_b16 %0,%1 offset:%c2":"=&v"(hi[ks]):"v"(vb),"i"(d0*4096+ks*1024+512):"memory");}
    asm volatile("s_waitcnt lgkmcnt(0)":::"memory");SBAR();
    #define PK(k) (bf16x8){lo[k][0],lo[k][1],lo[k][2],lo[k][3],hi[k][0],hi[k][1],hi[k][2],hi[k][3]}
    o[d0]=__builtin_amdgcn_mfma_f32_32x32x16_bf16(pa0,PK(0),o[d0],0,0,0);
    o[d0]=__builtin_amdgcn_mfma_f32_32x32x16_bf16(pa1,PK(1),o[d0],0,0,0);
    o[d0]=__builtin_amdgcn_mfma_f32_32x32x16_bf16(pa2,PK(2),o[d0],0,0,0);
    o[d0]=__builtin_amdgcn_mfma_f32_32x32x16_bf16(pa3,PK(3),o[d0],0,0,0);
    #undef PK
  }
}

#ifndef ATTN_STORE16
#define ATTN_STORE16(p,v) asm volatile("global_store_dwordx4 %0, %1, off sc1\n\ts_nop 1"::"v"(p),"v"(v):"memory")
#endif
template<int THRL,int KIND> __device__ __forceinline__ void attn_unit(int b,int h,int qb,unsigned char*ws,char*shm,int wave,bf16x8 (&qr)[4],bool pre,bool has_next,int nkind,int nb,int nh,int nqb){
  const bf16*Q=(const bf16*)(ws+WS_QO); const bf16*K=(const bf16*)(ws+WS_K); const bf16*V=(const bf16*)(ws+WS_V); unsigned char*O8=ws+WS_O8;
  float*ssq=(float*)(ws+WS_SSQA); const float*kpart=(const float*)(ws+WS_KPART); unsigned short*faro=(unsigned short*)(ws+WS_FARO); float*farl=(float*)(ws+WS_FARL);
  constexpr bool DIL=(KIND==1), FAR=(KIND==2); constexpr int RS=FAR?16:1;
  int tid=wave*64+mk_lane(); asm volatile("":"+v"(tid));
  const int lane=tid&63,r32=lane&31,hi=lane>>5; const int wid=__builtin_amdgcn_readfirstlane(tid>>6);
  const int rowbase=b*SEQ+(FAR?qb:0);   const int q0=FAR?0:qb*QB;
  const bf16*Qw=Q+(rowbase+(int)(q0+wid*QBLK)*RS)*DM+h*D;
  const int T0=DIL?(qb>2?4*qb-8:0):0;
  const bf16*Kh=K+(rowbase+(int)T0*KVBLK)*DM+h*D,*Vh=V+(rowbase+(int)T0*KVBLK)*DM+h*D;
  const unsigned lds0=(unsigned)(uintptr_t)shm;
  float*wsf=(float*)(shm+LDS_WS)+wid*64;
  const bf16*ksrc=Kh+(int)lane*RS*DM+wid*8;
  const bf16*vsrc=Vh+(int)(16*(wid&3)+(lane>>2))*RS*DM+(wid>>2)*32+(lane&3)*8;
  const unsigned kdst=lds0+LDS_K+wid*1024, vdst=lds0+LDS_V+wid*1024;
  #define DMA_K(t,slot) glds16(ksrc+(int)(t)*KVBLK*RS*DM,(unsigned)__builtin_amdgcn_readfirstlane(kdst+(slot)))
  #define DMA_V(t,slot) glds16(vsrc+(int)(t)*KVBLK*RS*DM,(unsigned)__builtin_amdgcn_readfirstlane(vdst+(slot)))
  const int vb0=(int)(lds0+LDS_V)+((lane>>4)&1)*32+(lane&3)*8+(4*hi+((lane&15)>>2))*64;
  const char*Kbase=shm+LDS_K; bf16x8 kf[8];
  const lds_cptr shm3=(lds_cptr)shm; const lds_cptr kp0=shm3+LDS_K+hi*1024+r32*16; const lds_cptr vp0=shm3+LDS_V+((lane>>4)&1)*32+(lane&3)*8+(4*hi+((lane&15)>>2))*64;
  const int NT=FAR?4:(q0+QB)/KVBLK-T0;
  if(!pre)DMA_K(0,0); DMA_V(0,0); if(!pre)DMA_K(1,SLOTB);
  #pragma unroll
  for(int d0=0;d0<4;++d0)if(!pre)qr[d0]=*reinterpret_cast<const bf16x8*>(&Qw[(int)r32*RS*DM+d0*16+hi*8]);
  float mhat=0.f,l_reg=0.f;f32x16 o[2];o[0]=f32x16{};o[1]=f32x16{};
  const int qrel=wid*QBLK+r32;
  const lds_cptr tabp=(lds_cptr)shm+LDS_TAB+lane*64;
  unsigned selmask=1u<<qb;
  if(KIND==0){
    f32x16 g=f32x16{};
    #pragma unroll
    for(int d0=0;d0<4;++d0){ float km[8];
      if(r32<16){ const float*kp_=kpart+(unsigned)((b*16+r32)*2)*512+h*64+d0*16+hi*8;
        const f32x4_t a0=*(const f32x4_t*)kp_,a1=*(const f32x4_t*)(kp_+4),b0=*(const f32x4_t*)(kp_+512),b1=*(const f32x4_t*)(kp_+516);
        km[0]=a0[0]+b0[0];km[1]=a0[1]+b0[1];km[2]=a0[2]+b0[2];km[3]=a0[3]+b0[3];km[4]=a1[0]+b1[0];km[5]=a1[1]+b1[1];km[6]=a1[2]+b1[2];km[7]=a1[3]+b1[3]; }
      else{ _Pragma("unroll") for(int j=0;j<8;++j)km[j]=0.f; }
      u32x4 wh,wl; float rs[8];
      wh[0]=cvtpk_s(km[0],km[1]);wh[1]=cvtpk_s(km[2],km[3]);wh[2]=cvtpk_s(km[4],km[5]);wh[3]=cvtpk_s(km[6],km[7]);
      #pragma unroll
      for(int j=0;j<4;++j){ rs[2*j]=km[2*j]-__uint_as_float(wh[j]<<16); rs[2*j+1]=km[2*j+1]-__uint_as_float(wh[j]&0xffff0000u); }
      wl[0]=cvtpk_s(rs[0],rs[1]);wl[1]=cvtpk_s(rs[2],rs[3]);wl[2]=cvtpk_s(rs[4],rs[5]);wl[3]=cvtpk_s(rs[6],rs[7]);
      g=__builtin_amdgcn_mfma_f32_32x32x16_bf16(__builtin_bit_cast(bf16x8,wh),qr[d0],g,0,0,0);
      g=__builtin_amdgcn_mfma_f32_32x32x16_bf16(__builtin_bit_cast(bf16x8,wl),qr[d0],g,0,0,0); }
    float gv[16];
    #pragma unroll
    for(int r=0;r<8;++r){ const float own=g[r],oth=__shfl_xor(own,32); const int bl=(r&3)+8*(r>>2); gv[bl]=hi?oth:own; gv[bl+4]=hi?own:oth; }
    #pragma unroll
    for(int j=0;j<16;++j) if(j>=qb)gv[j]=-3e38f;
    #pragma unroll
    for(int rd=0;rd<3;++rd){ float best=-3e38f;int bi=0;
      #pragma unroll
      for(int j=0;j<16;++j){ if(gv[j]>best){best=gv[j];bi=j;} }
      if(best>-3e38f)selmask|=1u<<bi;
      #pragma unroll
      for(int j=0;j<16;++j) if(j==bi)gv[j]=-3e38f; }
  }
  const int lo0=FAR?(32*wid-63):(q0-T0*KVBLK+32*wid-63);
  #define DMODE(t) dmode<KIND>(lo0-(t)*KVBLK)
  #define CMASK(P0,P1,t) do{ if(DIL){ if(md_t>=40){ const int dqh_=q0-(T0+(t))*KVBLK+qrel-4*hi; \
        if(md_t==41){ const f32x16 adj_=*(const __attribute__((address_space(3))) f32x16*)(tabp+3*TABB); dm_adj128(P0,P1,dqh_,adj_); } \
        else dm_range(P0,P1,dqh_-((md_t==40)?0:-4096),(md_t==40)?0x7fffffffu:4608u); } } \
    else if(FAR){ if(md_t==4)fmask(P0,P1,qrel-(t)*KVBLK-4*hi); } \
    else { int jb_=(t)-(NT-4); if(jb_>=0)cmask(P0,P1,jb_,qrel,hi); } }while(0)
  #define SETC(t) f32x16 ct; const int md_t=(KIND==0)?0:DMODE(t); { if(DIL){ const int to_=(md_t==0)?0:((md_t==2||md_t==42)?2*TABB:TABB); \
      const f32x16 tb_=*(const __attribute__((address_space(3))) f32x16*)(tabp+to_); _Pragma("unroll") for(int r=0;r<16;++r)ct[r]=tb_[r]-mhat; } \
    else { const float x_=(FAR?(md_t!=0):(((selmask>>((t)>>2))&1u)!=0u))?-mhat:-1e30f; _Pragma("unroll") for(int r=0;r<16;++r)ct[r]=x_; } asm volatile("":"+v"(ct)); }
  bool resc=false;
  #define START(P0,P1) do{ const float rm=rowmax(P0,P1); resc=false; \
    if(__any(rm>(float)THRL)){ const float dl=__builtin_fmaxf(rm,0.f); mhat=fadd_s(mhat,dl); \
      _Pragma("unroll") for(int r=0;r<16;++r){P0[r]=fsub_s(P0[r],dl);P1[r]=fsub_s(P1[r],dl);} \
      const float f=__builtin_amdgcn_exp2f(-dl); l_reg*=f; if(hi==0)wsf[r32]=f; resc=true; } \
    _Pragma("unroll") for(int r=0;r<16;++r)P0[r]=__builtin_amdgcn_exp2f(P0[r]); }while(0)
  #define RESC() do{ if(resc){ asm volatile("s_waitcnt lgkmcnt(0)":::"memory"); \
      _Pragma("unroll") for(int d_=0;d_<2;++d_) _Pragma("unroll") for(int r=0;r<16;++r)o[d_][r]*=wsf[crow(r,hi)]; } }while(0)
  f32x16 pA0,pA1,pB0,pB1;
  int sl_prev=0,sl_cur=0,sl_next=SLOTB;
  #define ROT() do{sl_prev=sl_cur;sl_cur=sl_next;sl_next=(sl_next==(NSLOT-1)*SLOTB)?0:sl_next+SLOTB;}while(0)
  if(!pre){ DMA_K(2,2*SLOTB);
    WAIT_BAR(3); }
  else { WAIT_BAR(1); }
  if(0)WAIT_BAR(3);
  { SETC(0); qkt(pA0,pA1,Kbase,qr,ct,r32,hi); asm volatile("s_nop 15\n\ts_nop 7":"+v"(pA0),"+v"(pA1));CMASK(pA0,pA1,0); }
  START(pA0,pA1);
  _Pragma("unroll") for(int r=0;r<16;++r)pA1[r]=__builtin_amdgcn_exp2f(pA1[r]);
  WAIT_BAR(0);
  RESC();
  DMA_K(3,0);DMA_V(1,SLOTB);
  ROT();
  kload8(kf,kp0+sl_cur);
  WAIT_BAR(2);
  s16x4 vlo[8],vhi[8]; u32x4 pw0,pw1,pw2,pw3;
  #define PKW(P,B) cvtpk_s(P[B],P[B+1])
  #define PAF(k) __builtin_bit_cast(bf16x8,pw##k)
  #define VFR(i) (bf16x8){vlo[i][0],vlo[i][1],vlo[i][2],vlo[i][3],vhi[i][0],vhi[i][1],vhi[i][2],vhi[i][3]}
  #define PIN(x) asm volatile("":"+v"(x))
  #define MX3(a,b,c) __builtin_fmaxf(__builtin_fmaxf((a),(b)),(c))
  #define GAPA(MF,A0,A1,A2,A3,W0,W1,PW) do{ MF; sacc+=A0; sacc+=A1; sacc+=A2; sacc+=A3; PIN(sacc); W0; W1; PIN(PW); SBAR(); }while(0)
  #define EX(v) __builtin_amdgcn_exp2f(v)
  #define GAPB(MF,X,B) do{ MF; X[B]=EX(X[B]); X[B+1]=EX(X[B+1]); X[B+2]=EX(X[B+2]); X[B+3]=EX(X[B+3]); PIN(X); SBAR(); }while(0)
  #define VRD(i) do{ vlo[i]=vtr(vp_+(((i)>>2)*4096+((i)&3)*1024)); vhi[i]=vtr(vp_+(((i)>>2)*4096+((i)&3)*1024+512)); }while(0)
  #define KRD(G,j) do{ if(G){ kload2(kf,kp0+sl_next,j); SBAR(); } }while(0)
  #define STEP(C0,C1,P0,P1,t,GK,GV,GL) do{ SBAR(); SETC(t); SBAR(); \
    const lds_cptr vp_=vp0+sl_prev; \
    VRD(0); SBAR(); float sacc=(P0[0]+P0[1]); \
    GAPA(C0=__builtin_amdgcn_mfma_f32_32x32x16_bf16(kf[0],qr[0],ct,0,0,0), P0[2],P0[3],P0[4],P0[5],     pw0[0]=PKW(P0,0), pw0[1]=PKW(P0,2), pw0); \
    VRD(4); SBAR(); GAPA(C1=__builtin_amdgcn_mfma_f32_32x32x16_bf16(kf[1],qr[0],ct,0,0,0), P0[6],P0[7],P0[8],P0[9],     pw0[2]=PKW(P0,4), pw0[3]=PKW(P0,6), pw0); \
    VRD(1); SBAR(); GAPA(C0=__builtin_amdgcn_mfma_f32_32x32x16_bf16(kf[2],qr[1],C0,0,0,0),   P0[10],P0[11],P0[12],P0[13], pw1[0]=PKW(P0,8), pw1[1]=PKW(P0,10), pw1); \
    VRD(5); SBAR(); GAPA(C1=__builtin_amdgcn_mfma_f32_32x32x16_bf16(kf[3],qr[1],C1,0,0,0),   P0[14],P0[15],P1[0],P1[1],   pw1[2]=PKW(P0,12),pw1[3]=PKW(P0,14), pw1); \
    VRD(2); SBAR(); GAPA(C0=__builtin_amdgcn_mfma_f32_32x32x16_bf16(kf[4],qr[2],C0,0,0,0),   P1[2],P1[3],P1[4],P1[5],     pw2[0]=PKW(P1,0), pw2[1]=PKW(P1,2), pw2); \
    VRD(6); SBAR(); GAPA(C1=__builtin_amdgcn_mfma_f32_32x32x16_bf16(kf[5],qr[2],C1,0,0,0),   P1[6],P1[7],P1[8],P1[9],     pw2[2]=PKW(P1,4), pw2[3]=PKW(P1,6), pw2); \
    VRD(3); SBAR(); GAPA(C0=__builtin_amdgcn_mfma_f32_32x32x16_bf16(kf[6],qr[3],C0,0,0,0),   P1[10],P1[11],P1[12],P1[13], pw3[0]=PKW(P1,8), pw3[1]=PKW(P1,10), pw3); \
    VRD(7); SBAR(); GAPA(C1=__builtin_amdgcn_mfma_f32_32x32x16_bf16(kf[7],qr[3],C1,0,0,0),   P1[14],P1[15],0.f,0.f,       pw3[2]=PKW(P1,12),pw3[3]=PKW(P1,14), pw3); \
    l_reg+=sacc; \
    if(GK){DMA_K((t)+3,sl_cur);} if(GV){DMA_V((t)+1,sl_next);} \
    CMASK(C0,C1,t); \
    { float a=MX3(C0[0],C0[1],C1[0]),b=MX3(C0[2],C0[3],C1[1]); a=MX3(a,C1[2],C1[3]); \
      _Pragma("unroll") for(int r=4;r<16;r+=4){a=MX3(a,C0[r],C0[r+1]);b=MX3(b,C0[r+2],C0[r+3]);a=MX3(a,C1[r],C1[r+1]);b=MX3(b,C1[r+2],C1[r+3]);} \
      float rm=__builtin_fmaxf(a,b); { auto rr=__builtin_amdgcn_permlane32_swap(__float_as_uint(rm),__float_as_uint(rm),false,false); rm=__builtin_fmaxf(__uint_as_float(rr[0]),__uint_as_float(rr[1])); } \
      resc=false; \
      if(__builtin_expect(__any(rm>(float)THRL),0)){ const float dl=__builtin_fmaxf(rm,0.f); mhat+=dl; \
        _Pragma("unroll") for(int r=0;r<16;++r){C0[r]-=dl;C1[r]-=dl;} \
        const float f=__builtin_amdgcn_exp2f(-dl); l_reg*=f; if(hi==0)wsf[r32]=f; resc=true; } } \
    SBAR(); \
    GAPB(o[0]=__builtin_amdgcn_mfma_f32_32x32x16_bf16(PAF(0),VFR(0),o[0],0,0,0), C0,0); \
    GAPB(o[1]=__builtin_amdgcn_mfma_f32_32x32x16_bf16(PAF(0),VFR(4),o[1],0,0,0), C0,4); \
    KRD(GL,0); GAPB(o[0]=__builtin_amdgcn_mfma_f32_32x32x16_bf16(PAF(1),VFR(1),o[0],0,0,0), C0,8); \
    KRD(GL,1); GAPB(o[1]=__builtin_amdgcn_mfma_f32_32x32x16_bf16(PAF(1),VFR(5),o[1],0,0,0), C0,12); \
    KRD(GL,2); GAPB(o[0]=__builtin_amdgcn_mfma_f32_32x32x16_bf16(PAF(2),VFR(2),o[0],0,0,0), C1,0); \
    KRD(GL,3); GAPB(o[1]=__builtin_amdgcn_mfma_f32_32x32x16_bf16(PAF(2),VFR(6),o[1],0,0,0), C1,4); \
    GAPB(o[0]=__builtin_amdgcn_mfma_f32_32x32x16_bf16(PAF(3),VFR(3),o[0],0,0,0), C1,8); \
    GAPB(o[1]=__builtin_amdgcn_mfma_f32_32x32x16_bf16(PAF(3),VFR(7),o[1],0,0,0), C1,12); \
    }while(0)
  int t=1;
  for(;t+5<NT;t+=2){
    STEP(pB0,pB1,pA0,pA1,t,true,true,true);     WAIT_BAR(2); RESC(); ROT();
    STEP(pA0,pA1,pB0,pB1,t+1,true,true,true);   WAIT_BAR(2); RESC(); ROT();
  }
  #define ENDW(tt) do{ if((tt)+3<NT){WAIT_BAR(2);} else if((tt)+2<NT){WAIT_BAR(1);} else {WAIT_BAR(0);} }while(0)
  for(;t+1<NT;t+=2){
    STEP(pB0,pB1,pA0,pA1,t,(t+3<NT),(t+1<NT),(t+1<NT));       ENDW(t);   RESC(); ROT();
    STEP(pA0,pA1,pB0,pB1,t+1,(t+4<NT),(t+2<NT),(t+2<NT));     ENDW(t+1); RESC(); ROT();
  }
  if(has_next){
    const int nRS=(nkind==2)?16:1, nrowbase=nb*SEQ+((nkind==2)?nqb:0), nT0=(nkind==1)?(nqb>2?4*nqb-8:0):0;
    const bf16*nks=K+(nrowbase+(int)nT0*KVBLK)*DM+nh*D+(int)lane*nRS*DM+wid*8;
    glds16(nks,(unsigned)__builtin_amdgcn_readfirstlane(kdst)); glds16(nks+(int)KVBLK*nRS*DM,(unsigned)__builtin_amdgcn_readfirstlane(kdst+SLOTB)); glds16(nks+(int)2*KVBLK*nRS*DM,(unsigned)__builtin_amdgcn_readfirstlane(kdst+2*SLOTB)); }
  STEP(pB0,pB1,pA0,pA1,NT-1,false,false,false); RESC();
  if(has_next){
    const int nRS=(nkind==2)?16:1, nrowbase=nb*SEQ+((nkind==2)?nqb:0), nq0=(nkind==2)?0:nqb*QB; const bf16*nQw=Q+(nrowbase+(int)(nq0+wid*QBLK)*nRS)*DM+nh*D;
    #pragma unroll
    for(int d0=0;d0<4;++d0)qr[d0]=*reinterpret_cast<const bf16x8*>(&nQw[(int)r32*nRS*DM+d0*16+hi*8]); }
  { float sacc=pB0[0]+pB0[1]; _Pragma("unroll") for(int r=2;r<16;++r)sacc+=pB0[r]; _Pragma("unroll") for(int r=0;r<16;++r)sacc+=pB1[r]; l_reg+=sacc;
    pw0=(u32x4){PKW(pB0,0),PKW(pB0,2),PKW(pB0,4),PKW(pB0,6)};pw1=(u32x4){PKW(pB0,8),PKW(pB0,10),PKW(pB0,12),PKW(pB0,14)};pw2=(u32x4){PKW(pB1,0),PKW(pB1,2),PKW(pB1,4),PKW(pB1,6)};pw3=(u32x4){PKW(pB1,8),PKW(pB1,10),PKW(pB1,12),PKW(pB1,14)};
    SBAR(); pv(o,vb0+sl_cur,PAF(0),PAF(1),PAF(2),PAF(3)); }
  #undef PKW
  #undef PAF
  #undef VFR
  #undef PIN
  #undef MX3
  #undef GAPA
  #undef GAPB
  #undef EX
  #undef VRD
  #undef KRD
  #undef STEP
  #undef ENDW
  {auto rr=__builtin_amdgcn_permlane32_swap(__float_as_uint(l_reg),__float_as_uint(l_reg),false,false);l_reg=__uint_as_float(rr[0])+__uint_as_float(rr[1]);}
  int lane_e=lane; asm volatile("":"+v"(lane_e));
  u32x4 fch[4];
  if(DIL){
    const unsigned short*fp=faro+(unsigned)(rowbase+q0+wid*QBLK+(lane_e>>3))*512+(h-8)*D+(lane_e&7)*8;
    #pragma unroll
    for(int i=0;i<4;++i)fch[i]=*(const u32x4*)(fp+(unsigned)i*8*512);
    const float*lp=farl+((unsigned)(rowbase+q0+wid*QBLK+(lane_e&31))*8+(h-8))*2; const float lf_=lp[0],mf_=lp[1];
    const float M_=__builtin_fmaxf(mhat,mf_),sa_=__builtin_amdgcn_exp2f(mhat-M_),sb_=__builtin_amdgcn_exp2f(mf_-M_),rl_=__builtin_amdgcn_rcpf(l_reg*sa_+lf_*sb_);
    if(hi==0){wsf[32+r32]=sa_*rl_;wsf[r32]=sb_*rl_;} }
  else if(hi==0)wsf[32+r32]=FAR?1.f:__builtin_amdgcn_rcpf(l_reg);
  asm volatile("s_waitcnt lgkmcnt(0)":::"memory");
  float rli[16];
  #pragma unroll
  for(int r=0;r<16;++r)rli[r]=wsf[32+crow(r,hi)];
  constexpr int OP=FAR?512:DM;
  bf16*Ow=(bf16*)faro+(rowbase+(int)wid*QBLK*RS)*OP+(h-8)*D;
  unsigned char*O8w=O8+(rowbase+q0+wid*QBLK)*DM+h*D;
  if(FAR&&hi==0){ float*lp=farl+((unsigned)(rowbase+(int)qrel*RS)*8+(h-8))*2; __hip_atomic_store((unsigned long long*)lp,((unsigned long long)__float_as_uint(mhat)<<32)|__float_as_uint(l_reg),__ATOMIC_RELAXED,__HIP_MEMORY_SCOPE_AGENT); }
  { bf16*stg=(bf16*)(shm+LDS_OST)+wid*2048;
    #pragma unroll
    for(int r=0;r<16;++r){const int orow=crow(r,hi);
      #pragma unroll
      for(int d0=0;d0<2;++d0)stg[orow*64+d0*32+r32]=__float2bfloat16(o[d0][r]*rli[r]);}
    asm volatile("s_waitcnt lgkmcnt(0)":::"memory");
    #pragma unroll
    for(int i=0;i<4;++i){const int row=i*8+(lane_e>>3),ch=lane_e&7; u32x4 v=*(const u32x4*)(stg+row*64+ch*8);
      if(DIL){ const float fb_=wsf[row];
        #pragma unroll
        for(int j=0;j<4;++j){ const float a_=__uint_as_float(v[j]<<16)+__uint_as_float(fch[i][j]<<16)*fb_, b_=__uint_as_float(v[j]&0xffff0000u)+__uint_as_float(fch[i][j]&0xffff0000u)*fb_; v[j]=cvtpk_s(a_,b_); } }
      if(FAR){ ATTN_STORE16(Ow+(int)row*RS*OP+ch*8,v); }
      else { unsigned w0_=0,w1_=0;
        w0_=__builtin_amdgcn_cvt_pk_fp8_f32(__uint_as_float(v[0]<<16)*64.f,__uint_as_float(v[0]&0xffff0000u)*64.f,w0_,false); w0_=__builtin_amdgcn_cvt_pk_fp8_f32(__uint_as_float(v[1]<<16)*64.f,__uint_as_float(v[1]&0xffff0000u)*64.f,w0_,true);
        w1_=__builtin_amdgcn_cvt_pk_fp8_f32(__uint_as_float(v[2]<<16)*64.f,__uint_as_float(v[2]&0xffff0000u)*64.f,w1_,false); w1_=__builtin_amdgcn_cvt_pk_fp8_f32(__uint_as_float(v[3]<<16)*64.f,__uint_as_float(v[3]&0xffff0000u)*64.f,w1_,true);
        *(unsigned long long*)(O8w+(int)row*DM+ch*8)=((unsigned long long)w1_<<32)|w0_; }
      float sq=0.f;
      #pragma unroll
      for(int j=0;j<4;++j){ const float a_=__uint_as_float(v[j]<<16), b_=__uint_as_float(v[j]&0xffff0000u); sq+=a_*a_+b_*b_; }
      sq+=__shfl_xor(sq,1); sq+=__shfl_xor(sq,2); sq+=__shfl_xor(sq,4);
      if(!FAR&&ch==0)ssq[(unsigned)(rowbase+q0+wid*QBLK+row)*16+h]=sq; } }
  asm volatile("s_waitcnt lgkmcnt(0)\n\ts_barrier":::"memory");
  #undef DMA_K
  #undef DMA_V
  #undef CMASK
  #undef START
  #undef RESC
  #undef ROT
}
constexpr int ATTN_LDS_BYTES=LDS_BYTES;
__device__ __forceinline__ void attn_tables(char*lds,int wave){
  float*tb=(float*)(lds+LDS_TAB);
  for(int e=wave*64+mk_lane();e<64*16;e+=512){ const int ln=e>>4,r=e&15,r32=ln&31,hi=ln>>5; const int z4=r32&3,z16=((r32&15)-4*hi)&15;
    const bool in4=(z4==(r&3)),in16=(z16==((r&3)+8*((r>>2)&1)));
    tb[e]=-1e30f; tb[1024+e]=in16?1.5849625007f:(in4?1.f:0.f); tb[2048+e]=in16?1.f:(in4?0.f:-1e30f); tb[3072+e]=in16?(1.f-1.5849625007f):(in4?-1.f:-1e30f); }
  __syncthreads();
}
template<int THRL=8> __device__ __forceinline__ void attn_phase(char*lds,unsigned char*ws,unsigned*cnt,int vcu,int G,int wave){
  const int g=vcu>>2,b=g>>3,hm=g&7,c=vcu&3;
  attn_tables(lds,wave);
  bf16x8 qr[4];
  { const int n_=(MK_REPEAT_PHASE==22?8:4); for(int i=0;i<n_;++i) attn_unit<THRL,2>(b,8+hm,4*c+(i&3),ws,lds,wave,qr,i>0,true,(i+1<n_)?2:0,b,(i+1<n_)?8+hm:hm,(i+1<n_)?4*c+((i+1)&3):15-c); }
  asm volatile("s_waitcnt vmcnt(0)":::"memory"); __syncthreads();
  if(wave==0&&mk_lane()==0) __hip_atomic_fetch_add(cnt,1u,__ATOMIC_RELAXED,__HIP_MEMORY_SCOPE_AGENT);
  #define QBSEL(i_) ((((i_)&3)==0)?15-c:((((i_)&3)==1)?8+c:((((i_)&3)==2)?7-c:c)))
  { const int n_=(MK_REPEAT_PHASE==20?8:4); for(int ii=0;ii<n_;++ii) attn_unit<THRL,0>(b,hm,QBSEL(ii),ws,lds,wave,qr,true,true,(ii+1<n_)?0:1,b,(ii+1<n_)?hm:8+hm,QBSEL(ii+1)); }
  if(wave==0&&mk_lane()==0){ unsigned sp=0; while(__hip_atomic_load(cnt,__ATOMIC_RELAXED,__HIP_MEMORY_SCOPE_AGENT)<(unsigned)G){ __builtin_amdgcn_s_sleep(2); if(++sp>(1u<<22))break; }
    __builtin_amdgcn_fence(__ATOMIC_ACQUIRE,"agent"); asm volatile("s_waitcnt vmcnt(0)":::"memory"); }
  __syncthreads();
  { const int n_=(MK_REPEAT_PHASE==21?8:4); for(int ii=0;ii<n_;++ii) attn_unit<THRL,1>(b,8+hm,QBSEL(ii),ws,lds,wave,qr,true,ii+1<n_,1,b,8+hm,QBSEL(ii+1)); }
  #undef QBSEL
}
#undef SBAR
#undef WAIT_BAR
}

struct Frame {
    LAS unsigned char* lds;
    volatile LAS unsigned* MISC;
    gu32* ctl;
    int wave;
    int vcu, G;
    const float *x, *attn_norm, *w_in, *moba_norm, *dil_norm, *w_out, *ffn_norm, *w_gate, *w_up, *w_down, *final_norm;
    float* out;
    bf16 *Wqkv_t, *Wo_t, *Wgu_t, *Wd_t;
    bf16 *QO, *KB, *VB, *XN, *OB; unsigned char *HB, *XN8;
    float *rope, *kpart, *ssqa, *ssq1, *ssq2;
};

__device__ __forceinline__ float wave_sum(float v) {
#pragma unroll
    for (int o = 1; o < 64; o <<= 1) v += __shfl_xor(v, o);
    return v;
}
__device__ __forceinline__ int qkv_vrow(int n) { const int part = n >> 10, head = (n >> 6) & 15, d = n & 63; return 256 * (part * 4 + (head >> 2)) + 128 * (d >> 5) + 32 * (head & 3) + (d & 31); }
template <int MODE>
__device__ __forceinline__ void p0_item(const float* W, int K, int N, bf16* WT, const float* g0, const float* g1, LAS float* scr, int item, int lane) {
    const int nblk = N / 32, kb = item / nblk, nb = item % nblk, k0 = 64 * kb, n0 = 32 * nb;
#pragma unroll 8
    for (int i = 0; i < 32; ++i) { const int kk = 2 * i + (lane >> 5), k = k0 + kk; float w = W[(size_t)k * N + n0 + (lane & 31)];
        if (MODE == 1) w *= (k < 512 ? g0[k] : g1[k - 512]);
        if (MODE == 2 || MODE == 3) w *= g0[k];
        scr[kk * 33 + (lane & 31)] = w; }
    LDS_WAIT(); asm volatile("" ::: "memory");
    const int c = lane & 7;
#pragma unroll
    for (int j = 0; j < 4; ++j) { const int n = (lane >> 3) + 8 * j; const LAS float* s = scr + (8 * c) * 33 + n;
        const int ns = n0 + n; int dr;
        if (MODE == 0) dr = qkv_vrow(ns); else if (MODE == 2) dr = 256 * (ns >> 7) + (ns & 127); else if (MODE == 3) dr = 256 * (ns >> 7) + 128 + (ns & 127); else dr = ns;
        bool f8 = MODE >= 1; size_t base8 = 0;
        if (MODE == 0) {
            const int pn = dr >> 8, lo = dr & 255; f8 = !(pn < 8 && (pn & 3) < 2);
            dr = (f8 ? (pn < 8 ? ((pn & 1) + 2 * (pn >> 2)) : pn - 4) : ((pn & 1) + 2 * (pn >> 2))) * 256 + lo; base8 = (size_t)QKV8_OFF; }
        if (f8) {
            const pg8::f32x4 a = {s[0 * 33], s[1 * 33], s[2 * 33], s[3 * 33]}, b = {s[4 * 33], s[5 * 33], s[6 * 33], s[7 * 33]};
            *(GAS pg8::u32x2*)((unsigned char*)WT + base8 + (size_t)dr * K + k0 + 8 * c) = pg8::pack8_fp8(a * pg8::F8_SW, b * pg8::F8_SW);
        } else {
            v4u o; o.x = pk2(s[0 * 33], s[1 * 33]); o.y = pk2(s[2 * 33], s[3 * 33]); o.z = pk2(s[4 * 33], s[5 * 33]); o.w = pk2(s[6 * 33], s[7 * 33]);
            *(GAS v4u*)(WT + (size_t)dr * K + k0 + 8 * c) = o; } }
    LDS_WAIT(); asm volatile("" ::: "memory");
}
template <int R>
__device__ __forceinline__ void rms_rows_to_bf16(Frame& F, const float* xrow, const float* gain, bf16* orow, unsigned char* orow8, float* rn) {
    const GAS f32x4* xr = (const GAS f32x4*)xrow + mk_lane(); const GAS f32x4* gr = (const GAS f32x4*)gain + mk_lane();
    f32x4 v[R][4]; float s[R];
#pragma unroll
    for (int r = 0; r < R; ++r)
#pragma unroll
        for (int j = 0; j < 4; ++j) v[r][j] = xr[r * 256 + 64 * j];
#pragma unroll
    for (int r = 0; r < R; ++r) { s[r] = 0.f;
#pragma unroll
        for (int j = 0; j < 4; ++j) s[r] += (v[r][j].x * v[r][j].x + v[r][j].y * v[r][j].y) + (v[r][j].z * v[r][j].z + v[r][j].w * v[r][j].w); }
#pragma unroll
    for (int o = 1; o < 64; o <<= 1)
#pragma unroll
        for (int r = 0; r < R; ++r) s[r] += __shfl_xor(s[r], o);
    const int ln_ = mk_lane(); GAS unsigned long long* o8 = (GAS unsigned long long*)orow + ln_; GAS unsigned* q8 = (GAS unsigned*)orow8 + ln_;
#pragma unroll
    for (int r = 0; r < R; ++r) { const float rms = sqrtf(s[r] * (1.f / D) + RMS_EPS), rstd = 1.f / rms; if (ln_ == 0) rn[r] = rms;
#pragma unroll
        for (int j = 0; j < 4; ++j) { const f32x4 g = gr[64 * j];
            const f32x4 y = v[r][j] * rstd * g;
            o8[r * 256 + 64 * j] = (unsigned long long)pk2(y.x, y.y) | ((unsigned long long)pk2(y.z, y.w) << 32);
            unsigned t = 0; t = __builtin_amdgcn_cvt_pk_fp8_f32(y.x * pg8::F8_SA, y.y * pg8::F8_SA, t, false); t = __builtin_amdgcn_cvt_pk_fp8_f32(y.z * pg8::F8_SA, y.w * pg8::F8_SA, t, true); q8[r * 256 + 64 * j] = t; } }
}
__device__ __forceinline__ void p0_prologue(Frame& F) {
    LAS float* scr = (LAS float*)(F.lds + RING_OFF + F.wave * 16384);
    const int gw = F.vcu * NWAVES + F.wave, NGW = F.G * NWAVES;
    constexpr int I_IN = (D / 64) * (NQKV / 32), I_O = (D / 64) * (D / 32), I_G = (D / 64) * (FF / 32), I_D = (FF / 64) * (D / 32);
    constexpr int NITEMS = I_IN + I_O + 2 * I_G + I_D;
    for (int it = gw; it < NITEMS; it += NGW) {
        int r = it;
        if (r < I_IN) { p0_item<0>(F.w_in, D, NQKV, F.Wqkv_t, nullptr, nullptr, scr, r, mk_lane()); continue; } r -= I_IN;
        if (r < I_O) { p0_item<1>(F.w_out, D, D, F.Wo_t, F.moba_norm, F.dil_norm, scr, r, mk_lane()); continue; } r -= I_O;
        if (r < I_G) { p0_item<2>(F.w_gate, D, FF, F.Wgu_t, F.ffn_norm, nullptr, scr, r, mk_lane()); continue; } r -= I_G;
        if (r < I_G) { p0_item<3>(F.w_up, D, FF, F.Wgu_t, F.ffn_norm, nullptr, scr, r, mk_lane()); continue; } r -= I_G;
        p0_item<4>(F.w_down, FF, D, F.Wd_t, nullptr, nullptr, scr, r, mk_lane());
    }
    for (int e = (F.vcu * NWAVES * 64) + F.wave * 64 + mk_lane(); e < SEQ * 32; e += F.G * NWAVES * 64) {
        const int s = e >> 5, j = e & 31;
        const float invf = __builtin_amdgcn_exp2f(-(float)j * (13.287712379549449f / 32.0f));
        double rev = (double)s * (double)invf * 0.15915494309189535; rev -= __builtin_floor(rev);
        const float r = (float)rev;
        pg8::f32x2 cs; cs.x = __builtin_amdgcn_cosf(r); cs.y = __builtin_amdgcn_sinf(r);
        *(GAS pg8::f32x2*)((pg8::f32x2*)F.rope + e) = cs;
    }
    for (int m = 4 * gw; m < M; m += 4 * NGW) rms_rows_to_bf16<4>(F, F.x + (size_t)m * D, F.attn_norm, F.XN + (size_t)m * D, F.XN8 + (size_t)m * D, (float*)(F.kpart + 131072) + m);
}

__device__ __forceinline__ void p6_final(Frame& F) {
    const int gw = F.vcu * NWAVES + F.wave, NGW = F.G * NWAVES;
    const GAS f32x4* gr = (const GAS f32x4*)F.final_norm + mk_lane();
    for (int m = gw; m < M; m += NGW) {
        GAS f32x4* xr = (GAS f32x4*)(F.out + (size_t)m * D) + mk_lane();
        const GAS f32x4* sp = (const GAS f32x4*)(F.ssq2 + (size_t)m * 16);
        const f32x4 a = sp[0], b = sp[1], c = sp[2], d = sp[3];
        const float ss = ((a.x + a.y) + (a.z + a.w)) + ((b.x + b.y) + (b.z + b.w)) + ((c.x + c.y) + (c.z + c.w)) + ((d.x + d.y) + (d.z + d.w));
        const float rstd = 1.f / sqrtf(ss * (1.f / D) + RMS_EPS);
#pragma unroll
        for (int j = 0; j < 4; ++j) { const f32x4 v = xr[64 * j], g = gr[64 * j]; xr[64 * j] = v * rstd * g; }
    }
}

struct Args { const float* in[11]; float* out; unsigned char* ws; int ph_lo, ph_hi, li, pad; };
__global__ void __launch_bounds__(NWAVES * 64, 2) mk_fwd(Args args) {
    extern __shared__ __attribute__((aligned(16))) unsigned char lds[];
    Frame F;
    F.lds = (LAS unsigned char*)lds;
    F.MISC = (volatile LAS unsigned*)(F.lds + MISC_OFF);
    F.wave = __builtin_amdgcn_readfirstlane((int)(threadIdx.x >> 6));
    F.G = gridDim.x; { const int bx = blockIdx.x; F.vcu = (F.G % 8 == 0) ? (bx % 8) * (F.G / 8) + bx / 8 : bx; }
#define GRID_BAR(seam) do { if (N_LAUNCHES == PER_PHASE) { if ((F.wave == 0 && mk_lane() == 0)) __hip_atomic_store(F.ctl + CW_TMO, 0xBADBA0u | (unsigned)(seam), RLX_AGENT); } \
    else { xcd_barrier(bar, F.wave); if (MK_REPEAT_PHASE == 30) xcd_barrier(bar, F.wave); } } while (0)
    unsigned char* ws = args.ws;
    F.ctl = (gu32*)(ws + WS_CTL);
    F.x = args.in[0]; F.attn_norm = args.in[1]; F.w_in = args.in[2]; F.moba_norm = args.in[3]; F.dil_norm = args.in[4]; F.w_out = args.in[5];
    F.ffn_norm = args.in[6]; F.w_gate = args.in[7]; F.w_up = args.in[8]; F.w_down = args.in[9]; F.final_norm = args.in[10]; F.out = args.out;
    F.Wqkv_t = (bf16*)(ws + WS_WQKV); F.Wo_t = (bf16*)(ws + WS_WO); F.Wgu_t = (bf16*)(ws + WS_WGU); F.Wd_t = (bf16*)(ws + WS_WD);
    F.QO = (bf16*)(ws + WS_QO); F.KB = (bf16*)(ws + WS_K); F.VB = (bf16*)(ws + WS_V); F.HB = ws + WS_H; F.XN8 = ws + WS_XN8; F.XN = (bf16*)(ws + WS_XN); F.OB = (bf16*)(ws + WS_O);
    F.rope = (float*)(ws + WS_ROPE); F.kpart = (float*)(ws + WS_KPART); F.ssqa = (float*)(ws + WS_SSQA); F.ssq1 = (float*)(ws + WS_SSQ1); F.ssq2 = (float*)(ws + WS_SSQ2);
    for (int u = F.wave * 64 + mk_lane(); u < (LDS_BYTES - LDSCTL_OFF) / 4; u += NWAVES * 64) ((LAS unsigned*)(F.lds + LDSCTL_OFF))[u] = 0u;
    __syncthreads();
    XcdBarrier bar; bar.bar = (unsigned*)(F.ctl + CW_BAR); bar.x = 0; bar.st = nullptr;
    if (N_LAUNCHES != PER_PHASE) bar = xcd_barrier_post((unsigned*)(F.ctl + CW_BAR), F.MISC + 8, F.wave);
    const int lo = args.ph_lo, hi = args.ph_hi;
#define IN(k) (lo <= (k) && (k) < hi)
#define BOTH(k) (IN(k) && IN((k) + 1))

    if (IN(0)) { for (int rp = 0; rp < (MK_REPEAT_PHASE == 0 ? 2 : 1); ++rp) p0_prologue(F); if (BOTH(0)) GRID_BAR(0); }

    if (IN(1)) {
        { pg8::Gemm g{F.XN, F.Wqkv_t, M, 1024, D}; pg8::StaticOrder S; S.init(M, 1024, F.G, (int)blockIdx.x, MK_REPEAT_PHASE == 1 ? 2 : 1);
          pg8::EpiQKV E{F.QO, (size_t)(WS_K - WS_QO) / 2, F.rope, F.kpart, QSCALE, 1, 1.f};
          pg8::gemm_phase<pg8::EpiQKV, pg8::StaticOrder, true, true>(F.lds + RING_OFF, g, S, E, F.wave); }
        { pg8::Gemm g{(const bf16*)F.XN8, (const bf16*)((const unsigned char*)F.Wqkv_t + QKV8_OFF), M, 2048, D}; pg8::StaticOrder S; S.init(M, 2048, F.G, (int)blockIdx.x, MK_REPEAT_PHASE == 1 ? 2 : 1);
          pg8::EpiQKV E{F.QO, (size_t)(WS_K - WS_QO) / 2, F.rope, F.kpart, QSCALE, 2, 1.f / (pg8::F8_SA * pg8::F8_SW)};
          pg8::gemm_phase<pg8::EpiQKV, pg8::StaticOrder, true, true, true>(F.lds + RING_OFF, g, S, E, F.wave); }
        if (BOTH(1)) GRID_BAR(1);
    }

    if (IN(2)) {
        if (F.G == 256) {
            for (int rp = 0; rp < (MK_REPEAT_PHASE == 2 ? 2 : 1); ++rp) attn_body::attn_phase<8>((char*)lds + RING_OFF, ws, (unsigned*)(F.ctl + CW_FAR), F.vcu, F.G, F.wave);
        }
        if (BOTH(2)) GRID_BAR(2);
    }

    if (IN(3)) {
        pg8::Gemm g{(const bf16*)(ws + WS_O8), F.Wo_t, M, D, D};   pg8::StaticOrder S; S.init(M, D, F.G, (int)blockIdx.x, MK_REPEAT_PHASE == 3 ? 2 : 1);
        pg8::EpiWo E{F.kpart + 131072, F.attn_norm, F.XN, (MK_REPEAT_PHASE == 3) ? (bf16*)(ws + 394 * MiB) : F.XN, (MK_REPEAT_PHASE == 3) ? ws + 458 * MiB : F.XN8, F.ssqa, F.ssq1};
        pg8::gemm_phase<pg8::EpiWo, pg8::StaticOrder, true, true, true>(F.lds + RING_OFF, g, S, E, F.wave);
        if (BOTH(3)) GRID_BAR(3);
    }

    if (IN(4)) {
        pg8::Gemm g{(const bf16*)((MK_REPEAT_PHASE == 3) ? ws + 458 * MiB : F.XN8), F.Wgu_t, M, NGU, D}; pg8::StaticOrder S; S.init(M, NGU, F.G, (int)blockIdx.x, MK_REPEAT_PHASE == 4 ? 2 : 1);
        pg8::EpiGU E{F.ssq1, F.HB};
        pg8::gemm_phase<pg8::EpiGU, pg8::StaticOrder, true, true, true>(F.lds + RING_OFF, g, S, E, F.wave);
        if (BOTH(4)) GRID_BAR(4);
    }

    if (IN(5)) {
        pg8::Gemm g{(const bf16*)F.HB, F.Wd_t, M, D, FF};   pg8::StaticOrder S; S.init(M, D, F.G, (int)blockIdx.x, MK_REPEAT_PHASE == 5 ? 2 : 1);
#if defined(MK_SPLIT_FINAL)
        pg8::EpiDown E{F.XN, F.out, F.ssq2};
        pg8::gemm_phase<pg8::EpiDown, pg8::StaticOrder, true, true, true>(F.lds + RING_OFF, g, S, E, F.wave);
        if (BOTH(5)) GRID_BAR(5);
#else
        if (F.G == 256) { pg8::EpiDownNorm E{(MK_REPEAT_PHASE == 3) ? (bf16*)(ws + 394 * MiB) : F.XN, F.out, F.ssq2, (unsigned*)(F.ctl + CW_PANEL), F.final_norm};
            pg8::gemm_phase<pg8::EpiDownNorm, pg8::StaticOrder, true, true, true>(F.lds + RING_OFF, g, S, E, F.wave); }
        else { pg8::EpiDown E{F.XN, F.out, F.ssq2}; pg8::gemm_phase<pg8::EpiDown, pg8::StaticOrder, true, true, true>(F.lds + RING_OFF, g, S, E, F.wave); GRID_BAR(5); p6_final(F); }
#endif
    }

#if defined(MK_SPLIT_FINAL)
    if (IN(6)) { p6_final(F); }
#endif
#undef IN
#undef BOTH
}

extern "C" void kernel_launch(void* const* d_in, const int* in_sizes, int n_in, void* d_out, int out_size, void* d_ws, size_t ws_size, hipStream_t stream) {
    static int grid = 0;
    if (grid == 0) {
        if (n_in != 11 || in_sizes[0] != M * D || out_size != M * D || ws_size < WS_END) { fprintf(stderr, "kernel_launch: unexpected shapes (n_in %d, in0 %d, out %d, ws %zu); nothing launched\n", n_in, n_in > 0 ? in_sizes[0] : -1, out_size, ws_size); grid = -1; return; }
        int dev = 0, cus = 0, per_cu = 0;
        if (hipGetDevice(&dev) != hipSuccess || hipDeviceGetAttribute(&cus, hipDeviceAttributeMultiprocessorCount, dev) != hipSuccess) { grid = -1; return; }
        if (hipFuncSetAttribute((const void*)mk_fwd, hipFuncAttributeMaxDynamicSharedMemorySize, LDS_BYTES) != hipSuccess) { fprintf(stderr, "kernel_launch: hipFuncSetAttribute failed\n"); grid = -1; return; }
        if (hipOccupancyMaxActiveBlocksPerMultiprocessor(&per_cu, (const void*)mk_fwd, NWAVES * 64, LDS_BYTES) != hipSuccess || per_cu < 1) { fprintf(stderr, "kernel_launch: occupancy query says %d blocks per CU\n", per_cu); (void)hipGetLastError(); per_cu = 1; }
        grid = cus;
        if (grid > 256) grid = 256;
    }
    if (grid < 0) return;
    if (hipMemsetAsync((char*)d_ws + WS_CTL, 0, CTL_ZERO_BYTES, stream) != hipSuccess) { fprintf(stderr, "kernel_launch: hipMemsetAsync failed\n"); return; }
    Args a{};
    for (int i = 0; i < 11; ++i) a.in[i] = (const float*)d_in[i];
    a.out = (float*)d_out; a.ws = (unsigned char*)d_ws;
    for (int li = 0; li < N_LAUNCHES; ++li) {
        a.ph_lo = (N_LAUNCHES == PER_PHASE) ? li : 0; a.ph_hi = (N_LAUNCHES == PER_PHASE) ? li + 1 : PER_PHASE; a.li = li;
        hipLaunchKernelGGL(mk_fwd, dim3(grid), dim3(NWAVES * 64), LDS_BYTES, stream, a);
        const hipError_t le = hipPeekAtLastError();
        if (le != hipSuccess) { fprintf(stderr, "kernel_launch: launch %d failed: %s\n", li, hipGetErrorName(le)); break; }
    }
}
```

```cpp
#include <hip/hip_runtime.h>
#include <cstdio>
#include <cstdint>
namespace pg8 {
#define PG8_LAS __attribute__((address_space(3)))
typedef unsigned short bf16_t;
typedef short bf16x8 __attribute__((ext_vector_type(8)));
typedef float f32x4 __attribute__((ext_vector_type(4)));
typedef unsigned u32x4 __attribute__((ext_vector_type(4)));
typedef int i32x4 __attribute__((ext_vector_type(4)));
typedef int i32x8 __attribute__((ext_vector_type(8)));
typedef unsigned u32x2 __attribute__((ext_vector_type(2)));
constexpr int BM = 256, BK = 64, HALF = 128, HTB = HALF * BK * 2  , STAGE_BYTES = 8 * HTB, NXCD = 8, WGM = 8;

__host__ __device__ __forceinline__ int lds_byte(int r, int c) { const int st = (r >> 4) * 2 + (c >> 5), rr = r & 15, cc = c & 31, ob = rr * 64 + cc * 2; return st * 1024 + (ob ^ (((ob >> 9) & 1) << 5)); }
__host__ __device__ __forceinline__ void stage_rc(int b, int& R, int& C) { const int st = b / 1024, sb = b % 1024, swz = sb ^ (((sb >> 9) & 1) << 5); R = (st >> 1) * 16 + swz / 64; C = (st & 1) * 32 + (swz % 64) / 2; }
__host__ __device__ __forceinline__ int perm32(int rho) { const int n = rho >> 4, i = rho & 15; return 8 * (i >> 2) + 4 * n + (i & 3); }

struct Unit { int pm, pn; };
struct Gemm { const bf16_t* A; const bf16_t* Bt; int M, N, K; };

struct StaticOrder {
    int nM, nN, nwg, G, c, reps, r0 = 0, r1 = 1 << 30;
    __host__ __device__ void init(int M, int N, int G_, int c_, int reps_ = 1) { nM = M / BM; nN = N / BM; nwg = nM * nN; G = G_; c = c_; reps = reps_; }
    __host__ __device__ bool next(int i, Unit& u) const {
        const int rounds = (nwg + G - 1) / G; i += r0; if (i >= reps * rounds || i >= r1) return false;
        const long L = (long)(i % rounds) * G + c; if (L >= nwg) return false;
        int wgid = (int)L; { const int q = nwg / NXCD, r = nwg % NXCD, xcd = wgid % NXCD, off = wgid / NXCD; wgid = (xcd < r ? xcd * (q + 1) : r * (q + 1) + (xcd - r) * q) + off; }
        const int nig = WGM * nN, gid = wgid / nig, fm = gid * WGM, gsz = (nM - fm) < WGM ? (nM - fm) : WGM;
        u.pm = fm + ((wgid % nig) % gsz); u.pn = (wgid % nig) / gsz; return true;
    }
    __device__ __forceinline__ void a_ready(const Unit&) const {}
    __device__ __forceinline__ void done(const Unit&) const {}
};


__device__ __forceinline__ unsigned cvt_pk_bf16(float lo, float hi) { unsigned r; asm volatile("v_cvt_pk_bf16_f32 %0, %1, %2" : "=v"(r) : "v"(lo), "v"(hi)); return r; }
__device__ __forceinline__ u32x4 pack8(const f32x4 a, const f32x4 b) { u32x4 w; w.x = cvt_pk_bf16(a[0], a[1]); w.y = cvt_pk_bf16(a[2], a[3]); w.z = cvt_pk_bf16(b[0], b[1]); w.w = cvt_pk_bf16(b[2], b[3]); return w; }
__device__ __forceinline__ float sum4(const f32x4 a) { return (a[0] + a[1]) + (a[2] + a[3]); }
__device__ __forceinline__ float sq4(const f32x4 a) { return (a[0] * a[0] + a[1] * a[1]) + (a[2] * a[2] + a[3] * a[3]); }
constexpr float RMS_EPS_F = 1e-6f;
__device__ __forceinline__ int lane_id() { int l; asm volatile("v_mbcnt_lo_u32_b32 %0, -1, 0\n\tv_mbcnt_hi_u32_b32 %0, -1, %0" : "=v"(l)); return l; }
__device__ __forceinline__ u32x2 pack8_fp8(const f32x4 a, const f32x4 b) { u32x2 w; unsigned t = 0;
    t = __builtin_amdgcn_cvt_pk_fp8_f32(a[0], a[1], t, false); t = __builtin_amdgcn_cvt_pk_fp8_f32(a[2], a[3], t, true); w.x = t; t = 0;
    t = __builtin_amdgcn_cvt_pk_fp8_f32(b[0], b[1], t, false); t = __builtin_amdgcn_cvt_pk_fp8_f32(b[2], b[3], t, true); w.y = t; return w; }
constexpr float F8_SA = 16.f, F8_SH = 8.f, F8_SW = 512.f, F8_SO = 64.f;
typedef float f32x2 __attribute__((ext_vector_type(2)));

struct EpiQKV {
    static constexpr bool PERM = true, AFTER_DRAIN = false, HAS_MID = false;
    bf16_t* Q; size_t part_stride; const float* rope; float* kpart; float qscale; int mapsel; float ascale;
    __device__ __forceinline__ void operator()(const f32x4 (&acc)[2][2][4][2], const Unit& u, int wr, int wc, int fr_, int fq_) const {
        const int ln_ = lane_id(), fr = ln_ & 15, fq = ln_ >> 4;
        const int rp = mapsel == 1 ? ((u.pn & 1) + 4 * (u.pn >> 1)) : (mapsel == 2 ? (u.pn < 4 ? (2 + (u.pn & 1) + 4 * (u.pn >> 1)) : u.pn + 4) : u.pn);
        const int part = rp >> 2, head = (rp & 3) * 4 + wc;
        bf16_t* base = Q + (size_t)part * part_stride + head * 64 + 8 * fq;
        const float sc = part == 0 ? qscale : 1.f;
        const bool rot = part != 2, km = (part == 1) && (head < 8);
        const int row0 = u.pm * BM + wr * 64 + fr;
        int rbase = row0; asm volatile("" : "+v"(rbase));
        f32x4 ks[2][2];
#pragma unroll
        for (int a = 0; a < 2; ++a)
#pragma unroll
            for (int b = 0; b < 2; ++b) ks[a][b] = (f32x4){0.f, 0.f, 0.f, 0.f};
#pragma unroll
        for (int ai = 0; ai < 2; ++ai)
#pragma unroll
            for (int m = 0; m < 4; ++m) {
                const int row = rbase + ai * HALF + m * 16;
                const int s = row & 4095;
                const f32x4* rp = (const f32x4*)(rope + ((size_t)s * 32 + 8 * fq) * 2);
                f32x4 t0, t1, t2, t3;
                if (rot) { t0 = rp[0]; t1 = rp[1]; t2 = rp[2]; t3 = rp[3]; } else { t0 = t1 = t2 = t3 = (f32x4){1.f, 0.f, 1.f, 0.f}; }
                f32x4 o1[2], o2[2];
#pragma unroll
                for (int n = 0; n < 2; ++n) {
                    const f32x4 cv = n == 0 ? (f32x4){t0[0], t0[2], t1[0], t1[2]} : (f32x4){t2[0], t2[2], t3[0], t3[2]};
                    const f32x4 sv = n == 0 ? (f32x4){t0[1], t0[3], t1[1], t1[3]} : (f32x4){t2[1], t2[3], t3[1], t3[3]};
                    const f32x4 x1 = acc[ai][0][m][n] * ascale, x2 = acc[ai][1][m][n] * ascale;
                    o1[n] = x1 * cv - x2 * sv; o2[n] = x2 * cv + x1 * sv;
                    if (km) { ks[0][n] += o1[n]; ks[1][n] += o2[n]; }
                    o1[n] = o1[n] * sc; o2[n] = o2[n] * sc;
                }
                bf16_t* rowp = base + (size_t)row * 1024;
                *(u32x4*)(rowp) = pack8(o1[0], o1[1]); *(u32x4*)(rowp + 32) = pack8(o2[0], o2[1]);
            }
        if (km) {
#pragma unroll
            for (int bj = 0; bj < 2; ++bj)
#pragma unroll
                for (int n = 0; n < 2; ++n) { f32x4 v = ks[bj][n];
#pragma unroll
                    for (int o = 1; o < 16; o <<= 1) { v[0] += __shfl_xor(v[0], o); v[1] += __shfl_xor(v[1], o); v[2] += __shfl_xor(v[2], o); v[3] += __shfl_xor(v[3], o); }
                    if (fr == 0) *(f32x4*)(kpart + (size_t)(u.pm * 2 + wr) * 512 + head * 64 + 32 * bj + 8 * fq + 4 * n) = v; }
        }
    }
};

struct EpiWo {
    static constexpr bool PERM = true, AFTER_DRAIN = false, HAS_MID = true;
    const float* rn0; const float* gain0; bf16_t* xn; bf16_t* xo; unsigned char* xn8;
    const float* ssq_att; float* ssq1;
    __device__ __forceinline__ void rstds(int row, int fq, float& rm, float& rd) const {
        const float s = sum4(*(const f32x4*)(ssq_att + (size_t)row * 16 + 4 * fq));
        const float t = s + __shfl_xor(s, 16), o = __shfl_xor(t, 32);
        rm = __builtin_amdgcn_rsqf((fq < 2 ? t : o) * (1.f / 512.f) + RMS_EPS_F);
        rd = __builtin_amdgcn_rsqf((fq < 2 ? o : t) * (1.f / 512.f) + RMS_EPS_F);
    }
    static constexpr float ASCALE = 1.f / (F8_SO * F8_SW);
    __device__ __forceinline__ void mid(f32x4 (&acc)[2][2][4][2], const Unit& u, int wr, int fr_) const {
        const int ln_ = lane_id(), fr = ln_ & 15, fq = ln_ >> 4;
        const int row0 = u.pm * BM + wr * 64 + fr;
        int rbase = row0; asm volatile("" : "+v"(rbase));
        float f[8];
#pragma unroll
        for (int i = 0; i < 8; ++i) { float rm, rd; rstds(rbase + (i >> 2) * HALF + (i & 3) * 16, fq, rm, rd); f[i] = rm / rd; }
#pragma unroll
        for (int ai = 0; ai < 2; ++ai)
#pragma unroll
            for (int m = 0; m < 4; ++m)
#pragma unroll
                for (int bj = 0; bj < 2; ++bj)
#pragma unroll
                    for (int n = 0; n < 2; ++n) acc[ai][bj][m][n] = acc[ai][bj][m][n] * f[ai * 4 + m];
    }
    __device__ __forceinline__ void operator()(const f32x4 (&acc)[2][2][4][2], const Unit& u, int wr, int wc, int fr_, int fq_) const {
        const int ln_ = lane_id(), fr = ln_ & 15, fq = ln_ >> 4;
        const int row0 = u.pm * BM + wr * 64 + fr, col0 = u.pn * BM + wc * 32 + 8 * fq;
        int rbase = row0; asm volatile("" : "+v"(rbase));
        f32x4 ig[2][2];
#pragma unroll
        for (int bj = 0; bj < 2; ++bj)
#pragma unroll
            for (int n = 0; n < 2; ++n) { const f32x4 g = *(const f32x4*)(gain0 + col0 + bj * HALF + 4 * n);
                ig[bj][n] = (f32x4){__builtin_amdgcn_rcpf(g[0]), __builtin_amdgcn_rcpf(g[1]), __builtin_amdgcn_rcpf(g[2]), __builtin_amdgcn_rcpf(g[3])}; }
#pragma unroll
        for (int ai = 0; ai < 2; ++ai)
#pragma unroll
            for (int m = 0; m < 4; ++m) { const int row = rbase + ai * HALF + m * 16; float rm, rd; rstds(row, fq, rm, rd); float s = 0.f; const float rn = rn0[row];
#pragma unroll
                for (int bj = 0; bj < 2; ++bj) { unsigned off = (unsigned)row * 1024u + col0 + bj * HALF; asm volatile("" : "+v"(off));
                    const u32x4 xw = *(const u32x4*)(xn + off);
                    const f32x4 xa = (f32x4){__uint_as_float(xw.x << 16), __uint_as_float(xw.x & 0xffff0000u), __uint_as_float(xw.y << 16), __uint_as_float(xw.y & 0xffff0000u)} * ig[bj][0] * rn;
                    const f32x4 xb = (f32x4){__uint_as_float(xw.z << 16), __uint_as_float(xw.z & 0xffff0000u), __uint_as_float(xw.w << 16), __uint_as_float(xw.w & 0xffff0000u)} * ig[bj][1] * rn;
                    const f32x4 v0 = xa + acc[ai][bj][m][0] * (rd * ASCALE), v1 = xb + acc[ai][bj][m][1] * (rd * ASCALE);
                    *(u32x4*)(xo + off) = pack8(v0, v1); *(u32x2*)(xn8 + off) = pack8_fp8(v0 * F8_SA, v1 * F8_SA); s += sq4(v0) + sq4(v1); }
                s += __shfl_xor(s, 16); s += __shfl_xor(s, 32);
                if (fq == 0) ssq1[(size_t)row * 16 + u.pn * 4 + wc] = s;
                asm volatile("" ::: "memory"); }
    }
};

struct EpiGU {
    static constexpr bool PERM = true, AFTER_DRAIN = false, HAS_MID = false;
    const float* ssq1; unsigned char* H;
    __device__ __forceinline__ void operator()(const f32x4 (&acc)[2][2][4][2], const Unit& u, int wr, int wc, int fr_, int fq_) const {
        const int ln_ = lane_id(), fr = ln_ & 15, fq = ln_ >> 4;
        const int row0 = u.pm * BM + wr * 64 + fr, col0 = u.pn * HALF + wc * 32 + 8 * fq;
        int rbase = row0; asm volatile("" : "+v"(rbase));
#pragma unroll
        for (int ai = 0; ai < 2; ++ai)
#pragma unroll
            for (int m = 0; m < 4; ++m) { const int row = rbase + ai * HALF + m * 16;
                float ss = sum4(*(const f32x4*)(ssq1 + (size_t)row * 16 + 4 * fq));
                ss += __shfl_xor(ss, 16); ss += __shfl_xor(ss, 32);
                const float rstd = __builtin_amdgcn_rsqf(ss * (1.f / 1024.f) + RMS_EPS_F) * (1.f / (F8_SA * F8_SW));
                f32x4 h[2];
                const float rs_e = rstd * -1.4426950408889634f, rs_u = rstd * (rstd * F8_SH);
#pragma unroll
                for (int n = 0; n < 2; ++n) { const f32x4 ea = acc[ai][0][m][n] * rs_e, gu = (acc[ai][0][m][n] * acc[ai][1][m][n]) * rs_u;
#pragma unroll
                    for (int i = 0; i < 4; ++i) h[n][i] = gu[i] * __builtin_amdgcn_rcpf(1.f + __builtin_amdgcn_exp2f(ea[i])); }
                *(u32x2*)(H + (size_t)row * 2816 + col0) = pack8_fp8(h[0], h[1]); }
    }
};

struct EpiDown {
    static constexpr bool PERM = true, AFTER_DRAIN = false, HAS_MID = false;
    const bf16_t* xn; float* out; float* ssq2;
    __device__ __forceinline__ void operator()(const f32x4 (&acc)[2][2][4][2], const Unit& u, int wr, int wc, int fr_, int fq_) const {
        const int ln_ = lane_id(), fr = ln_ & 15, fq = ln_ >> 4;
        const int row0 = u.pm * BM + wr * 64 + fr, col0 = u.pn * BM + wc * 32 + 8 * fq;
        int rbase = row0; asm volatile("" : "+v"(rbase));
#pragma unroll
        for (int ai = 0; ai < 2; ++ai)
#pragma unroll
            for (int m = 0; m < 4; ++m) { const int row = rbase + ai * HALF + m * 16; float s = 0.f;
#pragma unroll
                for (int bj = 0; bj < 2; ++bj) { const size_t off = (size_t)row * 1024 + col0 + bj * HALF;
                    const u32x4 xw = *(const u32x4*)(xn + off);
                    const f32x4 xa = {__uint_as_float(xw.x << 16), __uint_as_float(xw.x & 0xffff0000u), __uint_as_float(xw.y << 16), __uint_as_float(xw.y & 0xffff0000u)};
                    const f32x4 xb = {__uint_as_float(xw.z << 16), __uint_as_float(xw.z & 0xffff0000u), __uint_as_float(xw.w << 16), __uint_as_float(xw.w & 0xffff0000u)};
                    const f32x4 v0 = xa + acc[ai][bj][m][0] * (1.f / (F8_SH * F8_SW)), v1 = xb + acc[ai][bj][m][1] * (1.f / (F8_SH * F8_SW));
                    *(f32x4*)(out + off) = v0; *(f32x4*)(out + off + 4) = v1; s += sq4(v0) + sq4(v1); }
                s += __shfl_xor(s, 16); s += __shfl_xor(s, 32);
                if (fq == 0) ssq2[(size_t)row * 16 + u.pn * 4 + wc] = s;
                asm volatile("" ::: "memory"); }
    }
};

struct EpiDownNorm {
    static constexpr bool PERM = true, AFTER_DRAIN = false, HAS_MID = false;
    const bf16_t* xn; float* out; float* ssq2; unsigned* cnt; const float* gain;
    __device__ __forceinline__ void operator()(f32x4 (&acc)[2][2][4][2], const Unit& u, int wr, int wc, int fr_, int fq_) const {
        const int ln_ = lane_id(), fr = ln_ & 15, fq = ln_ >> 4;
        const int row0 = u.pm * BM + wr * 64 + fr, col0 = u.pn * BM + wc * 32 + 8 * fq;
        int rbase = row0; asm volatile("" : "+v"(rbase));
#pragma unroll
        for (int ai = 0; ai < 2; ++ai)
#pragma unroll
            for (int m = 0; m < 4; ++m) { const int row = rbase + ai * HALF + m * 16; float s = 0.f;
#pragma unroll
                for (int bj = 0; bj < 2; ++bj) { const size_t off = (size_t)row * 1024 + col0 + bj * HALF;
                    const u32x4 xw = *(const u32x4*)(xn + off);
                    const f32x4 xa = {__uint_as_float(xw.x << 16), __uint_as_float(xw.x & 0xffff0000u), __uint_as_float(xw.y << 16), __uint_as_float(xw.y & 0xffff0000u)};
                    const f32x4 xb = {__uint_as_float(xw.z << 16), __uint_as_float(xw.z & 0xffff0000u), __uint_as_float(xw.w << 16), __uint_as_float(xw.w & 0xffff0000u)};
                    acc[ai][bj][m][0] = acc[ai][bj][m][0] * (1.f / (F8_SH * F8_SW)) + xa; acc[ai][bj][m][1] = acc[ai][bj][m][1] * (1.f / (F8_SH * F8_SW)) + xb; s += sq4(acc[ai][bj][m][0]) + sq4(acc[ai][bj][m][1]); }
                s += __shfl_xor(s, 16); s += __shfl_xor(s, 32);
                if (fq == 0) __hip_atomic_store(ssq2 + (size_t)(u.pn * 4 + wc) * 32768 + row, s, __ATOMIC_RELAXED, __HIP_MEMORY_SCOPE_AGENT);
                asm volatile("" ::: "memory"); }
        asm volatile("s_waitcnt vmcnt(0)" ::: "memory");
        unsigned* cw = cnt + 64 * u.pm;
        if (fr == 0 && fq == 0) __hip_atomic_fetch_add(cw, 1u, __ATOMIC_RELAXED, __HIP_MEMORY_SCOPE_AGENT);
        { unsigned sp = 0; while ((unsigned)__builtin_amdgcn_readfirstlane((int)__hip_atomic_load(cw, __ATOMIC_RELAXED, __HIP_MEMORY_SCOPE_AGENT)) < 32u) { __builtin_amdgcn_s_sleep(1); if (++sp > (1u << 22)) break; } }
        f32x4 g[2][2];
#pragma unroll
        for (int bj = 0; bj < 2; ++bj) { g[bj][0] = *(const f32x4*)(gain + col0 + bj * HALF); g[bj][1] = *(const f32x4*)(gain + col0 + bj * HALF + 4); }
#pragma unroll
        for (int ai = 0; ai < 2; ++ai)
#pragma unroll
            for (int m = 0; m < 4; ++m) { const int row = rbase + ai * HALF + m * 16;
                const float* pp = ssq2 + (size_t)(4 * fq) * 32768 + row;
                float s = (__hip_atomic_load(pp, __ATOMIC_RELAXED, __HIP_MEMORY_SCOPE_AGENT) + __hip_atomic_load(pp + 32768, __ATOMIC_RELAXED, __HIP_MEMORY_SCOPE_AGENT))
                        + (__hip_atomic_load(pp + 2 * 32768, __ATOMIC_RELAXED, __HIP_MEMORY_SCOPE_AGENT) + __hip_atomic_load(pp + 3 * 32768, __ATOMIC_RELAXED, __HIP_MEMORY_SCOPE_AGENT));
                s += __shfl_xor(s, 16); s += __shfl_xor(s, 32);
                const float rstd = __builtin_amdgcn_rsqf(s * (1.f / 1024.f) + RMS_EPS_F);
#pragma unroll
                for (int bj = 0; bj < 2; ++bj) { const size_t off = (size_t)row * 1024 + col0 + bj * HALF;
                    *(f32x4*)(out + off) = acc[ai][bj][m][0] * rstd * g[bj][0]; *(f32x4*)(out + off + 4) = acc[ai][bj][m][1] * rstd * g[bj][1]; }
                asm volatile("" ::: "memory"); }
    }
};
template <class Epi, class Sched, bool ALIGN_EPI = false, bool SP2 = false, bool F8 = false>
__device__ __forceinline__ void gemm_phase(PG8_LAS unsigned char* lds, const Gemm g, const Sched& S, const Epi& E, int wave) {
    const int wid = __builtin_amdgcn_readfirstlane(wave), lane = lane_id(), tid = wid * 64 + lane, wr = wid >> 2, wc = wid & 3, fr = lane & 15, fq = lane >> 4;
    const int K = F8 ? g.K / 2 : g.K, nt = K / BK;
    unsigned voffA[2], voffB[2];
#pragma unroll
    for (int i = 0; i < 2; ++i) { int R, C; stage_rc(tid * 16 + i * 8192, R, C); const int Rb = Epi::PERM ? ((R & ~31) + perm32(R & 31)) : R;
        voffA[i] = (unsigned)(R * K + C) * 2u; voffB[i] = (unsigned)(Rb * K + C) * 2u; }
    const unsigned kstep = (unsigned)(BK * 2);
    const unsigned hstep = (unsigned)HALF * K * 2;
    const unsigned tstep = 2 * hstep;
    const unsigned ldsw = (unsigned)wid * 1024u;
    const int aoff = lds_byte(wr * 64 + fr, fq * 8), boff = lds_byte(wc * 32 + fr, fq * 8);
#define PG8_SA(b, h) (((b) * 2 + (h)) * HTB)
#define PG8_SB(b, h) ((4 + (b) * 2 + (h)) * HTB)
    const __amdgpu_buffer_rsrc_t rsA = __builtin_amdgcn_make_buffer_rsrc((void*)g.A, 0, 0x7fffffff, 0x00020000), rsB = __builtin_amdgcn_make_buffer_rsrc((void*)g.Bt, 0, 0x7fffffff, 0x00020000);
#define PG8_STAGE(bufoff, gbase, voff) do { _Pragma("unroll") for (int _i = 0; _i < 2; ++_i) \
        __builtin_amdgcn_raw_ptr_buffer_load_lds(PG8_RS_##voff, (PG8_LAS unsigned*)(lds + (bufoff) + ldsw + _i * 8192), 16, (voff)[_i], (int)(gbase), 0, 0); } while (0)
#define PG8_RS_voffA rsA
#define PG8_RS_voffB rsB
#define PG8_LD8(base, off) __builtin_shufflevector(*(const PG8_LAS i32x4*)((base) + (off)), *(const PG8_LAS i32x4*)((base) + (off) + 1024), 0, 1, 2, 3, 4, 5, 6, 7)
#define PG8_LDA(dst, b, h) do { if constexpr (F8) { _Pragma("unroll") for (int m = 0; m < 4; ++m) dst##8[m] = PG8_LD8(abase8, PG8_SA(b, h) + m * 2048); } else { \
        _Pragma("unroll") for (int m = 0; m < 4; ++m) _Pragma("unroll") for (int k = 0; k < 2; ++k) dst[m][k] = *(const PG8_LAS bf16x8*)(lds + PG8_SA(b, h) + aoff + m * 2048 + k * 1024); } } while (0)
#define PG8_LDB(dst, b, h) do { if constexpr (F8) { _Pragma("unroll") for (int n = 0; n < 2; ++n) dst##8[n] = PG8_LD8(bbase8, PG8_SB(b, h) - PG8_SB(0, 0) + n * 2048); } else { \
        _Pragma("unroll") for (int n = 0; n < 2; ++n) _Pragma("unroll") for (int k = 0; k < 2; ++k) dst[n][k] = *(const PG8_LAS bf16x8*)(lds + PG8_SB(b, h) + boff + n * 2048 + k * 1024); } } while (0)
#define PG8_MMA(ai, bj, At, Bt) do { __builtin_amdgcn_s_setprio(1); if constexpr (F8) { _Pragma("unroll") for (int m = 0; m < 4; ++m) _Pragma("unroll") for (int n = 0; n < 2; ++n) \
        acc[ai][bj][m][n] = __builtin_amdgcn_mfma_scale_f32_16x16x128_f8f6f4(Bt##8[n], At##8[m], acc[ai][bj][m][n], 0, 0, 0, 0, 0, 0); } else \
        _Pragma("unroll") for (int m = 0; m < 4; ++m) _Pragma("unroll") for (int n = 0; n < 2; ++n) _Pragma("unroll") for (int k = 0; k < 2; ++k) \
        acc[ai][bj][m][n] = __builtin_amdgcn_mfma_f32_16x16x32_bf16(Bt[n][k], At[m][k], acc[ai][bj][m][n], 0, 0, 0); __builtin_amdgcn_s_setprio(0); } while (0)
#define PG8_WAIT_V(n) asm volatile("s_waitcnt vmcnt(" #n ")" ::: "memory")
#define PG8_WAIT_L(n) asm volatile("s_waitcnt lgkmcnt(" #n ")" ::: "memory")
#define PG8_BAR __builtin_amdgcn_s_barrier()
#define PG8_SCHED __builtin_amdgcn_sched_barrier(0)
    Unit cur, nxt; int ui = 0;
    if (!S.next(0, cur)) return;
    f32x4 acc[2][2][4][2];
#pragma unroll
    for (int a = 0; a < 2; ++a)
#pragma unroll
        for (int b = 0; b < 2; ++b)
#pragma unroll
            for (int m = 0; m < 4; ++m)
#pragma unroll
                for (int n = 0; n < 2; ++n) acc[a][b][m][n] = (f32x4){0.f, 0.f, 0.f, 0.f};
    PG8_LAS unsigned char* abase8 = lds + aoff; PG8_LAS unsigned char* bbase8 = lds + PG8_SB(0, 0) + boff;
    if constexpr (F8) { asm volatile("" : "+v"(abase8)); asm volatile("" : "+v"(bbase8)); }
    bf16x8 At[4][2], B0[2][2], B1[2][2]; i32x8 At8[4], B08[2], B18[2];
    unsigned cA = (unsigned)cur.pm * tstep, cB = (unsigned)cur.pn * tstep;
    S.a_ready(cur);
    if constexpr (SP2) {
        PG8_STAGE(PG8_SB(0, 0), cB, voffB); PG8_STAGE(PG8_SB(0, 1), cB + hstep, voffB); PG8_STAGE(PG8_SA(0, 0), cA, voffA); PG8_STAGE(PG8_SA(0, 1), cA + hstep, voffA);
        if (wr == 1) PG8_BAR;
        PG8_WAIT_V(2); PG8_BAR;
        PG8_STAGE(PG8_SB(1, 0), cB + kstep, voffB); PG8_STAGE(PG8_SA(1, 0), cA + kstep, voffA); PG8_STAGE(PG8_SB(1, 1), cB + hstep + kstep, voffB);
        PG8_WAIT_V(6); PG8_BAR;
    } else {
        PG8_STAGE(PG8_SB(0, 0), cB, voffB); PG8_STAGE(PG8_SA(0, 0), cA, voffA); PG8_STAGE(PG8_SB(0, 1), cB + hstep, voffB); PG8_STAGE(PG8_SA(0, 1), cA + hstep, voffA);
        if (wr == 1) PG8_BAR;
        PG8_WAIT_V(4); PG8_BAR;
        PG8_STAGE(PG8_SB(1, 0), cB + kstep, voffB); PG8_STAGE(PG8_SA(1, 0), cA + kstep, voffA); PG8_STAGE(PG8_SB(1, 1), cB + hstep + kstep, voffB);
        PG8_WAIT_V(6); PG8_BAR;
    }
    for (;;) {
        const bool has_next = S.next(ui + 1, nxt);
        const unsigned nA = has_next ? (unsigned)nxt.pm * tstep : cA, nB = has_next ? (unsigned)nxt.pn * tstep : cB;
#pragma nounroll
        for (int t = 0; t < nt; t += 2) {
            if constexpr (Epi::HAS_MID) { if (t == (nt >> 1)) E.mid(acc, cur, wr, fr); }
            const bool last = (t == nt - 2);
            const unsigned a1 = cA + (unsigned)(t + 1) * kstep;
            const unsigned a2 = last ? nA : cA + (unsigned)(t + 2) * kstep, b2 = last ? nB : cB + (unsigned)(t + 2) * kstep;
            const unsigned a3 = a2 + kstep, b3 = b2 + kstep;
            if (last && has_next) S.a_ready(nxt);
            if constexpr (SP2) {
            PG8_LDB(B0, 0, 0); PG8_LDB(B1, 0, 1); PG8_SCHED; PG8_LDA(At, 0, 0); PG8_STAGE(PG8_SA(1, 1), a1 + hstep, voffA);
            PG8_WAIT_V(8); PG8_WAIT_L(0); PG8_BAR; PG8_MMA(0, 0, At, B0); PG8_MMA(0, 1, At, B1); PG8_BAR; PG8_SCHED;
            PG8_LDA(At, 0, 1); PG8_STAGE(PG8_SB(0, 0), b2, voffB); PG8_STAGE(PG8_SB(0, 1), b2 + hstep, voffB); PG8_STAGE(PG8_SA(0, 0), a2, voffA);
            PG8_WAIT_V(8); PG8_WAIT_L(0); PG8_BAR; PG8_MMA(1, 0, At, B0); PG8_MMA(1, 1, At, B1); PG8_BAR; PG8_SCHED;
            PG8_LDB(B0, 1, 0); PG8_LDB(B1, 1, 1); PG8_SCHED; PG8_LDA(At, 1, 0); PG8_STAGE(PG8_SA(0, 1), a2 + hstep, voffA);
            PG8_WAIT_V(8); PG8_WAIT_L(0); PG8_BAR; PG8_MMA(0, 0, At, B0); PG8_MMA(0, 1, At, B1); PG8_BAR; PG8_SCHED;
            PG8_LDA(At, 1, 1); PG8_STAGE(PG8_SB(1, 0), b3, voffB); PG8_STAGE(PG8_SB(1, 1), b3 + hstep, voffB); PG8_STAGE(PG8_SA(1, 0), a3, voffA);
            PG8_WAIT_V(8); PG8_WAIT_L(0); PG8_BAR; PG8_MMA(1, 0, At, B0); PG8_MMA(1, 1, At, B1); PG8_BAR; PG8_SCHED;
            } else {
            PG8_LDB(B0, 0, 0); PG8_SCHED; PG8_LDA(At, 0, 0); PG8_STAGE(PG8_SA(1, 1), a1 + hstep, voffA);
            PG8_WAIT_L(8); PG8_BAR; PG8_WAIT_L(0); PG8_MMA(0, 0, At, B0); PG8_BAR; PG8_SCHED;
            PG8_LDB(B1, 0, 1); PG8_STAGE(PG8_SB(0, 0), b2, voffB);
            PG8_BAR; PG8_WAIT_L(0); PG8_MMA(0, 1, At, B1); PG8_BAR;
            PG8_LDA(At, 0, 1); PG8_STAGE(PG8_SA(0, 0), a2, voffA);
            PG8_BAR; PG8_WAIT_L(0); PG8_MMA(1, 0, At, B0); PG8_BAR; PG8_SCHED;
            PG8_STAGE(PG8_SB(0, 1), b2 + hstep, voffB);
            PG8_WAIT_V(6); PG8_BAR; PG8_MMA(1, 1, At, B1); PG8_BAR;
            PG8_LDB(B0, 1, 0); PG8_SCHED; PG8_LDA(At, 1, 0); PG8_STAGE(PG8_SA(0, 1), a2 + hstep, voffA);
            PG8_WAIT_L(8); PG8_BAR; PG8_WAIT_L(0); PG8_MMA(0, 0, At, B0); PG8_BAR; PG8_SCHED;
            PG8_LDB(B1, 1, 1); PG8_STAGE(PG8_SB(1, 0), b3, voffB);
            PG8_BAR; PG8_WAIT_L(0); PG8_MMA(0, 1, At, B1); PG8_BAR;
            PG8_LDA(At, 1, 1); PG8_STAGE(PG8_SA(1, 0), a3, voffA);
            PG8_BAR; PG8_WAIT_L(0); PG8_MMA(1, 0, At, B0); PG8_BAR; PG8_SCHED;
            PG8_STAGE(PG8_SB(1, 1), b3 + hstep, voffB);
            PG8_WAIT_V(6); PG8_BAR; PG8_MMA(1, 1, At, B1); PG8_BAR;
            }
        }
        if constexpr (ALIGN_EPI) { if (wr == 0) PG8_BAR; }
        if constexpr (!Epi::AFTER_DRAIN) { E(acc, cur, wr, wc, fr, fq); S.done(cur); }
        if (!has_next) break;
#pragma unroll
        for (int a = 0; a < 2; ++a)
#pragma unroll
            for (int b = 0; b < 2; ++b)
#pragma unroll
                for (int m = 0; m < 4; ++m)
#pragma unroll
                    for (int n = 0; n < 2; ++n) acc[a][b][m][n] = (f32x4){0.f, 0.f, 0.f, 0.f};
        cur = nxt; cA = nA; cB = nB; ++ui;
        if constexpr (ALIGN_EPI) { if (wr == 1) PG8_BAR; }
    }
    PG8_WAIT_V(0);
    if constexpr (!ALIGN_EPI) { if (wr == 0) PG8_BAR; }
    PG8_BAR;
    if constexpr (Epi::AFTER_DRAIN) { E.fused(acc, cur, wr, wc, fr, fq, lds, wid, lane); S.done(cur); }
#undef PG8_SA
#undef PG8_SB
#undef PG8_STAGE
#undef PG8_RS_voffA
#undef PG8_RS_voffB
#undef PG8_LDA
#undef PG8_LDB
#undef PG8_MMA
#undef PG8_WAIT_V
#undef PG8_WAIT_L
#undef PG8_BAR
#undef PG8_SCHED
}
}

constexpr int NWAVES = 8;
#ifndef MK_N_LAUNCHES
#define MK_N_LAUNCHES 1
#endif
constexpr int PER_PHASE = 7;
constexpr int N_LAUNCHES = MK_N_LAUNCHES;

constexpr int BATCH = 8, SEQ = 4096, D = 1024, NH = 16, HD = 64, FF = 2816, NHM = 8;
constexpr int M = BATCH * SEQ;
constexpr int NQKV = 3 * D, NGU = 2 * FF;
constexpr float RMS_EPS = 1e-6f;
constexpr float QSCALE = 0.125f * 1.4426950408889634f;

constexpr size_t MiB = 1u << 20;
constexpr size_t WS_CTL = 0, CTL_ZERO_BYTES = 64 * 1024;
constexpr size_t WS_ROPE = 1 * MiB;
constexpr size_t WS_WQKV = 2 * MiB, WS_WO = 8 * MiB, WS_WGU = 10 * MiB, WS_WD = 21 * MiB;
constexpr size_t WS_KPART = 27 * MiB;
constexpr size_t WS_SSQA = 28 * MiB, WS_SSQ1 = 30 * MiB, WS_SSQ2 = 32 * MiB;
constexpr size_t WS_XN = 40 * MiB;
constexpr size_t WS_QO = 104 * MiB, WS_K = 168 * MiB, WS_V = 232 * MiB;
constexpr size_t WS_H = 104 * MiB;
#ifndef MK_REPEAT_PHASE
#define MK_REPEAT_PHASE -1
#endif
constexpr size_t WS_O = WS_QO;
constexpr size_t WS_FARO = 296 * MiB, WS_FARL = 328 * MiB;
constexpr size_t WS_XN8 = 330 * MiB;
constexpr size_t WS_O8 = 362 * MiB;
constexpr size_t WS_END = (MK_REPEAT_PHASE == 3 ? 490 : 394) * MiB;
constexpr size_t QKV8_OFF = 2 * MiB;
constexpr int CW_TMO = 0, CW_CODE = 1;
constexpr int CW_BAR = 4096;
constexpr int CW_PANEL = 8192;
constexpr int CW_FAR = 2048;

constexpr int RING_OFF = 0, RING_BYTES = 131072;
constexpr int LDSCTL_OFF = RING_BYTES, MISC_OFF = LDSCTL_OFF + 320;
constexpr int LDS_BYTES = 147456;
static_assert(WS_V - WS_K == WS_K - WS_QO, "Q | K | V equally spaced");
#define GAS __attribute__((address_space(1)))
#define LAS __attribute__((address_space(3)))
typedef unsigned short bf16;
typedef unsigned v4u __attribute__((ext_vector_type(4)));
typedef float f32x4 __attribute__((ext_vector_type(4)));
typedef short bf16x8 __attribute__((ext_vector_type(8)));
typedef GAS unsigned gu32;
typedef GAS unsigned long long gu64;
#define RLX_AGENT __ATOMIC_RELAXED, __HIP_MEMORY_SCOPE_AGENT
#define LDS_WAIT() asm volatile("s_waitcnt lgkmcnt(0)" ::: "memory")
#define VM_WAIT() asm volatile("s_waitcnt vmcnt(0)" ::: "memory")
__device__ __forceinline__ unsigned long long rt() { return __builtin_amdgcn_s_memrealtime(); }
__device__ __forceinline__ unsigned f2bf(float f) { unsigned u = __builtin_bit_cast(unsigned, f); return (u + 0x7fffu + ((u >> 16) & 1u)) >> 16; }
__device__ __forceinline__ unsigned pk2(float lo, float hi) { return f2bf(lo) | (f2bf(hi) << 16); }

#define XB_TMO      128
#define XB_XCNT(j)  (256  + 64 * (j))
#define XB_XSUB(j)  (1280 + 64 * (j))
#define XB_XGEN(j)  (2304 + 64 * (j))
#define XB_TOP      3328
#define XB_TOPGEN   3392
#define XCD_BAR_WORDS 3456
#define XB_SPIN_CAP (1u << 18)

__device__ __forceinline__ unsigned xb_ld(unsigned* p)              { return __hip_atomic_load(p, __ATOMIC_RELAXED, __HIP_MEMORY_SCOPE_AGENT); }
__device__ __forceinline__ unsigned xb_add(unsigned* p, unsigned v) { return __hip_atomic_fetch_add(p, v, __ATOMIC_RELAXED, __HIP_MEMORY_SCOPE_AGENT); }
__device__ __forceinline__ unsigned xb_xcc_id() { return (unsigned)__builtin_amdgcn_s_getreg((3 << 11) | 20) & 0xFu; }
#define XB_SPIN(cond, bar) do { unsigned _sp = 0; while (cond) { __builtin_amdgcn_s_sleep(1); \
    if ((++_sp & 255u) == 0u) { if (xb_ld(&(bar)[XB_TMO])) break; if (_sp > XB_SPIN_CAP) { atomicAdd(&(bar)[XB_TMO], 1u); break; } } } } while (0)

struct XcdBarrier {
    unsigned* bar; unsigned x;
    volatile LAS unsigned* st;
};

__device__ __forceinline__ int mk_lane() { int l; asm volatile("v_mbcnt_lo_u32_b32 %0, -1, 0\n\tv_mbcnt_hi_u32_b32 %0, -1, %0" : "=v"(l)); return l; }
__device__ __forceinline__ XcdBarrier xcd_barrier_post(unsigned* bar, volatile LAS unsigned* st, int wave) {
    XcdBarrier b; b.bar = bar; b.x = xb_xcc_id(); b.st = st;
    if (wave == 0 && mk_lane() == 0) (void)xb_add(&bar[XB_XCNT(b.x)], 1u);
    return b;
}
__device__ __forceinline__ void xcd_barrier_complete(unsigned* bar, unsigned x, unsigned& nloc, unsigned& nx) {
    const unsigned G = gridDim.x * gridDim.y * gridDim.z;
    unsigned sum, cnt, mine, sp = 0u;
    for (;;) {
        sum = 0u; cnt = 0u; mine = 0u;
#pragma unroll
        for (unsigned j = 0; j < 16; ++j) { const unsigned c = xb_ld(&bar[XB_XCNT(j)]); sum += c; cnt += (c > 0u) ? 1u : 0u; mine = (j == x) ? c : mine; }
        if (sum == G) break;
        __builtin_amdgcn_s_sleep(1);
        if ((++sp & 255u) == 0u) { if (xb_ld(&bar[XB_TMO])) break; if (sp > XB_SPIN_CAP) { atomicAdd(&bar[XB_TMO], 1u); break; } }
    }
    nloc = mine > 0u ? mine : 1u; nx = cnt > 0u ? cnt : 1u;
}

__device__ __forceinline__ void xcd_barrier(const XcdBarrier& b, int wave) {
    asm volatile("s_waitcnt vmcnt(0)" ::: "memory");
    __syncthreads();
    if (wave == 0 && mk_lane() == 0) {
        unsigned* bar = b.bar;
        __builtin_amdgcn_s_waitcnt(0);
        unsigned nloc = b.st[0], nx = b.st[1];
        if (nloc == 0u) { xcd_barrier_complete(bar, b.x, nloc, nx); b.st[0] = nloc; b.st[1] = nx; }
        const unsigned old = xb_add(&bar[XB_XSUB(b.x)], 1u);
        const unsigned gen = old / nloc;
        if (old + 1u == (gen + 1u) * nloc) {
            __builtin_amdgcn_fence(__ATOMIC_RELEASE, "agent");
            asm volatile("s_waitcnt vmcnt(0)" ::: "memory");
            const unsigned og = xb_add(&bar[XB_TOP], 1u);
            const unsigned tg = og / nx;
            if (og + 1u == (tg + 1u) * nx) xb_add(&bar[XB_TOPGEN], 1u);
            else XB_SPIN(xb_ld(&bar[XB_TOPGEN]) == tg, bar);
            __builtin_amdgcn_fence(__ATOMIC_ACQUIRE, "agent");
            xb_add(&bar[XB_XGEN(b.x)], 1u);
            asm volatile("s_waitcnt vmcnt(0)" ::: "memory");
        } else {
            XB_SPIN(xb_ld(&bar[XB_XGEN(b.x)]) == gen, bar);
            __builtin_amdgcn_fence(__ATOMIC_ACQUIRE, "agent");
            asm volatile("s_waitcnt vmcnt(0)" ::: "memory");
        }
    }
    __syncthreads();
}

#include <hip/hip_bf16.h>
#include <cmath>
namespace attn_body {
using bf16=__hip_bfloat16;
using bf16x8=__attribute__((ext_vector_type(8)))short;
using s16x4=__attribute__((ext_vector_type(4)))short;
using f32x16=__attribute__((ext_vector_type(16)))float;
using u32x4=__attribute__((ext_vector_type(4)))unsigned;
using f32x4_t=__attribute__((ext_vector_type(4)))float;
constexpr int BATCH=8,NHEAD=16,SEQ=4096,D=64,DM=NHEAD*D;
constexpr int NW=8,QBLK=32,QB=QBLK*NW,KVBLK=64,NQB=SEQ/QB;
constexpr int ATTN_PITCH=DM, ATTN_UNIT_ROWS=QB;
__device__ __forceinline__ int crow(int r,int hi){return (r&3)+8*(r>>2)+4*hi;}
#define SBAR() __builtin_amdgcn_sched_barrier(0)
__device__ __forceinline__ void cmask(f32x16&p0,f32x16&p1,int jb,int qrel,int hi){
  const float NEG=-INFINITY; int kb=64*jb+4*hi;
  #pragma unroll
  for(int r=0;r<16;++r){int kv=kb+(r&3)+8*(r>>2); if(kv>qrel)p0[r]=NEG; if(kv+32>qrel)p1[r]=NEG;}
}

__device__ __forceinline__ void dm_range(f32x16&p0,f32x16&p1,int x,unsigned bw){
  #pragma unroll
  for(int r=0;r<16;++r){ const int kp=(r&3)+8*(r>>2); if((unsigned)(x-kp)>bw)p0[r]=-1e30f; if((unsigned)(x-32-kp)>bw)p1[r]=-1e30f; } }
template<int KIND> __device__ __forceinline__ int dmode(int lo){
  if(KIND==2) return (lo+94<33||lo>128)?0:4;
  return (lo+94<0||lo>512)?0:((lo<0)?40:((lo+94<=128)?1:((lo<=128)?41:((lo+94<=512)?2:42)))); }
__device__ __forceinline__ void dm_adj128(f32x16&p0,f32x16&p1,int dqh,const f32x16&adj){
  #pragma unroll
  for(int r=0;r<16;++r){ const int kp=(r&3)+8*(r>>2); p0[r]+=(dqh-kp>128)?adj[r]:0.f; p1[r]+=(dqh-32-kp>128)?adj[r]:0.f; } }
__device__ __forceinline__ void fmask(f32x16&p0,f32x16&p1,int dq){
  #pragma unroll
  for(int r=0;r<16;++r){ const int kp=(r&3)+8*(r>>2); if((unsigned)(dq-kp-33)>95u)p0[r]=-1e30f; if((unsigned)(dq-kp-65)>95u)p1[r]=-1e30f; }
}
constexpr int NSLOT=3, SLOTB=8192;
constexpr int LDS_K=0, LDS_V=NSLOT*SLOTB, LDS_WS=2*NSLOT*SLOTB, LDS_OST=LDS_WS+NW*64*4, LDS_BYTES=LDS_OST+NW*4096;
constexpr int LDS_TAB=LDS_BYTES, TABB=4096, LDS_ALL=LDS_TAB+4*TABB;
constexpr float C2=0.125f*1.4426950408889634f;
__device__ __forceinline__ void glds16(const void*gsrc,unsigned lds_dst){unsigned keep;
  asm volatile("s_mov_b32 %0, m0\n\ts_mov_b32 m0, %2\n\ts_nop 0\n\tglobal_load_lds_dwordx4 %1, off\n\ts_mov_b32 m0, %0":"=&s"(keep):"v"(gsrc),"s"(lds_dst):"memory");}
__device__ __forceinline__ float max3f(float a,float b,float c){float r;asm("v_max3_f32 %0, %1, %2, %3":"=v"(r):"v"(a),"v"(b),"v"(c));return r;}
__device__ __forceinline__ float max2f(float a,float b){float r;asm("v_max_f32_e32 %0, %1, %2":"=v"(r):"v"(a),"v"(b));return r;}
__device__ __forceinline__ float fadd_s(float a,float b){float r;asm("v_add_f32_e32 %0, %1, %2":"=v"(r):"v"(a),"v"(b));return r;}
__device__ __forceinline__ float fsub_s(float a,float b){float r;asm("v_sub_f32_e32 %0, %1, %2":"=v"(r):"v"(a),"v"(b));return r;}
typedef float f32x2_t __attribute__((ext_vector_type(2))); typedef __bf16 bf16x2_t __attribute__((ext_vector_type(2)));
__device__ __forceinline__ unsigned cvtpk_s(float lo,float hi){f32x2_t v={lo,hi};bf16x2_t b=__builtin_convertvector(v,bf16x2_t);return __builtin_bit_cast(unsigned,b);}
#define WAIT_BAR(N) asm volatile("s_waitcnt vmcnt(" #N ") lgkmcnt(0)\n\ts_barrier":::"memory")

__device__ __forceinline__ void qkt(f32x16&p0,f32x16&p1,const char*Kslot,const bf16x8*qr,const f32x16&negm,int r32,int hi){
  const char*kb=Kslot+hi*1024+r32*16;
  #pragma unroll
  for(int d0=0;d0<4;++d0){
    const bf16x8 b0=*reinterpret_cast<const bf16x8*>(kb+d0*2048);
    const bf16x8 b1=*reinterpret_cast<const bf16x8*>(kb+d0*2048+512);
    if(d0==0){p0=__builtin_amdgcn_mfma_f32_32x32x16_bf16(b0,qr[0],negm,0,0,0);p1=__builtin_amdgcn_mfma_f32_32x32x16_bf16(b1,qr[0],negm,0,0,0);}
    else{p0=__builtin_amdgcn_mfma_f32_32x32x16_bf16(b0,qr[d0],p0,0,0,0);p1=__builtin_amdgcn_mfma_f32_32x32x16_bf16(b1,qr[d0],p1,0,0,0);}}
}
typedef __attribute__((address_space(3))) const char* lds_cptr;
typedef short v4i16_t __attribute__((ext_vector_type(4)));
__device__ __forceinline__ void kload8(bf16x8*kf,lds_cptr kp){
  kf[0]=*(const __attribute__((address_space(3))) bf16x8*)(kp);      kf[1]=*(const __attribute__((address_space(3))) bf16x8*)(kp+512);
  kf[2]=*(const __attribute__((address_space(3))) bf16x8*)(kp+2048); kf[3]=*(const __attribute__((address_space(3))) bf16x8*)(kp+2560);
  kf[4]=*(const __attribute__((address_space(3))) bf16x8*)(kp+4096); kf[5]=*(const __attribute__((address_space(3))) bf16x8*)(kp+4608);
  kf[6]=*(const __attribute__((address_space(3))) bf16x8*)(kp+6144); kf[7]=*(const __attribute__((address_space(3))) bf16x8*)(kp+6656);
}
__device__ __forceinline__ void kload2(bf16x8*kf,lds_cptr kp,int j){ kf[2*j]=*(const __attribute__((address_space(3))) bf16x8*)(kp+j*2048); kf[2*j+1]=*(const __attribute__((address_space(3))) bf16x8*)(kp+j*2048+512); }
__device__ __forceinline__ s16x4 vtr(lds_cptr p){ return __builtin_bit_cast(s16x4,__builtin_amdgcn_ds_read_tr16_b64_v4i16((__attribute__((address_space(3))) v4i16_t*)p)); }
__device__ __forceinline__ float rowmax(const f32x16&p0,const f32x16&p1){
  float a=max3f(p0[0],p0[1],p1[0]),b=max3f(p0[2],p0[3],p1[1]);a=max3f(a,p1[2],p1[3]);
  #pragma unroll
  for(int r=4;r<16;r+=4){a=max3f(a,p0[r],p0[r+1]);b=max3f(b,p0[r+2],p0[r+3]);a=max3f(a,p1[r],p1[r+1]);b=max3f(b,p1[r+2],p1[r+3]);}
  const float m=max2f(a,b);
  auto rr=__builtin_amdgcn_permlane32_swap(__float_as_uint(m),__float_as_uint(m),false,false);
  return max2f(__uint_as_float(rr[0]),__uint_as_float(rr[1]));
}
__device__ __forceinline__ void pv(f32x16*o,int vb,bf16x8 pa0,bf16x8 pa1,bf16x8 pa2,bf16x8 pa3){
  #pragma unroll
  for(int d0=0;d0<2;++d0){s16x4 lo[4],hi[4];
    #pragma unroll
    for(int ks=0;ks<4;++ks){
      asm volatile("ds_read_b64_tr_b16 %0,%1 offset:%c2":"=&v"(lo[ks]):"v"(vb),"i"(d0*4096+ks*1024):"memory");
      asm volatile("ds_read_b64_tr_b16 %0,%1 offset:%c2":"=&v"(hi[ks]):"v"(vb),"i"(d0*4096+ks*1024+512):"memory");}
    asm volatile("s_waitcnt lgkmcnt(0)":::"memory");SBAR();
    #define PK(k) (bf16x8){lo[k][0],lo[k][1],lo[k][2],lo[k][3],hi[k][0],hi[k][1],hi[k][2],hi[k][3]}
    o[d0]=__builtin_amdgcn_mfma_f32_32x32x16_bf16(pa0,PK(0),o[d0],0,0,0);
    o[d0]=__builtin_amdgcn_mfma_f32_32x32x16_bf16(pa1,PK(1),o[d0],0,0,0);
    o[d0]=__builtin_amdgcn_mfma_f32_32x32x16_bf16(pa2,PK(2),o[d0],0,0,0);
    o[d0]=__builtin_amdgcn_mfma_f32_32x32x16_bf16(pa3,PK(3),o[d0],0,0,0);
    #undef PK
  }
}

#ifndef ATTN_STORE16
#define ATTN_STORE16(p,v) asm volatile("global_store_dwordx4 %0, %1, off sc1\n\ts_nop 1"::"v"(p),"v"(v):"memory")
#endif
template<int THRL,int KIND> __device__ __forceinline__ void attn_unit(int b,int h,int qb,unsigned char*ws,char*shm,int wave,bf16x8 (&qr)[4],bool pre,bool has_next,int nkind,int nb,int nh,int nqb){
  const bf16*Q=(const bf16*)(ws+WS_QO); const bf16*K=(const bf16*)(ws+WS_K); const bf16*V=(const bf16*)(ws+WS_V); unsigned char*O8=ws+WS_O8;
  float*ssq=(float*)(ws+WS_SSQA); const float*kpart=(const float*)(ws+WS_KPART); unsigned short*faro=(unsigned short*)(ws+WS_FARO); float*farl=(float*)(ws+WS_FARL);
  constexpr bool DIL=(KIND==1), FAR=(KIND==2); constexpr int RS=FAR?16:1;
  int tid=wave*64+mk_lane(); asm volatile("":"+v"(tid));
  const int lane=tid&63,r32=lane&31,hi=lane>>5; const int wid=__builtin_amdgcn_readfirstlane(tid>>6);
  const int rowbase=b*SEQ+(FAR?qb:0);   const int q0=FAR?0:qb*QB;
  const bf16*Qw=Q+(rowbase+(int)(q0+wid*QBLK)*RS)*DM+h*D;
  const int T0=DIL?(qb>2?4*qb-8:0):0;
  const bf16*Kh=K+(rowbase+(int)T0*KVBLK)*DM+h*D,*Vh=V+(rowbase+(int)T0*KVBLK)*DM+h*D;
  const unsigned lds0=(unsigned)(uintptr_t)shm;
  float*wsf=(float*)(shm+LDS_WS)+wid*64;
  const bf16*ksrc=Kh+(int)lane*RS*DM+wid*8;
  const bf16*vsrc=Vh+(int)(16*(wid&3)+(lane>>2))*RS*DM+(wid>>2)*32+(lane&3)*8;
  const unsigned kdst=lds0+LDS_K+wid*1024, vdst=lds0+LDS_V+wid*1024;
  #define DMA_K(t,slot) glds16(ksrc+(int)(t)*KVBLK*RS*DM,(unsigned)__builtin_amdgcn_readfirstlane(kdst+(slot)))
  #define DMA_V(t,slot) glds16(vsrc+(int)(t)*KVBLK*RS*DM,(unsigned)__builtin_amdgcn_readfirstlane(vdst+(slot)))
  const int vb0=(int)(lds0+LDS_V)+((lane>>4)&1)*32+(lane&3)*8+(4*hi+((lane&15)>>2))*64;
  const char*Kbase=shm+LDS_K; bf16x8 kf[8];
  const lds_cptr shm3=(lds_cptr)shm; const lds_cptr kp0=shm3+LDS_K+hi*1024+r32*16; const lds_cptr vp0=shm3+LDS_V+((lane>>4)&1)*32+(lane&3)*8+(4*hi+((lane&15)>>2))*64;
  const int NT=FAR?4:(q0+QB)/KVBLK-T0;
  if(!pre)DMA_K(0,0); DMA_V(0,0); if(!pre)DMA_K(1,SLOTB);
  #pragma unroll
  for(int d0=0;d0<4;++d0)if(!pre)qr[d0]=*reinterpret_cast<const bf16x8*>(&Qw[(int)r32*RS*DM+d0*16+hi*8]);
  float mhat=0.f,l_reg=0.f;f32x16 o[2];o[0]=f32x16{};o[1]=f32x16{};
  const int qrel=wid*QBLK+r32;
  const lds_cptr tabp=(lds_cptr)shm+LDS_TAB+lane*64;
  unsigned selmask=1u<<qb;
  if(KIND==0){
    f32x16 g=f32x16{};
    #pragma unroll
    for(int d0=0;d0<4;++d0){ float km[8];
      if(r32<16){ const float*kp_=kpart+(unsigned)((b*16+r32)*2)*512+h*64+d0*16+hi*8;
        const f32x4_t a0=*(const f32x4_t*)kp_,a1=*(const f32x4_t*)(kp_+4),b0=*(const f32x4_t*)(kp_+512),b1=*(const f32x4_t*)(kp_+516);
        km[0]=a0[0]+b0[0];km[1]=a0[1]+b0[1];km[2]=a0[2]+b0[2];km[3]=a0[3]+b0[3];km[4]=a1[0]+b1[0];km[5]=a1[1]+b1[1];km[6]=a1[2]+b1[2];km[7]=a1[3]+b1[3]; }
      else{ _Pragma("unroll") for(int j=0;j<8;++j)km[j]=0.f; }
      u32x4 wh,wl; float rs[8];
      wh[0]=cvtpk_s(km[0],km[1]);wh[1]=cvtpk_s(km[2],km[3]);wh[2]=cvtpk_s(km[4],km[5]);wh[3]=cvtpk_s(km[6],km[7]);
      #pragma unroll
      for(int j=0;j<4;++j){ rs[2*j]=km[2*j]-__uint_as_float(wh[j]<<16); rs[2*j+1]=km[2*j+1]-__uint_as_float(wh[j]&0xffff0000u); }
      wl[0]=cvtpk_s(rs[0],rs[1]);wl[1]=cvtpk_s(rs[2],rs[3]);wl[2]=cvtpk_s(rs[4],rs[5]);wl[3]=cvtpk_s(rs[6],rs[7]);
      g=__builtin_amdgcn_mfma_f32_32x32x16_bf16(__builtin_bit_cast(bf16x8,wh),qr[d0],g,0,0,0);
      g=__builtin_amdgcn_mfma_f32_32x32x16_bf16(__builtin_bit_cast(bf16x8,wl),qr[d0],g,0,0,0); }
    float gv[16];
    #pragma unroll
    for(int r=0;r<8;++r){ const float own=g[r],oth=__shfl_xor(own,32); const int bl=(r&3)+8*(r>>2); gv[bl]=hi?oth:own; gv[bl+4]=hi?own:oth; }
    #pragma unroll
    for(int j=0;j<16;++j) if(j>=qb)gv[j]=-3e38f;
    #pragma unroll
    for(int rd=0;rd<3;++rd){ float best=-3e38f;int bi=0;
      #pragma unroll
      for(int j=0;j<16;++j){ if(gv[j]>best){best=gv[j];bi=j;} }
      if(best>-3e38f)selmask|=1u<<bi;
      #pragma unroll
      for(int j=0;j<16;++j) if(j==bi)gv[j]=-3e38f; }
  }
  const int lo0=FAR?(32*wid-63):(q0-T0*KVBLK+32*wid-63);
  #define DMODE(t) dmode<KIND>(lo0-(t)*KVBLK)
  #define CMASK(P0,P1,t) do{ if(DIL){ if(md_t>=40){ const int dqh_=q0-(T0+(t))*KVBLK+qrel-4*hi; \
        if(md_t==41){ const f32x16 adj_=*(const __attribute__((address_space(3))) f32x16*)(tabp+3*TABB); dm_adj128(P0,P1,dqh_,adj_); } \
        else dm_range(P0,P1,dqh_-((md_t==40)?0:-4096),(md_t==40)?0x7fffffffu:4608u); } } \
    else if(FAR){ if(md_t==4)fmask(P0,P1,qrel-(t)*KVBLK-4*hi); } \
    else { int jb_=(t)-(NT-4); if(jb_>=0)cmask(P0,P1,jb_,qrel,hi); } }while(0)
  #define SETC(t) f32x16 ct; const int md_t=(KIND==0)?0:DMODE(t); { if(DIL){ const int to_=(md_t==0)?0:((md_t==2||md_t==42)?2*TABB:TABB); \
      const f32x16 tb_=*(const __attribute__((address_space(3))) f32x16*)(tabp+to_); _Pragma("unroll") for(int r=0;r<16;++r)ct[r]=tb_[r]-mhat; } \
    else { const float x_=(FAR?(md_t!=0):(((selmask>>((t)>>2))&1u)!=0u))?-mhat:-1e30f; _Pragma("unroll") for(int r=0;r<16;++r)ct[r]=x_; } asm volatile("":"+v"(ct)); }
  bool resc=false;
  #define START(P0,P1) do{ const float rm=rowmax(P0,P1); resc=false; \
    if(__any(rm>(float)THRL)){ const float dl=__builtin_fmaxf(rm,0.f); mhat=fadd_s(mhat,dl); \
      _Pragma("unroll") for(int r=0;r<16;++r){P0[r]=fsub_s(P0[r],dl);P1[r]=fsub_s(P1[r],dl);} \
      const float f=__builtin_amdgcn_exp2f(-dl); l_reg*=f; if(hi==0)wsf[r32]=f; resc=true; } \
    _Pragma("unroll") for(int r=0;r<16;++r)P0[r]=__builtin_amdgcn_exp2f(P0[r]); }while(0)
  #define RESC() do{ if(resc){ asm volatile("s_waitcnt lgkmcnt(0)":::"memory"); \
      _Pragma("unroll") for(int d_=0;d_<2;++d_) _Pragma("unroll") for(int r=0;r<16;++r)o[d_][r]*=wsf[crow(r,hi)]; } }while(0)
  f32x16 pA0,pA1,pB0,pB1;
  int sl_prev=0,sl_cur=0,sl_next=SLOTB;
  #define ROT() do{sl_prev=sl_cur;sl_cur=sl_next;sl_next=(sl_next==(NSLOT-1)*SLOTB)?0:sl_next+SLOTB;}while(0)
  if(!pre){ DMA_K(2,2*SLOTB);
    WAIT_BAR(3); }
  else { WAIT_BAR(1); }
  if(0)WAIT_BAR(3);
  { SETC(0); qkt(pA0,pA1,Kbase,qr,ct,r32,hi); asm volatile("s_nop 15\n\ts_nop 7":"+v"(pA0),"+v"(pA1));CMASK(pA0,pA1,0); }
  START(pA0,pA1);
  _Pragma("unroll") for(int r=0;r<16;++r)pA1[r]=__builtin_amdgcn_exp2f(pA1[r]);
  WAIT_BAR(0);
  RESC();
  DMA_K(3,0);DMA_V(1,SLOTB);
  ROT();
  kload8(kf,kp0+sl_cur);
  WAIT_BAR(2);
  s16x4 vlo[8],vhi[8]; u32x4 pw0,pw1,pw2,pw3;
  #define PKW(P,B) cvtpk_s(P[B],P[B+1])
  #define PAF(k) __builtin_bit_cast(bf16x8,pw##k)
  #define VFR(i) (bf16x8){vlo[i][0],vlo[i][1],vlo[i][2],vlo[i][3],vhi[i][0],vhi[i][1],vhi[i][2],vhi[i][3]}
  #define PIN(x) asm volatile("":"+v"(x))
  #define MX3(a,b,c) __builtin_fmaxf(__builtin_fmaxf((a),(b)),(c))
  #define GAPA(MF,A0,A1,A2,A3,W0,W1,PW) do{ MF; sacc+=A0; sacc+=A1; sacc+=A2; sacc+=A3; PIN(sacc); W0; W1; PIN(PW); SBAR(); }while(0)
  #define EX(v) __builtin_amdgcn_exp2f(v)
  #define GAPB(MF,X,B) do{ MF; X[B]=EX(X[B]); X[B+1]=EX(X[B+1]); X[B+2]=EX(X[B+2]); X[B+3]=EX(X[B+3]); PIN(X); SBAR(); }while(0)
  #define VRD(i) do{ vlo[i]=vtr(vp_+(((i)>>2)*4096+((i)&3)*1024)); vhi[i]=vtr(vp_+(((i)>>2)*4096+((i)&3)*1024+512)); }while(0)
  #define KRD(G,j) do{ if(G){ kload2(kf,kp0+sl_next,j); SBAR(); } }while(0)
  #define STEP(C0,C1,P0,P1,t,GK,GV,GL) do{ SBAR(); SETC(t); SBAR(); \
    const lds_cptr vp_=vp0+sl_prev; \
    VRD(0); SBAR(); float sacc=(P0[0]+P0[1]); \
    GAPA(C0=__builtin_amdgcn_mfma_f32_32x32x16_bf16(kf[0],qr[0],ct,0,0,0), P0[2],P0[3],P0[4],P0[5],     pw0[0]=PKW(P0,0), pw0[1]=PKW(P0,2), pw0); \
    VRD(4); SBAR(); GAPA(C1=__builtin_amdgcn_mfma_f32_32x32x16_bf16(kf[1],qr[0],ct,0,0,0), P0[6],P0[7],P0[8],P0[9],     pw0[2]=PKW(P0,4), pw0[3]=PKW(P0,6), pw0); \
    VRD(1); SBAR(); GAPA(C0=__builtin_amdgcn_mfma_f32_32x32x16_bf16(kf[2],qr[1],C0,0,0,0),   P0[10],P0[11],P0[12],P0[13], pw1[0]=PKW(P0,8), pw1[1]=PKW(P0,10), pw1); \
    VRD(5); SBAR(); GAPA(C1=__builtin_amdgcn_mfma_f32_32x32x16_bf16(kf[3],qr[1],C1,0,0,0),   P0[14],P0[15],P1[0],P1[1],   pw1[2]=PKW(P0,12),pw1[3]=PKW(P0,14), pw1); \
    VRD(2); SBAR(); GAPA(C0=__builtin_amdgcn_mfma_f32_32x32x16_bf16(kf[4],qr[2],C0,0,0,0),   P1[2],P1[3],P1[4],P1[5],     pw2[0]=PKW(P1,0), pw2[1]=PKW(P1,2), pw2); \
    VRD(6); SBAR(); GAPA(C1=__builtin_amdgcn_mfma_f32_32x32x16_bf16(kf[5],qr[2],C1,0,0,0),   P1[6],P1[7],P1[8],P1[9],     pw2[2]=PKW(P1,4), pw2[3]=PKW(P1,6), pw2); \
    VRD(3); SBAR(); GAPA(C0=__builtin_amdgcn_mfma_f32_32x32x16_bf16(kf[6],qr[3],C0,0,0,0),   P1[10],P1[11],P1[12],P1[13], pw3[0]=PKW(P1,8), pw3[1]=PKW(P1,10), pw3); \
    VRD(7); SBAR(); GAPA(C1=__builtin_amdgcn_mfma_f32_32x32x16_bf16(kf[7],qr[3],C1,0,0,0),   P1[14],P1[15],0.f,0.f,       pw3[2]=PKW(P1,12),pw3[3]=PKW(P1,14), pw3); \
    l_reg+=sacc; \
    if(GK){DMA_K((t)+3,sl_cur);} if(GV){DMA_V((t)+1,sl_next);} \
    CMASK(C0,C1,t); \
    { float a=MX3(C0[0],C0[1],C1[0]),b=MX3(C0[2],C0[3],C1[1]); a=MX3(a,C1[2],C1[3]); \
      _Pragma("unroll") for(int r=4;r<16;r+=4){a=MX3(a,C0[r],C0[r+1]);b=MX3(b,C0[r+2],C0[r+3]);a=MX3(a,C1[r],C1[r+1]);b=MX3(b,C1[r+2],C1[r+3]);} \
      float rm=__builtin_fmaxf(a,b); { auto rr=__builtin_amdgcn_permlane32_swap(__float_as_uint(rm),__float_as_uint(rm),false,false); rm=__builtin_fmaxf(__uint_as_float(rr[0]),__uint_as_float(rr[1])); } \
      resc=false; \
      if(__builtin_expect(__any(rm>(float)THRL),0)){ const float dl=__builtin_fmaxf(rm,0.f); mhat+=dl; \
        _Pragma("unroll") for(int r=0;r<16;++r){C0[r]-=dl;C1[r]-=dl;} \
        const float f=__builtin_amdgcn_exp2f(-dl); l_reg*=f; if(hi==0)wsf[r32]=f; resc=true; } } \
    SBAR(); \
    GAPB(o[0]=__builtin_amdgcn_mfma_f32_32x32x16_bf16(PAF(0),VFR(0),o[0],0,0,0), C0,0); \
    GAPB(o[1]=__builtin_amdgcn_mfma_f32_32x32x16_bf16(PAF(0),VFR(4),o[1],0,0,0), C0,4); \
    KRD(GL,0); GAPB(o[0]=__builtin_amdgcn_mfma_f32_32x32x16_bf16(PAF(1),VFR(1),o[0],0,0,0), C0,8); \
    KRD(GL,1); GAPB(o[1]=__builtin_amdgcn_mfma_f32_32x32x16_bf16(PAF(1),VFR(5),o[1],0,0,0), C0,12); \
    KRD(GL,2); GAPB(o[0]=__builtin_amdgcn_mfma_f32_32x32x16_bf16(PAF(2),VFR(2),o[0],0,0,0), C1,0); \
    KRD(GL,3); GAPB(o[1]=__builtin_amdgcn_mfma_f32_32x32x16_bf16(PAF(2),VFR(6),o[1],0,0,0), C1,4); \
    GAPB(o[0]=__builtin_amdgcn_mfma_f32_32x32x16_bf16(PAF(3),VFR(3),o[0],0,0,0), C1,8); \
    GAPB(o[1]=__builtin_amdgcn_mfma_f32_32x32x16_bf16(PAF(3),VFR(7),o[1],0,0,0), C1,12); \
    }while(0)
  int t=1;
  for(;t+5<NT;t+=2){
    STEP(pB0,pB1,pA0,pA1,t,true,true,true);     WAIT_BAR(2); RESC(); ROT();
    STEP(pA0,pA1,pB0,pB1,t+1,true,true,true);   WAIT_BAR(2); RESC(); ROT();
  }
  #define ENDW(tt) do{ if((tt)+3<NT){WAIT_BAR(2);} else if((tt)+2<NT){WAIT_BAR(1);} else {WAIT_BAR(0);} }while(0)
  for(;t+1<NT;t+=2){
    STEP(pB0,pB1,pA0,pA1,t,(t+3<NT),(t+1<NT),(t+1<NT));       ENDW(t);   RESC(); ROT();
    STEP(pA0,pA1,pB0,pB1,t+1,(t+4<NT),(t+2<NT),(t+2<NT));     ENDW(t+1); RESC(); ROT();
  }
  if(has_next){
    const int nRS=(nkind==2)?16:1, nrowbase=nb*SEQ+((nkind==2)?nqb:0), nT0=(nkind==1)?(nqb>2?4*nqb-8:0):0;
    const bf16*nks=K+(nrowbase+(int)nT0*KVBLK)*DM+nh*D+(int)lane*nRS*DM+wid*8;
    glds16(nks,(unsigned)__builtin_amdgcn_readfirstlane(kdst)); glds16(nks+(int)KVBLK*nRS*DM,(unsigned)__builtin_amdgcn_readfirstlane(kdst+SLOTB)); glds16(nks+(int)2*KVBLK*nRS*DM,(unsigned)__builtin_amdgcn_readfirstlane(kdst+2*SLOTB)); }
  STEP(pB0,pB1,pA0,pA1,NT-1,false,false,false); RESC();
  if(has_next){
    const int nRS=(nkind==2)?16:1, nrowbase=nb*SEQ+((nkind==2)?nqb:0), nq0=(nkind==2)?0:nqb*QB; const bf16*nQw=Q+(nrowbase+(int)(nq0+wid*QBLK)*nRS)*DM+nh*D;
    #pragma unroll
    for(int d0=0;d0<4;++d0)qr[d0]=*reinterpret_cast<const bf16x8*>(&nQw[(int)r32*nRS*DM+d0*16+hi*8]); }
  { float sacc=pB0[0]+pB0[1]; _Pragma("unroll") for(int r=2;r<16;++r)sacc+=pB0[r]; _Pragma("unroll") for(int r=0;r<16;++r)sacc+=pB1[r]; l_reg+=sacc;
    pw0=(u32x4){PKW(pB0,0),PKW(pB0,2),PKW(pB0,4),PKW(pB0,6)};pw1=(u32x4){PKW(pB0,8),PKW(pB0,10),PKW(pB0,12),PKW(pB0,14)};pw2=(u32x4){PKW(pB1,0),PKW(pB1,2),PKW(pB1,4),PKW(pB1,6)};pw3=(u32x4){PKW(pB1,8),PKW(pB1,10),PKW(pB1,12),PKW(pB1,14)};
    SBAR(); pv(o,vb0+sl_cur,PAF(0),PAF(1),PAF(2),PAF(3)); }
  #undef PKW
  #undef PAF
  #undef VFR
  #undef PIN
  #undef MX3
  #undef GAPA
  #undef GAPB
  #undef EX
  #undef VRD
  #undef KRD
  #undef STEP
  #undef ENDW
  {auto rr=__builtin_amdgcn_permlane32_swap(__float_as_uint(l_reg),__float_as_uint(l_reg),false,false);l_reg=__uint_as_float(rr[0])+__uint_as_float(rr[1]);}
  int lane_e=lane; asm volatile("":"+v"(lane_e));
  u32x4 fch[4];
  if(DIL){
    const unsigned short*fp=faro+(unsigned)(rowbase+q0+wid*QBLK+(lane_e>>3))*512+(h-8)*D+(lane_e&7)*8;
    #pragma unroll
    for(int i=0;i<4;++i)fch[i]=*(const u32x4*)(fp+(unsigned)i*8*512);
    const int p_=q0+wid*QBLK+(lane_e&31); const float*lp=farl+((unsigned)(((b*8+(h-8))*16+(p_&15))*256+(p_>>4)))*2; const float lf_=lp[0],mf_=lp[1];
    const float M_=__builtin_fmaxf(mhat,mf_),sa_=__builtin_amdgcn_exp2f(mhat-M_),sb_=__builtin_amdgcn_exp2f(mf_-M_),rl_=__builtin_amdgcn_rcpf(l_reg*sa_+lf_*sb_);
    if(hi==0){wsf[32+r32]=sa_*rl_;wsf[r32]=sb_*rl_;} }
  else if(hi==0)wsf[32+r32]=FAR?1.f:__builtin_amdgcn_rcpf(l_reg);
  asm volatile("s_waitcnt lgkmcnt(0)":::"memory");
  float rli[16];
  #pragma unroll
  for(int r=0;r<16;++r)rli[r]=wsf[32+crow(r,hi)];
  constexpr int OP=FAR?512:DM;
  bf16*Ow=(bf16*)faro+(rowbase+(int)wid*QBLK*RS)*OP+(h-8)*D;
  unsigned char*O8w=O8+(rowbase+q0+wid*QBLK)*DM+h*D;
  if(FAR&&hi==0){ float*lp=farl+((unsigned)(((b*8+(h-8))*16+qb)*256+qrel))*2; __hip_atomic_store((unsigned long long*)lp,((unsigned long long)__float_as_uint(mhat)<<32)|__float_as_uint(l_reg),__ATOMIC_RELAXED,__HIP_MEMORY_SCOPE_AGENT); }
  { bf16*stg=(bf16*)(shm+LDS_OST)+wid*2048;
    #pragma unroll
    for(int r=0;r<16;++r){const int orow=crow(r,hi);
      #pragma unroll
      for(int d0=0;d0<2;++d0)stg[orow*64+d0*32+r32]=__float2bfloat16(o[d0][r]*rli[r]);}
    asm volatile("s_waitcnt lgkmcnt(0)":::"memory");
    #pragma unroll
    for(int i=0;i<4;++i){const int row=i*8+(lane_e>>3),ch=lane_e&7; u32x4 v=*(const u32x4*)(stg+row*64+ch*8);
      if(DIL){ const float fb_=wsf[row];
        #pragma unroll
        for(int j=0;j<4;++j){ const float a_=__uint_as_float(v[j]<<16)+__uint_as_float(fch[i][j]<<16)*fb_, b_=__uint_as_float(v[j]&0xffff0000u)+__uint_as_float(fch[i][j]&0xffff0000u)*fb_; v[j]=cvtpk_s(a_,b_); } }
      if(FAR){ ATTN_STORE16(Ow+(int)row*RS*OP+ch*8,v); }
      else { unsigned w0_=0,w1_=0;
        w0_=__builtin_amdgcn_cvt_pk_fp8_f32(__uint_as_float(v[0]<<16)*64.f,__uint_as_float(v[0]&0xffff0000u)*64.f,w0_,false); w0_=__builtin_amdgcn_cvt_pk_fp8_f32(__uint_as_float(v[1]<<16)*64.f,__uint_as_float(v[1]&0xffff0000u)*64.f,w0_,true);
        w1_=__builtin_amdgcn_cvt_pk_fp8_f32(__uint_as_float(v[2]<<16)*64.f,__uint_as_float(v[2]&0xffff0000u)*64.f,w1_,false); w1_=__builtin_amdgcn_cvt_pk_fp8_f32(__uint_as_float(v[3]<<16)*64.f,__uint_as_float(v[3]&0xffff0000u)*64.f,w1_,true);
        *(unsigned long long*)(O8w+(int)row*DM+ch*8)=((unsigned long long)w1_<<32)|w0_; }
      float sq=0.f;
      #pragma unroll
      for(int j=0;j<4;++j){ const float a_=__uint_as_float(v[j]<<16), b_=__uint_as_float(v[j]&0xffff0000u); sq+=a_*a_+b_*b_; }
      sq+=__shfl_xor(sq,1); sq+=__shfl_xor(sq,2); sq+=__shfl_xor(sq,4);
      if(!FAR&&ch==0)ssq[(unsigned)(rowbase+q0+wid*QBLK+row)*16+h]=sq; } }
  asm volatile("s_waitcnt lgkmcnt(0)\n\ts_barrier":::"memory");
  #undef DMA_K
  #undef DMA_V
  #undef CMASK
  #undef START
  #undef RESC
  #undef ROT
}
constexpr int ATTN_LDS_BYTES=LDS_BYTES;
__device__ __forceinline__ void attn_tables(char*lds,int wave){
  float*tb=(float*)(lds+LDS_TAB);
  for(int e=wave*64+mk_lane();e<64*16;e+=512){ const int ln=e>>4,r=e&15,r32=ln&31,hi=ln>>5; const int z4=r32&3,z16=((r32&15)-4*hi)&15;
    const bool in4=(z4==(r&3)),in16=(z16==((r&3)+8*((r>>2)&1)));
    tb[e]=-1e30f; tb[1024+e]=in16?1.5849625007f:(in4?1.f:0.f); tb[2048+e]=in16?1.f:(in4?0.f:-1e30f); tb[3072+e]=in16?(1.f-1.5849625007f):(in4?-1.f:-1e30f); }
  __syncthreads();
}
template<int THRL=8> __device__ __forceinline__ void attn_phase(char*lds,unsigned char*ws,unsigned*cnt,int vcu,int G,int wave){
  const int g=vcu>>2,b=g>>3,hm=g&7,c=vcu&3;
  attn_tables(lds,wave);
  bf16x8 qr[4];
  { const int n_=(MK_REPEAT_PHASE==22?8:4); for(int i=0;i<n_;++i) attn_unit<THRL,2>(b,8+hm,4*c+(i&3),ws,lds,wave,qr,i>0,true,(i+1<n_)?2:0,b,(i+1<n_)?8+hm:hm,(i+1<n_)?4*c+((i+1)&3):15-c); }
  asm volatile("s_waitcnt vmcnt(0)":::"memory"); __syncthreads();
  if(wave==0&&mk_lane()==0) __hip_atomic_fetch_add(cnt,1u,__ATOMIC_RELAXED,__HIP_MEMORY_SCOPE_AGENT);
  #define QBSEL(i_) ((((i_)&3)==0)?15-c:((((i_)&3)==1)?8+c:((((i_)&3)==2)?7-c:c)))
  { const int n_=(MK_REPEAT_PHASE==20?8:4); for(int ii=0;ii<n_;++ii) attn_unit<THRL,0>(b,hm,QBSEL(ii),ws,lds,wave,qr,true,true,(ii+1<n_)?0:1,b,(ii+1<n_)?hm:8+hm,QBSEL(ii+1)); }
  if(wave==0&&mk_lane()==0){ unsigned sp=0; while(__hip_atomic_load(cnt,__ATOMIC_RELAXED,__HIP_MEMORY_SCOPE_AGENT)<(unsigned)G){ __builtin_amdgcn_s_sleep(2); if(++sp>(1u<<22))break; }
    __builtin_amdgcn_fence(__ATOMIC_ACQUIRE,"agent"); asm volatile("s_waitcnt vmcnt(0)":::"memory"); }
  __syncthreads();
  { const int n_=(MK_REPEAT_PHASE==21?8:4); for(int ii=0;ii<n_;++ii) attn_unit<THRL,1>(b,8+hm,QBSEL(ii),ws,lds,wave,qr,true,ii+1<n_,1,b,8+hm,QBSEL(ii+1)); }
  #undef QBSEL
}
#undef SBAR
#undef WAIT_BAR
}

struct Frame {
    LAS unsigned char* lds;
    volatile LAS unsigned* MISC;
    gu32* ctl;
    int wave;
    int vcu, G;
    const float *x, *attn_norm, *w_in, *moba_norm, *dil_norm, *w_out, *ffn_norm, *w_gate, *w_up, *w_down, *final_norm;
    float* out;
    bf16 *Wqkv_t, *Wo_t, *Wgu_t, *Wd_t;
    bf16 *QO, *KB, *VB, *XN, *OB; unsigned char *HB, *XN8;
    float *rope, *kpart, *ssqa, *ssq1, *ssq2;
};

__device__ __forceinline__ float wave_sum(float v) {
#pragma unroll
    for (int o = 1; o < 64; o <<= 1) v += __shfl_xor(v, o);
    return v;
}
__device__ __forceinline__ int qkv_vrow(int n) { const int part = n >> 10, head = (n >> 6) & 15, d = n & 63; return 256 * (part * 4 + (head >> 2)) + 128 * (d >> 5) + 32 * (head & 3) + (d & 31); }
template <int MODE>
__device__ __forceinline__ void p0_item(const float* W, int K, int N, bf16* WT, const float* g0, const float* g1, LAS float* scr, int item, int lane) {
    const int nblk = N / 32, kb = item / nblk, nb = item % nblk, k0 = 64 * kb, n0 = 32 * nb;
#pragma unroll 8
    for (int i = 0; i < 32; ++i) { const int kk = 2 * i + (lane >> 5), k = k0 + kk; float w = W[(size_t)k * N + n0 + (lane & 31)];
        if (MODE == 1) w *= (k < 512 ? g0[k] : g1[k - 512]);
        if (MODE == 2 || MODE == 3) w *= g0[k];
        scr[kk * 33 + (lane & 31)] = w; }
    LDS_WAIT(); asm volatile("" ::: "memory");
    const int c = lane & 7;
#pragma unroll
    for (int j = 0; j < 4; ++j) { const int n = (lane >> 3) + 8 * j; const LAS float* s = scr + (8 * c) * 33 + n;
        const int ns = n0 + n; int dr;
        if (MODE == 0) dr = qkv_vrow(ns); else if (MODE == 2) dr = 256 * (ns >> 7) + (ns & 127); else if (MODE == 3) dr = 256 * (ns >> 7) + 128 + (ns & 127); else dr = ns;
        bool f8 = MODE >= 1; size_t base8 = 0;
        if (MODE == 0) {
            const int pn = dr >> 8, lo = dr & 255; f8 = !(pn < 8 && (pn & 3) < 2);
            dr = (f8 ? (pn < 8 ? ((pn & 1) + 2 * (pn >> 2)) : pn - 4) : ((pn & 1) + 2 * (pn >> 2))) * 256 + lo; base8 = (size_t)QKV8_OFF; }
        if (f8) {
            const pg8::f32x4 a = {s[0 * 33], s[1 * 33], s[2 * 33], s[3 * 33]}, b = {s[4 * 33], s[5 * 33], s[6 * 33], s[7 * 33]};
            *(GAS pg8::u32x2*)((unsigned char*)WT + base8 + (size_t)dr * K + k0 + 8 * c) = pg8::pack8_fp8(a * pg8::F8_SW, b * pg8::F8_SW);
        } else {
            v4u o; o.x = pk2(s[0 * 33], s[1 * 33]); o.y = pk2(s[2 * 33], s[3 * 33]); o.z = pk2(s[4 * 33], s[5 * 33]); o.w = pk2(s[6 * 33], s[7 * 33]);
            *(GAS v4u*)(WT + (size_t)dr * K + k0 + 8 * c) = o; } }
    LDS_WAIT(); asm volatile("" ::: "memory");
}
template <int R>
__device__ __forceinline__ void rms_rows_to_bf16(Frame& F, const float* xrow, const float* gain, bf16* orow, unsigned char* orow8, float* rn) {
    const GAS f32x4* xr = (const GAS f32x4*)xrow + mk_lane(); const GAS f32x4* gr = (const GAS f32x4*)gain + mk_lane();
    f32x4 v[R][4]; float s[R];
#pragma unroll
    for (int r = 0; r < R; ++r)
#pragma unroll
        for (int j = 0; j < 4; ++j) v[r][j] = xr[r * 256 + 64 * j];
#pragma unroll
    for (int r = 0; r < R; ++r) { s[r] = 0.f;
#pragma unroll
        for (int j = 0; j < 4; ++j) s[r] += (v[r][j].x * v[r][j].x + v[r][j].y * v[r][j].y) + (v[r][j].z * v[r][j].z + v[r][j].w * v[r][j].w); }
#pragma unroll
    for (int o = 1; o < 64; o <<= 1)
#pragma unroll
        for (int r = 0; r < R; ++r) s[r] += __shfl_xor(s[r], o);
    const int ln_ = mk_lane(); GAS unsigned long long* o8 = (GAS unsigned long long*)orow + ln_; GAS unsigned* q8 = (GAS unsigned*)orow8 + ln_;
#pragma unroll
    for (int r = 0; r < R; ++r) { const float rms = sqrtf(s[r] * (1.f / D) + RMS_EPS), rstd = 1.f / rms; if (ln_ == 0) rn[r] = rms;
#pragma unroll
        for (int j = 0; j < 4; ++j) { const f32x4 g = gr[64 * j];
            const f32x4 y = v[r][j] * rstd * g;
            o8[r * 256 + 64 * j] = (unsigned long long)pk2(y.x, y.y) | ((unsigned long long)pk2(y.z, y.w) << 32);
            unsigned t = 0; t = __builtin_amdgcn_cvt_pk_fp8_f32(y.x * pg8::F8_SA, y.y * pg8::F8_SA, t, false); t = __builtin_amdgcn_cvt_pk_fp8_f32(y.z * pg8::F8_SA, y.w * pg8::F8_SA, t, true); q8[r * 256 + 64 * j] = t; } }
}
__device__ __forceinline__ void p0_prologue(Frame& F) {
    LAS float* scr = (LAS float*)(F.lds + RING_OFF + F.wave * 16384);
    const int gw = F.vcu * NWAVES + F.wave, NGW = F.G * NWAVES;
    constexpr int I_IN = (D / 64) * (NQKV / 32), I_O = (D / 64) * (D / 32), I_G = (D / 64) * (FF / 32), I_D = (FF / 64) * (D / 32);
    constexpr int NITEMS = I_IN + I_O + 2 * I_G + I_D;
    for (int it = gw; it < NITEMS; it += NGW) {
        int r = it;
        if (r < I_IN) { p0_item<0>(F.w_in, D, NQKV, F.Wqkv_t, nullptr, nullptr, scr, r, mk_lane()); continue; } r -= I_IN;
        if (r < I_O) { p0_item<1>(F.w_out, D, D, F.Wo_t, F.moba_norm, F.dil_norm, scr, r, mk_lane()); continue; } r -= I_O;
        if (r < I_G) { p0_item<2>(F.w_gate, D, FF, F.Wgu_t, F.ffn_norm, nullptr, scr, r, mk_lane()); continue; } r -= I_G;
        if (r < I_G) { p0_item<3>(F.w_up, D, FF, F.Wgu_t, F.ffn_norm, nullptr, scr, r, mk_lane()); continue; } r -= I_G;
        p0_item<4>(F.w_down, FF, D, F.Wd_t, nullptr, nullptr, scr, r, mk_lane());
    }
    for (int e = (F.vcu * NWAVES * 64) + F.wave * 64 + mk_lane(); e < SEQ * 32; e += F.G * NWAVES * 64) {
        const int s = e >> 5, j = e & 31;
        const float invf = __builtin_amdgcn_exp2f(-(float)j * (13.287712379549449f / 32.0f));
        double rev = (double)s * (double)invf * 0.15915494309189535; rev -= __builtin_floor(rev);
        const float r = (float)rev;
        pg8::f32x2 cs; cs.x = __builtin_amdgcn_cosf(r); cs.y = __builtin_amdgcn_sinf(r);
        *(GAS pg8::f32x2*)((pg8::f32x2*)F.rope + e) = cs;
    }
    for (int m = 4 * gw; m < M; m += 4 * NGW) rms_rows_to_bf16<4>(F, F.x + (size_t)m * D, F.attn_norm, F.XN + (size_t)m * D, F.XN8 + (size_t)m * D, (float*)(F.kpart + 131072) + m);
}

__device__ __forceinline__ void p6_final(Frame& F) {
    const int gw = F.vcu * NWAVES + F.wave, NGW = F.G * NWAVES;
    const GAS f32x4* gr = (const GAS f32x4*)F.final_norm + mk_lane();
    for (int m = gw; m < M; m += NGW) {
        GAS f32x4* xr = (GAS f32x4*)(F.out + (size_t)m * D) + mk_lane();
        const GAS f32x4* sp = (const GAS f32x4*)(F.ssq2 + (size_t)m * 16);
        const f32x4 a = sp[0], b = sp[1], c = sp[2], d = sp[3];
        const float ss = ((a.x + a.y) + (a.z + a.w)) + ((b.x + b.y) + (b.z + b.w)) + ((c.x + c.y) + (c.z + c.w)) + ((d.x + d.y) + (d.z + d.w));
        const float rstd = 1.f / sqrtf(ss * (1.f / D) + RMS_EPS);
#pragma unroll
        for (int j = 0; j < 4; ++j) { const f32x4 v = xr[64 * j], g = gr[64 * j]; xr[64 * j] = v * rstd * g; }
    }
}

struct Args { const float* in[11]; float* out; unsigned char* ws; int ph_lo, ph_hi, li, pad; };
__global__ void __launch_bounds__(NWAVES * 64, 2) mk_fwd(Args args) {
    extern __shared__ __attribute__((aligned(16))) unsigned char lds[];
    Frame F;
    F.lds = (LAS unsigned char*)lds;
    F.MISC = (volatile LAS unsigned*)(F.lds + MISC_OFF);
    F.wave = __builtin_amdgcn_readfirstlane((int)(threadIdx.x >> 6));
    F.G = gridDim.x; { const int bx = blockIdx.x; F.vcu = (F.G % 8 == 0) ? (bx % 8) * (F.G / 8) + bx / 8 : bx; }
#define GRID_BAR(seam) do { if (N_LAUNCHES == PER_PHASE) { if ((F.wave == 0 && mk_lane() == 0)) __hip_atomic_store(F.ctl + CW_TMO, 0xBADBA0u | (unsigned)(seam), RLX_AGENT); } \
    else { xcd_barrier(bar, F.wave); if (MK_REPEAT_PHASE == 30) xcd_barrier(bar, F.wave); } } while (0)
    unsigned char* ws = args.ws;
    F.ctl = (gu32*)(ws + WS_CTL);
    F.x = args.in[0]; F.attn_norm = args.in[1]; F.w_in = args.in[2]; F.moba_norm = args.in[3]; F.dil_norm = args.in[4]; F.w_out = args.in[5];
    F.ffn_norm = args.in[6]; F.w_gate = args.in[7]; F.w_up = args.in[8]; F.w_down = args.in[9]; F.final_norm = args.in[10]; F.out = args.out;
    F.Wqkv_t = (bf16*)(ws + WS_WQKV); F.Wo_t = (bf16*)(ws + WS_WO); F.Wgu_t = (bf16*)(ws + WS_WGU); F.Wd_t = (bf16*)(ws + WS_WD);
    F.QO = (bf16*)(ws + WS_QO); F.KB = (bf16*)(ws + WS_K); F.VB = (bf16*)(ws + WS_V); F.HB = ws + WS_H; F.XN8 = ws + WS_XN8; F.XN = (bf16*)(ws + WS_XN); F.OB = (bf16*)(ws + WS_O);
    F.rope = (float*)(ws + WS_ROPE); F.kpart = (float*)(ws + WS_KPART); F.ssqa = (float*)(ws + WS_SSQA); F.ssq1 = (float*)(ws + WS_SSQ1); F.ssq2 = (float*)(ws + WS_SSQ2);
    for (int u = F.wave * 64 + mk_lane(); u < (LDS_BYTES - LDSCTL_OFF) / 4; u += NWAVES * 64) ((LAS unsigned*)(F.lds + LDSCTL_OFF))[u] = 0u;
    __syncthreads();
    XcdBarrier bar; bar.bar = (unsigned*)(F.ctl + CW_BAR); bar.x = 0; bar.st = nullptr;
    if (N_LAUNCHES != PER_PHASE) bar = xcd_barrier_post((unsigned*)(F.ctl + CW_BAR), F.MISC + 8, F.wave);
    const int lo = args.ph_lo, hi = args.ph_hi;
#define IN(k) (lo <= (k) && (k) < hi)
#define BOTH(k) (IN(k) && IN((k) + 1))

    if (IN(0)) { for (int rp = 0; rp < (MK_REPEAT_PHASE == 0 ? 2 : 1); ++rp) p0_prologue(F); if (BOTH(0)) GRID_BAR(0); }

    if (IN(1)) {
        { pg8::Gemm g{F.XN, F.Wqkv_t, M, 1024, D}; pg8::StaticOrder S; S.init(M, 1024, F.G, (int)blockIdx.x, MK_REPEAT_PHASE == 1 ? 2 : 1);
          pg8::EpiQKV E{F.QO, (size_t)(WS_K - WS_QO) / 2, F.rope, F.kpart, QSCALE, 1, 1.f};
          pg8::gemm_phase<pg8::EpiQKV, pg8::StaticOrder, true, true>(F.lds + RING_OFF, g, S, E, F.wave); }
        { pg8::Gemm g{(const bf16*)F.XN8, (const bf16*)((const unsigned char*)F.Wqkv_t + QKV8_OFF), M, 2048, D}; pg8::StaticOrder S; S.init(M, 2048, F.G, (int)blockIdx.x, MK_REPEAT_PHASE == 1 ? 2 : 1);
          pg8::EpiQKV E{F.QO, (size_t)(WS_K - WS_QO) / 2, F.rope, F.kpart, QSCALE, 2, 1.f / (pg8::F8_SA * pg8::F8_SW)};
          pg8::gemm_phase<pg8::EpiQKV, pg8::StaticOrder, true, true, true>(F.lds + RING_OFF, g, S, E, F.wave); }
        if (BOTH(1)) GRID_BAR(1);
    }

    if (IN(2)) {
        if (F.G == 256) {
            for (int rp = 0; rp < (MK_REPEAT_PHASE == 2 ? 2 : 1); ++rp) attn_body::attn_phase<8>((char*)lds + RING_OFF, ws, (unsigned*)(F.ctl + CW_FAR), F.vcu, F.G, F.wave);
        }
        if (BOTH(2)) GRID_BAR(2);
    }

    if (IN(3)) {
        pg8::Gemm g{(const bf16*)(ws + WS_O8), F.Wo_t, M, D, D};   pg8::StaticOrder S; S.init(M, D, F.G, (int)blockIdx.x, MK_REPEAT_PHASE == 3 ? 2 : 1);
        pg8::EpiWo E{F.kpart + 131072, F.attn_norm, F.XN, (MK_REPEAT_PHASE == 3) ? (bf16*)(ws + 394 * MiB) : F.XN, (MK_REPEAT_PHASE == 3) ? ws + 458 * MiB : F.XN8, F.ssqa, F.ssq1};
        pg8::gemm_phase<pg8::EpiWo, pg8::StaticOrder, true, true, true>(F.lds + RING_OFF, g, S, E, F.wave);
        if (BOTH(3)) GRID_BAR(3);
    }

    if (IN(4)) {
        pg8::Gemm g{(const bf16*)((MK_REPEAT_PHASE == 3) ? ws + 458 * MiB : F.XN8), F.Wgu_t, M, NGU, D}; pg8::StaticOrder S; S.init(M, NGU, F.G, (int)blockIdx.x, MK_REPEAT_PHASE == 4 ? 2 : 1);
        pg8::EpiGU E{F.ssq1, F.HB};
        if (MK_REPEAT_PHASE == 40) { S.r1 = 6; pg8::gemm_phase<pg8::EpiGU, pg8::StaticOrder, true, true, true>(F.lds + RING_OFF, g, S, E, F.wave); GRID_BAR(9); S.r0 = 6; S.r1 = 1 << 30; }
        pg8::gemm_phase<pg8::EpiGU, pg8::StaticOrder, true, true, true>(F.lds + RING_OFF, g, S, E, F.wave);
        if (BOTH(4)) GRID_BAR(4);
    }

    if (IN(5)) {
        pg8::Gemm g{(const bf16*)F.HB, F.Wd_t, M, D, FF};   pg8::StaticOrder S; S.init(M, D, F.G, (int)blockIdx.x, MK_REPEAT_PHASE == 5 ? 2 : 1);
#if defined(MK_SPLIT_FINAL)
        pg8::EpiDown E{F.XN, F.out, F.ssq2};
        pg8::gemm_phase<pg8::EpiDown, pg8::StaticOrder, true, true, true>(F.lds + RING_OFF, g, S, E, F.wave);
        if (BOTH(5)) GRID_BAR(5);
#else
        if (F.G == 256) { pg8::EpiDownNorm E{(MK_REPEAT_PHASE == 3) ? (bf16*)(ws + 394 * MiB) : F.XN, F.out, F.ssq2, (unsigned*)(F.ctl + CW_PANEL), F.final_norm};
            pg8::gemm_phase<pg8::EpiDownNorm, pg8::StaticOrder, true, true, true>(F.lds + RING_OFF, g, S, E, F.wave); }
        else { pg8::EpiDown E{F.XN, F.out, F.ssq2}; pg8::gemm_phase<pg8::EpiDown, pg8::StaticOrder, true, true, true>(F.lds + RING_OFF, g, S, E, F.wave); GRID_BAR(5); p6_final(F); }
#endif
    }

#if defined(MK_SPLIT_FINAL)
    if (IN(6)) { p6_final(F); }
#endif
#undef IN
#undef BOTH
}

extern "C" void kernel_launch(void* const* d_in, const int* in_sizes, int n_in, void* d_out, int out_size, void* d_ws, size_t ws_size, hipStream_t stream) {
    static int grid = 0;
    if (grid == 0) {
        if (n_in != 11 || in_sizes[0] != M * D || out_size != M * D || ws_size < WS_END) { fprintf(stderr, "kernel_launch: unexpected shapes (n_in %d, in0 %d, out %d, ws %zu); nothing launched\n", n_in, n_in > 0 ? in_sizes[0] : -1, out_size, ws_size); grid = -1; return; }
        int dev = 0, cus = 0, per_cu = 0;
        if (hipGetDevice(&dev) != hipSuccess || hipDeviceGetAttribute(&cus, hipDeviceAttributeMultiprocessorCount, dev) != hipSuccess) { grid = -1; return; }
        if (hipFuncSetAttribute((const void*)mk_fwd, hipFuncAttributeMaxDynamicSharedMemorySize, LDS_BYTES) != hipSuccess) { fprintf(stderr, "kernel_launch: hipFuncSetAttribute failed\n"); grid = -1; return; }
        if (hipOccupancyMaxActiveBlocksPerMultiprocessor(&per_cu, (const void*)mk_fwd, NWAVES * 64, LDS_BYTES) != hipSuccess || per_cu < 1) { fprintf(stderr, "kernel_launch: occupancy query says %d blocks per CU\n", per_cu); (void)hipGetLastError(); per_cu = 1; }
        grid = cus;
        if (grid > 256) grid = 256;
    }
    if (grid < 0) return;
    if (hipMemsetAsync((char*)d_ws + WS_CTL, 0, CTL_ZERO_BYTES, stream) != hipSuccess) { fprintf(stderr, "kernel_launch: hipMemsetAsync failed\n"); return; }
    Args a{};
    for (int i = 0; i < 11; ++i) a.in[i] = (const float*)d_in[i];
    a.out = (float*)d_out; a.ws = (unsigned char*)d_ws;
    for (int li = 0; li < N_LAUNCHES; ++li) {
        a.ph_lo = (N_LAUNCHES == PER_PHASE) ? li : 0; a.ph_hi = (N_LAUNCHES == PER_PHASE) ? li + 1 : PER_PHASE; a.li = li;
        hipLaunchKernelGGL(mk_fwd, dim3(grid), dim3(NWAVES * 64), LDS_BYTES, stream, a);
        const hipError_t le = hipPeekAtLastError();
        if (le != hipSuccess) { fprintf(stderr, "kernel_launch: launch %d failed: %s\n", li, hipGetErrorName(le)); break; }
    }
}
```

```cpp
#include <hip/hip_runtime.h>
#include <cstdio>
#include <cstdint>
namespace pg8 {
#define PG8_LAS __attribute__((address_space(3)))
typedef unsigned short bf16_t;
typedef short bf16x8 __attribute__((ext_vector_type(8)));
typedef float f32x4 __attribute__((ext_vector_type(4)));
typedef unsigned u32x4 __attribute__((ext_vector_type(4)));
typedef int i32x4 __attribute__((ext_vector_type(4)));
typedef int i32x8 __attribute__((ext_vector_type(8)));
typedef unsigned u32x2 __attribute__((ext_vector_type(2)));
constexpr int BM = 256, BK = 64, HALF = 128, HTB = HALF * BK * 2  , STAGE_BYTES = 8 * HTB, NXCD = 8, WGM = 8;

__host__ __device__ __forceinline__ int lds_byte(int r, int c) { const int st = (r >> 4) * 2 + (c >> 5), rr = r & 15, cc = c & 31, ob = rr * 64 + cc * 2; return st * 1024 + (ob ^ (((ob >> 9) & 1) << 5)); }
__host__ __device__ __forceinline__ void stage_rc(int b, int& R, int& C) { const int st = b / 1024, sb = b % 1024, swz = sb ^ (((sb >> 9) & 1) << 5); R = (st >> 1) * 16 + swz / 64; C = (st & 1) * 32 + (swz % 64) / 2; }
__host__ __device__ __forceinline__ int perm32(int rho) { const int n = rho >> 4, i = rho & 15; return 8 * (i >> 2) + 4 * n + (i & 3); }

struct Unit { int pm, pn; };
struct Gemm { const bf16_t* A; const bf16_t* Bt; int M, N, K; };

struct StaticOrder {
    int nM, nN, nwg, G, c, reps, r0 = 0, r1 = 1 << 30;
    __host__ __device__ void init(int M, int N, int G_, int c_, int reps_ = 1) { nM = M / BM; nN = N / BM; nwg = nM * nN; G = G_; c = c_; reps = reps_; }
    __host__ __device__ bool next(int i, Unit& u) const {
        const int rounds = (nwg + G - 1) / G; i += r0; if (i >= reps * rounds || i >= r1) return false;
        const long L = (long)(i % rounds) * G + c; if (L >= nwg) return false;
        int wgid = (int)L; { const int q = nwg / NXCD, r = nwg % NXCD, xcd = wgid % NXCD, off = wgid / NXCD; wgid = (xcd < r ? xcd * (q + 1) : r * (q + 1) + (xcd - r) * q) + off; }
        const int nig = WGM * nN, gid = wgid / nig, fm = gid * WGM, gsz = (nM - fm) < WGM ? (nM - fm) : WGM;
        u.pm = fm + ((wgid % nig) % gsz); u.pn = (wgid % nig) / gsz; return true;
    }
    __device__ __forceinline__ void a_ready(const Unit&) const {}
    __device__ __forceinline__ void done(const Unit&) const {}
};


__device__ __forceinline__ unsigned cvt_pk_bf16(float lo, float hi) { unsigned r; asm volatile("v_cvt_pk_bf16_f32 %0, %1, %2" : "=v"(r) : "v"(lo), "v"(hi)); return r; }
__device__ __forceinline__ u32x4 pack8(const f32x4 a, const f32x4 b) { u32x4 w; w.x = cvt_pk_bf16(a[0], a[1]); w.y = cvt_pk_bf16(a[2], a[3]); w.z = cvt_pk_bf16(b[0], b[1]); w.w = cvt_pk_bf16(b[2], b[3]); return w; }
__device__ __forceinline__ float sum4(const f32x4 a) { return (a[0] + a[1]) + (a[2] + a[3]); }
__device__ __forceinline__ float sq4(const f32x4 a) { return (a[0] * a[0] + a[1] * a[1]) + (a[2] * a[2] + a[3] * a[3]); }
constexpr float RMS_EPS_F = 1e-6f;
__device__ __forceinline__ int lane_id() { int l; asm volatile("v_mbcnt_lo_u32_b32 %0, -1, 0\n\tv_mbcnt_hi_u32_b32 %0, -1, %0" : "=v"(l)); return l; }
__device__ __forceinline__ u32x2 pack8_fp8(const f32x4 a, const f32x4 b) { u32x2 w; unsigned t = 0;
    t = __builtin_amdgcn_cvt_pk_fp8_f32(a[0], a[1], t, false); t = __builtin_amdgcn_cvt_pk_fp8_f32(a[2], a[3], t, true); w.x = t; t = 0;
    t = __builtin_amdgcn_cvt_pk_fp8_f32(b[0], b[1], t, false); t = __builtin_amdgcn_cvt_pk_fp8_f32(b[2], b[3], t, true); w.y = t; return w; }
constexpr float F8_SA = 16.f, F8_SH = 8.f, F8_SW = 512.f, F8_SO = 64.f;
typedef float f32x2 __attribute__((ext_vector_type(2)));

struct EpiQKV {
    static constexpr bool PERM = true, AFTER_DRAIN = false, HAS_MID = false;
    bf16_t* Q; size_t part_stride; const float* rope; float* kpart; float qscale; int mapsel; float ascale;
    __device__ __forceinline__ void operator()(const f32x4 (&acc)[2][2][4][2], const Unit& u, int wr, int wc, int fr_, int fq_) const {
        const int ln_ = lane_id(), fr = ln_ & 15, fq = ln_ >> 4;
        const int rp = mapsel == 1 ? ((u.pn & 1) + 4 * (u.pn >> 1)) : (mapsel == 2 ? (u.pn < 4 ? (2 + (u.pn & 1) + 4 * (u.pn >> 1)) : u.pn + 4) : u.pn);
        const int part = rp >> 2, head = (rp & 3) * 4 + wc;
        bf16_t* base = Q + (size_t)part * part_stride + head * 64 + 8 * fq;
        const float sc = part == 0 ? qscale : 1.f;
        const bool rot = part != 2, km = (part == 1) && (head < 8);
        const int row0 = u.pm * BM + wr * 64 + fr;
        int rbase = row0; asm volatile("" : "+v"(rbase));
        f32x4 ks[2][2];
#pragma unroll
        for (int a = 0; a < 2; ++a)
#pragma unroll
            for (int b = 0; b < 2; ++b) ks[a][b] = (f32x4){0.f, 0.f, 0.f, 0.f};
#pragma unroll
        for (int ai = 0; ai < 2; ++ai)
#pragma unroll
            for (int m = 0; m < 4; ++m) {
                const int row = rbase + ai * HALF + m * 16;
                const int s = row & 4095;
                const f32x4* rp = (const f32x4*)(rope + ((size_t)s * 32 + 8 * fq) * 2);
                f32x4 t0, t1, t2, t3;
                if (rot) { t0 = rp[0]; t1 = rp[1]; t2 = rp[2]; t3 = rp[3]; } else { t0 = t1 = t2 = t3 = (f32x4){1.f, 0.f, 1.f, 0.f}; }
                f32x4 o1[2], o2[2];
#pragma unroll
                for (int n = 0; n < 2; ++n) {
                    const f32x4 cv = n == 0 ? (f32x4){t0[0], t0[2], t1[0], t1[2]} : (f32x4){t2[0], t2[2], t3[0], t3[2]};
                    const f32x4 sv = n == 0 ? (f32x4){t0[1], t0[3], t1[1], t1[3]} : (f32x4){t2[1], t2[3], t3[1], t3[3]};
                    const f32x4 x1 = acc[ai][0][m][n] * ascale, x2 = acc[ai][1][m][n] * ascale;
                    o1[n] = x1 * cv - x2 * sv; o2[n] = x2 * cv + x1 * sv;
                    if (km) { ks[0][n] += o1[n]; ks[1][n] += o2[n]; }
                    o1[n] = o1[n] * sc; o2[n] = o2[n] * sc;
                }
                bf16_t* rowp = base + (size_t)row * 1024;
                *(u32x4*)(rowp) = pack8(o1[0], o1[1]); *(u32x4*)(rowp + 32) = pack8(o2[0], o2[1]);
            }
        if (km) {
#pragma unroll
            for (int bj = 0; bj < 2; ++bj)
#pragma unroll
                for (int n = 0; n < 2; ++n) { f32x4 v = ks[bj][n];
#pragma unroll
                    for (int o = 1; o < 16; o <<= 1) { v[0] += __shfl_xor(v[0], o); v[1] += __shfl_xor(v[1], o); v[2] += __shfl_xor(v[2], o); v[3] += __shfl_xor(v[3], o); }
                    if (fr == 0) *(f32x4*)(kpart + (size_t)(u.pm * 2 + wr) * 512 + head * 64 + 32 * bj + 8 * fq + 4 * n) = v; }
        }
    }
};

struct EpiWo {
    static constexpr bool PERM = true, AFTER_DRAIN = false, HAS_MID = true;
    const float* rn0; const float* gain0; bf16_t* xn; bf16_t* xo; unsigned char* xn8;
    const float* ssq_att; float* ssq1;
    __device__ __forceinline__ void rstds(int row, int fq, float& rm, float& rd) const {
        const float s = sum4(*(const f32x4*)(ssq_att + (size_t)row * 16 + 4 * fq));
        const float t = s + __shfl_xor(s, 16), o = __shfl_xor(t, 32);
        rm = __builtin_amdgcn_rsqf((fq < 2 ? t : o) * (1.f / 512.f) + RMS_EPS_F);
        rd = __builtin_amdgcn_rsqf((fq < 2 ? o : t) * (1.f / 512.f) + RMS_EPS_F);
    }
    static constexpr float ASCALE = 1.f / (F8_SO * F8_SW);
    __device__ __forceinline__ void mid(f32x4 (&acc)[2][2][4][2], const Unit& u, int wr, int fr_) const {
        const int ln_ = lane_id(), fr = ln_ & 15, fq = ln_ >> 4;
        const int row0 = u.pm * BM + wr * 64 + fr;
        int rbase = row0; asm volatile("" : "+v"(rbase));
        float f[8];
#pragma unroll
        for (int i = 0; i < 8; ++i) { float rm, rd; rstds(rbase + (i >> 2) * HALF + (i & 3) * 16, fq, rm, rd); f[i] = rm / rd; }
#pragma unroll
        for (int ai = 0; ai < 2; ++ai)
#pragma unroll
            for (int m = 0; m < 4; ++m)
#pragma unroll
                for (int bj = 0; bj < 2; ++bj)
#pragma unroll
                    for (int n = 0; n < 2; ++n) acc[ai][bj][m][n] = acc[ai][bj][m][n] * f[ai * 4 + m];
    }
    __device__ __forceinline__ void operator()(const f32x4 (&acc)[2][2][4][2], const Unit& u, int wr, int wc, int fr_, int fq_) const {
        const int ln_ = lane_id(), fr = ln_ & 15, fq = ln_ >> 4;
        const int row0 = u.pm * BM + wr * 64 + fr, col0 = u.pn * BM + wc * 32 + 8 * fq;
        int rbase = row0; asm volatile("" : "+v"(rbase));
        f32x4 ig[2][2];
#pragma unroll
        for (int bj = 0; bj < 2; ++bj)
#pragma unroll
            for (int n = 0; n < 2; ++n) { const f32x4 g = *(const f32x4*)(gain0 + col0 + bj * HALF + 4 * n);
                ig[bj][n] = (f32x4){__builtin_amdgcn_rcpf(g[0]), __builtin_amdgcn_rcpf(g[1]), __builtin_amdgcn_rcpf(g[2]), __builtin_amdgcn_rcpf(g[3])}; }
#pragma unroll
        for (int ai = 0; ai < 2; ++ai)
#pragma unroll
            for (int m = 0; m < 4; ++m) { const int row = rbase + ai * HALF + m * 16; float rm, rd; rstds(row, fq, rm, rd); float s = 0.f; const float rn = rn0[row];
#pragma unroll
                for (int bj = 0; bj < 2; ++bj) { unsigned off = (unsigned)row * 1024u + col0 + bj * HALF; asm volatile("" : "+v"(off));
                    const u32x4 xw = *(const u32x4*)(xn + off);
                    const f32x4 xa = (f32x4){__uint_as_float(xw.x << 16), __uint_as_float(xw.x & 0xffff0000u), __uint_as_float(xw.y << 16), __uint_as_float(xw.y & 0xffff0000u)} * ig[bj][0] * rn;
                    const f32x4 xb = (f32x4){__uint_as_float(xw.z << 16), __uint_as_float(xw.z & 0xffff0000u), __uint_as_float(xw.w << 16), __uint_as_float(xw.w & 0xffff0000u)} * ig[bj][1] * rn;
                    const f32x4 v0 = xa + acc[ai][bj][m][0] * (rd * ASCALE), v1 = xb + acc[ai][bj][m][1] * (rd * ASCALE);
                    *(u32x4*)(xo + off) = pack8(v0, v1); *(u32x2*)(xn8 + off) = pack8_fp8(v0 * F8_SA, v1 * F8_SA); s += sq4(v0) + sq4(v1); }
                s += __shfl_xor(s, 16); s += __shfl_xor(s, 32);
                if (fq == 0) ssq1[(size_t)row * 16 + u.pn * 4 + wc] = s;
                asm volatile("" ::: "memory"); }
    }
};

struct EpiGU {
    static constexpr bool PERM = true, AFTER_DRAIN = false, HAS_MID = false;
    const float* ssq1; unsigned char* H;
    __device__ __forceinline__ void operator()(const f32x4 (&acc)[2][2][4][2], const Unit& u, int wr, int wc, int fr_, int fq_) const {
        const int ln_ = lane_id(), fr = ln_ & 15, fq = ln_ >> 4;
        const int row0 = u.pm * BM + wr * 64 + fr, col0 = u.pn * HALF + wc * 32 + 8 * fq;
        int rbase = row0; asm volatile("" : "+v"(rbase));
#pragma unroll
        for (int ai = 0; ai < 2; ++ai)
#pragma unroll
            for (int m = 0; m < 4; ++m) { const int row = rbase + ai * HALF + m * 16;
                float ss = sum4(*(const f32x4*)(ssq1 + (size_t)row * 16 + 4 * fq));
                ss += __shfl_xor(ss, 16); ss += __shfl_xor(ss, 32);
                const float rstd = __builtin_amdgcn_rsqf(ss * (1.f / 1024.f) + RMS_EPS_F) * (1.f / (F8_SA * F8_SW));
                f32x4 h[2];
                const float rs_e = rstd * -1.4426950408889634f, rs_u = rstd * (rstd * F8_SH);
#pragma unroll
                for (int n = 0; n < 2; ++n) { const f32x4 ea = acc[ai][0][m][n] * rs_e, gu = (acc[ai][0][m][n] * acc[ai][1][m][n]) * rs_u;
#pragma unroll
                    for (int i = 0; i < 4; ++i) h[n][i] = gu[i] * __builtin_amdgcn_rcpf(1.f + __builtin_amdgcn_exp2f(ea[i])); }
                *(u32x2*)(H + (size_t)row * 2816 + col0) = pack8_fp8(h[0], h[1]); }
    }
};

struct EpiDown {
    static constexpr bool PERM = true, AFTER_DRAIN = false, HAS_MID = false;
    const bf16_t* xn; float* out; float* ssq2;
    __device__ __forceinline__ void operator()(const f32x4 (&acc)[2][2][4][2], const Unit& u, int wr, int wc, int fr_, int fq_) const {
        const int ln_ = lane_id(), fr = ln_ & 15, fq = ln_ >> 4;
        const int row0 = u.pm * BM + wr * 64 + fr, col0 = u.pn * BM + wc * 32 + 8 * fq;
        int rbase = row0; asm volatile("" : "+v"(rbase));
#pragma unroll
        for (int ai = 0; ai < 2; ++ai)
#pragma unroll
            for (int m = 0; m < 4; ++m) { const int row = rbase + ai * HALF + m * 16; float s = 0.f;
#pragma unroll
                for (int bj = 0; bj < 2; ++bj) { const size_t off = (size_t)row * 1024 + col0 + bj * HALF;
                    const u32x4 xw = *(const u32x4*)(xn + off);
                    const f32x4 xa = {__uint_as_float(xw.x << 16), __uint_as_float(xw.x & 0xffff0000u), __uint_as_float(xw.y << 16), __uint_as_float(xw.y & 0xffff0000u)};
                    const f32x4 xb = {__uint_as_float(xw.z << 16), __uint_as_float(xw.z & 0xffff0000u), __uint_as_float(xw.w << 16), __uint_as_float(xw.w & 0xffff0000u)};
                    const f32x4 v0 = xa + acc[ai][bj][m][0] * (1.f / (F8_SH * F8_SW)), v1 = xb + acc[ai][bj][m][1] * (1.f / (F8_SH * F8_SW));
                    *(f32x4*)(out + off) = v0; *(f32x4*)(out + off + 4) = v1; s += sq4(v0) + sq4(v1); }
                s += __shfl_xor(s, 16); s += __shfl_xor(s, 32);
                if (fq == 0) ssq2[(size_t)row * 16 + u.pn * 4 + wc] = s;
                asm volatile("" ::: "memory"); }
    }
};

struct EpiDownNorm {
    static constexpr bool PERM = true, AFTER_DRAIN = false, HAS_MID = false;
    const bf16_t* xn; float* out; float* ssq2; unsigned* cnt; const float* gain;
    __device__ __forceinline__ void operator()(f32x4 (&acc)[2][2][4][2], const Unit& u, int wr, int wc, int fr_, int fq_) const {
        const int ln_ = lane_id(), fr = ln_ & 15, fq = ln_ >> 4;
        const int row0 = u.pm * BM + wr * 64 + fr, col0 = u.pn * BM + wc * 32 + 8 * fq;
        int rbase = row0; asm volatile("" : "+v"(rbase));
#pragma unroll
        for (int ai = 0; ai < 2; ++ai)
#pragma unroll
            for (int m = 0; m < 4; ++m) { const int row = rbase + ai * HALF + m * 16; float s = 0.f;
#pragma unroll
                for (int bj = 0; bj < 2; ++bj) { const size_t off = (size_t)row * 1024 + col0 + bj * HALF;
                    const u32x4 xw = *(const u32x4*)(xn + off);
                    const f32x4 xa = {__uint_as_float(xw.x << 16), __uint_as_float(xw.x & 0xffff0000u), __uint_as_float(xw.y << 16), __uint_as_float(xw.y & 0xffff0000u)};
                    const f32x4 xb = {__uint_as_float(xw.z << 16), __uint_as_float(xw.z & 0xffff0000u), __uint_as_float(xw.w << 16), __uint_as_float(xw.w & 0xffff0000u)};
                    acc[ai][bj][m][0] = acc[ai][bj][m][0] * (1.f / (F8_SH * F8_SW)) + xa; acc[ai][bj][m][1] = acc[ai][bj][m][1] * (1.f / (F8_SH * F8_SW)) + xb; s += sq4(acc[ai][bj][m][0]) + sq4(acc[ai][bj][m][1]); }
                s += __shfl_xor(s, 16); s += __shfl_xor(s, 32);
                if (fq == 0) __hip_atomic_store(ssq2 + (size_t)(u.pn * 4 + wc) * 32768 + row, s, __ATOMIC_RELAXED, __HIP_MEMORY_SCOPE_AGENT);
                asm volatile("" ::: "memory"); }
        asm volatile("s_waitcnt vmcnt(0)" ::: "memory");
        unsigned* cw = cnt + 64 * u.pm;
        if (fr == 0 && fq == 0) __hip_atomic_fetch_add(cw, 1u, __ATOMIC_RELAXED, __HIP_MEMORY_SCOPE_AGENT);
        { unsigned sp = 0; while ((unsigned)__builtin_amdgcn_readfirstlane((int)__hip_atomic_load(cw, __ATOMIC_RELAXED, __HIP_MEMORY_SCOPE_AGENT)) < 32u) { __builtin_amdgcn_s_sleep(1); if (++sp > (1u << 22)) break; } }
        f32x4 g[2][2];
#pragma unroll
        for (int bj = 0; bj < 2; ++bj) { g[bj][0] = *(const f32x4*)(gain + col0 + bj * HALF); g[bj][1] = *(const f32x4*)(gain + col0 + bj * HALF + 4); }
#pragma unroll
        for (int ai = 0; ai < 2; ++ai)
#pragma unroll
            for (int m = 0; m < 4; ++m) { const int row = rbase + ai * HALF + m * 16;
                const float* pp = ssq2 + (size_t)(4 * fq) * 32768 + row;
                float s = (__hip_atomic_load(pp, __ATOMIC_RELAXED, __HIP_MEMORY_SCOPE_AGENT) + __hip_atomic_load(pp + 32768, __ATOMIC_RELAXED, __HIP_MEMORY_SCOPE_AGENT))
                        + (__hip_atomic_load(pp + 2 * 32768, __ATOMIC_RELAXED, __HIP_MEMORY_SCOPE_AGENT) + __hip_atomic_load(pp + 3 * 32768, __ATOMIC_RELAXED, __HIP_MEMORY_SCOPE_AGENT));
                s += __shfl_xor(s, 16); s += __shfl_xor(s, 32);
                const float rstd = __builtin_amdgcn_rsqf(s * (1.f / 1024.f) + RMS_EPS_F);
#pragma unroll
                for (int bj = 0; bj < 2; ++bj) { const size_t off = (size_t)row * 1024 + col0 + bj * HALF;
                    *(f32x4*)(out + off) = acc[ai][bj][m][0] * rstd * g[bj][0]; *(f32x4*)(out + off + 4) = acc[ai][bj][m][1] * rstd * g[bj][1]; }
                asm volatile("" ::: "memory"); }
    }
};
template <class Epi, class Sched, bool ALIGN_EPI = false, bool SP2 = false, bool F8 = false>
__device__ __forceinline__ void gemm_phase(PG8_LAS unsigned char* lds, const Gemm g, const Sched& S, const Epi& E, int wave) {
    const int wid = __builtin_amdgcn_readfirstlane(wave), lane = lane_id(), tid = wid * 64 + lane, wr = wid >> 2, wc = wid & 3, fr = lane & 15, fq = lane >> 4;
    const int K = F8 ? g.K / 2 : g.K, nt = K / BK;
    unsigned voffA[2], voffB[2];
#pragma unroll
    for (int i = 0; i < 2; ++i) { int R, C; stage_rc(tid * 16 + i * 8192, R, C); const int Rb = Epi::PERM ? ((R & ~31) + perm32(R & 31)) : R;
        voffA[i] = (unsigned)(R * K + C) * 2u; voffB[i] = (unsigned)(Rb * K + C) * 2u; }
    const unsigned kstep = (unsigned)(BK * 2);
    const unsigned hstep = (unsigned)HALF * K * 2;
    const unsigned tstep = 2 * hstep;
    const unsigned ldsw = (unsigned)wid * 1024u;
    const int aoff = lds_byte(wr * 64 + fr, fq * 8), boff = lds_byte(wc * 32 + fr, fq * 8);
#define PG8_SA(b, h) (((b) * 2 + (h)) * HTB)
#define PG8_SB(b, h) ((4 + (b) * 2 + (h)) * HTB)
    const __amdgpu_buffer_rsrc_t rsA = __builtin_amdgcn_make_buffer_rsrc((void*)g.A, 0, 0x7fffffff, 0x00020000), rsB = __builtin_amdgcn_make_buffer_rsrc((void*)g.Bt, 0, 0x7fffffff, 0x00020000);
#define PG8_STAGE(bufoff, gbase, voff) do { _Pragma("unroll") for (int _i = 0; _i < 2; ++_i) \
        __builtin_amdgcn_raw_ptr_buffer_load_lds(PG8_RS_##voff, (PG8_LAS unsigned*)(lds + (bufoff) + ldsw + _i * 8192), 16, (voff)[_i], (int)(gbase), 0, 0); } while (0)
#define PG8_RS_voffA rsA
#define PG8_RS_voffB rsB
#define PG8_LD8(base, off) __builtin_shufflevector(*(const PG8_LAS i32x4*)((base) + (off)), *(const PG8_LAS i32x4*)((base) + (off) + 1024), 0, 1, 2, 3, 4, 5, 6, 7)
#define PG8_LDA(dst, b, h) do { if constexpr (F8) { _Pragma("unroll") for (int m = 0; m < 4; ++m) dst##8[m] = PG8_LD8(abase8, PG8_SA(b, h) + m * 2048); } else { \
        _Pragma("unroll") for (int m = 0; m < 4; ++m) _Pragma("unroll") for (int k = 0; k < 2; ++k) dst[m][k] = *(const PG8_LAS bf16x8*)(lds + PG8_SA(b, h) + aoff + m * 2048 + k * 1024); } } while (0)
#define PG8_LDB(dst, b, h) do { if constexpr (F8) { _Pragma("unroll") for (int n = 0; n < 2; ++n) dst##8[n] = PG8_LD8(bbase8, PG8_SB(b, h) - PG8_SB(0, 0) + n * 2048); } else { \
        _Pragma("unroll") for (int n = 0; n < 2; ++n) _Pragma("unroll") for (int k = 0; k < 2; ++k) dst[n][k] = *(const PG8_LAS bf16x8*)(lds + PG8_SB(b, h) + boff + n * 2048 + k * 1024); } } while (0)
#define PG8_MMA(ai, bj, At, Bt) do { __builtin_amdgcn_s_setprio(1); if constexpr (F8) { _Pragma("unroll") for (int m = 0; m < 4; ++m) _Pragma("unroll") for (int n = 0; n < 2; ++n) \
        acc[ai][bj][m][n] = __builtin_amdgcn_mfma_scale_f32_16x16x128_f8f6f4(Bt##8[n], At##8[m], acc[ai][bj][m][n], 0, 0, 0, 0, 0, 0); } else \
        _Pragma("unroll") for (int m = 0; m < 4; ++m) _Pragma("unroll") for (int n = 0; n < 2; ++n) _Pragma("unroll") for (int k = 0; k < 2; ++k) \
        acc[ai][bj][m][n] = __builtin_amdgcn_mfma_f32_16x16x32_bf16(Bt[n][k], At[m][k], acc[ai][bj][m][n], 0, 0, 0); __builtin_amdgcn_s_setprio(0); } while (0)
#define PG8_WAIT_V(n) asm volatile("s_waitcnt vmcnt(" #n ")" ::: "memory")
#define PG8_WAIT_L(n) asm volatile("s_waitcnt lgkmcnt(" #n ")" ::: "memory")
#define PG8_BAR __builtin_amdgcn_s_barrier()
#define PG8_SCHED __builtin_amdgcn_sched_barrier(0)
    Unit cur, nxt; int ui = 0;
    if (!S.next(0, cur)) return;
    f32x4 acc[2][2][4][2];
#pragma unroll
    for (int a = 0; a < 2; ++a)
#pragma unroll
        for (int b = 0; b < 2; ++b)
#pragma unroll
            for (int m = 0; m < 4; ++m)
#pragma unroll
                for (int n = 0; n < 2; ++n) acc[a][b][m][n] = (f32x4){0.f, 0.f, 0.f, 0.f};
    PG8_LAS unsigned char* abase8 = lds + aoff; PG8_LAS unsigned char* bbase8 = lds + PG8_SB(0, 0) + boff;
    if constexpr (F8) { asm volatile("" : "+v"(abase8)); asm volatile("" : "+v"(bbase8)); }
    bf16x8 At[4][2], B0[2][2], B1[2][2]; i32x8 At8[4], B08[2], B18[2];
    unsigned cA = (unsigned)cur.pm * tstep, cB = (unsigned)cur.pn * tstep;
    S.a_ready(cur);
    if constexpr (SP2) {
        PG8_STAGE(PG8_SB(0, 0), cB, voffB); PG8_STAGE(PG8_SB(0, 1), cB + hstep, voffB); PG8_STAGE(PG8_SA(0, 0), cA, voffA); PG8_STAGE(PG8_SA(0, 1), cA + hstep, voffA);
        if (wr == 1) PG8_BAR;
        PG8_WAIT_V(2); PG8_BAR;
        PG8_STAGE(PG8_SB(1, 0), cB + kstep, voffB); PG8_STAGE(PG8_SA(1, 0), cA + kstep, voffA); PG8_STAGE(PG8_SB(1, 1), cB + hstep + kstep, voffB);
        PG8_WAIT_V(6); PG8_BAR;
    } else {
        PG8_STAGE(PG8_SB(0, 0), cB, voffB); PG8_STAGE(PG8_SA(0, 0), cA, voffA); PG8_STAGE(PG8_SB(0, 1), cB + hstep, voffB); PG8_STAGE(PG8_SA(0, 1), cA + hstep, voffA);
        if (wr == 1) PG8_BAR;
        PG8_WAIT_V(4); PG8_BAR;
        PG8_STAGE(PG8_SB(1, 0), cB + kstep, voffB); PG8_STAGE(PG8_SA(1, 0), cA + kstep, voffA); PG8_STAGE(PG8_SB(1, 1), cB + hstep + kstep, voffB);
        PG8_WAIT_V(6); PG8_BAR;
    }
    for (;;) {
        const bool has_next = S.next(ui + 1, nxt);
        const unsigned nA = has_next ? (unsigned)nxt.pm * tstep : cA, nB = has_next ? (unsigned)nxt.pn * tstep : cB;
#pragma nounroll
        for (int t = 0; t < nt; t += 2) {
            if constexpr (Epi::HAS_MID) { if (t == (nt >> 1)) E.mid(acc, cur, wr, fr); }
            const bool last = (t == nt - 2);
            const unsigned a1 = cA + (unsigned)(t + 1) * kstep;
            const unsigned a2 = last ? nA : cA + (unsigned)(t + 2) * kstep, b2 = last ? nB : cB + (unsigned)(t + 2) * kstep;
            const unsigned a3 = a2 + kstep, b3 = b2 + kstep;
            if (last && has_next) S.a_ready(nxt);
            if constexpr (SP2) {
            PG8_LDB(B0, 0, 0); PG8_LDB(B1, 0, 1); PG8_SCHED; PG8_LDA(At, 0, 0); PG8_STAGE(PG8_SA(1, 1), a1 + hstep, voffA);
            PG8_WAIT_V(8); PG8_WAIT_L(0); PG8_BAR; PG8_MMA(0, 0, At, B0); PG8_MMA(0, 1, At, B1); PG8_BAR; PG8_SCHED;
            PG8_LDA(At, 0, 1); PG8_STAGE(PG8_SB(0, 0), b2, voffB); PG8_STAGE(PG8_SB(0, 1), b2 + hstep, voffB); PG8_STAGE(PG8_SA(0, 0), a2, voffA);
            PG8_WAIT_V(8); PG8_WAIT_L(0); PG8_BAR; PG8_MMA(1, 0, At, B0); PG8_MMA(1, 1, At, B1); PG8_BAR; PG8_SCHED;
            PG8_LDB(B0, 1, 0); PG8_LDB(B1, 1, 1); PG8_SCHED; PG8_LDA(At, 1, 0); PG8_STAGE(PG8_SA(0, 1), a2 + hstep, voffA);
            PG8_WAIT_V(8); PG8_WAIT_L(0); PG8_BAR; PG8_MMA(0, 0, At, B0); PG8_MMA(0, 1, At, B1); PG8_BAR; PG8_SCHED;
            PG8_LDA(At, 1, 1); PG8_STAGE(PG8_SB(1, 0), b3, voffB); PG8_STAGE(PG8_SB(1, 1), b3 + hstep, voffB); PG8_STAGE(PG8_SA(1, 0), a3, voffA);
            PG8_WAIT_V(8); PG8_WAIT_L(0); PG8_BAR; PG8_MMA(1, 0, At, B0); PG8_MMA(1, 1, At, B1); PG8_BAR; PG8_SCHED;
            } else {
            PG8_LDB(B0, 0, 0); PG8_SCHED; PG8_LDA(At, 0, 0); PG8_STAGE(PG8_SA(1, 1), a1 + hstep, voffA);
            PG8_WAIT_L(8); PG8_BAR; PG8_WAIT_L(0); PG8_MMA(0, 0, At, B0); PG8_BAR; PG8_SCHED;
            PG8_LDB(B1, 0, 1); PG8_STAGE(PG8_SB(0, 0), b2, voffB);
            PG8_BAR; PG8_WAIT_L(0); PG8_MMA(0, 1, At, B1); PG8_BAR;
            PG8_LDA(At, 0, 1); PG8_STAGE(PG8_SA(0, 0), a2, voffA);
            PG8_BAR; PG8_WAIT_L(0); PG8_MMA(1, 0, At, B0); PG8_BAR; PG8_SCHED;
            PG8_STAGE(PG8_SB(0, 1), b2 + hstep, voffB);
            PG8_WAIT_V(6); PG8_BAR; PG8_MMA(1, 1, At, B1); PG8_BAR;
            PG8_LDB(B0, 1, 0); PG8_SCHED; PG8_LDA(At, 1, 0); PG8_STAGE(PG8_SA(0, 1), a2 + hstep, voffA);
            PG8_WAIT_L(8); PG8_BAR; PG8_WAIT_L(0); PG8_MMA(0, 0, At, B0); PG8_BAR; PG8_SCHED;
            PG8_LDB(B1, 1, 1); PG8_STAGE(PG8_SB(1, 0), b3, voffB);
            PG8_BAR; PG8_WAIT_L(0); PG8_MMA(0, 1, At, B1); PG8_BAR;
            PG8_LDA(At, 1, 1); PG8_STAGE(PG8_SA(1, 0), a3, voffA);
            PG8_BAR; PG8_WAIT_L(0); PG8_MMA(1, 0, At, B0); PG8_BAR; PG8_SCHED;
            PG8_STAGE(PG8_SB(1, 1), b3 + hstep, voffB);
            PG8_WAIT_V(6); PG8_BAR; PG8_MMA(1, 1, At, B1); PG8_BAR;
            }
        }
        if constexpr (ALIGN_EPI) { if (wr == 0) PG8_BAR; }
        if constexpr (!Epi::AFTER_DRAIN) { E(acc, cur, wr, wc, fr, fq); S.done(cur); }
        if (!has_next) break;
#pragma unroll
        for (int a = 0; a < 2; ++a)
#pragma unroll
            for (int b = 0; b < 2; ++b)
#pragma unroll
                for (int m = 0; m < 4; ++m)
#pragma unroll
                    for (int n = 0; n < 2; ++n) acc[a][b][m][n] = (f32x4){0.f, 0.f, 0.f, 0.f};
        cur = nxt; cA = nA; cB = nB; ++ui;
        if constexpr (ALIGN_EPI) { if (wr == 1) PG8_BAR; }
    }
    PG8_WAIT_V(0);
    if constexpr (!ALIGN_EPI) { if (wr == 0) PG8_BAR; }
    PG8_BAR;
    if constexpr (Epi::AFTER_DRAIN) { E.fused(acc, cur, wr, wc, fr, fq, lds, wid, lane); S.done(cur); }
#undef PG8_SA
#undef PG8_SB
#undef PG8_STAGE
#undef PG8_RS_voffA
#undef PG8_RS_voffB
#undef PG8_LDA
#undef PG8_LDB
#undef PG8_MMA
#undef PG8_WAIT_V
#undef PG8_WAIT_L
#undef PG8_BAR
#undef PG8_SCHED
}
}

constexpr int NWAVES = 8;
#ifndef MK_N_LAUNCHES
#define MK_N_LAUNCHES 1
#endif
constexpr int PER_PHASE = 7;
constexpr int N_LAUNCHES = MK_N_LAUNCHES;

constexpr int BATCH = 8, SEQ = 4096, D = 1024, NH = 16, HD = 64, FF = 2816, NHM = 8;
constexpr int M = BATCH * SEQ;
constexpr int NQKV = 3 * D, NGU = 2 * FF;
constexpr float RMS_EPS = 1e-6f;
constexpr float QSCALE = 0.125f * 1.4426950408889634f;

constexpr size_t MiB = 1u << 20;
constexpr size_t WS_CTL = 0, CTL_ZERO_BYTES = 64 * 1024;
constexpr size_t WS_ROPE = 1 * MiB;
constexpr size_t WS_WQKV = 2 * MiB, WS_WO = 8 * MiB, WS_WGU = 10 * MiB, WS_WD = 21 * MiB;
constexpr size_t WS_KPART = 27 * MiB;
constexpr size_t WS_SSQA = 28 * MiB, WS_SSQ1 = 30 * MiB, WS_SSQ2 = 32 * MiB;
constexpr size_t WS_XN = 40 * MiB;
constexpr size_t WS_QO = 104 * MiB, WS_K = 168 * MiB, WS_V = 232 * MiB;
constexpr size_t WS_H = 104 * MiB;
#ifndef MK_REPEAT_PHASE
#define MK_REPEAT_PHASE -1
#endif
constexpr size_t WS_O = WS_QO;
constexpr size_t WS_FARO = 296 * MiB, WS_FARL = 328 * MiB;
constexpr size_t WS_XN8 = 330 * MiB;
constexpr size_t WS_O8 = 362 * MiB;
constexpr size_t WS_END = (MK_REPEAT_PHASE == 3 ? 490 : 394) * MiB;
constexpr size_t QKV8_OFF = 2 * MiB;
constexpr int CW_TMO = 0, CW_CODE = 1;
constexpr int CW_BAR = 4096;
constexpr int CW_PANEL = 8192;
constexpr int CW_FAR = 2048;

constexpr int RING_OFF = 0, RING_BYTES = 131072;
constexpr int LDSCTL_OFF = RING_BYTES, MISC_OFF = LDSCTL_OFF + 320;
constexpr int LDS_BYTES = 147456;
static_assert(WS_V - WS_K == WS_K - WS_QO, "Q | K | V equally spaced");
#define GAS __attribute__((address_space(1)))
#define LAS __attribute__((address_space(3)))
typedef unsigned short bf16;
typedef unsigned v4u __attribute__((ext_vector_type(4)));
typedef float f32x4 __attribute__((ext_vector_type(4)));
typedef short bf16x8 __attribute__((ext_vector_type(8)));
typedef GAS unsigned gu32;
typedef GAS unsigned long long gu64;
#define RLX_AGENT __ATOMIC_RELAXED, __HIP_MEMORY_SCOPE_AGENT
#define LDS_WAIT() asm volatile("s_waitcnt lgkmcnt(0)" ::: "memory")
#define VM_WAIT() asm volatile("s_waitcnt vmcnt(0)" ::: "memory")
__device__ __forceinline__ unsigned long long rt() { return __builtin_amdgcn_s_memrealtime(); }
__device__ __forceinline__ unsigned f2bf(float f) { unsigned u = __builtin_bit_cast(unsigned, f); return (u + 0x7fffu + ((u >> 16) & 1u)) >> 16; }
__device__ __forceinline__ unsigned pk2(float lo, float hi) { return f2bf(lo) | (f2bf(hi) << 16); }

#define XB_TMO      128
#define XB_XCNT(j)  (256  + 64 * (j))
#define XB_XSUB(j)  (1280 + 64 * (j))
#define XB_XGEN(j)  (2304 + 64 * (j))
#define XB_TOP      3328
#define XB_TOPGEN   3392
#define XCD_BAR_WORDS 3456
#define XB_SPIN_CAP (1u << 18)

__device__ __forceinline__ unsigned xb_ld(unsigned* p)              { return __hip_atomic_load(p, __ATOMIC_RELAXED, __HIP_MEMORY_SCOPE_AGENT); }
__device__ __forceinline__ unsigned xb_add(unsigned* p, unsigned v) { return __hip_atomic_fetch_add(p, v, __ATOMIC_RELAXED, __HIP_MEMORY_SCOPE_AGENT); }
__device__ __forceinline__ unsigned xb_xcc_id() { return (unsigned)__builtin_amdgcn_s_getreg((3 << 11) | 20) & 0xFu; }
#define XB_SPIN(cond, bar) do { unsigned _sp = 0; while (cond) { __builtin_amdgcn_s_sleep(1); \
    if ((++_sp & 255u) == 0u) { if (xb_ld(&(bar)[XB_TMO])) break; if (_sp > XB_SPIN_CAP) { atomicAdd(&(bar)[XB_TMO], 1u); break; } } } } while (0)

struct XcdBarrier {
    unsigned* bar; unsigned x;
    volatile LAS unsigned* st;
};

__device__ __forceinline__ int mk_lane() { int l; asm volatile("v_mbcnt_lo_u32_b32 %0, -1, 0\n\tv_mbcnt_hi_u32_b32 %0, -1, %0" : "=v"(l)); return l; }
__device__ __forceinline__ XcdBarrier xcd_barrier_post(unsigned* bar, volatile LAS unsigned* st, int wave) {
    XcdBarrier b; b.bar = bar; b.x = xb_xcc_id(); b.st = st;
    if (wave == 0 && mk_lane() == 0) (void)xb_add(&bar[XB_XCNT(b.x)], 1u);
    return b;
}
__device__ __forceinline__ void xcd_barrier_complete(unsigned* bar, unsigned x, unsigned& nloc, unsigned& nx) {
    const unsigned G = gridDim.x * gridDim.y * gridDim.z;
    unsigned sum, cnt, mine, sp = 0u;
    for (;;) {
        sum = 0u; cnt = 0u; mine = 0u;
#pragma unroll
        for (unsigned j = 0; j < 16; ++j) { const unsigned c = xb_ld(&bar[XB_XCNT(j)]); sum += c; cnt += (c > 0u) ? 1u : 0u; mine = (j == x) ? c : mine; }
        if (sum == G) break;
        __builtin_amdgcn_s_sleep(1);
        if ((++sp & 255u) == 0u) { if (xb_ld(&bar[XB_TMO])) break; if (sp > XB_SPIN_CAP) { atomicAdd(&bar[XB_TMO], 1u); break; } }
    }
    nloc = mine > 0u ? mine : 1u; nx = cnt > 0u ? cnt : 1u;
}

__device__ __forceinline__ void xcd_barrier(const XcdBarrier& b, int wave) {
    asm volatile("s_waitcnt vmcnt(0)" ::: "memory");
    __syncthreads();
    if (wave == 0 && mk_lane() == 0) {
        unsigned* bar = b.bar;
        __builtin_amdgcn_s_waitcnt(0);
        unsigned nloc = b.st[0], nx = b.st[1];
        if (nloc == 0u) { xcd_barrier_complete(bar, b.x, nloc, nx); b.st[0] = nloc; b.st[1] = nx; }
        const unsigned old = xb_add(&bar[XB_XSUB(b.x)], 1u);
        const unsigned gen = old / nloc;
        if (old + 1u == (gen + 1u) * nloc) {
            __builtin_amdgcn_fence(__ATOMIC_RELEASE, "agent");
            asm volatile("s_waitcnt vmcnt(0)" ::: "memory");
            const unsigned og = xb_add(&bar[XB_TOP], 1u);
            const unsigned tg = og / nx;
            if (og + 1u == (tg + 1u) * nx) xb_add(&bar[XB_TOPGEN], 1u);
            else XB_SPIN(xb_ld(&bar[XB_TOPGEN]) == tg, bar);
            __builtin_amdgcn_fence(__ATOMIC_ACQUIRE, "agent");
            xb_add(&bar[XB_XGEN(b.x)], 1u);
            asm volatile("s_waitcnt vmcnt(0)" ::: "memory");
        } else {
            XB_SPIN(xb_ld(&bar[XB_XGEN(b.x)]) == gen, bar);
            __builtin_amdgcn_fence(__ATOMIC_ACQUIRE, "agent");
            asm volatile("s_waitcnt vmcnt(0)" ::: "memory");
        }
    }
    __syncthreads();
}

#include <hip/hip_bf16.h>
#include <cmath>
namespace attn_body {
using bf16=__hip_bfloat16;
using bf16x8=__attribute__((ext_vector_type(8)))short;
using s16x4=__attribute__((ext_vector_type(4)))short;
using f32x16=__attribute__((ext_vector_type(16)))float;
using u32x4=__attribute__((ext_vector_type(4)))unsigned;
using f32x4_t=__attribute__((ext_vector_type(4)))float;
constexpr int BATCH=8,NHEAD=16,SEQ=4096,D=64,DM=NHEAD*D;
constexpr int NW=8,QBLK=32,QB=QBLK*NW,KVBLK=64,NQB=SEQ/QB;
constexpr int ATTN_PITCH=DM, ATTN_UNIT_ROWS=QB;
__device__ __forceinline__ int crow(int r,int hi){return (r&3)+8*(r>>2)+4*hi;}
#define SBAR() __builtin_amdgcn_sched_barrier(0)
__device__ __forceinline__ void cmask(f32x16&p0,f32x16&p1,int jb,int qrel,int hi){
  const float NEG=-INFINITY; int kb=64*jb+4*hi;
  #pragma unroll
  for(int r=0;r<16;++r){int kv=kb+(r&3)+8*(r>>2); if(kv>qrel)p0[r]=NEG; if(kv+32>qrel)p1[r]=NEG;}
}

__device__ __forceinline__ void dm_range(f32x16&p0,f32x16&p1,int x,unsigned bw){
  #pragma unroll
  for(int r=0;r<16;++r){ const int kp=(r&3)+8*(r>>2); if((unsigned)(x-kp)>bw)p0[r]=-1e30f; if((unsigned)(x-32-kp)>bw)p1[r]=-1e30f; } }
template<int KIND> __device__ __forceinline__ int dmode(int lo){
  if(KIND==2) return (lo+94<33||lo>128)?0:4;
  return (lo+94<0||lo>512)?0:((lo<0)?40:((lo+94<=128)?1:((lo<=128)?41:((lo+94<=512)?2:42)))); }
__device__ __forceinline__ void dm_adj128(f32x16&p0,f32x16&p1,int dqh,const f32x16&adj){
  #pragma unroll
  for(int r=0;r<16;++r){ const int kp=(r&3)+8*(r>>2); p0[r]+=(dqh-kp>128)?adj[r]:0.f; p1[r]+=(dqh-32-kp>128)?adj[r]:0.f; } }
__device__ __forceinline__ void fmask(f32x16&p0,f32x16&p1,int dq){
  #pragma unroll
  for(int r=0;r<16;++r){ const int kp=(r&3)+8*(r>>2); if((unsigned)(dq-kp-33)>95u)p0[r]=-1e30f; if((unsigned)(dq-kp-65)>95u)p1[r]=-1e30f; }
}
constexpr int NSLOT=3, SLOTB=8192;
constexpr int LDS_K=0, LDS_V=NSLOT*SLOTB, LDS_WS=2*NSLOT*SLOTB, LDS_OST=LDS_WS+NW*64*4, LDS_BYTES=LDS_OST+NW*4096;
constexpr int LDS_TAB=LDS_BYTES, TABB=4096, LDS_ALL=LDS_TAB+4*TABB;
constexpr float C2=0.125f*1.4426950408889634f;
__device__ __forceinline__ void glds16(const void*gsrc,unsigned lds_dst){unsigned keep;
  asm volatile("s_mov_b32 %0, m0\n\ts_mov_b32 m0, %2\n\ts_nop 0\n\tglobal_load_lds_dwordx4 %1, off\n\ts_mov_b32 m0, %0":"=&s"(keep):"v"(gsrc),"s"(lds_dst):"memory");}
__device__ __forceinline__ float max3f(float a,float b,float c){float r;asm("v_max3_f32 %0, %1, %2, %3":"=v"(r):"v"(a),"v"(b),"v"(c));return r;}
__device__ __forceinline__ float max2f(float a,float b){float r;asm("v_max_f32_e32 %0, %1, %2":"=v"(r):"v"(a),"v"(b));return r;}
__device__ __forceinline__ float fadd_s(float a,float b){float r;asm("v_add_f32_e32 %0, %1, %2":"=v"(r):"v"(a),"v"(b));return r;}
__device__ __forceinline__ float fsub_s(float a,float b){float r;asm("v_sub_f32_e32 %0, %1, %2":"=v"(r):"v"(a),"v"(b));return r;}
typedef float f32x2_t __attribute__((ext_vector_type(2))); typedef __bf16 bf16x2_t __attribute__((ext_vector_type(2)));
__device__ __forceinline__ unsigned cvtpk_s(float lo,float hi){f32x2_t v={lo,hi};bf16x2_t b=__builtin_convertvector(v,bf16x2_t);return __builtin_bit_cast(unsigned,b);}
#define WAIT_BAR(N) asm volatile("s_waitcnt vmcnt(" #N ") lgkmcnt(0)\n\ts_barrier":::"memory")

__device__ __forceinline__ void qkt(f32x16&p0,f32x16&p1,const char*Kslot,const bf16x8*qr,const f32x16&negm,int r32,int hi){
  const char*kb=Kslot+hi*1024+r32*16;
  #pragma unroll
  for(int d0=0;d0<4;++d0){
    const bf16x8 b0=*reinterpret_cast<const bf16x8*>(kb+d0*2048);
    const bf16x8 b1=*reinterpret_cast<const bf16x8*>(kb+d0*2048+512);
    if(d0==0){p0=__builtin_amdgcn_mfma_f32_32x32x16_bf16(b0,qr[0],negm,0,0,0);p1=__builtin_amdgcn_mfma_f32_32x32x16_bf16(b1,qr[0],negm,0,0,0);}
    else{p0=__builtin_amdgcn_mfma_f32_32x32x16_bf16(b0,qr[d0],p0,0,0,0);p1=__builtin_amdgcn_mfma_f32_32x32x16_bf16(b1,qr[d0],p1,0,0,0);}}
}
typedef __attribute__((address_space(3))) const char* lds_cptr;
typedef short v4i16_t __attribute__((ext_vector_type(4)));
__device__ __forceinline__ void kload8(bf16x8*kf,lds_cptr kp){
  kf[0]=*(const __attribute__((address_space(3))) bf16x8*)(kp);      kf[1]=*(const __attribute__((address_space(3))) bf16x8*)(kp+512);
  kf[2]=*(const __attribute__((address_space(3))) bf16x8*)(kp+2048); kf[3]=*(const __attribute__((address_space(3))) bf16x8*)(kp+2560);
  kf[4]=*(const __attribute__((address_space(3))) bf16x8*)(kp+4096); kf[5]=*(const __attribute__((address_space(3))) bf16x8*)(kp+4608);
  kf[6]=*(const __attribute__((address_space(3))) bf16x8*)(kp+6144); kf[7]=*(const __attribute__((address_space(3))) bf16x8*)(kp+6656);
}
__device__ __forceinline__ void kload2(bf16x8*kf,lds_cptr kp,int j){ kf[2*j]=*(const __attribute__((address_space(3))) bf16x8*)(kp+j*2048); kf[2*j+1]=*(const __attribute__((address_space(3))) bf16x8*)(kp+j*2048+512); }
__device__ __forceinline__ s16x4 vtr(lds_cptr p){ return __builtin_bit_cast(s16x4,__builtin_amdgcn_ds_read_tr16_b64_v4i16((__attribute__((address_space(3))) v4i16_t*)p)); }
__device__ __forceinline__ float rowmax(const f32x16&p0,const f32x16&p1){
  float a=max3f(p0[0],p0[1],p1[0]),b=max3f(p0[2],p0[3],p1[1]);a=max3f(a,p1[2],p1[3]);
  #pragma unroll
  for(int r=4;r<16;r+=4){a=max3f(a,p0[r],p0[r+1]);b=max3f(b,p0[r+2],p0[r+3]);a=max3f(a,p1[r],p1[r+1]);b=max3f(b,p1[r+2],p1[r+3]);}
  const float m=max2f(a,b);
  auto rr=__builtin_amdgcn_permlane32_swap(__float_as_uint(m),__float_as_uint(m),false,false);
  return max2f(__uint_as_float(rr[0]),__uint_as_float(rr[1]));
}
__device__ __forceinline__ void pv(f32x16*o,int vb,bf16x8 pa0,bf16x8 pa1,bf16x8 pa2,bf16x8 pa3){
  #pragma unroll
  for(int d0=0;d0<2;++d0){s16x4 lo[4],hi[4];
    #pragma unroll
    for(int ks=0;ks<4;++ks){
      asm volatile("ds_read_b64_tr_b16 %0,%1 offset:%c2":"=&v"(lo[ks]):"v"(vb),"i"(d0*4096+ks*1024):"memory");
      asm volatile("ds_read_b64_tr_b16 %0,%1 offset:%c2":"=&v"(hi[ks]):"v"(vb),"i"(d0*4096+ks*1024+512):"memory");}
    asm volatile("s_waitcnt lgkmcnt(0)":::"memory");SBAR();
    #define PK(k) (bf16x8){lo[k][0],lo[k][1],lo[k][2],lo[k][3],hi[k][0],hi[k][1],hi[k][2],hi[k][3]}
    o[d0]=__builtin_amdgcn_mfma_f32_32x32x16_bf16(pa0,PK(0),o[d0],0,0,0);
    o[d0]=__builtin_amdgcn_mfma_f32_32x32x16_bf16(pa1,PK(1),o[d0],0,0,0);
    o[d0]=__builtin_amdgcn_mfma_f32_32x32x16_bf16(pa2,PK(2),o[d0],0,0,0);
    o[d0]=__builtin_amdgcn_mfma_f32_32x32x16_bf16(pa3,PK(3),o[d0],0,0,0);
    #undef PK
  }
}

#ifndef ATTN_STORE16
#define ATTN_STORE16(p,v) asm volatile("global_store_dwordx4 %0, %1, off sc1\n\ts_nop 1"::"v"(p),"v"(v):"memory")
#endif
template<int THRL,int KIND> __device__ __forceinline__ void attn_unit(int b,int h,int qb,unsigned char*ws,char*shm,int wave,bf16x8 (&qr)[4],bool pre,bool has_next,int nkind,int nb,int nh,int nqb){
  const bf16*Q=(const bf16*)(ws+WS_QO); const bf16*K=(const bf16*)(ws+WS_K); const bf16*V=(const bf16*)(ws+WS_V); unsigned char*O8=ws+WS_O8;
  float*ssq=(float*)(ws+WS_SSQA); const float*kpart=(const float*)(ws+WS_KPART); unsigned short*faro=(unsigned short*)(ws+WS_FARO); float*farl=(float*)(ws+WS_FARL);
  constexpr bool DIL=(KIND==1), FAR=(KIND==2); constexpr int RS=FAR?16:1;
  int tid=wave*64+mk_lane(); asm volatile("":"+v"(tid));
  const int lane=tid&63,r32=lane&31,hi=lane>>5; const int wid=__builtin_amdgcn_readfirstlane(tid>>6);
  const int rowbase=b*SEQ+(FAR?qb:0);   const int q0=FAR?0:qb*QB;
  const bf16*Qw=Q+(rowbase+(int)(q0+wid*QBLK)*RS)*DM+h*D;
  const int T0=DIL?(qb>2?4*qb-8:0):0;
  const bf16*Kh=K+(rowbase+(int)T0*KVBLK)*DM+h*D,*Vh=V+(rowbase+(int)T0*KVBLK)*DM+h*D;
  const unsigned lds0=(unsigned)(uintptr_t)shm;
  float*wsf=(float*)(shm+LDS_WS)+wid*64;
  const bf16*ksrc=Kh+(int)lane*RS*DM+wid*8;
  const bf16*vsrc=Vh+(int)(16*(wid&3)+(lane>>2))*RS*DM+(wid>>2)*32+(lane&3)*8;
  const unsigned kdst=lds0+LDS_K+wid*1024, vdst=lds0+LDS_V+wid*1024;
  #define DMA_K(t,slot) glds16(ksrc+(int)(t)*KVBLK*RS*DM,(unsigned)__builtin_amdgcn_readfirstlane(kdst+(slot)))
  #define DMA_V(t,slot) glds16(vsrc+(int)(t)*KVBLK*RS*DM,(unsigned)__builtin_amdgcn_readfirstlane(vdst+(slot)))
  const int vb0=(int)(lds0+LDS_V)+((lane>>4)&1)*32+(lane&3)*8+(4*hi+((lane&15)>>2))*64;
  const char*Kbase=shm+LDS_K; bf16x8 kf[8];
  const lds_cptr shm3=(lds_cptr)shm; const lds_cptr kp0=shm3+LDS_K+hi*1024+r32*16; const lds_cptr vp0=shm3+LDS_V+((lane>>4)&1)*32+(lane&3)*8+(4*hi+((lane&15)>>2))*64;
  const int NT=FAR?4:(q0+QB)/KVBLK-T0;
  if(!pre)DMA_K(0,0); DMA_V(0,0); if(!pre)DMA_K(1,SLOTB);
  #pragma unroll
  for(int d0=0;d0<4;++d0)if(!pre)qr[d0]=*reinterpret_cast<const bf16x8*>(&Qw[(int)r32*RS*DM+d0*16+hi*8]);
  float mhat=0.f,l_reg=0.f;f32x16 o[2];o[0]=f32x16{};o[1]=f32x16{};
  const int qrel=wid*QBLK+r32;
  const lds_cptr tabp=(lds_cptr)shm+LDS_TAB+lane*64;
  unsigned selmask=1u<<qb;
  if(KIND==0){
    f32x16 g=f32x16{};
    #pragma unroll
    for(int d0=0;d0<4;++d0){ float km[8];
      if(r32<16){ const float*kp_=kpart+(unsigned)((b*16+r32)*2)*512+h*64+d0*16+hi*8;
        const f32x4_t a0=*(const f32x4_t*)kp_,a1=*(const f32x4_t*)(kp_+4),b0=*(const f32x4_t*)(kp_+512),b1=*(const f32x4_t*)(kp_+516);
        km[0]=a0[0]+b0[0];km[1]=a0[1]+b0[1];km[2]=a0[2]+b0[2];km[3]=a0[3]+b0[3];km[4]=a1[0]+b1[0];km[5]=a1[1]+b1[1];km[6]=a1[2]+b1[2];km[7]=a1[3]+b1[3]; }
      else{ _Pragma("unroll") for(int j=0;j<8;++j)km[j]=0.f; }
      u32x4 wh,wl; float rs[8];
      wh[0]=cvtpk_s(km[0],km[1]);wh[1]=cvtpk_s(km[2],km[3]);wh[2]=cvtpk_s(km[4],km[5]);wh[3]=cvtpk_s(km[6],km[7]);
      #pragma unroll
      for(int j=0;j<4;++j){ rs[2*j]=km[2*j]-__uint_as_float(wh[j]<<16); rs[2*j+1]=km[2*j+1]-__uint_as_float(wh[j]&0xffff0000u); }
      wl[0]=cvtpk_s(rs[0],rs[1]);wl[1]=cvtpk_s(rs[2],rs[3]);wl[2]=cvtpk_s(rs[4],rs[5]);wl[3]=cvtpk_s(rs[6],rs[7]);
      g=__builtin_amdgcn_mfma_f32_32x32x16_bf16(__builtin_bit_cast(bf16x8,wh),qr[d0],g,0,0,0);
      g=__builtin_amdgcn_mfma_f32_32x32x16_bf16(__builtin_bit_cast(bf16x8,wl),qr[d0],g,0,0,0); }
    float gv[16];
    #pragma unroll
    for(int r=0;r<8;++r){ const float own=g[r],oth=__shfl_xor(own,32); const int bl=(r&3)+8*(r>>2); gv[bl]=hi?oth:own; gv[bl+4]=hi?own:oth; }
    #pragma unroll
    for(int j=0;j<16;++j) if(j>=qb)gv[j]=-3e38f;
    #pragma unroll
    for(int rd=0;rd<3;++rd){ float best=-3e38f;int bi=0;
      #pragma unroll
      for(int j=0;j<16;++j){ if(gv[j]>best){best=gv[j];bi=j;} }
      if(best>-3e38f)selmask|=1u<<bi;
      #pragma unroll
      for(int j=0;j<16;++j) if(j==bi)gv[j]=-3e38f; }
  }
  const int lo0=FAR?(32*wid-63):(q0-T0*KVBLK+32*wid-63);
  #define DMODE(t) dmode<KIND>(lo0-(t)*KVBLK)
  #define CMASK(P0,P1,t) do{ if(DIL){ if(md_t>=40){ const int dqh_=q0-(T0+(t))*KVBLK+qrel-4*hi; \
        if(md_t==41){ const f32x16 adj_=*(const __attribute__((address_space(3))) f32x16*)(tabp+3*TABB); dm_adj128(P0,P1,dqh_,adj_); } \
        else dm_range(P0,P1,dqh_-((md_t==40)?0:-4096),(md_t==40)?0x7fffffffu:4608u); } } \
    else if(FAR){ if(md_t==4)fmask(P0,P1,qrel-(t)*KVBLK-4*hi); } \
    else { int jb_=(t)-(NT-4); if(jb_>=0)cmask(P0,P1,jb_,qrel,hi); } }while(0)
  #define SETC(t) f32x16 ct; const int md_t=(KIND==0)?0:DMODE(t); { if(DIL){ const int to_=(md_t==0)?0:((md_t==2||md_t==42)?2*TABB:TABB); \
      const f32x16 tb_=*(const __attribute__((address_space(3))) f32x16*)(tabp+to_); _Pragma("unroll") for(int r=0;r<16;++r)ct[r]=tb_[r]-mhat; } \
    else { const float x_=(FAR?(md_t!=0):(((selmask>>((t)>>2))&1u)!=0u))?-mhat:-1e30f; _Pragma("unroll") for(int r=0;r<16;++r)ct[r]=x_; } asm volatile("":"+v"(ct)); }
  bool resc=false;
  #define START(P0,P1) do{ const float rm=rowmax(P0,P1); resc=false; \
    if(__any(rm>(float)THRL)){ const float dl=__builtin_fmaxf(rm,0.f); mhat=fadd_s(mhat,dl); \
      _Pragma("unroll") for(int r=0;r<16;++r){P0[r]=fsub_s(P0[r],dl);P1[r]=fsub_s(P1[r],dl);} \
      const float f=__builtin_amdgcn_exp2f(-dl); l_reg*=f; if(hi==0)wsf[r32]=f; resc=true; } \
    _Pragma("unroll") for(int r=0;r<16;++r)P0[r]=__builtin_amdgcn_exp2f(P0[r]); }while(0)
  #define RESC() do{ if(resc){ asm volatile("s_waitcnt lgkmcnt(0)":::"memory"); \
      _Pragma("unroll") for(int d_=0;d_<2;++d_) _Pragma("unroll") for(int r=0;r<16;++r)o[d_][r]*=wsf[crow(r,hi)]; } }while(0)
  f32x16 pA0,pA1,pB0,pB1;
  int sl_prev=0,sl_cur=0,sl_next=SLOTB;
  #define ROT() do{sl_prev=sl_cur;sl_cur=sl_next;sl_next=(sl_next==(NSLOT-1)*SLOTB)?0:sl_next+SLOTB;}while(0)
  if(!pre){ DMA_K(2,2*SLOTB);
    WAIT_BAR(3); }
  else { WAIT_BAR(1); }
  if(0)WAIT_BAR(3);
  { SETC(0); qkt(pA0,pA1,Kbase,qr,ct,r32,hi); asm volatile("s_nop 15\n\ts_nop 7":"+v"(pA0),"+v"(pA1));CMASK(pA0,pA1,0); }
  START(pA0,pA1);
  _Pragma("unroll") for(int r=0;r<16;++r)pA1[r]=__builtin_amdgcn_exp2f(pA1[r]);
  WAIT_BAR(0);
  RESC();
  DMA_K(3,0);DMA_V(1,SLOTB);
  ROT();
  kload8(kf,kp0+sl_cur);
  WAIT_BAR(2);
  s16x4 vlo[8],vhi[8]; u32x4 pw0,pw1,pw2,pw3;
  #define PKW(P,B) cvtpk_s(P[B],P[B+1])
  #define PAF(k) __builtin_bit_cast(bf16x8,pw##k)
  #define VFR(i) (bf16x8){vlo[i][0],vlo[i][1],vlo[i][2],vlo[i][3],vhi[i][0],vhi[i][1],vhi[i][2],vhi[i][3]}
  #define PIN(x) asm volatile("":"+v"(x))
  #define MX3(a,b,c) __builtin_fmaxf(__builtin_fmaxf((a),(b)),(c))
  #define GAPA(MF,A0,A1,A2,A3,W0,W1,PW) do{ MF; sacc+=A0; sacc+=A1; sacc+=A2; sacc+=A3; PIN(sacc); W0; W1; PIN(PW); SBAR(); }while(0)
  #define EX(v) __builtin_amdgcn_exp2f(v)
  #define GAPB(MF,X,B) do{ MF; X[B]=EX(X[B]); X[B+1]=EX(X[B+1]); X[B+2]=EX(X[B+2]); X[B+3]=EX(X[B+3]); PIN(X); SBAR(); }while(0)
  #define VRD(i) do{ vlo[i]=vtr(vp_+(((i)>>2)*4096+((i)&3)*1024)); vhi[i]=vtr(vp_+(((i)>>2)*4096+((i)&3)*1024+512)); }while(0)
  #define KRD(G,j) do{ if(G){ kload2(kf,kp0+sl_next,j); SBAR(); } }while(0)
  #define STEP(C0,C1,P0,P1,t,GK,GV,GL) do{ SBAR(); SETC(t); SBAR(); \
    const lds_cptr vp_=vp0+sl_prev; \
    VRD(0); SBAR(); float sacc=(P0[0]+P0[1]); \
    GAPA(C0=__builtin_amdgcn_mfma_f32_32x32x16_bf16(kf[0],qr[0],ct,0,0,0), P0[2],P0[3],P0[4],P0[5],     pw0[0]=PKW(P0,0), pw0[1]=PKW(P0,2), pw0); \
    VRD(4); SBAR(); GAPA(C1=__builtin_amdgcn_mfma_f32_32x32x16_bf16(kf[1],qr[0],ct,0,0,0), P0[6],P0[7],P0[8],P0[9],     pw0[2]=PKW(P0,4), pw0[3]=PKW(P0,6), pw0); \
    VRD(1); SBAR(); GAPA(C0=__builtin_amdgcn_mfma_f32_32x32x16_bf16(kf[2],qr[1],C0,0,0,0),   P0[10],P0[11],P0[12],P0[13], pw1[0]=PKW(P0,8), pw1[1]=PKW(P0,10), pw1); \
    VRD(5); SBAR(); GAPA(C1=__builtin_amdgcn_mfma_f32_32x32x16_bf16(kf[3],qr[1],C1,0,0,0),   P0[14],P0[15],P1[0],P1[1],   pw1[2]=PKW(P0,12),pw1[3]=PKW(P0,14), pw1); \
    VRD(2); SBAR(); GAPA(C0=__builtin_amdgcn_mfma_f32_32x32x16_bf16(kf[4],qr[2],C0,0,0,0),   P1[2],P1[3],P1[4],P1[5],     pw2[0]=PKW(P1,0), pw2[1]=PKW(P1,2), pw2); \
    VRD(6); SBAR(); GAPA(C1=__builtin_amdgcn_mfma_f32_32x32x16_bf16(kf[5],qr[2],C1,0,0,0),   P1[6],P1[7],P1[8],P1[9],     pw2[2]=PKW(P1,4), pw2[3]=PKW(P1,6), pw2); \
    VRD(3); SBAR(); GAPA(C0=__builtin_amdgcn_mfma_f32_32x32x16_bf16(kf[6],qr[3],C0,0,0,0),   P1[10],P1[11],P1[12],P1[13], pw3[0]=PKW(P1,8), pw3[1]=PKW(P1,10), pw3); \
    VRD(7); SBAR(); GAPA(C1=__builtin_amdgcn_mfma_f32_32x32x16_bf16(kf[7],qr[3],C1,0,0,0),   P1[14],P1[15],0.f,0.f,       pw3[2]=PKW(P1,12),pw3[3]=PKW(P1,14), pw3); \
    l_reg+=sacc; \
    if(GK){DMA_K((t)+3,sl_cur);} if(GV){DMA_V((t)+1,sl_next);} \
    CMASK(C0,C1,t); \
    { float a=MX3(C0[0],C0[1],C1[0]),b=MX3(C0[2],C0[3],C1[1]); a=MX3(a,C1[2],C1[3]); \
      _Pragma("unroll") for(int r=4;r<16;r+=4){a=MX3(a,C0[r],C0[r+1]);b=MX3(b,C0[r+2],C0[r+3]);a=MX3(a,C1[r],C1[r+1]);b=MX3(b,C1[r+2],C1[r+3]);} \
      float rm=__builtin_fmaxf(a,b); { auto rr=__builtin_amdgcn_permlane32_swap(__float_as_uint(rm),__float_as_uint(rm),false,false); rm=__builtin_fmaxf(__uint_as_float(rr[0]),__uint_as_float(rr[1])); } \
      resc=false; \
      if(__builtin_expect(__any(rm>(float)THRL),0)){ const float dl=__builtin_fmaxf(rm,0.f); mhat+=dl; \
        _Pragma("unroll") for(int r=0;r<16;++r){C0[r]-=dl;C1[r]-=dl;} \
        const float f=__builtin_amdgcn_exp2f(-dl); l_reg*=f; if(hi==0)wsf[r32]=f; resc=true; } } \
    SBAR(); \
    GAPB(o[0]=__builtin_amdgcn_mfma_f32_32x32x16_bf16(PAF(0),VFR(0),o[0],0,0,0), C0,0); \
    GAPB(o[1]=__builtin_amdgcn_mfma_f32_32x32x16_bf16(PAF(0),VFR(4),o[1],0,0,0), C0,4); \
    KRD(GL,0); GAPB(o[0]=__builtin_amdgcn_mfma_f32_32x32x16_bf16(PAF(1),VFR(1),o[0],0,0,0), C0,8); \
    KRD(GL,1); GAPB(o[1]=__builtin_amdgcn_mfma_f32_32x32x16_bf16(PAF(1),VFR(5),o[1],0,0,0), C0,12); \
    KRD(GL,2); GAPB(o[0]=__builtin_amdgcn_mfma_f32_32x32x16_bf16(PAF(2),VFR(2),o[0],0,0,0), C1,0); \
    KRD(GL,3); GAPB(o[1]=__builtin_amdgcn_mfma_f32_32x32x16_bf16(PAF(2),VFR(6),o[1],0,0,0), C1,4); \
    GAPB(o[0]=__builtin_amdgcn_mfma_f32_32x32x16_bf16(PAF(3),VFR(3),o[0],0,0,0), C1,8); \
    GAPB(o[1]=__builtin_amdgcn_mfma_f32_32x32x16_bf16(PAF(3),VFR(7),o[1],0,0,0), C1,12); \
    }while(0)
  int t=1;
  for(;t+5<NT;t+=2){
    STEP(pB0,pB1,pA0,pA1,t,true,true,true);     WAIT_BAR(2); RESC(); ROT();
    STEP(pA0,pA1,pB0,pB1,t+1,true,true,true);   WAIT_BAR(2); RESC(); ROT();
  }
  #define ENDW(tt) do{ if((tt)+3<NT){WAIT_BAR(2);} else if((tt)+2<NT){WAIT_BAR(1);} else {WAIT_BAR(0);} }while(0)
  for(;t+1<NT;t+=2){
    STEP(pB0,pB1,pA0,pA1,t,(t+3<NT),(t+1<NT),(t+1<NT));       ENDW(t);   RESC(); ROT();
    STEP(pA0,pA1,pB0,pB1,t+1,(t+4<NT),(t+2<NT),(t+2<NT));     ENDW(t+1); RESC(); ROT();
  }
  if(has_next){
    const int nRS=(nkind==2)?16:1, nrowbase=nb*SEQ+((nkind==2)?nqb:0), nT0=(nkind==1)?(nqb>2?4*nqb-8:0):0;
    const bf16*nks=K+(nrowbase+(int)nT0*KVBLK)*DM+nh*D+(int)lane*nRS*DM+wid*8;
    glds16(nks,(unsigned)__builtin_amdgcn_readfirstlane(kdst)); glds16(nks+(int)KVBLK*nRS*DM,(unsigned)__builtin_amdgcn_readfirstlane(kdst+SLOTB)); glds16(nks+(int)2*KVBLK*nRS*DM,(unsigned)__builtin_amdgcn_readfirstlane(kdst+2*SLOTB)); }
  STEP(pB0,pB1,pA0,pA1,NT-1,false,false,false); RESC();
  if(has_next){
    const int nRS=(nkind==2)?16:1, nrowbase=nb*SEQ+((nkind==2)?nqb:0), nq0=(nkind==2)?0:nqb*QB; const bf16*nQw=Q+(nrowbase+(int)(nq0+wid*QBLK)*nRS)*DM+nh*D;
    #pragma unroll
    for(int d0=0;d0<4;++d0)qr[d0]=*reinterpret_cast<const bf16x8*>(&nQw[(int)r32*nRS*DM+d0*16+hi*8]); }
  { float sacc=pB0[0]+pB0[1]; _Pragma("unroll") for(int r=2;r<16;++r)sacc+=pB0[r]; _Pragma("unroll") for(int r=0;r<16;++r)sacc+=pB1[r]; l_reg+=sacc;
    pw0=(u32x4){PKW(pB0,0),PKW(pB0,2),PKW(pB0,4),PKW(pB0,6)};pw1=(u32x4){PKW(pB0,8),PKW(pB0,10),PKW(pB0,12),PKW(pB0,14)};pw2=(u32x4){PKW(pB1,0),PKW(pB1,2),PKW(pB1,4),PKW(pB1,6)};pw3=(u32x4){PKW(pB1,8),PKW(pB1,10),PKW(pB1,12),PKW(pB1,14)};
    SBAR(); pv(o,vb0+sl_cur,PAF(0),PAF(1),PAF(2),PAF(3)); }
  #undef PKW
  #undef PAF
  #undef VFR
  #undef PIN
  #undef MX3
  #undef GAPA
  #undef GAPB
  #undef EX
  #undef VRD
  #undef KRD
  #undef STEP
  #undef ENDW
  {auto rr=__builtin_amdgcn_permlane32_swap(__float_as_uint(l_reg),__float_as_uint(l_reg),false,false);l_reg=__uint_as_float(rr[0])+__uint_as_float(rr[1]);}
  int lane_e=lane; asm volatile("":"+v"(lane_e));
  u32x4 fch[4];
  if(DIL){
    const unsigned short*fp=faro+(unsigned)(rowbase+q0+wid*QBLK+(lane_e>>3))*512+(h-8)*D+(lane_e&7)*8;
    #pragma unroll
    for(int i=0;i<4;++i)fch[i]=*(const u32x4*)(fp+(unsigned)i*8*512);
    const int p_=q0+wid*QBLK+(lane_e&31); const float*lp=farl+((unsigned)(((b*8+(h-8))*16+(p_&15))*256+(p_>>4)))*2; const float lf_=lp[0],mf_=lp[1];
    const float M_=__builtin_fmaxf(mhat,mf_),sa_=__builtin_amdgcn_exp2f(mhat-M_),sb_=__builtin_amdgcn_exp2f(mf_-M_),rl_=__builtin_amdgcn_rcpf(l_reg*sa_+lf_*sb_);
    if(hi==0){wsf[32+r32]=sa_*rl_;wsf[r32]=sb_*rl_;} }
  else if(hi==0)wsf[32+r32]=FAR?1.f:__builtin_amdgcn_rcpf(l_reg);
  asm volatile("s_waitcnt lgkmcnt(0)":::"memory");
  float rli[16];
  #pragma unroll
  for(int r=0;r<16;++r)rli[r]=wsf[32+crow(r,hi)];
  constexpr int OP=FAR?512:DM;
  bf16*Ow=(bf16*)faro+(rowbase+(int)wid*QBLK*RS)*OP+(h-8)*D;
  unsigned char*O8w=O8+(rowbase+q0+wid*QBLK)*DM+h*D;
  if(FAR&&hi==0){ float*lp=farl+((unsigned)(((b*8+(h-8))*16+qb)*256+qrel))*2; __hip_atomic_store((unsigned long long*)lp,((unsigned long long)__float_as_uint(mhat)<<32)|__float_as_uint(l_reg),__ATOMIC_RELAXED,__HIP_MEMORY_SCOPE_AGENT); }
  { bf16*stg=(bf16*)(shm+LDS_OST)+wid*2048;
    #pragma unroll
    for(int r=0;r<16;++r){const int orow=crow(r,hi);
      #pragma unroll
      for(int d0=0;d0<2;++d0)stg[orow*64+d0*32+r32]=__float2bfloat16(o[d0][r]*rli[r]);}
    asm volatile("s_waitcnt lgkmcnt(0)":::"memory");
    #pragma unroll
    for(int i=0;i<4;++i){const int row=i*8+(lane_e>>3),ch=lane_e&7; u32x4 v=*(const u32x4*)(stg+row*64+ch*8);
      if(DIL){ const float fb_=wsf[row];
        #pragma unroll
        for(int j=0;j<4;++j){ const float a_=__uint_as_float(v[j]<<16)+__uint_as_float(fch[i][j]<<16)*fb_, b_=__uint_as_float(v[j]&0xffff0000u)+__uint_as_float(fch[i][j]&0xffff0000u)*fb_; v[j]=cvtpk_s(a_,b_); } }
      if(FAR){ ATTN_STORE16(Ow+(int)row*RS*OP+ch*8,v); }
      else { unsigned w0_=0,w1_=0;
        w0_=__builtin_amdgcn_cvt_pk_fp8_f32(__uint_as_float(v[0]<<16)*64.f,__uint_as_float(v[0]&0xffff0000u)*64.f,w0_,false); w0_=__builtin_amdgcn_cvt_pk_fp8_f32(__uint_as_float(v[1]<<16)*64.f,__uint_as_float(v[1]&0xffff0000u)*64.f,w0_,true);
        w1_=__builtin_amdgcn_cvt_pk_fp8_f32(__uint_as_float(v[2]<<16)*64.f,__uint_as_float(v[2]&0xffff0000u)*64.f,w1_,false); w1_=__builtin_amdgcn_cvt_pk_fp8_f32(__uint_as_float(v[3]<<16)*64.f,__uint_as_float(v[3]&0xffff0000u)*64.f,w1_,true);
        *(unsigned long long*)(O8w+(int)row*DM+ch*8)=((unsigned long long)w1_<<32)|w0_; }
      float sq=0.f;
      #pragma unroll
      for(int j=0;j<4;++j){ const float a_=__uint_as_float(v[j]<<16), b_=__uint_as_float(v[j]&0xffff0000u); sq+=a_*a_+b_*b_; }
      sq+=__shfl_xor(sq,1); sq+=__shfl_xor(sq,2); sq+=__shfl_xor(sq,4);
      if(!FAR&&ch==0)ssq[(unsigned)(rowbase+q0+wid*QBLK+row)*16+h]=sq; } }
  asm volatile("s_waitcnt lgkmcnt(0)\n\ts_barrier":::"memory");
  #undef DMA_K
  #undef DMA_V
  #undef CMASK
  #undef START
  #undef RESC
  #undef ROT
}
constexpr int ATTN_LDS_BYTES=LDS_BYTES;
__device__ __forceinline__ void attn_tables(char*lds,int wave){
  float*tb=(float*)(lds+LDS_TAB);
  for(int e=wave*64+mk_lane();e<64*16;e+=512){ const int ln=e>>4,r=e&15,r32=ln&31,hi=ln>>5; const int z4=r32&3,z16=((r32&15)-4*hi)&15;
    const bool in4=(z4==(r&3)),in16=(z16==((r&3)+8*((r>>2)&1)));
    tb[e]=-1e30f; tb[1024+e]=in16?1.5849625007f:(in4?1.f:0.f); tb[2048+e]=in16?1.f:(in4?0.f:-1e30f); tb[3072+e]=in16?(1.f-1.5849625007f):(in4?-1.f:-1e30f); }
  __syncthreads();
}
template<int THRL=8> __device__ __forceinline__ void attn_phase(char*lds,unsigned char*ws,unsigned*cnt,int vcu,int G,int wave){
  const int g=vcu>>2,b=g>>3,hm=g&7,c=vcu&3;
  attn_tables(lds,wave);
  bf16x8 qr[4];
  { const int nf_=(c==0)?6:((c==1)?4:3), cb_=(c==0)?0:((c==1)?6:((c==2)?10:13)); const int n_=(MK_REPEAT_PHASE==22?2*nf_:nf_); for(int i=0;i<n_;++i) attn_unit<THRL,2>(b,8+hm,cb_+(i%nf_),ws,lds,wave,qr,i>0,true,(i+1<n_)?2:0,b,(i+1<n_)?8+hm:hm,(i+1<n_)?cb_+((i+1)%nf_):15-c); }
  asm volatile("s_waitcnt vmcnt(0)":::"memory"); __syncthreads();
  if(wave==0&&mk_lane()==0) __hip_atomic_fetch_add(cnt,1u,__ATOMIC_RELAXED,__HIP_MEMORY_SCOPE_AGENT);
  #define QBSEL(i_) ((((i_)&3)==0)?15-c:((((i_)&3)==1)?8+c:((((i_)&3)==2)?7-c:c)))
  { const int n_=(MK_REPEAT_PHASE==20?8:4); for(int ii=0;ii<n_;++ii) attn_unit<THRL,0>(b,hm,QBSEL(ii),ws,lds,wave,qr,true,true,(ii+1<n_)?0:1,b,(ii+1<n_)?hm:8+hm,QBSEL(ii+1)); }
  if(wave==0&&mk_lane()==0){ unsigned sp=0; while(__hip_atomic_load(cnt,__ATOMIC_RELAXED,__HIP_MEMORY_SCOPE_AGENT)<(unsigned)G){ __builtin_amdgcn_s_sleep(2); if(++sp>(1u<<22))break; }
    __builtin_amdgcn_fence(__ATOMIC_ACQUIRE,"agent"); asm volatile("s_waitcnt vmcnt(0)":::"memory"); }
  __syncthreads();
  { const int n_=(MK_REPEAT_PHASE==21?8:4); for(int ii=0;ii<n_;++ii) attn_unit<THRL,1>(b,8+hm,QBSEL(ii),ws,lds,wave,qr,true,ii+1<n_,1,b,8+hm,QBSEL(ii+1)); }
  #undef QBSEL
}
#undef SBAR
#undef WAIT_BAR
}

struct Frame {
    LAS unsigned char* lds;
    volatile LAS unsigned* MISC;
    gu32* ctl;
    int wave;
    int vcu, G;
    const float *x, *attn_norm, *w_in, *moba_norm, *dil_norm, *w_out, *ffn_norm, *w_gate, *w_up, *w_down, *final_norm;
    float* out;
    bf16 *Wqkv_t, *Wo_t, *Wgu_t, *Wd_t;
    bf16 *QO, *KB, *VB, *XN, *OB; unsigned char *HB, *XN8;
    float *rope, *kpart, *ssqa, *ssq1, *ssq2;
};

__device__ __forceinline__ float wave_sum(float v) {
#pragma unroll
    for (int o = 1; o < 64; o <<= 1) v += __shfl_xor(v, o);
    return v;
}
__device__ __forceinline__ int qkv_vrow(int n) { const int part = n >> 10, head = (n >> 6) & 15, d = n & 63; return 256 * (part * 4 + (head >> 2)) + 128 * (d >> 5) + 32 * (head & 3) + (d & 31); }
template <int MODE>
__device__ __forceinline__ void p0_item(const float* W, int K, int N, bf16* WT, const float* g0, const float* g1, LAS float* scr, int item, int lane) {
    const int nblk = N / 32, kb = item / nblk, nb = item % nblk, k0 = 64 * kb, n0 = 32 * nb;
#pragma unroll 8
    for (int i = 0; i < 32; ++i) { const int kk = 2 * i + (lane >> 5), k = k0 + kk; float w = W[(size_t)k * N + n0 + (lane & 31)];
        if (MODE == 1) w *= (k < 512 ? g0[k] : g1[k - 512]);
        if (MODE == 2 || MODE == 3) w *= g0[k];
        scr[kk * 33 + (lane & 31)] = w; }
    LDS_WAIT(); asm volatile("" ::: "memory");
    const int c = lane & 7;
#pragma unroll
    for (int j = 0; j < 4; ++j) { const int n = (lane >> 3) + 8 * j; const LAS float* s = scr + (8 * c) * 33 + n;
        const int ns = n0 + n; int dr;
        if (MODE == 0) dr = qkv_vrow(ns); else if (MODE == 2) dr = 256 * (ns >> 7) + (ns & 127); else if (MODE == 3) dr = 256 * (ns >> 7) + 128 + (ns & 127); else dr = ns;
        bool f8 = MODE >= 1; size_t base8 = 0;
        if (MODE == 0) {
            const int pn = dr >> 8, lo = dr & 255; f8 = !(pn < 8 && (pn & 3) < 2);
            dr = (f8 ? (pn < 8 ? ((pn & 1) + 2 * (pn >> 2)) : pn - 4) : ((pn & 1) + 2 * (pn >> 2))) * 256 + lo; base8 = (size_t)QKV8_OFF; }
        if (f8) {
            const pg8::f32x4 a = {s[0 * 33], s[1 * 33], s[2 * 33], s[3 * 33]}, b = {s[4 * 33], s[5 * 33], s[6 * 33], s[7 * 33]};
            *(GAS pg8::u32x2*)((unsigned char*)WT + base8 + (size_t)dr * K + k0 + 8 * c) = pg8::pack8_fp8(a * pg8::F8_SW, b * pg8::F8_SW);
        } else {
            v4u o; o.x = pk2(s[0 * 33], s[1 * 33]); o.y = pk2(s[2 * 33], s[3 * 33]); o.z = pk2(s[4 * 33], s[5 * 33]); o.w = pk2(s[6 * 33], s[7 * 33]);
            *(GAS v4u*)(WT + (size_t)dr * K + k0 + 8 * c) = o; } }
    LDS_WAIT(); asm volatile("" ::: "memory");
}
template <int R>
__device__ __forceinline__ void rms_rows_to_bf16(Frame& F, const float* xrow, const float* gain, bf16* orow, unsigned char* orow8, float* rn) {
    const GAS f32x4* xr = (const GAS f32x4*)xrow + mk_lane(); const GAS f32x4* gr = (const GAS f32x4*)gain + mk_lane();
    f32x4 v[R][4]; float s[R];
#pragma unroll
    for (int r = 0; r < R; ++r)
#pragma unroll
        for (int j = 0; j < 4; ++j) v[r][j] = xr[r * 256 + 64 * j];
#pragma unroll
    for (int r = 0; r < R; ++r) { s[r] = 0.f;
#pragma unroll
        for (int j = 0; j < 4; ++j) s[r] += (v[r][j].x * v[r][j].x + v[r][j].y * v[r][j].y) + (v[r][j].z * v[r][j].z + v[r][j].w * v[r][j].w); }
#pragma unroll
    for (int o = 1; o < 64; o <<= 1)
#pragma unroll
        for (int r = 0; r < R; ++r) s[r] += __shfl_xor(s[r], o);
    const int ln_ = mk_lane(); GAS unsigned long long* o8 = (GAS unsigned long long*)orow + ln_; GAS unsigned* q8 = (GAS unsigned*)orow8 + ln_;
#pragma unroll
    for (int r = 0; r < R; ++r) { const float rms = sqrtf(s[r] * (1.f / D) + RMS_EPS), rstd = 1.f / rms; if (ln_ == 0) rn[r] = rms;
#pragma unroll
        for (int j = 0; j < 4; ++j) { const f32x4 g = gr[64 * j];
            const f32x4 y = v[r][j] * rstd * g;
            o8[r * 256 + 64 * j] = (unsigned long long)pk2(y.x, y.y) | ((unsigned long long)pk2(y.z, y.w) << 32);
            unsigned t = 0; t = __builtin_amdgcn_cvt_pk_fp8_f32(y.x * pg8::F8_SA, y.y * pg8::F8_SA, t, false); t = __builtin_amdgcn_cvt_pk_fp8_f32(y.z * pg8::F8_SA, y.w * pg8::F8_SA, t, true); q8[r * 256 + 64 * j] = t; } }
}
__device__ __forceinline__ void p0_prologue(Frame& F) {
    LAS float* scr = (LAS float*)(F.lds + RING_OFF + F.wave * 16384);
    const int gw = F.vcu * NWAVES + F.wave, NGW = F.G * NWAVES;
    constexpr int I_IN = (D / 64) * (NQKV / 32), I_O = (D / 64) * (D / 32), I_G = (D / 64) * (FF / 32), I_D = (FF / 64) * (D / 32);
    constexpr int NITEMS = I_IN + I_O + 2 * I_G + I_D;
    for (int it = gw; it < NITEMS; it += NGW) {
        int r = it;
        if (r < I_IN) { p0_item<0>(F.w_in, D, NQKV, F.Wqkv_t, nullptr, nullptr, scr, r, mk_lane()); continue; } r -= I_IN;
        if (r < I_O) { p0_item<1>(F.w_out, D, D, F.Wo_t, F.moba_norm, F.dil_norm, scr, r, mk_lane()); continue; } r -= I_O;
        if (r < I_G) { p0_item<2>(F.w_gate, D, FF, F.Wgu_t, F.ffn_norm, nullptr, scr, r, mk_lane()); continue; } r -= I_G;
        if (r < I_G) { p0_item<3>(F.w_up, D, FF, F.Wgu_t, F.ffn_norm, nullptr, scr, r, mk_lane()); continue; } r -= I_G;
        p0_item<4>(F.w_down, FF, D, F.Wd_t, nullptr, nullptr, scr, r, mk_lane());
    }
    for (int e = (F.vcu * NWAVES * 64) + F.wave * 64 + mk_lane(); e < SEQ * 32; e += F.G * NWAVES * 64) {
        const int s = e >> 5, j = e & 31;
        const float invf = __builtin_amdgcn_exp2f(-(float)j * (13.287712379549449f / 32.0f));
        double rev = (double)s * (double)invf * 0.15915494309189535; rev -= __builtin_floor(rev);
        const float r = (float)rev;
        pg8::f32x2 cs; cs.x = __builtin_amdgcn_cosf(r); cs.y = __builtin_amdgcn_sinf(r);
        *(GAS pg8::f32x2*)((pg8::f32x2*)F.rope + e) = cs;
    }
    for (int m = 4 * gw; m < M; m += 4 * NGW) rms_rows_to_bf16<4>(F, F.x + (size_t)m * D, F.attn_norm, F.XN + (size_t)m * D, F.XN8 + (size_t)m * D, (float*)(F.kpart + 131072) + m);
}

__device__ __forceinline__ void p6_final(Frame& F) {
    const int gw = F.vcu * NWAVES + F.wave, NGW = F.G * NWAVES;
    const GAS f32x4* gr = (const GAS f32x4*)F.final_norm + mk_lane();
    for (int m = gw; m < M; m += NGW) {
        GAS f32x4* xr = (GAS f32x4*)(F.out + (size_t)m * D) + mk_lane();
        const GAS f32x4* sp = (const GAS f32x4*)(F.ssq2 + (size_t)m * 16);
        const f32x4 a = sp[0], b = sp[1], c = sp[2], d = sp[3];
        const float ss = ((a.x + a.y) + (a.z + a.w)) + ((b.x + b.y) + (b.z + b.w)) + ((c.x + c.y) + (c.z + c.w)) + ((d.x + d.y) + (d.z + d.w));
        const float rstd = 1.f / sqrtf(ss * (1.f / D) + RMS_EPS);
#pragma unroll
        for (int j = 0; j < 4; ++j) { const f32x4 v = xr[64 * j], g = gr[64 * j]; xr[64 * j] = v * rstd * g; }
    }
}

struct Args { const float* in[11]; float* out; unsigned char* ws; int ph_lo, ph_hi, li, pad; };
__global__ void __launch_bounds__(NWAVES * 64, 2) mk_fwd(Args args) {
    extern __shared__ __attribute__((aligned(16))) unsigned char lds[];
    Frame F;
    F.lds = (LAS unsigned char*)lds;
    F.MISC = (volatile LAS unsigned*)(F.lds + MISC_OFF);
    F.wave = __builtin_amdgcn_readfirstlane((int)(threadIdx.x >> 6));
    F.G = gridDim.x; { const int bx = blockIdx.x; F.vcu = (F.G % 8 == 0) ? (bx % 8) * (F.G / 8) + bx / 8 : bx; }
#define GRID_BAR(seam) do { if (N_LAUNCHES == PER_PHASE) { if ((F.wave == 0 && mk_lane() == 0)) __hip_atomic_store(F.ctl + CW_TMO, 0xBADBA0u | (unsigned)(seam), RLX_AGENT); } \
    else { xcd_barrier(bar, F.wave); if (MK_REPEAT_PHASE == 30) xcd_barrier(bar, F.wave); } } while (0)
    unsigned char* ws = args.ws;
    F.ctl = (gu32*)(ws + WS_CTL);
    F.x = args.in[0]; F.attn_norm = args.in[1]; F.w_in = args.in[2]; F.moba_norm = args.in[3]; F.dil_norm = args.in[4]; F.w_out = args.in[5];
    F.ffn_norm = args.in[6]; F.w_gate = args.in[7]; F.w_up = args.in[8]; F.w_down = args.in[9]; F.final_norm = args.in[10]; F.out = args.out;
    F.Wqkv_t = (bf16*)(ws + WS_WQKV); F.Wo_t = (bf16*)(ws + WS_WO); F.Wgu_t = (bf16*)(ws + WS_WGU); F.Wd_t = (bf16*)(ws + WS_WD);
    F.QO = (bf16*)(ws + WS_QO); F.KB = (bf16*)(ws + WS_K); F.VB = (bf16*)(ws + WS_V); F.HB = ws + WS_H; F.XN8 = ws + WS_XN8; F.XN = (bf16*)(ws + WS_XN); F.OB = (bf16*)(ws + WS_O);
    F.rope = (float*)(ws + WS_ROPE); F.kpart = (float*)(ws + WS_KPART); F.ssqa = (float*)(ws + WS_SSQA); F.ssq1 = (float*)(ws + WS_SSQ1); F.ssq2 = (float*)(ws + WS_SSQ2);
    for (int u = F.wave * 64 + mk_lane(); u < (LDS_BYTES - LDSCTL_OFF) / 4; u += NWAVES * 64) ((LAS unsigned*)(F.lds + LDSCTL_OFF))[u] = 0u;
    __syncthreads();
    XcdBarrier bar; bar.bar = (unsigned*)(F.ctl + CW_BAR); bar.x = 0; bar.st = nullptr;
    if (N_LAUNCHES != PER_PHASE) bar = xcd_barrier_post((unsigned*)(F.ctl + CW_BAR), F.MISC + 8, F.wave);
    const int lo = args.ph_lo, hi = args.ph_hi;
#define IN(k) (lo <= (k) && (k) < hi)
#define BOTH(k) (IN(k) && IN((k) + 1))

    if (IN(0)) { for (int rp = 0; rp < (MK_REPEAT_PHASE == 0 ? 2 : 1); ++rp) p0_prologue(F); if (BOTH(0)) GRID_BAR(0); }

    if (IN(1)) {
        { pg8::Gemm g{F.XN, F.Wqkv_t, M, 1024, D}; pg8::StaticOrder S; S.init(M, 1024, F.G, (int)blockIdx.x, MK_REPEAT_PHASE == 1 ? 2 : 1);
          pg8::EpiQKV E{F.QO, (size_t)(WS_K - WS_QO) / 2, F.rope, F.kpart, QSCALE, 1, 1.f};
          pg8::gemm_phase<pg8::EpiQKV, pg8::StaticOrder, true, true>(F.lds + RING_OFF, g, S, E, F.wave); }
        { pg8::Gemm g{(const bf16*)F.XN8, (const bf16*)((const unsigned char*)F.Wqkv_t + QKV8_OFF), M, 2048, D}; pg8::StaticOrder S; S.init(M, 2048, F.G, (int)blockIdx.x, MK_REPEAT_PHASE == 1 ? 2 : 1);
          pg8::EpiQKV E{F.QO, (size_t)(WS_K - WS_QO) / 2, F.rope, F.kpart, QSCALE, 2, 1.f / (pg8::F8_SA * pg8::F8_SW)};
          pg8::gemm_phase<pg8::EpiQKV, pg8::StaticOrder, true, true, true>(F.lds + RING_OFF, g, S, E, F.wave); }
        if (BOTH(1)) GRID_BAR(1);
    }

    if (IN(2)) {
        if (F.G == 256) {
            for (int rp = 0; rp < (MK_REPEAT_PHASE == 2 ? 2 : 1); ++rp) attn_body::attn_phase<8>((char*)lds + RING_OFF, ws, (unsigned*)(F.ctl + CW_FAR), F.vcu, F.G, F.wave);
        }
        if (BOTH(2)) GRID_BAR(2);
    }

    if (IN(3)) {
        pg8::Gemm g{(const bf16*)(ws + WS_O8), F.Wo_t, M, D, D};   pg8::StaticOrder S; S.init(M, D, F.G, (int)blockIdx.x, MK_REPEAT_PHASE == 3 ? 2 : 1);
        pg8::EpiWo E{F.kpart + 131072, F.attn_norm, F.XN, (MK_REPEAT_PHASE == 3) ? (bf16*)(ws + 394 * MiB) : F.XN, (MK_REPEAT_PHASE == 3) ? ws + 458 * MiB : F.XN8, F.ssqa, F.ssq1};
        pg8::gemm_phase<pg8::EpiWo, pg8::StaticOrder, true, true, true>(F.lds + RING_OFF, g, S, E, F.wave);
        if (BOTH(3)) GRID_BAR(3);
    }

    if (IN(4)) {
        pg8::Gemm g{(const bf16*)((MK_REPEAT_PHASE == 3) ? ws + 458 * MiB : F.XN8), F.Wgu_t, M, NGU, D}; pg8::StaticOrder S; S.init(M, NGU, F.G, (int)blockIdx.x, MK_REPEAT_PHASE == 4 ? 2 : 1);
        pg8::EpiGU E{F.ssq1, F.HB};
        if (MK_REPEAT_PHASE == 40) { S.r1 = 6; pg8::gemm_phase<pg8::EpiGU, pg8::StaticOrder, true, true, true>(F.lds + RING_OFF, g, S, E, F.wave); GRID_BAR(9); S.r0 = 6; S.r1 = 1 << 30; }
        pg8::gemm_phase<pg8::EpiGU, pg8::StaticOrder, true, true, true>(F.lds + RING_OFF, g, S, E, F.wave);
        if (BOTH(4)) GRID_BAR(4);
    }

    if (IN(5)) {
        pg8::Gemm g{(const bf16*)F.HB, F.Wd_t, M, D, FF};   pg8::StaticOrder S; S.init(M, D, F.G, (int)blockIdx.x, MK_REPEAT_PHASE == 5 ? 2 : 1);
#if defined(MK_SPLIT_FINAL)
        pg8::EpiDown E{F.XN, F.out, F.ssq2};
        pg8::gemm_phase<pg8::EpiDown, pg8::StaticOrder, true, true, true>(F.lds + RING_OFF, g, S, E, F.wave);
        if (BOTH(5)) GRID_BAR(5);
#else
        if (F.G == 256) { pg8::EpiDownNorm E{(MK_REPEAT_PHASE == 3) ? (bf16*)(ws + 394 * MiB) : F.XN, F.out, F.ssq2, (unsigned*)(F.ctl + CW_PANEL), F.final_norm};
            pg8::gemm_phase<pg8::EpiDownNorm, pg8::StaticOrder, true, true, true>(F.lds + RING_OFF, g, S, E, F.wave); }
        else { pg8::EpiDown E{F.XN, F.out, F.ssq2}; pg8::gemm_phase<pg8::EpiDown, pg8::StaticOrder, true, true, true>(F.lds + RING_OFF, g, S, E, F.wave); GRID_BAR(5); p6_final(F); }
#endif
    }

#if defined(MK_SPLIT_FINAL)
    if (IN(6)) { p6_final(F); }
#endif
#undef IN
#undef BOTH
}

extern "C" void kernel_launch(void* const* d_in, const int* in_sizes, int n_in, void* d_out, int out_size, void* d_ws, size_t ws_size, hipStream_t stream) {
    static int grid = 0;
    if (grid == 0) {
        if (n_in != 11 || in_sizes[0] != M * D || out_size != M * D || ws_size < WS_END) { fprintf(stderr, "kernel_launch: unexpected shapes (n_in %d, in0 %d, out %d, ws %zu); nothing launched\n", n_in, n_in > 0 ? in_sizes[0] : -1, out_size, ws_size); grid = -1; return; }
        int dev = 0, cus = 0, per_cu = 0;
        if (hipGetDevice(&dev) != hipSuccess || hipDeviceGetAttribute(&cus, hipDeviceAttributeMultiprocessorCount, dev) != hipSuccess) { grid = -1; return; }
        if (hipFuncSetAttribute((const void*)mk_fwd, hipFuncAttributeMaxDynamicSharedMemorySize, LDS_BYTES) != hipSuccess) { fprintf(stderr, "kernel_launch: hipFuncSetAttribute failed\n"); grid = -1; return; }
        if (hipOccupancyMaxActiveBlocksPerMultiprocessor(&per_cu, (const void*)mk_fwd, NWAVES * 64, LDS_BYTES) != hipSuccess || per_cu < 1) { fprintf(stderr, "kernel_launch: occupancy query says %d blocks per CU\n", per_cu); (void)hipGetLastError(); per_cu = 1; }
        grid = cus;
        if (grid > 256) grid = 256;
    }
    if (grid < 0) return;
    if (hipMemsetAsync((char*)d_ws + WS_CTL, 0, CTL_ZERO_BYTES, stream) != hipSuccess) { fprintf(stderr, "kernel_launch: hipMemsetAsync failed\n"); return; }
    Args a{};
    for (int i = 0; i < 11; ++i) a.in[i] = (const float*)d_in[i];
    a.out = (float*)d_out; a.ws = (unsigned char*)d_ws;
    for (int li = 0; li < N_LAUNCHES; ++li) {
        a.ph_lo = (N_LAUNCHES == PER_PHASE) ? li : 0; a.ph_hi = (N_LAUNCHES == PER_PHASE) ? li + 1 : PER_PHASE; a.li = li;
        hipLaunchKernelGGL(mk_fwd, dim3(grid), dim3(NWAVES * 64), LDS_BYTES, stream, a);
        const hipError_t le = hipPeekAtLastError();
        if (le != hipSuccess) { fprintf(stderr, "kernel_launch: launch %d failed: %s\n", li, hipGetErrorName(le)); break; }
    }
}
```

```cpp
#include <hip/hip_runtime.h>
#include <cstdio>
#include <cstdint>
namespace pg8 {
#define PG8_LAS __attribute__((address_space(3)))
typedef unsigned short bf16_t;
typedef short bf16x8 __attribute__((ext_vector_type(8)));
typedef float f32x4 __attribute__((ext_vector_type(4)));
typedef unsigned u32x4 __attribute__((ext_vector_type(4)));
typedef int i32x4 __attribute__((ext_vector_type(4)));
typedef int i32x8 __attribute__((ext_vector_type(8)));
typedef unsigned u32x2 __attribute__((ext_vector_type(2)));
constexpr int BM = 256, BK = 64, HALF = 128, HTB = HALF * BK * 2  , STAGE_BYTES = 8 * HTB, NXCD = 8, WGM = 8;

__host__ __device__ __forceinline__ int lds_byte(int r, int c) { const int st = (r >> 4) * 2 + (c >> 5), rr = r & 15, cc = c & 31, ob = rr * 64 + cc * 2; return st * 1024 + (ob ^ (((ob >> 9) & 1) << 5)); }
__host__ __device__ __forceinline__ void stage_rc(int b, int& R, int& C) { const int st = b / 1024, sb = b % 1024, swz = sb ^ (((sb >> 9) & 1) << 5); R = (st >> 1) * 16 + swz / 64; C = (st & 1) * 32 + (swz % 64) / 2; }
__host__ __device__ __forceinline__ int perm32(int rho) { const int n = rho >> 4, i = rho & 15; return 8 * (i >> 2) + 4 * n + (i & 3); }

struct Unit { int pm, pn; };
struct Gemm { const bf16_t* A; const bf16_t* Bt; int M, N, K; };

struct StaticOrder {
    int nM, nN, nwg, G, c, reps, r0 = 0, r1 = 1 << 30;
    __host__ __device__ void init(int M, int N, int G_, int c_, int reps_ = 1) { nM = M / BM; nN = N / BM; nwg = nM * nN; G = G_; c = c_; reps = reps_; }
    __host__ __device__ bool next(int i, Unit& u) const {
        const int rounds = (nwg + G - 1) / G; i += r0; if (i >= reps * rounds || i >= r1) return false;
        const long L = (long)(i % rounds) * G + c; if (L >= nwg) return false;
        int wgid = (int)L; { const int q = nwg / NXCD, r = nwg % NXCD, xcd = wgid % NXCD, off = wgid / NXCD; wgid = (xcd < r ? xcd * (q + 1) : r * (q + 1) + (xcd - r) * q) + off; }
        const int nig = WGM * nN, gid = wgid / nig, fm = gid * WGM, gsz = (nM - fm) < WGM ? (nM - fm) : WGM;
        u.pm = fm + ((wgid % nig) % gsz); u.pn = (wgid % nig) / gsz; return true;
    }
    __device__ __forceinline__ void a_ready(const Unit&) const {}
    __device__ __forceinline__ void done(const Unit&) const {}
};


__device__ __forceinline__ unsigned cvt_pk_bf16(float lo, float hi) { unsigned r; asm volatile("v_cvt_pk_bf16_f32 %0, %1, %2" : "=v"(r) : "v"(lo), "v"(hi)); return r; }
__device__ __forceinline__ u32x4 pack8(const f32x4 a, const f32x4 b) { u32x4 w; w.x = cvt_pk_bf16(a[0], a[1]); w.y = cvt_pk_bf16(a[2], a[3]); w.z = cvt_pk_bf16(b[0], b[1]); w.w = cvt_pk_bf16(b[2], b[3]); return w; }
__device__ __forceinline__ float sum4(const f32x4 a) { return (a[0] + a[1]) + (a[2] + a[3]); }
__device__ __forceinline__ float sq4(const f32x4 a) { return (a[0] * a[0] + a[1] * a[1]) + (a[2] * a[2] + a[3] * a[3]); }
constexpr float RMS_EPS_F = 1e-6f;
__device__ __forceinline__ int lane_id() { int l; asm volatile("v_mbcnt_lo_u32_b32 %0, -1, 0\n\tv_mbcnt_hi_u32_b32 %0, -1, %0" : "=v"(l)); return l; }
__device__ __forceinline__ u32x2 pack8_fp8(const f32x4 a, const f32x4 b) { u32x2 w; unsigned t = 0;
    t = __builtin_amdgcn_cvt_pk_fp8_f32(a[0], a[1], t, false); t = __builtin_amdgcn_cvt_pk_fp8_f32(a[2], a[3], t, true); w.x = t; t = 0;
    t = __builtin_amdgcn_cvt_pk_fp8_f32(b[0], b[1], t, false); t = __builtin_amdgcn_cvt_pk_fp8_f32(b[2], b[3], t, true); w.y = t; return w; }
constexpr float F8_SA = 16.f, F8_SH = 8.f, F8_SW = 512.f, F8_SO = 64.f;
typedef float f32x2 __attribute__((ext_vector_type(2)));

struct EpiQKV {
    static constexpr bool PERM = true, AFTER_DRAIN = false, HAS_MID = false;
    bf16_t* Q; size_t part_stride; const float* rope; float* kpart; float qscale; int mapsel; float ascale;
    __device__ __forceinline__ void operator()(const f32x4 (&acc)[2][2][4][2], const Unit& u, int wr, int wc, int fr_, int fq_) const {
        const int ln_ = lane_id(), fr = ln_ & 15, fq = ln_ >> 4;
        const int rp = mapsel == 1 ? ((u.pn & 1) + 4 * (u.pn >> 1)) : (mapsel == 2 ? (u.pn < 4 ? (2 + (u.pn & 1) + 4 * (u.pn >> 1)) : u.pn + 4) : u.pn);
        const int part = rp >> 2, head = (rp & 3) * 4 + wc;
        bf16_t* base = Q + (size_t)part * part_stride + head * 64 + 8 * fq;
        const float sc = part == 0 ? qscale : 1.f;
        const bool rot = part != 2, km = (part == 1) && (head < 8);
        const int row0 = u.pm * BM + wr * 64 + fr;
        int rbase = row0; asm volatile("" : "+v"(rbase));
        f32x4 ks[2][2];
#pragma unroll
        for (int a = 0; a < 2; ++a)
#pragma unroll
            for (int b = 0; b < 2; ++b) ks[a][b] = (f32x4){0.f, 0.f, 0.f, 0.f};
#pragma unroll
        for (int ai = 0; ai < 2; ++ai)
#pragma unroll
            for (int m = 0; m < 4; ++m) {
                const int row = rbase + ai * HALF + m * 16;
                const int s = row & 4095;
                const f32x4* rp = (const f32x4*)(rope + ((size_t)s * 32 + 8 * fq) * 2);
                f32x4 t0, t1, t2, t3;
                if (rot) { t0 = rp[0]; t1 = rp[1]; t2 = rp[2]; t3 = rp[3]; } else { t0 = t1 = t2 = t3 = (f32x4){1.f, 0.f, 1.f, 0.f}; }
                f32x4 o1[2], o2[2];
#pragma unroll
                for (int n = 0; n < 2; ++n) {
                    const f32x4 cv = n == 0 ? (f32x4){t0[0], t0[2], t1[0], t1[2]} : (f32x4){t2[0], t2[2], t3[0], t3[2]};
                    const f32x4 sv = n == 0 ? (f32x4){t0[1], t0[3], t1[1], t1[3]} : (f32x4){t2[1], t2[3], t3[1], t3[3]};
                    const f32x4 x1 = acc[ai][0][m][n] * ascale, x2 = acc[ai][1][m][n] * ascale;
                    o1[n] = x1 * cv - x2 * sv; o2[n] = x2 * cv + x1 * sv;
                    if (km) { ks[0][n] += o1[n]; ks[1][n] += o2[n]; }
                    o1[n] = o1[n] * sc; o2[n] = o2[n] * sc;
                }
                bf16_t* rowp = base + (size_t)row * 1024;
                *(u32x4*)(rowp) = pack8(o1[0], o1[1]); *(u32x4*)(rowp + 32) = pack8(o2[0], o2[1]);
            }
        if (km) {
#pragma unroll
            for (int bj = 0; bj < 2; ++bj)
#pragma unroll
                for (int n = 0; n < 2; ++n) { f32x4 v = ks[bj][n];
#pragma unroll
                    for (int o = 1; o < 16; o <<= 1) { v[0] += __shfl_xor(v[0], o); v[1] += __shfl_xor(v[1], o); v[2] += __shfl_xor(v[2], o); v[3] += __shfl_xor(v[3], o); }
                    if (fr == 0) *(f32x4*)(kpart + (size_t)(u.pm * 2 + wr) * 512 + head * 64 + 32 * bj + 8 * fq + 4 * n) = v; }
        }
    }
};

struct EpiWo {
    static constexpr bool PERM = true, AFTER_DRAIN = false, HAS_MID = true;
    const float* rn0; const float* gain0; bf16_t* xn; bf16_t* xo; unsigned char* xn8;
    const float* ssq_att; float* ssq1;
    __device__ __forceinline__ void rstds(int row, int fq, float& rm, float& rd) const {
        const float s = sum4(*(const f32x4*)(ssq_att + (size_t)row * 16 + 4 * fq));
        const float t = s + __shfl_xor(s, 16), o = __shfl_xor(t, 32);
        rm = __builtin_amdgcn_rsqf((fq < 2 ? t : o) * (1.f / 512.f) + RMS_EPS_F);
        rd = __builtin_amdgcn_rsqf((fq < 2 ? o : t) * (1.f / 512.f) + RMS_EPS_F);
    }
    static constexpr float ASCALE = 1.f / (F8_SO * F8_SW);
    __device__ __forceinline__ void mid(f32x4 (&acc)[2][2][4][2], const Unit& u, int wr, int fr_) const {
        const int ln_ = lane_id(), fr = ln_ & 15, fq = ln_ >> 4;
        const int row0 = u.pm * BM + wr * 64 + fr;
        int rbase = row0; asm volatile("" : "+v"(rbase));
        float f[8];
#pragma unroll
        for (int i = 0; i < 8; ++i) { float rm, rd; rstds(rbase + (i >> 2) * HALF + (i & 3) * 16, fq, rm, rd); f[i] = rm / rd; }
#pragma unroll
        for (int ai = 0; ai < 2; ++ai)
#pragma unroll
            for (int m = 0; m < 4; ++m)
#pragma unroll
                for (int bj = 0; bj < 2; ++bj)
#pragma unroll
                    for (int n = 0; n < 2; ++n) acc[ai][bj][m][n] = acc[ai][bj][m][n] * f[ai * 4 + m];
    }
    __device__ __forceinline__ void operator()(const f32x4 (&acc)[2][2][4][2], const Unit& u, int wr, int wc, int fr_, int fq_) const {
        const int ln_ = lane_id(), fr = ln_ & 15, fq = ln_ >> 4;
        const int row0 = u.pm * BM + wr * 64 + fr, col0 = u.pn * BM + wc * 32 + 8 * fq;
        int rbase = row0; asm volatile("" : "+v"(rbase));
        f32x4 ig[2][2];
#pragma unroll
        for (int bj = 0; bj < 2; ++bj)
#pragma unroll
            for (int n = 0; n < 2; ++n) { const f32x4 g = *(const f32x4*)(gain0 + col0 + bj * HALF + 4 * n);
                ig[bj][n] = (f32x4){__builtin_amdgcn_rcpf(g[0]), __builtin_amdgcn_rcpf(g[1]), __builtin_amdgcn_rcpf(g[2]), __builtin_amdgcn_rcpf(g[3])}; }
#pragma unroll
        for (int ai = 0; ai < 2; ++ai)
#pragma unroll
            for (int m = 0; m < 4; ++m) { const int row = rbase + ai * HALF + m * 16; float rm, rd; rstds(row, fq, rm, rd); float s = 0.f; const float rn = rn0[row];
#pragma unroll
                for (int bj = 0; bj < 2; ++bj) { unsigned off = (unsigned)row * 1024u + col0 + bj * HALF; asm volatile("" : "+v"(off));
                    const u32x4 xw = *(const u32x4*)(xn + off);
                    const f32x4 xa = (f32x4){__uint_as_float(xw.x << 16), __uint_as_float(xw.x & 0xffff0000u), __uint_as_float(xw.y << 16), __uint_as_float(xw.y & 0xffff0000u)} * ig[bj][0] * rn;
                    const f32x4 xb = (f32x4){__uint_as_float(xw.z << 16), __uint_as_float(xw.z & 0xffff0000u), __uint_as_float(xw.w << 16), __uint_as_float(xw.w & 0xffff0000u)} * ig[bj][1] * rn;
                    const f32x4 v0 = xa + acc[ai][bj][m][0] * (rd * ASCALE), v1 = xb + acc[ai][bj][m][1] * (rd * ASCALE);
                    *(u32x4*)(xo + off) = pack8(v0, v1); *(u32x2*)(xn8 + off) = pack8_fp8(v0 * F8_SA, v1 * F8_SA); s += sq4(v0) + sq4(v1); }
                s += __shfl_xor(s, 16); s += __shfl_xor(s, 32);
                if (fq == 0) ssq1[(size_t)row * 16 + u.pn * 4 + wc] = s;
                asm volatile("" ::: "memory"); }
    }
};

struct EpiGU {
    static constexpr bool PERM = true, AFTER_DRAIN = false, HAS_MID = false;
    const float* ssq1; unsigned char* H;
    __device__ __forceinline__ void operator()(const f32x4 (&acc)[2][2][4][2], const Unit& u, int wr, int wc, int fr_, int fq_) const {
        const int ln_ = lane_id(), fr = ln_ & 15, fq = ln_ >> 4;
        const int row0 = u.pm * BM + wr * 64 + fr, col0 = u.pn * HALF + wc * 32 + 8 * fq;
        int rbase = row0; asm volatile("" : "+v"(rbase));
#pragma unroll
        for (int ai = 0; ai < 2; ++ai)
#pragma unroll
            for (int m = 0; m < 4; ++m) { const int row = rbase + ai * HALF + m * 16;
                float ss = sum4(*(const f32x4*)(ssq1 + (size_t)row * 16 + 4 * fq));
                ss += __shfl_xor(ss, 16); ss += __shfl_xor(ss, 32);
                const float rstd = __builtin_amdgcn_rsqf(ss * (1.f / 1024.f) + RMS_EPS_F) * (1.f / (F8_SA * F8_SW));
                f32x4 h[2];
                const float rs_e = rstd * -1.4426950408889634f, rs_u = rstd * (rstd * F8_SH);
#pragma unroll
                for (int n = 0; n < 2; ++n) { const f32x4 ea = acc[ai][0][m][n] * rs_e, gu = (acc[ai][0][m][n] * acc[ai][1][m][n]) * rs_u;
#pragma unroll
                    for (int i = 0; i < 4; ++i) h[n][i] = gu[i] * __builtin_amdgcn_rcpf(1.f + __builtin_amdgcn_exp2f(ea[i])); }
                *(u32x2*)(H + (size_t)row * 2816 + col0) = pack8_fp8(h[0], h[1]); }
    }
};

struct EpiDown {
    static constexpr bool PERM = true, AFTER_DRAIN = false, HAS_MID = false;
    const bf16_t* xn; float* out; float* ssq2;
    __device__ __forceinline__ void operator()(const f32x4 (&acc)[2][2][4][2], const Unit& u, int wr, int wc, int fr_, int fq_) const {
        const int ln_ = lane_id(), fr = ln_ & 15, fq = ln_ >> 4;
        const int row0 = u.pm * BM + wr * 64 + fr, col0 = u.pn * BM + wc * 32 + 8 * fq;
        int rbase = row0; asm volatile("" : "+v"(rbase));
#pragma unroll
        for (int ai = 0; ai < 2; ++ai)
#pragma unroll
            for (int m = 0; m < 4; ++m) { const int row = rbase + ai * HALF + m * 16; float s = 0.f;
#pragma unroll
                for (int bj = 0; bj < 2; ++bj) { const size_t off = (size_t)row * 1024 + col0 + bj * HALF;
                    const u32x4 xw = *(const u32x4*)(xn + off);
                    const f32x4 xa = {__uint_as_float(xw.x << 16), __uint_as_float(xw.x & 0xffff0000u), __uint_as_float(xw.y << 16), __uint_as_float(xw.y & 0xffff0000u)};
                    const f32x4 xb = {__uint_as_float(xw.z << 16), __uint_as_float(xw.z & 0xffff0000u), __uint_as_float(xw.w << 16), __uint_as_float(xw.w & 0xffff0000u)};
                    const f32x4 v0 = xa + acc[ai][bj][m][0] * (1.f / (F8_SH * F8_SW)), v1 = xb + acc[ai][bj][m][1] * (1.f / (F8_SH * F8_SW));
                    *(f32x4*)(out + off) = v0; *(f32x4*)(out + off + 4) = v1; s += sq4(v0) + sq4(v1); }
                s += __shfl_xor(s, 16); s += __shfl_xor(s, 32);
                if (fq == 0) ssq2[(size_t)row * 16 + u.pn * 4 + wc] = s;
                asm volatile("" ::: "memory"); }
    }
};

struct EpiDownNorm {
    static constexpr bool PERM = true, AFTER_DRAIN = false, HAS_MID = false;
    const bf16_t* xn; float* out; float* ssq2; unsigned* cnt; const float* gain;
    __device__ __forceinline__ void operator()(f32x4 (&acc)[2][2][4][2], const Unit& u, int wr, int wc, int fr_, int fq_) const {
        const int ln_ = lane_id(), fr = ln_ & 15, fq = ln_ >> 4;
        const int row0 = u.pm * BM + wr * 64 + fr, col0 = u.pn * BM + wc * 32 + 8 * fq;
        int rbase = row0; asm volatile("" : "+v"(rbase));
#pragma unroll
        for (int ai = 0; ai < 2; ++ai)
#pragma unroll
            for (int m = 0; m < 4; ++m) { const int row = rbase + ai * HALF + m * 16; float s = 0.f;
#pragma unroll
                for (int bj = 0; bj < 2; ++bj) { const size_t off = (size_t)row * 1024 + col0 + bj * HALF;
                    const u32x4 xw = *(const u32x4*)(xn + off);
                    const f32x4 xa = {__uint_as_float(xw.x << 16), __uint_as_float(xw.x & 0xffff0000u), __uint_as_float(xw.y << 16), __uint_as_float(xw.y & 0xffff0000u)};
                    const f32x4 xb = {__uint_as_float(xw.z << 16), __uint_as_float(xw.z & 0xffff0000u), __uint_as_float(xw.w << 16), __uint_as_float(xw.w & 0xffff0000u)};
                    acc[ai][bj][m][0] = acc[ai][bj][m][0] * (1.f / (F8_SH * F8_SW)) + xa; acc[ai][bj][m][1] = acc[ai][bj][m][1] * (1.f / (F8_SH * F8_SW)) + xb; s += sq4(acc[ai][bj][m][0]) + sq4(acc[ai][bj][m][1]); }
                s += __shfl_xor(s, 16); s += __shfl_xor(s, 32);
                if (fq == 0) __hip_atomic_store(ssq2 + (size_t)(u.pn * 4 + wc) * 32768 + row, s, __ATOMIC_RELAXED, __HIP_MEMORY_SCOPE_AGENT);
                asm volatile("" ::: "memory"); }
        asm volatile("s_waitcnt vmcnt(0)" ::: "memory");
        unsigned* cw = cnt + 64 * u.pm;
        if (fr == 0 && fq == 0) __hip_atomic_fetch_add(cw, 1u, __ATOMIC_RELAXED, __HIP_MEMORY_SCOPE_AGENT);
        { unsigned sp = 0; while ((unsigned)__builtin_amdgcn_readfirstlane((int)__hip_atomic_load(cw, __ATOMIC_RELAXED, __HIP_MEMORY_SCOPE_AGENT)) < 32u) { __builtin_amdgcn_s_sleep(1); if (++sp > (1u << 22)) break; } }
        f32x4 g[2][2];
#pragma unroll
        for (int bj = 0; bj < 2; ++bj) { g[bj][0] = *(const f32x4*)(gain + col0 + bj * HALF); g[bj][1] = *(const f32x4*)(gain + col0 + bj * HALF + 4); }
#pragma unroll
        for (int ai = 0; ai < 2; ++ai)
#pragma unroll
            for (int m = 0; m < 4; ++m) { const int row = rbase + ai * HALF + m * 16;
                const float* pp = ssq2 + (size_t)(4 * fq) * 32768 + row;
                float s = (__hip_atomic_load(pp, __ATOMIC_RELAXED, __HIP_MEMORY_SCOPE_AGENT) + __hip_atomic_load(pp + 32768, __ATOMIC_RELAXED, __HIP_MEMORY_SCOPE_AGENT))
                        + (__hip_atomic_load(pp + 2 * 32768, __ATOMIC_RELAXED, __HIP_MEMORY_SCOPE_AGENT) + __hip_atomic_load(pp + 3 * 32768, __ATOMIC_RELAXED, __HIP_MEMORY_SCOPE_AGENT));
                s += __shfl_xor(s, 16); s += __shfl_xor(s, 32);
                const float rstd = __builtin_amdgcn_rsqf(s * (1.f / 1024.f) + RMS_EPS_F);
#pragma unroll
                for (int bj = 0; bj < 2; ++bj) { const size_t off = (size_t)row * 1024 + col0 + bj * HALF;
                    *(f32x4*)(out + off) = acc[ai][bj][m][0] * rstd * g[bj][0]; *(f32x4*)(out + off + 4) = acc[ai][bj][m][1] * rstd * g[bj][1]; }
                asm volatile("" ::: "memory"); }
    }
};
template <class Epi, class Sched, bool ALIGN_EPI = false, bool SP2 = false, bool F8 = false>
__device__ __forceinline__ void gemm_phase(PG8_LAS unsigned char* lds, const Gemm g, const Sched& S, const Epi& E, int wave) {
    const int wid = __builtin_amdgcn_readfirstlane(wave), lane = lane_id(), tid = wid * 64 + lane, wr = wid >> 2, wc = wid & 3, fr = lane & 15, fq = lane >> 4;
    const int K = F8 ? g.K / 2 : g.K, nt = K / BK;
    unsigned voffA[2], voffB[2];
#pragma unroll
    for (int i = 0; i < 2; ++i) { int R, C; stage_rc(tid * 16 + i * 8192, R, C); const int Rb = Epi::PERM ? ((R & ~31) + perm32(R & 31)) : R;
        voffA[i] = (unsigned)(R * K + C) * 2u; voffB[i] = (unsigned)(Rb * K + C) * 2u; }
    const unsigned kstep = (unsigned)(BK * 2);
    const unsigned hstep = (unsigned)HALF * K * 2;
    const unsigned tstep = 2 * hstep;
    const unsigned ldsw = (unsigned)wid * 1024u;
    const int aoff = lds_byte(wr * 64 + fr, fq * 8), boff = lds_byte(wc * 32 + fr, fq * 8);
#define PG8_SA(b, h) (((b) * 2 + (h)) * HTB)
#define PG8_SB(b, h) ((4 + (b) * 2 + (h)) * HTB)
    const __amdgpu_buffer_rsrc_t rsA = __builtin_amdgcn_make_buffer_rsrc((void*)g.A, 0, 0x7fffffff, 0x00020000), rsB = __builtin_amdgcn_make_buffer_rsrc((void*)g.Bt, 0, 0x7fffffff, 0x00020000);
#define PG8_STAGE(bufoff, gbase, voff) do { _Pragma("unroll") for (int _i = 0; _i < 2; ++_i) \
        __builtin_amdgcn_raw_ptr_buffer_load_lds(PG8_RS_##voff, (PG8_LAS unsigned*)(lds + (bufoff) + ldsw + _i * 8192), 16, (voff)[_i], (int)(gbase), 0, 0); } while (0)
#define PG8_RS_voffA rsA
#define PG8_RS_voffB rsB
#define PG8_LD8(base, off) __builtin_shufflevector(*(const PG8_LAS i32x4*)((base) + (off)), *(const PG8_LAS i32x4*)((base) + (off) + 1024), 0, 1, 2, 3, 4, 5, 6, 7)
#define PG8_LDA(dst, b, h) do { if constexpr (F8) { _Pragma("unroll") for (int m = 0; m < 4; ++m) dst##8[m] = PG8_LD8(abase8, PG8_SA(b, h) + m * 2048); } else { \
        _Pragma("unroll") for (int m = 0; m < 4; ++m) _Pragma("unroll") for (int k = 0; k < 2; ++k) dst[m][k] = *(const PG8_LAS bf16x8*)(lds + PG8_SA(b, h) + aoff + m * 2048 + k * 1024); } } while (0)
#define PG8_LDB(dst, b, h) do { if constexpr (F8) { _Pragma("unroll") for (int n = 0; n < 2; ++n) dst##8[n] = PG8_LD8(bbase8, PG8_SB(b, h) - PG8_SB(0, 0) + n * 2048); } else { \
        _Pragma("unroll") for (int n = 0; n < 2; ++n) _Pragma("unroll") for (int k = 0; k < 2; ++k) dst[n][k] = *(const PG8_LAS bf16x8*)(lds + PG8_SB(b, h) + boff + n * 2048 + k * 1024); } } while (0)
#define PG8_MMA(ai, bj, At, Bt) do { __builtin_amdgcn_s_setprio(1); if constexpr (F8) { _Pragma("unroll") for (int m = 0; m < 4; ++m) _Pragma("unroll") for (int n = 0; n < 2; ++n) \
        acc[ai][bj][m][n] = __builtin_amdgcn_mfma_scale_f32_16x16x128_f8f6f4(Bt##8[n], At##8[m], acc[ai][bj][m][n], 0, 0, 0, 0, 0, 0); } else \
        _Pragma("unroll") for (int m = 0; m < 4; ++m) _Pragma("unroll") for (int n = 0; n < 2; ++n) _Pragma("unroll") for (int k = 0; k < 2; ++k) \
        acc[ai][bj][m][n] = __builtin_amdgcn_mfma_f32_16x16x32_bf16(Bt[n][k], At[m][k], acc[ai][bj][m][n], 0, 0, 0); __builtin_amdgcn_s_setprio(0); } while (0)
#define PG8_WAIT_V(n) asm volatile("s_waitcnt vmcnt(" #n ")" ::: "memory")
#define PG8_WAIT_L(n) asm volatile("s_waitcnt lgkmcnt(" #n ")" ::: "memory")
#define PG8_BAR __builtin_amdgcn_s_barrier()
#define PG8_SCHED __builtin_amdgcn_sched_barrier(0)
    Unit cur, nxt; int ui = 0;
    if (!S.next(0, cur)) return;
    f32x4 acc[2][2][4][2];
#pragma unroll
    for (int a = 0; a < 2; ++a)
#pragma unroll
        for (int b = 0; b < 2; ++b)
#pragma unroll
            for (int m = 0; m < 4; ++m)
#pragma unroll
                for (int n = 0; n < 2; ++n) acc[a][b][m][n] = (f32x4){0.f, 0.f, 0.f, 0.f};
    PG8_LAS unsigned char* abase8 = lds + aoff; PG8_LAS unsigned char* bbase8 = lds + PG8_SB(0, 0) + boff;
    if constexpr (F8) { asm volatile("" : "+v"(abase8)); asm volatile("" : "+v"(bbase8)); }
    bf16x8 At[4][2], B0[2][2], B1[2][2]; i32x8 At8[4], B08[2], B18[2];
    unsigned cA = (unsigned)cur.pm * tstep, cB = (unsigned)cur.pn * tstep;
    S.a_ready(cur);
    if constexpr (SP2) {
        PG8_STAGE(PG8_SB(0, 0), cB, voffB); PG8_STAGE(PG8_SB(0, 1), cB + hstep, voffB); PG8_STAGE(PG8_SA(0, 0), cA, voffA); PG8_STAGE(PG8_SA(0, 1), cA + hstep, voffA);
        if (wr == 1) PG8_BAR;
        PG8_WAIT_V(2); PG8_BAR;
        PG8_STAGE(PG8_SB(1, 0), cB + kstep, voffB); PG8_STAGE(PG8_SA(1, 0), cA + kstep, voffA); PG8_STAGE(PG8_SB(1, 1), cB + hstep + kstep, voffB);
        PG8_WAIT_V(6); PG8_BAR;
    } else {
        PG8_STAGE(PG8_SB(0, 0), cB, voffB); PG8_STAGE(PG8_SA(0, 0), cA, voffA); PG8_STAGE(PG8_SB(0, 1), cB + hstep, voffB); PG8_STAGE(PG8_SA(0, 1), cA + hstep, voffA);
        if (wr == 1) PG8_BAR;
        PG8_WAIT_V(4); PG8_BAR;
        PG8_STAGE(PG8_SB(1, 0), cB + kstep, voffB); PG8_STAGE(PG8_SA(1, 0), cA + kstep, voffA); PG8_STAGE(PG8_SB(1, 1), cB + hstep + kstep, voffB);
        PG8_WAIT_V(6); PG8_BAR;
    }
    for (;;) {
        const bool has_next = S.next(ui + 1, nxt);
        const unsigned nA = has_next ? (unsigned)nxt.pm * tstep : cA, nB = has_next ? (unsigned)nxt.pn * tstep : cB;
#pragma nounroll
        for (int t = 0; t < nt; t += 2) {
            if constexpr (Epi::HAS_MID) { if (t == (nt >> 1)) E.mid(acc, cur, wr, fr); }
            const bool last = (t == nt - 2);
            const unsigned a1 = cA + (unsigned)(t + 1) * kstep;
            const unsigned a2 = last ? nA : cA + (unsigned)(t + 2) * kstep, b2 = last ? nB : cB + (unsigned)(t + 2) * kstep;
            const unsigned a3 = a2 + kstep, b3 = b2 + kstep;
            if (last && has_next) S.a_ready(nxt);
            if constexpr (SP2) {
            PG8_LDB(B0, 0, 0); PG8_LDB(B1, 0, 1); PG8_SCHED; PG8_LDA(At, 0, 0); PG8_STAGE(PG8_SA(1, 1), a1 + hstep, voffA);
            PG8_WAIT_V(8); PG8_WAIT_L(0); PG8_BAR; PG8_MMA(0, 0, At, B0); PG8_MMA(0, 1, At, B1); PG8_BAR; PG8_SCHED;
            PG8_LDA(At, 0, 1); PG8_STAGE(PG8_SB(0, 0), b2, voffB); PG8_STAGE(PG8_SB(0, 1), b2 + hstep, voffB); PG8_STAGE(PG8_SA(0, 0), a2, voffA);
            PG8_WAIT_V(8); PG8_WAIT_L(0); PG8_BAR; PG8_MMA(1, 0, At, B0); PG8_MMA(1, 1, At, B1); PG8_BAR; PG8_SCHED;
            PG8_LDB(B0, 1, 0); PG8_LDB(B1, 1, 1); PG8_SCHED; PG8_LDA(At, 1, 0); PG8_STAGE(PG8_SA(0, 1), a2 + hstep, voffA);
            PG8_WAIT_V(8); PG8_WAIT_L(0); PG8_BAR; PG8_MMA(0, 0, At, B0); PG8_MMA(0, 1, At, B1); PG8_BAR; PG8_SCHED;
            PG8_LDA(At, 1, 1); PG8_STAGE(PG8_SB(1, 0), b3, voffB); PG8_STAGE(PG8_SB(1, 1), b3 + hstep, voffB); PG8_STAGE(PG8_SA(1, 0), a3, voffA);
            PG8_WAIT_V(8); PG8_WAIT_L(0); PG8_BAR; PG8_MMA(1, 0, At, B0); PG8_MMA(1, 1, At, B1); PG8_BAR; PG8_SCHED;
            } else {
            PG8_LDB(B0, 0, 0); PG8_SCHED; PG8_LDA(At, 0, 0); PG8_STAGE(PG8_SA(1, 1), a1 + hstep, voffA);
            PG8_WAIT_L(8); PG8_BAR; PG8_WAIT_L(0); PG8_MMA(0, 0, At, B0); PG8_BAR; PG8_SCHED;
            PG8_LDB(B1, 0, 1); PG8_STAGE(PG8_SB(0, 0), b2, voffB);
            PG8_BAR; PG8_WAIT_L(0); PG8_MMA(0, 1, At, B1); PG8_BAR;
            PG8_LDA(At, 0, 1); PG8_STAGE(PG8_SA(0, 0), a2, voffA);
            PG8_BAR; PG8_WAIT_L(0); PG8_MMA(1, 0, At, B0); PG8_BAR; PG8_SCHED;
            PG8_STAGE(PG8_SB(0, 1), b2 + hstep, voffB);
            PG8_WAIT_V(6); PG8_BAR; PG8_MMA(1, 1, At, B1); PG8_BAR;
            PG8_LDB(B0, 1, 0); PG8_SCHED; PG8_LDA(At, 1, 0); PG8_STAGE(PG8_SA(0, 1), a2 + hstep, voffA);
            PG8_WAIT_L(8); PG8_BAR; PG8_WAIT_L(0); PG8_MMA(0, 0, At, B0); PG8_BAR; PG8_SCHED;
            PG8_LDB(B1, 1, 1); PG8_STAGE(PG8_SB(1, 0), b3, voffB);
            PG8_BAR; PG8_WAIT_L(0); PG8_MMA(0, 1, At, B1); PG8_BAR;
            PG8_LDA(At, 1, 1); PG8_STAGE(PG8_SA(1, 0), a3, voffA);
            PG8_BAR; PG8_WAIT_L(0); PG8_MMA(1, 0, At, B0); PG8_BAR; PG8_SCHED;
            PG8_STAGE(PG8_SB(1, 1), b3 + hstep, voffB);
            PG8_WAIT_V(6); PG8_BAR; PG8_MMA(1, 1, At, B1); PG8_BAR;
            }
        }
        if constexpr (ALIGN_EPI) { if (wr == 0) PG8_BAR; }
        if constexpr (!Epi::AFTER_DRAIN) { E(acc, cur, wr, wc, fr, fq); S.done(cur); }
        if (!has_next) break;
#pragma unroll
        for (int a = 0; a < 2; ++a)
#pragma unroll
            for (int b = 0; b < 2; ++b)
#pragma unroll
                for (int m = 0; m < 4; ++m)
#pragma unroll
                    for (int n = 0; n < 2; ++n) acc[a][b][m][n] = (f32x4){0.f, 0.f, 0.f, 0.f};
        cur = nxt; cA = nA; cB = nB; ++ui;
        if constexpr (ALIGN_EPI) { if (wr == 1) PG8_BAR; }
    }
    PG8_WAIT_V(0);
    if constexpr (!ALIGN_EPI) { if (wr == 0) PG8_BAR; }
    PG8_BAR;
    if constexpr (Epi::AFTER_DRAIN) { E.fused(acc, cur, wr, wc, fr, fq, lds, wid, lane); S.done(cur); }
#undef PG8_SA
#undef PG8_SB
#undef PG8_STAGE
#undef PG8_RS_voffA
#undef PG8_RS_voffB
#undef PG8_LDA
#undef PG8_LDB
#undef PG8_MMA
#undef PG8_WAIT_V
#undef PG8_WAIT_L
#undef PG8_BAR
#undef PG8_SCHED
}
}

constexpr int NWAVES = 8;
#ifndef MK_N_LAUNCHES
#define MK_N_LAUNCHES 1
#endif
constexpr int PER_PHASE = 7;
constexpr int N_LAUNCHES = MK_N_LAUNCHES;

constexpr int BATCH = 8, SEQ = 4096, D = 1024, NH = 16, HD = 64, FF = 2816, NHM = 8;
constexpr int M = BATCH * SEQ;
constexpr int NQKV = 3 * D, NGU = 2 * FF;
constexpr float RMS_EPS = 1e-6f;
constexpr float QSCALE = 0.125f * 1.4426950408889634f;

constexpr size_t MiB = 1u << 20;
constexpr size_t WS_CTL = 0, CTL_ZERO_BYTES = 64 * 1024;
constexpr size_t WS_ROPE = 1 * MiB;
constexpr size_t WS_WQKV = 2 * MiB, WS_WO = 8 * MiB, WS_WGU = 10 * MiB, WS_WD = 21 * MiB;
constexpr size_t WS_KPART = 27 * MiB;
constexpr size_t WS_SSQA = 28 * MiB, WS_SSQ1 = 30 * MiB, WS_SSQ2 = 32 * MiB;
constexpr size_t WS_XN = 40 * MiB;
constexpr size_t WS_QO = 104 * MiB, WS_K = 168 * MiB, WS_V = 232 * MiB;
constexpr size_t WS_H = 104 * MiB;
#ifndef MK_REPEAT_PHASE
#define MK_REPEAT_PHASE -1
#endif
constexpr size_t WS_O = WS_QO;
constexpr size_t WS_FARO = 296 * MiB, WS_FARL = 328 * MiB;
constexpr size_t WS_XN8 = 330 * MiB;
constexpr size_t WS_O8 = 362 * MiB;
constexpr size_t WS_END = (MK_REPEAT_PHASE == 3 ? 490 : 394) * MiB;
constexpr size_t QKV8_OFF = 2 * MiB;
constexpr int CW_TMO = 0, CW_CODE = 1;
constexpr int CW_BAR = 4096;
constexpr int CW_PANEL = 8192;
constexpr int CW_FAR = 2048;

constexpr int RING_OFF = 0, RING_BYTES = 131072;
constexpr int LDSCTL_OFF = RING_BYTES, MISC_OFF = LDSCTL_OFF + 320;
constexpr int LDS_BYTES = 147456;
static_assert(WS_V - WS_K == WS_K - WS_QO, "Q | K | V equally spaced");
#define GAS __attribute__((address_space(1)))
#define LAS __attribute__((address_space(3)))
typedef unsigned short bf16;
typedef unsigned v4u __attribute__((ext_vector_type(4)));
typedef float f32x4 __attribute__((ext_vector_type(4)));
typedef short bf16x8 __attribute__((ext_vector_type(8)));
typedef GAS unsigned gu32;
typedef GAS unsigned long long gu64;
#define RLX_AGENT __ATOMIC_RELAXED, __HIP_MEMORY_SCOPE_AGENT
#define LDS_WAIT() asm volatile("s_waitcnt lgkmcnt(0)" ::: "memory")
#define VM_WAIT() asm volatile("s_waitcnt vmcnt(0)" ::: "memory")
__device__ __forceinline__ unsigned long long rt() { return __builtin_amdgcn_s_memrealtime(); }
__device__ __forceinline__ unsigned f2bf(float f) { unsigned u = __builtin_bit_cast(unsigned, f); return (u + 0x7fffu + ((u >> 16) & 1u)) >> 16; }
__device__ __forceinline__ unsigned pk2(float lo, float hi) { return f2bf(lo) | (f2bf(hi) << 16); }

#define XB_TMO      128
#define XB_XCNT(j)  (256  + 64 * (j))
#define XB_XSUB(j)  (1280 + 64 * (j))
#define XB_XGEN(j)  (2304 + 64 * (j))
#define XB_TOP      3328
#define XB_TOPGEN   3392
#define XCD_BAR_WORDS 3456
#define XB_SPIN_CAP (1u << 18)

__device__ __forceinline__ unsigned xb_ld(unsigned* p)              { return __hip_atomic_load(p, __ATOMIC_RELAXED, __HIP_MEMORY_SCOPE_AGENT); }
__device__ __forceinline__ unsigned xb_add(unsigned* p, unsigned v) { return __hip_atomic_fetch_add(p, v, __ATOMIC_RELAXED, __HIP_MEMORY_SCOPE_AGENT); }
__device__ __forceinline__ unsigned xb_xcc_id() { return (unsigned)__builtin_amdgcn_s_getreg((3 << 11) | 20) & 0xFu; }
#define XB_SPIN(cond, bar) do { unsigned _sp = 0; while (cond) { __builtin_amdgcn_s_sleep(1); \
    if ((++_sp & 255u) == 0u) { if (xb_ld(&(bar)[XB_TMO])) break; if (_sp > XB_SPIN_CAP) { atomicAdd(&(bar)[XB_TMO], 1u); break; } } } } while (0)

struct XcdBarrier {
    unsigned* bar; unsigned x;
    volatile LAS unsigned* st;
};

__device__ __forceinline__ int mk_lane() { int l; asm volatile("v_mbcnt_lo_u32_b32 %0, -1, 0\n\tv_mbcnt_hi_u32_b32 %0, -1, %0" : "=v"(l)); return l; }
__device__ __forceinline__ XcdBarrier xcd_barrier_post(unsigned* bar, volatile LAS unsigned* st, int wave) {
    XcdBarrier b; b.bar = bar; b.x = xb_xcc_id(); b.st = st;
    if (wave == 0 && mk_lane() == 0) (void)xb_add(&bar[XB_XCNT(b.x)], 1u);
    return b;
}
__device__ __forceinline__ void xcd_barrier_complete(unsigned* bar, unsigned x, unsigned& nloc, unsigned& nx) {
    const unsigned G = gridDim.x * gridDim.y * gridDim.z;
    unsigned sum, cnt, mine, sp = 0u;
    for (;;) {
        sum = 0u; cnt = 0u; mine = 0u;
#pragma unroll
        for (unsigned j = 0; j < 16; ++j) { const unsigned c = xb_ld(&bar[XB_XCNT(j)]); sum += c; cnt += (c > 0u) ? 1u : 0u; mine = (j == x) ? c : mine; }
        if (sum == G) break;
        __builtin_amdgcn_s_sleep(1);
        if ((++sp & 255u) == 0u) { if (xb_ld(&bar[XB_TMO])) break; if (sp > XB_SPIN_CAP) { atomicAdd(&bar[XB_TMO], 1u); break; } }
    }
    nloc = mine > 0u ? mine : 1u; nx = cnt > 0u ? cnt : 1u;
}

__device__ __forceinline__ void xcd_barrier(const XcdBarrier& b, int wave) {
    asm volatile("s_waitcnt vmcnt(0)" ::: "memory");
    __syncthreads();
    if (wave == 0 && mk_lane() == 0) {
        unsigned* bar = b.bar;
        __builtin_amdgcn_s_waitcnt(0);
        unsigned nloc = b.st[0], nx = b.st[1];
        if (nloc == 0u) { xcd_barrier_complete(bar, b.x, nloc, nx); b.st[0] = nloc; b.st[1] = nx; }
        const unsigned old = xb_add(&bar[XB_XSUB(b.x)], 1u);
        const unsigned gen = old / nloc;
        if (old + 1u == (gen + 1u) * nloc) {
            __builtin_amdgcn_fence(__ATOMIC_RELEASE, "agent");
            asm volatile("s_waitcnt vmcnt(0)" ::: "memory");
            const unsigned og = xb_add(&bar[XB_TOP], 1u);
            const unsigned tg = og / nx;
            if (og + 1u == (tg + 1u) * nx) xb_add(&bar[XB_TOPGEN], 1u);
            else XB_SPIN(xb_ld(&bar[XB_TOPGEN]) == tg, bar);
            __builtin_amdgcn_fence(__ATOMIC_ACQUIRE, "agent");
            xb_add(&bar[XB_XGEN(b.x)], 1u);
            asm volatile("s_waitcnt vmcnt(0)" ::: "memory");
        } else {
            XB_SPIN(xb_ld(&bar[XB_XGEN(b.x)]) == gen, bar);
            __builtin_amdgcn_fence(__ATOMIC_ACQUIRE, "agent");
            asm volatile("s_waitcnt vmcnt(0)" ::: "memory");
        }
    }
    __syncthreads();
}

#include <hip/hip_bf16.h>
#include <cmath>
namespace attn_body {
using bf16=__hip_bfloat16;
using bf16x8=__attribute__((ext_vector_type(8)))short;
using s16x4=__attribute__((ext_vector_type(4)))short;
using f32x16=__attribute__((ext_vector_type(16)))float;
using u32x4=__attribute__((ext_vector_type(4)))unsigned;
using f32x4_t=__attribute__((ext_vector_type(4)))float;
constexpr int BATCH=8,NHEAD=16,SEQ=4096,D=64,DM=NHEAD*D;
constexpr int NW=8,QBLK=32,QB=QBLK*NW,KVBLK=64,NQB=SEQ/QB;
constexpr int ATTN_PITCH=DM, ATTN_UNIT_ROWS=QB;
__device__ __forceinline__ int crow(int r,int hi){return (r&3)+8*(r>>2)+4*hi;}
#define SBAR() __builtin_amdgcn_sched_barrier(0)
__device__ __forceinline__ void cmask(f32x16&p0,f32x16&p1,int jb,int qrel,int hi){
  const float NEG=-INFINITY; int kb=64*jb+4*hi;
  #pragma unroll
  for(int r=0;r<16;++r){int kv=kb+(r&3)+8*(r>>2); if(kv>qrel)p0[r]=NEG; if(kv+32>qrel)p1[r]=NEG;}
}

__device__ __forceinline__ void dm_range(f32x16&p0,f32x16&p1,int x,unsigned bw){
  #pragma unroll
  for(int r=0;r<16;++r){ const int kp=(r&3)+8*(r>>2); if((unsigned)(x-kp)>bw)p0[r]=-1e30f; if((unsigned)(x-32-kp)>bw)p1[r]=-1e30f; } }
template<int KIND> __device__ __forceinline__ int dmode(int lo){
  if(KIND==2) return (lo+94<33||lo>128)?0:4;
  return (lo+94<0||lo>512)?0:((lo<0)?40:((lo+94<=128)?1:((lo<=128)?41:((lo+94<=512)?2:42)))); }
__device__ __forceinline__ void dm_adj128(f32x16&p0,f32x16&p1,int dqh,const f32x16&adj){
  #pragma unroll
  for(int r=0;r<16;++r){ const int kp=(r&3)+8*(r>>2); p0[r]+=(dqh-kp>128)?adj[r]:0.f; p1[r]+=(dqh-32-kp>128)?adj[r]:0.f; } }
__device__ __forceinline__ void fmask(f32x16&p0,f32x16&p1,int dq){
  #pragma unroll
  for(int r=0;r<16;++r){ const int kp=(r&3)+8*(r>>2); if((unsigned)(dq-kp-33)>95u)p0[r]=-1e30f; if((unsigned)(dq-kp-65)>95u)p1[r]=-1e30f; }
}
constexpr int NSLOT=3, SLOTB=8192;
constexpr int LDS_K=0, LDS_V=NSLOT*SLOTB, LDS_WS=2*NSLOT*SLOTB, LDS_OST=LDS_WS+NW*64*4, LDS_BYTES=LDS_OST+NW*4096;
constexpr int LDS_TAB=LDS_BYTES, TABB=4096, LDS_ALL=LDS_TAB+4*TABB;
constexpr float C2=0.125f*1.4426950408889634f;
__device__ __forceinline__ void glds16(const void*gsrc,unsigned lds_dst){unsigned keep;
  asm volatile("s_mov_b32 %0, m0\n\ts_mov_b32 m0, %2\n\ts_nop 0\n\tglobal_load_lds_dwordx4 %1, off\n\ts_mov_b32 m0, %0":"=&s"(keep):"v"(gsrc),"s"(lds_dst):"memory");}
__device__ __forceinline__ float max3f(float a,float b,float c){float r;asm("v_max3_f32 %0, %1, %2, %3":"=v"(r):"v"(a),"v"(b),"v"(c));return r;}
__device__ __forceinline__ float max2f(float a,float b){float r;asm("v_max_f32_e32 %0, %1, %2":"=v"(r):"v"(a),"v"(b));return r;}
__device__ __forceinline__ float fadd_s(float a,float b){float r;asm("v_add_f32_e32 %0, %1, %2":"=v"(r):"v"(a),"v"(b));return r;}
__device__ __forceinline__ float fsub_s(float a,float b){float r;asm("v_sub_f32_e32 %0, %1, %2":"=v"(r):"v"(a),"v"(b));return r;}
typedef float f32x2_t __attribute__((ext_vector_type(2))); typedef __bf16 bf16x2_t __attribute__((ext_vector_type(2)));
__device__ __forceinline__ unsigned cvtpk_s(float lo,float hi){f32x2_t v={lo,hi};bf16x2_t b=__builtin_convertvector(v,bf16x2_t);return __builtin_bit_cast(unsigned,b);}
#define WAIT_BAR(N) asm volatile("s_waitcnt vmcnt(" #N ") lgkmcnt(0)\n\ts_barrier":::"memory")

__device__ __forceinline__ void qkt(f32x16&p0,f32x16&p1,const char*Kslot,const bf16x8*qr,const f32x16&negm,int r32,int hi){
  const char*kb=Kslot+hi*1024+r32*16;
  #pragma unroll
  for(int d0=0;d0<4;++d0){
    const bf16x8 b0=*reinterpret_cast<const bf16x8*>(kb+d0*2048);
    const bf16x8 b1=*reinterpret_cast<const bf16x8*>(kb+d0*2048+512);
    if(d0==0){p0=__builtin_amdgcn_mfma_f32_32x32x16_bf16(b0,qr[0],negm,0,0,0);p1=__builtin_amdgcn_mfma_f32_32x32x16_bf16(b1,qr[0],negm,0,0,0);}
    else{p0=__builtin_amdgcn_mfma_f32_32x32x16_bf16(b0,qr[d0],p0,0,0,0);p1=__builtin_amdgcn_mfma_f32_32x32x16_bf16(b1,qr[d0],p1,0,0,0);}}
}
typedef __attribute__((address_space(3))) const char* lds_cptr;
typedef short v4i16_t __attribute__((ext_vector_type(4)));
__device__ __forceinline__ void kload8(bf16x8*kf,lds_cptr kp){
  kf[0]=*(const __attribute__((address_space(3))) bf16x8*)(kp);      kf[1]=*(const __attribute__((address_space(3))) bf16x8*)(kp+512);
  kf[2]=*(const __attribute__((address_space(3))) bf16x8*)(kp+2048); kf[3]=*(const __attribute__((address_space(3))) bf16x8*)(kp+2560);
  kf[4]=*(const __attribute__((address_space(3))) bf16x8*)(kp+4096); kf[5]=*(const __attribute__((address_space(3))) bf16x8*)(kp+4608);
  kf[6]=*(const __attribute__((address_space(3))) bf16x8*)(kp+6144); kf[7]=*(const __attribute__((address_space(3))) bf16x8*)(kp+6656);
}
__device__ __forceinline__ void kload2(bf16x8*kf,lds_cptr kp,int j){ kf[2*j]=*(const __attribute__((address_space(3))) bf16x8*)(kp+j*2048); kf[2*j+1]=*(const __attribute__((address_space(3))) bf16x8*)(kp+j*2048+512); }
__device__ __forceinline__ s16x4 vtr(lds_cptr p){ return __builtin_bit_cast(s16x4,__builtin_amdgcn_ds_read_tr16_b64_v4i16((__attribute__((address_space(3))) v4i16_t*)p)); }
__device__ __forceinline__ float rowmax(const f32x16&p0,const f32x16&p1){
  float a=max3f(p0[0],p0[1],p1[0]),b=max3f(p0[2],p0[3],p1[1]);a=max3f(a,p1[2],p1[3]);
  #pragma unroll
  for(int r=4;r<16;r+=4){a=max3f(a,p0[r],p0[r+1]);b=max3f(b,p0[r+2],p0[r+3]);a=max3f(a,p1[r],p1[r+1]);b=max3f(b,p1[r+2],p1[r+3]);}
  const float m=max2f(a,b);
  auto rr=__builtin_amdgcn_permlane32_swap(__float_as_uint(m),__float_as_uint(m),false,false);
  return max2f(__uint_as_float(rr[0]),__uint_as_float(rr[1]));
}
__device__ __forceinline__ void pv(f32x16*o,int vb,bf16x8 pa0,bf16x8 pa1,bf16x8 pa2,bf16x8 pa3){
  #pragma unroll
  for(int d0=0;d0<2;++d0){s16x4 lo[4],hi[4];
    #pragma unroll
    for(int ks=0;ks<4;++ks){
      asm volatile("ds_read_b64_tr_b16 %0,%1 offset:%c2":"=&v"(lo[ks]):"v"(vb),"i"(d0*4096+ks*1024):"memory");
      asm volatile("ds_read_b64_tr_b16 %0,%1 offset:%c2":"=&v"(hi[ks]):"v"(vb),"i"(d0*4096+ks*1024+512):"memory");}
    asm volatile("s_waitcnt lgkmcnt(0)":::"memory");SBAR();
    #define PK(k) (bf16x8){lo[k][0],lo[k][1],lo[k][2],lo[k][3],hi[k][0],hi[k][1],hi[k][2],hi[k][3]}
    o[d0]=__builtin_amdgcn_mfma_f32_32x32x16_bf16(pa0,PK(0),o[d0],0,0,0);
    o[d0]=__builtin_amdgcn_mfma_f32_32x32x16_bf16(pa1,PK(1),o[d0],0,0,0);
    o[d0]=__builtin_amdgcn_mfma_f32_32x32x16_bf16(pa2,PK(2),o[d0],0,0,0);
    o[d0]=__builtin_amdgcn_mfma_f32_32x32x16_bf16(pa3,PK(3),o[d0],0,0,0);
    #undef PK
  }
}

#ifndef ATTN_STORE16
#define ATTN_STORE16(p,v) asm volatile("global_store_dwordx4 %0, %1, off sc1\n\ts_nop 1"::"v"(p),"v"(v):"memory")
#endif
template<int THRL,int KIND> __device__ __forceinline__ void attn_unit(int b,int h,int qb,unsigned char*ws,char*shm,int wave,bf16x8 (&qr)[4],bool pre,bool has_next,int nkind,int nb,int nh,int nqb){
  const bf16*Q=(const bf16*)(ws+WS_QO); const bf16*K=(const bf16*)(ws+WS_K); const bf16*V=(const bf16*)(ws+WS_V); unsigned char*O8=ws+WS_O8;
  float*ssq=(float*)(ws+WS_SSQA); const float*kpart=(const float*)(ws+WS_KPART); unsigned short*faro=(unsigned short*)(ws+WS_FARO); float*farl=(float*)(ws+WS_FARL);
  constexpr bool DIL=(KIND==1), FAR=(KIND==2); constexpr int RS=FAR?16:1;
  int tid=wave*64+mk_lane(); asm volatile("":"+v"(tid));
  const int lane=tid&63,r32=lane&31,hi=lane>>5; const int wid=__builtin_amdgcn_readfirstlane(tid>>6);
  const int rowbase=b*SEQ+(FAR?qb:0);   const int q0=FAR?0:qb*QB;
  const bf16*Qw=Q+(rowbase+(int)(q0+wid*QBLK)*RS)*DM+h*D;
  const int T0=DIL?(qb>2?4*qb-8:0):0;
  const bf16*Kh=K+(rowbase+(int)T0*KVBLK)*DM+h*D,*Vh=V+(rowbase+(int)T0*KVBLK)*DM+h*D;
  const unsigned lds0=(unsigned)(uintptr_t)shm;
  float*wsf=(float*)(shm+LDS_WS)+wid*64;
  const bf16*ksrc=Kh+(int)lane*RS*DM+wid*8;
  const bf16*vsrc=Vh+(int)(16*(wid&3)+(lane>>2))*RS*DM+(wid>>2)*32+(lane&3)*8;
  const unsigned kdst=lds0+LDS_K+wid*1024, vdst=lds0+LDS_V+wid*1024;
  #define DMA_K(t,slot) glds16(ksrc+(int)(t)*KVBLK*RS*DM,(unsigned)__builtin_amdgcn_readfirstlane(kdst+(slot)))
  #define DMA_V(t,slot) glds16(vsrc+(int)(t)*KVBLK*RS*DM,(unsigned)__builtin_amdgcn_readfirstlane(vdst+(slot)))
  const int vb0=(int)(lds0+LDS_V)+((lane>>4)&1)*32+(lane&3)*8+(4*hi+((lane&15)>>2))*64;
  const char*Kbase=shm+LDS_K; bf16x8 kf[8];
  const lds_cptr shm3=(lds_cptr)shm; const lds_cptr kp0=shm3+LDS_K+hi*1024+r32*16; const lds_cptr vp0=shm3+LDS_V+((lane>>4)&1)*32+(lane&3)*8+(4*hi+((lane&15)>>2))*64;
  const int NT=FAR?4:(q0+QB)/KVBLK-T0;
  if(!pre)DMA_K(0,0); DMA_V(0,0); if(!pre)DMA_K(1,SLOTB);
  #pragma unroll
  for(int d0=0;d0<4;++d0)if(!pre)qr[d0]=*reinterpret_cast<const bf16x8*>(&Qw[(int)r32*RS*DM+d0*16+hi*8]);
  float mhat=0.f,l_reg=0.f;f32x16 o[2];o[0]=f32x16{};o[1]=f32x16{};
  const int qrel=wid*QBLK+r32;
  const lds_cptr tabp=(lds_cptr)shm+LDS_TAB+lane*64;
  unsigned selmask=1u<<qb;
  if(KIND==0){
    f32x16 g=f32x16{};
    #pragma unroll
    for(int d0=0;d0<4;++d0){ float km[8];
      if(r32<16){ const float*kp_=kpart+(unsigned)((b*16+r32)*2)*512+h*64+d0*16+hi*8;
        const f32x4_t a0=*(const f32x4_t*)kp_,a1=*(const f32x4_t*)(kp_+4),b0=*(const f32x4_t*)(kp_+512),b1=*(const f32x4_t*)(kp_+516);
        km[0]=a0[0]+b0[0];km[1]=a0[1]+b0[1];km[2]=a0[2]+b0[2];km[3]=a0[3]+b0[3];km[4]=a1[0]+b1[0];km[5]=a1[1]+b1[1];km[6]=a1[2]+b1[2];km[7]=a1[3]+b1[3]; }
      else{ _Pragma("unroll") for(int j=0;j<8;++j)km[j]=0.f; }
      u32x4 wh,wl; float rs[8];
      wh[0]=cvtpk_s(km[0],km[1]);wh[1]=cvtpk_s(km[2],km[3]);wh[2]=cvtpk_s(km[4],km[5]);wh[3]=cvtpk_s(km[6],km[7]);
      #pragma unroll
      for(int j=0;j<4;++j){ rs[2*j]=km[2*j]-__uint_as_float(wh[j]<<16); rs[2*j+1]=km[2*j+1]-__uint_as_float(wh[j]&0xffff0000u); }
      wl[0]=cvtpk_s(rs[0],rs[1]);wl[1]=cvtpk_s(rs[2],rs[3]);wl[2]=cvtpk_s(rs[4],rs[5]);wl[3]=cvtpk_s(rs[6],rs[7]);
      g=__builtin_amdgcn_mfma_f32_32x32x16_bf16(__builtin_bit_cast(bf16x8,wh),qr[d0],g,0,0,0);
      g=__builtin_amdgcn_mfma_f32_32x32x16_bf16(__builtin_bit_cast(bf16x8,wl),qr[d0],g,0,0,0); }
    float gv[16];
    #pragma unroll
    for(int r=0;r<8;++r){ const float own=g[r],oth=__shfl_xor(own,32); const int bl=(r&3)+8*(r>>2); gv[bl]=hi?oth:own; gv[bl+4]=hi?own:oth; }
    #pragma unroll
    for(int j=0;j<16;++j) if(j>=qb)gv[j]=-3e38f;
    #pragma unroll
    for(int rd=0;rd<3;++rd){ float best=-3e38f;int bi=0;
      #pragma unroll
      for(int j=0;j<16;++j){ if(gv[j]>best){best=gv[j];bi=j;} }
      if(best>-3e38f)selmask|=1u<<bi;
      #pragma unroll
      for(int j=0;j<16;++j) if(j==bi)gv[j]=-3e38f; }
  }
  const int lo0=FAR?(32*wid-63):(q0-T0*KVBLK+32*wid-63);
  #define DMODE(t) dmode<KIND>(lo0-(t)*KVBLK)
  #define CMASK(P0,P1,t) do{ if(DIL){ if(md_t>=40){ const int dqh_=q0-(T0+(t))*KVBLK+qrel-4*hi; \
        if(md_t==41){ const f32x16 adj_=*(const __attribute__((address_space(3))) f32x16*)(tabp+3*TABB); dm_adj128(P0,P1,dqh_,adj_); } \
        else dm_range(P0,P1,dqh_-((md_t==40)?0:-4096),(md_t==40)?0x7fffffffu:4608u); } } \
    else if(FAR){ if(md_t==4)fmask(P0,P1,qrel-(t)*KVBLK-4*hi); } \
    else { int jb_=(t)-(NT-4); if(jb_>=0)cmask(P0,P1,jb_,qrel,hi); } }while(0)
  #define SETC(t) f32x16 ct; const int md_t=(KIND==0)?0:DMODE(t); { if(DIL){ const int to_=(md_t==0)?0:((md_t==2||md_t==42)?2*TABB:TABB); \
      const f32x16 tb_=*(const __attribute__((address_space(3))) f32x16*)(tabp+to_); _Pragma("unroll") for(int r=0;r<16;++r)ct[r]=tb_[r]-mhat; } \
    else { const float x_=(FAR?(md_t!=0):(((selmask>>((t)>>2))&1u)!=0u))?-mhat:-1e30f; _Pragma("unroll") for(int r=0;r<16;++r)ct[r]=x_; } asm volatile("":"+v"(ct)); }
  bool resc=false;
  #define START(P0,P1) do{ const float rm=rowmax(P0,P1); resc=false; \
    if(__any(rm>(float)THRL)){ const float dl=__builtin_fmaxf(rm,0.f); mhat=fadd_s(mhat,dl); \
      _Pragma("unroll") for(int r=0;r<16;++r){P0[r]=fsub_s(P0[r],dl);P1[r]=fsub_s(P1[r],dl);} \
      const float f=__builtin_amdgcn_exp2f(-dl); l_reg*=f; if(hi==0)wsf[r32]=f; resc=true; } \
    _Pragma("unroll") for(int r=0;r<16;++r)P0[r]=__builtin_amdgcn_exp2f(P0[r]); }while(0)
  #define RESC() do{ if(resc){ asm volatile("s_waitcnt lgkmcnt(0)":::"memory"); \
      _Pragma("unroll") for(int d_=0;d_<2;++d_) _Pragma("unroll") for(int r=0;r<16;++r)o[d_][r]*=wsf[crow(r,hi)]; } }while(0)
  f32x16 pA0,pA1,pB0,pB1;
  int sl_prev=0,sl_cur=0,sl_next=SLOTB;
  #define ROT() do{sl_prev=sl_cur;sl_cur=sl_next;sl_next=(sl_next==(NSLOT-1)*SLOTB)?0:sl_next+SLOTB;}while(0)
  if(!pre){ DMA_K(2,2*SLOTB);
    WAIT_BAR(3); }
  else { WAIT_BAR(1); }
  if(0)WAIT_BAR(3);
  { SETC(0); qkt(pA0,pA1,Kbase,qr,ct,r32,hi); asm volatile("s_nop 15\n\ts_nop 7":"+v"(pA0),"+v"(pA1));CMASK(pA0,pA1,0); }
  START(pA0,pA1);
  _Pragma("unroll") for(int r=0;r<16;++r)pA1[r]=__builtin_amdgcn_exp2f(pA1[r]);
  WAIT_BAR(0);
  RESC();
  DMA_K(3,0);DMA_V(1,SLOTB);
  ROT();
  kload8(kf,kp0+sl_cur);
  WAIT_BAR(2);
  s16x4 vlo[8],vhi[8]; u32x4 pw0,pw1,pw2,pw3;
  #define PKW(P,B) cvtpk_s(P[B],P[B+1])
  #define PAF(k) __builtin_bit_cast(bf16x8,pw##k)
  #define VFR(i) (bf16x8){vlo[i][0],vlo[i][1],vlo[i][2],vlo[i][3],vhi[i][0],vhi[i][1],vhi[i][2],vhi[i][3]}
  #define PIN(x) asm volatile("":"+v"(x))
  #define MX3(a,b,c) __builtin_fmaxf(__builtin_fmaxf((a),(b)),(c))
  #define GAPA(MF,A0,A1,A2,A3,W0,W1,PW) do{ MF; sacc+=A0; sacc+=A1; sacc+=A2; sacc+=A3; PIN(sacc); W0; W1; PIN(PW); SBAR(); }while(0)
  #define EX(v) __builtin_amdgcn_exp2f(v)
  #define GAPB(MF,X,B) do{ MF; X[B]=EX(X[B]); X[B+1]=EX(X[B+1]); X[B+2]=EX(X[B+2]); X[B+3]=EX(X[B+3]); PIN(X); SBAR(); }while(0)
  #define VRD(i) do{ vlo[i]=vtr(vp_+(((i)>>2)*4096+((i)&3)*1024)); vhi[i]=vtr(vp_+(((i)>>2)*4096+((i)&3)*1024+512)); }while(0)
  #define KRD(G,j) do{ if(G){ kload2(kf,kp0+sl_next,j); SBAR(); } }while(0)
  #define STEP(C0,C1,P0,P1,t,GK,GV,GL) do{ SBAR(); SETC(t); SBAR(); \
    const lds_cptr vp_=vp0+sl_prev; \
    VRD(0); SBAR(); float sacc=(P0[0]+P0[1]); \
    GAPA(C0=__builtin_amdgcn_mfma_f32_32x32x16_bf16(kf[0],qr[0],ct,0,0,0), P0[2],P0[3],P0[4],P0[5],     pw0[0]=PKW(P0,0), pw0[1]=PKW(P0,2), pw0); \
    VRD(4); SBAR(); GAPA(C1=__builtin_amdgcn_mfma_f32_32x32x16_bf16(kf[1],qr[0],ct,0,0,0), P0[6],P0[7],P0[8],P0[9],     pw0[2]=PKW(P0,4), pw0[3]=PKW(P0,6), pw0); \
    VRD(1); SBAR(); GAPA(C0=__builtin_amdgcn_mfma_f32_32x32x16_bf16(kf[2],qr[1],C0,0,0,0),   P0[10],P0[11],P0[12],P0[13], pw1[0]=PKW(P0,8), pw1[1]=PKW(P0,10), pw1); \
    VRD(5); SBAR(); GAPA(C1=__builtin_amdgcn_mfma_f32_32x32x16_bf16(kf[3],qr[1],C1,0,0,0),   P0[14],P0[15],P1[0],P1[1],   pw1[2]=PKW(P0,12),pw1[3]=PKW(P0,14), pw1); \
    VRD(2); SBAR(); GAPA(C0=__builtin_amdgcn_mfma_f32_32x32x16_bf16(kf[4],qr[2],C0,0,0,0),   P1[2],P1[3],P1[4],P1[5],     pw2[0]=PKW(P1,0), pw2[1]=PKW(P1,2), pw2); \
    VRD(6); SBAR(); GAPA(C1=__builtin_amdgcn_mfma_f32_32x32x16_bf16(kf[5],qr[2],C1,0,0,0),   P1[6],P1[7],P1[8],P1[9],     pw2[2]=PKW(P1,4), pw2[3]=PKW(P1,6), pw2); \
    VRD(3); SBAR(); GAPA(C0=__builtin_amdgcn_mfma_f32_32x32x16_bf16(kf[6],qr[3],C0,0,0,0),   P1[10],P1[11],P1[12],P1[13], pw3[0]=PKW(P1,8), pw3[1]=PKW(P1,10), pw3); \
    VRD(7); SBAR(); GAPA(C1=__builtin_amdgcn_mfma_f32_32x32x16_bf16(kf[7],qr[3],C1,0,0,0),   P1[14],P1[15],0.f,0.f,       pw3[2]=PKW(P1,12),pw3[3]=PKW(P1,14), pw3); \
    l_reg+=sacc; \
    if(GK){DMA_K((t)+3,sl_cur);} if(GV){DMA_V((t)+1,sl_next);} \
    CMASK(C0,C1,t); \
    { float a=MX3(C0[0],C0[1],C1[0]),b=MX3(C0[2],C0[3],C1[1]); a=MX3(a,C1[2],C1[3]); \
      _Pragma("unroll") for(int r=4;r<16;r+=4){a=MX3(a,C0[r],C0[r+1]);b=MX3(b,C0[r+2],C0[r+3]);a=MX3(a,C1[r],C1[r+1]);b=MX3(b,C1[r+2],C1[r+3]);} \
      float rm=__builtin_fmaxf(a,b); { auto rr=__builtin_amdgcn_permlane32_swap(__float_as_uint(rm),__float_as_uint(rm),false,false); rm=__builtin_fmaxf(__uint_as_float(rr[0]),__uint_as_float(rr[1])); } \
      resc=false; \
      if(__builtin_expect(__any(rm>(float)THRL),0)){ const float dl=__builtin_fmaxf(rm,0.f); mhat+=dl; \
        _Pragma("unroll") for(int r=0;r<16;++r){C0[r]-=dl;C1[r]-=dl;} \
        const float f=__builtin_amdgcn_exp2f(-dl); l_reg*=f; if(hi==0)wsf[r32]=f; resc=true; } } \
    SBAR(); \
    GAPB(o[0]=__builtin_amdgcn_mfma_f32_32x32x16_bf16(PAF(0),VFR(0),o[0],0,0,0), C0,0); \
    GAPB(o[1]=__builtin_amdgcn_mfma_f32_32x32x16_bf16(PAF(0),VFR(4),o[1],0,0,0), C0,4); \
    KRD(GL,0); GAPB(o[0]=__builtin_amdgcn_mfma_f32_32x32x16_bf16(PAF(1),VFR(1),o[0],0,0,0), C0,8); \
    KRD(GL,1); GAPB(o[1]=__builtin_amdgcn_mfma_f32_32x32x16_bf16(PAF(1),VFR(5),o[1],0,0,0), C0,12); \
    KRD(GL,2); GAPB(o[0]=__builtin_amdgcn_mfma_f32_32x32x16_bf16(PAF(2),VFR(2),o[0],0,0,0), C1,0); \
    KRD(GL,3); GAPB(o[1]=__builtin_amdgcn_mfma_f32_32x32x16_bf16(PAF(2),VFR(6),o[1],0,0,0), C1,4); \
    GAPB(o[0]=__builtin_amdgcn_mfma_f32_32x32x16_bf16(PAF(3),VFR(3),o[0],0,0,0), C1,8); \
    GAPB(o[1]=__builtin_amdgcn_mfma_f32_32x32x16_bf16(PAF(3),VFR(7),o[1],0,0,0), C1,12); \
    }while(0)
  int t=1;
  for(;t+5<NT;t+=2){
    STEP(pB0,pB1,pA0,pA1,t,true,true,true);     WAIT_BAR(2); RESC(); ROT();
    STEP(pA0,pA1,pB0,pB1,t+1,true,true,true);   WAIT_BAR(2); RESC(); ROT();
  }
  #define ENDW(tt) do{ if((tt)+3<NT){WAIT_BAR(2);} else if((tt)+2<NT){WAIT_BAR(1);} else {WAIT_BAR(0);} }while(0)
  for(;t+1<NT;t+=2){
    STEP(pB0,pB1,pA0,pA1,t,(t+3<NT),(t+1<NT),(t+1<NT));       ENDW(t);   RESC(); ROT();
    STEP(pA0,pA1,pB0,pB1,t+1,(t+4<NT),(t+2<NT),(t+2<NT));     ENDW(t+1); RESC(); ROT();
  }
  if(has_next){
    const int nRS=(nkind==2)?16:1, nrowbase=nb*SEQ+((nkind==2)?nqb:0), nT0=(nkind==1)?(nqb>2?4*nqb-8:0):0;
    const bf16*nks=K+(nrowbase+(int)nT0*KVBLK)*DM+nh*D+(int)lane*nRS*DM+wid*8;
    glds16(nks,(unsigned)__builtin_amdgcn_readfirstlane(kdst)); glds16(nks+(int)KVBLK*nRS*DM,(unsigned)__builtin_amdgcn_readfirstlane(kdst+SLOTB)); glds16(nks+(int)2*KVBLK*nRS*DM,(unsigned)__builtin_amdgcn_readfirstlane(kdst+2*SLOTB)); }
  STEP(pB0,pB1,pA0,pA1,NT-1,false,false,false); RESC();
  if(has_next){
    const int nRS=(nkind==2)?16:1, nrowbase=nb*SEQ+((nkind==2)?nqb:0), nq0=(nkind==2)?0:nqb*QB; const bf16*nQw=Q+(nrowbase+(int)(nq0+wid*QBLK)*nRS)*DM+nh*D;
    #pragma unroll
    for(int d0=0;d0<4;++d0)qr[d0]=*reinterpret_cast<const bf16x8*>(&nQw[(int)r32*nRS*DM+d0*16+hi*8]); }
  { float sacc=pB0[0]+pB0[1]; _Pragma("unroll") for(int r=2;r<16;++r)sacc+=pB0[r]; _Pragma("unroll") for(int r=0;r<16;++r)sacc+=pB1[r]; l_reg+=sacc;
    pw0=(u32x4){PKW(pB0,0),PKW(pB0,2),PKW(pB0,4),PKW(pB0,6)};pw1=(u32x4){PKW(pB0,8),PKW(pB0,10),PKW(pB0,12),PKW(pB0,14)};pw2=(u32x4){PKW(pB1,0),PKW(pB1,2),PKW(pB1,4),PKW(pB1,6)};pw3=(u32x4){PKW(pB1,8),PKW(pB1,10),PKW(pB1,12),PKW(pB1,14)};
    SBAR(); pv(o,vb0+sl_cur,PAF(0),PAF(1),PAF(2),PAF(3)); }
  #undef PKW
  #undef PAF
  #undef VFR
  #undef PIN
  #undef MX3
  #undef GAPA
  #undef GAPB
  #undef EX
  #undef VRD
  #undef KRD
  #undef STEP
  #undef ENDW
  {auto rr=__builtin_amdgcn_permlane32_swap(__float_as_uint(l_reg),__float_as_uint(l_reg),false,false);l_reg=__uint_as_float(rr[0])+__uint_as_float(rr[1]);}
  int lane_e=lane; asm volatile("":"+v"(lane_e));
  u32x4 fch[4];
  if(DIL){
    const unsigned short*fp=faro+(unsigned)(rowbase+q0+wid*QBLK+(lane_e>>3))*512+(h-8)*D+(lane_e&7)*8;
    #pragma unroll
    for(int i=0;i<4;++i)fch[i]=*(const u32x4*)(fp+(unsigned)i*8*512);
    const int p_=q0+wid*QBLK+(lane_e&31); const float*lp=farl+((unsigned)(((b*8+(h-8))*16+(p_&15))*256+(p_>>4)))*2; const float lf_=lp[0],mf_=lp[1];
    const float M_=__builtin_fmaxf(mhat,mf_),sa_=__builtin_amdgcn_exp2f(mhat-M_),sb_=__builtin_amdgcn_exp2f(mf_-M_),rl_=__builtin_amdgcn_rcpf(l_reg*sa_+lf_*sb_);
    if(hi==0){wsf[32+r32]=sa_*rl_;wsf[r32]=sb_*rl_;} }
  else if(hi==0)wsf[32+r32]=FAR?1.f:__builtin_amdgcn_rcpf(l_reg);
  asm volatile("s_waitcnt lgkmcnt(0)":::"memory");
  float rli[16];
  #pragma unroll
  for(int r=0;r<16;++r)rli[r]=wsf[32+crow(r,hi)];
  constexpr int OP=FAR?512:DM;
  bf16*Ow=(bf16*)faro+(rowbase+(int)wid*QBLK*RS)*OP+(h-8)*D;
  unsigned char*O8w=O8+(rowbase+q0+wid*QBLK)*DM+h*D;
  if(FAR&&hi==0){ float*lp=farl+((unsigned)(((b*8+(h-8))*16+qb)*256+qrel))*2; __hip_atomic_store((unsigned long long*)lp,((unsigned long long)__float_as_uint(mhat)<<32)|__float_as_uint(l_reg),__ATOMIC_RELAXED,__HIP_MEMORY_SCOPE_AGENT); }
  { bf16*stg=(bf16*)(shm+LDS_OST)+wid*2048;
    #pragma unroll
    for(int r=0;r<16;++r){const int orow=crow(r,hi);
      #pragma unroll
      for(int d0=0;d0<2;++d0)stg[orow*64+d0*32+r32]=__float2bfloat16(o[d0][r]*rli[r]);}
    asm volatile("s_waitcnt lgkmcnt(0)":::"memory");
    #pragma unroll
    for(int i=0;i<4;++i){const int row=i*8+(lane_e>>3),ch=lane_e&7; u32x4 v=*(const u32x4*)(stg+row*64+ch*8);
      if(DIL){ const float fb_=wsf[row];
        #pragma unroll
        for(int j=0;j<4;++j){ const float a_=__uint_as_float(v[j]<<16)+__uint_as_float(fch[i][j]<<16)*fb_, b_=__uint_as_float(v[j]&0xffff0000u)+__uint_as_float(fch[i][j]&0xffff0000u)*fb_; v[j]=cvtpk_s(a_,b_); } }
      if(FAR){ ATTN_STORE16(Ow+(int)row*RS*OP+ch*8,v); }
      else { unsigned w0_=0,w1_=0;
        w0_=__builtin_amdgcn_cvt_pk_fp8_f32(__uint_as_float(v[0]<<16)*64.f,__uint_as_float(v[0]&0xffff0000u)*64.f,w0_,false); w0_=__builtin_amdgcn_cvt_pk_fp8_f32(__uint_as_float(v[1]<<16)*64.f,__uint_as_float(v[1]&0xffff0000u)*64.f,w0_,true);
        w1_=__builtin_amdgcn_cvt_pk_fp8_f32(__uint_as_float(v[2]<<16)*64.f,__uint_as_float(v[2]&0xffff0000u)*64.f,w1_,false); w1_=__builtin_amdgcn_cvt_pk_fp8_f32(__uint_as_float(v[3]<<16)*64.f,__uint_as_float(v[3]&0xffff0000u)*64.f,w1_,true);
        *(unsigned long long*)(O8w+(int)row*DM+ch*8)=((unsigned long long)w1_<<32)|w0_; }
      float sq=0.f;
      #pragma unroll
      for(int j=0;j<4;++j){ const float a_=__uint_as_float(v[j]<<16), b_=__uint_as_float(v[j]&0xffff0000u); sq+=a_*a_+b_*b_; }
      sq+=__shfl_xor(sq,1); sq+=__shfl_xor(sq,2); sq+=__shfl_xor(sq,4);
      if(!FAR&&ch==0)ssq[(unsigned)(rowbase+q0+wid*QBLK+row)*16+h]=sq; } }
  asm volatile("s_waitcnt lgkmcnt(0)\n\ts_barrier":::"memory");
  #undef DMA_K
  #undef DMA_V
  #undef CMASK
  #undef START
  #undef RESC
  #undef ROT
}
constexpr int ATTN_LDS_BYTES=LDS_BYTES;
__device__ __forceinline__ void attn_tables(char*lds,int wave){
  float*tb=(float*)(lds+LDS_TAB);
  for(int e=wave*64+mk_lane();e<64*16;e+=512){ const int ln=e>>4,r=e&15,r32=ln&31,hi=ln>>5; const int z4=r32&3,z16=((r32&15)-4*hi)&15;
    const bool in4=(z4==(r&3)),in16=(z16==((r&3)+8*((r>>2)&1)));
    tb[e]=-1e30f; tb[1024+e]=in16?1.5849625007f:(in4?1.f:0.f); tb[2048+e]=in16?1.f:(in4?0.f:-1e30f); tb[3072+e]=in16?(1.f-1.5849625007f):(in4?-1.f:-1e30f); }
  __syncthreads();
}
template<int THRL=8> __device__ __forceinline__ void attn_phase(char*lds,unsigned char*ws,unsigned*cnt,int vcu,int G,int wave){
  const int g=vcu>>2,b=g>>3,hm=g&7,c=vcu&3;
  attn_tables(lds,wave);
  bf16x8 qr[4];
  { const int nf_=(c==0)?6:((c==1)?4:3), cb_=(c==0)?0:((c==1)?6:((c==2)?10:13)); const int n_=(MK_REPEAT_PHASE==22?2*nf_:nf_); for(int i=0;i<n_;++i) attn_unit<THRL,2>(b,8+hm,cb_+(i%nf_),ws,lds,wave,qr,i>0,true,(i+1<n_)?2:0,b,(i+1<n_)?8+hm:hm,(i+1<n_)?cb_+((i+1)%nf_):15-c); }
  asm volatile("s_waitcnt vmcnt(0)":::"memory"); __syncthreads();
  if(wave==0&&mk_lane()==0) __hip_atomic_fetch_add(cnt,1u,__ATOMIC_RELAXED,__HIP_MEMORY_SCOPE_AGENT);
  #define QBSEL(i_) ((((i_)&3)==0)?15-c:((((i_)&3)==1)?8+c:((((i_)&3)==2)?7-c:c)))
  { const int n_=(MK_REPEAT_PHASE==20?8:4); for(int ii=0;ii<n_;++ii) attn_unit<THRL,0>(b,hm,QBSEL(ii),ws,lds,wave,qr,true,true,(ii+1<n_)?0:1,b,(ii+1<n_)?hm:8+hm,QBSEL(ii+1)); }
  if(wave==0&&mk_lane()==0){ unsigned sp=0; while(__hip_atomic_load(cnt,__ATOMIC_RELAXED,__HIP_MEMORY_SCOPE_AGENT)<(unsigned)G){ __builtin_amdgcn_s_sleep(2); if(++sp>(1u<<22))break; }
    __builtin_amdgcn_fence(__ATOMIC_ACQUIRE,"agent"); asm volatile("s_waitcnt vmcnt(0)":::"memory"); }
  __syncthreads();
  { const int n_=(MK_REPEAT_PHASE==21?8:4); for(int ii=0;ii<n_;++ii) attn_unit<THRL,1>(b,8+hm,QBSEL(ii),ws,lds,wave,qr,true,ii+1<n_,1,b,8+hm,QBSEL(ii+1)); }
  #undef QBSEL
}
#undef SBAR
#undef WAIT_BAR
}

struct Frame {
    LAS unsigned char* lds;
    volatile LAS unsigned* MISC;
    gu32* ctl;
    int wave;
    int vcu, G;
    const float *x, *attn_norm, *w_in, *moba_norm, *dil_norm, *w_out, *ffn_norm, *w_gate, *w_up, *w_down, *final_norm;
    float* out;
    bf16 *Wqkv_t, *Wo_t, *Wgu_t, *Wd_t;
    bf16 *QO, *KB, *VB, *XN, *OB; unsigned char *HB, *XN8;
    float *rope, *kpart, *ssqa, *ssq1, *ssq2;
};

__device__ __forceinline__ float wave_sum(float v) {
#pragma unroll
    for (int o = 1; o < 64; o <<= 1) v += __shfl_xor(v, o);
    return v;
}
__device__ __forceinline__ int qkv_vrow(int n) { const int part = n >> 10, head = (n >> 6) & 15, d = n & 63; return 256 * (part * 4 + (head >> 2)) + 128 * (d >> 5) + 32 * (head & 3) + (d & 31); }
template <int MODE>
__device__ __forceinline__ void p0_item(const float* W, int K, int N, bf16* WT, const float* g0, const float* g1, LAS float* scr, int item, int lane) {
    const int nblk = N / 32, kb = item / nblk, nb = item % nblk, k0 = 64 * kb, n0 = 32 * nb;
#pragma unroll 8
    for (int i = 0; i < 32; ++i) { const int kk = 2 * i + (lane >> 5), k = k0 + kk; float w = W[(size_t)k * N + n0 + (lane & 31)];
        if (MODE == 1) w *= (k < 512 ? g0[k] : g1[k - 512]);
        if (MODE == 2 || MODE == 3) w *= g0[k];
        scr[kk * 33 + (lane & 31)] = w; }
    LDS_WAIT(); asm volatile("" ::: "memory");
    const int c = lane & 7;
#pragma unroll
    for (int j = 0; j < 4; ++j) { const int n = (lane >> 3) + 8 * j; const LAS float* s = scr + (8 * c) * 33 + n;
        const int ns = n0 + n; int dr;
        if (MODE == 0) dr = qkv_vrow(ns); else if (MODE == 2) dr = 256 * (ns >> 7) + (ns & 127); else if (MODE == 3) dr = 256 * (ns >> 7) + 128 + (ns & 127); else dr = ns;
        bool f8 = MODE >= 1; size_t base8 = 0;
        if (MODE == 0) {
            const int pn = dr >> 8, lo = dr & 255; f8 = !(pn < 8 && (pn & 3) < 2);
            dr = (f8 ? (pn < 8 ? ((pn & 1) + 2 * (pn >> 2)) : pn - 4) : ((pn & 1) + 2 * (pn >> 2))) * 256 + lo; base8 = (size_t)QKV8_OFF; }
        if (f8) {
            const pg8::f32x4 a = {s[0 * 33], s[1 * 33], s[2 * 33], s[3 * 33]}, b = {s[4 * 33], s[5 * 33], s[6 * 33], s[7 * 33]};
            *(GAS pg8::u32x2*)((unsigned char*)WT + base8 + (size_t)dr * K + k0 + 8 * c) = pg8::pack8_fp8(a * pg8::F8_SW, b * pg8::F8_SW);
        } else {
            v4u o; o.x = pk2(s[0 * 33], s[1 * 33]); o.y = pk2(s[2 * 33], s[3 * 33]); o.z = pk2(s[4 * 33], s[5 * 33]); o.w = pk2(s[6 * 33], s[7 * 33]);
            *(GAS v4u*)(WT + (size_t)dr * K + k0 + 8 * c) = o; } }
    LDS_WAIT(); asm volatile("" ::: "memory");
}
template <int R>
__device__ __forceinline__ void rms_rows_to_bf16(Frame& F, const float* xrow, const float* gain, bf16* orow, unsigned char* orow8, float* rn) {
    const GAS f32x4* xr = (const GAS f32x4*)xrow + mk_lane(); const GAS f32x4* gr = (const GAS f32x4*)gain + mk_lane();
    f32x4 v[R][4]; float s[R];
#pragma unroll
    for (int r = 0; r < R; ++r)
#pragma unroll
        for (int j = 0; j < 4; ++j) v[r][j] = __builtin_nontemporal_load(xr + r * 256 + 64 * j);
#pragma unroll
    for (int r = 0; r < R; ++r) { s[r] = 0.f;
#pragma unroll
        for (int j = 0; j < 4; ++j) s[r] += (v[r][j].x * v[r][j].x + v[r][j].y * v[r][j].y) + (v[r][j].z * v[r][j].z + v[r][j].w * v[r][j].w); }
#pragma unroll
    for (int o = 1; o < 64; o <<= 1)
#pragma unroll
        for (int r = 0; r < R; ++r) s[r] += __shfl_xor(s[r], o);
    const int ln_ = mk_lane(); GAS unsigned long long* o8 = (GAS unsigned long long*)orow + ln_; GAS unsigned* q8 = (GAS unsigned*)orow8 + ln_;
#pragma unroll
    for (int r = 0; r < R; ++r) { const float rms = sqrtf(s[r] * (1.f / D) + RMS_EPS), rstd = 1.f / rms; if (ln_ == 0) rn[r] = rms;
#pragma unroll
        for (int j = 0; j < 4; ++j) { const f32x4 g = gr[64 * j];
            const f32x4 y = v[r][j] * rstd * g;
            o8[r * 256 + 64 * j] = (unsigned long long)pk2(y.x, y.y) | ((unsigned long long)pk2(y.z, y.w) << 32);
            unsigned t = 0; t = __builtin_amdgcn_cvt_pk_fp8_f32(y.x * pg8::F8_SA, y.y * pg8::F8_SA, t, false); t = __builtin_amdgcn_cvt_pk_fp8_f32(y.z * pg8::F8_SA, y.w * pg8::F8_SA, t, true); q8[r * 256 + 64 * j] = t; } }
}
__device__ __forceinline__ void p0_prologue(Frame& F) {
    LAS float* scr = (LAS float*)(F.lds + RING_OFF + F.wave * 16384);
    const int gw = F.vcu * NWAVES + F.wave, NGW = F.G * NWAVES;
    constexpr int I_IN = (D / 64) * (NQKV / 32), I_O = (D / 64) * (D / 32), I_G = (D / 64) * (FF / 32), I_D = (FF / 64) * (D / 32);
    constexpr int NITEMS = I_IN + I_O + 2 * I_G + I_D;
    for (int it = gw; it < NITEMS; it += NGW) {
        int r = it;
        if (r < I_IN) { p0_item<0>(F.w_in, D, NQKV, F.Wqkv_t, nullptr, nullptr, scr, r, mk_lane()); continue; } r -= I_IN;
        if (r < I_O) { p0_item<1>(F.w_out, D, D, F.Wo_t, F.moba_norm, F.dil_norm, scr, r, mk_lane()); continue; } r -= I_O;
        if (r < I_G) { p0_item<2>(F.w_gate, D, FF, F.Wgu_t, F.ffn_norm, nullptr, scr, r, mk_lane()); continue; } r -= I_G;
        if (r < I_G) { p0_item<3>(F.w_up, D, FF, F.Wgu_t, F.ffn_norm, nullptr, scr, r, mk_lane()); continue; } r -= I_G;
        p0_item<4>(F.w_down, FF, D, F.Wd_t, nullptr, nullptr, scr, r, mk_lane());
    }
    for (int e = (F.vcu * NWAVES * 64) + F.wave * 64 + mk_lane(); e < SEQ * 32; e += F.G * NWAVES * 64) {
        const int s = e >> 5, j = e & 31;
        const float invf = __builtin_amdgcn_exp2f(-(float)j * (13.287712379549449f / 32.0f));
        double rev = (double)s * (double)invf * 0.15915494309189535; rev -= __builtin_floor(rev);
        const float r = (float)rev;
        pg8::f32x2 cs; cs.x = __builtin_amdgcn_cosf(r); cs.y = __builtin_amdgcn_sinf(r);
        *(GAS pg8::f32x2*)((pg8::f32x2*)F.rope + e) = cs;
    }
    for (int m = 4 * gw; m < M; m += 4 * NGW) rms_rows_to_bf16<4>(F, F.x + (size_t)m * D, F.attn_norm, F.XN + (size_t)m * D, F.XN8 + (size_t)m * D, (float*)(F.kpart + 131072) + m);
}

__device__ __forceinline__ void p6_final(Frame& F) {
    const int gw = F.vcu * NWAVES + F.wave, NGW = F.G * NWAVES;
    const GAS f32x4* gr = (const GAS f32x4*)F.final_norm + mk_lane();
    for (int m = gw; m < M; m += NGW) {
        GAS f32x4* xr = (GAS f32x4*)(F.out + (size_t)m * D) + mk_lane();
        const GAS f32x4* sp = (const GAS f32x4*)(F.ssq2 + (size_t)m * 16);
        const f32x4 a = sp[0], b = sp[1], c = sp[2], d = sp[3];
        const float ss = ((a.x + a.y) + (a.z + a.w)) + ((b.x + b.y) + (b.z + b.w)) + ((c.x + c.y) + (c.z + c.w)) + ((d.x + d.y) + (d.z + d.w));
        const float rstd = 1.f / sqrtf(ss * (1.f / D) + RMS_EPS);
#pragma unroll
        for (int j = 0; j < 4; ++j) { const f32x4 v = xr[64 * j], g = gr[64 * j]; xr[64 * j] = v * rstd * g; }
    }
}

struct Args { const float* in[11]; float* out; unsigned char* ws; int ph_lo, ph_hi, li, pad; };
__global__ void __launch_bounds__(NWAVES * 64, 2) mk_fwd(Args args) {
    extern __shared__ __attribute__((aligned(16))) unsigned char lds[];
    Frame F;
    F.lds = (LAS unsigned char*)lds;
    F.MISC = (volatile LAS unsigned*)(F.lds + MISC_OFF);
    F.wave = __builtin_amdgcn_readfirstlane((int)(threadIdx.x >> 6));
    F.G = gridDim.x; { const int bx = blockIdx.x; F.vcu = (F.G % 8 == 0) ? (bx % 8) * (F.G / 8) + bx / 8 : bx; }
#define GRID_BAR(seam) do { if (N_LAUNCHES == PER_PHASE) { if ((F.wave == 0 && mk_lane() == 0)) __hip_atomic_store(F.ctl + CW_TMO, 0xBADBA0u | (unsigned)(seam), RLX_AGENT); } \
    else { xcd_barrier(bar, F.wave); if (MK_REPEAT_PHASE == 30) xcd_barrier(bar, F.wave); } } while (0)
    unsigned char* ws = args.ws;
    F.ctl = (gu32*)(ws + WS_CTL);
    F.x = args.in[0]; F.attn_norm = args.in[1]; F.w_in = args.in[2]; F.moba_norm = args.in[3]; F.dil_norm = args.in[4]; F.w_out = args.in[5];
    F.ffn_norm = args.in[6]; F.w_gate = args.in[7]; F.w_up = args.in[8]; F.w_down = args.in[9]; F.final_norm = args.in[10]; F.out = args.out;
    F.Wqkv_t = (bf16*)(ws + WS_WQKV); F.Wo_t = (bf16*)(ws + WS_WO); F.Wgu_t = (bf16*)(ws + WS_WGU); F.Wd_t = (bf16*)(ws + WS_WD);
    F.QO = (bf16*)(ws + WS_QO); F.KB = (bf16*)(ws + WS_K); F.VB = (bf16*)(ws + WS_V); F.HB = ws + WS_H; F.XN8 = ws + WS_XN8; F.XN = (bf16*)(ws + WS_XN); F.OB = (bf16*)(ws + WS_O);
    F.rope = (float*)(ws + WS_ROPE); F.kpart = (float*)(ws + WS_KPART); F.ssqa = (float*)(ws + WS_SSQA); F.ssq1 = (float*)(ws + WS_SSQ1); F.ssq2 = (float*)(ws + WS_SSQ2);
    for (int u = F.wave * 64 + mk_lane(); u < (LDS_BYTES - LDSCTL_OFF) / 4; u += NWAVES * 64) ((LAS unsigned*)(F.lds + LDSCTL_OFF))[u] = 0u;
    __syncthreads();
    XcdBarrier bar; bar.bar = (unsigned*)(F.ctl + CW_BAR); bar.x = 0; bar.st = nullptr;
    if (N_LAUNCHES != PER_PHASE) bar = xcd_barrier_post((unsigned*)(F.ctl + CW_BAR), F.MISC + 8, F.wave);
    const int lo = args.ph_lo, hi = args.ph_hi;
#define IN(k) (lo <= (k) && (k) < hi)
#define BOTH(k) (IN(k) && IN((k) + 1))

    if (IN(0)) { for (int rp = 0; rp < (MK_REPEAT_PHASE == 0 ? 2 : 1); ++rp) p0_prologue(F); if (BOTH(0)) GRID_BAR(0); }

    if (IN(1)) {
        { pg8::Gemm g{F.XN, F.Wqkv_t, M, 1024, D}; pg8::StaticOrder S; S.init(M, 1024, F.G, (int)blockIdx.x, MK_REPEAT_PHASE == 1 ? 2 : 1);
          pg8::EpiQKV E{F.QO, (size_t)(WS_K - WS_QO) / 2, F.rope, F.kpart, QSCALE, 1, 1.f};
          pg8::gemm_phase<pg8::EpiQKV, pg8::StaticOrder, true, true>(F.lds + RING_OFF, g, S, E, F.wave); }
        { pg8::Gemm g{(const bf16*)F.XN8, (const bf16*)((const unsigned char*)F.Wqkv_t + QKV8_OFF), M, 2048, D}; pg8::StaticOrder S; S.init(M, 2048, F.G, (int)blockIdx.x, MK_REPEAT_PHASE == 1 ? 2 : 1);
          pg8::EpiQKV E{F.QO, (size_t)(WS_K - WS_QO) / 2, F.rope, F.kpart, QSCALE, 2, 1.f / (pg8::F8_SA * pg8::F8_SW)};
          pg8::gemm_phase<pg8::EpiQKV, pg8::StaticOrder, true, true, true>(F.lds + RING_OFF, g, S, E, F.wave); }
        if (BOTH(1)) GRID_BAR(1);
    }

    if (IN(2)) {
        if (F.G == 256) {
            for (int rp = 0; rp < (MK_REPEAT_PHASE == 2 ? 2 : 1); ++rp) attn_body::attn_phase<8>((char*)lds + RING_OFF, ws, (unsigned*)(F.ctl + CW_FAR), F.vcu, F.G, F.wave);
        }
        if (BOTH(2)) GRID_BAR(2);
    }

    if (IN(3)) {
        pg8::Gemm g{(const bf16*)(ws + WS_O8), F.Wo_t, M, D, D};   pg8::StaticOrder S; S.init(M, D, F.G, (int)blockIdx.x, MK_REPEAT_PHASE == 3 ? 2 : 1);
        pg8::EpiWo E{F.kpart + 131072, F.attn_norm, F.XN, (MK_REPEAT_PHASE == 3) ? (bf16*)(ws + 394 * MiB) : F.XN, (MK_REPEAT_PHASE == 3) ? ws + 458 * MiB : F.XN8, F.ssqa, F.ssq1};
        pg8::gemm_phase<pg8::EpiWo, pg8::StaticOrder, true, true, true>(F.lds + RING_OFF, g, S, E, F.wave);
        if (BOTH(3)) GRID_BAR(3);
    }

    if (IN(4)) {
        pg8::Gemm g{(const bf16*)((MK_REPEAT_PHASE == 3) ? ws + 458 * MiB : F.XN8), F.Wgu_t, M, NGU, D}; pg8::StaticOrder S; S.init(M, NGU, F.G, (int)blockIdx.x, MK_REPEAT_PHASE == 4 ? 2 : 1);
        pg8::EpiGU E{F.ssq1, F.HB};
        if (MK_REPEAT_PHASE == 40) { S.r1 = 6; pg8::gemm_phase<pg8::EpiGU, pg8::StaticOrder, true, true, true>(F.lds + RING_OFF, g, S, E, F.wave); GRID_BAR(9); S.r0 = 6; S.r1 = 1 << 30; }
        pg8::gemm_phase<pg8::EpiGU, pg8::StaticOrder, true, true, true>(F.lds + RING_OFF, g, S, E, F.wave);
        if (BOTH(4)) GRID_BAR(4);
    }

    if (IN(5)) {
        pg8::Gemm g{(const bf16*)F.HB, F.Wd_t, M, D, FF};   pg8::StaticOrder S; S.init(M, D, F.G, (int)blockIdx.x, MK_REPEAT_PHASE == 5 ? 2 : 1);
#if defined(MK_SPLIT_FINAL)
        pg8::EpiDown E{F.XN, F.out, F.ssq2};
        pg8::gemm_phase<pg8::EpiDown, pg8::StaticOrder, true, true, true>(F.lds + RING_OFF, g, S, E, F.wave);
        if (BOTH(5)) GRID_BAR(5);
#else
        if (F.G == 256) { pg8::EpiDownNorm E{(MK_REPEAT_PHASE == 3) ? (bf16*)(ws + 394 * MiB) : F.XN, F.out, F.ssq2, (unsigned*)(F.ctl + CW_PANEL), F.final_norm};
            pg8::gemm_phase<pg8::EpiDownNorm, pg8::StaticOrder, true, true, true>(F.lds + RING_OFF, g, S, E, F.wave); }
        else { pg8::EpiDown E{F.XN, F.out, F.ssq2}; pg8::gemm_phase<pg8::EpiDown, pg8::StaticOrder, true, true, true>(F.lds + RING_OFF, g, S, E, F.wave); GRID_BAR(5); p6_final(F); }
#endif
    }

#if defined(MK_SPLIT_FINAL)
    if (IN(6)) { p6_final(F); }
#endif
#undef IN
#undef BOTH
}

extern "C" void kernel_launch(void* const* d_in, const int* in_sizes, int n_in, void* d_out, int out_size, void* d_ws, size_t ws_size, hipStream_t stream) {
    static int grid = 0;
    if (grid == 0) {
        if (n_in != 11 || in_sizes[0] != M * D || out_size != M * D || ws_size < WS_END) { fprintf(stderr, "kernel_launch: unexpected shapes (n_in %d, in0 %d, out %d, ws %zu); nothing launched\n", n_in, n_in > 0 ? in_sizes[0] : -1, out_size, ws_size); grid = -1; return; }
        int dev = 0, cus = 0, per_cu = 0;
        if (hipGetDevice(&dev) != hipSuccess || hipDeviceGetAttribute(&cus, hipDeviceAttributeMultiprocessorCount, dev) != hipSuccess) { grid = -1; return; }
        if (hipFuncSetAttribute((const void*)mk_fwd, hipFuncAttributeMaxDynamicSharedMemorySize, LDS_BYTES) != hipSuccess) { fprintf(stderr, "kernel_launch: hipFuncSetAttribute failed\n"); grid = -1; return; }
        if (hipOccupancyMaxActiveBlocksPerMultiprocessor(&per_cu, (const void*)mk_fwd, NWAVES * 64, LDS_BYTES) != hipSuccess || per_cu < 1) { fprintf(stderr, "kernel_launch: occupancy query says %d blocks per CU\n", per_cu); (void)hipGetLastError(); per_cu = 1; }
        grid = cus;
        if (grid > 256) grid = 256;
    }
    if (grid < 0) return;
    if (hipMemsetAsync((char*)d_ws + WS_CTL, 0, CTL_ZERO_BYTES, stream) != hipSuccess) { fprintf(stderr, "kernel_launch: hipMemsetAsync failed\n"); return; }
    Args a{};
    for (int i = 0; i < 11; ++i) a.in[i] = (const float*)d_in[i];
    a.out = (float*)d_out; a.ws = (unsigned char*)d_ws;
    for (int li = 0; li < N_LAUNCHES; ++li) {
        a.ph_lo = (N_LAUNCHES == PER_PHASE) ? li : 0; a.ph_hi = (N_LAUNCHES == PER_PHASE) ? li + 1 : PER_PHASE; a.li = li;
        hipLaunchKernelGGL(mk_fwd, dim3(grid), dim3(NWAVES * 64), LDS_BYTES, stream, a);
        const hipError_t le = hipPeekAtLastError();
        if (le != hipSuccess) { fprintf(stderr, "kernel_launch: launch %d failed: %s\n", li, hipGetErrorName(le)); break; }
    }
}
```

```cpp
#include <hip/hip_runtime.h>
#include <cstdio>
#include <cstdint>
namespace pg8 {
#define PG8_LAS __attribute__((address_space(3)))
typedef unsigned short bf16_t;
typedef short bf16x8 __attribute__((ext_vector_type(8)));
typedef float f32x4 __attribute__((ext_vector_type(4)));
typedef unsigned u32x4 __attribute__((ext_vector_type(4)));
typedef int i32x4 __attribute__((ext_vector_type(4)));
typedef int i32x8 __attribute__((ext_vector_type(8)));
typedef unsigned u32x2 __attribute__((ext_vector_type(2)));
constexpr int BM = 256, BK = 64, HALF = 128, HTB = HALF * BK * 2  , STAGE_BYTES = 8 * HTB, NXCD = 8, WGM = 8;

__host__ __device__ __forceinline__ int lds_byte(int r, int c) { const int st = (r >> 4) * 2 + (c >> 5), rr = r & 15, cc = c & 31, ob = rr * 64 + cc * 2; return st * 1024 + (ob ^ (((ob >> 9) & 1) << 5)); }
__host__ __device__ __forceinline__ void stage_rc(int b, int& R, int& C) { const int st = b / 1024, sb = b % 1024, swz = sb ^ (((sb >> 9) & 1) << 5); R = (st >> 1) * 16 + swz / 64; C = (st & 1) * 32 + (swz % 64) / 2; }
__host__ __device__ __forceinline__ int perm32(int rho) { const int n = rho >> 4, i = rho & 15; return 8 * (i >> 2) + 4 * n + (i & 3); }

struct Unit { int pm, pn; };
struct Gemm { const bf16_t* A; const bf16_t* Bt; int M, N, K; };

struct StaticOrder {
    int nM, nN, nwg, G, c, reps, r0 = 0, r1 = 1 << 30;
    __host__ __device__ void init(int M, int N, int G_, int c_, int reps_ = 1) { nM = M / BM; nN = N / BM; nwg = nM * nN; G = G_; c = c_; reps = reps_; }
    __host__ __device__ bool next(int i, Unit& u) const {
        const int rounds = (nwg + G - 1) / G; i += r0; if (i >= reps * rounds || i >= r1) return false;
        const long L = (long)(i % rounds) * G + c; if (L >= nwg) return false;
        int wgid = (int)L; { const int q = nwg / NXCD, r = nwg % NXCD, xcd = wgid % NXCD, off = wgid / NXCD; wgid = (xcd < r ? xcd * (q + 1) : r * (q + 1) + (xcd - r) * q) + off; }
        const int nig = WGM * nN, gid = wgid / nig, fm = gid * WGM, gsz = (nM - fm) < WGM ? (nM - fm) : WGM;
        u.pm = fm + ((wgid % nig) % gsz); u.pn = (wgid % nig) / gsz; return true;
    }
    __device__ __forceinline__ void a_ready(const Unit&) const {}
    __device__ __forceinline__ void done(const Unit&) const {}
};


__device__ __forceinline__ unsigned cvt_pk_bf16(float lo, float hi) { unsigned r; asm volatile("v_cvt_pk_bf16_f32 %0, %1, %2" : "=v"(r) : "v"(lo), "v"(hi)); return r; }
__device__ __forceinline__ u32x4 pack8(const f32x4 a, const f32x4 b) { u32x4 w; w.x = cvt_pk_bf16(a[0], a[1]); w.y = cvt_pk_bf16(a[2], a[3]); w.z = cvt_pk_bf16(b[0], b[1]); w.w = cvt_pk_bf16(b[2], b[3]); return w; }
__device__ __forceinline__ float sum4(const f32x4 a) { return (a[0] + a[1]) + (a[2] + a[3]); }
__device__ __forceinline__ float sq4(const f32x4 a) { return (a[0] * a[0] + a[1] * a[1]) + (a[2] * a[2] + a[3] * a[3]); }
constexpr float RMS_EPS_F = 1e-6f;
__device__ __forceinline__ int lane_id() { int l; asm volatile("v_mbcnt_lo_u32_b32 %0, -1, 0\n\tv_mbcnt_hi_u32_b32 %0, -1, %0" : "=v"(l)); return l; }
__device__ __forceinline__ u32x2 pack8_fp8(const f32x4 a, const f32x4 b) { u32x2 w; unsigned t = 0;
    t = __builtin_amdgcn_cvt_pk_fp8_f32(a[0], a[1], t, false); t = __builtin_amdgcn_cvt_pk_fp8_f32(a[2], a[3], t, true); w.x = t; t = 0;
    t = __builtin_amdgcn_cvt_pk_fp8_f32(b[0], b[1], t, false); t = __builtin_amdgcn_cvt_pk_fp8_f32(b[2], b[3], t, true); w.y = t; return w; }
constexpr float F8_SA = 16.f, F8_SH = 8.f, F8_SW = 512.f, F8_SO = 64.f;
typedef float f32x2 __attribute__((ext_vector_type(2)));

struct EpiQKV {
    static constexpr bool PERM = true, AFTER_DRAIN = false, HAS_MID = false;
    bf16_t* Q; size_t part_stride; const float* rope; float* kpart; float qscale; int mapsel; float ascale;
    __device__ __forceinline__ void operator()(const f32x4 (&acc)[2][2][4][2], const Unit& u, int wr, int wc, int fr_, int fq_) const {
        const int ln_ = lane_id(), fr = ln_ & 15, fq = ln_ >> 4;
        const int rp = mapsel == 1 ? ((u.pn & 1) + 4 * (u.pn >> 1)) : (mapsel == 2 ? (u.pn < 4 ? (2 + (u.pn & 1) + 4 * (u.pn >> 1)) : u.pn + 4) : u.pn);
        const int part = rp >> 2, head = (rp & 3) * 4 + wc;
        bf16_t* base = Q + (size_t)part * part_stride + head * 64 + 8 * fq;
        const float sc = part == 0 ? qscale : 1.f;
        const bool rot = part != 2, km = (part == 1) && (head < 8);
        const int row0 = u.pm * BM + wr * 64 + fr;
        int rbase = row0; asm volatile("" : "+v"(rbase));
        f32x4 ks[2][2];
#pragma unroll
        for (int a = 0; a < 2; ++a)
#pragma unroll
            for (int b = 0; b < 2; ++b) ks[a][b] = (f32x4){0.f, 0.f, 0.f, 0.f};
#pragma unroll
        for (int ai = 0; ai < 2; ++ai)
#pragma unroll
            for (int m = 0; m < 4; ++m) {
                const int row = rbase + ai * HALF + m * 16;
                const int s = row & 4095;
                const f32x4* rp = (const f32x4*)(rope + ((size_t)s * 32 + 8 * fq) * 2);
                f32x4 t0, t1, t2, t3;
                if (rot) { t0 = rp[0]; t1 = rp[1]; t2 = rp[2]; t3 = rp[3]; } else { t0 = t1 = t2 = t3 = (f32x4){1.f, 0.f, 1.f, 0.f}; }
                f32x4 o1[2], o2[2];
#pragma unroll
                for (int n = 0; n < 2; ++n) {
                    const f32x4 cv = n == 0 ? (f32x4){t0[0], t0[2], t1[0], t1[2]} : (f32x4){t2[0], t2[2], t3[0], t3[2]};
                    const f32x4 sv = n == 0 ? (f32x4){t0[1], t0[3], t1[1], t1[3]} : (f32x4){t2[1], t2[3], t3[1], t3[3]};
                    const f32x4 x1 = acc[ai][0][m][n] * ascale, x2 = acc[ai][1][m][n] * ascale;
                    o1[n] = x1 * cv - x2 * sv; o2[n] = x2 * cv + x1 * sv;
                    if (km) { ks[0][n] += o1[n]; ks[1][n] += o2[n]; }
                    o1[n] = o1[n] * sc; o2[n] = o2[n] * sc;
                }
                bf16_t* rowp = base + (size_t)row * 1024;
                *(u32x4*)(rowp) = pack8(o1[0], o1[1]); *(u32x4*)(rowp + 32) = pack8(o2[0], o2[1]);
            }
        if (km) {
#pragma unroll
            for (int bj = 0; bj < 2; ++bj)
#pragma unroll
                for (int n = 0; n < 2; ++n) { f32x4 v = ks[bj][n];
#pragma unroll
                    for (int o = 1; o < 16; o <<= 1) { v[0] += __shfl_xor(v[0], o); v[1] += __shfl_xor(v[1], o); v[2] += __shfl_xor(v[2], o); v[3] += __shfl_xor(v[3], o); }
                    if (fr == 0) *(f32x4*)(kpart + (size_t)(u.pm * 2 + wr) * 512 + head * 64 + 32 * bj + 8 * fq + 4 * n) = v; }
        }
    }
};

struct EpiWo {
    static constexpr bool PERM = true, AFTER_DRAIN = false, HAS_MID = true;
    const float* rn0; const float* gain0; bf16_t* xn; bf16_t* xo; unsigned char* xn8;
    const float* ssq_att; float* ssq1;
    __device__ __forceinline__ void rstds(int row, int fq, float& rm, float& rd) const {
        const float s = sum4(*(const f32x4*)(ssq_att + (size_t)row * 16 + 4 * fq));
        const float t = s + __shfl_xor(s, 16), o = __shfl_xor(t, 32);
        rm = __builtin_amdgcn_rsqf((fq < 2 ? t : o) * (1.f / 512.f) + RMS_EPS_F);
        rd = __builtin_amdgcn_rsqf((fq < 2 ? o : t) * (1.f / 512.f) + RMS_EPS_F);
    }
    static constexpr float ASCALE = 1.f / (F8_SO * F8_SW);
    __device__ __forceinline__ void mid(f32x4 (&acc)[2][2][4][2], const Unit& u, int wr, int fr_) const {
        const int ln_ = lane_id(), fr = ln_ & 15, fq = ln_ >> 4;
        const int row0 = u.pm * BM + wr * 64 + fr;
        int rbase = row0; asm volatile("" : "+v"(rbase));
        float f[8];
#pragma unroll
        for (int i = 0; i < 8; ++i) { float rm, rd; rstds(rbase + (i >> 2) * HALF + (i & 3) * 16, fq, rm, rd); f[i] = rm / rd; }
#pragma unroll
        for (int ai = 0; ai < 2; ++ai)
#pragma unroll
            for (int m = 0; m < 4; ++m)
#pragma unroll
                for (int bj = 0; bj < 2; ++bj)
#pragma unroll
                    for (int n = 0; n < 2; ++n) acc[ai][bj][m][n] = acc[ai][bj][m][n] * f[ai * 4 + m];
    }
    __device__ __forceinline__ void operator()(const f32x4 (&acc)[2][2][4][2], const Unit& u, int wr, int wc, int fr_, int fq_) const {
        const int ln_ = lane_id(), fr = ln_ & 15, fq = ln_ >> 4;
        const int row0 = u.pm * BM + wr * 64 + fr, col0 = u.pn * BM + wc * 32 + 8 * fq;
        int rbase = row0; asm volatile("" : "+v"(rbase));
        f32x4 ig[2][2];
#pragma unroll
        for (int bj = 0; bj < 2; ++bj)
#pragma unroll
            for (int n = 0; n < 2; ++n) { const f32x4 g = *(const f32x4*)(gain0 + col0 + bj * HALF + 4 * n);
                ig[bj][n] = (f32x4){__builtin_amdgcn_rcpf(g[0]), __builtin_amdgcn_rcpf(g[1]), __builtin_amdgcn_rcpf(g[2]), __builtin_amdgcn_rcpf(g[3])}; }
#pragma unroll
        for (int ai = 0; ai < 2; ++ai)
#pragma unroll
            for (int m = 0; m < 4; ++m) { const int row = rbase + ai * HALF + m * 16; float rm, rd; rstds(row, fq, rm, rd); float s = 0.f; const float rn = rn0[row];
#pragma unroll
                for (int bj = 0; bj < 2; ++bj) { unsigned off = (unsigned)row * 1024u + col0 + bj * HALF; asm volatile("" : "+v"(off));
                    const u32x4 xw = __builtin_nontemporal_load((const u32x4*)(xn + off));
                    const f32x4 xa = (f32x4){__uint_as_float(xw.x << 16), __uint_as_float(xw.x & 0xffff0000u), __uint_as_float(xw.y << 16), __uint_as_float(xw.y & 0xffff0000u)} * ig[bj][0] * rn;
                    const f32x4 xb = (f32x4){__uint_as_float(xw.z << 16), __uint_as_float(xw.z & 0xffff0000u), __uint_as_float(xw.w << 16), __uint_as_float(xw.w & 0xffff0000u)} * ig[bj][1] * rn;
                    const f32x4 v0 = xa + acc[ai][bj][m][0] * (rd * ASCALE), v1 = xb + acc[ai][bj][m][1] * (rd * ASCALE);
                    *(u32x4*)(xo + off) = pack8(v0, v1); *(u32x2*)(xn8 + off) = pack8_fp8(v0 * F8_SA, v1 * F8_SA); s += sq4(v0) + sq4(v1); }
                s += __shfl_xor(s, 16); s += __shfl_xor(s, 32);
                if (fq == 0) ssq1[(size_t)row * 16 + u.pn * 4 + wc] = s;
                asm volatile("" ::: "memory"); }
    }
};

struct EpiGU {
    static constexpr bool PERM = true, AFTER_DRAIN = false, HAS_MID = false;
    const float* ssq1; unsigned char* H;
    __device__ __forceinline__ u32x2 row8(const f32x4 (&acc)[2][2][4][2], int ai, int m, int row, int fq) const {
        float ss = sum4(*(const f32x4*)(ssq1 + (size_t)row * 16 + 4 * fq));
        ss += __shfl_xor(ss, 16); ss += __shfl_xor(ss, 32);
        const float rstd = __builtin_amdgcn_rsqf(ss * (1.f / 1024.f) + RMS_EPS_F) * (1.f / (F8_SA * F8_SW));
        f32x4 h[2];
        const float rs_e = rstd * -1.4426950408889634f, rs_u = rstd * (rstd * F8_SH);
#pragma unroll
        for (int n = 0; n < 2; ++n) { const f32x4 ea = acc[ai][0][m][n] * rs_e, gu = (acc[ai][0][m][n] * acc[ai][1][m][n]) * rs_u;
#pragma unroll
            for (int i = 0; i < 4; ++i) h[n][i] = gu[i] * __builtin_amdgcn_rcpf(1.f + __builtin_amdgcn_exp2f(ea[i])); }
        return pack8_fp8(h[0], h[1]);
    }
    __device__ __forceinline__ void operator()(const f32x4 (&acc)[2][2][4][2], const Unit& u, int wr, int wc, int fr_, int fq_) const {
        const int ln_ = lane_id(), fr = ln_ & 15, fq = ln_ >> 4;
        const int row0 = u.pm * BM + wr * 64 + fr, colp = u.pn * HALF + wc * 32 + 16 * (fq >> 1);
        int rbase = row0; asm volatile("" : "+v"(rbase));
#pragma unroll
        for (int ai = 0; ai < 2; ++ai)
#pragma unroll
            for (int mp = 0; mp < 2; ++mp) { const int rowa = rbase + ai * HALF + mp * 32, rowb = rowa + 16;
                const u32x2 wa = row8(acc, ai, 2 * mp, rowa, fq), wb = row8(acc, ai, 2 * mp + 1, rowb, fq);
                const auto sx = __builtin_amdgcn_permlane16_swap(wa.x, wb.x, false, false), sy = __builtin_amdgcn_permlane16_swap(wa.y, wb.y, false, false);
                u32x4 w; w.x = sx[0]; w.y = sy[0]; w.z = sx[1]; w.w = sy[1];
                *(u32x4*)(H + (size_t)((fq & 1) ? rowb : rowa) * 2816 + colp) = w; }
    }
};

struct EpiDown {
    static constexpr bool PERM = true, AFTER_DRAIN = false, HAS_MID = false;
    const bf16_t* xn; float* out; float* ssq2;
    __device__ __forceinline__ void operator()(const f32x4 (&acc)[2][2][4][2], const Unit& u, int wr, int wc, int fr_, int fq_) const {
        const int ln_ = lane_id(), fr = ln_ & 15, fq = ln_ >> 4;
        const int row0 = u.pm * BM + wr * 64 + fr, col0 = u.pn * BM + wc * 32 + 8 * fq;
        int rbase = row0; asm volatile("" : "+v"(rbase));
#pragma unroll
        for (int ai = 0; ai < 2; ++ai)
#pragma unroll
            for (int m = 0; m < 4; ++m) { const int row = rbase + ai * HALF + m * 16; float s = 0.f;
#pragma unroll
                for (int bj = 0; bj < 2; ++bj) { const size_t off = (size_t)row * 1024 + col0 + bj * HALF;
                    const u32x4 xw = __builtin_nontemporal_load((const u32x4*)(xn + off));
                    const f32x4 xa = {__uint_as_float(xw.x << 16), __uint_as_float(xw.x & 0xffff0000u), __uint_as_float(xw.y << 16), __uint_as_float(xw.y & 0xffff0000u)};
                    const f32x4 xb = {__uint_as_float(xw.z << 16), __uint_as_float(xw.z & 0xffff0000u), __uint_as_float(xw.w << 16), __uint_as_float(xw.w & 0xffff0000u)};
                    const f32x4 v0 = xa + acc[ai][bj][m][0] * (1.f / (F8_SH * F8_SW)), v1 = xb + acc[ai][bj][m][1] * (1.f / (F8_SH * F8_SW));
                    *(f32x4*)(out + off) = v0; *(f32x4*)(out + off + 4) = v1; s += sq4(v0) + sq4(v1); }
                s += __shfl_xor(s, 16); s += __shfl_xor(s, 32);
                if (fq == 0) ssq2[(size_t)row * 16 + u.pn * 4 + wc] = s;
                asm volatile("" ::: "memory"); }
    }
};

struct EpiDownNorm {
    static constexpr bool PERM = true, AFTER_DRAIN = false, HAS_MID = false;
    const bf16_t* xn; float* out; float* ssq2; unsigned* cnt; const float* gain;
    __device__ __forceinline__ void operator()(f32x4 (&acc)[2][2][4][2], const Unit& u, int wr, int wc, int fr_, int fq_) const {
        const int ln_ = lane_id(), fr = ln_ & 15, fq = ln_ >> 4;
        const int row0 = u.pm * BM + wr * 64 + fr, col0 = u.pn * BM + wc * 32 + 8 * fq;
        int rbase = row0; asm volatile("" : "+v"(rbase));
#pragma unroll
        for (int ai = 0; ai < 2; ++ai)
#pragma unroll
            for (int m = 0; m < 4; ++m) { const int row = rbase + ai * HALF + m * 16; float s = 0.f;
#pragma unroll
                for (int bj = 0; bj < 2; ++bj) { const size_t off = (size_t)row * 1024 + col0 + bj * HALF;
                    const u32x4 xw = __builtin_nontemporal_load((const u32x4*)(xn + off));
                    const f32x4 xa = {__uint_as_float(xw.x << 16), __uint_as_float(xw.x & 0xffff0000u), __uint_as_float(xw.y << 16), __uint_as_float(xw.y & 0xffff0000u)};
                    const f32x4 xb = {__uint_as_float(xw.z << 16), __uint_as_float(xw.z & 0xffff0000u), __uint_as_float(xw.w << 16), __uint_as_float(xw.w & 0xffff0000u)};
                    acc[ai][bj][m][0] = acc[ai][bj][m][0] * (1.f / (F8_SH * F8_SW)) + xa; acc[ai][bj][m][1] = acc[ai][bj][m][1] * (1.f / (F8_SH * F8_SW)) + xb; s += sq4(acc[ai][bj][m][0]) + sq4(acc[ai][bj][m][1]); }
                s += __shfl_xor(s, 16); s += __shfl_xor(s, 32);
                if (fq == 0) __hip_atomic_store(ssq2 + (size_t)(u.pn * 4 + wc) * 32768 + row, s, __ATOMIC_RELAXED, __HIP_MEMORY_SCOPE_AGENT);
                asm volatile("" ::: "memory"); }
        asm volatile("s_waitcnt vmcnt(0)" ::: "memory");
        unsigned* cw = cnt + 64 * u.pm;
        if (fr == 0 && fq == 0) __hip_atomic_fetch_add(cw, 1u, __ATOMIC_RELAXED, __HIP_MEMORY_SCOPE_AGENT);
        { unsigned sp = 0; while ((unsigned)__builtin_amdgcn_readfirstlane((int)__hip_atomic_load(cw, __ATOMIC_RELAXED, __HIP_MEMORY_SCOPE_AGENT)) < 32u) { __builtin_amdgcn_s_sleep(1); if (++sp > (1u << 22)) break; } }
        f32x4 g[2][2];
#pragma unroll
        for (int bj = 0; bj < 2; ++bj) { g[bj][0] = *(const f32x4*)(gain + col0 + bj * HALF); g[bj][1] = *(const f32x4*)(gain + col0 + bj * HALF + 4); }
#pragma unroll
        for (int ai = 0; ai < 2; ++ai)
#pragma unroll
            for (int m = 0; m < 4; ++m) { const int row = rbase + ai * HALF + m * 16;
                const float* pp = ssq2 + (size_t)(4 * fq) * 32768 + row;
                float s = (__hip_atomic_load(pp, __ATOMIC_RELAXED, __HIP_MEMORY_SCOPE_AGENT) + __hip_atomic_load(pp + 32768, __ATOMIC_RELAXED, __HIP_MEMORY_SCOPE_AGENT))
                        + (__hip_atomic_load(pp + 2 * 32768, __ATOMIC_RELAXED, __HIP_MEMORY_SCOPE_AGENT) + __hip_atomic_load(pp + 3 * 32768, __ATOMIC_RELAXED, __HIP_MEMORY_SCOPE_AGENT));
                s += __shfl_xor(s, 16); s += __shfl_xor(s, 32);
                const float rstd = __builtin_amdgcn_rsqf(s * (1.f / 1024.f) + RMS_EPS_F);
#pragma unroll
                for (int bj = 0; bj < 2; ++bj) { const size_t off = (size_t)row * 1024 + col0 + bj * HALF;
                    *(f32x4*)(out + off) = acc[ai][bj][m][0] * rstd * g[bj][0]; *(f32x4*)(out + off + 4) = acc[ai][bj][m][1] * rstd * g[bj][1]; }
                asm volatile("" ::: "memory"); }
    }
};
template <class Epi, class Sched, bool ALIGN_EPI = false, bool SP2 = false, bool F8 = false>
__device__ __forceinline__ void gemm_phase(PG8_LAS unsigned char* lds, const Gemm g, const Sched& S, const Epi& E, int wave) {
    const int wid = __builtin_amdgcn_readfirstlane(wave), lane = lane_id(), tid = wid * 64 + lane, wr = wid >> 2, wc = wid & 3, fr = lane & 15, fq = lane >> 4;
    const int K = F8 ? g.K / 2 : g.K, nt = K / BK;
    unsigned voffA[2], voffB[2];
#pragma unroll
    for (int i = 0; i < 2; ++i) { int R, C; stage_rc(tid * 16 + i * 8192, R, C); const int Rb = Epi::PERM ? ((R & ~31) + perm32(R & 31)) : R;
        voffA[i] = (unsigned)(R * K + C) * 2u; voffB[i] = (unsigned)(Rb * K + C) * 2u; }
    const unsigned kstep = (unsigned)(BK * 2);
    const unsigned hstep = (unsigned)HALF * K * 2;
    const unsigned tstep = 2 * hstep;
    const unsigned ldsw = (unsigned)wid * 1024u;
    const int aoff = lds_byte(wr * 64 + fr, fq * 8), boff = lds_byte(wc * 32 + fr, fq * 8);
#define PG8_SA(b, h) (((b) * 2 + (h)) * HTB)
#define PG8_SB(b, h) ((4 + (b) * 2 + (h)) * HTB)
    const __amdgpu_buffer_rsrc_t rsA = __builtin_amdgcn_make_buffer_rsrc((void*)g.A, 0, 0x7fffffff, 0x00020000), rsB = __builtin_amdgcn_make_buffer_rsrc((void*)g.Bt, 0, 0x7fffffff, 0x00020000);
#define PG8_STAGE(bufoff, gbase, voff) do { _Pragma("unroll") for (int _i = 0; _i < 2; ++_i) \
        __builtin_amdgcn_raw_ptr_buffer_load_lds(PG8_RS_##voff, (PG8_LAS unsigned*)(lds + (bufoff) + ldsw + _i * 8192), 16, (voff)[_i], (int)(gbase), 0, 0); } while (0)
#define PG8_RS_voffA rsA
#define PG8_RS_voffB rsB
#define PG8_LD8(base, off) __builtin_shufflevector(*(const PG8_LAS i32x4*)((base) + (off)), *(const PG8_LAS i32x4*)((base) + (off) + 1024), 0, 1, 2, 3, 4, 5, 6, 7)
#define PG8_LDA(dst, b, h) do { if constexpr (F8) { _Pragma("unroll") for (int m = 0; m < 4; ++m) dst##8[m] = PG8_LD8(abase8, PG8_SA(b, h) + m * 2048); } else { \
        _Pragma("unroll") for (int m = 0; m < 4; ++m) _Pragma("unroll") for (int k = 0; k < 2; ++k) dst[m][k] = *(const PG8_LAS bf16x8*)(lds + PG8_SA(b, h) + aoff + m * 2048 + k * 1024); } } while (0)
#define PG8_LDB(dst, b, h) do { if constexpr (F8) { _Pragma("unroll") for (int n = 0; n < 2; ++n) dst##8[n] = PG8_LD8(bbase8, PG8_SB(b, h) - PG8_SB(0, 0) + n * 2048); } else { \
        _Pragma("unroll") for (int n = 0; n < 2; ++n) _Pragma("unroll") for (int k = 0; k < 2; ++k) dst[n][k] = *(const PG8_LAS bf16x8*)(lds + PG8_SB(b, h) + boff + n * 2048 + k * 1024); } } while (0)
#define PG8_MMA(ai, bj, At, Bt) do { __builtin_amdgcn_s_setprio(1); if constexpr (F8) { _Pragma("unroll") for (int m = 0; m < 4; ++m) _Pragma("unroll") for (int n = 0; n < 2; ++n) \
        acc[ai][bj][m][n] = __builtin_amdgcn_mfma_scale_f32_16x16x128_f8f6f4(Bt##8[n], At##8[m], acc[ai][bj][m][n], 0, 0, 0, 0, 0, 0); } else \
        _Pragma("unroll") for (int m = 0; m < 4; ++m) _Pragma("unroll") for (int n = 0; n < 2; ++n) _Pragma("unroll") for (int k = 0; k < 2; ++k) \
        acc[ai][bj][m][n] = __builtin_amdgcn_mfma_f32_16x16x32_bf16(Bt[n][k], At[m][k], acc[ai][bj][m][n], 0, 0, 0); __builtin_amdgcn_s_setprio(0); } while (0)
#define PG8_WAIT_V(n) asm volatile("s_waitcnt vmcnt(" #n ")" ::: "memory")
#define PG8_WAIT_L(n) asm volatile("s_waitcnt lgkmcnt(" #n ")" ::: "memory")
#define PG8_BAR __builtin_amdgcn_s_barrier()
#define PG8_SCHED __builtin_amdgcn_sched_barrier(0)
    Unit cur, nxt; int ui = 0;
    if (!S.next(0, cur)) return;
    f32x4 acc[2][2][4][2];
#pragma unroll
    for (int a = 0; a < 2; ++a)
#pragma unroll
        for (int b = 0; b < 2; ++b)
#pragma unroll
            for (int m = 0; m < 4; ++m)
#pragma unroll
                for (int n = 0; n < 2; ++n) acc[a][b][m][n] = (f32x4){0.f, 0.f, 0.f, 0.f};
    PG8_LAS unsigned char* abase8 = lds + aoff; PG8_LAS unsigned char* bbase8 = lds + PG8_SB(0, 0) + boff;
    if constexpr (F8) { asm volatile("" : "+v"(abase8)); asm volatile("" : "+v"(bbase8)); }
    bf16x8 At[4][2], B0[2][2], B1[2][2]; i32x8 At8[4], B08[2], B18[2];
    unsigned cA = (unsigned)cur.pm * tstep, cB = (unsigned)cur.pn * tstep;
    S.a_ready(cur);
    if constexpr (SP2) {
        PG8_STAGE(PG8_SB(0, 0), cB, voffB); PG8_STAGE(PG8_SB(0, 1), cB + hstep, voffB); PG8_STAGE(PG8_SA(0, 0), cA, voffA); PG8_STAGE(PG8_SA(0, 1), cA + hstep, voffA);
        if (wr == 1) PG8_BAR;
        PG8_WAIT_V(2); PG8_BAR;
        PG8_STAGE(PG8_SB(1, 0), cB + kstep, voffB); PG8_STAGE(PG8_SA(1, 0), cA + kstep, voffA); PG8_STAGE(PG8_SB(1, 1), cB + hstep + kstep, voffB);
        PG8_WAIT_V(6); PG8_BAR;
    } else {
        PG8_STAGE(PG8_SB(0, 0), cB, voffB); PG8_STAGE(PG8_SA(0, 0), cA, voffA); PG8_STAGE(PG8_SB(0, 1), cB + hstep, voffB); PG8_STAGE(PG8_SA(0, 1), cA + hstep, voffA);
        if (wr == 1) PG8_BAR;
        PG8_WAIT_V(4); PG8_BAR;
        PG8_STAGE(PG8_SB(1, 0), cB + kstep, voffB); PG8_STAGE(PG8_SA(1, 0), cA + kstep, voffA); PG8_STAGE(PG8_SB(1, 1), cB + hstep + kstep, voffB);
        PG8_WAIT_V(6); PG8_BAR;
    }
    for (;;) {
        const bool has_next = S.next(ui + 1, nxt);
        const unsigned nA = has_next ? (unsigned)nxt.pm * tstep : cA, nB = has_next ? (unsigned)nxt.pn * tstep : cB;
#pragma nounroll
        for (int t = 0; t < nt; t += 2) {
            if constexpr (Epi::HAS_MID) { if (t == (nt >> 1)) E.mid(acc, cur, wr, fr); }
            const bool last = (t == nt - 2);
            const unsigned a1 = cA + (unsigned)(t + 1) * kstep;
            const unsigned a2 = last ? nA : cA + (unsigned)(t + 2) * kstep, b2 = last ? nB : cB + (unsigned)(t + 2) * kstep;
            const unsigned a3 = a2 + kstep, b3 = b2 + kstep;
            if (last && has_next) S.a_ready(nxt);
            if constexpr (SP2) {
            PG8_LDB(B0, 0, 0); PG8_LDB(B1, 0, 1); PG8_SCHED; PG8_LDA(At, 0, 0); PG8_STAGE(PG8_SA(1, 1), a1 + hstep, voffA);
            PG8_WAIT_V(8); PG8_WAIT_L(0); PG8_BAR; PG8_MMA(0, 0, At, B0); PG8_MMA(0, 1, At, B1); PG8_BAR; PG8_SCHED;
            PG8_LDA(At, 0, 1); PG8_STAGE(PG8_SB(0, 0), b2, voffB); PG8_STAGE(PG8_SB(0, 1), b2 + hstep, voffB); PG8_STAGE(PG8_SA(0, 0), a2, voffA);
            PG8_WAIT_V(8); PG8_WAIT_L(0); PG8_BAR; PG8_MMA(1, 0, At, B0); PG8_MMA(1, 1, At, B1); PG8_BAR; PG8_SCHED;
            PG8_LDB(B0, 1, 0); PG8_LDB(B1, 1, 1); PG8_SCHED; PG8_LDA(At, 1, 0); PG8_STAGE(PG8_SA(0, 1), a2 + hstep, voffA);
            PG8_WAIT_V(8); PG8_WAIT_L(0); PG8_BAR; PG8_MMA(0, 0, At, B0); PG8_MMA(0, 1, At, B1); PG8_BAR; PG8_SCHED;
            PG8_LDA(At, 1, 1); PG8_STAGE(PG8_SB(1, 0), b3, voffB); PG8_STAGE(PG8_SB(1, 1), b3 + hstep, voffB); PG8_STAGE(PG8_SA(1, 0), a3, voffA);
            PG8_WAIT_V(8); PG8_WAIT_L(0); PG8_BAR; PG8_MMA(1, 0, At, B0); PG8_MMA(1, 1, At, B1); PG8_BAR; PG8_SCHED;
            } else {
            PG8_LDB(B0, 0, 0); PG8_SCHED; PG8_LDA(At, 0, 0); PG8_STAGE(PG8_SA(1, 1), a1 + hstep, voffA);
            PG8_WAIT_L(8); PG8_BAR; PG8_WAIT_L(0); PG8_MMA(0, 0, At, B0); PG8_BAR; PG8_SCHED;
            PG8_LDB(B1, 0, 1); PG8_STAGE(PG8_SB(0, 0), b2, voffB);
            PG8_BAR; PG8_WAIT_L(0); PG8_MMA(0, 1, At, B1); PG8_BAR;
            PG8_LDA(At, 0, 1); PG8_STAGE(PG8_SA(0, 0), a2, voffA);
            PG8_BAR; PG8_WAIT_L(0); PG8_MMA(1, 0, At, B0); PG8_BAR; PG8_SCHED;
            PG8_STAGE(PG8_SB(0, 1), b2 + hstep, voffB);
            PG8_WAIT_V(6); PG8_BAR; PG8_MMA(1, 1, At, B1); PG8_BAR;
            PG8_LDB(B0, 1, 0); PG8_SCHED; PG8_LDA(At, 1, 0); PG8_STAGE(PG8_SA(0, 1), a2 + hstep, voffA);
            PG8_WAIT_L(8); PG8_BAR; PG8_WAIT_L(0); PG8_MMA(0, 0, At, B0); PG8_BAR; PG8_SCHED;
            PG8_LDB(B1, 1, 1); PG8_STAGE(PG8_SB(1, 0), b3, voffB);
            PG8_BAR; PG8_WAIT_L(0); PG8_MMA(0, 1, At, B1); PG8_BAR;
            PG8_LDA(At, 1, 1); PG8_STAGE(PG8_SA(1, 0), a3, voffA);
            PG8_BAR; PG8_WAIT_L(0); PG8_MMA(1, 0, At, B0); PG8_BAR; PG8_SCHED;
            PG8_STAGE(PG8_SB(1, 1), b3 + hstep, voffB);
            PG8_WAIT_V(6); PG8_BAR; PG8_MMA(1, 1, At, B1); PG8_BAR;
            }
        }
        if constexpr (ALIGN_EPI) { if (wr == 0) PG8_BAR; }
        if constexpr (!Epi::AFTER_DRAIN) { E(acc, cur, wr, wc, fr, fq); S.done(cur); }
        if (!has_next) break;
#pragma unroll
        for (int a = 0; a < 2; ++a)
#pragma unroll
            for (int b = 0; b < 2; ++b)
#pragma unroll
                for (int m = 0; m < 4; ++m)
#pragma unroll
                    for (int n = 0; n < 2; ++n) acc[a][b][m][n] = (f32x4){0.f, 0.f, 0.f, 0.f};
        cur = nxt; cA = nA; cB = nB; ++ui;
        if constexpr (ALIGN_EPI) { if (wr == 1) PG8_BAR; }
    }
    PG8_WAIT_V(0);
    if constexpr (!ALIGN_EPI) { if (wr == 0) PG8_BAR; }
    PG8_BAR;
    if constexpr (Epi::AFTER_DRAIN) { E.fused(acc, cur, wr, wc, fr, fq, lds, wid, lane); S.done(cur); }
#undef PG8_SA
#undef PG8_SB
#undef PG8_STAGE
#undef PG8_RS_voffA
#undef PG8_RS_voffB
#undef PG8_LDA
#undef PG8_LDB
#undef PG8_MMA
#undef PG8_WAIT_V
#undef PG8_WAIT_L
#undef PG8_BAR
#undef PG8_SCHED
}
}

constexpr int NWAVES = 8;
#ifndef MK_N_LAUNCHES
#define MK_N_LAUNCHES 1
#endif
constexpr int PER_PHASE = 7;
constexpr int N_LAUNCHES = MK_N_LAUNCHES;

constexpr int BATCH = 8, SEQ = 4096, D = 1024, NH = 16, HD = 64, FF = 2816, NHM = 8;
constexpr int M = BATCH * SEQ;
constexpr int NQKV = 3 * D, NGU = 2 * FF;
constexpr float RMS_EPS = 1e-6f;
constexpr float QSCALE = 0.125f * 1.4426950408889634f;

constexpr size_t MiB = 1u << 20;
constexpr size_t WS_CTL = 0, CTL_ZERO_BYTES = 64 * 1024;
constexpr size_t WS_ROPE = 1 * MiB;
constexpr size_t WS_WQKV = 2 * MiB, WS_WO = 8 * MiB, WS_WGU = 10 * MiB, WS_WD = 21 * MiB;
constexpr size_t WS_KPART = 27 * MiB;
constexpr size_t WS_SSQA = 28 * MiB, WS_SSQ1 = 30 * MiB, WS_SSQ2 = 32 * MiB;
constexpr size_t WS_XN = 40 * MiB;
constexpr size_t WS_QO = 104 * MiB, WS_K = 168 * MiB, WS_V = 232 * MiB;
constexpr size_t WS_H = 104 * MiB;
#ifndef MK_REPEAT_PHASE
#define MK_REPEAT_PHASE -1
#endif
constexpr size_t WS_O = WS_QO;
constexpr size_t WS_FARO = 296 * MiB, WS_FARL = 328 * MiB;
constexpr size_t WS_XN8 = 330 * MiB;
constexpr size_t WS_O8 = 362 * MiB;
constexpr size_t WS_END = (MK_REPEAT_PHASE == 3 ? 490 : 394) * MiB;
constexpr size_t QKV8_OFF = 2 * MiB;
constexpr int CW_TMO = 0, CW_CODE = 1;
constexpr int CW_BAR = 4096;
constexpr int CW_PANEL = 8192;
constexpr int CW_FAR = 2048;

constexpr int RING_OFF = 0, RING_BYTES = 131072;
constexpr int LDSCTL_OFF = RING_BYTES, MISC_OFF = LDSCTL_OFF + 320;
constexpr int LDS_BYTES = 147456;
static_assert(WS_V - WS_K == WS_K - WS_QO, "Q | K | V equally spaced");
#define GAS __attribute__((address_space(1)))
#define LAS __attribute__((address_space(3)))
typedef unsigned short bf16;
typedef unsigned v4u __attribute__((ext_vector_type(4)));
typedef float f32x4 __attribute__((ext_vector_type(4)));
typedef short bf16x8 __attribute__((ext_vector_type(8)));
typedef GAS unsigned gu32;
typedef GAS unsigned long long gu64;
#define RLX_AGENT __ATOMIC_RELAXED, __HIP_MEMORY_SCOPE_AGENT
#define LDS_WAIT() asm volatile("s_waitcnt lgkmcnt(0)" ::: "memory")
#define VM_WAIT() asm volatile("s_waitcnt vmcnt(0)" ::: "memory")
__device__ __forceinline__ unsigned long long rt() { return __builtin_amdgcn_s_memrealtime(); }
__device__ __forceinline__ unsigned f2bf(float f) { unsigned u = __builtin_bit_cast(unsigned, f); return (u + 0x7fffu + ((u >> 16) & 1u)) >> 16; }
__device__ __forceinline__ unsigned pk2(float lo, float hi) { return f2bf(lo) | (f2bf(hi) << 16); }

#define XB_TMO      128
#define XB_XCNT(j)  (256  + 64 * (j))
#define XB_XSUB(j)  (1280 + 64 * (j))
#define XB_XGEN(j)  (2304 + 64 * (j))
#define XB_TOP      3328
#define XB_TOPGEN   3392
#define XCD_BAR_WORDS 3456
#define XB_SPIN_CAP (1u << 18)

__device__ __forceinline__ unsigned xb_ld(unsigned* p)              { return __hip_atomic_load(p, __ATOMIC_RELAXED, __HIP_MEMORY_SCOPE_AGENT); }
__device__ __forceinline__ unsigned xb_add(unsigned* p, unsigned v) { return __hip_atomic_fetch_add(p, v, __ATOMIC_RELAXED, __HIP_MEMORY_SCOPE_AGENT); }
__device__ __forceinline__ unsigned xb_xcc_id() { return (unsigned)__builtin_amdgcn_s_getreg((3 << 11) | 20) & 0xFu; }
#define XB_SPIN(cond, bar) do { unsigned _sp = 0; while (cond) { __builtin_amdgcn_s_sleep(1); \
    if ((++_sp & 255u) == 0u) { if (xb_ld(&(bar)[XB_TMO])) break; if (_sp > XB_SPIN_CAP) { atomicAdd(&(bar)[XB_TMO], 1u); break; } } } } while (0)

struct XcdBarrier {
    unsigned* bar; unsigned x;
    volatile LAS unsigned* st;
};

__device__ __forceinline__ int mk_lane() { int l; asm volatile("v_mbcnt_lo_u32_b32 %0, -1, 0\n\tv_mbcnt_hi_u32_b32 %0, -1, %0" : "=v"(l)); return l; }
__device__ __forceinline__ XcdBarrier xcd_barrier_post(unsigned* bar, volatile LAS unsigned* st, int wave) {
    XcdBarrier b; b.bar = bar; b.x = xb_xcc_id(); b.st = st;
    if (wave == 0 && mk_lane() == 0) (void)xb_add(&bar[XB_XCNT(b.x)], 1u);
    return b;
}
__device__ __forceinline__ void xcd_barrier_complete(unsigned* bar, unsigned x, unsigned& nloc, unsigned& nx) {
    const unsigned G = gridDim.x * gridDim.y * gridDim.z;
    unsigned sum, cnt, mine, sp = 0u;
    for (;;) {
        sum = 0u; cnt = 0u; mine = 0u;
#pragma unroll
        for (unsigned j = 0; j < 16; ++j) { const unsigned c = xb_ld(&bar[XB_XCNT(j)]); sum += c; cnt += (c > 0u) ? 1u : 0u; mine = (j == x) ? c : mine; }
        if (sum == G) break;
        __builtin_amdgcn_s_sleep(1);
        if ((++sp & 255u) == 0u) { if (xb_ld(&bar[XB_TMO])) break; if (sp > XB_SPIN_CAP) { atomicAdd(&bar[XB_TMO], 1u); break; } }
    }
    nloc = mine > 0u ? mine : 1u; nx = cnt > 0u ? cnt : 1u;
}

__device__ __forceinline__ void xcd_barrier(const XcdBarrier& b, int wave) {
    asm volatile("s_waitcnt vmcnt(0)" ::: "memory");
    __syncthreads();
    if (wave == 0 && mk_lane() == 0) {
        unsigned* bar = b.bar;
        __builtin_amdgcn_s_waitcnt(0);
        unsigned nloc = b.st[0], nx = b.st[1];
        if (nloc == 0u) { xcd_barrier_complete(bar, b.x, nloc, nx); b.st[0] = nloc; b.st[1] = nx; }
        const unsigned old = xb_add(&bar[XB_XSUB(b.x)], 1u);
        const unsigned gen = old / nloc;
        if (old + 1u == (gen + 1u) * nloc) {
            __builtin_amdgcn_fence(__ATOMIC_RELEASE, "agent");
            asm volatile("s_waitcnt vmcnt(0)" ::: "memory");
            const unsigned og = xb_add(&bar[XB_TOP], 1u);
            const unsigned tg = og / nx;
            if (og + 1u == (tg + 1u) * nx) xb_add(&bar[XB_TOPGEN], 1u);
            else XB_SPIN(xb_ld(&bar[XB_TOPGEN]) == tg, bar);
            __builtin_amdgcn_fence(__ATOMIC_ACQUIRE, "agent");
            xb_add(&bar[XB_XGEN(b.x)], 1u);
            asm volatile("s_waitcnt vmcnt(0)" ::: "memory");
        } else {
            XB_SPIN(xb_ld(&bar[XB_XGEN(b.x)]) == gen, bar);
            __builtin_amdgcn_fence(__ATOMIC_ACQUIRE, "agent");
            asm volatile("s_waitcnt vmcnt(0)" ::: "memory");
        }
    }
    __syncthreads();
}

#include <hip/hip_bf16.h>
#include <cmath>
namespace attn_body {
using bf16=__hip_bfloat16;
using bf16x8=__attribute__((ext_vector_type(8)))short;
using s16x4=__attribute__((ext_vector_type(4)))short;
using f32x16=__attribute__((ext_vector_type(16)))float;
using u32x4=__attribute__((ext_vector_type(4)))unsigned;
using f32x4_t=__attribute__((ext_vector_type(4)))float;
constexpr int BATCH=8,NHEAD=16,SEQ=4096,D=64,DM=NHEAD*D;
constexpr int NW=8,QBLK=32,QB=QBLK*NW,KVBLK=64,NQB=SEQ/QB;
constexpr int ATTN_PITCH=DM, ATTN_UNIT_ROWS=QB;
__device__ __forceinline__ int crow(int r,int hi){return (r&3)+8*(r>>2)+4*hi;}
#define SBAR() __builtin_amdgcn_sched_barrier(0)
__device__ __forceinline__ void cmask(f32x16&p0,f32x16&p1,int jb,int qrel,int hi){
  const float NEG=-INFINITY; int kb=64*jb+4*hi;
  #pragma unroll
  for(int r=0;r<16;++r){int kv=kb+(r&3)+8*(r>>2); if(kv>qrel)p0[r]=NEG; if(kv+32>qrel)p1[r]=NEG;}
}

__device__ __forceinline__ void dm_range(f32x16&p0,f32x16&p1,int x,unsigned bw){
  #pragma unroll
  for(int r=0;r<16;++r){ const int kp=(r&3)+8*(r>>2); if((unsigned)(x-kp)>bw)p0[r]=-1e30f; if((unsigned)(x-32-kp)>bw)p1[r]=-1e30f; } }
template<int KIND> __device__ __forceinline__ int dmode(int lo){
  if(KIND==2) return (lo+94<33||lo>128)?0:4;
  return (lo+94<0||lo>512)?0:((lo<0)?40:((lo+94<=128)?1:((lo<=128)?41:((lo+94<=512)?2:42)))); }
__device__ __forceinline__ void dm_adj128(f32x16&p0,f32x16&p1,int dqh,const f32x16&adj){
  #pragma unroll
  for(int r=0;r<16;++r){ const int kp=(r&3)+8*(r>>2); p0[r]+=(dqh-kp>128)?adj[r]:0.f; p1[r]+=(dqh-32-kp>128)?adj[r]:0.f; } }
__device__ __forceinline__ void fmask(f32x16&p0,f32x16&p1,int dq){
  #pragma unroll
  for(int r=0;r<16;++r){ const int kp=(r&3)+8*(r>>2); if((unsigned)(dq-kp-33)>95u)p0[r]=-1e30f; if((unsigned)(dq-kp-65)>95u)p1[r]=-1e30f; }
}
constexpr int NSLOT=3, SLOTB=8192;
constexpr int LDS_K=0, LDS_V=NSLOT*SLOTB, LDS_WS=2*NSLOT*SLOTB, LDS_OST=LDS_WS+NW*64*4, LDS_BYTES=LDS_OST+NW*4096;
constexpr int LDS_TAB=LDS_BYTES, TABB=4096, LDS_ALL=LDS_TAB+4*TABB;
constexpr float C2=0.125f*1.4426950408889634f;
__device__ __forceinline__ void glds16(const void*gsrc,unsigned lds_dst){unsigned keep;
  asm volatile("s_mov_b32 %0, m0\n\ts_mov_b32 m0, %2\n\ts_nop 0\n\tglobal_load_lds_dwordx4 %1, off\n\ts_mov_b32 m0, %0":"=&s"(keep):"v"(gsrc),"s"(lds_dst):"memory");}
__device__ __forceinline__ float max3f(float a,float b,float c){float r;asm("v_max3_f32 %0, %1, %2, %3":"=v"(r):"v"(a),"v"(b),"v"(c));return r;}
__device__ __forceinline__ float max2f(float a,float b){float r;asm("v_max_f32_e32 %0, %1, %2":"=v"(r):"v"(a),"v"(b));return r;}
__device__ __forceinline__ float fadd_s(float a,float b){float r;asm("v_add_f32_e32 %0, %1, %2":"=v"(r):"v"(a),"v"(b));return r;}
__device__ __forceinline__ float fsub_s(float a,float b){float r;asm("v_sub_f32_e32 %0, %1, %2":"=v"(r):"v"(a),"v"(b));return r;}
typedef float f32x2_t __attribute__((ext_vector_type(2))); typedef __bf16 bf16x2_t __attribute__((ext_vector_type(2)));
__device__ __forceinline__ unsigned cvtpk_s(float lo,float hi){f32x2_t v={lo,hi};bf16x2_t b=__builtin_convertvector(v,bf16x2_t);return __builtin_bit_cast(unsigned,b);}
#define WAIT_BAR(N) asm volatile("s_waitcnt vmcnt(" #N ") lgkmcnt(0)\n\ts_barrier":::"memory")

__device__ __forceinline__ void qkt(f32x16&p0,f32x16&p1,const char*Kslot,const bf16x8*qr,const f32x16&negm,int r32,int hi){
  const char*kb=Kslot+hi*1024+r32*16;
  #pragma unroll
  for(int d0=0;d0<4;++d0){
    const bf16x8 b0=*reinterpret_cast<const bf16x8*>(kb+d0*2048);
    const bf16x8 b1=*reinterpret_cast<const bf16x8*>(kb+d0*2048+512);
    if(d0==0){p0=__builtin_amdgcn_mfma_f32_32x32x16_bf16(b0,qr[0],negm,0,0,0);p1=__builtin_amdgcn_mfma_f32_32x32x16_bf16(b1,qr[0],negm,0,0,0);}
    else{p0=__builtin_amdgcn_mfma_f32_32x32x16_bf16(b0,qr[d0],p0,0,0,0);p1=__builtin_amdgcn_mfma_f32_32x32x16_bf16(b1,qr[d0],p1,0,0,0);}}
}
typedef __attribute__((address_space(3))) const char* lds_cptr;
typedef short v4i16_t __attribute__((ext_vector_type(4)));
__device__ __forceinline__ void kload8(bf16x8*kf,lds_cptr kp){
  kf[0]=*(const __attribute__((address_space(3))) bf16x8*)(kp);      kf[1]=*(const __attribute__((address_space(3))) bf16x8*)(kp+512);
  kf[2]=*(const __attribute__((address_space(3))) bf16x8*)(kp+2048); kf[3]=*(const __attribute__((address_space(3))) bf16x8*)(kp+2560);
  kf[4]=*(const __attribute__((address_space(3))) bf16x8*)(kp+4096); kf[5]=*(const __attribute__((address_space(3))) bf16x8*)(kp+4608);
  kf[6]=*(const __attribute__((address_space(3))) bf16x8*)(kp+6144); kf[7]=*(const __attribute__((address_space(3))) bf16x8*)(kp+6656);
}
__device__ __forceinline__ void kload2(bf16x8*kf,lds_cptr kp,int j){ kf[2*j]=*(const __attribute__((address_space(3))) bf16x8*)(kp+j*2048); kf[2*j+1]=*(const __attribute__((address_space(3))) bf16x8*)(kp+j*2048+512); }
__device__ __forceinline__ s16x4 vtr(lds_cptr p){ return __builtin_bit_cast(s16x4,__builtin_amdgcn_ds_read_tr16_b64_v4i16((__attribute__((address_space(3))) v4i16_t*)p)); }
__device__ __forceinline__ float rowmax(const f32x16&p0,const f32x16&p1){
  float a=max3f(p0[0],p0[1],p1[0]),b=max3f(p0[2],p0[3],p1[1]);a=max3f(a,p1[2],p1[3]);
  #pragma unroll
  for(int r=4;r<16;r+=4){a=max3f(a,p0[r],p0[r+1]);b=max3f(b,p0[r+2],p0[r+3]);a=max3f(a,p1[r],p1[r+1]);b=max3f(b,p1[r+2],p1[r+3]);}
  const float m=max2f(a,b);
  auto rr=__builtin_amdgcn_permlane32_swap(__float_as_uint(m),__float_as_uint(m),false,false);
  return max2f(__uint_as_float(rr[0]),__uint_as_float(rr[1]));
}
__device__ __forceinline__ void pv(f32x16*o,int vb,bf16x8 pa0,bf16x8 pa1,bf16x8 pa2,bf16x8 pa3){
  #pragma unroll
  for(int d0=0;d0<2;++d0){s16x4 lo[4],hi[4];
    #pragma unroll
    for(int ks=0;ks<4;++ks){
      asm volatile("ds_read_b64_tr_b16 %0,%1 offset:%c2":"=&v"(lo[ks]):"v"(vb),"i"(d0*4096+ks*1024):"memory");
      asm volatile("ds_read_b64_tr_b16 %0,%1 offset:%c2":"=&v"(hi[ks]):"v"(vb),"i"(d0*4096+ks*1024+512):"memory");}
    asm volatile("s_waitcnt lgkmcnt(0)":::"memory");SBAR();
    #define PK(k) (bf16x8){lo[k][0],lo[k][1],lo[k][2],lo[k][3],hi[k][0],hi[k][1],hi[k][2],hi[k][3]}
    o[d0]=__builtin_amdgcn_mfma_f32_32x32x16_bf16(pa0,PK(0),o[d0],0,0,0);
    o[d0]=__builtin_amdgcn_mfma_f32_32x32x16_bf16(pa1,PK(1),o[d0],0,0,0);
    o[d0]=__builtin_amdgcn_mfma_f32_32x32x16_bf16(pa2,PK(2),o[d0],0,0,0);
    o[d0]=__builtin_amdgcn_mfma_f32_32x32x16_bf16(pa3,PK(3),o[d0],0,0,0);
    #undef PK
  }
}

#ifndef ATTN_STORE16
#define ATTN_STORE16(p,v) asm volatile("global_store_dwordx4 %0, %1, off sc1\n\ts_nop 1"::"v"(p),"v"(v):"memory")
#endif
template<int THRL,int KIND> __device__ __forceinline__ void attn_unit(int b,int h,int qb,unsigned char*ws,char*shm,int wave,bf16x8 (&qr)[4],bool pre,bool has_next,int nkind,int nb,int nh,int nqb){
  const bf16*Q=(const bf16*)(ws+WS_QO); const bf16*K=(const bf16*)(ws+WS_K); const bf16*V=(const bf16*)(ws+WS_V); unsigned char*O8=ws+WS_O8;
  float*ssq=(float*)(ws+WS_SSQA); const float*kpart=(const float*)(ws+WS_KPART); unsigned short*faro=(unsigned short*)(ws+WS_FARO); float*farl=(float*)(ws+WS_FARL);
  constexpr bool DIL=(KIND==1), FAR=(KIND==2); constexpr int RS=FAR?16:1;
  int tid=wave*64+mk_lane(); asm volatile("":"+v"(tid));
  const int lane=tid&63,r32=lane&31,hi=lane>>5; const int wid=__builtin_amdgcn_readfirstlane(tid>>6);
  const int rowbase=b*SEQ+(FAR?qb:0);   const int q0=FAR?0:qb*QB;
  const bf16*Qw=Q+(rowbase+(int)(q0+wid*QBLK)*RS)*DM+h*D;
  const int T0=DIL?(qb>2?4*qb-8:0):0;
  const bf16*Kh=K+(rowbase+(int)T0*KVBLK)*DM+h*D,*Vh=V+(rowbase+(int)T0*KVBLK)*DM+h*D;
  const unsigned lds0=(unsigned)(uintptr_t)shm;
  float*wsf=(float*)(shm+LDS_WS)+wid*64;
  const bf16*ksrc=Kh+(int)lane*RS*DM+wid*8;
  const bf16*vsrc=Vh+(int)(16*(wid&3)+(lane>>2))*RS*DM+(wid>>2)*32+(lane&3)*8;
  const unsigned kdst=lds0+LDS_K+wid*1024, vdst=lds0+LDS_V+wid*1024;
  #define DMA_K(t,slot) glds16(ksrc+(int)(t)*KVBLK*RS*DM,(unsigned)__builtin_amdgcn_readfirstlane(kdst+(slot)))
  #define DMA_V(t,slot) glds16(vsrc+(int)(t)*KVBLK*RS*DM,(unsigned)__builtin_amdgcn_readfirstlane(vdst+(slot)))
  const int vb0=(int)(lds0+LDS_V)+((lane>>4)&1)*32+(lane&3)*8+(4*hi+((lane&15)>>2))*64;
  const char*Kbase=shm+LDS_K; bf16x8 kf[8];
  const lds_cptr shm3=(lds_cptr)shm; const lds_cptr kp0=shm3+LDS_K+hi*1024+r32*16; const lds_cptr vp0=shm3+LDS_V+((lane>>4)&1)*32+(lane&3)*8+(4*hi+((lane&15)>>2))*64;
  const int NT=FAR?4:(q0+QB)/KVBLK-T0;
  if(!pre)DMA_K(0,0); DMA_V(0,0); if(!pre)DMA_K(1,SLOTB);
  #pragma unroll
  for(int d0=0;d0<4;++d0)if(!pre)qr[d0]=*reinterpret_cast<const bf16x8*>(&Qw[(int)r32*RS*DM+d0*16+hi*8]);
  float mhat=0.f,l_reg=0.f;f32x16 o[2];o[0]=f32x16{};o[1]=f32x16{};
  const int qrel=wid*QBLK+r32;
  const lds_cptr tabp=(lds_cptr)shm+LDS_TAB+lane*64;
  unsigned selmask=1u<<qb;
  if(KIND==0){
    f32x16 g=f32x16{};
    #pragma unroll
    for(int d0=0;d0<4;++d0){ float km[8];
      if(r32<16){ const float*kp_=kpart+(unsigned)((b*16+r32)*2)*512+h*64+d0*16+hi*8;
        const f32x4_t a0=*(const f32x4_t*)kp_,a1=*(const f32x4_t*)(kp_+4),b0=*(const f32x4_t*)(kp_+512),b1=*(const f32x4_t*)(kp_+516);
        km[0]=a0[0]+b0[0];km[1]=a0[1]+b0[1];km[2]=a0[2]+b0[2];km[3]=a0[3]+b0[3];km[4]=a1[0]+b1[0];km[5]=a1[1]+b1[1];km[6]=a1[2]+b1[2];km[7]=a1[3]+b1[3]; }
      else{ _Pragma("unroll") for(int j=0;j<8;++j)km[j]=0.f; }
      u32x4 wh,wl; float rs[8];
      wh[0]=cvtpk_s(km[0],km[1]);wh[1]=cvtpk_s(km[2],km[3]);wh[2]=cvtpk_s(km[4],km[5]);wh[3]=cvtpk_s(km[6],km[7]);
      #pragma unroll
      for(int j=0;j<4;++j){ rs[2*j]=km[2*j]-__uint_as_float(wh[j]<<16); rs[2*j+1]=km[2*j+1]-__uint_as_float(wh[j]&0xffff0000u); }
      wl[0]=cvtpk_s(rs[0],rs[1]);wl[1]=cvtpk_s(rs[2],rs[3]);wl[2]=cvtpk_s(rs[4],rs[5]);wl[3]=cvtpk_s(rs[6],rs[7]);
      g=__builtin_amdgcn_mfma_f32_32x32x16_bf16(__builtin_bit_cast(bf16x8,wh),qr[d0],g,0,0,0);
      g=__builtin_amdgcn_mfma_f32_32x32x16_bf16(__builtin_bit_cast(bf16x8,wl),qr[d0],g,0,0,0); }
    float gv[16];
    #pragma unroll
    for(int r=0;r<8;++r){ const float own=g[r],oth=__shfl_xor(own,32); const int bl=(r&3)+8*(r>>2); gv[bl]=hi?oth:own; gv[bl+4]=hi?own:oth; }
    #pragma unroll
    for(int j=0;j<16;++j) if(j>=qb)gv[j]=-3e38f;
    #pragma unroll
    for(int rd=0;rd<3;++rd){ float best=-3e38f;int bi=0;
      #pragma unroll
      for(int j=0;j<16;++j){ if(gv[j]>best){best=gv[j];bi=j;} }
      if(best>-3e38f)selmask|=1u<<bi;
      #pragma unroll
      for(int j=0;j<16;++j) if(j==bi)gv[j]=-3e38f; }
  }
  const int lo0=FAR?(32*wid-63):(q0-T0*KVBLK+32*wid-63);
  #define DMODE(t) dmode<KIND>(lo0-(t)*KVBLK)
  #define CMASK(P0,P1,t) do{ if(DIL){ if(md_t>=40){ const int dqh_=q0-(T0+(t))*KVBLK+qrel-4*hi; \
        if(md_t==41){ const f32x16 adj_=*(const __attribute__((address_space(3))) f32x16*)(tabp+3*TABB); dm_adj128(P0,P1,dqh_,adj_); } \
        else dm_range(P0,P1,dqh_-((md_t==40)?0:-4096),(md_t==40)?0x7fffffffu:4608u); } } \
    else if(FAR){ if(md_t==4)fmask(P0,P1,qrel-(t)*KVBLK-4*hi); } \
    else { int jb_=(t)-(NT-4); if(jb_>=0)cmask(P0,P1,jb_,qrel,hi); } }while(0)
  #define SETC(t) f32x16 ct; const int md_t=(KIND==0)?0:DMODE(t); { if(DIL){ const int to_=(md_t==0)?0:((md_t==2||md_t==42)?2*TABB:TABB); \
      const f32x16 tb_=*(const __attribute__((address_space(3))) f32x16*)(tabp+to_); _Pragma("unroll") for(int r=0;r<16;++r)ct[r]=tb_[r]-mhat; } \
    else { const float x_=(FAR?(md_t!=0):(((selmask>>((t)>>2))&1u)!=0u))?-mhat:-1e30f; _Pragma("unroll") for(int r=0;r<16;++r)ct[r]=x_; } asm volatile("":"+v"(ct)); }
  bool resc=false;
  #define START(P0,P1) do{ const float rm=rowmax(P0,P1); resc=false; \
    if(__any(rm>(float)THRL)){ const float dl=__builtin_fmaxf(rm,0.f); mhat=fadd_s(mhat,dl); \
      _Pragma("unroll") for(int r=0;r<16;++r){P0[r]=fsub_s(P0[r],dl);P1[r]=fsub_s(P1[r],dl);} \
      const float f=__builtin_amdgcn_exp2f(-dl); l_reg*=f; if(hi==0)wsf[r32]=f; resc=true; } \
    _Pragma("unroll") for(int r=0;r<16;++r)P0[r]=__builtin_amdgcn_exp2f(P0[r]); }while(0)
  #define RESC() do{ if(resc){ asm volatile("s_waitcnt lgkmcnt(0)":::"memory"); \
      _Pragma("unroll") for(int d_=0;d_<2;++d_) _Pragma("unroll") for(int r=0;r<16;++r)o[d_][r]*=wsf[crow(r,hi)]; } }while(0)
  f32x16 pA0,pA1,pB0,pB1;
  int sl_prev=0,sl_cur=0,sl_next=SLOTB;
  #define ROT() do{sl_prev=sl_cur;sl_cur=sl_next;sl_next=(sl_next==(NSLOT-1)*SLOTB)?0:sl_next+SLOTB;}while(0)
  if(!pre){ DMA_K(2,2*SLOTB);
    WAIT_BAR(3); }
  else { WAIT_BAR(1); }
  if(0)WAIT_BAR(3);
  { SETC(0); qkt(pA0,pA1,Kbase,qr,ct,r32,hi); asm volatile("s_nop 15\n\ts_nop 7":"+v"(pA0),"+v"(pA1));CMASK(pA0,pA1,0); }
  START(pA0,pA1);
  _Pragma("unroll") for(int r=0;r<16;++r)pA1[r]=__builtin_amdgcn_exp2f(pA1[r]);
  WAIT_BAR(0);
  RESC();
  DMA_K(3,0);DMA_V(1,SLOTB);
  ROT();
  kload8(kf,kp0+sl_cur);
  WAIT_BAR(2);
  s16x4 vlo[8],vhi[8]; u32x4 pw0,pw1,pw2,pw3;
  #define PKW(P,B) cvtpk_s(P[B],P[B+1])
  #define PAF(k) __builtin_bit_cast(bf16x8,pw##k)
  #define VFR(i) (bf16x8){vlo[i][0],vlo[i][1],vlo[i][2],vlo[i][3],vhi[i][0],vhi[i][1],vhi[i][2],vhi[i][3]}
  #define PIN(x) asm volatile("":"+v"(x))
  #define MX3(a,b,c) __builtin_fmaxf(__builtin_fmaxf((a),(b)),(c))
  #define GAPA(MF,A0,A1,A2,A3,W0,W1,PW) do{ MF; sacc+=A0; sacc+=A1; sacc+=A2; sacc+=A3; PIN(sacc); W0; W1; PIN(PW); SBAR(); }while(0)
  #define EX(v) __builtin_amdgcn_exp2f(v)
  #define GAPB(MF,X,B) do{ MF; X[B]=EX(X[B]); X[B+1]=EX(X[B+1]); X[B+2]=EX(X[B+2]); X[B+3]=EX(X[B+3]); PIN(X); SBAR(); }while(0)
  #define VRD(i) do{ vlo[i]=vtr(vp_+(((i)>>2)*4096+((i)&3)*1024)); vhi[i]=vtr(vp_+(((i)>>2)*4096+((i)&3)*1024+512)); }while(0)
  #define KRD(G,j) do{ if(G){ kload2(kf,kp0+sl_next,j); SBAR(); } }while(0)
  #define STEP(C0,C1,P0,P1,t,GK,GV,GL) do{ SBAR(); SETC(t); SBAR(); \
    const lds_cptr vp_=vp0+sl_prev; \
    VRD(0); SBAR(); float sacc=(P0[0]+P0[1]); \
    GAPA(C0=__builtin_amdgcn_mfma_f32_32x32x16_bf16(kf[0],qr[0],ct,0,0,0), P0[2],P0[3],P0[4],P0[5],     pw0[0]=PKW(P0,0), pw0[1]=PKW(P0,2), pw0); \
    VRD(4); SBAR(); GAPA(C1=__builtin_amdgcn_mfma_f32_32x32x16_bf16(kf[1],qr[0],ct,0,0,0), P0[6],P0[7],P0[8],P0[9],     pw0[2]=PKW(P0,4), pw0[3]=PKW(P0,6), pw0); \
    VRD(1); SBAR(); GAPA(C0=__builtin_amdgcn_mfma_f32_32x32x16_bf16(kf[2],qr[1],C0,0,0,0),   P0[10],P0[11],P0[12],P0[13], pw1[0]=PKW(P0,8), pw1[1]=PKW(P0,10), pw1); \
    VRD(5); SBAR(); GAPA(C1=__builtin_amdgcn_mfma_f32_32x32x16_bf16(kf[3],qr[1],C1,0,0,0),   P0[14],P0[15],P1[0],P1[1],   pw1[2]=PKW(P0,12),pw1[3]=PKW(P0,14), pw1); \
    VRD(2); SBAR(); GAPA(C0=__builtin_amdgcn_mfma_f32_32x32x16_bf16(kf[4],qr[2],C0,0,0,0),   P1[2],P1[3],P1[4],P1[5],     pw2[0]=PKW(P1,0), pw2[1]=PKW(P1,2), pw2); \
    VRD(6); SBAR(); GAPA(C1=__builtin_amdgcn_mfma_f32_32x32x16_bf16(kf[5],qr[2],C1,0,0,0),   P1[6],P1[7],P1[8],P1[9],     pw2[2]=PKW(P1,4), pw2[3]=PKW(P1,6), pw2); \
    VRD(3); SBAR(); GAPA(C0=__builtin_amdgcn_mfma_f32_32x32x16_bf16(kf[6],qr[3],C0,0,0,0),   P1[10],P1[11],P1[12],P1[13], pw3[0]=PKW(P1,8), pw3[1]=PKW(P1,10), pw3); \
    VRD(7); SBAR(); GAPA(C1=__builtin_amdgcn_mfma_f32_32x32x16_bf16(kf[7],qr[3],C1,0,0,0),   P1[14],P1[15],0.f,0.f,       pw3[2]=PKW(P1,12),pw3[3]=PKW(P1,14), pw3); \
    l_reg+=sacc; \
    if(GK){DMA_K((t)+3,sl_cur);} if(GV){DMA_V((t)+1,sl_next);} \
    CMASK(C0,C1,t); \
    { float a=MX3(C0[0],C0[1],C1[0]),b=MX3(C0[2],C0[3],C1[1]); a=MX3(a,C1[2],C1[3]); \
      _Pragma("unroll") for(int r=4;r<16;r+=4){a=MX3(a,C0[r],C0[r+1]);b=MX3(b,C0[r+2],C0[r+3]);a=MX3(a,C1[r],C1[r+1]);b=MX3(b,C1[r+2],C1[r+3]);} \
      float rm=__builtin_fmaxf(a,b); { auto rr=__builtin_amdgcn_permlane32_swap(__float_as_uint(rm),__float_as_uint(rm),false,false); rm=__builtin_fmaxf(__uint_as_float(rr[0]),__uint_as_float(rr[1])); } \
      resc=false; \
      if(__builtin_expect(__any(rm>(float)THRL),0)){ const float dl=__builtin_fmaxf(rm,0.f); mhat+=dl; \
        _Pragma("unroll") for(int r=0;r<16;++r){C0[r]-=dl;C1[r]-=dl;} \
        const float f=__builtin_amdgcn_exp2f(-dl); l_reg*=f; if(hi==0)wsf[r32]=f; resc=true; } } \
    SBAR(); \
    GAPB(o[0]=__builtin_amdgcn_mfma_f32_32x32x16_bf16(PAF(0),VFR(0),o[0],0,0,0), C0,0); \
    GAPB(o[1]=__builtin_amdgcn_mfma_f32_32x32x16_bf16(PAF(0),VFR(4),o[1],0,0,0), C0,4); \
    KRD(GL,0); GAPB(o[0]=__builtin_amdgcn_mfma_f32_32x32x16_bf16(PAF(1),VFR(1),o[0],0,0,0), C0,8); \
    KRD(GL,1); GAPB(o[1]=__builtin_amdgcn_mfma_f32_32x32x16_bf16(PAF(1),VFR(5),o[1],0,0,0), C0,12); \
    KRD(GL,2); GAPB(o[0]=__builtin_amdgcn_mfma_f32_32x32x16_bf16(PAF(2),VFR(2),o[0],0,0,0), C1,0); \
    KRD(GL,3); GAPB(o[1]=__builtin_amdgcn_mfma_f32_32x32x16_bf16(PAF(2),VFR(6),o[1],0,0,0), C1,4); \
    GAPB(o[0]=__builtin_amdgcn_mfma_f32_32x32x16_bf16(PAF(3),VFR(3),o[0],0,0,0), C1,8); \
    GAPB(o[1]=__builtin_amdgcn_mfma_f32_32x32x16_bf16(PAF(3),VFR(7),o[1],0,0,0), C1,12); \
    }while(0)
  int t=1;
  for(;t+5<NT;t+=2){
    STEP(pB0,pB1,pA0,pA1,t,true,true,true);     WAIT_BAR(2); RESC(); ROT();
    STEP(pA0,pA1,pB0,pB1,t+1,true,true,true);   WAIT_BAR(2); RESC(); ROT();
  }
  #define ENDW(tt) do{ if((tt)+3<NT){WAIT_BAR(2);} else if((tt)+2<NT){WAIT_BAR(1);} else {WAIT_BAR(0);} }while(0)
  for(;t+1<NT;t+=2){
    STEP(pB0,pB1,pA0,pA1,t,(t+3<NT),(t+1<NT),(t+1<NT));       ENDW(t);   RESC(); ROT();
    STEP(pA0,pA1,pB0,pB1,t+1,(t+4<NT),(t+2<NT),(t+2<NT));     ENDW(t+1); RESC(); ROT();
  }
  if(has_next){
    const int nRS=(nkind==2)?16:1, nrowbase=nb*SEQ+((nkind==2)?nqb:0), nT0=(nkind==1)?(nqb>2?4*nqb-8:0):0;
    const bf16*nks=K+(nrowbase+(int)nT0*KVBLK)*DM+nh*D+(int)lane*nRS*DM+wid*8;
    glds16(nks,(unsigned)__builtin_amdgcn_readfirstlane(kdst)); glds16(nks+(int)KVBLK*nRS*DM,(unsigned)__builtin_amdgcn_readfirstlane(kdst+SLOTB)); glds16(nks+(int)2*KVBLK*nRS*DM,(unsigned)__builtin_amdgcn_readfirstlane(kdst+2*SLOTB)); }
  STEP(pB0,pB1,pA0,pA1,NT-1,false,false,false); RESC();
  if(has_next){
    const int nRS=(nkind==2)?16:1, nrowbase=nb*SEQ+((nkind==2)?nqb:0), nq0=(nkind==2)?0:nqb*QB; const bf16*nQw=Q+(nrowbase+(int)(nq0+wid*QBLK)*nRS)*DM+nh*D;
    #pragma unroll
    for(int d0=0;d0<4;++d0)qr[d0]=*reinterpret_cast<const bf16x8*>(&nQw[(int)r32*nRS*DM+d0*16+hi*8]); }
  { float sacc=pB0[0]+pB0[1]; _Pragma("unroll") for(int r=2;r<16;++r)sacc+=pB0[r]; _Pragma("unroll") for(int r=0;r<16;++r)sacc+=pB1[r]; l_reg+=sacc;
    pw0=(u32x4){PKW(pB0,0),PKW(pB0,2),PKW(pB0,4),PKW(pB0,6)};pw1=(u32x4){PKW(pB0,8),PKW(pB0,10),PKW(pB0,12),PKW(pB0,14)};pw2=(u32x4){PKW(pB1,0),PKW(pB1,2),PKW(pB1,4),PKW(pB1,6)};pw3=(u32x4){PKW(pB1,8),PKW(pB1,10),PKW(pB1,12),PKW(pB1,14)};
    SBAR(); pv(o,vb0+sl_cur,PAF(0),PAF(1),PAF(2),PAF(3)); }
  #undef PKW
  #undef PAF
  #undef VFR
  #undef PIN
  #undef MX3
  #undef GAPA
  #undef GAPB
  #undef EX
  #undef VRD
  #undef KRD
  #undef STEP
  #undef ENDW
  {auto rr=__builtin_amdgcn_permlane32_swap(__float_as_uint(l_reg),__float_as_uint(l_reg),false,false);l_reg=__uint_as_float(rr[0])+__uint_as_float(rr[1]);}
  int lane_e=lane; asm volatile("":"+v"(lane_e));
  u32x4 fch[4];
  if(DIL){
    const unsigned short*fp=faro+(unsigned)(rowbase+q0+wid*QBLK+(lane_e>>3))*512+(h-8)*D+(lane_e&7)*8;
    #pragma unroll
    for(int i=0;i<4;++i)fch[i]=*(const u32x4*)(fp+(unsigned)i*8*512);
    const int p_=q0+wid*QBLK+(lane_e&31); const float*lp=farl+((unsigned)(((b*8+(h-8))*16+(p_&15))*256+(p_>>4)))*2; const float lf_=lp[0],mf_=lp[1];
    const float M_=__builtin_fmaxf(mhat,mf_),sa_=__builtin_amdgcn_exp2f(mhat-M_),sb_=__builtin_amdgcn_exp2f(mf_-M_),rl_=__builtin_amdgcn_rcpf(l_reg*sa_+lf_*sb_);
    if(hi==0){wsf[32+r32]=sa_*rl_;wsf[r32]=sb_*rl_;} }
  else if(hi==0)wsf[32+r32]=FAR?1.f:__builtin_amdgcn_rcpf(l_reg);
  asm volatile("s_waitcnt lgkmcnt(0)":::"memory");
  float rli[16];
  #pragma unroll
  for(int r=0;r<16;++r)rli[r]=wsf[32+crow(r,hi)];
  constexpr int OP=FAR?512:DM;
  bf16*Ow=(bf16*)faro+(rowbase+(int)wid*QBLK*RS)*OP+(h-8)*D;
  unsigned char*O8w=O8+(rowbase+q0+wid*QBLK)*DM+h*D;
  if(FAR&&hi==0){ float*lp=farl+((unsigned)(((b*8+(h-8))*16+qb)*256+qrel))*2; __hip_atomic_store((unsigned long long*)lp,((unsigned long long)__float_as_uint(mhat)<<32)|__float_as_uint(l_reg),__ATOMIC_RELAXED,__HIP_MEMORY_SCOPE_AGENT); }
  { bf16*stg=(bf16*)(shm+LDS_OST)+wid*2048;
    #pragma unroll
    for(int r=0;r<16;++r){const int orow=crow(r,hi);
      #pragma unroll
      for(int d0=0;d0<2;++d0)stg[orow*64+d0*32+r32]=__float2bfloat16(o[d0][r]*rli[r]);}
    asm volatile("s_waitcnt lgkmcnt(0)":::"memory");
    #pragma unroll
    for(int i=0;i<4;++i){const int row=i*8+(lane_e>>3),ch=lane_e&7; u32x4 v=*(const u32x4*)(stg+row*64+ch*8);
      if(DIL){ const float fb_=wsf[row];
        #pragma unroll
        for(int j=0;j<4;++j){ const float a_=__uint_as_float(v[j]<<16)+__uint_as_float(fch[i][j]<<16)*fb_, b_=__uint_as_float(v[j]&0xffff0000u)+__uint_as_float(fch[i][j]&0xffff0000u)*fb_; v[j]=cvtpk_s(a_,b_); } }
      if(FAR){ ATTN_STORE16(Ow+(int)row*RS*OP+ch*8,v); }
      else { unsigned w0_=0,w1_=0;
        w0_=__builtin_amdgcn_cvt_pk_fp8_f32(__uint_as_float(v[0]<<16)*64.f,__uint_as_float(v[0]&0xffff0000u)*64.f,w0_,false); w0_=__builtin_amdgcn_cvt_pk_fp8_f32(__uint_as_float(v[1]<<16)*64.f,__uint_as_float(v[1]&0xffff0000u)*64.f,w0_,true);
        w1_=__builtin_amdgcn_cvt_pk_fp8_f32(__uint_as_float(v[2]<<16)*64.f,__uint_as_float(v[2]&0xffff0000u)*64.f,w1_,false); w1_=__builtin_amdgcn_cvt_pk_fp8_f32(__uint_as_float(v[3]<<16)*64.f,__uint_as_float(v[3]&0xffff0000u)*64.f,w1_,true);
        *(unsigned long long*)(O8w+(int)row*DM+ch*8)=((unsigned long long)w1_<<32)|w0_; }
      float sq=0.f;
      #pragma unroll
      for(int j=0;j<4;++j){ const float a_=__uint_as_float(v[j]<<16), b_=__uint_as_float(v[j]&0xffff0000u); sq+=a_*a_+b_*b_; }
      sq+=__shfl_xor(sq,1); sq+=__shfl_xor(sq,2); sq+=__shfl_xor(sq,4);
      if(!FAR&&ch==0)ssq[(unsigned)(rowbase+q0+wid*QBLK+row)*16+h]=sq; } }
  asm volatile("s_waitcnt lgkmcnt(0)\n\ts_barrier":::"memory");
  #undef DMA_K
  #undef DMA_V
  #undef CMASK
  #undef START
  #undef RESC
  #undef ROT
}
constexpr int ATTN_LDS_BYTES=LDS_BYTES;
__device__ __forceinline__ void attn_tables(char*lds,int wave){
  float*tb=(float*)(lds+LDS_TAB);
  for(int e=wave*64+mk_lane();e<64*16;e+=512){ const int ln=e>>4,r=e&15,r32=ln&31,hi=ln>>5; const int z4=r32&3,z16=((r32&15)-4*hi)&15;
    const bool in4=(z4==(r&3)),in16=(z16==((r&3)+8*((r>>2)&1)));
    tb[e]=-1e30f; tb[1024+e]=in16?1.5849625007f:(in4?1.f:0.f); tb[2048+e]=in16?1.f:(in4?0.f:-1e30f); tb[3072+e]=in16?(1.f-1.5849625007f):(in4?-1.f:-1e30f); }
  __syncthreads();
}
template<int THRL=8> __device__ __forceinline__ void attn_phase(char*lds,unsigned char*ws,unsigned*cnt,int vcu,int G,int wave){
  const int g=vcu>>2,b=g>>3,hm=g&7,c=vcu&3;
  attn_tables(lds,wave);
  bf16x8 qr[4];
  { const int nf_=(c==0)?6:((c==1)?4:3), cb_=(c==0)?0:((c==1)?6:((c==2)?10:13)); const int n_=(MK_REPEAT_PHASE==22?2*nf_:nf_); for(int i=0;i<n_;++i) attn_unit<THRL,2>(b,8+hm,cb_+(i%nf_),ws,lds,wave,qr,i>0,true,(i+1<n_)?2:0,b,(i+1<n_)?8+hm:hm,(i+1<n_)?cb_+((i+1)%nf_):15-c); }
  asm volatile("s_waitcnt vmcnt(0)":::"memory"); __syncthreads();
  if(wave==0&&mk_lane()==0) __hip_atomic_fetch_add(cnt,1u,__ATOMIC_RELAXED,__HIP_MEMORY_SCOPE_AGENT);
  #define QBSEL(i_) ((((i_)&3)==0)?15-c:((((i_)&3)==1)?8+c:((((i_)&3)==2)?7-c:c)))
  { const int n_=(MK_REPEAT_PHASE==20?8:4); for(int ii=0;ii<n_;++ii) attn_unit<THRL,0>(b,hm,QBSEL(ii),ws,lds,wave,qr,true,true,(ii+1<n_)?0:1,b,(ii+1<n_)?hm:8+hm,QBSEL(ii+1)); }
  if(wave==0&&mk_lane()==0){ unsigned sp=0; while(__hip_atomic_load(cnt,__ATOMIC_RELAXED,__HIP_MEMORY_SCOPE_AGENT)<(unsigned)G){ __builtin_amdgcn_s_sleep(2); if(++sp>(1u<<22))break; }
    __builtin_amdgcn_fence(__ATOMIC_ACQUIRE,"agent"); asm volatile("s_waitcnt vmcnt(0)":::"memory"); }
  __syncthreads();
  { const int n_=(MK_REPEAT_PHASE==21?8:4); for(int ii=0;ii<n_;++ii) attn_unit<THRL,1>(b,8+hm,QBSEL(ii),ws,lds,wave,qr,true,ii+1<n_,1,b,8+hm,QBSEL(ii+1)); }
  #undef QBSEL
}
#undef SBAR
#undef WAIT_BAR
}

struct Frame {
    LAS unsigned char* lds;
    volatile LAS unsigned* MISC;
    gu32* ctl;
    int wave;
    int vcu, G;
    const float *x, *attn_norm, *w_in, *moba_norm, *dil_norm, *w_out, *ffn_norm, *w_gate, *w_up, *w_down, *final_norm;
    float* out;
    bf16 *Wqkv_t, *Wo_t, *Wgu_t, *Wd_t;
    bf16 *QO, *KB, *VB, *XN, *OB; unsigned char *HB, *XN8;
    float *rope, *kpart, *ssqa, *ssq1, *ssq2;
};

__device__ __forceinline__ float wave_sum(float v) {
#pragma unroll
    for (int o = 1; o < 64; o <<= 1) v += __shfl_xor(v, o);
    return v;
}
__device__ __forceinline__ int qkv_vrow(int n) { const int part = n >> 10, head = (n >> 6) & 15, d = n & 63; return 256 * (part * 4 + (head >> 2)) + 128 * (d >> 5) + 32 * (head & 3) + (d & 31); }
template <int MODE>
__device__ __forceinline__ void p0_item(const float* W, int K, int N, bf16* WT, const float* g0, const float* g1, LAS float* scr, int item, int lane) {
    const int nblk = N / 32, kb = item / nblk, nb = item % nblk, k0 = 64 * kb, n0 = 32 * nb;
#pragma unroll 8
    for (int i = 0; i < 32; ++i) { const int kk = 2 * i + (lane >> 5), k = k0 + kk; float w = __builtin_nontemporal_load(W + (size_t)k * N + n0 + (lane & 31));
        if (MODE == 1) w *= (k < 512 ? g0[k] : g1[k - 512]);
        if (MODE == 2 || MODE == 3) w *= g0[k];
        scr[kk * 33 + (lane & 31)] = w; }
    LDS_WAIT(); asm volatile("" ::: "memory");
    const int c = lane & 7;
#pragma unroll
    for (int j = 0; j < 4; ++j) { const int n = (lane >> 3) + 8 * j; const LAS float* s = scr + (8 * c) * 33 + n;
        const int ns = n0 + n; int dr;
        if (MODE == 0) dr = qkv_vrow(ns); else if (MODE == 2) dr = 256 * (ns >> 7) + (ns & 127); else if (MODE == 3) dr = 256 * (ns >> 7) + 128 + (ns & 127); else dr = ns;
        bool f8 = MODE >= 1; size_t base8 = 0;
        if (MODE == 0) {
            const int pn = dr >> 8, lo = dr & 255; f8 = !(pn < 8 && (pn & 3) < 2);
            dr = (f8 ? (pn < 8 ? ((pn & 1) + 2 * (pn >> 2)) : pn - 4) : ((pn & 1) + 2 * (pn >> 2))) * 256 + lo; base8 = (size_t)QKV8_OFF; }
        if (f8) {
            const pg8::f32x4 a = {s[0 * 33], s[1 * 33], s[2 * 33], s[3 * 33]}, b = {s[4 * 33], s[5 * 33], s[6 * 33], s[7 * 33]};
            *(GAS pg8::u32x2*)((unsigned char*)WT + base8 + (size_t)dr * K + k0 + 8 * c) = pg8::pack8_fp8(a * pg8::F8_SW, b * pg8::F8_SW);
        } else {
            v4u o; o.x = pk2(s[0 * 33], s[1 * 33]); o.y = pk2(s[2 * 33], s[3 * 33]); o.z = pk2(s[4 * 33], s[5 * 33]); o.w = pk2(s[6 * 33], s[7 * 33]);
            *(GAS v4u*)(WT + (size_t)dr * K + k0 + 8 * c) = o; } }
    LDS_WAIT(); asm volatile("" ::: "memory");
}
template <int R>
__device__ __forceinline__ void rms_rows_to_bf16(Frame& F, const float* xrow, const float* gain, bf16* orow, unsigned char* orow8, float* rn) {
    const GAS f32x4* xr = (const GAS f32x4*)xrow + mk_lane(); const GAS f32x4* gr = (const GAS f32x4*)gain + mk_lane();
    f32x4 v[R][4]; float s[R];
#pragma unroll
    for (int r = 0; r < R; ++r)
#pragma unroll
        for (int j = 0; j < 4; ++j) v[r][j] = __builtin_nontemporal_load(xr + r * 256 + 64 * j);
#pragma unroll
    for (int r = 0; r < R; ++r) { s[r] = 0.f;
#pragma unroll
        for (int j = 0; j < 4; ++j) s[r] += (v[r][j].x * v[r][j].x + v[r][j].y * v[r][j].y) + (v[r][j].z * v[r][j].z + v[r][j].w * v[r][j].w); }
#pragma unroll
    for (int o = 1; o < 64; o <<= 1)
#pragma unroll
        for (int r = 0; r < R; ++r) s[r] += __shfl_xor(s[r], o);
    const int ln_ = mk_lane(); GAS unsigned long long* o8 = (GAS unsigned long long*)orow + ln_; GAS unsigned* q8 = (GAS unsigned*)orow8 + ln_;
#pragma unroll
    for (int r = 0; r < R; ++r) { const float rms = sqrtf(s[r] * (1.f / D) + RMS_EPS), rstd = 1.f / rms; if (ln_ == 0) rn[r] = rms;
#pragma unroll
        for (int j = 0; j < 4; ++j) { const f32x4 g = gr[64 * j];
            const f32x4 y = v[r][j] * rstd * g;
            o8[r * 256 + 64 * j] = (unsigned long long)pk2(y.x, y.y) | ((unsigned long long)pk2(y.z, y.w) << 32);
            unsigned t = 0; t = __builtin_amdgcn_cvt_pk_fp8_f32(y.x * pg8::F8_SA, y.y * pg8::F8_SA, t, false); t = __builtin_amdgcn_cvt_pk_fp8_f32(y.z * pg8::F8_SA, y.w * pg8::F8_SA, t, true); q8[r * 256 + 64 * j] = t; } }
}
__device__ __forceinline__ void p0_prologue(Frame& F) {
    LAS float* scr = (LAS float*)(F.lds + RING_OFF + F.wave * 16384);
    const int gw = F.vcu * NWAVES + F.wave, NGW = F.G * NWAVES;
    constexpr int I_IN = (D / 64) * (NQKV / 32), I_O = (D / 64) * (D / 32), I_G = (D / 64) * (FF / 32), I_D = (FF / 64) * (D / 32);
    constexpr int NITEMS = I_IN + I_O + 2 * I_G + I_D;
    for (int it = gw; it < NITEMS; it += NGW) {
        int r = it;
        if (r < I_IN) { p0_item<0>(F.w_in, D, NQKV, F.Wqkv_t, nullptr, nullptr, scr, r, mk_lane()); continue; } r -= I_IN;
        if (r < I_O) { p0_item<1>(F.w_out, D, D, F.Wo_t, F.moba_norm, F.dil_norm, scr, r, mk_lane()); continue; } r -= I_O;
        if (r < I_G) { p0_item<2>(F.w_gate, D, FF, F.Wgu_t, F.ffn_norm, nullptr, scr, r, mk_lane()); continue; } r -= I_G;
        if (r < I_G) { p0_item<3>(F.w_up, D, FF, F.Wgu_t, F.ffn_norm, nullptr, scr, r, mk_lane()); continue; } r -= I_G;
        p0_item<4>(F.w_down, FF, D, F.Wd_t, nullptr, nullptr, scr, r, mk_lane());
    }
    for (int e = (F.vcu * NWAVES * 64) + F.wave * 64 + mk_lane(); e < SEQ * 32; e += F.G * NWAVES * 64) {
        const int s = e >> 5, j = e & 31;
        const float invf = __builtin_amdgcn_exp2f(-(float)j * (13.287712379549449f / 32.0f));
        double rev = (double)s * (double)invf * 0.15915494309189535; rev -= __builtin_floor(rev);
        const float r = (float)rev;
        pg8::f32x2 cs; cs.x = __builtin_amdgcn_cosf(r); cs.y = __builtin_amdgcn_sinf(r);
        *(GAS pg8::f32x2*)((pg8::f32x2*)F.rope + e) = cs;
    }
    for (int m = 4 * gw; m < M; m += 4 * NGW) rms_rows_to_bf16<4>(F, F.x + (size_t)m * D, F.attn_norm, F.XN + (size_t)m * D, F.XN8 + (size_t)m * D, (float*)(F.kpart + 131072) + m);
}

__device__ __forceinline__ void p6_final(Frame& F) {
    const int gw = F.vcu * NWAVES + F.wave, NGW = F.G * NWAVES;
    const GAS f32x4* gr = (const GAS f32x4*)F.final_norm + mk_lane();
    for (int m = gw; m < M; m += NGW) {
        GAS f32x4* xr = (GAS f32x4*)(F.out + (size_t)m * D) + mk_lane();
        const GAS f32x4* sp = (const GAS f32x4*)(F.ssq2 + (size_t)m * 16);
        const f32x4 a = sp[0], b = sp[1], c = sp[2], d = sp[3];
        const float ss = ((a.x + a.y) + (a.z + a.w)) + ((b.x + b.y) + (b.z + b.w)) + ((c.x + c.y) + (c.z + c.w)) + ((d.x + d.y) + (d.z + d.w));
        const float rstd = 1.f / sqrtf(ss * (1.f / D) + RMS_EPS);
#pragma unroll
        for (int j = 0; j < 4; ++j) { const f32x4 v = xr[64 * j], g = gr[64 * j]; xr[64 * j] = v * rstd * g; }
    }
}

struct Args { const float* in[11]; float* out; unsigned char* ws; int ph_lo, ph_hi, li, pad; };
__global__ void __launch_bounds__(NWAVES * 64, 2) mk_fwd(Args args) {
    extern __shared__ __attribute__((aligned(16))) unsigned char lds[];
    Frame F;
    F.lds = (LAS unsigned char*)lds;
    F.MISC = (volatile LAS unsigned*)(F.lds + MISC_OFF);
    F.wave = __builtin_amdgcn_readfirstlane((int)(threadIdx.x >> 6));
    F.G = gridDim.x; { const int bx = blockIdx.x; F.vcu = (F.G % 8 == 0) ? (bx % 8) * (F.G / 8) + bx / 8 : bx; }
#define GRID_BAR(seam) do { if (N_LAUNCHES == PER_PHASE) { if ((F.wave == 0 && mk_lane() == 0)) __hip_atomic_store(F.ctl + CW_TMO, 0xBADBA0u | (unsigned)(seam), RLX_AGENT); } \
    else { xcd_barrier(bar, F.wave); if (MK_REPEAT_PHASE == 30) xcd_barrier(bar, F.wave); } } while (0)
    unsigned char* ws = args.ws;
    F.ctl = (gu32*)(ws + WS_CTL);
    F.x = args.in[0]; F.attn_norm = args.in[1]; F.w_in = args.in[2]; F.moba_norm = args.in[3]; F.dil_norm = args.in[4]; F.w_out = args.in[5];
    F.ffn_norm = args.in[6]; F.w_gate = args.in[7]; F.w_up = args.in[8]; F.w_down = args.in[9]; F.final_norm = args.in[10]; F.out = args.out;
    F.Wqkv_t = (bf16*)(ws + WS_WQKV); F.Wo_t = (bf16*)(ws + WS_WO); F.Wgu_t = (bf16*)(ws + WS_WGU); F.Wd_t = (bf16*)(ws + WS_WD);
    F.QO = (bf16*)(ws + WS_QO); F.KB = (bf16*)(ws + WS_K); F.VB = (bf16*)(ws + WS_V); F.HB = ws + WS_H; F.XN8 = ws + WS_XN8; F.XN = (bf16*)(ws + WS_XN); F.OB = (bf16*)(ws + WS_O);
    F.rope = (float*)(ws + WS_ROPE); F.kpart = (float*)(ws + WS_KPART); F.ssqa = (float*)(ws + WS_SSQA); F.ssq1 = (float*)(ws + WS_SSQ1); F.ssq2 = (float*)(ws + WS_SSQ2);
    for (int u = F.wave * 64 + mk_lane(); u < (LDS_BYTES - LDSCTL_OFF) / 4; u += NWAVES * 64) ((LAS unsigned*)(F.lds + LDSCTL_OFF))[u] = 0u;
    __syncthreads();
    XcdBarrier bar; bar.bar = (unsigned*)(F.ctl + CW_BAR); bar.x = 0; bar.st = nullptr;
    if (N_LAUNCHES != PER_PHASE) bar = xcd_barrier_post((unsigned*)(F.ctl + CW_BAR), F.MISC + 8, F.wave);
    const int lo = args.ph_lo, hi = args.ph_hi;
#define IN(k) (lo <= (k) && (k) < hi)
#define BOTH(k) (IN(k) && IN((k) + 1))

    if (IN(0)) { for (int rp = 0; rp < (MK_REPEAT_PHASE == 0 ? 2 : 1); ++rp) p0_prologue(F); if (BOTH(0)) GRID_BAR(0); }

    if (IN(1)) {
        { pg8::Gemm g{F.XN, F.Wqkv_t, M, 1024, D}; pg8::StaticOrder S; S.init(M, 1024, F.G, (int)blockIdx.x, MK_REPEAT_PHASE == 1 ? 2 : 1);
          pg8::EpiQKV E{F.QO, (size_t)(WS_K - WS_QO) / 2, F.rope, F.kpart, QSCALE, 1, 1.f};
          pg8::gemm_phase<pg8::EpiQKV, pg8::StaticOrder, true, true>(F.lds + RING_OFF, g, S, E, F.wave); }
        { pg8::Gemm g{(const bf16*)F.XN8, (const bf16*)((const unsigned char*)F.Wqkv_t + QKV8_OFF), M, 2048, D}; pg8::StaticOrder S; S.init(M, 2048, F.G, (int)blockIdx.x, MK_REPEAT_PHASE == 1 ? 2 : 1);
          pg8::EpiQKV E{F.QO, (size_t)(WS_K - WS_QO) / 2, F.rope, F.kpart, QSCALE, 2, 1.f / (pg8::F8_SA * pg8::F8_SW)};
          pg8::gemm_phase<pg8::EpiQKV, pg8::StaticOrder, true, true, true>(F.lds + RING_OFF, g, S, E, F.wave); }
        if (BOTH(1)) GRID_BAR(1);
    }

    if (IN(2)) {
        if (F.G == 256) {
            for (int rp = 0; rp < (MK_REPEAT_PHASE == 2 ? 2 : 1); ++rp) attn_body::attn_phase<8>((char*)lds + RING_OFF, ws, (unsigned*)(F.ctl + CW_FAR), F.vcu, F.G, F.wave);
        }
        if (BOTH(2)) GRID_BAR(2);
    }

    if (IN(3)) {
        pg8::Gemm g{(const bf16*)(ws + WS_O8), F.Wo_t, M, D, D};   pg8::StaticOrder S; S.init(M, D, F.G, (int)blockIdx.x, MK_REPEAT_PHASE == 3 ? 2 : 1);
        pg8::EpiWo E{F.kpart + 131072, F.attn_norm, F.XN, (MK_REPEAT_PHASE == 3) ? (bf16*)(ws + 394 * MiB) : F.XN, (MK_REPEAT_PHASE == 3) ? ws + 458 * MiB : F.XN8, F.ssqa, F.ssq1};
        pg8::gemm_phase<pg8::EpiWo, pg8::StaticOrder, true, true, true>(F.lds + RING_OFF, g, S, E, F.wave);
        if (BOTH(3)) GRID_BAR(3);
    }

    if (IN(4)) {
        pg8::Gemm g{(const bf16*)((MK_REPEAT_PHASE == 3) ? ws + 458 * MiB : F.XN8), F.Wgu_t, M, NGU, D}; pg8::StaticOrder S; S.init(M, NGU, F.G, (int)blockIdx.x, MK_REPEAT_PHASE == 4 ? 2 : 1);
        pg8::EpiGU E{F.ssq1, F.HB};
        if (MK_REPEAT_PHASE == 40) { S.r1 = 6; pg8::gemm_phase<pg8::EpiGU, pg8::StaticOrder, true, true, true>(F.lds + RING_OFF, g, S, E, F.wave); GRID_BAR(9); S.r0 = 6; S.r1 = 1 << 30; }
        pg8::gemm_phase<pg8::EpiGU, pg8::StaticOrder, true, true, true>(F.lds + RING_OFF, g, S, E, F.wave);
        if (BOTH(4)) GRID_BAR(4);
    }

    if (IN(5)) {
        pg8::Gemm g{(const bf16*)F.HB, F.Wd_t, M, D, FF};   pg8::StaticOrder S; S.init(M, D, F.G, (int)blockIdx.x, MK_REPEAT_PHASE == 5 ? 2 : 1);
#if defined(MK_SPLIT_FINAL)
        pg8::EpiDown E{F.XN, F.out, F.ssq2};
        pg8::gemm_phase<pg8::EpiDown, pg8::StaticOrder, true, true, true>(F.lds + RING_OFF, g, S, E, F.wave);
        if (BOTH(5)) GRID_BAR(5);
#else
        if (F.G == 256) { pg8::EpiDownNorm E{(MK_REPEAT_PHASE == 3) ? (bf16*)(ws + 394 * MiB) : F.XN, F.out, F.ssq2, (unsigned*)(F.ctl + CW_PANEL), F.final_norm};
            pg8::gemm_phase<pg8::EpiDownNorm, pg8::StaticOrder, true, true, true>(F.lds + RING_OFF, g, S, E, F.wave); }
        else { pg8::EpiDown E{F.XN, F.out, F.ssq2}; pg8::gemm_phase<pg8::EpiDown, pg8::StaticOrder, true, true, true>(F.lds + RING_OFF, g, S, E, F.wave); GRID_BAR(5); p6_final(F); }
#endif
    }

#if defined(MK_SPLIT_FINAL)
    if (IN(6)) { p6_final(F); }
#endif
#undef IN
#undef BOTH
}

extern "C" void kernel_launch(void* const* d_in, const int* in_sizes, int n_in, void* d_out, int out_size, void* d_ws, size_t ws_size, hipStream_t stream) {
    static int grid = 0;
    if (grid == 0) {
        if (n_in != 11 || in_sizes[0] != M * D || out_size != M * D || ws_size < WS_END) { fprintf(stderr, "kernel_launch: unexpected shapes (n_in %d, in0 %d, out %d, ws %zu); nothing launched\n", n_in, n_in > 0 ? in_sizes[0] : -1, out_size, ws_size); grid = -1; return; }
        int dev = 0, cus = 0, per_cu = 0;
        if (hipGetDevice(&dev) != hipSuccess || hipDeviceGetAttribute(&cus, hipDeviceAttributeMultiprocessorCount, dev) != hipSuccess) { grid = -1; return; }
        if (hipFuncSetAttribute((const void*)mk_fwd, hipFuncAttributeMaxDynamicSharedMemorySize, LDS_BYTES) != hipSuccess) { fprintf(stderr, "kernel_launch: hipFuncSetAttribute failed\n"); grid = -1; return; }
        if (hipOccupancyMaxActiveBlocksPerMultiprocessor(&per_cu, (const void*)mk_fwd, NWAVES * 64, LDS_BYTES) != hipSuccess || per_cu < 1) { fprintf(stderr, "kernel_launch: occupancy query says %d blocks per CU\n", per_cu); (void)hipGetLastError(); per_cu = 1; }
        grid = cus;
        if (grid > 256) grid = 256;
    }
    if (grid < 0) return;
    if (hipMemsetAsync((char*)d_ws + WS_CTL, 0, CTL_ZERO_BYTES, stream) != hipSuccess) { fprintf(stderr, "kernel_launch: hipMemsetAsync failed\n"); return; }
    Args a{};
    for (int i = 0; i < 11; ++i) a.in[i] = (const float*)d_in[i];
    a.out = (float*)d_out; a.ws = (unsigned char*)d_ws;
    for (int li = 0; li < N_LAUNCHES; ++li) {
        a.ph_lo = (N_LAUNCHES == PER_PHASE) ? li : 0; a.ph_hi = (N_LAUNCHES == PER_PHASE) ? li + 1 : PER_PHASE; a.li = li;
        hipLaunchKernelGGL(mk_fwd, dim3(grid), dim3(NWAVES * 64), LDS_BYTES, stream, a);
        const hipError_t le = hipPeekAtLastError();
        if (le != hipSuccess) { fprintf(stderr, "kernel_launch: launch %d failed: %s\n", li, hipGetErrorName(le)); break; }
    }
}
```

```cpp
#include <hip/hip_runtime.h>
#include <cstdio>
#include <cstdint>
namespace pg8 {
#define PG8_LAS __attribute__((address_space(3)))
typedef unsigned short bf16_t;
typedef short bf16x8 __attribute__((ext_vector_type(8)));
typedef float f32x4 __attribute__((ext_vector_type(4)));
typedef unsigned u32x4 __attribute__((ext_vector_type(4)));
typedef int i32x4 __attribute__((ext_vector_type(4)));
typedef int i32x8 __attribute__((ext_vector_type(8)));
typedef unsigned u32x2 __attribute__((ext_vector_type(2)));
constexpr int BM = 256, BK = 64, HALF = 128, HTB = HALF * BK * 2  , STAGE_BYTES = 8 * HTB, NXCD = 8, WGM = 8;

__host__ __device__ __forceinline__ int lds_byte(int r, int c) { const int st = (r >> 4) * 2 + (c >> 5), rr = r & 15, cc = c & 31, ob = rr * 64 + cc * 2; return st * 1024 + (ob ^ (((ob >> 9) & 1) << 5)); }
__host__ __device__ __forceinline__ void stage_rc(int b, int& R, int& C) { const int st = b / 1024, sb = b % 1024, swz = sb ^ (((sb >> 9) & 1) << 5); R = (st >> 1) * 16 + swz / 64; C = (st & 1) * 32 + (swz % 64) / 2; }
__host__ __device__ __forceinline__ int perm32(int rho) { const int n = rho >> 4, i = rho & 15; return 8 * (i >> 2) + 4 * n + (i & 3); }

struct Unit { int pm, pn; };
struct Gemm { const bf16_t* A; const bf16_t* Bt; int M, N, K; };

struct StaticOrder {
    int nM, nN, nwg, G, c, reps, r0 = 0, r1 = 1 << 30;
    __host__ __device__ void init(int M, int N, int G_, int c_, int reps_ = 1) { nM = M / BM; nN = N / BM; nwg = nM * nN; G = G_; c = c_; reps = reps_; }
    __host__ __device__ bool next(int i, Unit& u) const {
        const int rounds = (nwg + G - 1) / G; i += r0; if (i >= reps * rounds || i >= r1) return false;
        const long L = (long)(i % rounds) * G + c; if (L >= nwg) return false;
        int wgid = (int)L; { const int q = nwg / NXCD, r = nwg % NXCD, xcd = wgid % NXCD, off = wgid / NXCD; wgid = (xcd < r ? xcd * (q + 1) : r * (q + 1) + (xcd - r) * q) + off; }
        const int nig = WGM * nN, gid = wgid / nig, fm = gid * WGM, gsz = (nM - fm) < WGM ? (nM - fm) : WGM;
        u.pm = fm + ((wgid % nig) % gsz); u.pn = (wgid % nig) / gsz; return true;
    }
    __device__ __forceinline__ void a_ready(const Unit&) const {}
    __device__ __forceinline__ void done(const Unit&) const {}
};


__device__ __forceinline__ unsigned cvt_pk_bf16(float lo, float hi) { unsigned r; asm volatile("v_cvt_pk_bf16_f32 %0, %1, %2" : "=v"(r) : "v"(lo), "v"(hi)); return r; }
__device__ __forceinline__ u32x4 pack8(const f32x4 a, const f32x4 b) { u32x4 w; w.x = cvt_pk_bf16(a[0], a[1]); w.y = cvt_pk_bf16(a[2], a[3]); w.z = cvt_pk_bf16(b[0], b[1]); w.w = cvt_pk_bf16(b[2], b[3]); return w; }
__device__ __forceinline__ float sum4(const f32x4 a) { return (a[0] + a[1]) + (a[2] + a[3]); }
__device__ __forceinline__ float sq4(const f32x4 a) { return (a[0] * a[0] + a[1] * a[1]) + (a[2] * a[2] + a[3] * a[3]); }
constexpr float RMS_EPS_F = 1e-6f;
__device__ __forceinline__ int lane_id() { int l; asm volatile("v_mbcnt_lo_u32_b32 %0, -1, 0\n\tv_mbcnt_hi_u32_b32 %0, -1, %0" : "=v"(l)); return l; }
__device__ __forceinline__ u32x2 pack8_fp8(const f32x4 a, const f32x4 b) { u32x2 w; unsigned t = 0;
    t = __builtin_amdgcn_cvt_pk_fp8_f32(a[0], a[1], t, false); t = __builtin_amdgcn_cvt_pk_fp8_f32(a[2], a[3], t, true); w.x = t; t = 0;
    t = __builtin_amdgcn_cvt_pk_fp8_f32(b[0], b[1], t, false); t = __builtin_amdgcn_cvt_pk_fp8_f32(b[2], b[3], t, true); w.y = t; return w; }
constexpr float F8_SA = 16.f, F8_SH = 8.f, F8_SW = 512.f, F8_SO = 64.f;
typedef float f32x2 __attribute__((ext_vector_type(2)));

struct EpiQKV {
    static constexpr bool PERM = true, AFTER_DRAIN = false, HAS_MID = false;
    bf16_t* Q; size_t part_stride; const float* rope; float* kpart; float qscale; int mapsel; float ascale;
    __device__ __forceinline__ void operator()(const f32x4 (&acc)[2][2][4][2], const Unit& u, int wr, int wc, int fr_, int fq_) const {
        const int ln_ = lane_id(), fr = ln_ & 15, fq = ln_ >> 4;
        const int rp = mapsel == 1 ? ((u.pn & 1) + 4 * (u.pn >> 1)) : (mapsel == 2 ? (u.pn < 4 ? (2 + (u.pn & 1) + 4 * (u.pn >> 1)) : u.pn + 4) : u.pn);
        const int part = rp >> 2, head = (rp & 3) * 4 + wc;
        bf16_t* base = Q + (size_t)part * part_stride + head * 64 + 8 * fq;
        const float sc = part == 0 ? qscale : 1.f;
        const bool rot = part != 2, km = (part == 1) && (head < 8);
        const int row0 = u.pm * BM + wr * 64 + fr;
        int rbase = row0; asm volatile("" : "+v"(rbase));
        f32x4 T[2][4], S16[4];
#pragma unroll
        for (int q = 0; q < 4; ++q) { T[0][q] = T[1][q] = S16[q] = (f32x4){1.f, 0.f, 1.f, 0.f}; }
        if (rot) {
            const f32x4* r16 = (const f32x4*)(rope + ((size_t)16 * 32 + 8 * fq) * 2);
            const f32x4* ra = (const f32x4*)(rope + ((size_t)(rbase & 4095) * 32 + 8 * fq) * 2);
            const f32x4* rb = (const f32x4*)(rope + ((size_t)((rbase + HALF) & 4095) * 32 + 8 * fq) * 2);
#pragma unroll
            for (int q = 0; q < 4; ++q) { T[0][q] = ra[q]; T[1][q] = rb[q]; S16[q] = r16[q]; }
        }
        f32x4 ks[2][2];
#pragma unroll
        for (int a = 0; a < 2; ++a)
#pragma unroll
            for (int b = 0; b < 2; ++b) ks[a][b] = (f32x4){0.f, 0.f, 0.f, 0.f};
#pragma unroll
        for (int ai = 0; ai < 2; ++ai)
#pragma unroll
            for (int m = 0; m < 4; ++m) {
                const int row = rbase + ai * HALF + m * 16;
                if (m > 0 && rot) {
#pragma unroll
                    for (int q = 0; q < 4; ++q) { const f32x4 t = T[ai][q], st = S16[q];
                        T[ai][q] = (f32x4){t[0] * st[0] - t[1] * st[1], t[1] * st[0] + t[0] * st[1], t[2] * st[2] - t[3] * st[3], t[3] * st[2] + t[2] * st[3]}; }
                }
                const f32x4 t0 = T[ai][0], t1 = T[ai][1], t2 = T[ai][2], t3 = T[ai][3];
                f32x4 o1[2], o2[2];
#pragma unroll
                for (int n = 0; n < 2; ++n) {
                    const f32x4 cv = n == 0 ? (f32x4){t0[0], t0[2], t1[0], t1[2]} : (f32x4){t2[0], t2[2], t3[0], t3[2]};
                    const f32x4 sv = n == 0 ? (f32x4){t0[1], t0[3], t1[1], t1[3]} : (f32x4){t2[1], t2[3], t3[1], t3[3]};
                    const f32x4 x1 = acc[ai][0][m][n] * ascale, x2 = acc[ai][1][m][n] * ascale;
                    o1[n] = x1 * cv - x2 * sv; o2[n] = x2 * cv + x1 * sv;
                    if (km) { ks[0][n] += o1[n]; ks[1][n] += o2[n]; }
                    o1[n] = o1[n] * sc; o2[n] = o2[n] * sc;
                }
                bf16_t* rowp = base + (size_t)row * 1024;
                *(u32x4*)(rowp) = pack8(o1[0], o1[1]); *(u32x4*)(rowp + 32) = pack8(o2[0], o2[1]);
            }
        if (km) {
#pragma unroll
            for (int bj = 0; bj < 2; ++bj)
#pragma unroll
                for (int n = 0; n < 2; ++n) { f32x4 v = ks[bj][n];
#pragma unroll
                    for (int o = 1; o < 16; o <<= 1) { v[0] += __shfl_xor(v[0], o); v[1] += __shfl_xor(v[1], o); v[2] += __shfl_xor(v[2], o); v[3] += __shfl_xor(v[3], o); }
                    if (fr == 0) *(f32x4*)(kpart + (size_t)(u.pm * 2 + wr) * 512 + head * 64 + 32 * bj + 8 * fq + 4 * n) = v; }
        }
    }
};

struct EpiWo {
    static constexpr bool PERM = true, AFTER_DRAIN = false, HAS_MID = true;
    const float* rn0; const float* gain0; bf16_t* xn; bf16_t* xo; unsigned char* xn8;
    const float* ssq_att; float* ssq1;
    __device__ __forceinline__ void rstds(int row, int fq, float& rm, float& rd) const {
        const float s = sum4(*(const f32x4*)(ssq_att + (size_t)row * 16 + 4 * fq));
        const float t = s + __shfl_xor(s, 16), o = __shfl_xor(t, 32);
        rm = __builtin_amdgcn_rsqf((fq < 2 ? t : o) * (1.f / 512.f) + RMS_EPS_F);
        rd = __builtin_amdgcn_rsqf((fq < 2 ? o : t) * (1.f / 512.f) + RMS_EPS_F);
    }
    static constexpr float ASCALE = 1.f / (F8_SO * F8_SW);
    __device__ __forceinline__ void mid(f32x4 (&acc)[2][2][4][2], const Unit& u, int wr, int fr_) const {
        const int ln_ = lane_id(), fr = ln_ & 15, fq = ln_ >> 4;
        const int row0 = u.pm * BM + wr * 64 + fr;
        int rbase = row0; asm volatile("" : "+v"(rbase));
        float f[8];
#pragma unroll
        for (int i = 0; i < 8; ++i) { float rm, rd; rstds(rbase + (i >> 2) * HALF + (i & 3) * 16, fq, rm, rd); f[i] = rm / rd; }
#pragma unroll
        for (int ai = 0; ai < 2; ++ai)
#pragma unroll
            for (int m = 0; m < 4; ++m)
#pragma unroll
                for (int bj = 0; bj < 2; ++bj)
#pragma unroll
                    for (int n = 0; n < 2; ++n) acc[ai][bj][m][n] = acc[ai][bj][m][n] * f[ai * 4 + m];
    }
    __device__ __forceinline__ void operator()(const f32x4 (&acc)[2][2][4][2], const Unit& u, int wr, int wc, int fr_, int fq_) const {
        const int ln_ = lane_id(), fr = ln_ & 15, fq = ln_ >> 4;
        const int row0 = u.pm * BM + wr * 64 + fr, col0 = u.pn * BM + wc * 32 + 8 * fq;
        int rbase = row0; asm volatile("" : "+v"(rbase));
        f32x4 ig[2][2];
#pragma unroll
        for (int bj = 0; bj < 2; ++bj)
#pragma unroll
            for (int n = 0; n < 2; ++n) { const f32x4 g = *(const f32x4*)(gain0 + col0 + bj * HALF + 4 * n);
                ig[bj][n] = (f32x4){__builtin_amdgcn_rcpf(g[0]), __builtin_amdgcn_rcpf(g[1]), __builtin_amdgcn_rcpf(g[2]), __builtin_amdgcn_rcpf(g[3])}; }
        u32x4 xw[2][4][2]; f32x4 sa[2][4]; float rnv[2][4];
#define EPIWO_ISSUE(ai) do { _Pragma("unroll") for (int m = 0; m < 4; ++m) { unsigned row = (unsigned)(rbase + (ai) * HALF + m * 16); asm volatile("" : "+v"(row));     \
            sa[ai][m] = *(const f32x4*)((const char*)ssq_att + (row * 64u + 16u * fq)); rnv[ai][m] = *(const float*)((const char*)rn0 + row * 4u); \
            _Pragma("unroll") for (int bj = 0; bj < 2; ++bj) xw[ai][m][bj] = __builtin_nontemporal_load((const u32x4*)((const char*)xn + (row * 2048u + (unsigned)(col0 + bj * HALF) * 2u))); } } while (0)
        u32x4 pb[4][2]; u32x2 p8[4][2]; float sq[4];
#define EPIWO_COMPUTE(ai) do { _Pragma("unroll") for (int m = 0; m < 4; ++m) { \
            const float s4 = sum4(sa[ai][m]); const float t = s4 + __shfl_xor(s4, 16), o = __shfl_xor(t, 32); \
            const float rd = __builtin_amdgcn_rsqf((fq < 2 ? o : t) * (1.f / 512.f) + RMS_EPS_F); const float rn = rnv[ai][m]; float s = 0.f; \
            _Pragma("unroll") for (int bj = 0; bj < 2; ++bj) { const u32x4 w = xw[ai][m][bj]; \
                const f32x4 xa = (f32x4){__uint_as_float(w.x << 16), __uint_as_float(w.x & 0xffff0000u), __uint_as_float(w.y << 16), __uint_as_float(w.y & 0xffff0000u)} * ig[bj][0] * rn; \
                const f32x4 xb = (f32x4){__uint_as_float(w.z << 16), __uint_as_float(w.z & 0xffff0000u), __uint_as_float(w.w << 16), __uint_as_float(w.w & 0xffff0000u)} * ig[bj][1] * rn; \
                const f32x4 v0 = xa + acc[ai][bj][m][0] * (rd * ASCALE), v1 = xb + acc[ai][bj][m][1] * (rd * ASCALE); \
                pb[m][bj] = pack8(v0, v1); p8[m][bj] = pack8_fp8(v0 * F8_SA, v1 * F8_SA); s += sq4(v0) + sq4(v1); } \
            s += __shfl_xor(s, 16); s += __shfl_xor(s, 32); sq[m] = s; } } while (0)
#define EPIWO_STORE(ai) do { _Pragma("unroll") for (int m = 0; m < 4; ++m) { unsigned row = (unsigned)(rbase + (ai) * HALF + m * 16); asm volatile("" : "+v"(row)); \
            _Pragma("unroll") for (int bj = 0; bj < 2; ++bj) { const unsigned off = row * 1024u + (unsigned)(col0 + bj * HALF); *(u32x4*)((char*)xo + off * 2u) = pb[m][bj]; *(u32x2*)(xn8 + off) = p8[m][bj]; } \
            if (fq == 0) *(float*)((char*)ssq1 + (row * 64u + (unsigned)(u.pn * 4 + wc) * 4u)) = sq[m]; } } while (0)
        EPIWO_ISSUE(0);
        asm volatile("" ::: "memory");
        EPIWO_COMPUTE(0);
        asm volatile("" ::: "memory");
        EPIWO_ISSUE(1);
        asm volatile("" ::: "memory");
        EPIWO_STORE(0);
        asm volatile("" ::: "memory");
        EPIWO_COMPUTE(1);
        EPIWO_STORE(1);
#undef EPIWO_ISSUE
#undef EPIWO_COMPUTE
#undef EPIWO_STORE
    }
};

struct EpiGU {
    static constexpr bool PERM = true, AFTER_DRAIN = false, HAS_MID = false;
    const float* ssq1; unsigned char* H;
    __device__ __forceinline__ u32x2 row8(const f32x4 (&acc)[2][2][4][2], int ai, int m, float rstd) const {
        f32x4 h[2];
        const float rs_e = rstd * -1.4426950408889634f, rs_u = rstd * (rstd * F8_SH);
#pragma unroll
        for (int n = 0; n < 2; ++n) { const f32x4 ea = acc[ai][0][m][n] * rs_e, gu = (acc[ai][0][m][n] * acc[ai][1][m][n]) * rs_u;
#pragma unroll
            for (int i = 0; i < 4; ++i) h[n][i] = gu[i] * __builtin_amdgcn_rcpf(1.f + __builtin_amdgcn_exp2f(ea[i])); }
        return pack8_fp8(h[0], h[1]);
    }
    __device__ __forceinline__ void operator()(const f32x4 (&acc)[2][2][4][2], const Unit& u, int wr, int wc, int fr_, int fq_) const {
        const int ln_ = lane_id(), fr = ln_ & 15, fq = ln_ >> 4;
        const int row0 = u.pm * BM + wr * 64 + fr, colp = u.pn * HALF + wc * 32 + 16 * (fq >> 1);
        int rbase = row0; asm volatile("" : "+v"(rbase));
        f32x4 sv[8]; float rs[8];
#pragma unroll
        for (int i = 0; i < 8; ++i) sv[i] = *(const f32x4*)(ssq1 + (size_t)(rbase + (i >> 2) * HALF + (i & 3) * 16) * 16 + 4 * fq);
#pragma unroll
        for (int i = 0; i < 8; ++i) { float ss = sum4(sv[i]); ss += __shfl_xor(ss, 16); ss += __shfl_xor(ss, 32); rs[i] = __builtin_amdgcn_rsqf(ss * (1.f / 1024.f) + RMS_EPS_F) * (1.f / (F8_SA * F8_SW)); }
#pragma unroll
        for (int ai = 0; ai < 2; ++ai)
#pragma unroll
            for (int mp = 0; mp < 2; ++mp) { const int rowa = rbase + ai * HALF + mp * 32, rowb = rowa + 16;
                const u32x2 wa = row8(acc, ai, 2 * mp, rs[ai * 4 + 2 * mp]), wb = row8(acc, ai, 2 * mp + 1, rs[ai * 4 + 2 * mp + 1]);
                const auto sx = __builtin_amdgcn_permlane16_swap(wa.x, wb.x, false, false), sy = __builtin_amdgcn_permlane16_swap(wa.y, wb.y, false, false);
                u32x4 w; w.x = sx[0]; w.y = sy[0]; w.z = sx[1]; w.w = sy[1];
                *(u32x4*)(H + (size_t)((fq & 1) ? rowb : rowa) * 2816 + colp) = w; }
    }
};

struct EpiDown {
    static constexpr bool PERM = true, AFTER_DRAIN = false, HAS_MID = false;
    const bf16_t* xn; float* out; float* ssq2;
    __device__ __forceinline__ void operator()(const f32x4 (&acc)[2][2][4][2], const Unit& u, int wr, int wc, int fr_, int fq_) const {
        const int ln_ = lane_id(), fr = ln_ & 15, fq = ln_ >> 4;
        const int row0 = u.pm * BM + wr * 64 + fr, col0 = u.pn * BM + wc * 32 + 8 * fq;
        int rbase = row0; asm volatile("" : "+v"(rbase));
#pragma unroll
        for (int ai = 0; ai < 2; ++ai)
#pragma unroll
            for (int m = 0; m < 4; ++m) { const int row = rbase + ai * HALF + m * 16; float s = 0.f;
#pragma unroll
                for (int bj = 0; bj < 2; ++bj) { const size_t off = (size_t)row * 1024 + col0 + bj * HALF;
                    const u32x4 xw = __builtin_nontemporal_load((const u32x4*)(xn + off));
                    const f32x4 xa = {__uint_as_float(xw.x << 16), __uint_as_float(xw.x & 0xffff0000u), __uint_as_float(xw.y << 16), __uint_as_float(xw.y & 0xffff0000u)};
                    const f32x4 xb = {__uint_as_float(xw.z << 16), __uint_as_float(xw.z & 0xffff0000u), __uint_as_float(xw.w << 16), __uint_as_float(xw.w & 0xffff0000u)};
                    const f32x4 v0 = xa + acc[ai][bj][m][0] * (1.f / (F8_SH * F8_SW)), v1 = xb + acc[ai][bj][m][1] * (1.f / (F8_SH * F8_SW));
                    *(f32x4*)(out + off) = v0; *(f32x4*)(out + off + 4) = v1; s += sq4(v0) + sq4(v1); }
                s += __shfl_xor(s, 16); s += __shfl_xor(s, 32);
                if (fq == 0) ssq2[(size_t)row * 16 + u.pn * 4 + wc] = s;
                asm volatile("" ::: "memory"); }
    }
};

struct EpiDownNorm {
    static constexpr bool PERM = true, AFTER_DRAIN = false, HAS_MID = false;
    const bf16_t* xn; float* out; float* ssq2; unsigned* cnt; const float* gain;
    __device__ __forceinline__ void operator()(f32x4 (&acc)[2][2][4][2], const Unit& u, int wr, int wc, int fr_, int fq_) const {
        const int ln_ = lane_id(), fr = ln_ & 15, fq = ln_ >> 4;
        const int row0 = u.pm * BM + wr * 64 + fr, col0 = u.pn * BM + wc * 32 + 8 * fq;
        int rbase = row0; asm volatile("" : "+v"(rbase));
        {
            u32x4 xw[2][4][2];
#pragma unroll
            for (int ai = 0; ai < 2; ++ai)
#pragma unroll
                for (int m = 0; m < 4; ++m)
#pragma unroll
                    for (int bj = 0; bj < 2; ++bj) { unsigned off = (unsigned)(rbase + ai * HALF + m * 16) * 1024u + col0 + bj * HALF; asm volatile("" : "+v"(off)); xw[ai][m][bj] = __builtin_nontemporal_load((const u32x4*)(xn + off)); }
#pragma unroll
            for (int ai = 0; ai < 2; ++ai)
#pragma unroll
                for (int m = 0; m < 4; ++m) { const int row = rbase + ai * HALF + m * 16; float s = 0.f;
#pragma unroll
                    for (int bj = 0; bj < 2; ++bj) { const u32x4 w = xw[ai][m][bj];
                        const f32x4 xa = {__uint_as_float(w.x << 16), __uint_as_float(w.x & 0xffff0000u), __uint_as_float(w.y << 16), __uint_as_float(w.y & 0xffff0000u)};
                        const f32x4 xb = {__uint_as_float(w.z << 16), __uint_as_float(w.z & 0xffff0000u), __uint_as_float(w.w << 16), __uint_as_float(w.w & 0xffff0000u)};
                        acc[ai][bj][m][0] = acc[ai][bj][m][0] * (1.f / (F8_SH * F8_SW)) + xa; acc[ai][bj][m][1] = acc[ai][bj][m][1] * (1.f / (F8_SH * F8_SW)) + xb; s += sq4(acc[ai][bj][m][0]) + sq4(acc[ai][bj][m][1]); }
                    s += __shfl_xor(s, 16); s += __shfl_xor(s, 32);
                    if (fq == 0) __hip_atomic_store(ssq2 + (size_t)(u.pn * 4 + wc) * 32768 + row, s, __ATOMIC_RELAXED, __HIP_MEMORY_SCOPE_AGENT); }
        }
        asm volatile("s_waitcnt vmcnt(0)" ::: "memory");
        unsigned* cw = cnt + 64 * u.pm;
        if (fr == 0 && fq == 0) __hip_atomic_fetch_add(cw, 1u, __ATOMIC_RELAXED, __HIP_MEMORY_SCOPE_AGENT);
        { unsigned sp = 0; while ((unsigned)__builtin_amdgcn_readfirstlane((int)__hip_atomic_load(cw, __ATOMIC_RELAXED, __HIP_MEMORY_SCOPE_AGENT)) < 32u) { __builtin_amdgcn_s_sleep(1); if (++sp > (1u << 22)) break; } }
        f32x4 g[2][2];
#pragma unroll
        for (int bj = 0; bj < 2; ++bj) { g[bj][0] = *(const f32x4*)(gain + col0 + bj * HALF); g[bj][1] = *(const f32x4*)(gain + col0 + bj * HALF + 4); }
        float pv[8][4];
#pragma unroll
        for (int i = 0; i < 8; ++i) { const float* pp = ssq2 + (size_t)(4 * fq) * 32768 + (rbase + (i >> 2) * HALF + (i & 3) * 16);
#pragma unroll
            for (int j = 0; j < 4; ++j) pv[i][j] = __hip_atomic_load(pp + j * 32768, __ATOMIC_RELAXED, __HIP_MEMORY_SCOPE_AGENT); }
#pragma unroll
        for (int ai = 0; ai < 2; ++ai)
#pragma unroll
            for (int m = 0; m < 4; ++m) { const int row = rbase + ai * HALF + m * 16;
                float s = (pv[ai * 4 + m][0] + pv[ai * 4 + m][1]) + (pv[ai * 4 + m][2] + pv[ai * 4 + m][3]);
                s += __shfl_xor(s, 16); s += __shfl_xor(s, 32);
                const float rstd = __builtin_amdgcn_rsqf(s * (1.f / 1024.f) + RMS_EPS_F);
#pragma unroll
                for (int bj = 0; bj < 2; ++bj) { const size_t off = (size_t)row * 1024 + col0 + bj * HALF;
                    *(f32x4*)(out + off) = acc[ai][bj][m][0] * rstd * g[bj][0]; *(f32x4*)(out + off + 4) = acc[ai][bj][m][1] * rstd * g[bj][1]; } }
    }
};
template <class Epi, class Sched, bool ALIGN_EPI = false, bool SP2 = false, bool F8 = false>
__device__ __forceinline__ void gemm_phase(PG8_LAS unsigned char* lds, const Gemm g, const Sched& S, const Epi& E, int wave) {
    const int wid = __builtin_amdgcn_readfirstlane(wave), lane = lane_id(), tid = wid * 64 + lane, wr = wid >> 2, wc = wid & 3, fr = lane & 15, fq = lane >> 4;
    const int K = F8 ? g.K / 2 : g.K, nt = K / BK;
    unsigned voffA[2], voffB[2];
#pragma unroll
    for (int i = 0; i < 2; ++i) { int R, C; stage_rc(tid * 16 + i * 8192, R, C); const int Rb = Epi::PERM ? ((R & ~31) + perm32(R & 31)) : R;
        voffA[i] = (unsigned)(R * K + C) * 2u; voffB[i] = (unsigned)(Rb * K + C) * 2u; }
    const unsigned kstep = (unsigned)(BK * 2);
    const unsigned hstep = (unsigned)HALF * K * 2;
    const unsigned tstep = 2 * hstep;
    const unsigned ldsw = (unsigned)wid * 1024u;
    const int aoff = lds_byte(wr * 64 + fr, fq * 8), boff = lds_byte(wc * 32 + fr, fq * 8);
#define PG8_SA(b, h) (((b) * 2 + (h)) * HTB)
#define PG8_SB(b, h) ((4 + (b) * 2 + (h)) * HTB)
    const __amdgpu_buffer_rsrc_t rsA = __builtin_amdgcn_make_buffer_rsrc((void*)g.A, 0, 0x7fffffff, 0x00020000), rsB = __builtin_amdgcn_make_buffer_rsrc((void*)g.Bt, 0, 0x7fffffff, 0x00020000);
#define PG8_STAGE(bufoff, gbase, voff) do { _Pragma("unroll") for (int _i = 0; _i < 2; ++_i) \
        __builtin_amdgcn_raw_ptr_buffer_load_lds(PG8_RS_##voff, (PG8_LAS unsigned*)(lds + (bufoff) + ldsw + _i * 8192), 16, (voff)[_i], (int)(gbase), 0, 0); } while (0)
#define PG8_RS_voffA rsA
#define PG8_RS_voffB rsB
#define PG8_LD8(base, off) __builtin_shufflevector(*(const PG8_LAS i32x4*)((base) + (off)), *(const PG8_LAS i32x4*)((base) + (off) + 1024), 0, 1, 2, 3, 4, 5, 6, 7)
#define PG8_LDA(dst, b, h) do { if constexpr (F8) { _Pragma("unroll") for (int m = 0; m < 4; ++m) dst##8[m] = PG8_LD8(abase8, PG8_SA(b, h) + m * 2048); } else { \
        _Pragma("unroll") for (int m = 0; m < 4; ++m) _Pragma("unroll") for (int k = 0; k < 2; ++k) dst[m][k] = *(const PG8_LAS bf16x8*)(lds + PG8_SA(b, h) + aoff + m * 2048 + k * 1024); } } while (0)
#define PG8_LDB(dst, b, h) do { if constexpr (F8) { _Pragma("unroll") for (int n = 0; n < 2; ++n) dst##8[n] = PG8_LD8(bbase8, PG8_SB(b, h) - PG8_SB(0, 0) + n * 2048); } else { \
        _Pragma("unroll") for (int n = 0; n < 2; ++n) _Pragma("unroll") for (int k = 0; k < 2; ++k) dst[n][k] = *(const PG8_LAS bf16x8*)(lds + PG8_SB(b, h) + boff + n * 2048 + k * 1024); } } while (0)
#define PG8_MMA(ai, bj, At, Bt) do { __builtin_amdgcn_s_setprio(1); if constexpr (F8) { _Pragma("unroll") for (int m = 0; m < 4; ++m) _Pragma("unroll") for (int n = 0; n < 2; ++n) \
        acc[ai][bj][m][n] = __builtin_amdgcn_mfma_scale_f32_16x16x128_f8f6f4(Bt##8[n], At##8[m], acc[ai][bj][m][n], 0, 0, 0, 0, 0, 0); } else \
        _Pragma("unroll") for (int m = 0; m < 4; ++m) _Pragma("unroll") for (int n = 0; n < 2; ++n) _Pragma("unroll") for (int k = 0; k < 2; ++k) \
        acc[ai][bj][m][n] = __builtin_amdgcn_mfma_f32_16x16x32_bf16(Bt[n][k], At[m][k], acc[ai][bj][m][n], 0, 0, 0); __builtin_amdgcn_s_setprio(0); } while (0)
#define PG8_WAIT_V(n) asm volatile("s_waitcnt vmcnt(" #n ")" ::: "memory")
#define PG8_WAIT_L(n) asm volatile("s_waitcnt lgkmcnt(" #n ")" ::: "memory")
#define PG8_BAR __builtin_amdgcn_s_barrier()
#define PG8_SCHED __builtin_amdgcn_sched_barrier(0)
    Unit cur, nxt; int ui = 0;
    if (!S.next(0, cur)) return;
    f32x4 acc[2][2][4][2];
#pragma unroll
    for (int a = 0; a < 2; ++a)
#pragma unroll
        for (int b = 0; b < 2; ++b)
#pragma unroll
            for (int m = 0; m < 4; ++m)
#pragma unroll
                for (int n = 0; n < 2; ++n) acc[a][b][m][n] = (f32x4){0.f, 0.f, 0.f, 0.f};
    PG8_LAS unsigned char* abase8 = lds + aoff; PG8_LAS unsigned char* bbase8 = lds + PG8_SB(0, 0) + boff;
    if constexpr (F8) { asm volatile("" : "+v"(abase8)); asm volatile("" : "+v"(bbase8)); }
    bf16x8 At[4][2], B0[2][2], B1[2][2]; i32x8 At8[4], B08[2], B18[2];
    unsigned cA = (unsigned)cur.pm * tstep, cB = (unsigned)cur.pn * tstep;
    S.a_ready(cur);
    if constexpr (SP2) {
        PG8_STAGE(PG8_SB(0, 0), cB, voffB); PG8_STAGE(PG8_SB(0, 1), cB + hstep, voffB); PG8_STAGE(PG8_SA(0, 0), cA, voffA); PG8_STAGE(PG8_SA(0, 1), cA + hstep, voffA);
        if (wr == 1) PG8_BAR;
        PG8_WAIT_V(2); PG8_BAR;
        PG8_STAGE(PG8_SB(1, 0), cB + kstep, voffB); PG8_STAGE(PG8_SA(1, 0), cA + kstep, voffA); PG8_STAGE(PG8_SB(1, 1), cB + hstep + kstep, voffB);
        PG8_WAIT_V(6); PG8_BAR;
    } else {
        PG8_STAGE(PG8_SB(0, 0), cB, voffB); PG8_STAGE(PG8_SA(0, 0), cA, voffA); PG8_STAGE(PG8_SB(0, 1), cB + hstep, voffB); PG8_STAGE(PG8_SA(0, 1), cA + hstep, voffA);
        if (wr == 1) PG8_BAR;
        PG8_WAIT_V(4); PG8_BAR;
        PG8_STAGE(PG8_SB(1, 0), cB + kstep, voffB); PG8_STAGE(PG8_SA(1, 0), cA + kstep, voffA); PG8_STAGE(PG8_SB(1, 1), cB + hstep + kstep, voffB);
        PG8_WAIT_V(6); PG8_BAR;
    }
    for (;;) {
        const bool has_next = S.next(ui + 1, nxt);
        const unsigned nA = has_next ? (unsigned)nxt.pm * tstep : cA, nB = has_next ? (unsigned)nxt.pn * tstep : cB;
#pragma nounroll
        for (int t = 0; t < nt; t += 2) {
            if constexpr (Epi::HAS_MID) { if (t == (nt >> 1)) E.mid(acc, cur, wr, fr); }
            const bool last = (t == nt - 2);
            const unsigned a1 = cA + (unsigned)(t + 1) * kstep;
            const unsigned a2 = last ? nA : cA + (unsigned)(t + 2) * kstep, b2 = last ? nB : cB + (unsigned)(t + 2) * kstep;
            const unsigned a3 = a2 + kstep, b3 = b2 + kstep;
            if (last && has_next) S.a_ready(nxt);
            if constexpr (SP2) {
            PG8_LDB(B0, 0, 0); PG8_LDB(B1, 0, 1); PG8_SCHED; PG8_LDA(At, 0, 0); PG8_STAGE(PG8_SA(1, 1), a1 + hstep, voffA);
            PG8_WAIT_V(8); PG8_WAIT_L(0); PG8_BAR; PG8_MMA(0, 0, At, B0); PG8_MMA(0, 1, At, B1); PG8_BAR; PG8_SCHED;
            PG8_LDA(At, 0, 1); PG8_STAGE(PG8_SB(0, 0), b2, voffB); PG8_STAGE(PG8_SB(0, 1), b2 + hstep, voffB); PG8_STAGE(PG8_SA(0, 0), a2, voffA);
            PG8_WAIT_V(8); PG8_WAIT_L(0); PG8_BAR; PG8_MMA(1, 0, At, B0); PG8_MMA(1, 1, At, B1); PG8_BAR; PG8_SCHED;
            PG8_LDB(B0, 1, 0); PG8_LDB(B1, 1, 1); PG8_SCHED; PG8_LDA(At, 1, 0); PG8_STAGE(PG8_SA(0, 1), a2 + hstep, voffA);
            PG8_WAIT_V(8); PG8_WAIT_L(0); PG8_BAR; PG8_MMA(0, 0, At, B0); PG8_MMA(0, 1, At, B1); PG8_BAR; PG8_SCHED;
            PG8_LDA(At, 1, 1); PG8_STAGE(PG8_SB(1, 0), b3, voffB); PG8_STAGE(PG8_SB(1, 1), b3 + hstep, voffB); PG8_STAGE(PG8_SA(1, 0), a3, voffA);
            PG8_WAIT_V(8); PG8_WAIT_L(0); PG8_BAR; PG8_MMA(1, 0, At, B0); PG8_MMA(1, 1, At, B1); PG8_BAR; PG8_SCHED;
            } else {
            PG8_LDB(B0, 0, 0); PG8_SCHED; PG8_LDA(At, 0, 0); PG8_STAGE(PG8_SA(1, 1), a1 + hstep, voffA);
            PG8_WAIT_L(8); PG8_BAR; PG8_WAIT_L(0); PG8_MMA(0, 0, At, B0); PG8_BAR; PG8_SCHED;
            PG8_LDB(B1, 0, 1); PG8_STAGE(PG8_SB(0, 0), b2, voffB);
            PG8_BAR; PG8_WAIT_L(0); PG8_MMA(0, 1, At, B1); PG8_BAR;
            PG8_LDA(At, 0, 1); PG8_STAGE(PG8_SA(0, 0), a2, voffA);
            PG8_BAR; PG8_WAIT_L(0); PG8_MMA(1, 0, At, B0); PG8_BAR; PG8_SCHED;
            PG8_STAGE(PG8_SB(0, 1), b2 + hstep, voffB);
            PG8_WAIT_V(6); PG8_BAR; PG8_MMA(1, 1, At, B1); PG8_BAR;
            PG8_LDB(B0, 1, 0); PG8_SCHED; PG8_LDA(At, 1, 0); PG8_STAGE(PG8_SA(0, 1), a2 + hstep, voffA);
            PG8_WAIT_L(8); PG8_BAR; PG8_WAIT_L(0); PG8_MMA(0, 0, At, B0); PG8_BAR; PG8_SCHED;
            PG8_LDB(B1, 1, 1); PG8_STAGE(PG8_SB(1, 0), b3, voffB);
            PG8_BAR; PG8_WAIT_L(0); PG8_MMA(0, 1, At, B1); PG8_BAR;
            PG8_LDA(At, 1, 1); PG8_STAGE(PG8_SA(1, 0), a3, voffA);
            PG8_BAR; PG8_WAIT_L(0); PG8_MMA(1, 0, At, B0); PG8_BAR; PG8_SCHED;
            PG8_STAGE(PG8_SB(1, 1), b3 + hstep, voffB);
            PG8_WAIT_V(6); PG8_BAR; PG8_MMA(1, 1, At, B1); PG8_BAR;
            }
        }
        if constexpr (ALIGN_EPI) { if (wr == 0) PG8_BAR; }
        if constexpr (!Epi::AFTER_DRAIN) { E(acc, cur, wr, wc, fr, fq); S.done(cur); }
        if (!has_next) break;
#pragma unroll
        for (int a = 0; a < 2; ++a)
#pragma unroll
            for (int b = 0; b < 2; ++b)
#pragma unroll
                for (int m = 0; m < 4; ++m)
#pragma unroll
                    for (int n = 0; n < 2; ++n) acc[a][b][m][n] = (f32x4){0.f, 0.f, 0.f, 0.f};
        cur = nxt; cA = nA; cB = nB; ++ui;
        if constexpr (ALIGN_EPI) { if (wr == 1) PG8_BAR; }
    }
    PG8_WAIT_V(0);
    if constexpr (!ALIGN_EPI) { if (wr == 0) PG8_BAR; }
    PG8_BAR;
    if constexpr (Epi::AFTER_DRAIN) { E.fused(acc, cur, wr, wc, fr, fq, lds, wid, lane); S.done(cur); }
#undef PG8_SA
#undef PG8_SB
#undef PG8_STAGE
#undef PG8_RS_voffA
#undef PG8_RS_voffB
#undef PG8_LDA
#undef PG8_LDB
#undef PG8_MMA
#undef PG8_WAIT_V
#undef PG8_WAIT_L
#undef PG8_BAR
#undef PG8_SCHED
}
}

constexpr int NWAVES = 8;
#ifndef MK_N_LAUNCHES
#define MK_N_LAUNCHES 1
#endif
#ifndef MK_STAG1
#define MK_STAG1 1
#endif
constexpr int PER_PHASE = 7;
constexpr int N_LAUNCHES = MK_N_LAUNCHES;

constexpr int BATCH = 8, SEQ = 4096, D = 1024, NH = 16, HD = 64, FF = 2816, NHM = 8;
constexpr int M = BATCH * SEQ;
constexpr int NQKV = 3 * D, NGU = 2 * FF;
constexpr float RMS_EPS = 1e-6f;
constexpr float QSCALE = 0.125f * 1.4426950408889634f;

constexpr size_t MiB = 1u << 20;
constexpr size_t WS_CTL = 0, CTL_ZERO_BYTES = 64 * 1024;
constexpr size_t WS_ROPE = 1 * MiB;
constexpr size_t WS_WQKV = 2 * MiB, WS_WO = 8 * MiB, WS_WGU = 10 * MiB, WS_WD = 21 * MiB;
constexpr size_t WS_KPART = 27 * MiB;
constexpr size_t WS_SSQA = 28 * MiB, WS_SSQ1 = 30 * MiB, WS_SSQ2 = 32 * MiB;
constexpr size_t WS_XN = 40 * MiB;
constexpr size_t WS_QO = 104 * MiB, WS_K = 168 * MiB, WS_V = 232 * MiB;
constexpr size_t WS_H = 104 * MiB;
#ifndef MK_REPEAT_PHASE
#define MK_REPEAT_PHASE -1
#endif
constexpr size_t WS_O = WS_QO;
constexpr size_t WS_FARO = 296 * MiB, WS_FARL = 328 * MiB;
constexpr size_t WS_XN8 = 330 * MiB;
constexpr size_t WS_O8 = 362 * MiB;
constexpr size_t WS_END = (MK_REPEAT_PHASE == 3 ? 490 : 394) * MiB;
constexpr size_t QKV8_OFF = 2 * MiB;
constexpr int CW_TMO = 0, CW_CODE = 1;
constexpr int CW_BAR = 4096;
constexpr int CW_PANEL = 8192;
constexpr int CW_FAR = 2048;

constexpr int RING_OFF = 0, RING_BYTES = 131072;
constexpr int LDSCTL_OFF = RING_BYTES, MISC_OFF = LDSCTL_OFF + 320;
constexpr int LDS_BYTES = 147456;
static_assert(WS_V - WS_K == WS_K - WS_QO, "Q | K | V equally spaced");
#define GAS __attribute__((address_space(1)))
#define LAS __attribute__((address_space(3)))
typedef unsigned short bf16;
typedef unsigned v4u __attribute__((ext_vector_type(4)));
typedef float f32x4 __attribute__((ext_vector_type(4)));
typedef short bf16x8 __attribute__((ext_vector_type(8)));
typedef GAS unsigned gu32;
typedef GAS unsigned long long gu64;
#define RLX_AGENT __ATOMIC_RELAXED, __HIP_MEMORY_SCOPE_AGENT
#define LDS_WAIT() asm volatile("s_waitcnt lgkmcnt(0)" ::: "memory")
#define VM_WAIT() asm volatile("s_waitcnt vmcnt(0)" ::: "memory")
__device__ __forceinline__ unsigned long long rt() { return __builtin_amdgcn_s_memrealtime(); }
__device__ __forceinline__ unsigned f2bf(float f) { unsigned u = __builtin_bit_cast(unsigned, f); return (u + 0x7fffu + ((u >> 16) & 1u)) >> 16; }
__device__ __forceinline__ unsigned pk2(float lo, float hi) { return f2bf(lo) | (f2bf(hi) << 16); }

#define XB_TMO      128
#define XB_XCNT(j)  (256  + 64 * (j))
#define XB_XSUB(j)  (1280 + 64 * (j))
#define XB_XGEN(j)  (2304 + 64 * (j))
#define XB_TOP      3328
#define XB_TOPGEN   3392
#define XCD_BAR_WORDS 3456
#define XB_SPIN_CAP (1u << 18)

__device__ __forceinline__ unsigned xb_ld(unsigned* p)              { return __hip_atomic_load(p, __ATOMIC_RELAXED, __HIP_MEMORY_SCOPE_AGENT); }
__device__ __forceinline__ unsigned xb_add(unsigned* p, unsigned v) { return __hip_atomic_fetch_add(p, v, __ATOMIC_RELAXED, __HIP_MEMORY_SCOPE_AGENT); }
__device__ __forceinline__ unsigned xb_xcc_id() { return (unsigned)__builtin_amdgcn_s_getreg((3 << 11) | 20) & 0xFu; }
#define XB_SPIN(cond, bar) do { unsigned _sp = 0; while (cond) { __builtin_amdgcn_s_sleep(1); \
    if ((++_sp & 255u) == 0u) { if (xb_ld(&(bar)[XB_TMO])) break; if (_sp > XB_SPIN_CAP) { atomicAdd(&(bar)[XB_TMO], 1u); break; } } } } while (0)

struct XcdBarrier {
    unsigned* bar; unsigned x;
    volatile LAS unsigned* st;
};

__device__ __forceinline__ int mk_lane() { int l; asm volatile("v_mbcnt_lo_u32_b32 %0, -1, 0\n\tv_mbcnt_hi_u32_b32 %0, -1, %0" : "=v"(l)); return l; }
__device__ __forceinline__ XcdBarrier xcd_barrier_post(unsigned* bar, volatile LAS unsigned* st, int wave) {
    XcdBarrier b; b.bar = bar; b.x = xb_xcc_id(); b.st = st;
    if (wave == 0 && mk_lane() == 0) (void)xb_add(&bar[XB_XCNT(b.x)], 1u);
    return b;
}
__device__ __forceinline__ void xcd_barrier_complete(unsigned* bar, unsigned x, unsigned& nloc, unsigned& nx) {
    const unsigned G = gridDim.x * gridDim.y * gridDim.z;
    unsigned sum, cnt, mine, sp = 0u;
    for (;;) {
        sum = 0u; cnt = 0u; mine = 0u;
#pragma unroll
        for (unsigned j = 0; j < 16; ++j) { const unsigned c = xb_ld(&bar[XB_XCNT(j)]); sum += c; cnt += (c > 0u) ? 1u : 0u; mine = (j == x) ? c : mine; }
        if (sum == G) break;
        __builtin_amdgcn_s_sleep(1);
        if ((++sp & 255u) == 0u) { if (xb_ld(&bar[XB_TMO])) break; if (sp > XB_SPIN_CAP) { atomicAdd(&bar[XB_TMO], 1u); break; } }
    }
    nloc = mine > 0u ? mine : 1u; nx = cnt > 0u ? cnt : 1u;
}

__device__ __forceinline__ void xcd_barrier(const XcdBarrier& b, int wave) {
    asm volatile("s_waitcnt vmcnt(0)" ::: "memory");
    __syncthreads();
    if (wave == 0 && mk_lane() == 0) {
        unsigned* bar = b.bar;
        __builtin_amdgcn_s_waitcnt(0);
        unsigned nloc = b.st[0], nx = b.st[1];
        if (nloc == 0u) { xcd_barrier_complete(bar, b.x, nloc, nx); b.st[0] = nloc; b.st[1] = nx; }
        const unsigned old = xb_add(&bar[XB_XSUB(b.x)], 1u);
        const unsigned gen = old / nloc;
        if (old + 1u == (gen + 1u) * nloc) {
            __builtin_amdgcn_fence(__ATOMIC_RELEASE, "agent");
            asm volatile("s_waitcnt vmcnt(0)" ::: "memory");
            const unsigned og = xb_add(&bar[XB_TOP], 1u);
            const unsigned tg = og / nx;
            if (og + 1u == (tg + 1u) * nx) xb_add(&bar[XB_TOPGEN], 1u);
            else XB_SPIN(xb_ld(&bar[XB_TOPGEN]) == tg, bar);
            __builtin_amdgcn_fence(__ATOMIC_ACQUIRE, "agent");
            xb_add(&bar[XB_XGEN(b.x)], 1u);
            asm volatile("s_waitcnt vmcnt(0)" ::: "memory");
        } else {
            XB_SPIN(xb_ld(&bar[XB_XGEN(b.x)]) == gen, bar);
            __builtin_amdgcn_fence(__ATOMIC_ACQUIRE, "agent");
            asm volatile("s_waitcnt vmcnt(0)" ::: "memory");
        }
    }
    __syncthreads();
}

#include <hip/hip_bf16.h>
#include <cmath>
namespace attn_body {
using bf16=__hip_bfloat16;
using bf16x8=__attribute__((ext_vector_type(8)))short;
using s16x4=__attribute__((ext_vector_type(4)))short;
using f32x16=__attribute__((ext_vector_type(16)))float;
using u32x4=__attribute__((ext_vector_type(4)))unsigned;
using f32x4_t=__attribute__((ext_vector_type(4)))float;
constexpr int BATCH=8,NHEAD=16,SEQ=4096,D=64,DM=NHEAD*D;
constexpr int NW=8,QBLK=32,QB=QBLK*NW,KVBLK=64,NQB=SEQ/QB;
constexpr int ATTN_PITCH=DM, ATTN_UNIT_ROWS=QB;
__device__ __forceinline__ int crow(int r,int hi){return (r&3)+8*(r>>2)+4*hi;}
#define SBAR() __builtin_amdgcn_sched_barrier(0)
__device__ __forceinline__ void cmask(f32x16&p0,f32x16&p1,int jb,int qrel,int hi){
  const float NEG=-INFINITY; int kb=64*jb+4*hi;
  #pragma unroll
  for(int r=0;r<16;++r){int kv=kb+(r&3)+8*(r>>2); if(kv>qrel)p0[r]=NEG; if(kv+32>qrel)p1[r]=NEG;}
}

__device__ __forceinline__ void dm_range(f32x16&p0,f32x16&p1,int x,unsigned bw){
  #pragma unroll
  for(int r=0;r<16;++r){ const int kp=(r&3)+8*(r>>2); if((unsigned)(x-kp)>bw)p0[r]=-1e30f; if((unsigned)(x-32-kp)>bw)p1[r]=-1e30f; } }
template<int KIND> __device__ __forceinline__ int dmode(int lo){
  if(KIND==2) return (lo+94<33||lo>128)?0:4;
  return (lo+94<0||lo>512)?0:((lo<0)?40:((lo+94<=128)?1:((lo<=128)?41:((lo+94<=512)?2:42)))); }
__device__ __forceinline__ void dm_adj128(f32x16&p0,f32x16&p1,int dqh,const f32x16&adj){
  #pragma unroll
  for(int r=0;r<16;++r){ const int kp=(r&3)+8*(r>>2); p0[r]+=(dqh-kp>128)?adj[r]:0.f; p1[r]+=(dqh-32-kp>128)?adj[r]:0.f; } }
__device__ __forceinline__ void fmask(f32x16&p0,f32x16&p1,int dq){
  #pragma unroll
  for(int r=0;r<16;++r){ const int kp=(r&3)+8*(r>>2); if((unsigned)(dq-kp-33)>95u)p0[r]=-1e30f; if((unsigned)(dq-kp-65)>95u)p1[r]=-1e30f; }
}
constexpr int NSLOT=3, SLOTB=8192;
constexpr int LDS_K=0, LDS_V=NSLOT*SLOTB, LDS_WS=2*NSLOT*SLOTB, LDS_OST=LDS_WS+NW*64*4, LDS_BYTES=LDS_OST+NW*4096;
constexpr int LDS_TAB=LDS_BYTES, TABB=4096, LDS_ALL=LDS_TAB+4*TABB;
constexpr float C2=0.125f*1.4426950408889634f;
__device__ __forceinline__ void glds16(const void*gsrc,unsigned lds_dst){unsigned keep;
  asm volatile("s_mov_b32 %0, m0\n\ts_mov_b32 m0, %2\n\ts_nop 0\n\tglobal_load_lds_dwordx4 %1, off\n\ts_mov_b32 m0, %0":"=&s"(keep):"v"(gsrc),"s"(lds_dst):"memory");}
__device__ __forceinline__ float max3f(float a,float b,float c){float r;asm("v_max3_f32 %0, %1, %2, %3":"=v"(r):"v"(a),"v"(b),"v"(c));return r;}
__device__ __forceinline__ float max2f(float a,float b){float r;asm("v_max_f32_e32 %0, %1, %2":"=v"(r):"v"(a),"v"(b));return r;}
__device__ __forceinline__ float fadd_s(float a,float b){float r;asm("v_add_f32_e32 %0, %1, %2":"=v"(r):"v"(a),"v"(b));return r;}
__device__ __forceinline__ float fsub_s(float a,float b){float r;asm("v_sub_f32_e32 %0, %1, %2":"=v"(r):"v"(a),"v"(b));return r;}
typedef float f32x2_t __attribute__((ext_vector_type(2))); typedef __bf16 bf16x2_t __attribute__((ext_vector_type(2)));
__device__ __forceinline__ unsigned cvtpk_s(float lo,float hi){f32x2_t v={lo,hi};bf16x2_t b=__builtin_convertvector(v,bf16x2_t);return __builtin_bit_cast(unsigned,b);}
#define WAIT_BAR(N) asm volatile("s_waitcnt vmcnt(" #N ") lgkmcnt(0)\n\ts_barrier":::"memory")

__device__ __forceinline__ void qkt(f32x16&p0,f32x16&p1,const char*Kslot,const bf16x8*qr,const f32x16&negm,int r32,int hi){
  const char*kb=Kslot+hi*1024+r32*16;
  #pragma unroll
  for(int d0=0;d0<4;++d0){
    const bf16x8 b0=*reinterpret_cast<const bf16x8*>(kb+d0*2048);
    const bf16x8 b1=*reinterpret_cast<const bf16x8*>(kb+d0*2048+512);
    if(d0==0){p0=__builtin_amdgcn_mfma_f32_32x32x16_bf16(b0,qr[0],negm,0,0,0);p1=__builtin_amdgcn_mfma_f32_32x32x16_bf16(b1,qr[0],negm,0,0,0);}
    else{p0=__builtin_amdgcn_mfma_f32_32x32x16_bf16(b0,qr[d0],p0,0,0,0);p1=__builtin_amdgcn_mfma_f32_32x32x16_bf16(b1,qr[d0],p1,0,0,0);}}
}
typedef __attribute__((address_space(3))) const char* lds_cptr;
typedef short v4i16_t __attribute__((ext_vector_type(4)));
__device__ __forceinline__ void kload8(bf16x8*kf,lds_cptr kp){
  kf[0]=*(const __attribute__((address_space(3))) bf16x8*)(kp);      kf[1]=*(const __attribute__((address_space(3))) bf16x8*)(kp+512);
  kf[2]=*(const __attribute__((address_space(3))) bf16x8*)(kp+2048); kf[3]=*(const __attribute__((address_space(3))) bf16x8*)(kp+2560);
  kf[4]=*(const __attribute__((address_space(3))) bf16x8*)(kp+4096); kf[5]=*(const __attribute__((address_space(3))) bf16x8*)(kp+4608);
  kf[6]=*(const __attribute__((address_space(3))) bf16x8*)(kp+6144); kf[7]=*(const __attribute__((address_space(3))) bf16x8*)(kp+6656);
}
__device__ __forceinline__ void kload2(bf16x8*kf,lds_cptr kp,int j){ kf[2*j]=*(const __attribute__((address_space(3))) bf16x8*)(kp+j*2048); kf[2*j+1]=*(const __attribute__((address_space(3))) bf16x8*)(kp+j*2048+512); }
__device__ __forceinline__ s16x4 vtr(lds_cptr p){ return __builtin_bit_cast(s16x4,__builtin_amdgcn_ds_read_tr16_b64_v4i16((__attribute__((address_space(3))) v4i16_t*)p)); }
__device__ __forceinline__ float rowmax(const f32x16&p0,const f32x16&p1){
  float a=max3f(p0[0],p0[1],p1[0]),b=max3f(p0[2],p0[3],p1[1]);a=max3f(a,p1[2],p1[3]);
  #pragma unroll
  for(int r=4;r<16;r+=4){a=max3f(a,p0[r],p0[r+1]);b=max3f(b,p0[r+2],p0[r+3]);a=max3f(a,p1[r],p1[r+1]);b=max3f(b,p1[r+2],p1[r+3]);}
  const float m=max2f(a,b);
  auto rr=__builtin_amdgcn_permlane32_swap(__float_as_uint(m),__float_as_uint(m),false,false);
  return max2f(__uint_as_float(rr[0]),__uint_as_float(rr[1]));
}
__device__ __forceinline__ void pv(f32x16*o,int vb,bf16x8 pa0,bf16x8 pa1,bf16x8 pa2,bf16x8 pa3){
  #pragma unroll
  for(int d0=0;d0<2;++d0){s16x4 lo[4],hi[4];
    #pragma unroll
    for(int ks=0;ks<4;++ks){
      asm volatile("ds_read_b64_tr_b16 %0,%1 offset:%c2":"=&v"(lo[ks]):"v"(vb),"i"(d0*4096+ks*1024):"memory");
      asm volatile("ds_read_b64_tr_b16 %0,%1 offset:%c2":"=&v"(hi[ks]):"v"(vb),"i"(d0*4096+ks*1024+512):"memory");}
    asm volatile("s_waitcnt lgkmcnt(0)":::"memory");SBAR();
    #define PK(k) (bf16x8){lo[k][0],lo[k][1],lo[k][2],lo[k][3],hi[k][0],hi[k][1],hi[k][2],hi[k][3]}
    o[d0]=__builtin_amdgcn_mfma_f32_32x32x16_bf16(pa0,PK(0),o[d0],0,0,0);
    o[d0]=__builtin_amdgcn_mfma_f32_32x32x16_bf16(pa1,PK(1),o[d0],0,0,0);
    o[d0]=__builtin_amdgcn_mfma_f32_32x32x16_bf16(pa2,PK(2),o[d0],0,0,0);
    o[d0]=__builtin_amdgcn_mfma_f32_32x32x16_bf16(pa3,PK(3),o[d0],0,0,0);
    #undef PK
  }
}

#ifndef ATTN_STORE16
#define ATTN_STORE16(p,v) asm volatile("global_store_dwordx4 %0, %1, off sc1\n\ts_nop 1"::"v"(p),"v"(v):"memory")
#endif
template<int THRL,int KIND> __device__ __forceinline__ void attn_unit(int b,int h,int qb,unsigned char*ws,char*shm,int wave,bf16x8 (&qr)[4],bool pre,bool has_next,int nkind,int nb,int nh,int nqb){
  const bf16*Q=(const bf16*)(ws+WS_QO); const bf16*K=(const bf16*)(ws+WS_K); const bf16*V=(const bf16*)(ws+WS_V); unsigned char*O8=ws+WS_O8;
  float*ssq=(float*)(ws+WS_SSQA); const float*kpart=(const float*)(ws+WS_KPART); unsigned short*faro=(unsigned short*)(ws+WS_FARO); float*farl=(float*)(ws+WS_FARL);
  constexpr bool DIL=(KIND==1), FAR=(KIND==2); constexpr int RS=FAR?16:1;
  int tid=wave*64+mk_lane(); asm volatile("":"+v"(tid));
  const int lane=tid&63,r32=lane&31,hi=lane>>5; const int wid=__builtin_amdgcn_readfirstlane(tid>>6);
  const int rowbase=b*SEQ+(FAR?qb:0);   const int q0=FAR?0:qb*QB;
  const bf16*Qw=Q+(rowbase+(int)(q0+wid*QBLK)*RS)*DM+h*D;
  const int T0=DIL?(qb>2?4*qb-8:0):0;
  const bf16*Kh=K+(rowbase+(int)T0*KVBLK)*DM+h*D,*Vh=V+(rowbase+(int)T0*KVBLK)*DM+h*D;
  const unsigned lds0=(unsigned)(uintptr_t)shm;
  float*wsf=(float*)(shm+LDS_WS)+wid*64;
  const bf16*ksrc=Kh+(int)lane*RS*DM+wid*8;
  const bf16*vsrc=Vh+(int)(16*(wid&3)+(lane>>2))*RS*DM+(wid>>2)*32+(lane&3)*8;
  const unsigned kdst=lds0+LDS_K+wid*1024, vdst=lds0+LDS_V+wid*1024;
  #define DMA_K(t,slot) glds16(ksrc+(int)(t)*KVBLK*RS*DM,(unsigned)__builtin_amdgcn_readfirstlane(kdst+(slot)))
  #define DMA_V(t,slot) glds16(vsrc+(int)(t)*KVBLK*RS*DM,(unsigned)__builtin_amdgcn_readfirstlane(vdst+(slot)))
  const int vb0=(int)(lds0+LDS_V)+((lane>>4)&1)*32+(lane&3)*8+(4*hi+((lane&15)>>2))*64;
  const char*Kbase=shm+LDS_K; bf16x8 kf[8];
  const lds_cptr shm3=(lds_cptr)shm; const lds_cptr kp0=shm3+LDS_K+hi*1024+r32*16; const lds_cptr vp0=shm3+LDS_V+((lane>>4)&1)*32+(lane&3)*8+(4*hi+((lane&15)>>2))*64;
  const int NT=FAR?4:(q0+QB)/KVBLK-T0;
  if(!pre)DMA_K(0,0); DMA_V(0,0); if(!pre)DMA_K(1,SLOTB);
  #pragma unroll
  for(int d0=0;d0<4;++d0)if(!pre)qr[d0]=*reinterpret_cast<const bf16x8*>(&Qw[(int)r32*RS*DM+d0*16+hi*8]);
  float mhat=0.f,l_reg=0.f;f32x16 o[2];o[0]=f32x16{};o[1]=f32x16{};
  const int qrel=wid*QBLK+r32;
  const lds_cptr tabp=(lds_cptr)shm+LDS_TAB+lane*64;
  unsigned selmask=1u<<qb;
  if(KIND==0){
    f32x16 g=f32x16{};
    #pragma unroll
    for(int d0=0;d0<4;++d0){ float km[8];
      if(r32<16){ const float*kp_=kpart+(unsigned)((b*16+r32)*2)*512+h*64+d0*16+hi*8;
        const f32x4_t a0=*(const f32x4_t*)kp_,a1=*(const f32x4_t*)(kp_+4),b0=*(const f32x4_t*)(kp_+512),b1=*(const f32x4_t*)(kp_+516);
        km[0]=a0[0]+b0[0];km[1]=a0[1]+b0[1];km[2]=a0[2]+b0[2];km[3]=a0[3]+b0[3];km[4]=a1[0]+b1[0];km[5]=a1[1]+b1[1];km[6]=a1[2]+b1[2];km[7]=a1[3]+b1[3]; }
      else{ _Pragma("unroll") for(int j=0;j<8;++j)km[j]=0.f; }
      u32x4 wh,wl; float rs[8];
      wh[0]=cvtpk_s(km[0],km[1]);wh[1]=cvtpk_s(km[2],km[3]);wh[2]=cvtpk_s(km[4],km[5]);wh[3]=cvtpk_s(km[6],km[7]);
      #pragma unroll
      for(int j=0;j<4;++j){ rs[2*j]=km[2*j]-__uint_as_float(wh[j]<<16); rs[2*j+1]=km[2*j+1]-__uint_as_float(wh[j]&0xffff0000u); }
      wl[0]=cvtpk_s(rs[0],rs[1]);wl[1]=cvtpk_s(rs[2],rs[3]);wl[2]=cvtpk_s(rs[4],rs[5]);wl[3]=cvtpk_s(rs[6],rs[7]);
      g=__builtin_amdgcn_mfma_f32_32x32x16_bf16(__builtin_bit_cast(bf16x8,wh),qr[d0],g,0,0,0);
      g=__builtin_amdgcn_mfma_f32_32x32x16_bf16(__builtin_bit_cast(bf16x8,wl),qr[d0],g,0,0,0); }
    float gv[16];
    #pragma unroll
    for(int r=0;r<8;++r){ const float own=g[r],oth=__shfl_xor(own,32); const int bl=(r&3)+8*(r>>2); gv[bl]=hi?oth:own; gv[bl+4]=hi?own:oth; }
    #pragma unroll
    for(int j=0;j<16;++j) if(j>=qb)gv[j]=-3e38f;
    #pragma unroll
    for(int rd=0;rd<3;++rd){ float best=-3e38f;int bi=0;
      #pragma unroll
      for(int j=0;j<16;++j){ if(gv[j]>best){best=gv[j];bi=j;} }
      if(best>-3e38f)selmask|=1u<<bi;
      #pragma unroll
      for(int j=0;j<16;++j) if(j==bi)gv[j]=-3e38f; }
  }
  const int lo0=FAR?(32*wid-63):(q0-T0*KVBLK+32*wid-63);
  #define DMODE(t) dmode<KIND>(lo0-(t)*KVBLK)
  #define CMASK(P0,P1,t) do{ if(DIL){ if(md_t>=40){ const int dqh_=q0-(T0+(t))*KVBLK+qrel-4*hi; \
        if(md_t==41){ const f32x16 adj_=*(const __attribute__((address_space(3))) f32x16*)(tabp+3*TABB); dm_adj128(P0,P1,dqh_,adj_); } \
        else dm_range(P0,P1,dqh_-((md_t==40)?0:-4096),(md_t==40)?0x7fffffffu:4608u); } } \
    else if(FAR){ if(md_t==4)fmask(P0,P1,qrel-(t)*KVBLK-4*hi); } \
    else { int jb_=(t)-(NT-4); if(jb_>=0)cmask(P0,P1,jb_,qrel,hi); } }while(0)
  #define SETC(t) f32x16 ct; const int md_t=(KIND==0)?0:DMODE(t); { if(DIL){ const int to_=(md_t==0)?0:((md_t==2||md_t==42)?2*TABB:TABB); \
      const f32x16 tb_=*(const __attribute__((address_space(3))) f32x16*)(tabp+to_); _Pragma("unroll") for(int r=0;r<16;++r)ct[r]=tb_[r]-mhat; } \
    else { const float x_=(FAR?(md_t!=0):(((selmask>>((t)>>2))&1u)!=0u))?-mhat:-1e30f; _Pragma("unroll") for(int r=0;r<16;++r)ct[r]=x_; } asm volatile("":"+v"(ct)); }
  bool resc=false;
  #define START(P0,P1) do{ const float rm=rowmax(P0,P1); resc=false; \
    if(__any(rm>(float)THRL)){ const float dl=__builtin_fmaxf(rm,0.f); mhat=fadd_s(mhat,dl); \
      _Pragma("unroll") for(int r=0;r<16;++r){P0[r]=fsub_s(P0[r],dl);P1[r]=fsub_s(P1[r],dl);} \
      const float f=__builtin_amdgcn_exp2f(-dl); l_reg*=f; if(hi==0)wsf[r32]=f; resc=true; } \
    _Pragma("unroll") for(int r=0;r<16;++r)P0[r]=__builtin_amdgcn_exp2f(P0[r]); }while(0)
  #define RESC() do{ if(resc){ asm volatile("s_waitcnt lgkmcnt(0)":::"memory"); \
      _Pragma("unroll") for(int d_=0;d_<2;++d_) _Pragma("unroll") for(int r=0;r<16;++r)o[d_][r]*=wsf[crow(r,hi)]; } }while(0)
  f32x16 pA0,pA1,pB0,pB1;
  int sl_prev=0,sl_cur=0,sl_next=SLOTB;
  #define ROT() do{sl_prev=sl_cur;sl_cur=sl_next;sl_next=(sl_next==(NSLOT-1)*SLOTB)?0:sl_next+SLOTB;}while(0)
  if(!pre){ DMA_K(2,2*SLOTB);
    WAIT_BAR(3); }
  else { WAIT_BAR(1); }
  if(0)WAIT_BAR(3);
  { SETC(0); qkt(pA0,pA1,Kbase,qr,ct,r32,hi); asm volatile("s_nop 15\n\ts_nop 7":"+v"(pA0),"+v"(pA1));CMASK(pA0,pA1,0); }
  START(pA0,pA1);
  _Pragma("unroll") for(int r=0;r<16;++r)pA1[r]=__builtin_amdgcn_exp2f(pA1[r]);
  WAIT_BAR(0);
  RESC();
  DMA_K(3,0);DMA_V(1,SLOTB);
  ROT();
  kload8(kf,kp0+sl_cur);
  WAIT_BAR(2);
  s16x4 vlo[8],vhi[8]; u32x4 pw0,pw1,pw2,pw3;
  #define PKW(P,B) cvtpk_s(P[B],P[B+1])
  #define PAF(k) __builtin_bit_cast(bf16x8,pw##k)
  #define VFR(i) (bf16x8){vlo[i][0],vlo[i][1],vlo[i][2],vlo[i][3],vhi[i][0],vhi[i][1],vhi[i][2],vhi[i][3]}
  #define PIN(x) asm volatile("":"+v"(x))
  #define MX3(a,b,c) __builtin_fmaxf(__builtin_fmaxf((a),(b)),(c))
  #define GAPA(MF,A0,A1,A2,A3,W0,W1,PW) do{ MF; sacc+=A0; sacc+=A1; sacc+=A2; sacc+=A3; PIN(sacc); W0; W1; PIN(PW); SBAR(); }while(0)
  #define EX(v) __builtin_amdgcn_exp2f(v)
  #define GAPB(MF,X,B) do{ MF; X[B]=EX(X[B]); X[B+1]=EX(X[B+1]); X[B+2]=EX(X[B+2]); X[B+3]=EX(X[B+3]); PIN(X); SBAR(); }while(0)
  #define VRD(i) do{ vlo[i]=vtr(vp_+(((i)>>2)*4096+((i)&3)*1024)); vhi[i]=vtr(vp_+(((i)>>2)*4096+((i)&3)*1024+512)); }while(0)
  #define KRD(G,j) do{ if(G){ kload2(kf,kp0+sl_next,j); SBAR(); } }while(0)
  #define STEP(C0,C1,P0,P1,t,GK,GV,GL) do{ SBAR(); SETC(t); SBAR(); \
    const lds_cptr vp_=vp0+sl_prev; \
    VRD(0); SBAR(); float sacc=(P0[0]+P0[1]); \
    GAPA(C0=__builtin_amdgcn_mfma_f32_32x32x16_bf16(kf[0],qr[0],ct,0,0,0), P0[2],P0[3],P0[4],P0[5],     pw0[0]=PKW(P0,0), pw0[1]=PKW(P0,2), pw0); \
    VRD(4); SBAR(); GAPA(C1=__builtin_amdgcn_mfma_f32_32x32x16_bf16(kf[1],qr[0],ct,0,0,0), P0[6],P0[7],P0[8],P0[9],     pw0[2]=PKW(P0,4), pw0[3]=PKW(P0,6), pw0); \
    VRD(1); SBAR(); GAPA(C0=__builtin_amdgcn_mfma_f32_32x32x16_bf16(kf[2],qr[1],C0,0,0,0),   P0[10],P0[11],P0[12],P0[13], pw1[0]=PKW(P0,8), pw1[1]=PKW(P0,10), pw1); \
    VRD(5); SBAR(); GAPA(C1=__builtin_amdgcn_mfma_f32_32x32x16_bf16(kf[3],qr[1],C1,0,0,0),   P0[14],P0[15],P1[0],P1[1],   pw1[2]=PKW(P0,12),pw1[3]=PKW(P0,14), pw1); \
    VRD(2); SBAR(); GAPA(C0=__builtin_amdgcn_mfma_f32_32x32x16_bf16(kf[4],qr[2],C0,0,0,0),   P1[2],P1[3],P1[4],P1[5],     pw2[0]=PKW(P1,0), pw2[1]=PKW(P1,2), pw2); \
    VRD(6); SBAR(); GAPA(C1=__builtin_amdgcn_mfma_f32_32x32x16_bf16(kf[5],qr[2],C1,0,0,0),   P1[6],P1[7],P1[8],P1[9],     pw2[2]=PKW(P1,4), pw2[3]=PKW(P1,6), pw2); \
    VRD(3); SBAR(); GAPA(C0=__builtin_amdgcn_mfma_f32_32x32x16_bf16(kf[6],qr[3],C0,0,0,0),   P1[10],P1[11],P1[12],P1[13], pw3[0]=PKW(P1,8), pw3[1]=PKW(P1,10), pw3); \
    VRD(7); SBAR(); GAPA(C1=__builtin_amdgcn_mfma_f32_32x32x16_bf16(kf[7],qr[3],C1,0,0,0),   P1[14],P1[15],0.f,0.f,       pw3[2]=PKW(P1,12),pw3[3]=PKW(P1,14), pw3); \
    l_reg+=sacc; \
    if(GK){DMA_K((t)+3,sl_cur);} if(GV){DMA_V((t)+1,sl_next);} \
    CMASK(C0,C1,t); \
    { float a=MX3(C0[0],C0[1],C1[0]),b=MX3(C0[2],C0[3],C1[1]); a=MX3(a,C1[2],C1[3]); \
      _Pragma("unroll") for(int r=4;r<16;r+=4){a=MX3(a,C0[r],C0[r+1]);b=MX3(b,C0[r+2],C0[r+3]);a=MX3(a,C1[r],C1[r+1]);b=MX3(b,C1[r+2],C1[r+3]);} \
      float rm=__builtin_fmaxf(a,b); { auto rr=__builtin_amdgcn_permlane32_swap(__float_as_uint(rm),__float_as_uint(rm),false,false); rm=__builtin_fmaxf(__uint_as_float(rr[0]),__uint_as_float(rr[1])); } \
      resc=false; \
      if(__builtin_expect(__any(rm>(float)THRL),0)){ const float dl=__builtin_fmaxf(rm,0.f); mhat+=dl; \
        _Pragma("unroll") for(int r=0;r<16;++r){C0[r]-=dl;C1[r]-=dl;} \
        const float f=__builtin_amdgcn_exp2f(-dl); l_reg*=f; if(hi==0)wsf[r32]=f; resc=true; } } \
    SBAR(); \
    GAPB(o[0]=__builtin_amdgcn_mfma_f32_32x32x16_bf16(PAF(0),VFR(0),o[0],0,0,0), C0,0); \
    GAPB(o[1]=__builtin_amdgcn_mfma_f32_32x32x16_bf16(PAF(0),VFR(4),o[1],0,0,0), C0,4); \
    KRD(GL,0); GAPB(o[0]=__builtin_amdgcn_mfma_f32_32x32x16_bf16(PAF(1),VFR(1),o[0],0,0,0), C0,8); \
    KRD(GL,1); GAPB(o[1]=__builtin_amdgcn_mfma_f32_32x32x16_bf16(PAF(1),VFR(5),o[1],0,0,0), C0,12); \
    KRD(GL,2); GAPB(o[0]=__builtin_amdgcn_mfma_f32_32x32x16_bf16(PAF(2),VFR(2),o[0],0,0,0), C1,0); \
    KRD(GL,3); GAPB(o[1]=__builtin_amdgcn_mfma_f32_32x32x16_bf16(PAF(2),VFR(6),o[1],0,0,0), C1,4); \
    GAPB(o[0]=__builtin_amdgcn_mfma_f32_32x32x16_bf16(PAF(3),VFR(3),o[0],0,0,0), C1,8); \
    GAPB(o[1]=__builtin_amdgcn_mfma_f32_32x32x16_bf16(PAF(3),VFR(7),o[1],0,0,0), C1,12); \
    }while(0)
  int t=1;
  for(;t+5<NT;t+=2){
    STEP(pB0,pB1,pA0,pA1,t,true,true,true);     WAIT_BAR(2); RESC(); ROT();
    STEP(pA0,pA1,pB0,pB1,t+1,true,true,true);   WAIT_BAR(2); RESC(); ROT();
  }
  #define ENDW(tt) do{ if((tt)+3<NT){WAIT_BAR(2);} else if((tt)+2<NT){WAIT_BAR(1);} else {WAIT_BAR(0);} }while(0)
  for(;t+1<NT;t+=2){
    STEP(pB0,pB1,pA0,pA1,t,(t+3<NT),(t+1<NT),(t+1<NT));       ENDW(t);   RESC(); ROT();
    STEP(pA0,pA1,pB0,pB1,t+1,(t+4<NT),(t+2<NT),(t+2<NT));     ENDW(t+1); RESC(); ROT();
  }
  if(has_next){
    const int nRS=(nkind==2)?16:1, nrowbase=nb*SEQ+((nkind==2)?nqb:0), nT0=(nkind==1)?(nqb>2?4*nqb-8:0):0;
    const bf16*nks=K+(nrowbase+(int)nT0*KVBLK)*DM+nh*D+(int)lane*nRS*DM+wid*8;
    glds16(nks,(unsigned)__builtin_amdgcn_readfirstlane(kdst)); glds16(nks+(int)KVBLK*nRS*DM,(unsigned)__builtin_amdgcn_readfirstlane(kdst+SLOTB)); glds16(nks+(int)2*KVBLK*nRS*DM,(unsigned)__builtin_amdgcn_readfirstlane(kdst+2*SLOTB)); }
  STEP(pB0,pB1,pA0,pA1,NT-1,false,false,false); RESC();
  if(has_next){
    const int nRS=(nkind==2)?16:1, nrowbase=nb*SEQ+((nkind==2)?nqb:0), nq0=(nkind==2)?0:nqb*QB; const bf16*nQw=Q+(nrowbase+(int)(nq0+wid*QBLK)*nRS)*DM+nh*D;
    #pragma unroll
    for(int d0=0;d0<4;++d0)qr[d0]=*reinterpret_cast<const bf16x8*>(&nQw[(int)r32*nRS*DM+d0*16+hi*8]); }
  { float sacc=pB0[0]+pB0[1]; _Pragma("unroll") for(int r=2;r<16;++r)sacc+=pB0[r]; _Pragma("unroll") for(int r=0;r<16;++r)sacc+=pB1[r]; l_reg+=sacc;
    pw0=(u32x4){PKW(pB0,0),PKW(pB0,2),PKW(pB0,4),PKW(pB0,6)};pw1=(u32x4){PKW(pB0,8),PKW(pB0,10),PKW(pB0,12),PKW(pB0,14)};pw2=(u32x4){PKW(pB1,0),PKW(pB1,2),PKW(pB1,4),PKW(pB1,6)};pw3=(u32x4){PKW(pB1,8),PKW(pB1,10),PKW(pB1,12),PKW(pB1,14)};
    SBAR(); pv(o,vb0+sl_cur,PAF(0),PAF(1),PAF(2),PAF(3)); }
  #undef PKW
  #undef PAF
  #undef VFR
  #undef PIN
  #undef MX3
  #undef GAPA
  #undef GAPB
  #undef EX
  #undef VRD
  #undef KRD
  #undef STEP
  #undef ENDW
  {auto rr=__builtin_amdgcn_permlane32_swap(__float_as_uint(l_reg),__float_as_uint(l_reg),false,false);l_reg=__uint_as_float(rr[0])+__uint_as_float(rr[1]);}
  int lane_e=lane; asm volatile("":"+v"(lane_e));
  u32x4 fch[4];
  if(DIL){
    const unsigned short*fp=faro+(unsigned)(rowbase+q0+wid*QBLK+(lane_e>>3))*512+(h-8)*D+(lane_e&7)*8;
    #pragma unroll
    for(int i=0;i<4;++i)fch[i]=*(const u32x4*)(fp+(unsigned)i*8*512);
    const int p_=q0+wid*QBLK+(lane_e&31); const float*lp=farl+((unsigned)(((b*8+(h-8))*16+(p_&15))*256+(p_>>4)))*2; const float lf_=lp[0],mf_=lp[1];
    const float M_=__builtin_fmaxf(mhat,mf_),sa_=__builtin_amdgcn_exp2f(mhat-M_),sb_=__builtin_amdgcn_exp2f(mf_-M_),rl_=__builtin_amdgcn_rcpf(l_reg*sa_+lf_*sb_);
    if(hi==0){wsf[32+r32]=sa_*rl_;wsf[r32]=sb_*rl_;} }
  else if(hi==0)wsf[32+r32]=FAR?1.f:__builtin_amdgcn_rcpf(l_reg);
  asm volatile("s_waitcnt lgkmcnt(0)":::"memory");
  float rli[16];
  #pragma unroll
  for(int r=0;r<16;++r)rli[r]=wsf[32+crow(r,hi)];
  constexpr int OP=FAR?512:DM;
  bf16*Ow=(bf16*)faro+(rowbase+(int)wid*QBLK*RS)*OP+(h-8)*D;
  unsigned char*O8w=O8+(rowbase+q0+wid*QBLK)*DM+h*D;
  if(FAR&&hi==0){ float*lp=farl+((unsigned)(((b*8+(h-8))*16+qb)*256+qrel))*2; __hip_atomic_store((unsigned long long*)lp,((unsigned long long)__float_as_uint(mhat)<<32)|__float_as_uint(l_reg),__ATOMIC_RELAXED,__HIP_MEMORY_SCOPE_AGENT); }
  { bf16*stg=(bf16*)(shm+LDS_OST)+wid*2048;
    #pragma unroll
    for(int r=0;r<16;++r){const int orow=crow(r,hi);
      #pragma unroll
      for(int d0=0;d0<2;++d0)stg[orow*64+d0*32+r32]=__float2bfloat16(o[d0][r]*rli[r]);}
    asm volatile("s_waitcnt lgkmcnt(0)":::"memory");
    #pragma unroll
    for(int i=0;i<4;++i){const int row=i*8+(lane_e>>3),ch=lane_e&7; u32x4 v=*(const u32x4*)(stg+row*64+ch*8);
      if(DIL){ const float fb_=wsf[row];
        #pragma unroll
        for(int j=0;j<4;++j){ const float a_=__uint_as_float(v[j]<<16)+__uint_as_float(fch[i][j]<<16)*fb_, b_=__uint_as_float(v[j]&0xffff0000u)+__uint_as_float(fch[i][j]&0xffff0000u)*fb_; v[j]=cvtpk_s(a_,b_); } }
      if(FAR){ ATTN_STORE16(Ow+(int)row*RS*OP+ch*8,v); }
      else { unsigned w0_=0,w1_=0;
        w0_=__builtin_amdgcn_cvt_pk_fp8_f32(__uint_as_float(v[0]<<16)*64.f,__uint_as_float(v[0]&0xffff0000u)*64.f,w0_,false); w0_=__builtin_amdgcn_cvt_pk_fp8_f32(__uint_as_float(v[1]<<16)*64.f,__uint_as_float(v[1]&0xffff0000u)*64.f,w0_,true);
        w1_=__builtin_amdgcn_cvt_pk_fp8_f32(__uint_as_float(v[2]<<16)*64.f,__uint_as_float(v[2]&0xffff0000u)*64.f,w1_,false); w1_=__builtin_amdgcn_cvt_pk_fp8_f32(__uint_as_float(v[3]<<16)*64.f,__uint_as_float(v[3]&0xffff0000u)*64.f,w1_,true);
        *(unsigned long long*)(O8w+(int)row*DM+ch*8)=((unsigned long long)w1_<<32)|w0_; }
      float sq=0.f;
      #pragma unroll
      for(int j=0;j<4;++j){ const float a_=__uint_as_float(v[j]<<16), b_=__uint_as_float(v[j]&0xffff0000u); sq+=a_*a_+b_*b_; }
      sq+=__shfl_xor(sq,1); sq+=__shfl_xor(sq,2); sq+=__shfl_xor(sq,4);
      if(!FAR&&ch==0)ssq[(unsigned)(rowbase+q0+wid*QBLK+row)*16+h]=sq; } }
  asm volatile("s_waitcnt lgkmcnt(0)\n\ts_barrier":::"memory");
  #undef DMA_K
  #undef DMA_V
  #undef CMASK
  #undef START
  #undef RESC
  #undef ROT
}
constexpr int ATTN_LDS_BYTES=LDS_BYTES;
__device__ __forceinline__ void attn_tables(char*lds,int wave){
  float*tb=(float*)(lds+LDS_TAB);
  for(int e=wave*64+mk_lane();e<64*16;e+=512){ const int ln=e>>4,r=e&15,r32=ln&31,hi=ln>>5; const int z4=r32&3,z16=((r32&15)-4*hi)&15;
    const bool in4=(z4==(r&3)),in16=(z16==((r&3)+8*((r>>2)&1)));
    tb[e]=-1e30f; tb[1024+e]=in16?1.5849625007f:(in4?1.f:0.f); tb[2048+e]=in16?1.f:(in4?0.f:-1e30f); tb[3072+e]=in16?(1.f-1.5849625007f):(in4?-1.f:-1e30f); }
  __syncthreads();
}
template<int THRL=8> __device__ __forceinline__ void attn_phase(char*lds,unsigned char*ws,unsigned*cnt,int vcu,int G,int wave){
  const int g=vcu>>2,b=g>>3,hm=g&7,c=vcu&3;
  attn_tables(lds,wave);
  bf16x8 qr[4];
  { const int nf_=(c==0)?6:((c==1)?4:3), cb_=(c==0)?0:((c==1)?6:((c==2)?10:13)); const int n_=(MK_REPEAT_PHASE==22?2*nf_:nf_); for(int i=0;i<n_;++i) attn_unit<THRL,2>(b,8+hm,cb_+(i%nf_),ws,lds,wave,qr,i>0,true,(i+1<n_)?2:0,b,(i+1<n_)?8+hm:hm,(i+1<n_)?cb_+((i+1)%nf_):15-c); }
  asm volatile("s_waitcnt vmcnt(0)":::"memory"); __syncthreads();
  if(wave==0&&mk_lane()==0) __hip_atomic_fetch_add(cnt,1u,__ATOMIC_RELAXED,__HIP_MEMORY_SCOPE_AGENT);
  #define QBSEL(i_) ((((i_)&3)==0)?15-c:((((i_)&3)==1)?8+c:((((i_)&3)==2)?7-c:c)))
  { const int n_=(MK_REPEAT_PHASE==20?8:4); for(int ii=0;ii<n_;++ii) attn_unit<THRL,0>(b,hm,QBSEL(ii),ws,lds,wave,qr,true,true,(ii+1<n_)?0:1,b,(ii+1<n_)?hm:8+hm,QBSEL(ii+1)); }
  if(wave==0&&mk_lane()==0){ unsigned sp=0; while(__hip_atomic_load(cnt,__ATOMIC_RELAXED,__HIP_MEMORY_SCOPE_AGENT)<(unsigned)G){ __builtin_amdgcn_s_sleep(2); if(++sp>(1u<<22))break; }
    __builtin_amdgcn_fence(__ATOMIC_ACQUIRE,"agent"); asm volatile("s_waitcnt vmcnt(0)":::"memory"); }
  __syncthreads();
  { const int n_=(MK_REPEAT_PHASE==21?8:4); for(int ii=0;ii<n_;++ii) attn_unit<THRL,1>(b,8+hm,QBSEL(ii),ws,lds,wave,qr,true,ii+1<n_,1,b,8+hm,QBSEL(ii+1)); }
  #undef QBSEL
}
#undef SBAR
#undef WAIT_BAR
}

struct Frame {
    LAS unsigned char* lds;
    volatile LAS unsigned* MISC;
    gu32* ctl;
    int wave;
    int vcu, G;
    const float *x, *attn_norm, *w_in, *moba_norm, *dil_norm, *w_out, *ffn_norm, *w_gate, *w_up, *w_down, *final_norm;
    float* out;
    bf16 *Wqkv_t, *Wo_t, *Wgu_t, *Wd_t;
    bf16 *QO, *KB, *VB, *XN, *OB; unsigned char *HB, *XN8;
    float *rope, *kpart, *ssqa, *ssq1, *ssq2;
};

__device__ __forceinline__ float wave_sum(float v) {
#pragma unroll
    for (int o = 1; o < 64; o <<= 1) v += __shfl_xor(v, o);
    return v;
}
__device__ __forceinline__ int qkv_vrow(int n) { const int part = n >> 10, head = (n >> 6) & 15, d = n & 63; return 256 * (part * 4 + (head >> 2)) + 128 * (d >> 5) + 32 * (head & 3) + (d & 31); }
template <int MODE>
__device__ __forceinline__ void p0_item(const float* W, int K, int N, bf16* WT, const float* g0, const float* g1, LAS float* scr, int item, int lane) {
    const int nblk = N / 32, kb = item / nblk, nb = item % nblk, k0 = 64 * kb, n0 = 32 * nb;
#pragma unroll 8
    for (int i = 0; i < 32; ++i) { const int kk = 2 * i + (lane >> 5), k = k0 + kk; float w = __builtin_nontemporal_load(W + (size_t)k * N + n0 + (lane & 31));
        if (MODE == 1) w *= (k < 512 ? g0[k] : g1[k - 512]);
        if (MODE == 2 || MODE == 3) w *= g0[k];
        scr[kk * 33 + (lane & 31)] = w; }
    LDS_WAIT(); asm volatile("" ::: "memory");
    const int c = lane & 7;
#pragma unroll
    for (int j = 0; j < 4; ++j) { const int n = (lane >> 3) + 8 * j; const LAS float* s = scr + (8 * c) * 33 + n;
        const int ns = n0 + n; int dr;
        if (MODE == 0) dr = qkv_vrow(ns); else if (MODE == 2) dr = 256 * (ns >> 7) + (ns & 127); else if (MODE == 3) dr = 256 * (ns >> 7) + 128 + (ns & 127); else dr = ns;
        bool f8 = MODE >= 1; size_t base8 = 0;
        if (MODE == 0) {
            const int pn = dr >> 8, lo = dr & 255; f8 = !(pn < 8 && (pn & 3) < 2);
            dr = (f8 ? (pn < 8 ? ((pn & 1) + 2 * (pn >> 2)) : pn - 4) : ((pn & 1) + 2 * (pn >> 2))) * 256 + lo; base8 = (size_t)QKV8_OFF; }
        if (f8) {
            const pg8::f32x4 a = {s[0 * 33], s[1 * 33], s[2 * 33], s[3 * 33]}, b = {s[4 * 33], s[5 * 33], s[6 * 33], s[7 * 33]};
            *(GAS pg8::u32x2*)((unsigned char*)WT + base8 + (size_t)dr * K + k0 + 8 * c) = pg8::pack8_fp8(a * pg8::F8_SW, b * pg8::F8_SW);
        } else {
            v4u o; o.x = pk2(s[0 * 33], s[1 * 33]); o.y = pk2(s[2 * 33], s[3 * 33]); o.z = pk2(s[4 * 33], s[5 * 33]); o.w = pk2(s[6 * 33], s[7 * 33]);
            *(GAS v4u*)(WT + (size_t)dr * K + k0 + 8 * c) = o; } }
    LDS_WAIT(); asm volatile("" ::: "memory");
}
template <int R>
__device__ __forceinline__ void rms_rows_to_bf16(Frame& F, const float* xrow, const float* gain, bf16* orow, unsigned char* orow8, float* rn) {
    const GAS f32x4* xr = (const GAS f32x4*)xrow + mk_lane(); const GAS f32x4* gr = (const GAS f32x4*)gain + mk_lane();
    f32x4 v[R][4]; float s[R];
#pragma unroll
    for (int r = 0; r < R; ++r)
#pragma unroll
        for (int j = 0; j < 4; ++j) v[r][j] = __builtin_nontemporal_load(xr + r * 256 + 64 * j);
#pragma unroll
    for (int r = 0; r < R; ++r) { s[r] = 0.f;
#pragma unroll
        for (int j = 0; j < 4; ++j) s[r] += (v[r][j].x * v[r][j].x + v[r][j].y * v[r][j].y) + (v[r][j].z * v[r][j].z + v[r][j].w * v[r][j].w); }
#pragma unroll
    for (int o = 1; o < 64; o <<= 1)
#pragma unroll
        for (int r = 0; r < R; ++r) s[r] += __shfl_xor(s[r], o);
    const int ln_ = mk_lane(); GAS unsigned long long* o8 = (GAS unsigned long long*)orow + ln_; GAS unsigned* q8 = (GAS unsigned*)orow8 + ln_;
#pragma unroll
    for (int r = 0; r < R; ++r) { const float rms = sqrtf(s[r] * (1.f / D) + RMS_EPS), rstd = 1.f / rms; if (ln_ == 0) rn[r] = rms;
#pragma unroll
        for (int j = 0; j < 4; ++j) { const f32x4 g = gr[64 * j];
            const f32x4 y = v[r][j] * rstd * g;
            o8[r * 256 + 64 * j] = (unsigned long long)pk2(y.x, y.y) | ((unsigned long long)pk2(y.z, y.w) << 32);
            unsigned t = 0; t = __builtin_amdgcn_cvt_pk_fp8_f32(y.x * pg8::F8_SA, y.y * pg8::F8_SA, t, false); t = __builtin_amdgcn_cvt_pk_fp8_f32(y.z * pg8::F8_SA, y.w * pg8::F8_SA, t, true); q8[r * 256 + 64 * j] = t; } }
}
__device__ __forceinline__ void p0_prologue(Frame& F) {
    LAS float* scr = (LAS float*)(F.lds + RING_OFF + F.wave * 16384);
    const int gw = F.vcu * NWAVES + F.wave, NGW = F.G * NWAVES;
    constexpr int I_IN = (D / 64) * (NQKV / 32), I_O = (D / 64) * (D / 32), I_G = (D / 64) * (FF / 32), I_D = (FF / 64) * (D / 32);
    constexpr int NITEMS = I_IN + I_O + 2 * I_G + I_D;
    for (int it = gw; it < NITEMS; it += NGW) {
        int r = it;
        if (r < I_IN) { p0_item<0>(F.w_in, D, NQKV, F.Wqkv_t, nullptr, nullptr, scr, r, mk_lane()); continue; } r -= I_IN;
        if (r < I_O) { p0_item<1>(F.w_out, D, D, F.Wo_t, F.moba_norm, F.dil_norm, scr, r, mk_lane()); continue; } r -= I_O;
        if (r < I_G) { p0_item<2>(F.w_gate, D, FF, F.Wgu_t, F.ffn_norm, nullptr, scr, r, mk_lane()); continue; } r -= I_G;
        if (r < I_G) { p0_item<3>(F.w_up, D, FF, F.Wgu_t, F.ffn_norm, nullptr, scr, r, mk_lane()); continue; } r -= I_G;
        p0_item<4>(F.w_down, FF, D, F.Wd_t, nullptr, nullptr, scr, r, mk_lane());
    }
    for (int e = (F.vcu * NWAVES * 64) + F.wave * 64 + mk_lane(); e < SEQ * 32; e += F.G * NWAVES * 64) {
        const int s = e >> 5, j = e & 31;
        const float invf = __builtin_amdgcn_exp2f(-(float)j * (13.287712379549449f / 32.0f));
        double rev = (double)s * (double)invf * 0.15915494309189535; rev -= __builtin_floor(rev);
        const float r = (float)rev;
        pg8::f32x2 cs; cs.x = __builtin_amdgcn_cosf(r); cs.y = __builtin_amdgcn_sinf(r);
        *(GAS pg8::f32x2*)((pg8::f32x2*)F.rope + e) = cs;
    }
    for (int m = 4 * gw; m < M; m += 4 * NGW) rms_rows_to_bf16<4>(F, F.x + (size_t)m * D, F.attn_norm, F.XN + (size_t)m * D, F.XN8 + (size_t)m * D, (float*)(F.kpart + 131072) + m);
}

__device__ __forceinline__ void p6_final(Frame& F) {
    const int gw = F.vcu * NWAVES + F.wave, NGW = F.G * NWAVES;
    const GAS f32x4* gr = (const GAS f32x4*)F.final_norm + mk_lane();
    for (int m = gw; m < M; m += NGW) {
        GAS f32x4* xr = (GAS f32x4*)(F.out + (size_t)m * D) + mk_lane();
        const GAS f32x4* sp = (const GAS f32x4*)(F.ssq2 + (size_t)m * 16);
        const f32x4 a = sp[0], b = sp[1], c = sp[2], d = sp[3];
        const float ss = ((a.x + a.y) + (a.z + a.w)) + ((b.x + b.y) + (b.z + b.w)) + ((c.x + c.y) + (c.z + c.w)) + ((d.x + d.y) + (d.z + d.w));
        const float rstd = 1.f / sqrtf(ss * (1.f / D) + RMS_EPS);
#pragma unroll
        for (int j = 0; j < 4; ++j) { const f32x4 v = xr[64 * j], g = gr[64 * j]; xr[64 * j] = v * rstd * g; }
    }
}

struct Args { const float* in[11]; float* out; unsigned char* ws; int ph_lo, ph_hi, li, pad; };
__global__ void __launch_bounds__(NWAVES * 64, 2) mk_fwd(Args args) {
    extern __shared__ __attribute__((aligned(16))) unsigned char lds[];
    Frame F;
    F.lds = (LAS unsigned char*)lds;
    F.MISC = (volatile LAS unsigned*)(F.lds + MISC_OFF);
    F.wave = __builtin_amdgcn_readfirstlane((int)(threadIdx.x >> 6));
    F.G = gridDim.x; { const int bx = blockIdx.x; F.vcu = (F.G % 8 == 0) ? (bx % 8) * (F.G / 8) + bx / 8 : bx; }
#define GRID_BAR(seam) do { if (N_LAUNCHES == PER_PHASE) { if ((F.wave == 0 && mk_lane() == 0)) __hip_atomic_store(F.ctl + CW_TMO, 0xBADBA0u | (unsigned)(seam), RLX_AGENT); } \
    else { xcd_barrier(bar, F.wave); if (MK_REPEAT_PHASE == 30) xcd_barrier(bar, F.wave); } } while (0)
    unsigned char* ws = args.ws;
    F.ctl = (gu32*)(ws + WS_CTL);
    F.x = args.in[0]; F.attn_norm = args.in[1]; F.w_in = args.in[2]; F.moba_norm = args.in[3]; F.dil_norm = args.in[4]; F.w_out = args.in[5];
    F.ffn_norm = args.in[6]; F.w_gate = args.in[7]; F.w_up = args.in[8]; F.w_down = args.in[9]; F.final_norm = args.in[10]; F.out = args.out;
    F.Wqkv_t = (bf16*)(ws + WS_WQKV); F.Wo_t = (bf16*)(ws + WS_WO); F.Wgu_t = (bf16*)(ws + WS_WGU); F.Wd_t = (bf16*)(ws + WS_WD);
    F.QO = (bf16*)(ws + WS_QO); F.KB = (bf16*)(ws + WS_K); F.VB = (bf16*)(ws + WS_V); F.HB = ws + WS_H; F.XN8 = ws + WS_XN8; F.XN = (bf16*)(ws + WS_XN); F.OB = (bf16*)(ws + WS_O);
    F.rope = (float*)(ws + WS_ROPE); F.kpart = (float*)(ws + WS_KPART); F.ssqa = (float*)(ws + WS_SSQA); F.ssq1 = (float*)(ws + WS_SSQ1); F.ssq2 = (float*)(ws + WS_SSQ2);
    for (int u = F.wave * 64 + mk_lane(); u < (LDS_BYTES - LDSCTL_OFF) / 4; u += NWAVES * 64) ((LAS unsigned*)(F.lds + LDSCTL_OFF))[u] = 0u;
    __syncthreads();
    XcdBarrier bar; bar.bar = (unsigned*)(F.ctl + CW_BAR); bar.x = 0; bar.st = nullptr;
    if (N_LAUNCHES != PER_PHASE) bar = xcd_barrier_post((unsigned*)(F.ctl + CW_BAR), F.MISC + 8, F.wave);
    const int lo = args.ph_lo, hi = args.ph_hi;
#define IN(k) (lo <= (k) && (k) < hi)
#define BOTH(k) (IN(k) && IN((k) + 1))

    if (IN(0)) { for (int rp = 0; rp < (MK_REPEAT_PHASE == 0 ? 2 : 1); ++rp) p0_prologue(F); if (BOTH(0)) GRID_BAR(0); }

    if (IN(1)) {
        if (MK_STAG1 > 0 && ((blockIdx.x >> 3) & 1)) { for (int i = 0; i < MK_STAG1; ++i) __builtin_amdgcn_s_sleep(127); }
        { pg8::Gemm g{F.XN, F.Wqkv_t, M, 1024, D}; pg8::StaticOrder S; S.init(M, 1024, F.G, (int)blockIdx.x, MK_REPEAT_PHASE == 1 ? 2 : 1);
          pg8::EpiQKV E{F.QO, (size_t)(WS_K - WS_QO) / 2, F.rope, F.kpart, QSCALE, 1, 1.f};
          pg8::gemm_phase<pg8::EpiQKV, pg8::StaticOrder, true, true>(F.lds + RING_OFF, g, S, E, F.wave); }
        { pg8::Gemm g{(const bf16*)F.XN8, (const bf16*)((const unsigned char*)F.Wqkv_t + QKV8_OFF), M, 2048, D}; pg8::StaticOrder S; S.init(M, 2048, F.G, (int)blockIdx.x, MK_REPEAT_PHASE == 1 ? 2 : 1);
          pg8::EpiQKV E{F.QO, (size_t)(WS_K - WS_QO) / 2, F.rope, F.kpart, QSCALE, 2, 1.f / (pg8::F8_SA * pg8::F8_SW)};
          pg8::gemm_phase<pg8::EpiQKV, pg8::StaticOrder, true, true, true>(F.lds + RING_OFF, g, S, E, F.wave); }
        if (BOTH(1)) GRID_BAR(1);
    }

    if (IN(2)) {
        if (F.G == 256) {
            for (int rp = 0; rp < (MK_REPEAT_PHASE == 2 ? 2 : 1); ++rp) attn_body::attn_phase<8>((char*)lds + RING_OFF, ws, (unsigned*)(F.ctl + CW_FAR), F.vcu, F.G, F.wave);
        }
        if (BOTH(2)) GRID_BAR(2);
    }

    if (IN(3)) {
        pg8::Gemm g{(const bf16*)(ws + WS_O8), F.Wo_t, M, D, D};   pg8::StaticOrder S; S.init(M, D, F.G, (int)blockIdx.x, MK_REPEAT_PHASE == 3 ? 2 : 1);
        pg8::EpiWo E{F.kpart + 131072, F.attn_norm, F.XN, (MK_REPEAT_PHASE == 3) ? (bf16*)(ws + 394 * MiB) : F.XN, (MK_REPEAT_PHASE == 3) ? ws + 458 * MiB : F.XN8, F.ssqa, F.ssq1};
        pg8::gemm_phase<pg8::EpiWo, pg8::StaticOrder, true, true, true>(F.lds + RING_OFF, g, S, E, F.wave);
        if (BOTH(3)) GRID_BAR(3);
    }

    if (IN(4)) {
        pg8::Gemm g{(const bf16*)((MK_REPEAT_PHASE == 3) ? ws + 458 * MiB : F.XN8), F.Wgu_t, M, NGU, D}; pg8::StaticOrder S; S.init(M, NGU, F.G, (int)blockIdx.x, MK_REPEAT_PHASE == 4 ? 2 : 1);
        pg8::EpiGU E{F.ssq1, F.HB};
        if (MK_REPEAT_PHASE == 40) { S.r1 = 6; pg8::gemm_phase<pg8::EpiGU, pg8::StaticOrder, true, true, true>(F.lds + RING_OFF, g, S, E, F.wave); GRID_BAR(9); S.r0 = 6; S.r1 = 1 << 30; }
        pg8::gemm_phase<pg8::EpiGU, pg8::StaticOrder, true, true, true>(F.lds + RING_OFF, g, S, E, F.wave);
        if (BOTH(4)) GRID_BAR(4);
    }

    if (IN(5)) {
        pg8::Gemm g{(const bf16*)F.HB, F.Wd_t, M, D, FF};   pg8::StaticOrder S; S.init(M, D, F.G, (int)blockIdx.x, MK_REPEAT_PHASE == 5 ? 2 : 1);
#if defined(MK_SPLIT_FINAL)
        pg8::EpiDown E{F.XN, F.out, F.ssq2};
        pg8::gemm_phase<pg8::EpiDown, pg8::StaticOrder, true, true, true>(F.lds + RING_OFF, g, S, E, F.wave);
        if (BOTH(5)) GRID_BAR(5);
#else
        if (F.G == 256) { pg8::EpiDownNorm E{(MK_REPEAT_PHASE == 3) ? (bf16*)(ws + 394 * MiB) : F.XN, F.out, F.ssq2, (unsigned*)(F.ctl + CW_PANEL), F.final_norm};
            pg8::gemm_phase<pg8::EpiDownNorm, pg8::StaticOrder, true, true, true>(F.lds + RING_OFF, g, S, E, F.wave); }
        else { pg8::EpiDown E{F.XN, F.out, F.ssq2}; pg8::gemm_phase<pg8::EpiDown, pg8::StaticOrder, true, true, true>(F.lds + RING_OFF, g, S, E, F.wave); GRID_BAR(5); p6_final(F); }
#endif
    }

#if defined(MK_SPLIT_FINAL)
    if (IN(6)) { p6_final(F); }
#endif
#undef IN
#undef BOTH
}

extern "C" void kernel_launch(void* const* d_in, const int* in_sizes, int n_in, void* d_out, int out_size, void* d_ws, size_t ws_size, hipStream_t stream) {
    static int grid = 0;
    if (grid == 0) {
        if (n_in != 11 || in_sizes[0] != M * D || out_size != M * D || ws_size < WS_END) { fprintf(stderr, "kernel_launch: unexpected shapes (n_in %d, in0 %d, out %d, ws %zu); nothing launched\n", n_in, n_in > 0 ? in_sizes[0] : -1, out_size, ws_size); grid = -1; return; }
        int dev = 0, cus = 0, per_cu = 0;
        if (hipGetDevice(&dev) != hipSuccess || hipDeviceGetAttribute(&cus, hipDeviceAttributeMultiprocessorCount, dev) != hipSuccess) { grid = -1; return; }
        if (hipFuncSetAttribute((const void*)mk_fwd, hipFuncAttributeMaxDynamicSharedMemorySize, LDS_BYTES) != hipSuccess) { fprintf(stderr, "kernel_launch: hipFuncSetAttribute failed\n"); grid = -1; return; }
        if (hipOccupancyMaxActiveBlocksPerMultiprocessor(&per_cu, (const void*)mk_fwd, NWAVES * 64, LDS_BYTES) != hipSuccess || per_cu < 1) { fprintf(stderr, "kernel_launch: occupancy query says %d blocks per CU\n", per_cu); (void)hipGetLastError(); per_cu = 1; }
        grid = cus;
        if (grid > 256) grid = 256;
    }
    if (grid < 0) return;
    if (hipMemsetAsync((char*)d_ws + WS_CTL, 0, CTL_ZERO_BYTES, stream) != hipSuccess) { fprintf(stderr, "kernel_launch: hipMemsetAsync failed\n"); return; }
    Args a{};
    for (int i = 0; i < 11; ++i) a.in[i] = (const float*)d_in[i];
    a.out = (float*)d_out; a.ws = (unsigned char*)d_ws;
    for (int li = 0; li < N_LAUNCHES; ++li) {
        a.ph_lo = (N_LAUNCHES == PER_PHASE) ? li : 0; a.ph_hi = (N_LAUNCHES == PER_PHASE) ? li + 1 : PER_PHASE; a.li = li;
        hipLaunchKernelGGL(mk_fwd, dim3(grid), dim3(NWAVES * 64), LDS_BYTES, stream, a);
        const hipError_t le = hipPeekAtLastError();
        if (le != hipSuccess) { fprintf(stderr, "kernel_launch: launch %d failed: %s\n", li, hipGetErrorName(le)); break; }
    }
}
```

```cpp
#include <hip/hip_runtime.h>
#include <cstdio>
#include <cstdint>
namespace pg8 {
#define PG8_LAS __attribute__((address_space(3)))
typedef unsigned short bf16_t;
typedef short bf16x8 __attribute__((ext_vector_type(8)));
typedef float f32x4 __attribute__((ext_vector_type(4)));
typedef unsigned u32x4 __attribute__((ext_vector_type(4)));
typedef int i32x4 __attribute__((ext_vector_type(4)));
typedef int i32x8 __attribute__((ext_vector_type(8)));
typedef unsigned u32x2 __attribute__((ext_vector_type(2)));
constexpr int BM = 256, BK = 64, HALF = 128, HTB = HALF * BK * 2  , STAGE_BYTES = 8 * HTB, NXCD = 8, WGM = 8;

__host__ __device__ __forceinline__ int lds_byte(int r, int c) { const int st = (r >> 4) * 2 + (c >> 5), rr = r & 15, cc = c & 31, ob = rr * 64 + cc * 2; return st * 1024 + (ob ^ (((ob >> 9) & 1) << 5)); }
__host__ __device__ __forceinline__ void stage_rc(int b, int& R, int& C) { const int st = b / 1024, sb = b % 1024, swz = sb ^ (((sb >> 9) & 1) << 5); R = (st >> 1) * 16 + swz / 64; C = (st & 1) * 32 + (swz % 64) / 2; }
__host__ __device__ __forceinline__ int perm32(int rho) { const int n = rho >> 4, i = rho & 15; return 8 * (i >> 2) + 4 * n + (i & 3); }

struct Unit { int pm, pn; };
struct Gemm { const bf16_t* A; const bf16_t* Bt; int M, N, K; };

struct StaticOrder {
    int nM, nN, nwg, G, c, reps, r0 = 0, r1 = 1 << 30;
    __host__ __device__ void init(int M, int N, int G_, int c_, int reps_ = 1) { nM = M / BM; nN = N / BM; nwg = nM * nN; G = G_; c = c_; reps = reps_; }
    __host__ __device__ bool next(int i, Unit& u) const {
        const int rounds = (nwg + G - 1) / G; i += r0; if (i >= reps * rounds || i >= r1) return false;
        const long L = (long)(i % rounds) * G + c; if (L >= nwg) return false;
        int wgid = (int)L; { const int q = nwg / NXCD, r = nwg % NXCD, xcd = wgid % NXCD, off = wgid / NXCD; wgid = (xcd < r ? xcd * (q + 1) : r * (q + 1) + (xcd - r) * q) + off; }
        const int nig = WGM * nN, gid = wgid / nig, fm = gid * WGM, gsz = (nM - fm) < WGM ? (nM - fm) : WGM;
        u.pm = fm + ((wgid % nig) % gsz); u.pn = (wgid % nig) / gsz; return true;
    }
    __device__ __forceinline__ void a_ready(const Unit&) const {}
    __device__ __forceinline__ void done(const Unit&) const {}
};


__device__ __forceinline__ unsigned cvt_pk_bf16(float lo, float hi) { unsigned r; asm volatile("v_cvt_pk_bf16_f32 %0, %1, %2" : "=v"(r) : "v"(lo), "v"(hi)); return r; }
__device__ __forceinline__ u32x4 pack8(const f32x4 a, const f32x4 b) { u32x4 w; w.x = cvt_pk_bf16(a[0], a[1]); w.y = cvt_pk_bf16(a[2], a[3]); w.z = cvt_pk_bf16(b[0], b[1]); w.w = cvt_pk_bf16(b[2], b[3]); return w; }
__device__ __forceinline__ float sum4(const f32x4 a) { return (a[0] + a[1]) + (a[2] + a[3]); }
__device__ __forceinline__ float sq4(const f32x4 a) { return (a[0] * a[0] + a[1] * a[1]) + (a[2] * a[2] + a[3] * a[3]); }
constexpr float RMS_EPS_F = 1e-6f;
__device__ __forceinline__ int lane_id() { int l; asm volatile("v_mbcnt_lo_u32_b32 %0, -1, 0\n\tv_mbcnt_hi_u32_b32 %0, -1, %0" : "=v"(l)); return l; }
__device__ __forceinline__ u32x2 pack8_fp8(const f32x4 a, const f32x4 b) { u32x2 w; unsigned t = 0;
    t = __builtin_amdgcn_cvt_pk_fp8_f32(a[0], a[1], t, false); t = __builtin_amdgcn_cvt_pk_fp8_f32(a[2], a[3], t, true); w.x = t; t = 0;
    t = __builtin_amdgcn_cvt_pk_fp8_f32(b[0], b[1], t, false); t = __builtin_amdgcn_cvt_pk_fp8_f32(b[2], b[3], t, true); w.y = t; return w; }
constexpr float F8_SA = 16.f, F8_SH = 8.f, F8_SW = 512.f, F8_SO = 64.f;
typedef float f32x2 __attribute__((ext_vector_type(2)));

struct EpiQKV {
    static constexpr bool PERM = true, AFTER_DRAIN = false, HAS_MID = false;
    bf16_t* Q; size_t part_stride; const float* rope; float* kpart; float qscale; int mapsel; float ascale;
    __device__ __forceinline__ void operator()(const f32x4 (&acc)[2][2][4][2], const Unit& u, int wr, int wc, int fr_, int fq_) const {
        const int ln_ = lane_id(), fr = ln_ & 15, fq = ln_ >> 4;
        const int rp = mapsel == 1 ? ((u.pn & 1) + 4 * (u.pn >> 1)) : (mapsel == 2 ? (u.pn < 4 ? (2 + (u.pn & 1) + 4 * (u.pn >> 1)) : u.pn + 4) : u.pn);
        const int part = rp >> 2, head = (rp & 3) * 4 + wc;
        bf16_t* base = Q + (size_t)part * part_stride + head * 64 + 8 * fq;
        const float sc = part == 0 ? qscale : 1.f;
        const bool rot = part != 2, km = (part == 1) && (head < 8);
        const int row0 = u.pm * BM + wr * 64 + fr;
        int rbase = row0; asm volatile("" : "+v"(rbase));
        f32x4 T[2][4], S16[4];
#pragma unroll
        for (int q = 0; q < 4; ++q) { T[0][q] = T[1][q] = S16[q] = (f32x4){1.f, 0.f, 1.f, 0.f}; }
        if (rot) {
            const f32x4* r16 = (const f32x4*)(rope + ((size_t)16 * 32 + 8 * fq) * 2);
            const f32x4* ra = (const f32x4*)(rope + ((size_t)(rbase & 4095) * 32 + 8 * fq) * 2);
            const f32x4* rb = (const f32x4*)(rope + ((size_t)((rbase + HALF) & 4095) * 32 + 8 * fq) * 2);
#pragma unroll
            for (int q = 0; q < 4; ++q) { T[0][q] = ra[q]; T[1][q] = rb[q]; S16[q] = r16[q]; }
        }
        f32x4 ks[2][2];
#pragma unroll
        for (int a = 0; a < 2; ++a)
#pragma unroll
            for (int b = 0; b < 2; ++b) ks[a][b] = (f32x4){0.f, 0.f, 0.f, 0.f};
#pragma unroll
        for (int ai = 0; ai < 2; ++ai)
#pragma unroll
            for (int m = 0; m < 4; ++m) {
                const int row = rbase + ai * HALF + m * 16;
                if (m > 0 && rot) {
#pragma unroll
                    for (int q = 0; q < 4; ++q) { const f32x4 t = T[ai][q], st = S16[q];
                        T[ai][q] = (f32x4){t[0] * st[0] - t[1] * st[1], t[1] * st[0] + t[0] * st[1], t[2] * st[2] - t[3] * st[3], t[3] * st[2] + t[2] * st[3]}; }
                }
                const f32x4 t0 = T[ai][0], t1 = T[ai][1], t2 = T[ai][2], t3 = T[ai][3];
                f32x4 o1[2], o2[2];
#pragma unroll
                for (int n = 0; n < 2; ++n) {
                    const f32x4 cv = n == 0 ? (f32x4){t0[0], t0[2], t1[0], t1[2]} : (f32x4){t2[0], t2[2], t3[0], t3[2]};
                    const f32x4 sv = n == 0 ? (f32x4){t0[1], t0[3], t1[1], t1[3]} : (f32x4){t2[1], t2[3], t3[1], t3[3]};
                    const f32x4 x1 = acc[ai][0][m][n] * ascale, x2 = acc[ai][1][m][n] * ascale;
                    o1[n] = x1 * cv - x2 * sv; o2[n] = x2 * cv + x1 * sv;
                    if (km) { ks[0][n] += o1[n]; ks[1][n] += o2[n]; }
                    o1[n] = o1[n] * sc; o2[n] = o2[n] * sc;
                }
                bf16_t* rowp = base + (size_t)row * 1024;
                *(u32x4*)(rowp) = pack8(o1[0], o1[1]); *(u32x4*)(rowp + 32) = pack8(o2[0], o2[1]);
            }
        if (km) {
#pragma unroll
            for (int bj = 0; bj < 2; ++bj)
#pragma unroll
                for (int n = 0; n < 2; ++n) { f32x4 v = ks[bj][n];
#pragma unroll
                    for (int o = 1; o < 16; o <<= 1) { v[0] += __shfl_xor(v[0], o); v[1] += __shfl_xor(v[1], o); v[2] += __shfl_xor(v[2], o); v[3] += __shfl_xor(v[3], o); }
                    if (fr == 0) *(f32x4*)(kpart + (size_t)(u.pm * 2 + wr) * 512 + head * 64 + 32 * bj + 8 * fq + 4 * n) = v; }
        }
    }
};

struct EpiWo {
    static constexpr bool PERM = true, AFTER_DRAIN = false, HAS_MID = true;
    const float* rn0; const float* gain0; bf16_t* xn; bf16_t* xo; unsigned char* xn8;
    const float* ssq_att; float* ssq1;
    __device__ __forceinline__ void rstds(int row, int fq, float& rm, float& rd) const {
        const float s = sum4(*(const f32x4*)(ssq_att + (size_t)row * 16 + 4 * fq));
        const float t = s + __shfl_xor(s, 16), o = __shfl_xor(t, 32);
        rm = __builtin_amdgcn_rsqf((fq < 2 ? t : o) * (1.f / 512.f) + RMS_EPS_F);
        rd = __builtin_amdgcn_rsqf((fq < 2 ? o : t) * (1.f / 512.f) + RMS_EPS_F);
    }
    static constexpr float ASCALE = 1.f / (F8_SO * F8_SW);
    __device__ __forceinline__ void mid(f32x4 (&acc)[2][2][4][2], const Unit& u, int wr, int fr_) const {
        const int ln_ = lane_id(), fr = ln_ & 15, fq = ln_ >> 4;
        const int row0 = u.pm * BM + wr * 64 + fr;
        int rbase = row0; asm volatile("" : "+v"(rbase));
        float f[8];
#pragma unroll
        for (int i = 0; i < 8; ++i) { float rm, rd; rstds(rbase + (i >> 2) * HALF + (i & 3) * 16, fq, rm, rd); f[i] = rm / rd; }
#pragma unroll
        for (int ai = 0; ai < 2; ++ai)
#pragma unroll
            for (int m = 0; m < 4; ++m)
#pragma unroll
                for (int bj = 0; bj < 2; ++bj)
#pragma unroll
                    for (int n = 0; n < 2; ++n) acc[ai][bj][m][n] = acc[ai][bj][m][n] * f[ai * 4 + m];
    }
    __device__ __forceinline__ void operator()(const f32x4 (&acc)[2][2][4][2], const Unit& u, int wr, int wc, int fr_, int fq_) const {
        const int ln_ = lane_id(), fr = ln_ & 15, fq = ln_ >> 4;
        const int row0 = u.pm * BM + wr * 64 + fr, col0 = u.pn * BM + wc * 32 + 8 * fq;
        int rbase = row0; asm volatile("" : "+v"(rbase));
        f32x4 ig[2][2];
#pragma unroll
        for (int bj = 0; bj < 2; ++bj)
#pragma unroll
            for (int n = 0; n < 2; ++n) { const f32x4 g = *(const f32x4*)(gain0 + col0 + bj * HALF + 4 * n);
                ig[bj][n] = (f32x4){__builtin_amdgcn_rcpf(g[0]), __builtin_amdgcn_rcpf(g[1]), __builtin_amdgcn_rcpf(g[2]), __builtin_amdgcn_rcpf(g[3])}; }
        u32x4 xw[2][4][2]; f32x4 sa[2][4]; float rnv[2][4];
#define EPIWO_ISSUE(ai) do { _Pragma("unroll") for (int m = 0; m < 4; ++m) { unsigned row = (unsigned)(rbase + (ai) * HALF + m * 16); asm volatile("" : "+v"(row));     \
            sa[ai][m] = *(const f32x4*)((const char*)ssq_att + (row * 64u + 16u * fq)); rnv[ai][m] = *(const float*)((const char*)rn0 + row * 4u); \
            _Pragma("unroll") for (int bj = 0; bj < 2; ++bj) xw[ai][m][bj] = __builtin_nontemporal_load((const u32x4*)((const char*)xn + (row * 2048u + (unsigned)(col0 + bj * HALF) * 2u))); } } while (0)
        u32x4 pb[4][2]; u32x2 p8[4][2]; float sq[4];
#define EPIWO_COMPUTE(ai) do { _Pragma("unroll") for (int m = 0; m < 4; ++m) { \
            const float s4 = sum4(sa[ai][m]); const float t = s4 + __shfl_xor(s4, 16), o = __shfl_xor(t, 32); \
            const float rd = __builtin_amdgcn_rsqf((fq < 2 ? o : t) * (1.f / 512.f) + RMS_EPS_F); const float rn = rnv[ai][m]; float s = 0.f; \
            _Pragma("unroll") for (int bj = 0; bj < 2; ++bj) { const u32x4 w = xw[ai][m][bj]; \
                const f32x4 xa = (f32x4){__uint_as_float(w.x << 16), __uint_as_float(w.x & 0xffff0000u), __uint_as_float(w.y << 16), __uint_as_float(w.y & 0xffff0000u)} * ig[bj][0] * rn; \
                const f32x4 xb = (f32x4){__uint_as_float(w.z << 16), __uint_as_float(w.z & 0xffff0000u), __uint_as_float(w.w << 16), __uint_as_float(w.w & 0xffff0000u)} * ig[bj][1] * rn; \
                const f32x4 v0 = xa + acc[ai][bj][m][0] * (rd * ASCALE), v1 = xb + acc[ai][bj][m][1] * (rd * ASCALE); \
                pb[m][bj] = pack8(v0, v1); p8[m][bj] = pack8_fp8(v0 * F8_SA, v1 * F8_SA); s += sq4(v0) + sq4(v1); } \
            s += __shfl_xor(s, 16); s += __shfl_xor(s, 32); sq[m] = s; } } while (0)
#define EPIWO_STORE(ai) do { _Pragma("unroll") for (int m = 0; m < 4; ++m) { unsigned row = (unsigned)(rbase + (ai) * HALF + m * 16); asm volatile("" : "+v"(row)); \
            _Pragma("unroll") for (int bj = 0; bj < 2; ++bj) { const unsigned off = row * 1024u + (unsigned)(col0 + bj * HALF); *(u32x4*)((char*)xo + off * 2u) = pb[m][bj]; *(u32x2*)(xn8 + off) = p8[m][bj]; } \
            if (fq == 0) *(float*)((char*)ssq1 + (row * 64u + (unsigned)(u.pn * 4 + wc) * 4u)) = sq[m]; } } while (0)
        EPIWO_ISSUE(0);
        asm volatile("" ::: "memory");
        EPIWO_COMPUTE(0);
        asm volatile("" ::: "memory");
        EPIWO_ISSUE(1);
        asm volatile("" ::: "memory");
        EPIWO_STORE(0);
        asm volatile("" ::: "memory");
        EPIWO_COMPUTE(1);
        EPIWO_STORE(1);
#undef EPIWO_ISSUE
#undef EPIWO_COMPUTE
#undef EPIWO_STORE
    }
};

struct EpiGU {
    static constexpr bool PERM = true, AFTER_DRAIN = false, HAS_MID = false;
    const float* ssq1; unsigned char* H;
    __device__ __forceinline__ u32x2 row8(const f32x4 (&acc)[2][2][4][2], int ai, int m, float rstd) const {
        const float rs_e = rstd * -1.4426950408889634f, rs_u = rstd * (rstd * F8_SH);
        const f32x2 e2 = {rs_e, rs_e}, u2 = {rs_u, rs_u}, one2 = {1.f, 1.f};
        u32x2 w;
#pragma unroll
        for (int n = 0; n < 2; ++n) { unsigned t = 0;
#pragma unroll
            for (int p = 0; p < 2; ++p) { const f32x2 gg = {acc[ai][0][m][n][2 * p], acc[ai][0][m][n][2 * p + 1]}, uu = {acc[ai][1][m][n][2 * p], acc[ai][1][m][n][2 * p + 1]};
                const f32x2 ea = gg * e2, gu = (gg * uu) * u2;
                const f32x2 den = (f32x2){__builtin_amdgcn_exp2f(ea.x), __builtin_amdgcn_exp2f(ea.y)} + one2;
                const f32x2 hh = gu * (f32x2){__builtin_amdgcn_rcpf(den.x), __builtin_amdgcn_rcpf(den.y)};
                t = p == 0 ? __builtin_amdgcn_cvt_pk_fp8_f32(hh.x, hh.y, t, false) : __builtin_amdgcn_cvt_pk_fp8_f32(hh.x, hh.y, t, true); }
            if (n == 0) w.x = t; else w.y = t; }
        return w;
    }
    __device__ __forceinline__ void operator()(const f32x4 (&acc)[2][2][4][2], const Unit& u, int wr, int wc, int fr_, int fq_) const {
        const int ln_ = lane_id(), fr = ln_ & 15, fq = ln_ >> 4;
        const int row0 = u.pm * BM + wr * 64 + fr, colp = u.pn * HALF + wc * 32 + 16 * (fq >> 1);
        int rbase = row0; asm volatile("" : "+v"(rbase));
        f32x4 sv[8]; float rs[8];
#pragma unroll
        for (int i = 0; i < 8; ++i) sv[i] = *(const f32x4*)(ssq1 + (size_t)(rbase + (i >> 2) * HALF + (i & 3) * 16) * 16 + 4 * fq);
#pragma unroll
        for (int i = 0; i < 8; ++i) { float ss = sum4(sv[i]); ss += __shfl_xor(ss, 16); ss += __shfl_xor(ss, 32); rs[i] = __builtin_amdgcn_rsqf(ss * (1.f / 1024.f) + RMS_EPS_F) * (1.f / (F8_SA * F8_SW)); }
#pragma unroll
        for (int ai = 0; ai < 2; ++ai)
#pragma unroll
            for (int mp = 0; mp < 2; ++mp) { const int rowa = rbase + ai * HALF + mp * 32, rowb = rowa + 16;
                const u32x2 wa = row8(acc, ai, 2 * mp, rs[ai * 4 + 2 * mp]), wb = row8(acc, ai, 2 * mp + 1, rs[ai * 4 + 2 * mp + 1]);
                const auto sx = __builtin_amdgcn_permlane16_swap(wa.x, wb.x, false, false), sy = __builtin_amdgcn_permlane16_swap(wa.y, wb.y, false, false);
                u32x4 w; w.x = sx[0]; w.y = sy[0]; w.z = sx[1]; w.w = sy[1];
                *(u32x4*)(H + (size_t)((fq & 1) ? rowb : rowa) * 2816 + colp) = w; }
    }
};

struct EpiDown {
    static constexpr bool PERM = true, AFTER_DRAIN = false, HAS_MID = false;
    const bf16_t* xn; float* out; float* ssq2;
    __device__ __forceinline__ void operator()(const f32x4 (&acc)[2][2][4][2], const Unit& u, int wr, int wc, int fr_, int fq_) const {
        const int ln_ = lane_id(), fr = ln_ & 15, fq = ln_ >> 4;
        const int row0 = u.pm * BM + wr * 64 + fr, col0 = u.pn * BM + wc * 32 + 8 * fq;
        int rbase = row0; asm volatile("" : "+v"(rbase));
#pragma unroll
        for (int ai = 0; ai < 2; ++ai)
#pragma unroll
            for (int m = 0; m < 4; ++m) { const int row = rbase + ai * HALF + m * 16; float s = 0.f;
#pragma unroll
                for (int bj = 0; bj < 2; ++bj) { const size_t off = (size_t)row * 1024 + col0 + bj * HALF;
                    const u32x4 xw = __builtin_nontemporal_load((const u32x4*)(xn + off));
                    const f32x4 xa = {__uint_as_float(xw.x << 16), __uint_as_float(xw.x & 0xffff0000u), __uint_as_float(xw.y << 16), __uint_as_float(xw.y & 0xffff0000u)};
                    const f32x4 xb = {__uint_as_float(xw.z << 16), __uint_as_float(xw.z & 0xffff0000u), __uint_as_float(xw.w << 16), __uint_as_float(xw.w & 0xffff0000u)};
                    const f32x4 v0 = xa + acc[ai][bj][m][0] * (1.f / (F8_SH * F8_SW)), v1 = xb + acc[ai][bj][m][1] * (1.f / (F8_SH * F8_SW));
                    *(f32x4*)(out + off) = v0; *(f32x4*)(out + off + 4) = v1; s += sq4(v0) + sq4(v1); }
                s += __shfl_xor(s, 16); s += __shfl_xor(s, 32);
                if (fq == 0) ssq2[(size_t)row * 16 + u.pn * 4 + wc] = s;
                asm volatile("" ::: "memory"); }
    }
};

struct EpiDownNorm {
    static constexpr bool PERM = true, AFTER_DRAIN = false, HAS_MID = false;
    const bf16_t* xn; float* out; float* ssq2; unsigned* cnt; const float* gain;
    __device__ __forceinline__ void operator()(f32x4 (&acc)[2][2][4][2], const Unit& u, int wr, int wc, int fr_, int fq_) const {
        const int ln_ = lane_id(), fr = ln_ & 15, fq = ln_ >> 4;
        const int row0 = u.pm * BM + wr * 64 + fr, col0 = u.pn * BM + wc * 32 + 8 * fq;
        int rbase = row0; asm volatile("" : "+v"(rbase));
        {
            u32x4 xw[2][4][2];
#pragma unroll
            for (int ai = 0; ai < 2; ++ai)
#pragma unroll
                for (int m = 0; m < 4; ++m)
#pragma unroll
                    for (int bj = 0; bj < 2; ++bj) { unsigned off = (unsigned)(rbase + ai * HALF + m * 16) * 1024u + col0 + bj * HALF; asm volatile("" : "+v"(off)); xw[ai][m][bj] = __builtin_nontemporal_load((const u32x4*)(xn + off)); }
#pragma unroll
            for (int ai = 0; ai < 2; ++ai)
#pragma unroll
                for (int m = 0; m < 4; ++m) { const int row = rbase + ai * HALF + m * 16; float s = 0.f;
#pragma unroll
                    for (int bj = 0; bj < 2; ++bj) { const u32x4 w = xw[ai][m][bj];
                        const f32x4 xa = {__uint_as_float(w.x << 16), __uint_as_float(w.x & 0xffff0000u), __uint_as_float(w.y << 16), __uint_as_float(w.y & 0xffff0000u)};
                        const f32x4 xb = {__uint_as_float(w.z << 16), __uint_as_float(w.z & 0xffff0000u), __uint_as_float(w.w << 16), __uint_as_float(w.w & 0xffff0000u)};
                        acc[ai][bj][m][0] = acc[ai][bj][m][0] * (1.f / (F8_SH * F8_SW)) + xa; acc[ai][bj][m][1] = acc[ai][bj][m][1] * (1.f / (F8_SH * F8_SW)) + xb; s += sq4(acc[ai][bj][m][0]) + sq4(acc[ai][bj][m][1]); }
                    s += __shfl_xor(s, 16); s += __shfl_xor(s, 32);
                    if (fq == 0) __hip_atomic_store(ssq2 + (size_t)(u.pn * 4 + wc) * 32768 + row, s, __ATOMIC_RELAXED, __HIP_MEMORY_SCOPE_AGENT); }
        }
        asm volatile("s_waitcnt vmcnt(0)" ::: "memory");
        unsigned* cw = cnt + 64 * u.pm;
        if (fr == 0 && fq == 0) __hip_atomic_fetch_add(cw, 1u, __ATOMIC_RELAXED, __HIP_MEMORY_SCOPE_AGENT);
        { unsigned sp = 0; while ((unsigned)__builtin_amdgcn_readfirstlane((int)__hip_atomic_load(cw, __ATOMIC_RELAXED, __HIP_MEMORY_SCOPE_AGENT)) < 32u) { __builtin_amdgcn_s_sleep(1); if (++sp > (1u << 22)) break; } }
        f32x4 g[2][2];
#pragma unroll
        for (int bj = 0; bj < 2; ++bj) { g[bj][0] = *(const f32x4*)(gain + col0 + bj * HALF); g[bj][1] = *(const f32x4*)(gain + col0 + bj * HALF + 4); }
        float pv[8][4];
#pragma unroll
        for (int i = 0; i < 8; ++i) { const float* pp = ssq2 + (size_t)(4 * fq) * 32768 + (rbase + (i >> 2) * HALF + (i & 3) * 16);
#pragma unroll
            for (int j = 0; j < 4; ++j) pv[i][j] = __hip_atomic_load(pp + j * 32768, __ATOMIC_RELAXED, __HIP_MEMORY_SCOPE_AGENT); }
#pragma unroll
        for (int ai = 0; ai < 2; ++ai)
#pragma unroll
            for (int m = 0; m < 4; ++m) { const int row = rbase + ai * HALF + m * 16;
                float s = (pv[ai * 4 + m][0] + pv[ai * 4 + m][1]) + (pv[ai * 4 + m][2] + pv[ai * 4 + m][3]);
                s += __shfl_xor(s, 16); s += __shfl_xor(s, 32);
                const float rstd = __builtin_amdgcn_rsqf(s * (1.f / 1024.f) + RMS_EPS_F);
#pragma unroll
                for (int bj = 0; bj < 2; ++bj) { const size_t off = (size_t)row * 1024 + col0 + bj * HALF;
                    *(f32x4*)(out + off) = acc[ai][bj][m][0] * rstd * g[bj][0]; *(f32x4*)(out + off + 4) = acc[ai][bj][m][1] * rstd * g[bj][1]; } }
    }
};
template <class Epi, class Sched, bool ALIGN_EPI = false, bool SP2 = false, bool F8 = false>
__device__ __forceinline__ void gemm_phase(PG8_LAS unsigned char* lds, const Gemm g, const Sched& S, const Epi& E, int wave) {
    const int wid = __builtin_amdgcn_readfirstlane(wave), lane = lane_id(), tid = wid * 64 + lane, wr = wid >> 2, wc = wid & 3, fr = lane & 15, fq = lane >> 4;
    const int K = F8 ? g.K / 2 : g.K, nt = K / BK;
    unsigned voffA[2], voffB[2];
#pragma unroll
    for (int i = 0; i < 2; ++i) { int R, C; stage_rc(tid * 16 + i * 8192, R, C); const int Rb = Epi::PERM ? ((R & ~31) + perm32(R & 31)) : R;
        voffA[i] = (unsigned)(R * K + C) * 2u; voffB[i] = (unsigned)(Rb * K + C) * 2u; }
    const unsigned kstep = (unsigned)(BK * 2);
    const unsigned hstep = (unsigned)HALF * K * 2;
    const unsigned tstep = 2 * hstep;
    const unsigned ldsw = (unsigned)wid * 1024u;
    const int aoff = lds_byte(wr * 64 + fr, fq * 8), boff = lds_byte(wc * 32 + fr, fq * 8);
#define PG8_SA(b, h) (((b) * 2 + (h)) * HTB)
#define PG8_SB(b, h) ((4 + (b) * 2 + (h)) * HTB)
    const __amdgpu_buffer_rsrc_t rsA = __builtin_amdgcn_make_buffer_rsrc((void*)g.A, 0, 0x7fffffff, 0x00020000), rsB = __builtin_amdgcn_make_buffer_rsrc((void*)g.Bt, 0, 0x7fffffff, 0x00020000);
#define PG8_STAGE(bufoff, gbase, voff) do { _Pragma("unroll") for (int _i = 0; _i < 2; ++_i) \
        __builtin_amdgcn_raw_ptr_buffer_load_lds(PG8_RS_##voff, (PG8_LAS unsigned*)(lds + (bufoff) + ldsw + _i * 8192), 16, (voff)[_i], (int)(gbase), 0, 0); } while (0)
#define PG8_RS_voffA rsA
#define PG8_RS_voffB rsB
#define PG8_LD8(base, off) __builtin_shufflevector(*(const PG8_LAS i32x4*)((base) + (off)), *(const PG8_LAS i32x4*)((base) + (off) + 1024), 0, 1, 2, 3, 4, 5, 6, 7)
#define PG8_LDA(dst, b, h) do { if constexpr (F8) { _Pragma("unroll") for (int m = 0; m < 4; ++m) dst##8[m] = PG8_LD8(abase8, PG8_SA(b, h) + m * 2048); } else { \
        _Pragma("unroll") for (int m = 0; m < 4; ++m) _Pragma("unroll") for (int k = 0; k < 2; ++k) dst[m][k] = *(const PG8_LAS bf16x8*)(lds + PG8_SA(b, h) + aoff + m * 2048 + k * 1024); } } while (0)
#define PG8_LDB(dst, b, h) do { if constexpr (F8) { _Pragma("unroll") for (int n = 0; n < 2; ++n) dst##8[n] = PG8_LD8(bbase8, PG8_SB(b, h) - PG8_SB(0, 0) + n * 2048); } else { \
        _Pragma("unroll") for (int n = 0; n < 2; ++n) _Pragma("unroll") for (int k = 0; k < 2; ++k) dst[n][k] = *(const PG8_LAS bf16x8*)(lds + PG8_SB(b, h) + boff + n * 2048 + k * 1024); } } while (0)
#define PG8_MMA(ai, bj, At, Bt) do { __builtin_amdgcn_s_setprio(1); if constexpr (F8) { _Pragma("unroll") for (int m = 0; m < 4; ++m) _Pragma("unroll") for (int n = 0; n < 2; ++n) \
        acc[ai][bj][m][n] = __builtin_amdgcn_mfma_scale_f32_16x16x128_f8f6f4(Bt##8[n], At##8[m], acc[ai][bj][m][n], 0, 0, 0, 0, 0, 0); } else \
        _Pragma("unroll") for (int m = 0; m < 4; ++m) _Pragma("unroll") for (int n = 0; n < 2; ++n) _Pragma("unroll") for (int k = 0; k < 2; ++k) \
        acc[ai][bj][m][n] = __builtin_amdgcn_mfma_f32_16x16x32_bf16(Bt[n][k], At[m][k], acc[ai][bj][m][n], 0, 0, 0); __builtin_amdgcn_s_setprio(0); } while (0)
#define PG8_WAIT_V(n) asm volatile("s_waitcnt vmcnt(" #n ")" ::: "memory")
#define PG8_WAIT_L(n) asm volatile("s_waitcnt lgkmcnt(" #n ")" ::: "memory")
#define PG8_BAR __builtin_amdgcn_s_barrier()
#define PG8_SCHED __builtin_amdgcn_sched_barrier(0)
    Unit cur, nxt; int ui = 0;
    if (!S.next(0, cur)) return;
    f32x4 acc[2][2][4][2];
#pragma unroll
    for (int a = 0; a < 2; ++a)
#pragma unroll
        for (int b = 0; b < 2; ++b)
#pragma unroll
            for (int m = 0; m < 4; ++m)
#pragma unroll
                for (int n = 0; n < 2; ++n) acc[a][b][m][n] = (f32x4){0.f, 0.f, 0.f, 0.f};
    PG8_LAS unsigned char* abase8 = lds + aoff; PG8_LAS unsigned char* bbase8 = lds + PG8_SB(0, 0) + boff;
    if constexpr (F8) { asm volatile("" : "+v"(abase8)); asm volatile("" : "+v"(bbase8)); }
    bf16x8 At[4][2], B0[2][2], B1[2][2]; i32x8 At8[4], B08[2], B18[2];
    unsigned cA = (unsigned)cur.pm * tstep, cB = (unsigned)cur.pn * tstep;
    S.a_ready(cur);
    if constexpr (SP2) {
        PG8_STAGE(PG8_SB(0, 0), cB, voffB); PG8_STAGE(PG8_SB(0, 1), cB + hstep, voffB); PG8_STAGE(PG8_SA(0, 0), cA, voffA); PG8_STAGE(PG8_SA(0, 1), cA + hstep, voffA);
        if (wr == 1) PG8_BAR;
        PG8_WAIT_V(2); PG8_BAR;
        PG8_STAGE(PG8_SB(1, 0), cB + kstep, voffB); PG8_STAGE(PG8_SA(1, 0), cA + kstep, voffA); PG8_STAGE(PG8_SB(1, 1), cB + hstep + kstep, voffB);
        PG8_WAIT_V(6); PG8_BAR;
    } else {
        PG8_STAGE(PG8_SB(0, 0), cB, voffB); PG8_STAGE(PG8_SA(0, 0), cA, voffA); PG8_STAGE(PG8_SB(0, 1), cB + hstep, voffB); PG8_STAGE(PG8_SA(0, 1), cA + hstep, voffA);
        if (wr == 1) PG8_BAR;
        PG8_WAIT_V(4); PG8_BAR;
        PG8_STAGE(PG8_SB(1, 0), cB + kstep, voffB); PG8_STAGE(PG8_SA(1, 0), cA + kstep, voffA); PG8_STAGE(PG8_SB(1, 1), cB + hstep + kstep, voffB);
        PG8_WAIT_V(6); PG8_BAR;
    }
    for (;;) {
        const bool has_next = S.next(ui + 1, nxt);
        const unsigned nA = has_next ? (unsigned)nxt.pm * tstep : cA, nB = has_next ? (unsigned)nxt.pn * tstep : cB;
#pragma nounroll
        for (int t = 0; t < nt; t += 2) {
            if constexpr (Epi::HAS_MID) { if (t == (nt >> 1)) E.mid(acc, cur, wr, fr); }
            const bool last = (t == nt - 2);
            const unsigned a1 = cA + (unsigned)(t + 1) * kstep;
            const unsigned a2 = last ? nA : cA + (unsigned)(t + 2) * kstep, b2 = last ? nB : cB + (unsigned)(t + 2) * kstep;
            const unsigned a3 = a2 + kstep, b3 = b2 + kstep;
            if (last && has_next) S.a_ready(nxt);
            if constexpr (SP2) {
            PG8_LDB(B0, 0, 0); PG8_LDB(B1, 0, 1); PG8_SCHED; PG8_LDA(At, 0, 0); PG8_STAGE(PG8_SA(1, 1), a1 + hstep, voffA);
            PG8_WAIT_V(8); PG8_WAIT_L(0); PG8_BAR; PG8_MMA(0, 0, At, B0); PG8_MMA(0, 1, At, B1); PG8_BAR; PG8_SCHED;
            PG8_LDA(At, 0, 1); PG8_STAGE(PG8_SB(0, 0), b2, voffB); PG8_STAGE(PG8_SB(0, 1), b2 + hstep, voffB); PG8_STAGE(PG8_SA(0, 0), a2, voffA);
            PG8_WAIT_V(8); PG8_WAIT_L(0); PG8_BAR; PG8_MMA(1, 0, At, B0); PG8_MMA(1, 1, At, B1); PG8_BAR; PG8_SCHED;
            PG8_LDB(B0, 1, 0); PG8_LDB(B1, 1, 1); PG8_SCHED; PG8_LDA(At, 1, 0); PG8_STAGE(PG8_SA(0, 1), a2 + hstep, voffA);
            PG8_WAIT_V(8); PG8_WAIT_L(0); PG8_BAR; PG8_MMA(0, 0, At, B0); PG8_MMA(0, 1, At, B1); PG8_BAR; PG8_SCHED;
            PG8_LDA(At, 1, 1); PG8_STAGE(PG8_SB(1, 0), b3, voffB); PG8_STAGE(PG8_SB(1, 1), b3 + hstep, voffB); PG8_STAGE(PG8_SA(1, 0), a3, voffA);
            PG8_WAIT_V(8); PG8_WAIT_L(0); PG8_BAR; PG8_MMA(1, 0, At, B0); PG8_MMA(1, 1, At, B1); PG8_BAR; PG8_SCHED;
            } else {
            PG8_LDB(B0, 0, 0); PG8_SCHED; PG8_LDA(At, 0, 0); PG8_STAGE(PG8_SA(1, 1), a1 + hstep, voffA);
            PG8_WAIT_L(8); PG8_BAR; PG8_WAIT_L(0); PG8_MMA(0, 0, At, B0); PG8_BAR; PG8_SCHED;
            PG8_LDB(B1, 0, 1); PG8_STAGE(PG8_SB(0, 0), b2, voffB);
            PG8_BAR; PG8_WAIT_L(0); PG8_MMA(0, 1, At, B1); PG8_BAR;
            PG8_LDA(At, 0, 1); PG8_STAGE(PG8_SA(0, 0), a2, voffA);
            PG8_BAR; PG8_WAIT_L(0); PG8_MMA(1, 0, At, B0); PG8_BAR; PG8_SCHED;
            PG8_STAGE(PG8_SB(0, 1), b2 + hstep, voffB);
            PG8_WAIT_V(6); PG8_BAR; PG8_MMA(1, 1, At, B1); PG8_BAR;
            PG8_LDB(B0, 1, 0); PG8_SCHED; PG8_LDA(At, 1, 0); PG8_STAGE(PG8_SA(0, 1), a2 + hstep, voffA);
            PG8_WAIT_L(8); PG8_BAR; PG8_WAIT_L(0); PG8_MMA(0, 0, At, B0); PG8_BAR; PG8_SCHED;
            PG8_LDB(B1, 1, 1); PG8_STAGE(PG8_SB(1, 0), b3, voffB);
            PG8_BAR; PG8_WAIT_L(0); PG8_MMA(0, 1, At, B1); PG8_BAR;
            PG8_LDA(At, 1, 1); PG8_STAGE(PG8_SA(1, 0), a3, voffA);
            PG8_BAR; PG8_WAIT_L(0); PG8_MMA(1, 0, At, B0); PG8_BAR; PG8_SCHED;
            PG8_STAGE(PG8_SB(1, 1), b3 + hstep, voffB);
            PG8_WAIT_V(6); PG8_BAR; PG8_MMA(1, 1, At, B1); PG8_BAR;
            }
        }
        if constexpr (ALIGN_EPI) { if (wr == 0) PG8_BAR; }
        if constexpr (!Epi::AFTER_DRAIN) { E(acc, cur, wr, wc, fr, fq); S.done(cur); }
        if (!has_next) break;
#pragma unroll
        for (int a = 0; a < 2; ++a)
#pragma unroll
            for (int b = 0; b < 2; ++b)
#pragma unroll
                for (int m = 0; m < 4; ++m)
#pragma unroll
                    for (int n = 0; n < 2; ++n) acc[a][b][m][n] = (f32x4){0.f, 0.f, 0.f, 0.f};
        cur = nxt; cA = nA; cB = nB; ++ui;
        if constexpr (ALIGN_EPI) { if (wr == 1) PG8_BAR; }
    }
    PG8_WAIT_V(0);
    if constexpr (!ALIGN_EPI) { if (wr == 0) PG8_BAR; }
    PG8_BAR;
    if constexpr (Epi::AFTER_DRAIN) { E.fused(acc, cur, wr, wc, fr, fq, lds, wid, lane); S.done(cur); }
#undef PG8_SA
#undef PG8_SB
#undef PG8_STAGE
#undef PG8_RS_voffA
#undef PG8_RS_voffB
#undef PG8_LDA
#undef PG8_LDB
#undef PG8_MMA
#undef PG8_WAIT_V
#undef PG8_WAIT_L
#undef PG8_BAR
#undef PG8_SCHED
}
}

constexpr int NWAVES = 8;
#ifndef MK_N_LAUNCHES
#define MK_N_LAUNCHES 1
#endif
#ifndef MK_STAG1
#define MK_STAG1 0
#endif
#ifndef MK_STAG5
#define MK_STAG5 0
#endif
constexpr int PER_PHASE = 7;
constexpr int N_LAUNCHES = MK_N_LAUNCHES;

constexpr int BATCH = 8, SEQ = 4096, D = 1024, NH = 16, HD = 64, FF = 2816, NHM = 8;
constexpr int M = BATCH * SEQ;
constexpr int NQKV = 3 * D, NGU = 2 * FF;
constexpr float RMS_EPS = 1e-6f;
constexpr float QSCALE = 0.125f * 1.4426950408889634f;

constexpr size_t MiB = 1u << 20;
constexpr size_t WS_CTL = 0, CTL_ZERO_BYTES = 64 * 1024;
constexpr size_t WS_ROPE = 1 * MiB;
constexpr size_t WS_WQKV = 2 * MiB, WS_WO = 8 * MiB, WS_WGU = 10 * MiB, WS_WD = 21 * MiB;
constexpr size_t WS_KPART = 27 * MiB;
constexpr size_t WS_SSQA = 28 * MiB, WS_SSQ1 = 30 * MiB, WS_SSQ2 = 32 * MiB;
constexpr size_t WS_XN = 40 * MiB;
constexpr size_t WS_QO = 104 * MiB, WS_K = 168 * MiB, WS_V = 232 * MiB;
constexpr size_t WS_H = 104 * MiB;
#ifndef MK_REPEAT_PHASE
#define MK_REPEAT_PHASE -1
#endif
constexpr size_t WS_O = WS_QO;
constexpr size_t WS_FARO = 296 * MiB, WS_FARL = 328 * MiB;
constexpr size_t WS_XN8 = 330 * MiB;
constexpr size_t WS_O8 = 362 * MiB;
constexpr size_t WS_END = (MK_REPEAT_PHASE == 3 ? 490 : 394) * MiB;
constexpr size_t QKV8_OFF = 2 * MiB;
constexpr int CW_TMO = 0, CW_CODE = 1;
constexpr int CW_BAR = 4096;
constexpr int CW_PANEL = 8192;
constexpr int CW_FAR = 2048;

constexpr int RING_OFF = 0, RING_BYTES = 131072;
constexpr int LDSCTL_OFF = RING_BYTES, MISC_OFF = LDSCTL_OFF + 320;
constexpr int LDS_BYTES = 147456;
static_assert(WS_V - WS_K == WS_K - WS_QO, "Q | K | V equally spaced");
#define GAS __attribute__((address_space(1)))
#define LAS __attribute__((address_space(3)))
typedef unsigned short bf16;
typedef unsigned v4u __attribute__((ext_vector_type(4)));
typedef float f32x4 __attribute__((ext_vector_type(4)));
typedef short bf16x8 __attribute__((ext_vector_type(8)));
typedef GAS unsigned gu32;
typedef GAS unsigned long long gu64;
#define RLX_AGENT __ATOMIC_RELAXED, __HIP_MEMORY_SCOPE_AGENT
#define LDS_WAIT() asm volatile("s_waitcnt lgkmcnt(0)" ::: "memory")
#define VM_WAIT() asm volatile("s_waitcnt vmcnt(0)" ::: "memory")
__device__ __forceinline__ unsigned long long rt() { return __builtin_amdgcn_s_memrealtime(); }
__device__ __forceinline__ unsigned f2bf(float f) { unsigned u = __builtin_bit_cast(unsigned, f); return (u + 0x7fffu + ((u >> 16) & 1u)) >> 16; }
__device__ __forceinline__ unsigned pk2(float lo, float hi) { return f2bf(lo) | (f2bf(hi) << 16); }

#define XB_TMO      128
#define XB_XCNT(j)  (256  + 64 * (j))
#define XB_XSUB(j)  (1280 + 64 * (j))
#define XB_XGEN(j)  (2304 + 64 * (j))
#define XB_TOP      3328
#define XB_TOPGEN   3392
#define XCD_BAR_WORDS 3456
#define XB_SPIN_CAP (1u << 18)

__device__ __forceinline__ unsigned xb_ld(unsigned* p)              { return __hip_atomic_load(p, __ATOMIC_RELAXED, __HIP_MEMORY_SCOPE_AGENT); }
__device__ __forceinline__ unsigned xb_add(unsigned* p, unsigned v) { return __hip_atomic_fetch_add(p, v, __ATOMIC_RELAXED, __HIP_MEMORY_SCOPE_AGENT); }
__device__ __forceinline__ unsigned xb_xcc_id() { return (unsigned)__builtin_amdgcn_s_getreg((3 << 11) | 20) & 0xFu; }
#define XB_SPIN(cond, bar) do { unsigned _sp = 0; while (cond) { __builtin_amdgcn_s_sleep(1); \
    if ((++_sp & 255u) == 0u) { if (xb_ld(&(bar)[XB_TMO])) break; if (_sp > XB_SPIN_CAP) { atomicAdd(&(bar)[XB_TMO], 1u); break; } } } } while (0)

struct XcdBarrier {
    unsigned* bar; unsigned x;
    volatile LAS unsigned* st;
};

__device__ __forceinline__ int mk_lane() { int l; asm volatile("v_mbcnt_lo_u32_b32 %0, -1, 0\n\tv_mbcnt_hi_u32_b32 %0, -1, %0" : "=v"(l)); return l; }
__device__ __forceinline__ XcdBarrier xcd_barrier_post(unsigned* bar, volatile LAS unsigned* st, int wave) {
    XcdBarrier b; b.bar = bar; b.x = xb_xcc_id(); b.st = st;
    if (wave == 0 && mk_lane() == 0) (void)xb_add(&bar[XB_XCNT(b.x)], 1u);
    return b;
}
__device__ __forceinline__ void xcd_barrier_complete(unsigned* bar, unsigned x, unsigned& nloc, unsigned& nx) {
    const unsigned G = gridDim.x * gridDim.y * gridDim.z;
    unsigned sum, cnt, mine, sp = 0u;
    for (;;) {
        sum = 0u; cnt = 0u; mine = 0u;
#pragma unroll
        for (unsigned j = 0; j < 16; ++j) { const unsigned c = xb_ld(&bar[XB_XCNT(j)]); sum += c; cnt += (c > 0u) ? 1u : 0u; mine = (j == x) ? c : mine; }
        if (sum == G) break;
        __builtin_amdgcn_s_sleep(1);
        if ((++sp & 255u) == 0u) { if (xb_ld(&bar[XB_TMO])) break; if (sp > XB_SPIN_CAP) { atomicAdd(&bar[XB_TMO], 1u); break; } }
    }
    nloc = mine > 0u ? mine : 1u; nx = cnt > 0u ? cnt : 1u;
}

__device__ __forceinline__ void xcd_barrier(const XcdBarrier& b, int wave) {
    asm volatile("s_waitcnt vmcnt(0)" ::: "memory");
    __syncthreads();
    if (wave == 0 && mk_lane() == 0) {
        unsigned* bar = b.bar;
        __builtin_amdgcn_s_waitcnt(0);
        unsigned nloc = b.st[0], nx = b.st[1];
        if (nloc == 0u) { xcd_barrier_complete(bar, b.x, nloc, nx); b.st[0] = nloc; b.st[1] = nx; }
        const unsigned old = xb_add(&bar[XB_XSUB(b.x)], 1u);
        const unsigned gen = old / nloc;
        if (old + 1u == (gen + 1u) * nloc) {
            __builtin_amdgcn_fence(__ATOMIC_RELEASE, "agent");
            asm volatile("s_waitcnt vmcnt(0)" ::: "memory");
            const unsigned og = xb_add(&bar[XB_TOP], 1u);
            const unsigned tg = og / nx;
            if (og + 1u == (tg + 1u) * nx) xb_add(&bar[XB_TOPGEN], 1u);
            else XB_SPIN(xb_ld(&bar[XB_TOPGEN]) == tg, bar);
            __builtin_amdgcn_fence(__ATOMIC_ACQUIRE, "agent");
            xb_add(&bar[XB_XGEN(b.x)], 1u);
            asm volatile("s_waitcnt vmcnt(0)" ::: "memory");
        } else {
            XB_SPIN(xb_ld(&bar[XB_XGEN(b.x)]) == gen, bar);
            __builtin_amdgcn_fence(__ATOMIC_ACQUIRE, "agent");
            asm volatile("s_waitcnt vmcnt(0)" ::: "memory");
        }
    }
    __syncthreads();
}

#include <hip/hip_bf16.h>
#include <cmath>
namespace attn_body {
using bf16=__hip_bfloat16;
using bf16x8=__attribute__((ext_vector_type(8)))short;
using s16x4=__attribute__((ext_vector_type(4)))short;
using f32x16=__attribute__((ext_vector_type(16)))float;
using u32x4=__attribute__((ext_vector_type(4)))unsigned;
using f32x4_t=__attribute__((ext_vector_type(4)))float;
constexpr int BATCH=8,NHEAD=16,SEQ=4096,D=64,DM=NHEAD*D;
constexpr int NW=8,QBLK=32,QB=QBLK*NW,KVBLK=64,NQB=SEQ/QB;
constexpr int ATTN_PITCH=DM, ATTN_UNIT_ROWS=QB;
__device__ __forceinline__ int crow(int r,int hi){return (r&3)+8*(r>>2)+4*hi;}
#define SBAR() __builtin_amdgcn_sched_barrier(0)
__device__ __forceinline__ void cmask(f32x16&p0,f32x16&p1,int jb,int qrel,int hi){
  const float NEG=-INFINITY; int kb=64*jb+4*hi;
  #pragma unroll
  for(int r=0;r<16;++r){int kv=kb+(r&3)+8*(r>>2); if(kv>qrel)p0[r]=NEG; if(kv+32>qrel)p1[r]=NEG;}
}

__device__ __forceinline__ void dm_range(f32x16&p0,f32x16&p1,int x,unsigned bw){
  #pragma unroll
  for(int r=0;r<16;++r){ const int kp=(r&3)+8*(r>>2); if((unsigned)(x-kp)>bw)p0[r]=-1e30f; if((unsigned)(x-32-kp)>bw)p1[r]=-1e30f; } }
template<int KIND> __device__ __forceinline__ int dmode(int lo){
  if(KIND==2) return (lo+94<33||lo>128)?0:4;
  return (lo+94<0||lo>512)?0:((lo<0)?40:((lo+94<=128)?1:((lo<=128)?41:((lo+94<=512)?2:42)))); }
__device__ __forceinline__ void dm_adj128(f32x16&p0,f32x16&p1,int dqh,const f32x16&adj){
  #pragma unroll
  for(int r=0;r<16;++r){ const int kp=(r&3)+8*(r>>2); p0[r]+=(dqh-kp>128)?adj[r]:0.f; p1[r]+=(dqh-32-kp>128)?adj[r]:0.f; } }
__device__ __forceinline__ void fmask(f32x16&p0,f32x16&p1,int dq){
  #pragma unroll
  for(int r=0;r<16;++r){ const int kp=(r&3)+8*(r>>2); if((unsigned)(dq-kp-33)>95u)p0[r]=-1e30f; if((unsigned)(dq-kp-65)>95u)p1[r]=-1e30f; }
}
constexpr int NSLOT=3, SLOTB=8192;
constexpr int LDS_K=0, LDS_V=NSLOT*SLOTB, LDS_WS=2*NSLOT*SLOTB, LDS_OST=LDS_WS+NW*64*4, LDS_BYTES=LDS_OST+NW*4096;
constexpr int LDS_TAB=LDS_BYTES, TABB=4096, LDS_ALL=LDS_TAB+4*TABB;
constexpr float C2=0.125f*1.4426950408889634f;
__device__ __forceinline__ void glds16(const void*gsrc,unsigned lds_dst){unsigned keep;
  asm volatile("s_mov_b32 %0, m0\n\ts_mov_b32 m0, %2\n\ts_nop 0\n\tglobal_load_lds_dwordx4 %1, off\n\ts_mov_b32 m0, %0":"=&s"(keep):"v"(gsrc),"s"(lds_dst):"memory");}
__device__ __forceinline__ float max3f(float a,float b,float c){float r;asm("v_max3_f32 %0, %1, %2, %3":"=v"(r):"v"(a),"v"(b),"v"(c));return r;}
__device__ __forceinline__ float max2f(float a,float b){float r;asm("v_max_f32_e32 %0, %1, %2":"=v"(r):"v"(a),"v"(b));return r;}
__device__ __forceinline__ float fadd_s(float a,float b){float r;asm("v_add_f32_e32 %0, %1, %2":"=v"(r):"v"(a),"v"(b));return r;}
__device__ __forceinline__ float fsub_s(float a,float b){float r;asm("v_sub_f32_e32 %0, %1, %2":"=v"(r):"v"(a),"v"(b));return r;}
typedef float f32x2_t __attribute__((ext_vector_type(2))); typedef __bf16 bf16x2_t __attribute__((ext_vector_type(2)));
__device__ __forceinline__ unsigned cvtpk_s(float lo,float hi){f32x2_t v={lo,hi};bf16x2_t b=__builtin_convertvector(v,bf16x2_t);return __builtin_bit_cast(unsigned,b);}
#define WAIT_BAR(N) asm volatile("s_waitcnt vmcnt(" #N ") lgkmcnt(0)\n\ts_barrier":::"memory")

__device__ __forceinline__ void qkt(f32x16&p0,f32x16&p1,const char*Kslot,const bf16x8*qr,const f32x16&negm,int r32,int hi){
  const char*kb=Kslot+hi*1024+r32*16;
  #pragma unroll
  for(int d0=0;d0<4;++d0){
    const bf16x8 b0=*reinterpret_cast<const bf16x8*>(kb+d0*2048);
    const bf16x8 b1=*reinterpret_cast<const bf16x8*>(kb+d0*2048+512);
    if(d0==0){p0=__builtin_amdgcn_mfma_f32_32x32x16_bf16(b0,qr[0],negm,0,0,0);p1=__builtin_amdgcn_mfma_f32_32x32x16_bf16(b1,qr[0],negm,0,0,0);}
    else{p0=__builtin_amdgcn_mfma_f32_32x32x16_bf16(b0,qr[d0],p0,0,0,0);p1=__builtin_amdgcn_mfma_f32_32x32x16_bf16(b1,qr[d0],p1,0,0,0);}}
}
typedef __attribute__((address_space(3))) const char* lds_cptr;
typedef short v4i16_t __attribute__((ext_vector_type(4)));
__device__ __forceinline__ void kload8(bf16x8*kf,lds_cptr kp){
  kf[0]=*(const __attribute__((address_space(3))) bf16x8*)(kp);      kf[1]=*(const __attribute__((address_space(3))) bf16x8*)(kp+512);
  kf[2]=*(const __attribute__((address_space(3))) bf16x8*)(kp+2048); kf[3]=*(const __attribute__((address_space(3))) bf16x8*)(kp+2560);
  kf[4]=*(const __attribute__((address_space(3))) bf16x8*)(kp+4096); kf[5]=*(const __attribute__((address_space(3))) bf16x8*)(kp+4608);
  kf[6]=*(const __attribute__((address_space(3))) bf16x8*)(kp+6144); kf[7]=*(const __attribute__((address_space(3))) bf16x8*)(kp+6656);
}
__device__ __forceinline__ void kload2(bf16x8*kf,lds_cptr kp,int j){ kf[2*j]=*(const __attribute__((address_space(3))) bf16x8*)(kp+j*2048); kf[2*j+1]=*(const __attribute__((address_space(3))) bf16x8*)(kp+j*2048+512); }
__device__ __forceinline__ s16x4 vtr(lds_cptr p){ return __builtin_bit_cast(s16x4,__builtin_amdgcn_ds_read_tr16_b64_v4i16((__attribute__((address_space(3))) v4i16_t*)p)); }
__device__ __forceinline__ float rowmax(const f32x16&p0,const f32x16&p1){
  float a=max3f(p0[0],p0[1],p1[0]),b=max3f(p0[2],p0[3],p1[1]);a=max3f(a,p1[2],p1[3]);
  #pragma unroll
  for(int r=4;r<16;r+=4){a=max3f(a,p0[r],p0[r+1]);b=max3f(b,p0[r+2],p0[r+3]);a=max3f(a,p1[r],p1[r+1]);b=max3f(b,p1[r+2],p1[r+3]);}
  const float m=max2f(a,b);
  auto rr=__builtin_amdgcn_permlane32_swap(__float_as_uint(m),__float_as_uint(m),false,false);
  return max2f(__uint_as_float(rr[0]),__uint_as_float(rr[1]));
}
__device__ __forceinline__ void pv(f32x16*o,int vb,bf16x8 pa0,bf16x8 pa1,bf16x8 pa2,bf16x8 pa3){
  #pragma unroll
  for(int d0=0;d0<2;++d0){s16x4 lo[4],hi[4];
    #pragma unroll
    for(int ks=0;ks<4;++ks){
      asm volatile("ds_read_b64_tr_b16 %0,%1 offset:%c2":"=&v"(lo[ks]):"v"(vb),"i"(d0*4096+ks*1024):"memory");
      asm volatile("ds_read_b64_tr_b16 %0,%1 offset:%c2":"=&v"(hi[ks]):"v"(vb),"i"(d0*4096+ks*1024+512):"memory");}
    asm volatile("s_waitcnt lgkmcnt(0)":::"memory");SBAR();
    #define PK(k) (bf16x8){lo[k][0],lo[k][1],lo[k][2],lo[k][3],hi[k][0],hi[k][1],hi[k][2],hi[k][3]}
    o[d0]=__builtin_amdgcn_mfma_f32_32x32x16_bf16(pa0,PK(0),o[d0],0,0,0);
    o[d0]=__builtin_amdgcn_mfma_f32_32x32x16_bf16(pa1,PK(1),o[d0],0,0,0);
    o[d0]=__builtin_amdgcn_mfma_f32_32x32x16_bf16(pa2,PK(2),o[d0],0,0,0);
    o[d0]=__builtin_amdgcn_mfma_f32_32x32x16_bf16(pa3,PK(3),o[d0],0,0,0);
    #undef PK
  }
}

#ifndef ATTN_STORE16
#define ATTN_STORE16(p,v) asm volatile("global_store_dwordx4 %0, %1, off sc1\n\ts_nop 1"::"v"(p),"v"(v):"memory")
#endif
template<int THRL,int KIND> __device__ __forceinline__ void attn_unit(int b,int h,int qb,unsigned char*ws,char*shm,int wave,bf16x8 (&qr)[4],bool pre,bool has_next,int nkind,int nb,int nh,int nqb){
  const bf16*Q=(const bf16*)(ws+WS_QO); const bf16*K=(const bf16*)(ws+WS_K); const bf16*V=(const bf16*)(ws+WS_V); unsigned char*O8=ws+WS_O8;
  float*ssq=(float*)(ws+WS_SSQA); const float*kpart=(const float*)(ws+WS_KPART); unsigned short*faro=(unsigned short*)(ws+WS_FARO); float*farl=(float*)(ws+WS_FARL);
  constexpr bool DIL=(KIND==1), FAR=(KIND==2); constexpr int RS=FAR?16:1;
  int tid=wave*64+mk_lane(); asm volatile("":"+v"(tid));
  const int lane=tid&63,r32=lane&31,hi=lane>>5; const int wid=__builtin_amdgcn_readfirstlane(tid>>6);
  const int rowbase=b*SEQ+(FAR?qb:0);   const int q0=FAR?0:qb*QB;
  const bf16*Qw=Q+(rowbase+(int)(q0+wid*QBLK)*RS)*DM+h*D;
  const int T0=DIL?(qb>2?4*qb-8:0):0;
  const bf16*Kh=K+(rowbase+(int)T0*KVBLK)*DM+h*D,*Vh=V+(rowbase+(int)T0*KVBLK)*DM+h*D;
  const unsigned lds0=(unsigned)(uintptr_t)shm;
  float*wsf=(float*)(shm+LDS_WS)+wid*64;
  const bf16*ksrc=Kh+(int)lane*RS*DM+wid*8;
  const bf16*vsrc=Vh+(int)(16*(wid&3)+(lane>>2))*RS*DM+(wid>>2)*32+(lane&3)*8;
  const unsigned kdst=lds0+LDS_K+wid*1024, vdst=lds0+LDS_V+wid*1024;
  #define DMA_K(t,slot) glds16(ksrc+(int)(t)*KVBLK*RS*DM,(unsigned)__builtin_amdgcn_readfirstlane(kdst+(slot)))
  #define DMA_V(t,slot) glds16(vsrc+(int)(t)*KVBLK*RS*DM,(unsigned)__builtin_amdgcn_readfirstlane(vdst+(slot)))
  const int vb0=(int)(lds0+LDS_V)+((lane>>4)&1)*32+(lane&3)*8+(4*hi+((lane&15)>>2))*64;
  const char*Kbase=shm+LDS_K; bf16x8 kf[8];
  const lds_cptr shm3=(lds_cptr)shm; const lds_cptr kp0=shm3+LDS_K+hi*1024+r32*16; const lds_cptr vp0=shm3+LDS_V+((lane>>4)&1)*32+(lane&3)*8+(4*hi+((lane&15)>>2))*64;
  const int NT=FAR?4:(q0+QB)/KVBLK-T0;
  if(!pre)DMA_K(0,0); DMA_V(0,0); if(!pre)DMA_K(1,SLOTB);
  #pragma unroll
  for(int d0=0;d0<4;++d0)if(!pre)qr[d0]=*reinterpret_cast<const bf16x8*>(&Qw[(int)r32*RS*DM+d0*16+hi*8]);
  float mhat=0.f,l_reg=0.f;f32x16 o[2];o[0]=f32x16{};o[1]=f32x16{};
  const int qrel=wid*QBLK+r32;
  const lds_cptr tabp=(lds_cptr)shm+LDS_TAB+lane*64;
  unsigned selmask=1u<<qb;
  if(KIND==0){
    f32x16 g=f32x16{};
    #pragma unroll
    for(int d0=0;d0<4;++d0){ float km[8];
      if(r32<16){ const float*kp_=kpart+(unsigned)((b*16+r32)*2)*512+h*64+d0*16+hi*8;
        const f32x4_t a0=*(const f32x4_t*)kp_,a1=*(const f32x4_t*)(kp_+4),b0=*(const f32x4_t*)(kp_+512),b1=*(const f32x4_t*)(kp_+516);
        km[0]=a0[0]+b0[0];km[1]=a0[1]+b0[1];km[2]=a0[2]+b0[2];km[3]=a0[3]+b0[3];km[4]=a1[0]+b1[0];km[5]=a1[1]+b1[1];km[6]=a1[2]+b1[2];km[7]=a1[3]+b1[3]; }
      else{ _Pragma("unroll") for(int j=0;j<8;++j)km[j]=0.f; }
      u32x4 wh,wl; float rs[8];
      wh[0]=cvtpk_s(km[0],km[1]);wh[1]=cvtpk_s(km[2],km[3]);wh[2]=cvtpk_s(km[4],km[5]);wh[3]=cvtpk_s(km[6],km[7]);
      #pragma unroll
      for(int j=0;j<4;++j){ rs[2*j]=km[2*j]-__uint_as_float(wh[j]<<16); rs[2*j+1]=km[2*j+1]-__uint_as_float(wh[j]&0xffff0000u); }
      wl[0]=cvtpk_s(rs[0],rs[1]);wl[1]=cvtpk_s(rs[2],rs[3]);wl[2]=cvtpk_s(rs[4],rs[5]);wl[3]=cvtpk_s(rs[6],rs[7]);
      g=__builtin_amdgcn_mfma_f32_32x32x16_bf16(__builtin_bit_cast(bf16x8,wh),qr[d0],g,0,0,0);
      g=__builtin_amdgcn_mfma_f32_32x32x16_bf16(__builtin_bit_cast(bf16x8,wl),qr[d0],g,0,0,0); }
    float gv[16];
    #pragma unroll
    for(int r=0;r<8;++r){ const float own=g[r],oth=__shfl_xor(own,32); const int bl=(r&3)+8*(r>>2); gv[bl]=hi?oth:own; gv[bl+4]=hi?own:oth; }
    #pragma unroll
    for(int j=0;j<16;++j) if(j>=qb)gv[j]=-3e38f;
    #pragma unroll
    for(int rd=0;rd<3;++rd){ float best=-3e38f;int bi=0;
      #pragma unroll
      for(int j=0;j<16;++j){ if(gv[j]>best){best=gv[j];bi=j;} }
      if(best>-3e38f)selmask|=1u<<bi;
      #pragma unroll
      for(int j=0;j<16;++j) if(j==bi)gv[j]=-3e38f; }
  }
  const int lo0=FAR?(32*wid-63):(q0-T0*KVBLK+32*wid-63);
  #define DMODE(t) dmode<KIND>(lo0-(t)*KVBLK)
  #define CMASK(P0,P1,t) do{ if(DIL){ if(md_t>=40){ const int dqh_=q0-(T0+(t))*KVBLK+qrel-4*hi; \
        if(md_t==41){ const f32x16 adj_=*(const __attribute__((address_space(3))) f32x16*)(tabp+3*TABB); dm_adj128(P0,P1,dqh_,adj_); } \
        else dm_range(P0,P1,dqh_-((md_t==40)?0:-4096),(md_t==40)?0x7fffffffu:4608u); } } \
    else if(FAR){ if(md_t==4)fmask(P0,P1,qrel-(t)*KVBLK-4*hi); } \
    else { int jb_=(t)-(NT-4); if(jb_>=0)cmask(P0,P1,jb_,qrel,hi); } }while(0)
  #define SETC(t) f32x16 ct; const int md_t=(KIND==0)?0:DMODE(t); { if(DIL){ const int to_=(md_t==0)?0:((md_t==2||md_t==42)?2*TABB:TABB); \
      const f32x16 tb_=*(const __attribute__((address_space(3))) f32x16*)(tabp+to_); _Pragma("unroll") for(int r=0;r<16;++r)ct[r]=tb_[r]-mhat; } \
    else { const float x_=(FAR?(md_t!=0):(((selmask>>((t)>>2))&1u)!=0u))?-mhat:-1e30f; _Pragma("unroll") for(int r=0;r<16;++r)ct[r]=x_; } asm volatile("":"+v"(ct)); }
  bool resc=false;
  #define START(P0,P1) do{ const float rm=rowmax(P0,P1); resc=false; \
    if(__any(rm>(float)THRL)){ const float dl=__builtin_fmaxf(rm,0.f); mhat=fadd_s(mhat,dl); \
      _Pragma("unroll") for(int r=0;r<16;++r){P0[r]=fsub_s(P0[r],dl);P1[r]=fsub_s(P1[r],dl);} \
      const float f=__builtin_amdgcn_exp2f(-dl); l_reg*=f; if(hi==0)wsf[r32]=f; resc=true; } \
    _Pragma("unroll") for(int r=0;r<16;++r)P0[r]=__builtin_amdgcn_exp2f(P0[r]); }while(0)
  #define RESC() do{ if(resc){ asm volatile("s_waitcnt lgkmcnt(0)":::"memory"); \
      _Pragma("unroll") for(int d_=0;d_<2;++d_) _Pragma("unroll") for(int r=0;r<16;++r)o[d_][r]*=wsf[crow(r,hi)]; } }while(0)
  f32x16 pA0,pA1,pB0,pB1;
  int sl_prev=0,sl_cur=0,sl_next=SLOTB;
  #define ROT() do{sl_prev=sl_cur;sl_cur=sl_next;sl_next=(sl_next==(NSLOT-1)*SLOTB)?0:sl_next+SLOTB;}while(0)
  if(!pre){ DMA_K(2,2*SLOTB);
    WAIT_BAR(3); }
  else { WAIT_BAR(1); }
  if(0)WAIT_BAR(3);
  { SETC(0); qkt(pA0,pA1,Kbase,qr,ct,r32,hi); asm volatile("s_nop 15\n\ts_nop 7":"+v"(pA0),"+v"(pA1));CMASK(pA0,pA1,0); }
  START(pA0,pA1);
  _Pragma("unroll") for(int r=0;r<16;++r)pA1[r]=__builtin_amdgcn_exp2f(pA1[r]);
  WAIT_BAR(0);
  RESC();
  DMA_K(3,0);DMA_V(1,SLOTB);
  ROT();
  kload8(kf,kp0+sl_cur);
  WAIT_BAR(2);
  s16x4 vlo[8],vhi[8]; u32x4 pw0,pw1,pw2,pw3;
  #define PKW(P,B) cvtpk_s(P[B],P[B+1])
  #define PAF(k) __builtin_bit_cast(bf16x8,pw##k)
  #define VFR(i) (bf16x8){vlo[i][0],vlo[i][1],vlo[i][2],vlo[i][3],vhi[i][0],vhi[i][1],vhi[i][2],vhi[i][3]}
  #define PIN(x) asm volatile("":"+v"(x))
  #define MX3(a,b,c) __builtin_fmaxf(__builtin_fmaxf((a),(b)),(c))
  #define GAPA(MF,A0,A1,A2,A3,W0,W1,PW) do{ MF; sacc+=A0; sacc+=A1; sacc+=A2; sacc+=A3; PIN(sacc); W0; W1; PIN(PW); SBAR(); }while(0)
  #define EX(v) __builtin_amdgcn_exp2f(v)
  #define GAPB(MF,X,B) do{ MF; X[B]=EX(X[B]); X[B+1]=EX(X[B+1]); X[B+2]=EX(X[B+2]); X[B+3]=EX(X[B+3]); PIN(X); SBAR(); }while(0)
  #define VRD(i) do{ vlo[i]=vtr(vp_+(((i)>>2)*4096+((i)&3)*1024)); vhi[i]=vtr(vp_+(((i)>>2)*4096+((i)&3)*1024+512)); }while(0)
  #define KRD(G,j) do{ if(G){ kload2(kf,kp0+sl_next,j); SBAR(); } }while(0)
  #define STEP(C0,C1,P0,P1,t,GK,GV,GL) do{ SBAR(); SETC(t); SBAR(); \
    const lds_cptr vp_=vp0+sl_prev; \
    VRD(0); SBAR(); float sacc=(P0[0]+P0[1]); \
    GAPA(C0=__builtin_amdgcn_mfma_f32_32x32x16_bf16(kf[0],qr[0],ct,0,0,0), P0[2],P0[3],P0[4],P0[5],     pw0[0]=PKW(P0,0), pw0[1]=PKW(P0,2), pw0); \
    VRD(4); SBAR(); GAPA(C1=__builtin_amdgcn_mfma_f32_32x32x16_bf16(kf[1],qr[0],ct,0,0,0), P0[6],P0[7],P0[8],P0[9],     pw0[2]=PKW(P0,4), pw0[3]=PKW(P0,6), pw0); \
    VRD(1); SBAR(); GAPA(C0=__builtin_amdgcn_mfma_f32_32x32x16_bf16(kf[2],qr[1],C0,0,0,0),   P0[10],P0[11],P0[12],P0[13], pw1[0]=PKW(P0,8), pw1[1]=PKW(P0,10), pw1); \
    VRD(5); SBAR(); GAPA(C1=__builtin_amdgcn_mfma_f32_32x32x16_bf16(kf[3],qr[1],C1,0,0,0),   P0[14],P0[15],P1[0],P1[1],   pw1[2]=PKW(P0,12),pw1[3]=PKW(P0,14), pw1); \
    VRD(2); SBAR(); GAPA(C0=__builtin_amdgcn_mfma_f32_32x32x16_bf16(kf[4],qr[2],C0,0,0,0),   P1[2],P1[3],P1[4],P1[5],     pw2[0]=PKW(P1,0), pw2[1]=PKW(P1,2), pw2); \
    VRD(6); SBAR(); GAPA(C1=__builtin_amdgcn_mfma_f32_32x32x16_bf16(kf[5],qr[2],C1,0,0,0),   P1[6],P1[7],P1[8],P1[9],     pw2[2]=PKW(P1,4), pw2[3]=PKW(P1,6), pw2); \
    VRD(3); SBAR(); GAPA(C0=__builtin_amdgcn_mfma_f32_32x32x16_bf16(kf[6],qr[3],C0,0,0,0),   P1[10],P1[11],P1[12],P1[13], pw3[0]=PKW(P1,8), pw3[1]=PKW(P1,10), pw3); \
    VRD(7); SBAR(); GAPA(C1=__builtin_amdgcn_mfma_f32_32x32x16_bf16(kf[7],qr[3],C1,0,0,0),   P1[14],P1[15],0.f,0.f,       pw3[2]=PKW(P1,12),pw3[3]=PKW(P1,14), pw3); \
    l_reg+=sacc; \
    if(GK){DMA_K((t)+3,sl_cur);} if(GV){DMA_V((t)+1,sl_next);} \
    CMASK(C0,C1,t); \
    { float a=MX3(C0[0],C0[1],C1[0]),b=MX3(C0[2],C0[3],C1[1]); a=MX3(a,C1[2],C1[3]); \
      _Pragma("unroll") for(int r=4;r<16;r+=4){a=MX3(a,C0[r],C0[r+1]);b=MX3(b,C0[r+2],C0[r+3]);a=MX3(a,C1[r],C1[r+1]);b=MX3(b,C1[r+2],C1[r+3]);} \
      float rm=__builtin_fmaxf(a,b); { auto rr=__builtin_amdgcn_permlane32_swap(__float_as_uint(rm),__float_as_uint(rm),false,false); rm=__builtin_fmaxf(__uint_as_float(rr[0]),__uint_as_float(rr[1])); } \
      resc=false; \
      if(__builtin_expect(__any(rm>(float)THRL),0)){ const float dl=__builtin_fmaxf(rm,0.f); mhat+=dl; \
        _Pragma("unroll") for(int r=0;r<16;++r){C0[r]-=dl;C1[r]-=dl;} \
        const float f=__builtin_amdgcn_exp2f(-dl); l_reg*=f; if(hi==0)wsf[r32]=f; resc=true; } } \
    SBAR(); \
    GAPB(o[0]=__builtin_amdgcn_mfma_f32_32x32x16_bf16(PAF(0),VFR(0),o[0],0,0,0), C0,0); \
    GAPB(o[1]=__builtin_amdgcn_mfma_f32_32x32x16_bf16(PAF(0),VFR(4),o[1],0,0,0), C0,4); \
    KRD(GL,0); GAPB(o[0]=__builtin_amdgcn_mfma_f32_32x32x16_bf16(PAF(1),VFR(1),o[0],0,0,0), C0,8); \
    KRD(GL,1); GAPB(o[1]=__builtin_amdgcn_mfma_f32_32x32x16_bf16(PAF(1),VFR(5),o[1],0,0,0), C0,12); \
    KRD(GL,2); GAPB(o[0]=__builtin_amdgcn_mfma_f32_32x32x16_bf16(PAF(2),VFR(2),o[0],0,0,0), C1,0); \
    KRD(GL,3); GAPB(o[1]=__builtin_amdgcn_mfma_f32_32x32x16_bf16(PAF(2),VFR(6),o[1],0,0,0), C1,4); \
    GAPB(o[0]=__builtin_amdgcn_mfma_f32_32x32x16_bf16(PAF(3),VFR(3),o[0],0,0,0), C1,8); \
    GAPB(o[1]=__builtin_amdgcn_mfma_f32_32x32x16_bf16(PAF(3),VFR(7),o[1],0,0,0), C1,12); \
    }while(0)
  int t=1;
  for(;t+5<NT;t+=2){
    STEP(pB0,pB1,pA0,pA1,t,true,true,true);     WAIT_BAR(2); RESC(); ROT();
    STEP(pA0,pA1,pB0,pB1,t+1,true,true,true);   WAIT_BAR(2); RESC(); ROT();
  }
  #define ENDW(tt) do{ if((tt)+3<NT){WAIT_BAR(2);} else if((tt)+2<NT){WAIT_BAR(1);} else {WAIT_BAR(0);} }while(0)
  for(;t+1<NT;t+=2){
    STEP(pB0,pB1,pA0,pA1,t,(t+3<NT),(t+1<NT),(t+1<NT));       ENDW(t);   RESC(); ROT();
    STEP(pA0,pA1,pB0,pB1,t+1,(t+4<NT),(t+2<NT),(t+2<NT));     ENDW(t+1); RESC(); ROT();
  }
  if(has_next){
    const int nRS=(nkind==2)?16:1, nrowbase=nb*SEQ+((nkind==2)?nqb:0), nT0=(nkind==1)?(nqb>2?4*nqb-8:0):0;
    const bf16*nks=K+(nrowbase+(int)nT0*KVBLK)*DM+nh*D+(int)lane*nRS*DM+wid*8;
    glds16(nks,(unsigned)__builtin_amdgcn_readfirstlane(kdst)); glds16(nks+(int)KVBLK*nRS*DM,(unsigned)__builtin_amdgcn_readfirstlane(kdst+SLOTB)); glds16(nks+(int)2*KVBLK*nRS*DM,(unsigned)__builtin_amdgcn_readfirstlane(kdst+2*SLOTB)); }
  STEP(pB0,pB1,pA0,pA1,NT-1,false,false,false); RESC();
  if(has_next){
    const int nRS=(nkind==2)?16:1, nrowbase=nb*SEQ+((nkind==2)?nqb:0), nq0=(nkind==2)?0:nqb*QB; const bf16*nQw=Q+(nrowbase+(int)(nq0+wid*QBLK)*nRS)*DM+nh*D;
    #pragma unroll
    for(int d0=0;d0<4;++d0)qr[d0]=*reinterpret_cast<const bf16x8*>(&nQw[(int)r32*nRS*DM+d0*16+hi*8]); }
  { float sacc=pB0[0]+pB0[1]; _Pragma("unroll") for(int r=2;r<16;++r)sacc+=pB0[r]; _Pragma("unroll") for(int r=0;r<16;++r)sacc+=pB1[r]; l_reg+=sacc;
    pw0=(u32x4){PKW(pB0,0),PKW(pB0,2),PKW(pB0,4),PKW(pB0,6)};pw1=(u32x4){PKW(pB0,8),PKW(pB0,10),PKW(pB0,12),PKW(pB0,14)};pw2=(u32x4){PKW(pB1,0),PKW(pB1,2),PKW(pB1,4),PKW(pB1,6)};pw3=(u32x4){PKW(pB1,8),PKW(pB1,10),PKW(pB1,12),PKW(pB1,14)};
    SBAR(); pv(o,vb0+sl_cur,PAF(0),PAF(1),PAF(2),PAF(3)); }
  #undef PKW
  #undef PAF
  #undef VFR
  #undef PIN
  #undef MX3
  #undef GAPA
  #undef GAPB
  #undef EX
  #undef VRD
  #undef KRD
  #undef STEP
  #undef ENDW
  {auto rr=__builtin_amdgcn_permlane32_swap(__float_as_uint(l_reg),__float_as_uint(l_reg),false,false);l_reg=__uint_as_float(rr[0])+__uint_as_float(rr[1]);}
  int lane_e=lane; asm volatile("":"+v"(lane_e));
  u32x4 fch[4];
  if(DIL){
    const unsigned short*fp=faro+(unsigned)(rowbase+q0+wid*QBLK+(lane_e>>3))*512+(h-8)*D+(lane_e&7)*8;
    #pragma unroll
    for(int i=0;i<4;++i)fch[i]=*(const u32x4*)(fp+(unsigned)i*8*512);
    const int p_=q0+wid*QBLK+(lane_e&31); const float*lp=farl+((unsigned)(((b*8+(h-8))*16+(p_&15))*256+(p_>>4)))*2; const float lf_=lp[0],mf_=lp[1];
    const float M_=__builtin_fmaxf(mhat,mf_),sa_=__builtin_amdgcn_exp2f(mhat-M_),sb_=__builtin_amdgcn_exp2f(mf_-M_),rl_=__builtin_amdgcn_rcpf(l_reg*sa_+lf_*sb_);
    if(hi==0){wsf[32+r32]=sa_*rl_;wsf[r32]=sb_*rl_;} }
  else if(hi==0)wsf[32+r32]=FAR?1.f:__builtin_amdgcn_rcpf(l_reg);
  asm volatile("s_waitcnt lgkmcnt(0)":::"memory");
  float rli[16];
  #pragma unroll
  for(int r=0;r<16;++r)rli[r]=wsf[32+crow(r,hi)];
  constexpr int OP=FAR?512:DM;
  bf16*Ow=(bf16*)faro+(rowbase+(int)wid*QBLK*RS)*OP+(h-8)*D;
  unsigned char*O8w=O8+(rowbase+q0+wid*QBLK)*DM+h*D;
  if(FAR&&hi==0){ float*lp=farl+((unsigned)(((b*8+(h-8))*16+qb)*256+qrel))*2; __hip_atomic_store((unsigned long long*)lp,((unsigned long long)__float_as_uint(mhat)<<32)|__float_as_uint(l_reg),__ATOMIC_RELAXED,__HIP_MEMORY_SCOPE_AGENT); }
  { bf16*stg=(bf16*)(shm+LDS_OST)+wid*2048;
    #pragma unroll
    for(int r=0;r<16;++r){const int orow=crow(r,hi);
      #pragma unroll
      for(int d0=0;d0<2;++d0)stg[orow*64+d0*32+r32]=__float2bfloat16(o[d0][r]*rli[r]);}
    asm volatile("s_waitcnt lgkmcnt(0)":::"memory");
    #pragma unroll
    for(int i=0;i<4;++i){const int row=i*8+(lane_e>>3),ch=lane_e&7; u32x4 v=*(const u32x4*)(stg+row*64+ch*8);
      if(DIL){ const float fb_=wsf[row];
        #pragma unroll
        for(int j=0;j<4;++j){ const float a_=__uint_as_float(v[j]<<16)+__uint_as_float(fch[i][j]<<16)*fb_, b_=__uint_as_float(v[j]&0xffff0000u)+__uint_as_float(fch[i][j]&0xffff0000u)*fb_; v[j]=cvtpk_s(a_,b_); } }
      if(FAR){ ATTN_STORE16(Ow+(int)row*RS*OP+ch*8,v); }
      else { unsigned w0_=0,w1_=0;
        w0_=__builtin_amdgcn_cvt_pk_fp8_f32(__uint_as_float(v[0]<<16)*64.f,__uint_as_float(v[0]&0xffff0000u)*64.f,w0_,false); w0_=__builtin_amdgcn_cvt_pk_fp8_f32(__uint_as_float(v[1]<<16)*64.f,__uint_as_float(v[1]&0xffff0000u)*64.f,w0_,true);
        w1_=__builtin_amdgcn_cvt_pk_fp8_f32(__uint_as_float(v[2]<<16)*64.f,__uint_as_float(v[2]&0xffff0000u)*64.f,w1_,false); w1_=__builtin_amdgcn_cvt_pk_fp8_f32(__uint_as_float(v[3]<<16)*64.f,__uint_as_float(v[3]&0xffff0000u)*64.f,w1_,true);
        *(unsigned long long*)(O8w+(int)row*DM+ch*8)=((unsigned long long)w1_<<32)|w0_; }
      float sq=0.f;
      #pragma unroll
      for(int j=0;j<4;++j){ const float a_=__uint_as_float(v[j]<<16), b_=__uint_as_float(v[j]&0xffff0000u); sq+=a_*a_+b_*b_; }
      sq+=__shfl_xor(sq,1); sq+=__shfl_xor(sq,2); sq+=__shfl_xor(sq,4);
      if(!FAR&&ch==0)ssq[(unsigned)(rowbase+q0+wid*QBLK+row)*16+h]=sq; } }
  asm volatile("s_waitcnt lgkmcnt(0)\n\ts_barrier":::"memory");
  #undef DMA_K
  #undef DMA_V
  #undef CMASK
  #undef START
  #undef RESC
  #undef ROT
}
constexpr int ATTN_LDS_BYTES=LDS_BYTES;
__device__ __forceinline__ void attn_tables(char*lds,int wave){
  float*tb=(float*)(lds+LDS_TAB);
  for(int e=wave*64+mk_lane();e<64*16;e+=512){ const int ln=e>>4,r=e&15,r32=ln&31,hi=ln>>5; const int z4=r32&3,z16=((r32&15)-4*hi)&15;
    const bool in4=(z4==(r&3)),in16=(z16==((r&3)+8*((r>>2)&1)));
    tb[e]=-1e30f; tb[1024+e]=in16?1.5849625007f:(in4?1.f:0.f); tb[2048+e]=in16?1.f:(in4?0.f:-1e30f); tb[3072+e]=in16?(1.f-1.5849625007f):(in4?-1.f:-1e30f); }
  __syncthreads();
}
template<int THRL=8> __device__ __forceinline__ void attn_phase(char*lds,unsigned char*ws,unsigned*cnt,int vcu,int G,int wave){
  const int g=vcu>>2,b=g>>3,hm=g&7,c=vcu&3;
  attn_tables(lds,wave);
  bf16x8 qr[4];
  { const int nf_=(c==0)?6:((c==1)?4:3), cb_=(c==0)?0:((c==1)?6:((c==2)?10:13)); const int n_=(MK_REPEAT_PHASE==22?2*nf_:nf_); for(int i=0;i<n_;++i) attn_unit<THRL,2>(b,8+hm,cb_+(i%nf_),ws,lds,wave,qr,i>0,true,(i+1<n_)?2:0,b,(i+1<n_)?8+hm:hm,(i+1<n_)?cb_+((i+1)%nf_):15-c); }
  asm volatile("s_waitcnt vmcnt(0)":::"memory"); __syncthreads();
  if(wave==0&&mk_lane()==0) __hip_atomic_fetch_add(cnt,1u,__ATOMIC_RELAXED,__HIP_MEMORY_SCOPE_AGENT);
  #define QBSEL(i_) ((((i_)&3)==0)?15-c:((((i_)&3)==1)?8+c:((((i_)&3)==2)?7-c:c)))
  { const int n_=(MK_REPEAT_PHASE==20?8:4); for(int ii=0;ii<n_;++ii) attn_unit<THRL,0>(b,hm,QBSEL(ii),ws,lds,wave,qr,true,true,(ii+1<n_)?0:1,b,(ii+1<n_)?hm:8+hm,QBSEL(ii+1)); }
  if(wave==0&&mk_lane()==0){ unsigned sp=0; while(__hip_atomic_load(cnt,__ATOMIC_RELAXED,__HIP_MEMORY_SCOPE_AGENT)<(unsigned)G){ __builtin_amdgcn_s_sleep(2); if(++sp>(1u<<22))break; }
    __builtin_amdgcn_fence(__ATOMIC_ACQUIRE,"agent"); asm volatile("s_waitcnt vmcnt(0)":::"memory"); }
  __syncthreads();
  { const int n_=(MK_REPEAT_PHASE==21?8:4); for(int ii=0;ii<n_;++ii) attn_unit<THRL,1>(b,8+hm,QBSEL(ii),ws,lds,wave,qr,true,ii+1<n_,1,b,8+hm,QBSEL(ii+1)); }
  #undef QBSEL
}
#undef SBAR
#undef WAIT_BAR
}

struct Frame {
    LAS unsigned char* lds;
    volatile LAS unsigned* MISC;
    gu32* ctl;
    int wave;
    int vcu, G;
    const float *x, *attn_norm, *w_in, *moba_norm, *dil_norm, *w_out, *ffn_norm, *w_gate, *w_up, *w_down, *final_norm;
    float* out;
    bf16 *Wqkv_t, *Wo_t, *Wgu_t, *Wd_t;
    bf16 *QO, *KB, *VB, *XN, *OB; unsigned char *HB, *XN8;
    float *rope, *kpart, *ssqa, *ssq1, *ssq2;
};

__device__ __forceinline__ float wave_sum(float v) {
#pragma unroll
    for (int o = 1; o < 64; o <<= 1) v += __shfl_xor(v, o);
    return v;
}
__device__ __forceinline__ int qkv_vrow(int n) { const int part = n >> 10, head = (n >> 6) & 15, d = n & 63; return 256 * (part * 4 + (head >> 2)) + 128 * (d >> 5) + 32 * (head & 3) + (d & 31); }
template <int MODE>
__device__ __forceinline__ void p0_item(const float* W, int K, int N, bf16* WT, const float* g0, const float* g1, LAS float* scr, int item, int lane) {
    const int nblk = N / 32, kb = item / nblk, nb = item % nblk, k0 = 64 * kb, n0 = 32 * nb;
#pragma unroll 8
    for (int i = 0; i < 32; ++i) { const int kk = 2 * i + (lane >> 5), k = k0 + kk; float w = __builtin_nontemporal_load(W + (size_t)k * N + n0 + (lane & 31));
        if (MODE == 1) w *= (k < 512 ? g0[k] : g1[k - 512]);
        if (MODE == 2 || MODE == 3) w *= g0[k];
        scr[kk * 33 + (lane & 31)] = w; }
    LDS_WAIT(); asm volatile("" ::: "memory");
    const int c = lane & 7;
#pragma unroll
    for (int j = 0; j < 4; ++j) { const int n = (lane >> 3) + 8 * j; const LAS float* s = scr + (8 * c) * 33 + n;
        const int ns = n0 + n; int dr;
        if (MODE == 0) dr = qkv_vrow(ns); else if (MODE == 2) dr = 256 * (ns >> 7) + (ns & 127); else if (MODE == 3) dr = 256 * (ns >> 7) + 128 + (ns & 127); else dr = ns;
        bool f8 = MODE >= 1; size_t base8 = 0;
        if (MODE == 0) {
            const int pn = dr >> 8, lo = dr & 255; f8 = !(pn < 8 && (pn & 3) < 2);
            dr = (f8 ? (pn < 8 ? ((pn & 1) + 2 * (pn >> 2)) : pn - 4) : ((pn & 1) + 2 * (pn >> 2))) * 256 + lo; base8 = (size_t)QKV8_OFF; }
        if (f8) {
            const pg8::f32x4 a = {s[0 * 33], s[1 * 33], s[2 * 33], s[3 * 33]}, b = {s[4 * 33], s[5 * 33], s[6 * 33], s[7 * 33]};
            *(GAS pg8::u32x2*)((unsigned char*)WT + base8 + (size_t)dr * K + k0 + 8 * c) = pg8::pack8_fp8(a * pg8::F8_SW, b * pg8::F8_SW);
        } else {
            v4u o; o.x = pk2(s[0 * 33], s[1 * 33]); o.y = pk2(s[2 * 33], s[3 * 33]); o.z = pk2(s[4 * 33], s[5 * 33]); o.w = pk2(s[6 * 33], s[7 * 33]);
            *(GAS v4u*)(WT + (size_t)dr * K + k0 + 8 * c) = o; } }
    LDS_WAIT(); asm volatile("" ::: "memory");
}
template <int R>
__device__ __forceinline__ void rms_rows_to_bf16(Frame& F, const float* xrow, const float* gain, bf16* orow, unsigned char* orow8, float* rn) {
    const GAS f32x4* xr = (const GAS f32x4*)xrow + mk_lane(); const GAS f32x4* gr = (const GAS f32x4*)gain + mk_lane();
    f32x4 v[R][4]; float s[R];
#pragma unroll
    for (int r = 0; r < R; ++r)
#pragma unroll
        for (int j = 0; j < 4; ++j) v[r][j] = __builtin_nontemporal_load(xr + r * 256 + 64 * j);
#pragma unroll
    for (int r = 0; r < R; ++r) { s[r] = 0.f;
#pragma unroll
        for (int j = 0; j < 4; ++j) s[r] += (v[r][j].x * v[r][j].x + v[r][j].y * v[r][j].y) + (v[r][j].z * v[r][j].z + v[r][j].w * v[r][j].w); }
#pragma unroll
    for (int o = 1; o < 64; o <<= 1)
#pragma unroll
        for (int r = 0; r < R; ++r) s[r] += __shfl_xor(s[r], o);
    const int ln_ = mk_lane(); GAS unsigned long long* o8 = (GAS unsigned long long*)orow + ln_; GAS unsigned* q8 = (GAS unsigned*)orow8 + ln_;
#pragma unroll
    for (int r = 0; r < R; ++r) { const float rms = sqrtf(s[r] * (1.f / D) + RMS_EPS), rstd = 1.f / rms; if (ln_ == 0) rn[r] = rms;
#pragma unroll
        for (int j = 0; j < 4; ++j) { const f32x4 g = gr[64 * j];
            const f32x4 y = v[r][j] * rstd * g;
            o8[r * 256 + 64 * j] = (unsigned long long)pk2(y.x, y.y) | ((unsigned long long)pk2(y.z, y.w) << 32);
            unsigned t = 0; t = __builtin_amdgcn_cvt_pk_fp8_f32(y.x * pg8::F8_SA, y.y * pg8::F8_SA, t, false); t = __builtin_amdgcn_cvt_pk_fp8_f32(y.z * pg8::F8_SA, y.w * pg8::F8_SA, t, true); q8[r * 256 + 64 * j] = t; } }
}
__device__ __forceinline__ void p0_prologue(Frame& F) {
    LAS float* scr = (LAS float*)(F.lds + RING_OFF + F.wave * 16384);
    const int gw = F.vcu * NWAVES + F.wave, NGW = F.G * NWAVES;
    constexpr int I_IN = (D / 64) * (NQKV / 32), I_O = (D / 64) * (D / 32), I_G = (D / 64) * (FF / 32), I_D = (FF / 64) * (D / 32);
    constexpr int NITEMS = I_IN + I_O + 2 * I_G + I_D;
    for (int it = gw; it < NITEMS; it += NGW) {
        int r = it;
        if (r < I_IN) { p0_item<0>(F.w_in, D, NQKV, F.Wqkv_t, nullptr, nullptr, scr, r, mk_lane()); continue; } r -= I_IN;
        if (r < I_O) { p0_item<1>(F.w_out, D, D, F.Wo_t, F.moba_norm, F.dil_norm, scr, r, mk_lane()); continue; } r -= I_O;
        if (r < I_G) { p0_item<2>(F.w_gate, D, FF, F.Wgu_t, F.ffn_norm, nullptr, scr, r, mk_lane()); continue; } r -= I_G;
        if (r < I_G) { p0_item<3>(F.w_up, D, FF, F.Wgu_t, F.ffn_norm, nullptr, scr, r, mk_lane()); continue; } r -= I_G;
        p0_item<4>(F.w_down, FF, D, F.Wd_t, nullptr, nullptr, scr, r, mk_lane());
    }
    for (int e = (F.vcu * NWAVES * 64) + F.wave * 64 + mk_lane(); e < SEQ * 32; e += F.G * NWAVES * 64) {
        const int s = e >> 5, j = e & 31;
        const float invf = __builtin_amdgcn_exp2f(-(float)j * (13.287712379549449f / 32.0f));
        double rev = (double)s * (double)invf * 0.15915494309189535; rev -= __builtin_floor(rev);
        const float r = (float)rev;
        pg8::f32x2 cs; cs.x = __builtin_amdgcn_cosf(r); cs.y = __builtin_amdgcn_sinf(r);
        *(GAS pg8::f32x2*)((pg8::f32x2*)F.rope + e) = cs;
    }
    for (int m = 4 * gw; m < M; m += 4 * NGW) rms_rows_to_bf16<4>(F, F.x + (size_t)m * D, F.attn_norm, F.XN + (size_t)m * D, F.XN8 + (size_t)m * D, (float*)(F.kpart + 131072) + m);
}

__device__ __forceinline__ void p6_final(Frame& F) {
    const int gw = F.vcu * NWAVES + F.wave, NGW = F.G * NWAVES;
    const GAS f32x4* gr = (const GAS f32x4*)F.final_norm + mk_lane();
    for (int m = gw; m < M; m += NGW) {
        GAS f32x4* xr = (GAS f32x4*)(F.out + (size_t)m * D) + mk_lane();
        const GAS f32x4* sp = (const GAS f32x4*)(F.ssq2 + (size_t)m * 16);
        const f32x4 a = sp[0], b = sp[1], c = sp[2], d = sp[3];
        const float ss = ((a.x + a.y) + (a.z + a.w)) + ((b.x + b.y) + (b.z + b.w)) + ((c.x + c.y) + (c.z + c.w)) + ((d.x + d.y) + (d.z + d.w));
        const float rstd = 1.f / sqrtf(ss * (1.f / D) + RMS_EPS);
#pragma unroll
        for (int j = 0; j < 4; ++j) { const f32x4 v = xr[64 * j], g = gr[64 * j]; xr[64 * j] = v * rstd * g; }
    }
}

struct Args { const float* in[11]; float* out; unsigned char* ws; int ph_lo, ph_hi, li, pad; };
__global__ void __launch_bounds__(NWAVES * 64, 2) mk_fwd(Args args) {
    extern __shared__ __attribute__((aligned(16))) unsigned char lds[];
    Frame F;
    F.lds = (LAS unsigned char*)lds;
    F.MISC = (volatile LAS unsigned*)(F.lds + MISC_OFF);
    F.wave = __builtin_amdgcn_readfirstlane((int)(threadIdx.x >> 6));
    F.G = gridDim.x; { const int bx = blockIdx.x; F.vcu = (F.G % 8 == 0) ? (bx % 8) * (F.G / 8) + bx / 8 : bx; }
#define GRID_BAR(seam) do { if (N_LAUNCHES == PER_PHASE) { if ((F.wave == 0 && mk_lane() == 0)) __hip_atomic_store(F.ctl + CW_TMO, 0xBADBA0u | (unsigned)(seam), RLX_AGENT); } \
    else { xcd_barrier(bar, F.wave); if (MK_REPEAT_PHASE == 30) xcd_barrier(bar, F.wave); } } while (0)
    unsigned char* ws = args.ws;
    F.ctl = (gu32*)(ws + WS_CTL);
    F.x = args.in[0]; F.attn_norm = args.in[1]; F.w_in = args.in[2]; F.moba_norm = args.in[3]; F.dil_norm = args.in[4]; F.w_out = args.in[5];
    F.ffn_norm = args.in[6]; F.w_gate = args.in[7]; F.w_up = args.in[8]; F.w_down = args.in[9]; F.final_norm = args.in[10]; F.out = args.out;
    F.Wqkv_t = (bf16*)(ws + WS_WQKV); F.Wo_t = (bf16*)(ws + WS_WO); F.Wgu_t = (bf16*)(ws + WS_WGU); F.Wd_t = (bf16*)(ws + WS_WD);
    F.QO = (bf16*)(ws + WS_QO); F.KB = (bf16*)(ws + WS_K); F.VB = (bf16*)(ws + WS_V); F.HB = ws + WS_H; F.XN8 = ws + WS_XN8; F.XN = (bf16*)(ws + WS_XN); F.OB = (bf16*)(ws + WS_O);
    F.rope = (float*)(ws + WS_ROPE); F.kpart = (float*)(ws + WS_KPART); F.ssqa = (float*)(ws + WS_SSQA); F.ssq1 = (float*)(ws + WS_SSQ1); F.ssq2 = (float*)(ws + WS_SSQ2);
    for (int u = F.wave * 64 + mk_lane(); u < (LDS_BYTES - LDSCTL_OFF) / 4; u += NWAVES * 64) ((LAS unsigned*)(F.lds + LDSCTL_OFF))[u] = 0u;
    __syncthreads();
    XcdBarrier bar; bar.bar = (unsigned*)(F.ctl + CW_BAR); bar.x = 0; bar.st = nullptr;
    if (N_LAUNCHES != PER_PHASE) bar = xcd_barrier_post((unsigned*)(F.ctl + CW_BAR), F.MISC + 8, F.wave);
    const int lo = args.ph_lo, hi = args.ph_hi;
#define IN(k) (lo <= (k) && (k) < hi)
#define BOTH(k) (IN(k) && IN((k) + 1))

    if (IN(0)) { for (int rp = 0; rp < (MK_REPEAT_PHASE == 0 ? 2 : 1); ++rp) p0_prologue(F); if (BOTH(0)) GRID_BAR(0); }

    if (IN(1)) {
        if (MK_STAG1 > 0 && ((blockIdx.x >> 3) & 1)) { for (int i = 0; i < MK_STAG1; ++i) __builtin_amdgcn_s_sleep(127); }
        { pg8::Gemm g{F.XN, F.Wqkv_t, M, 1024, D}; pg8::StaticOrder S; S.init(M, 1024, F.G, (int)blockIdx.x, MK_REPEAT_PHASE == 1 ? 2 : 1);
          pg8::EpiQKV E{F.QO, (size_t)(WS_K - WS_QO) / 2, F.rope, F.kpart, QSCALE, 1, 1.f};
          pg8::gemm_phase<pg8::EpiQKV, pg8::StaticOrder, true, true>(F.lds + RING_OFF, g, S, E, F.wave); }
        { pg8::Gemm g{(const bf16*)F.XN8, (const bf16*)((const unsigned char*)F.Wqkv_t + QKV8_OFF), M, 2048, D}; pg8::StaticOrder S; S.init(M, 2048, F.G, (int)blockIdx.x, MK_REPEAT_PHASE == 1 ? 2 : 1);
          pg8::EpiQKV E{F.QO, (size_t)(WS_K - WS_QO) / 2, F.rope, F.kpart, QSCALE, 2, 1.f / (pg8::F8_SA * pg8::F8_SW)};
          pg8::gemm_phase<pg8::EpiQKV, pg8::StaticOrder, true, true, true>(F.lds + RING_OFF, g, S, E, F.wave); }
        if (BOTH(1)) GRID_BAR(1);
    }

    if (IN(2)) {
        if (F.G == 256) {
            for (int rp = 0; rp < (MK_REPEAT_PHASE == 2 ? 2 : 1); ++rp) attn_body::attn_phase<8>((char*)lds + RING_OFF, ws, (unsigned*)(F.ctl + CW_FAR), F.vcu, F.G, F.wave);
        }
        if (BOTH(2)) GRID_BAR(2);
    }

    if (IN(3)) {
        pg8::Gemm g{(const bf16*)(ws + WS_O8), F.Wo_t, M, D, D};   pg8::StaticOrder S; S.init(M, D, F.G, (int)blockIdx.x, MK_REPEAT_PHASE == 3 ? 2 : 1);
        pg8::EpiWo E{F.kpart + 131072, F.attn_norm, F.XN, (MK_REPEAT_PHASE == 3) ? (bf16*)(ws + 394 * MiB) : F.XN, (MK_REPEAT_PHASE == 3) ? ws + 458 * MiB : F.XN8, F.ssqa, F.ssq1};
        pg8::gemm_phase<pg8::EpiWo, pg8::StaticOrder, true, true, true>(F.lds + RING_OFF, g, S, E, F.wave);
        if (BOTH(3)) GRID_BAR(3);
    }

    if (IN(4)) {
        pg8::Gemm g{(const bf16*)((MK_REPEAT_PHASE == 3) ? ws + 458 * MiB : F.XN8), F.Wgu_t, M, NGU, D}; pg8::StaticOrder S; S.init(M, NGU, F.G, (int)blockIdx.x, MK_REPEAT_PHASE == 4 ? 2 : 1);
        pg8::EpiGU E{F.ssq1, F.HB};
        if (MK_REPEAT_PHASE == 40) { S.r1 = 6; pg8::gemm_phase<pg8::EpiGU, pg8::StaticOrder, true, true, true>(F.lds + RING_OFF, g, S, E, F.wave); GRID_BAR(9); S.r0 = 6; S.r1 = 1 << 30; }
        pg8::gemm_phase<pg8::EpiGU, pg8::StaticOrder, true, true, true>(F.lds + RING_OFF, g, S, E, F.wave);
        if (BOTH(4)) GRID_BAR(4);
    }

    if (IN(5)) {
        if (MK_STAG5 > 0 && ((blockIdx.x >> 3) & 1)) { for (int i = 0; i < MK_STAG5; ++i) __builtin_amdgcn_s_sleep(127); }
        pg8::Gemm g{(const bf16*)F.HB, F.Wd_t, M, D, FF};   pg8::StaticOrder S; S.init(M, D, F.G, (int)blockIdx.x, MK_REPEAT_PHASE == 5 ? 2 : 1);
#if defined(MK_SPLIT_FINAL)
        pg8::EpiDown E{F.XN, F.out, F.ssq2};
        pg8::gemm_phase<pg8::EpiDown, pg8::StaticOrder, true, true, true>(F.lds + RING_OFF, g, S, E, F.wave);
        if (BOTH(5)) GRID_BAR(5);
#else
        if (F.G == 256) { pg8::EpiDownNorm E{(MK_REPEAT_PHASE == 3) ? (bf16*)(ws + 394 * MiB) : F.XN, F.out, F.ssq2, (unsigned*)(F.ctl + CW_PANEL), F.final_norm};
            pg8::gemm_phase<pg8::EpiDownNorm, pg8::StaticOrder, true, true, true>(F.lds + RING_OFF, g, S, E, F.wave); }
        else { pg8::EpiDown E{F.XN, F.out, F.ssq2}; pg8::gemm_phase<pg8::EpiDown, pg8::StaticOrder, true, true, true>(F.lds + RING_OFF, g, S, E, F.wave); GRID_BAR(5); p6_final(F); }
#endif
    }

#if defined(MK_SPLIT_FINAL)
    if (IN(6)) { p6_final(F); }
#endif
#undef IN
#undef BOTH
}

extern "C" void kernel_launch(void* const* d_in, const int* in_sizes, int n_in, void* d_out, int out_size, void* d_ws, size_t ws_size, hipStream_t stream) {
    static int grid = 0;
    if (grid == 0) {
        if (n_in != 11 || in_sizes[0] != M * D || out_size != M * D || ws_size < WS_END) { fprintf(stderr, "kernel_launch: unexpected shapes (n_in %d, in0 %d, out %d, ws %zu); nothing launched\n", n_in, n_in > 0 ? in_sizes[0] : -1, out_size, ws_size); grid = -1; return; }
        int dev = 0, cus = 0, per_cu = 0;
        if (hipGetDevice(&dev) != hipSuccess || hipDeviceGetAttribute(&cus, hipDeviceAttributeMultiprocessorCount, dev) != hipSuccess) { grid = -1; return; }
        if (hipFuncSetAttribute((const void*)mk_fwd, hipFuncAttributeMaxDynamicSharedMemorySize, LDS_BYTES) != hipSuccess) { fprintf(stderr, "kernel_launch: hipFuncSetAttribute failed\n"); grid = -1; return; }
        if (hipOccupancyMaxActiveBlocksPerMultiprocessor(&per_cu, (const void*)mk_fwd, NWAVES * 64, LDS_BYTES) != hipSuccess || per_cu < 1) { fprintf(stderr, "kernel_launch: occupancy query says %d blocks per CU\n", per_cu); (void)hipGetLastError(); per_cu = 1; }
        grid = cus;
        if (grid > 256) grid = 256;
    }
    if (grid < 0) return;
    if (hipMemsetAsync((char*)d_ws + WS_CTL, 0, CTL_ZERO_BYTES, stream) != hipSuccess) { fprintf(stderr, "kernel_launch: hipMemsetAsync failed\n"); return; }
    Args a{};
    for (int i = 0; i < 11; ++i) a.in[i] = (const float*)d_in[i];
    a.out = (float*)d_out; a.ws = (unsigned char*)d_ws;
    for (int li = 0; li < N_LAUNCHES; ++li) {
        a.ph_lo = (N_LAUNCHES == PER_PHASE) ? li : 0; a.ph_hi = (N_LAUNCHES == PER_PHASE) ? li + 1 : PER_PHASE; a.li = li;
        hipLaunchKernelGGL(mk_fwd, dim3(grid), dim3(NWAVES * 64), LDS_BYTES, stream, a);
        const hipError_t le = hipPeekAtLastError();
        if (le != hipSuccess) { fprintf(stderr, "kernel_launch: launch %d failed: %s\n", li, hipGetErrorName(le)); break; }
    }
}
```

```cpp
#include <hip/hip_runtime.h>
#include <cstdio>
#include <cstdint>
namespace pg8 {
#define PG8_LAS __attribute__((address_space(3)))
typedef unsigned short bf16_t;
typedef short bf16x8 __attribute__((ext_vector_type(8)));
typedef float f32x4 __attribute__((ext_vector_type(4)));
typedef unsigned u32x4 __attribute__((ext_vector_type(4)));
typedef int i32x4 __attribute__((ext_vector_type(4)));
typedef int i32x8 __attribute__((ext_vector_type(8)));
typedef unsigned u32x2 __attribute__((ext_vector_type(2)));
constexpr int BM = 256, BK = 64, HALF = 128, HTB = HALF * BK * 2  , STAGE_BYTES = 8 * HTB, NXCD = 8, WGM = 8;

__host__ __device__ __forceinline__ int lds_byte(int r, int c) { const int st = (r >> 4) * 2 + (c >> 5), rr = r & 15, cc = c & 31, ob = rr * 64 + cc * 2; return st * 1024 + (ob ^ (((ob >> 9) & 1) << 5)); }
__host__ __device__ __forceinline__ void stage_rc(int b, int& R, int& C) { const int st = b / 1024, sb = b % 1024, swz = sb ^ (((sb >> 9) & 1) << 5); R = (st >> 1) * 16 + swz / 64; C = (st & 1) * 32 + (swz % 64) / 2; }
__host__ __device__ __forceinline__ int perm32(int rho) { const int n = rho >> 4, i = rho & 15; return 8 * (i >> 2) + 4 * n + (i & 3); }

struct Unit { int pm, pn; };
struct Gemm { const bf16_t* A; const bf16_t* Bt; int M, N, K; };

struct StaticOrder {
    int nM, nN, nwg, G, c, reps, r0 = 0, r1 = 1 << 30;
    __host__ __device__ void init(int M, int N, int G_, int c_, int reps_ = 1) { nM = M / BM; nN = N / BM; nwg = nM * nN; G = G_; c = c_; reps = reps_; }
    __host__ __device__ bool next(int i, Unit& u) const {
        const int rounds = (nwg + G - 1) / G; i += r0; if (i >= reps * rounds || i >= r1) return false;
        const long L = (long)(i % rounds) * G + c; if (L >= nwg) return false;
        int wgid = (int)L; { const int q = nwg / NXCD, r = nwg % NXCD, xcd = wgid % NXCD, off = wgid / NXCD; wgid = (xcd < r ? xcd * (q + 1) : r * (q + 1) + (xcd - r) * q) + off; }
        const int nig = WGM * nN, gid = wgid / nig, fm = gid * WGM, gsz = (nM - fm) < WGM ? (nM - fm) : WGM;
        u.pm = fm + ((wgid % nig) % gsz); u.pn = (wgid % nig) / gsz; return true;
    }
    __device__ __forceinline__ void a_ready(const Unit&) const {}
    __device__ __forceinline__ void done(const Unit&) const {}
};


__device__ __forceinline__ unsigned cvt_pk_bf16(float lo, float hi) { unsigned r; asm volatile("v_cvt_pk_bf16_f32 %0, %1, %2" : "=v"(r) : "v"(lo), "v"(hi)); return r; }
__device__ __forceinline__ u32x4 pack8(const f32x4 a, const f32x4 b) { u32x4 w; w.x = cvt_pk_bf16(a[0], a[1]); w.y = cvt_pk_bf16(a[2], a[3]); w.z = cvt_pk_bf16(b[0], b[1]); w.w = cvt_pk_bf16(b[2], b[3]); return w; }
__device__ __forceinline__ float sum4(const f32x4 a) { return (a[0] + a[1]) + (a[2] + a[3]); }
__device__ __forceinline__ float sq4(const f32x4 a) { return (a[0] * a[0] + a[1] * a[1]) + (a[2] * a[2] + a[3] * a[3]); }
constexpr float RMS_EPS_F = 1e-6f;
__device__ __forceinline__ int lane_id() { int l; asm volatile("v_mbcnt_lo_u32_b32 %0, -1, 0\n\tv_mbcnt_hi_u32_b32 %0, -1, %0" : "=v"(l)); return l; }
__device__ __forceinline__ u32x2 pack8_fp8(const f32x4 a, const f32x4 b) { u32x2 w; unsigned t = 0;
    t = __builtin_amdgcn_cvt_pk_fp8_f32(a[0], a[1], t, false); t = __builtin_amdgcn_cvt_pk_fp8_f32(a[2], a[3], t, true); w.x = t; t = 0;
    t = __builtin_amdgcn_cvt_pk_fp8_f32(b[0], b[1], t, false); t = __builtin_amdgcn_cvt_pk_fp8_f32(b[2], b[3], t, true); w.y = t; return w; }
constexpr float F8_SA = 16.f, F8_SH = 8.f, F8_SW = 512.f, F8_SO = 64.f;
typedef float f32x2 __attribute__((ext_vector_type(2)));

struct EpiQKV {
    static constexpr bool PERM = true, AFTER_DRAIN = false, HAS_MID = false;
    bf16_t* Q; size_t part_stride; const float* rope; float* kpart; float qscale; int mapsel; float ascale;
    __device__ __forceinline__ void operator()(const f32x4 (&acc)[2][2][4][2], const Unit& u, int wr, int wc, int fr_, int fq_) const {
        const int ln_ = lane_id(), fr = ln_ & 15, fq = ln_ >> 4;
        const int rp = mapsel == 1 ? ((u.pn & 1) + 4 * (u.pn >> 1)) : (mapsel == 2 ? (u.pn < 4 ? (2 + (u.pn & 1) + 4 * (u.pn >> 1)) : u.pn + 4) : u.pn);
        const int part = rp >> 2, head = (rp & 3) * 4 + wc;
        bf16_t* base = Q + (size_t)part * part_stride + head * 64 + 8 * fq;
        const float sc = part == 0 ? qscale : 1.f;
        const bool rot = part != 2, km = (part == 1) && (head < 8);
        const int row0 = u.pm * BM + wr * 64 + fr;
        int rbase = row0; asm volatile("" : "+v"(rbase));
        f32x4 T[2][4], S16[4];
#pragma unroll
        for (int q = 0; q < 4; ++q) { T[0][q] = T[1][q] = S16[q] = (f32x4){1.f, 0.f, 1.f, 0.f}; }
        if (rot) {
            const f32x4* r16 = (const f32x4*)(rope + ((size_t)16 * 32 + 8 * fq) * 2);
            const f32x4* ra = (const f32x4*)(rope + ((size_t)(rbase & 4095) * 32 + 8 * fq) * 2);
            const f32x4* rb = (const f32x4*)(rope + ((size_t)((rbase + HALF) & 4095) * 32 + 8 * fq) * 2);
#pragma unroll
            for (int q = 0; q < 4; ++q) { T[0][q] = ra[q]; T[1][q] = rb[q]; S16[q] = r16[q]; }
        }
        f32x4 ks[2][2];
#pragma unroll
        for (int a = 0; a < 2; ++a)
#pragma unroll
            for (int b = 0; b < 2; ++b) ks[a][b] = (f32x4){0.f, 0.f, 0.f, 0.f};
#pragma unroll
        for (int ai = 0; ai < 2; ++ai)
#pragma unroll
            for (int m = 0; m < 4; ++m) {
                const int row = rbase + ai * HALF + m * 16;
                if (m > 0 && rot) {
#pragma unroll
                    for (int q = 0; q < 4; ++q) { const f32x4 t = T[ai][q], st = S16[q];
                        T[ai][q] = (f32x4){t[0] * st[0] - t[1] * st[1], t[1] * st[0] + t[0] * st[1], t[2] * st[2] - t[3] * st[3], t[3] * st[2] + t[2] * st[3]}; }
                }
                const f32x4 t0 = T[ai][0], t1 = T[ai][1], t2 = T[ai][2], t3 = T[ai][3];
                f32x4 o1[2], o2[2];
#pragma unroll
                for (int n = 0; n < 2; ++n) {
                    const f32x4 cv = n == 0 ? (f32x4){t0[0], t0[2], t1[0], t1[2]} : (f32x4){t2[0], t2[2], t3[0], t3[2]};
                    const f32x4 sv = n == 0 ? (f32x4){t0[1], t0[3], t1[1], t1[3]} : (f32x4){t2[1], t2[3], t3[1], t3[3]};
                    const f32x4 x1 = acc[ai][0][m][n] * ascale, x2 = acc[ai][1][m][n] * ascale;
                    o1[n] = x1 * cv - x2 * sv; o2[n] = x2 * cv + x1 * sv;
                    if (km) { ks[0][n] += o1[n]; ks[1][n] += o2[n]; }
                    o1[n] = o1[n] * sc; o2[n] = o2[n] * sc;
                }
                bf16_t* rowp = base + (size_t)row * 1024;
                *(u32x4*)(rowp) = pack8(o1[0], o1[1]); *(u32x4*)(rowp + 32) = pack8(o2[0], o2[1]);
            }
        if (km) {
#pragma unroll
            for (int bj = 0; bj < 2; ++bj)
#pragma unroll
                for (int n = 0; n < 2; ++n) { f32x4 v = ks[bj][n];
#pragma unroll
                    for (int o = 1; o < 16; o <<= 1) { v[0] += __shfl_xor(v[0], o); v[1] += __shfl_xor(v[1], o); v[2] += __shfl_xor(v[2], o); v[3] += __shfl_xor(v[3], o); }
                    if (fr == 0) *(f32x4*)(kpart + (size_t)(u.pm * 2 + wr) * 512 + head * 64 + 32 * bj + 8 * fq + 4 * n) = v; }
        }
    }
};

struct EpiWo {
    static constexpr bool PERM = true, AFTER_DRAIN = false, HAS_MID = true;
    const float* rn0; const float* gain0; bf16_t* xn; bf16_t* xo; unsigned char* xn8;
    const float* ssq_att; float* ssq1;
    __device__ __forceinline__ void rstds(int row, int fq, float& rm, float& rd) const {
        const float s = sum4(*(const f32x4*)(ssq_att + (size_t)row * 16 + 4 * fq));
        const float t = s + __shfl_xor(s, 16), o = __shfl_xor(t, 32);
        rm = __builtin_amdgcn_rsqf((fq < 2 ? t : o) * (1.f / 512.f) + RMS_EPS_F);
        rd = __builtin_amdgcn_rsqf((fq < 2 ? o : t) * (1.f / 512.f) + RMS_EPS_F);
    }
    static constexpr float ASCALE = 1.f / (F8_SO * F8_SW);
    __device__ __forceinline__ void mid(f32x4 (&acc)[2][2][4][2], const Unit& u, int wr, int fr_) const {
        const int ln_ = lane_id(), fr = ln_ & 15, fq = ln_ >> 4;
        const int row0 = u.pm * BM + wr * 64 + fr;
        int rbase = row0; asm volatile("" : "+v"(rbase));
        float f[8];
#pragma unroll
        for (int i = 0; i < 8; ++i) { float rm, rd; rstds(rbase + (i >> 2) * HALF + (i & 3) * 16, fq, rm, rd); f[i] = rm / rd; }
#pragma unroll
        for (int ai = 0; ai < 2; ++ai)
#pragma unroll
            for (int m = 0; m < 4; ++m)
#pragma unroll
                for (int bj = 0; bj < 2; ++bj)
#pragma unroll
                    for (int n = 0; n < 2; ++n) acc[ai][bj][m][n] = acc[ai][bj][m][n] * f[ai * 4 + m];
    }
    __device__ __forceinline__ void operator()(const f32x4 (&acc)[2][2][4][2], const Unit& u, int wr, int wc, int fr_, int fq_) const {
        const int ln_ = lane_id(), fr = ln_ & 15, fq = ln_ >> 4;
        const int row0 = u.pm * BM + wr * 64 + fr, col0 = u.pn * BM + wc * 32 + 8 * fq;
        int rbase = row0; asm volatile("" : "+v"(rbase));
        f32x4 ig[2][2];
#pragma unroll
        for (int bj = 0; bj < 2; ++bj)
#pragma unroll
            for (int n = 0; n < 2; ++n) { const f32x4 g = *(const f32x4*)(gain0 + col0 + bj * HALF + 4 * n);
                ig[bj][n] = (f32x4){__builtin_amdgcn_rcpf(g[0]), __builtin_amdgcn_rcpf(g[1]), __builtin_amdgcn_rcpf(g[2]), __builtin_amdgcn_rcpf(g[3])}; }
        u32x4 xw[2][4][2]; f32x4 sa[2][4]; float rnv[2][4];
#define EPIWO_ISSUE(ai) do { _Pragma("unroll") for (int m = 0; m < 4; ++m) { unsigned row = (unsigned)(rbase + (ai) * HALF + m * 16); asm volatile("" : "+v"(row));     \
            sa[ai][m] = *(const f32x4*)((const char*)ssq_att + (row * 64u + 16u * fq)); rnv[ai][m] = *(const float*)((const char*)rn0 + row * 4u); \
            _Pragma("unroll") for (int bj = 0; bj < 2; ++bj) xw[ai][m][bj] = __builtin_nontemporal_load((const u32x4*)((const char*)xn + (row * 2048u + (unsigned)(col0 + bj * HALF) * 2u))); } } while (0)
        u32x4 pb[4][2]; u32x2 p8[4][2]; float sq[4];
#define EPIWO_COMPUTE(ai) do { _Pragma("unroll") for (int m = 0; m < 4; ++m) { \
            const float s4 = sum4(sa[ai][m]); const float t = s4 + __shfl_xor(s4, 16), o = __shfl_xor(t, 32); \
            const float rd = __builtin_amdgcn_rsqf((fq < 2 ? o : t) * (1.f / 512.f) + RMS_EPS_F); const float rn = rnv[ai][m]; float s = 0.f; \
            _Pragma("unroll") for (int bj = 0; bj < 2; ++bj) { const u32x4 w = xw[ai][m][bj]; \
                const f32x4 xa = (f32x4){__uint_as_float(w.x << 16), __uint_as_float(w.x & 0xffff0000u), __uint_as_float(w.y << 16), __uint_as_float(w.y & 0xffff0000u)} * ig[bj][0] * rn; \
                const f32x4 xb = (f32x4){__uint_as_float(w.z << 16), __uint_as_float(w.z & 0xffff0000u), __uint_as_float(w.w << 16), __uint_as_float(w.w & 0xffff0000u)} * ig[bj][1] * rn; \
                const f32x4 v0 = xa + acc[ai][bj][m][0] * (rd * ASCALE), v1 = xb + acc[ai][bj][m][1] * (rd * ASCALE); \
                pb[m][bj] = pack8(v0, v1); p8[m][bj] = pack8_fp8(v0 * F8_SA, v1 * F8_SA); s += sq4(v0) + sq4(v1); } \
            s += __shfl_xor(s, 16); s += __shfl_xor(s, 32); sq[m] = s; } } while (0)
#define EPIWO_STORE(ai) do { _Pragma("unroll") for (int m = 0; m < 4; ++m) { unsigned row = (unsigned)(rbase + (ai) * HALF + m * 16); asm volatile("" : "+v"(row)); \
            _Pragma("unroll") for (int bj = 0; bj < 2; ++bj) { const unsigned off = row * 1024u + (unsigned)(col0 + bj * HALF); *(u32x4*)((char*)xo + off * 2u) = pb[m][bj]; *(u32x2*)(xn8 + off) = p8[m][bj]; } \
            if (fq == 0) *(float*)((char*)ssq1 + (row * 64u + (unsigned)(u.pn * 4 + wc) * 4u)) = sq[m]; } } while (0)
        EPIWO_ISSUE(0);
        asm volatile("" ::: "memory");
        EPIWO_COMPUTE(0);
        asm volatile("" ::: "memory");
        EPIWO_ISSUE(1);
        asm volatile("" ::: "memory");
        EPIWO_STORE(0);
        asm volatile("" ::: "memory");
        EPIWO_COMPUTE(1);
        EPIWO_STORE(1);
#undef EPIWO_ISSUE
#undef EPIWO_COMPUTE
#undef EPIWO_STORE
    }
};

struct EpiGU {
    static constexpr bool PERM = true, AFTER_DRAIN = false, HAS_MID = false;
    const float* ssq1; unsigned char* H;
    __device__ __forceinline__ u32x2 row8(const f32x4 (&acc)[2][2][4][2], int ai, int m, float rstd) const {
        const float rs_e = rstd * -1.4426950408889634f, rs_u = rstd * (rstd * F8_SH);
        const f32x2 e2 = {rs_e, rs_e}, u2 = {rs_u, rs_u}, one2 = {1.f, 1.f};
        u32x2 w;
#pragma unroll
        for (int n = 0; n < 2; ++n) { unsigned t = 0;
#pragma unroll
            for (int p = 0; p < 2; ++p) { const f32x2 gg = {acc[ai][0][m][n][2 * p], acc[ai][0][m][n][2 * p + 1]}, uu = {acc[ai][1][m][n][2 * p], acc[ai][1][m][n][2 * p + 1]};
                const f32x2 ea = gg * e2, gu = (gg * uu) * u2;
                const f32x2 den = (f32x2){__builtin_amdgcn_exp2f(ea.x), __builtin_amdgcn_exp2f(ea.y)} + one2;
                const f32x2 hh = gu * (f32x2){__builtin_amdgcn_rcpf(den.x), __builtin_amdgcn_rcpf(den.y)};
                t = p == 0 ? __builtin_amdgcn_cvt_pk_fp8_f32(hh.x, hh.y, t, false) : __builtin_amdgcn_cvt_pk_fp8_f32(hh.x, hh.y, t, true); }
            if (n == 0) w.x = t; else w.y = t; }
        return w;
    }
    __device__ __forceinline__ void operator()(const f32x4 (&acc)[2][2][4][2], const Unit& u, int wr, int wc, int fr_, int fq_) const {
        const int ln_ = lane_id(), fr = ln_ & 15, fq = ln_ >> 4;
        const int row0 = u.pm * BM + wr * 64 + fr, colp = u.pn * HALF + wc * 32 + 16 * (fq >> 1);
        int rbase = row0; asm volatile("" : "+v"(rbase));
        f32x4 sv[8]; float rs[8];
#pragma unroll
        for (int i = 0; i < 8; ++i) sv[i] = *(const f32x4*)(ssq1 + (size_t)(rbase + (i >> 2) * HALF + (i & 3) * 16) * 16 + 4 * fq);
#pragma unroll
        for (int i = 0; i < 8; ++i) { float ss = sum4(sv[i]); ss += __shfl_xor(ss, 16); ss += __shfl_xor(ss, 32); rs[i] = __builtin_amdgcn_rsqf(ss * (1.f / 1024.f) + RMS_EPS_F) * (1.f / (F8_SA * F8_SW)); }
#pragma unroll
        for (int ai = 0; ai < 2; ++ai)
#pragma unroll
            for (int mp = 0; mp < 2; ++mp) { const int rowa = rbase + ai * HALF + mp * 32, rowb = rowa + 16;
                const u32x2 wa = row8(acc, ai, 2 * mp, rs[ai * 4 + 2 * mp]), wb = row8(acc, ai, 2 * mp + 1, rs[ai * 4 + 2 * mp + 1]);
                const auto sx = __builtin_amdgcn_permlane16_swap(wa.x, wb.x, false, false), sy = __builtin_amdgcn_permlane16_swap(wa.y, wb.y, false, false);
                u32x4 w; w.x = sx[0]; w.y = sy[0]; w.z = sx[1]; w.w = sy[1];
                *(u32x4*)(H + (size_t)((fq & 1) ? rowb : rowa) * 2816 + colp) = w; }
    }
};

struct EpiDown {
    static constexpr bool PERM = true, AFTER_DRAIN = false, HAS_MID = false;
    const bf16_t* xn; float* out; float* ssq2;
    __device__ __forceinline__ void operator()(const f32x4 (&acc)[2][2][4][2], const Unit& u, int wr, int wc, int fr_, int fq_) const {
        const int ln_ = lane_id(), fr = ln_ & 15, fq = ln_ >> 4;
        const int row0 = u.pm * BM + wr * 64 + fr, col0 = u.pn * BM + wc * 32 + 8 * fq;
        int rbase = row0; asm volatile("" : "+v"(rbase));
#pragma unroll
        for (int ai = 0; ai < 2; ++ai)
#pragma unroll
            for (int m = 0; m < 4; ++m) { const int row = rbase + ai * HALF + m * 16; float s = 0.f;
#pragma unroll
                for (int bj = 0; bj < 2; ++bj) { const size_t off = (size_t)row * 1024 + col0 + bj * HALF;
                    const u32x4 xw = __builtin_nontemporal_load((const u32x4*)(xn + off));
                    const f32x4 xa = {__uint_as_float(xw.x << 16), __uint_as_float(xw.x & 0xffff0000u), __uint_as_float(xw.y << 16), __uint_as_float(xw.y & 0xffff0000u)};
                    const f32x4 xb = {__uint_as_float(xw.z << 16), __uint_as_float(xw.z & 0xffff0000u), __uint_as_float(xw.w << 16), __uint_as_float(xw.w & 0xffff0000u)};
                    const f32x4 v0 = xa + acc[ai][bj][m][0] * (1.f / (F8_SH * F8_SW)), v1 = xb + acc[ai][bj][m][1] * (1.f / (F8_SH * F8_SW));
                    *(f32x4*)(out + off) = v0; *(f32x4*)(out + off + 4) = v1; s += sq4(v0) + sq4(v1); }
                s += __shfl_xor(s, 16); s += __shfl_xor(s, 32);
                if (fq == 0) ssq2[(size_t)row * 16 + u.pn * 4 + wc] = s;
                asm volatile("" ::: "memory"); }
    }
};

struct EpiDownNorm {
    static constexpr bool PERM = true, AFTER_DRAIN = false, HAS_MID = false;
    const bf16_t* xn; float* out; float* ssq2; unsigned* cnt; const float* gain;
    __device__ __forceinline__ void operator()(f32x4 (&acc)[2][2][4][2], const Unit& u, int wr, int wc, int fr_, int fq_) const {
        const int ln_ = lane_id(), fr = ln_ & 15, fq = ln_ >> 4;
        const int row0 = u.pm * BM + wr * 64 + fr, col0 = u.pn * BM + wc * 32 + 8 * fq;
        int rbase = row0; asm volatile("" : "+v"(rbase));
        {
            u32x4 xw[2][4][2];
#pragma unroll
            for (int ai = 0; ai < 2; ++ai)
#pragma unroll
                for (int m = 0; m < 4; ++m)
#pragma unroll
                    for (int bj = 0; bj < 2; ++bj) { unsigned off = (unsigned)(rbase + ai * HALF + m * 16) * 1024u + col0 + bj * HALF; asm volatile("" : "+v"(off)); xw[ai][m][bj] = __builtin_nontemporal_load((const u32x4*)(xn + off)); }
#pragma unroll
            for (int ai = 0; ai < 2; ++ai)
#pragma unroll
                for (int m = 0; m < 4; ++m) { const int row = rbase + ai * HALF + m * 16; float s = 0.f;
#pragma unroll
                    for (int bj = 0; bj < 2; ++bj) { const u32x4 w = xw[ai][m][bj];
                        const f32x4 xa = {__uint_as_float(w.x << 16), __uint_as_float(w.x & 0xffff0000u), __uint_as_float(w.y << 16), __uint_as_float(w.y & 0xffff0000u)};
                        const f32x4 xb = {__uint_as_float(w.z << 16), __uint_as_float(w.z & 0xffff0000u), __uint_as_float(w.w << 16), __uint_as_float(w.w & 0xffff0000u)};
                        acc[ai][bj][m][0] = acc[ai][bj][m][0] * (1.f / (F8_SH * F8_SW)) + xa; acc[ai][bj][m][1] = acc[ai][bj][m][1] * (1.f / (F8_SH * F8_SW)) + xb; s += sq4(acc[ai][bj][m][0]) + sq4(acc[ai][bj][m][1]); }
                    s += __shfl_xor(s, 16); s += __shfl_xor(s, 32);
                    if (fq == 0) __hip_atomic_store(ssq2 + (size_t)(u.pn * 4 + wc) * 32768 + row, s, __ATOMIC_RELAXED, __HIP_MEMORY_SCOPE_AGENT); }
        }
        asm volatile("s_waitcnt vmcnt(0)" ::: "memory");
        unsigned* cw = cnt + 64 * u.pm;
        if (fr == 0 && fq == 0) __hip_atomic_fetch_add(cw, 1u, __ATOMIC_RELAXED, __HIP_MEMORY_SCOPE_AGENT);
        { unsigned sp = 0; while ((unsigned)__builtin_amdgcn_readfirstlane((int)__hip_atomic_load(cw, __ATOMIC_RELAXED, __HIP_MEMORY_SCOPE_AGENT)) < 32u) { __builtin_amdgcn_s_sleep(1); if (++sp > (1u << 22)) break; } }
        f32x4 g[2][2];
#pragma unroll
        for (int bj = 0; bj < 2; ++bj) { g[bj][0] = *(const f32x4*)(gain + col0 + bj * HALF); g[bj][1] = *(const f32x4*)(gain + col0 + bj * HALF + 4); }
        float pv[8][4];
#pragma unroll
        for (int i = 0; i < 8; ++i) { const float* pp = ssq2 + (size_t)(4 * fq) * 32768 + (rbase + (i >> 2) * HALF + (i & 3) * 16);
#pragma unroll
            for (int j = 0; j < 4; ++j) pv[i][j] = __hip_atomic_load(pp + j * 32768, __ATOMIC_RELAXED, __HIP_MEMORY_SCOPE_AGENT); }
#pragma unroll
        for (int ai = 0; ai < 2; ++ai)
#pragma unroll
            for (int m = 0; m < 4; ++m) { const int row = rbase + ai * HALF + m * 16;
                float s = (pv[ai * 4 + m][0] + pv[ai * 4 + m][1]) + (pv[ai * 4 + m][2] + pv[ai * 4 + m][3]);
                s += __shfl_xor(s, 16); s += __shfl_xor(s, 32);
                const float rstd = __builtin_amdgcn_rsqf(s * (1.f / 1024.f) + RMS_EPS_F);
#pragma unroll
                for (int bj = 0; bj < 2; ++bj) { const size_t off = (size_t)row * 1024 + col0 + bj * HALF;
                    *(f32x4*)(out + off) = acc[ai][bj][m][0] * rstd * g[bj][0]; *(f32x4*)(out + off + 4) = acc[ai][bj][m][1] * rstd * g[bj][1]; } }
    }
};
template <class Epi, class Sched, bool ALIGN_EPI = false, bool SP2 = false, bool F8 = false>
__device__ __forceinline__ void gemm_phase(PG8_LAS unsigned char* lds, const Gemm g, const Sched& S, const Epi& E, int wave) {
    const int wid = __builtin_amdgcn_readfirstlane(wave), lane = lane_id(), tid = wid * 64 + lane, wr = wid >> 2, wc = wid & 3, fr = lane & 15, fq = lane >> 4;
    const int K = F8 ? g.K / 2 : g.K, nt = K / BK;
    unsigned voffA[2], voffB[2];
#pragma unroll
    for (int i = 0; i < 2; ++i) { int R, C; stage_rc(tid * 16 + i * 8192, R, C); const int Rb = Epi::PERM ? ((R & ~31) + perm32(R & 31)) : R;
        voffA[i] = (unsigned)(R * K + C) * 2u; voffB[i] = (unsigned)(Rb * K + C) * 2u; }
    const unsigned kstep = (unsigned)(BK * 2);
    const unsigned hstep = (unsigned)HALF * K * 2;
    const unsigned tstep = 2 * hstep;
    const unsigned ldsw = (unsigned)wid * 1024u;
    const int aoff = lds_byte(wr * 64 + fr, fq * 8), boff = lds_byte(wc * 32 + fr, fq * 8);
#define PG8_SA(b, h) (((b) * 2 + (h)) * HTB)
#define PG8_SB(b, h) ((4 + (b) * 2 + (h)) * HTB)
    const __amdgpu_buffer_rsrc_t rsA = __builtin_amdgcn_make_buffer_rsrc((void*)g.A, 0, 0x7fffffff, 0x00020000), rsB = __builtin_amdgcn_make_buffer_rsrc((void*)g.Bt, 0, 0x7fffffff, 0x00020000);
#define PG8_STAGE(bufoff, gbase, voff) do { _Pragma("unroll") for (int _i = 0; _i < 2; ++_i) \
        __builtin_amdgcn_raw_ptr_buffer_load_lds(PG8_RS_##voff, (PG8_LAS unsigned*)(lds + (bufoff) + ldsw + _i * 8192), 16, (voff)[_i], (int)(gbase), 0, 0); } while (0)
#define PG8_RS_voffA rsA
#define PG8_RS_voffB rsB
#define PG8_LD8(base, off) __builtin_shufflevector(*(const PG8_LAS i32x4*)((base) + (off)), *(const PG8_LAS i32x4*)((base) + (off) + 1024), 0, 1, 2, 3, 4, 5, 6, 7)
#define PG8_LDA(dst, b, h) do { if constexpr (F8) { _Pragma("unroll") for (int m = 0; m < 4; ++m) dst##8[m] = PG8_LD8(abase8, PG8_SA(b, h) + m * 2048); } else { \
        _Pragma("unroll") for (int m = 0; m < 4; ++m) _Pragma("unroll") for (int k = 0; k < 2; ++k) dst[m][k] = *(const PG8_LAS bf16x8*)(lds + PG8_SA(b, h) + aoff + m * 2048 + k * 1024); } } while (0)
#define PG8_LDB(dst, b, h) do { if constexpr (F8) { _Pragma("unroll") for (int n = 0; n < 2; ++n) dst##8[n] = PG8_LD8(bbase8, PG8_SB(b, h) - PG8_SB(0, 0) + n * 2048); } else { \
        _Pragma("unroll") for (int n = 0; n < 2; ++n) _Pragma("unroll") for (int k = 0; k < 2; ++k) dst[n][k] = *(const PG8_LAS bf16x8*)(lds + PG8_SB(b, h) + boff + n * 2048 + k * 1024); } } while (0)
#define PG8_MMA(ai, bj, At, Bt) do { __builtin_amdgcn_s_setprio(1); if constexpr (F8) { _Pragma("unroll") for (int m = 0; m < 4; ++m) _Pragma("unroll") for (int n = 0; n < 2; ++n) \
        acc[ai][bj][m][n] = __builtin_amdgcn_mfma_scale_f32_16x16x128_f8f6f4(Bt##8[n], At##8[m], acc[ai][bj][m][n], 0, 0, 0, 0, 0, 0); } else \
        _Pragma("unroll") for (int m = 0; m < 4; ++m) _Pragma("unroll") for (int n = 0; n < 2; ++n) _Pragma("unroll") for (int k = 0; k < 2; ++k) \
        acc[ai][bj][m][n] = __builtin_amdgcn_mfma_f32_16x16x32_bf16(Bt[n][k], At[m][k], acc[ai][bj][m][n], 0, 0, 0); __builtin_amdgcn_s_setprio(0); } while (0)
#define PG8_WAIT_V(n) asm volatile("s_waitcnt vmcnt(" #n ")" ::: "memory")
#define PG8_WAIT_L(n) asm volatile("s_waitcnt lgkmcnt(" #n ")" ::: "memory")
#define PG8_BAR __builtin_amdgcn_s_barrier()
#define PG8_SCHED __builtin_amdgcn_sched_barrier(0)
    Unit cur, nxt; int ui = 0;
    if (!S.next(0, cur)) return;
    f32x4 acc[2][2][4][2];
#pragma unroll
    for (int a = 0; a < 2; ++a)
#pragma unroll
        for (int b = 0; b < 2; ++b)
#pragma unroll
            for (int m = 0; m < 4; ++m)
#pragma unroll
                for (int n = 0; n < 2; ++n) acc[a][b][m][n] = (f32x4){0.f, 0.f, 0.f, 0.f};
    PG8_LAS unsigned char* abase8 = lds + aoff; PG8_LAS unsigned char* bbase8 = lds + PG8_SB(0, 0) + boff;
    if constexpr (F8) { asm volatile("" : "+v"(abase8)); asm volatile("" : "+v"(bbase8)); }
    bf16x8 At[4][2], B0[2][2], B1[2][2]; i32x8 At8[4], B08[2], B18[2];
    unsigned cA = (unsigned)cur.pm * tstep, cB = (unsigned)cur.pn * tstep;
    S.a_ready(cur);
    if constexpr (SP2) {
        PG8_STAGE(PG8_SB(0, 0), cB, voffB); PG8_STAGE(PG8_SB(0, 1), cB + hstep, voffB); PG8_STAGE(PG8_SA(0, 0), cA, voffA); PG8_STAGE(PG8_SA(0, 1), cA + hstep, voffA);
        if (wr == 1) PG8_BAR;
        PG8_WAIT_V(2); PG8_BAR;
        PG8_STAGE(PG8_SB(1, 0), cB + kstep, voffB); PG8_STAGE(PG8_SA(1, 0), cA + kstep, voffA); PG8_STAGE(PG8_SB(1, 1), cB + hstep + kstep, voffB);
        PG8_WAIT_V(6); PG8_BAR;
    } else {
        PG8_STAGE(PG8_SB(0, 0), cB, voffB); PG8_STAGE(PG8_SA(0, 0), cA, voffA); PG8_STAGE(PG8_SB(0, 1), cB + hstep, voffB); PG8_STAGE(PG8_SA(0, 1), cA + hstep, voffA);
        if (wr == 1) PG8_BAR;
        PG8_WAIT_V(4); PG8_BAR;
        PG8_STAGE(PG8_SB(1, 0), cB + kstep, voffB); PG8_STAGE(PG8_SA(1, 0), cA + kstep, voffA); PG8_STAGE(PG8_SB(1, 1), cB + hstep + kstep, voffB);
        PG8_WAIT_V(6); PG8_BAR;
    }
    for (;;) {
        const bool has_next = S.next(ui + 1, nxt);
        const unsigned nA = has_next ? (unsigned)nxt.pm * tstep : cA, nB = has_next ? (unsigned)nxt.pn * tstep : cB;
#pragma nounroll
        for (int t = 0; t < nt; t += 2) {
            if constexpr (Epi::HAS_MID) { if (t == (nt >> 1)) E.mid(acc, cur, wr, fr); }
            const bool last = (t == nt - 2);
            const unsigned a1 = cA + (unsigned)(t + 1) * kstep;
            const unsigned a2 = last ? nA : cA + (unsigned)(t + 2) * kstep, b2 = last ? nB : cB + (unsigned)(t + 2) * kstep;
            const unsigned a3 = a2 + kstep, b3 = b2 + kstep;
            if (last && has_next) S.a_ready(nxt);
            if constexpr (SP2) {
            PG8_LDB(B0, 0, 0); PG8_LDB(B1, 0, 1); PG8_SCHED; PG8_LDA(At, 0, 0); PG8_STAGE(PG8_SA(1, 1), a1 + hstep, voffA);
            PG8_WAIT_V(8); PG8_WAIT_L(0); PG8_BAR; PG8_MMA(0, 0, At, B0); PG8_MMA(0, 1, At, B1); PG8_BAR; PG8_SCHED;
            PG8_LDA(At, 0, 1); PG8_STAGE(PG8_SB(0, 0), b2, voffB); PG8_STAGE(PG8_SB(0, 1), b2 + hstep, voffB); PG8_STAGE(PG8_SA(0, 0), a2, voffA);
            PG8_WAIT_V(8); PG8_WAIT_L(0); PG8_BAR; PG8_MMA(1, 0, At, B0); PG8_MMA(1, 1, At, B1); PG8_BAR; PG8_SCHED;
            PG8_LDB(B0, 1, 0); PG8_LDB(B1, 1, 1); PG8_SCHED; PG8_LDA(At, 1, 0); PG8_STAGE(PG8_SA(0, 1), a2 + hstep, voffA);
            PG8_WAIT_V(8); PG8_WAIT_L(0); PG8_BAR; PG8_MMA(0, 0, At, B0); PG8_MMA(0, 1, At, B1); PG8_BAR; PG8_SCHED;
            PG8_LDA(At, 1, 1); PG8_STAGE(PG8_SB(1, 0), b3, voffB); PG8_STAGE(PG8_SB(1, 1), b3 + hstep, voffB); PG8_STAGE(PG8_SA(1, 0), a3, voffA);
            PG8_WAIT_V(8); PG8_WAIT_L(0); PG8_BAR; PG8_MMA(1, 0, At, B0); PG8_MMA(1, 1, At, B1); PG8_BAR; PG8_SCHED;
            } else {
            PG8_LDB(B0, 0, 0); PG8_SCHED; PG8_LDA(At, 0, 0); PG8_STAGE(PG8_SA(1, 1), a1 + hstep, voffA);
            PG8_WAIT_L(8); PG8_BAR; PG8_WAIT_L(0); PG8_MMA(0, 0, At, B0); PG8_BAR; PG8_SCHED;
            PG8_LDB(B1, 0, 1); PG8_STAGE(PG8_SB(0, 0), b2, voffB);
            PG8_BAR; PG8_WAIT_L(0); PG8_MMA(0, 1, At, B1); PG8_BAR;
            PG8_LDA(At, 0, 1); PG8_STAGE(PG8_SA(0, 0), a2, voffA);
            PG8_BAR; PG8_WAIT_L(0); PG8_MMA(1, 0, At, B0); PG8_BAR; PG8_SCHED;
            PG8_STAGE(PG8_SB(0, 1), b2 + hstep, voffB);
            PG8_WAIT_V(6); PG8_BAR; PG8_MMA(1, 1, At, B1); PG8_BAR;
            PG8_LDB(B0, 1, 0); PG8_SCHED; PG8_LDA(At, 1, 0); PG8_STAGE(PG8_SA(0, 1), a2 + hstep, voffA);
            PG8_WAIT_L(8); PG8_BAR; PG8_WAIT_L(0); PG8_MMA(0, 0, At, B0); PG8_BAR; PG8_SCHED;
            PG8_LDB(B1, 1, 1); PG8_STAGE(PG8_SB(1, 0), b3, voffB);
            PG8_BAR; PG8_WAIT_L(0); PG8_MMA(0, 1, At, B1); PG8_BAR;
            PG8_LDA(At, 1, 1); PG8_STAGE(PG8_SA(1, 0), a3, voffA);
            PG8_BAR; PG8_WAIT_L(0); PG8_MMA(1, 0, At, B0); PG8_BAR; PG8_SCHED;
            PG8_STAGE(PG8_SB(1, 1), b3 + hstep, voffB);
            PG8_WAIT_V(6); PG8_BAR; PG8_MMA(1, 1, At, B1); PG8_BAR;
            }
        }
        if constexpr (ALIGN_EPI) { if (wr == 0) PG8_BAR; }
        if constexpr (!Epi::AFTER_DRAIN) { E(acc, cur, wr, wc, fr, fq); S.done(cur); }
        if (!has_next) break;
#pragma unroll
        for (int a = 0; a < 2; ++a)
#pragma unroll
            for (int b = 0; b < 2; ++b)
#pragma unroll
                for (int m = 0; m < 4; ++m)
#pragma unroll
                    for (int n = 0; n < 2; ++n) acc[a][b][m][n] = (f32x4){0.f, 0.f, 0.f, 0.f};
        cur = nxt; cA = nA; cB = nB; ++ui;
        if constexpr (ALIGN_EPI) { if (wr == 1) PG8_BAR; }
    }
    PG8_WAIT_V(0);
    if constexpr (!ALIGN_EPI) { if (wr == 0) PG8_BAR; }
    PG8_BAR;
    if constexpr (Epi::AFTER_DRAIN) { E.fused(acc, cur, wr, wc, fr, fq, lds, wid, lane); S.done(cur); }
#undef PG8_SA
#undef PG8_SB
#undef PG8_STAGE
#undef PG8_RS_voffA
#undef PG8_RS_voffB
#undef PG8_LDA
#undef PG8_LDB
#undef PG8_MMA
#undef PG8_WAIT_V
#undef PG8_WAIT_L
#undef PG8_BAR
#undef PG8_SCHED
}
}

constexpr int NWAVES = 8;
#ifndef MK_N_LAUNCHES
#define MK_N_LAUNCHES 1
#endif
#ifndef MK_STAG1
#define MK_STAG1 0
#endif
#ifndef MK_STAG5
#define MK_STAG5 0
#endif
#ifndef MK_LOCAL_BAR
#define MK_LOCAL_BAR 1
#endif
constexpr int PER_PHASE = 7;
constexpr int N_LAUNCHES = MK_N_LAUNCHES;

constexpr int BATCH = 8, SEQ = 4096, D = 1024, NH = 16, HD = 64, FF = 2816, NHM = 8;
constexpr int M = BATCH * SEQ;
constexpr int NQKV = 3 * D, NGU = 2 * FF;
constexpr float RMS_EPS = 1e-6f;
constexpr float QSCALE = 0.125f * 1.4426950408889634f;

constexpr size_t MiB = 1u << 20;
constexpr size_t WS_CTL = 0, CTL_ZERO_BYTES = 64 * 1024;
constexpr size_t WS_ROPE = 1 * MiB;
constexpr size_t WS_WQKV = 2 * MiB, WS_WO = 8 * MiB, WS_WGU = 10 * MiB, WS_WD = 21 * MiB;
constexpr size_t WS_KPART = 27 * MiB;
constexpr size_t WS_SSQA = 28 * MiB, WS_SSQ1 = 30 * MiB, WS_SSQ2 = 32 * MiB;
constexpr size_t WS_XN = 40 * MiB;
constexpr size_t WS_QO = 104 * MiB, WS_K = 168 * MiB, WS_V = 232 * MiB;
constexpr size_t WS_H = 394 * MiB;
#ifndef MK_REPEAT_PHASE
#define MK_REPEAT_PHASE -1
#endif
constexpr size_t WS_O = WS_QO;
constexpr size_t WS_FARO = 296 * MiB, WS_FARL = 328 * MiB;
constexpr size_t WS_XN8 = 330 * MiB;
constexpr size_t WS_O8 = 362 * MiB;
constexpr size_t WS_END = 482 * MiB;
static_assert(MK_REPEAT_PHASE != 3, "probe 3 needs two more buffers than d_ws has room for");
constexpr size_t QKV8_OFF = 2 * MiB;
constexpr int CW_TMO = 0, CW_CODE = 1;
constexpr int CW_BAR = 4096;
constexpr int CW_PANEL = 8192;
constexpr int CW_FAR = 2048;

constexpr int RING_OFF = 0, RING_BYTES = 131072;
constexpr int LDSCTL_OFF = RING_BYTES, MISC_OFF = LDSCTL_OFF + 320;
constexpr int LDS_BYTES = 147456;
static_assert(WS_V - WS_K == WS_K - WS_QO, "Q | K | V equally spaced");
#define GAS __attribute__((address_space(1)))
#define LAS __attribute__((address_space(3)))
typedef unsigned short bf16;
typedef unsigned v4u __attribute__((ext_vector_type(4)));
typedef float f32x4 __attribute__((ext_vector_type(4)));
typedef short bf16x8 __attribute__((ext_vector_type(8)));
typedef GAS unsigned gu32;
typedef GAS unsigned long long gu64;
#define RLX_AGENT __ATOMIC_RELAXED, __HIP_MEMORY_SCOPE_AGENT
#define LDS_WAIT() asm volatile("s_waitcnt lgkmcnt(0)" ::: "memory")
#define VM_WAIT() asm volatile("s_waitcnt vmcnt(0)" ::: "memory")
__device__ __forceinline__ unsigned long long rt() { return __builtin_amdgcn_s_memrealtime(); }
__device__ __forceinline__ unsigned f2bf(float f) { unsigned u = __builtin_bit_cast(unsigned, f); return (u + 0x7fffu + ((u >> 16) & 1u)) >> 16; }
__device__ __forceinline__ unsigned pk2(float lo, float hi) { return f2bf(lo) | (f2bf(hi) << 16); }

#define XB_TMO      128
#define XB_XCNT(j)  (256  + 64 * (j))
#define XB_XSUB(j)  (1280 + 64 * (j))
#define XB_XGEN(j)  (2304 + 64 * (j))
#define XB_TOP      3328
#define XB_TOPGEN   3392
#define XCD_BAR_WORDS 3456
#define XB_GRPX(g)  (3520 + (g))
#define XB_XGRP(j)  (3536 + (j))
#define XB_MISMATCH 3584
#define XB_SPIN_CAP (1u << 18)

__device__ __forceinline__ unsigned xb_ld(unsigned* p)              { return __hip_atomic_load(p, __ATOMIC_RELAXED, __HIP_MEMORY_SCOPE_AGENT); }
__device__ __forceinline__ unsigned xb_add(unsigned* p, unsigned v) { return __hip_atomic_fetch_add(p, v, __ATOMIC_RELAXED, __HIP_MEMORY_SCOPE_AGENT); }
__device__ __forceinline__ unsigned xb_xcc_id() { return (unsigned)__builtin_amdgcn_s_getreg((3 << 11) | 20) & 0xFu; }
#define XB_SPIN(cond, bar) do { unsigned _sp = 0; while (cond) { __builtin_amdgcn_s_sleep(1); \
    if ((++_sp & 255u) == 0u) { if (xb_ld(&(bar)[XB_TMO])) break; if (_sp > XB_SPIN_CAP) { atomicAdd(&(bar)[XB_TMO], 1u); break; } } } } while (0)

struct XcdBarrier {
    unsigned* bar; unsigned x;
    volatile LAS unsigned* st;
};

__device__ __forceinline__ int mk_lane() { int l; asm volatile("v_mbcnt_lo_u32_b32 %0, -1, 0\n\tv_mbcnt_hi_u32_b32 %0, -1, %0" : "=v"(l)); return l; }
__device__ __forceinline__ XcdBarrier xcd_barrier_post(unsigned* bar, volatile LAS unsigned* st, int wave) {
    XcdBarrier b; b.bar = bar; b.x = xb_xcc_id(); b.st = st;
    if (wave == 0 && mk_lane() == 0) {
        const unsigned g = blockIdx.x & 7u;
        unsigned e0 = 0u, e1 = 0u;
        if (!__hip_atomic_compare_exchange_strong(&bar[XB_GRPX(g)], &e0, b.x + 1u, __ATOMIC_RELAXED, __ATOMIC_RELAXED, __HIP_MEMORY_SCOPE_AGENT) && e0 != b.x + 1u) (void)xb_add(&bar[XB_MISMATCH], 1u);
        if (!__hip_atomic_compare_exchange_strong(&bar[XB_XGRP(b.x)], &e1, g + 1u, __ATOMIC_RELAXED, __ATOMIC_RELAXED, __HIP_MEMORY_SCOPE_AGENT) && e1 != g + 1u) (void)xb_add(&bar[XB_MISMATCH], 1u);
        (void)xb_add(&bar[XB_XCNT(b.x)], 1u);
    }
    return b;
}
__device__ __forceinline__ void xcd_barrier_complete(unsigned* bar, unsigned x, unsigned& nloc, unsigned& nx) {
    const unsigned G = gridDim.x * gridDim.y * gridDim.z;
    unsigned sum, cnt, mine, sp = 0u;
    for (;;) {
        sum = 0u; cnt = 0u; mine = 0u;
#pragma unroll
        for (unsigned j = 0; j < 16; ++j) { const unsigned c = xb_ld(&bar[XB_XCNT(j)]); sum += c; cnt += (c > 0u) ? 1u : 0u; mine = (j == x) ? c : mine; }
        if (sum == G) break;
        __builtin_amdgcn_s_sleep(1);
        if ((++sp & 255u) == 0u) { if (xb_ld(&bar[XB_TMO])) break; if (sp > XB_SPIN_CAP) { atomicAdd(&bar[XB_TMO], 1u); break; } }
    }
    nloc = mine > 0u ? mine : 1u; nx = cnt > 0u ? cnt : 1u;
}

__device__ __forceinline__ void xcd_barrier(const XcdBarrier& b, int wave, bool local = false) {
    asm volatile("s_waitcnt vmcnt(0)" ::: "memory");
    __syncthreads();
    if (wave == 0 && mk_lane() == 0) {
        unsigned* bar = b.bar;
        __builtin_amdgcn_s_waitcnt(0);
        unsigned nloc = b.st[0], nx = b.st[1];
        if (nloc == 0u) { xcd_barrier_complete(bar, b.x, nloc, nx); b.st[0] = nloc; b.st[1] = nx; }
        const unsigned old = xb_add(&bar[XB_XSUB(b.x)], 1u);
        const unsigned gen = old / nloc;
        if (local) {
            if (old + 1u == (gen + 1u) * nloc) xb_add(&bar[XB_XGEN(b.x)], 1u);
            else XB_SPIN(xb_ld(&bar[XB_XGEN(b.x)]) == gen, bar);
            __builtin_amdgcn_fence(__ATOMIC_ACQUIRE, "agent");
            asm volatile("s_waitcnt vmcnt(0)" ::: "memory");
        } else
        if (old + 1u == (gen + 1u) * nloc) {
            __builtin_amdgcn_fence(__ATOMIC_RELEASE, "agent");
            asm volatile("s_waitcnt vmcnt(0)" ::: "memory");
            const unsigned og = xb_add(&bar[XB_TOP], 1u);
            const unsigned tg = og / nx;
            if (og + 1u == (tg + 1u) * nx) xb_add(&bar[XB_TOPGEN], 1u);
            else XB_SPIN(xb_ld(&bar[XB_TOPGEN]) == tg, bar);
            __builtin_amdgcn_fence(__ATOMIC_ACQUIRE, "agent");
            xb_add(&bar[XB_XGEN(b.x)], 1u);
            asm volatile("s_waitcnt vmcnt(0)" ::: "memory");
        } else {
            XB_SPIN(xb_ld(&bar[XB_XGEN(b.x)]) == gen, bar);
            __builtin_amdgcn_fence(__ATOMIC_ACQUIRE, "agent");
            asm volatile("s_waitcnt vmcnt(0)" ::: "memory");
        }
    }
    __syncthreads();
}

#include <hip/hip_bf16.h>
#include <cmath>
namespace attn_body {
using bf16=__hip_bfloat16;
using bf16x8=__attribute__((ext_vector_type(8)))short;
using s16x4=__attribute__((ext_vector_type(4)))short;
using f32x16=__attribute__((ext_vector_type(16)))float;
using u32x4=__attribute__((ext_vector_type(4)))unsigned;
using f32x4_t=__attribute__((ext_vector_type(4)))float;
constexpr int BATCH=8,NHEAD=16,SEQ=4096,D=64,DM=NHEAD*D;
constexpr int NW=8,QBLK=32,QB=QBLK*NW,KVBLK=64,NQB=SEQ/QB;
constexpr int ATTN_PITCH=DM, ATTN_UNIT_ROWS=QB;
__device__ __forceinline__ int crow(int r,int hi){return (r&3)+8*(r>>2)+4*hi;}
#define SBAR() __builtin_amdgcn_sched_barrier(0)
__device__ __forceinline__ void cmask(f32x16&p0,f32x16&p1,int jb,int qrel,int hi){
  const float NEG=-INFINITY; int kb=64*jb+4*hi;
  #pragma unroll
  for(int r=0;r<16;++r){int kv=kb+(r&3)+8*(r>>2); if(kv>qrel)p0[r]=NEG; if(kv+32>qrel)p1[r]=NEG;}
}

__device__ __forceinline__ void dm_range(f32x16&p0,f32x16&p1,int x,unsigned bw){
  #pragma unroll
  for(int r=0;r<16;++r){ const int kp=(r&3)+8*(r>>2); if((unsigned)(x-kp)>bw)p0[r]=-1e30f; if((unsigned)(x-32-kp)>bw)p1[r]=-1e30f; } }
template<int KIND> __device__ __forceinline__ int dmode(int lo){
  if(KIND==2) return (lo+94<33||lo>128)?0:4;
  return (lo+94<0||lo>512)?0:((lo<0)?40:((lo+94<=128)?1:((lo<=128)?41:((lo+94<=512)?2:42)))); }
__device__ __forceinline__ void dm_adj128(f32x16&p0,f32x16&p1,int dqh,const f32x16&adj){
  #pragma unroll
  for(int r=0;r<16;++r){ const int kp=(r&3)+8*(r>>2); p0[r]+=(dqh-kp>128)?adj[r]:0.f; p1[r]+=(dqh-32-kp>128)?adj[r]:0.f; } }
__device__ __forceinline__ void fmask(f32x16&p0,f32x16&p1,int dq){
  #pragma unroll
  for(int r=0;r<16;++r){ const int kp=(r&3)+8*(r>>2); if((unsigned)(dq-kp-33)>95u)p0[r]=-1e30f; if((unsigned)(dq-kp-65)>95u)p1[r]=-1e30f; }
}
constexpr int NSLOT=3, SLOTB=8192;
constexpr int LDS_K=0, LDS_V=NSLOT*SLOTB, LDS_WS=2*NSLOT*SLOTB, LDS_OST=LDS_WS+NW*64*4, LDS_BYTES=LDS_OST+NW*4096;
constexpr int LDS_TAB=LDS_BYTES, TABB=4096, LDS_ALL=LDS_TAB+4*TABB;
constexpr float C2=0.125f*1.4426950408889634f;
__device__ __forceinline__ void glds16(const void*gsrc,unsigned lds_dst){unsigned keep;
  asm volatile("s_mov_b32 %0, m0\n\ts_mov_b32 m0, %2\n\ts_nop 0\n\tglobal_load_lds_dwordx4 %1, off\n\ts_mov_b32 m0, %0":"=&s"(keep):"v"(gsrc),"s"(lds_dst):"memory");}
__device__ __forceinline__ float max3f(float a,float b,float c){float r;asm("v_max3_f32 %0, %1, %2, %3":"=v"(r):"v"(a),"v"(b),"v"(c));return r;}
__device__ __forceinline__ float max2f(float a,float b){float r;asm("v_max_f32_e32 %0, %1, %2":"=v"(r):"v"(a),"v"(b));return r;}
__device__ __forceinline__ float fadd_s(float a,float b){float r;asm("v_add_f32_e32 %0, %1, %2":"=v"(r):"v"(a),"v"(b));return r;}
__device__ __forceinline__ float fsub_s(float a,float b){float r;asm("v_sub_f32_e32 %0, %1, %2":"=v"(r):"v"(a),"v"(b));return r;}
typedef float f32x2_t __attribute__((ext_vector_type(2))); typedef __bf16 bf16x2_t __attribute__((ext_vector_type(2)));
__device__ __forceinline__ unsigned cvtpk_s(float lo,float hi){f32x2_t v={lo,hi};bf16x2_t b=__builtin_convertvector(v,bf16x2_t);return __builtin_bit_cast(unsigned,b);}
#define WAIT_BAR(N) asm volatile("s_waitcnt vmcnt(" #N ") lgkmcnt(0)\n\ts_barrier":::"memory")

__device__ __forceinline__ void qkt(f32x16&p0,f32x16&p1,const char*Kslot,const bf16x8*qr,const f32x16&negm,int r32,int hi){
  const char*kb=Kslot+hi*1024+r32*16;
  #pragma unroll
  for(int d0=0;d0<4;++d0){
    const bf16x8 b0=*reinterpret_cast<const bf16x8*>(kb+d0*2048);
    const bf16x8 b1=*reinterpret_cast<const bf16x8*>(kb+d0*2048+512);
    if(d0==0){p0=__builtin_amdgcn_mfma_f32_32x32x16_bf16(b0,qr[0],negm,0,0,0);p1=__builtin_amdgcn_mfma_f32_32x32x16_bf16(b1,qr[0],negm,0,0,0);}
    else{p0=__builtin_amdgcn_mfma_f32_32x32x16_bf16(b0,qr[d0],p0,0,0,0);p1=__builtin_amdgcn_mfma_f32_32x32x16_bf16(b1,qr[d0],p1,0,0,0);}}
}
typedef __attribute__((address_space(3))) const char* lds_cptr;
typedef short v4i16_t __attribute__((ext_vector_type(4)));
__device__ __forceinline__ void kload8(bf16x8*kf,lds_cptr kp){
  kf[0]=*(const __attribute__((address_space(3))) bf16x8*)(kp);      kf[1]=*(const __attribute__((address_space(3))) bf16x8*)(kp+512);
  kf[2]=*(const __attribute__((address_space(3))) bf16x8*)(kp+2048); kf[3]=*(const __attribute__((address_space(3))) bf16x8*)(kp+2560);
  kf[4]=*(const __attribute__((address_space(3))) bf16x8*)(kp+4096); kf[5]=*(const __attribute__((address_space(3))) bf16x8*)(kp+4608);
  kf[6]=*(const __attribute__((address_space(3))) bf16x8*)(kp+6144); kf[7]=*(const __attribute__((address_space(3))) bf16x8*)(kp+6656);
}
__device__ __forceinline__ void kload2(bf16x8*kf,lds_cptr kp,int j){ kf[2*j]=*(const __attribute__((address_space(3))) bf16x8*)(kp+j*2048); kf[2*j+1]=*(const __attribute__((address_space(3))) bf16x8*)(kp+j*2048+512); }
__device__ __forceinline__ s16x4 vtr(lds_cptr p){ return __builtin_bit_cast(s16x4,__builtin_amdgcn_ds_read_tr16_b64_v4i16((__attribute__((address_space(3))) v4i16_t*)p)); }
__device__ __forceinline__ float rowmax(const f32x16&p0,const f32x16&p1){
  float a=max3f(p0[0],p0[1],p1[0]),b=max3f(p0[2],p0[3],p1[1]);a=max3f(a,p1[2],p1[3]);
  #pragma unroll
  for(int r=4;r<16;r+=4){a=max3f(a,p0[r],p0[r+1]);b=max3f(b,p0[r+2],p0[r+3]);a=max3f(a,p1[r],p1[r+1]);b=max3f(b,p1[r+2],p1[r+3]);}
  const float m=max2f(a,b);
  auto rr=__builtin_amdgcn_permlane32_swap(__float_as_uint(m),__float_as_uint(m),false,false);
  return max2f(__uint_as_float(rr[0]),__uint_as_float(rr[1]));
}
__device__ __forceinline__ void pv(f32x16*o,int vb,bf16x8 pa0,bf16x8 pa1,bf16x8 pa2,bf16x8 pa3){
  #pragma unroll
  for(int d0=0;d0<2;++d0){s16x4 lo[4],hi[4];
    #pragma unroll
    for(int ks=0;ks<4;++ks){
      asm volatile("ds_read_b64_tr_b16 %0,%1 offset:%c2":"=&v"(lo[ks]):"v"(vb),"i"(d0*4096+ks*1024):"memory");
      asm volatile("ds_read_b64_tr_b16 %0,%1 offset:%c2":"=&v"(hi[ks]):"v"(vb),"i"(d0*4096+ks*1024+512):"memory");}
    asm volatile("s_waitcnt lgkmcnt(0)":::"memory");SBAR();
    #define PK(k) (bf16x8){lo[k][0],lo[k][1],lo[k][2],lo[k][3],hi[k][0],hi[k][1],hi[k][2],hi[k][3]}
    o[d0]=__builtin_amdgcn_mfma_f32_32x32x16_bf16(pa0,PK(0),o[d0],0,0,0);
    o[d0]=__builtin_amdgcn_mfma_f32_32x32x16_bf16(pa1,PK(1),o[d0],0,0,0);
    o[d0]=__builtin_amdgcn_mfma_f32_32x32x16_bf16(pa2,PK(2),o[d0],0,0,0);
    o[d0]=__builtin_amdgcn_mfma_f32_32x32x16_bf16(pa3,PK(3),o[d0],0,0,0);
    #undef PK
  }
}

#ifndef ATTN_STORE16
#define ATTN_STORE16(p,v) asm volatile("global_store_dwordx4 %0, %1, off sc1\n\ts_nop 1"::"v"(p),"v"(v):"memory")
#endif
template<int THRL,int KIND> __device__ __forceinline__ void attn_unit(int b,int h,int qb,unsigned char*ws,char*shm,int wave,bf16x8 (&qr)[4],bool pre,bool has_next,int nkind,int nb,int nh,int nqb){
  const bf16*Q=(const bf16*)(ws+WS_QO); const bf16*K=(const bf16*)(ws+WS_K); const bf16*V=(const bf16*)(ws+WS_V); unsigned char*O8=ws+WS_O8;
  float*ssq=(float*)(ws+WS_SSQA); const float*kpart=(const float*)(ws+WS_KPART); unsigned short*faro=(unsigned short*)(ws+WS_FARO); float*farl=(float*)(ws+WS_FARL);
  constexpr bool DIL=(KIND==1), FAR=(KIND==2); constexpr int RS=FAR?16:1;
  int tid=wave*64+mk_lane(); asm volatile("":"+v"(tid));
  const int lane=tid&63,r32=lane&31,hi=lane>>5; const int wid=__builtin_amdgcn_readfirstlane(tid>>6);
  const int rowbase=b*SEQ+(FAR?qb:0);   const int q0=FAR?0:qb*QB;
  const bf16*Qw=Q+(rowbase+(int)(q0+wid*QBLK)*RS)*DM+h*D;
  const int T0=DIL?(qb>2?4*qb-8:0):0;
  const bf16*Kh=K+(rowbase+(int)T0*KVBLK)*DM+h*D,*Vh=V+(rowbase+(int)T0*KVBLK)*DM+h*D;
  const unsigned lds0=(unsigned)(uintptr_t)shm;
  float*wsf=(float*)(shm+LDS_WS)+wid*64;
  const bf16*ksrc=Kh+(int)lane*RS*DM+wid*8;
  const bf16*vsrc=Vh+(int)(16*(wid&3)+(lane>>2))*RS*DM+(wid>>2)*32+(lane&3)*8;
  const unsigned kdst=lds0+LDS_K+wid*1024, vdst=lds0+LDS_V+wid*1024;
  #define DMA_K(t,slot) glds16(ksrc+(int)(t)*KVBLK*RS*DM,(unsigned)__builtin_amdgcn_readfirstlane(kdst+(slot)))
  #define DMA_V(t,slot) glds16(vsrc+(int)(t)*KVBLK*RS*DM,(unsigned)__builtin_amdgcn_readfirstlane(vdst+(slot)))
  const int vb0=(int)(lds0+LDS_V)+((lane>>4)&1)*32+(lane&3)*8+(4*hi+((lane&15)>>2))*64;
  const char*Kbase=shm+LDS_K; bf16x8 kf[8];
  const lds_cptr shm3=(lds_cptr)shm; const lds_cptr kp0=shm3+LDS_K+hi*1024+r32*16; const lds_cptr vp0=shm3+LDS_V+((lane>>4)&1)*32+(lane&3)*8+(4*hi+((lane&15)>>2))*64;
  const int NT=FAR?4:(q0+QB)/KVBLK-T0;
  if(!pre)DMA_K(0,0); DMA_V(0,0); if(!pre)DMA_K(1,SLOTB);
  #pragma unroll
  for(int d0=0;d0<4;++d0)if(!pre)qr[d0]=*reinterpret_cast<const bf16x8*>(&Qw[(int)r32*RS*DM+d0*16+hi*8]);
  float mhat=0.f,l_reg=0.f;f32x16 o[2];o[0]=f32x16{};o[1]=f32x16{};
  const int qrel=wid*QBLK+r32;
  const lds_cptr tabp=(lds_cptr)shm+LDS_TAB+lane*64;
  unsigned selmask=1u<<qb;
  if(KIND==0){
    f32x16 g=f32x16{};
    #pragma unroll
    for(int d0=0;d0<4;++d0){ float km[8];
      if(r32<16){ const float*kp_=kpart+(unsigned)((b*16+r32)*2)*512+h*64+d0*16+hi*8;
        const f32x4_t a0=*(const f32x4_t*)kp_,a1=*(const f32x4_t*)(kp_+4),b0=*(const f32x4_t*)(kp_+512),b1=*(const f32x4_t*)(kp_+516);
        km[0]=a0[0]+b0[0];km[1]=a0[1]+b0[1];km[2]=a0[2]+b0[2];km[3]=a0[3]+b0[3];km[4]=a1[0]+b1[0];km[5]=a1[1]+b1[1];km[6]=a1[2]+b1[2];km[7]=a1[3]+b1[3]; }
      else{ _Pragma("unroll") for(int j=0;j<8;++j)km[j]=0.f; }
      u32x4 wh,wl; float rs[8];
      wh[0]=cvtpk_s(km[0],km[1]);wh[1]=cvtpk_s(km[2],km[3]);wh[2]=cvtpk_s(km[4],km[5]);wh[3]=cvtpk_s(km[6],km[7]);
      #pragma unroll
      for(int j=0;j<4;++j){ rs[2*j]=km[2*j]-__uint_as_float(wh[j]<<16); rs[2*j+1]=km[2*j+1]-__uint_as_float(wh[j]&0xffff0000u); }
      wl[0]=cvtpk_s(rs[0],rs[1]);wl[1]=cvtpk_s(rs[2],rs[3]);wl[2]=cvtpk_s(rs[4],rs[5]);wl[3]=cvtpk_s(rs[6],rs[7]);
      g=__builtin_amdgcn_mfma_f32_32x32x16_bf16(__builtin_bit_cast(bf16x8,wh),qr[d0],g,0,0,0);
      g=__builtin_amdgcn_mfma_f32_32x32x16_bf16(__builtin_bit_cast(bf16x8,wl),qr[d0],g,0,0,0); }
    float gv[16];
    #pragma unroll
    for(int r=0;r<8;++r){ const float own=g[r],oth=__shfl_xor(own,32); const int bl=(r&3)+8*(r>>2); gv[bl]=hi?oth:own; gv[bl+4]=hi?own:oth; }
    #pragma unroll
    for(int j=0;j<16;++j) if(j>=qb)gv[j]=-3e38f;
    #pragma unroll
    for(int rd=0;rd<3;++rd){ float best=-3e38f;int bi=0;
      #pragma unroll
      for(int j=0;j<16;++j){ if(gv[j]>best){best=gv[j];bi=j;} }
      if(best>-3e38f)selmask|=1u<<bi;
      #pragma unroll
      for(int j=0;j<16;++j) if(j==bi)gv[j]=-3e38f; }
  }
  const int lo0=FAR?(32*wid-63):(q0-T0*KVBLK+32*wid-63);
  #define DMODE(t) dmode<KIND>(lo0-(t)*KVBLK)
  #define CMASK(P0,P1,t) do{ if(DIL){ if(md_t>=40){ const int dqh_=q0-(T0+(t))*KVBLK+qrel-4*hi; \
        if(md_t==41){ const f32x16 adj_=*(const __attribute__((address_space(3))) f32x16*)(tabp+3*TABB); dm_adj128(P0,P1,dqh_,adj_); } \
        else dm_range(P0,P1,dqh_-((md_t==40)?0:-4096),(md_t==40)?0x7fffffffu:4608u); } } \
    else if(FAR){ if(md_t==4)fmask(P0,P1,qrel-(t)*KVBLK-4*hi); } \
    else { int jb_=(t)-(NT-4); if(jb_>=0)cmask(P0,P1,jb_,qrel,hi); } }while(0)
  #define SETC(t) f32x16 ct; const int md_t=(KIND==0)?0:DMODE(t); { if(DIL){ const int to_=(md_t==0)?0:((md_t==2||md_t==42)?2*TABB:TABB); \
      const f32x16 tb_=*(const __attribute__((address_space(3))) f32x16*)(tabp+to_); _Pragma("unroll") for(int r=0;r<16;++r)ct[r]=tb_[r]-mhat; } \
    else { const float x_=(FAR?(md_t!=0):(((selmask>>((t)>>2))&1u)!=0u))?-mhat:-1e30f; _Pragma("unroll") for(int r=0;r<16;++r)ct[r]=x_; } asm volatile("":"+v"(ct)); }
  bool resc=false;
  #define START(P0,P1) do{ const float rm=rowmax(P0,P1); resc=false; \
    if(__any(rm>(float)THRL)){ const float dl=__builtin_fmaxf(rm,0.f); mhat=fadd_s(mhat,dl); \
      _Pragma("unroll") for(int r=0;r<16;++r){P0[r]=fsub_s(P0[r],dl);P1[r]=fsub_s(P1[r],dl);} \
      const float f=__builtin_amdgcn_exp2f(-dl); l_reg*=f; if(hi==0)wsf[r32]=f; resc=true; } \
    _Pragma("unroll") for(int r=0;r<16;++r)P0[r]=__builtin_amdgcn_exp2f(P0[r]); }while(0)
  #define RESC() do{ if(resc){ asm volatile("s_waitcnt lgkmcnt(0)":::"memory"); \
      _Pragma("unroll") for(int d_=0;d_<2;++d_) _Pragma("unroll") for(int r=0;r<16;++r)o[d_][r]*=wsf[crow(r,hi)]; } }while(0)
  f32x16 pA0,pA1,pB0,pB1;
  int sl_prev=0,sl_cur=0,sl_next=SLOTB;
  #define ROT() do{sl_prev=sl_cur;sl_cur=sl_next;sl_next=(sl_next==(NSLOT-1)*SLOTB)?0:sl_next+SLOTB;}while(0)
  if(!pre){ DMA_K(2,2*SLOTB);
    WAIT_BAR(3); }
  else { WAIT_BAR(1); }
  if(0)WAIT_BAR(3);
  { SETC(0); qkt(pA0,pA1,Kbase,qr,ct,r32,hi); asm volatile("s_nop 15\n\ts_nop 7":"+v"(pA0),"+v"(pA1));CMASK(pA0,pA1,0); }
  START(pA0,pA1);
  _Pragma("unroll") for(int r=0;r<16;++r)pA1[r]=__builtin_amdgcn_exp2f(pA1[r]);
  WAIT_BAR(0);
  RESC();
  DMA_K(3,0);DMA_V(1,SLOTB);
  ROT();
  kload8(kf,kp0+sl_cur);
  WAIT_BAR(2);
  s16x4 vlo[8],vhi[8]; u32x4 pw0,pw1,pw2,pw3;
  #define PKW(P,B) cvtpk_s(P[B],P[B+1])
  #define PAF(k) __builtin_bit_cast(bf16x8,pw##k)
  #define VFR(i) (bf16x8){vlo[i][0],vlo[i][1],vlo[i][2],vlo[i][3],vhi[i][0],vhi[i][1],vhi[i][2],vhi[i][3]}
  #define PIN(x) asm volatile("":"+v"(x))
  #define MX3(a,b,c) __builtin_fmaxf(__builtin_fmaxf((a),(b)),(c))
  #define GAPA(MF,A0,A1,A2,A3,W0,W1,PW) do{ MF; sacc+=A0; sacc+=A1; sacc+=A2; sacc+=A3; PIN(sacc); W0; W1; PIN(PW); SBAR(); }while(0)
  #define EX(v) __builtin_amdgcn_exp2f(v)
  #define GAPB(MF,X,B) do{ MF; X[B]=EX(X[B]); X[B+1]=EX(X[B+1]); X[B+2]=EX(X[B+2]); X[B+3]=EX(X[B+3]); PIN(X); SBAR(); }while(0)
  #define VRD(i) do{ vlo[i]=vtr(vp_+(((i)>>2)*4096+((i)&3)*1024)); vhi[i]=vtr(vp_+(((i)>>2)*4096+((i)&3)*1024+512)); }while(0)
  #define KRD(G,j) do{ if(G){ kload2(kf,kp0+sl_next,j); SBAR(); } }while(0)
  #define STEP(C0,C1,P0,P1,t,GK,GV,GL) do{ SBAR(); SETC(t); SBAR(); \
    const lds_cptr vp_=vp0+sl_prev; \
    VRD(0); SBAR(); float sacc=(P0[0]+P0[1]); \
    GAPA(C0=__builtin_amdgcn_mfma_f32_32x32x16_bf16(kf[0],qr[0],ct,0,0,0), P0[2],P0[3],P0[4],P0[5],     pw0[0]=PKW(P0,0), pw0[1]=PKW(P0,2), pw0); \
    VRD(4); SBAR(); GAPA(C1=__builtin_amdgcn_mfma_f32_32x32x16_bf16(kf[1],qr[0],ct,0,0,0), P0[6],P0[7],P0[8],P0[9],     pw0[2]=PKW(P0,4), pw0[3]=PKW(P0,6), pw0); \
    VRD(1); SBAR(); GAPA(C0=__builtin_amdgcn_mfma_f32_32x32x16_bf16(kf[2],qr[1],C0,0,0,0),   P0[10],P0[11],P0[12],P0[13], pw1[0]=PKW(P0,8), pw1[1]=PKW(P0,10), pw1); \
    VRD(5); SBAR(); GAPA(C1=__builtin_amdgcn_mfma_f32_32x32x16_bf16(kf[3],qr[1],C1,0,0,0),   P0[14],P0[15],P1[0],P1[1],   pw1[2]=PKW(P0,12),pw1[3]=PKW(P0,14), pw1); \
    VRD(2); SBAR(); GAPA(C0=__builtin_amdgcn_mfma_f32_32x32x16_bf16(kf[4],qr[2],C0,0,0,0),   P1[2],P1[3],P1[4],P1[5],     pw2[0]=PKW(P1,0), pw2[1]=PKW(P1,2), pw2); \
    VRD(6); SBAR(); GAPA(C1=__builtin_amdgcn_mfma_f32_32x32x16_bf16(kf[5],qr[2],C1,0,0,0),   P1[6],P1[7],P1[8],P1[9],     pw2[2]=PKW(P1,4), pw2[3]=PKW(P1,6), pw2); \
    VRD(3); SBAR(); GAPA(C0=__builtin_amdgcn_mfma_f32_32x32x16_bf16(kf[6],qr[3],C0,0,0,0),   P1[10],P1[11],P1[12],P1[13], pw3[0]=PKW(P1,8), pw3[1]=PKW(P1,10), pw3); \
    VRD(7); SBAR(); GAPA(C1=__builtin_amdgcn_mfma_f32_32x32x16_bf16(kf[7],qr[3],C1,0,0,0),   P1[14],P1[15],0.f,0.f,       pw3[2]=PKW(P1,12),pw3[3]=PKW(P1,14), pw3); \
    l_reg+=sacc; \
    if(GK){DMA_K((t)+3,sl_cur);} if(GV){DMA_V((t)+1,sl_next);} \
    CMASK(C0,C1,t); \
    { float a=MX3(C0[0],C0[1],C1[0]),b=MX3(C0[2],C0[3],C1[1]); a=MX3(a,C1[2],C1[3]); \
      _Pragma("unroll") for(int r=4;r<16;r+=4){a=MX3(a,C0[r],C0[r+1]);b=MX3(b,C0[r+2],C0[r+3]);a=MX3(a,C1[r],C1[r+1]);b=MX3(b,C1[r+2],C1[r+3]);} \
      float rm=__builtin_fmaxf(a,b); { auto rr=__builtin_amdgcn_permlane32_swap(__float_as_uint(rm),__float_as_uint(rm),false,false); rm=__builtin_fmaxf(__uint_as_float(rr[0]),__uint_as_float(rr[1])); } \
      resc=false; \
      if(__builtin_expect(__any(rm>(float)THRL),0)){ const float dl=__builtin_fmaxf(rm,0.f); mhat+=dl; \
        _Pragma("unroll") for(int r=0;r<16;++r){C0[r]-=dl;C1[r]-=dl;} \
        const float f=__builtin_amdgcn_exp2f(-dl); l_reg*=f; if(hi==0)wsf[r32]=f; resc=true; } } \
    SBAR(); \
    GAPB(o[0]=__builtin_amdgcn_mfma_f32_32x32x16_bf16(PAF(0),VFR(0),o[0],0,0,0), C0,0); \
    GAPB(o[1]=__builtin_amdgcn_mfma_f32_32x32x16_bf16(PAF(0),VFR(4),o[1],0,0,0), C0,4); \
    KRD(GL,0); GAPB(o[0]=__builtin_amdgcn_mfma_f32_32x32x16_bf16(PAF(1),VFR(1),o[0],0,0,0), C0,8); \
    KRD(GL,1); GAPB(o[1]=__builtin_amdgcn_mfma_f32_32x32x16_bf16(PAF(1),VFR(5),o[1],0,0,0), C0,12); \
    KRD(GL,2); GAPB(o[0]=__builtin_amdgcn_mfma_f32_32x32x16_bf16(PAF(2),VFR(2),o[0],0,0,0), C1,0); \
    KRD(GL,3); GAPB(o[1]=__builtin_amdgcn_mfma_f32_32x32x16_bf16(PAF(2),VFR(6),o[1],0,0,0), C1,4); \
    GAPB(o[0]=__builtin_amdgcn_mfma_f32_32x32x16_bf16(PAF(3),VFR(3),o[0],0,0,0), C1,8); \
    GAPB(o[1]=__builtin_amdgcn_mfma_f32_32x32x16_bf16(PAF(3),VFR(7),o[1],0,0,0), C1,12); \
    }while(0)
  int t=1;
  for(;t+5<NT;t+=2){
    STEP(pB0,pB1,pA0,pA1,t,true,true,true);     WAIT_BAR(2); RESC(); ROT();
    STEP(pA0,pA1,pB0,pB1,t+1,true,true,true);   WAIT_BAR(2); RESC(); ROT();
  }
  #define ENDW(tt) do{ if((tt)+3<NT){WAIT_BAR(2);} else if((tt)+2<NT){WAIT_BAR(1);} else {WAIT_BAR(0);} }while(0)
  for(;t+1<NT;t+=2){
    STEP(pB0,pB1,pA0,pA1,t,(t+3<NT),(t+1<NT),(t+1<NT));       ENDW(t);   RESC(); ROT();
    STEP(pA0,pA1,pB0,pB1,t+1,(t+4<NT),(t+2<NT),(t+2<NT));     ENDW(t+1); RESC(); ROT();
  }
  if(has_next){
    const int nRS=(nkind==2)?16:1, nrowbase=nb*SEQ+((nkind==2)?nqb:0), nT0=(nkind==1)?(nqb>2?4*nqb-8:0):0;
    const bf16*nks=K+(nrowbase+(int)nT0*KVBLK)*DM+nh*D+(int)lane*nRS*DM+wid*8;
    glds16(nks,(unsigned)__builtin_amdgcn_readfirstlane(kdst)); glds16(nks+(int)KVBLK*nRS*DM,(unsigned)__builtin_amdgcn_readfirstlane(kdst+SLOTB)); glds16(nks+(int)2*KVBLK*nRS*DM,(unsigned)__builtin_amdgcn_readfirstlane(kdst+2*SLOTB)); }
  STEP(pB0,pB1,pA0,pA1,NT-1,false,false,false); RESC();
  if(has_next){
    const int nRS=(nkind==2)?16:1, nrowbase=nb*SEQ+((nkind==2)?nqb:0), nq0=(nkind==2)?0:nqb*QB; const bf16*nQw=Q+(nrowbase+(int)(nq0+wid*QBLK)*nRS)*DM+nh*D;
    #pragma unroll
    for(int d0=0;d0<4;++d0)qr[d0]=*reinterpret_cast<const bf16x8*>(&nQw[(int)r32*nRS*DM+d0*16+hi*8]); }
  { float sacc=pB0[0]+pB0[1]; _Pragma("unroll") for(int r=2;r<16;++r)sacc+=pB0[r]; _Pragma("unroll") for(int r=0;r<16;++r)sacc+=pB1[r]; l_reg+=sacc;
    pw0=(u32x4){PKW(pB0,0),PKW(pB0,2),PKW(pB0,4),PKW(pB0,6)};pw1=(u32x4){PKW(pB0,8),PKW(pB0,10),PKW(pB0,12),PKW(pB0,14)};pw2=(u32x4){PKW(pB1,0),PKW(pB1,2),PKW(pB1,4),PKW(pB1,6)};pw3=(u32x4){PKW(pB1,8),PKW(pB1,10),PKW(pB1,12),PKW(pB1,14)};
    SBAR(); pv(o,vb0+sl_cur,PAF(0),PAF(1),PAF(2),PAF(3)); }
  #undef PKW
  #undef PAF
  #undef VFR
  #undef PIN
  #undef MX3
  #undef GAPA
  #undef GAPB
  #undef EX
  #undef VRD
  #undef KRD
  #undef STEP
  #undef ENDW
  {auto rr=__builtin_amdgcn_permlane32_swap(__float_as_uint(l_reg),__float_as_uint(l_reg),false,false);l_reg=__uint_as_float(rr[0])+__uint_as_float(rr[1]);}
  int lane_e=lane; asm volatile("":"+v"(lane_e));
  u32x4 fch[4];
  if(DIL){
    const unsigned short*fp=faro+(unsigned)(rowbase+q0+wid*QBLK+(lane_e>>3))*512+(h-8)*D+(lane_e&7)*8;
    #pragma unroll
    for(int i=0;i<4;++i)fch[i]=*(const u32x4*)(fp+(unsigned)i*8*512);
    const int p_=q0+wid*QBLK+(lane_e&31); const float*lp=farl+((unsigned)(((b*8+(h-8))*16+(p_&15))*256+(p_>>4)))*2; const float lf_=lp[0],mf_=lp[1];
    const float M_=__builtin_fmaxf(mhat,mf_),sa_=__builtin_amdgcn_exp2f(mhat-M_),sb_=__builtin_amdgcn_exp2f(mf_-M_),rl_=__builtin_amdgcn_rcpf(l_reg*sa_+lf_*sb_);
    if(hi==0){wsf[32+r32]=sa_*rl_;wsf[r32]=sb_*rl_;} }
  else if(hi==0)wsf[32+r32]=FAR?1.f:__builtin_amdgcn_rcpf(l_reg);
  asm volatile("s_waitcnt lgkmcnt(0)":::"memory");
  float rli[16];
  #pragma unroll
  for(int r=0;r<16;++r)rli[r]=wsf[32+crow(r,hi)];
  constexpr int OP=FAR?512:DM;
  bf16*Ow=(bf16*)faro+(rowbase+(int)wid*QBLK*RS)*OP+(h-8)*D;
  unsigned char*O8w=O8+(rowbase+q0+wid*QBLK)*DM+h*D;
  if(FAR&&hi==0){ float*lp=farl+((unsigned)(((b*8+(h-8))*16+qb)*256+qrel))*2; __hip_atomic_store((unsigned long long*)lp,((unsigned long long)__float_as_uint(mhat)<<32)|__float_as_uint(l_reg),__ATOMIC_RELAXED,__HIP_MEMORY_SCOPE_AGENT); }
  { bf16*stg=(bf16*)(shm+LDS_OST)+wid*2048;
    #pragma unroll
    for(int r=0;r<16;++r){const int orow=crow(r,hi);
      #pragma unroll
      for(int d0=0;d0<2;++d0)stg[orow*64+d0*32+r32]=__float2bfloat16(o[d0][r]*rli[r]);}
    asm volatile("s_waitcnt lgkmcnt(0)":::"memory");
    #pragma unroll
    for(int i=0;i<4;++i){const int row=i*8+(lane_e>>3),ch=lane_e&7; u32x4 v=*(const u32x4*)(stg+row*64+ch*8);
      if(DIL){ const float fb_=wsf[row];
        #pragma unroll
        for(int j=0;j<4;++j){ const float a_=__uint_as_float(v[j]<<16)+__uint_as_float(fch[i][j]<<16)*fb_, b_=__uint_as_float(v[j]&0xffff0000u)+__uint_as_float(fch[i][j]&0xffff0000u)*fb_; v[j]=cvtpk_s(a_,b_); } }
      if(FAR){ ATTN_STORE16(Ow+(int)row*RS*OP+ch*8,v); }
      else { unsigned w0_=0,w1_=0;
        w0_=__builtin_amdgcn_cvt_pk_fp8_f32(__uint_as_float(v[0]<<16)*64.f,__uint_as_float(v[0]&0xffff0000u)*64.f,w0_,false); w0_=__builtin_amdgcn_cvt_pk_fp8_f32(__uint_as_float(v[1]<<16)*64.f,__uint_as_float(v[1]&0xffff0000u)*64.f,w0_,true);
        w1_=__builtin_amdgcn_cvt_pk_fp8_f32(__uint_as_float(v[2]<<16)*64.f,__uint_as_float(v[2]&0xffff0000u)*64.f,w1_,false); w1_=__builtin_amdgcn_cvt_pk_fp8_f32(__uint_as_float(v[3]<<16)*64.f,__uint_as_float(v[3]&0xffff0000u)*64.f,w1_,true);
        *(unsigned long long*)(O8w+(int)row*DM+ch*8)=((unsigned long long)w1_<<32)|w0_; }
      float sq=0.f;
      #pragma unroll
      for(int j=0;j<4;++j){ const float a_=__uint_as_float(v[j]<<16), b_=__uint_as_float(v[j]&0xffff0000u); sq+=a_*a_+b_*b_; }
      sq+=__shfl_xor(sq,1); sq+=__shfl_xor(sq,2); sq+=__shfl_xor(sq,4);
      if(!FAR&&ch==0)ssq[(unsigned)(rowbase+q0+wid*QBLK+row)*16+h]=sq; } }
  asm volatile("s_waitcnt lgkmcnt(0)\n\ts_barrier":::"memory");
  #undef DMA_K
  #undef DMA_V
  #undef CMASK
  #undef START
  #undef RESC
  #undef ROT
}
constexpr int ATTN_LDS_BYTES=LDS_BYTES;
__device__ __forceinline__ void attn_tables(char*lds,int wave){
  float*tb=(float*)(lds+LDS_TAB);
  for(int e=wave*64+mk_lane();e<64*16;e+=512){ const int ln=e>>4,r=e&15,r32=ln&31,hi=ln>>5; const int z4=r32&3,z16=((r32&15)-4*hi)&15;
    const bool in4=(z4==(r&3)),in16=(z16==((r&3)+8*((r>>2)&1)));
    tb[e]=-1e30f; tb[1024+e]=in16?1.5849625007f:(in4?1.f:0.f); tb[2048+e]=in16?1.f:(in4?0.f:-1e30f); tb[3072+e]=in16?(1.f-1.5849625007f):(in4?-1.f:-1e30f); }
  __syncthreads();
}
template<int THRL=8> __device__ __forceinline__ void attn_phase(char*lds,unsigned char*ws,unsigned*cnt,int vcu,int G,int wave){
  const int g=vcu>>2,b=g>>3,hm=g&7,c=vcu&3;
  attn_tables(lds,wave);
  bf16x8 qr[4];
  { const int nf_=(c==0)?6:((c==1)?4:3), cb_=(c==0)?0:((c==1)?6:((c==2)?10:13)); const int n_=(MK_REPEAT_PHASE==22?2*nf_:nf_); for(int i=0;i<n_;++i) attn_unit<THRL,2>(b,8+hm,cb_+(i%nf_),ws,lds,wave,qr,i>0,true,(i+1<n_)?2:0,b,(i+1<n_)?8+hm:hm,(i+1<n_)?cb_+((i+1)%nf_):15-c); }
  asm volatile("s_waitcnt vmcnt(0)":::"memory"); __syncthreads();
  if(wave==0&&mk_lane()==0) __hip_atomic_fetch_add(cnt+64*b,1u,__ATOMIC_RELAXED,__HIP_MEMORY_SCOPE_AGENT);
  #define QBSEL(i_) ((((i_)&3)==0)?15-c:((((i_)&3)==1)?8+c:((((i_)&3)==2)?7-c:c)))
  { const int n_=(MK_REPEAT_PHASE==20?8:4); for(int ii=0;ii<n_;++ii) attn_unit<THRL,0>(b,hm,QBSEL(ii),ws,lds,wave,qr,true,true,(ii+1<n_)?0:1,b,(ii+1<n_)?hm:8+hm,QBSEL(ii+1)); }
  if(wave==0&&mk_lane()==0){ unsigned sp=0; while(__hip_atomic_load(cnt+64*b,__ATOMIC_RELAXED,__HIP_MEMORY_SCOPE_AGENT)<(unsigned)(G>>3)){     __builtin_amdgcn_s_sleep(2); if(++sp>(1u<<22))break; }
    __builtin_amdgcn_fence(__ATOMIC_ACQUIRE,"agent"); asm volatile("s_waitcnt vmcnt(0)":::"memory"); }
  __syncthreads();
  { const int n_=(MK_REPEAT_PHASE==21?8:4); for(int ii=0;ii<n_;++ii) attn_unit<THRL,1>(b,8+hm,QBSEL(ii),ws,lds,wave,qr,true,ii+1<n_,1,b,8+hm,QBSEL(ii+1)); }
  #undef QBSEL
}
#undef SBAR
#undef WAIT_BAR
}

struct Frame {
    LAS unsigned char* lds;
    volatile LAS unsigned* MISC;
    gu32* ctl;
    int wave;
    int vcu, G;
    const float *x, *attn_norm, *w_in, *moba_norm, *dil_norm, *w_out, *ffn_norm, *w_gate, *w_up, *w_down, *final_norm;
    float* out;
    bf16 *Wqkv_t, *Wo_t, *Wgu_t, *Wd_t;
    bf16 *QO, *KB, *VB, *XN, *OB; unsigned char *HB, *XN8;
    float *rope, *kpart, *ssqa, *ssq1, *ssq2;
};

__device__ __forceinline__ float wave_sum(float v) {
#pragma unroll
    for (int o = 1; o < 64; o <<= 1) v += __shfl_xor(v, o);
    return v;
}
__device__ __forceinline__ int qkv_vrow(int n) { const int part = n >> 10, head = (n >> 6) & 15, d = n & 63; return 256 * (part * 4 + (head >> 2)) + 128 * (d >> 5) + 32 * (head & 3) + (d & 31); }
template <int MODE>
__device__ __forceinline__ void p0_item(const float* W, int K, int N, bf16* WT, const float* g0, const float* g1, LAS float* scr, int item, int lane) {
    const int nblk = N / 32, kb = item / nblk, nb = item % nblk, k0 = 64 * kb, n0 = 32 * nb;
#pragma unroll 8
    for (int i = 0; i < 32; ++i) { const int kk = 2 * i + (lane >> 5), k = k0 + kk; float w = __builtin_nontemporal_load(W + (size_t)k * N + n0 + (lane & 31));
        if (MODE == 1) w *= (k < 512 ? g0[k] : g1[k - 512]);
        if (MODE == 2 || MODE == 3) w *= g0[k];
        scr[kk * 33 + (lane & 31)] = w; }
    LDS_WAIT(); asm volatile("" ::: "memory");
    const int c = lane & 7;
#pragma unroll
    for (int j = 0; j < 4; ++j) { const int n = (lane >> 3) + 8 * j; const LAS float* s = scr + (8 * c) * 33 + n;
        const int ns = n0 + n; int dr;
        if (MODE == 0) dr = qkv_vrow(ns); else if (MODE == 2) dr = 256 * (ns >> 7) + (ns & 127); else if (MODE == 3) dr = 256 * (ns >> 7) + 128 + (ns & 127); else dr = ns;
        bool f8 = MODE >= 1; size_t base8 = 0;
        if (MODE == 0) {
            const int pn = dr >> 8, lo = dr & 255; f8 = !(pn < 8 && (pn & 3) < 2);
            dr = (f8 ? (pn < 8 ? ((pn & 1) + 2 * (pn >> 2)) : pn - 4) : ((pn & 1) + 2 * (pn >> 2))) * 256 + lo; base8 = (size_t)QKV8_OFF; }
        if (f8) {
            const pg8::f32x4 a = {s[0 * 33], s[1 * 33], s[2 * 33], s[3 * 33]}, b = {s[4 * 33], s[5 * 33], s[6 * 33], s[7 * 33]};
            *(GAS pg8::u32x2*)((unsigned char*)WT + base8 + (size_t)dr * K + k0 + 8 * c) = pg8::pack8_fp8(a * pg8::F8_SW, b * pg8::F8_SW);
        } else {
            v4u o; o.x = pk2(s[0 * 33], s[1 * 33]); o.y = pk2(s[2 * 33], s[3 * 33]); o.z = pk2(s[4 * 33], s[5 * 33]); o.w = pk2(s[6 * 33], s[7 * 33]);
            *(GAS v4u*)(WT + (size_t)dr * K + k0 + 8 * c) = o; } }
    LDS_WAIT(); asm volatile("" ::: "memory");
}
template <int R>
__device__ __forceinline__ void rms_rows_to_bf16(Frame& F, const float* xrow, const float* gain, bf16* orow, unsigned char* orow8, float* rn) {
    const GAS f32x4* xr = (const GAS f32x4*)xrow + mk_lane(); const GAS f32x4* gr = (const GAS f32x4*)gain + mk_lane();
    f32x4 v[R][4]; float s[R];
#pragma unroll
    for (int r = 0; r < R; ++r)
#pragma unroll
        for (int j = 0; j < 4; ++j) v[r][j] = __builtin_nontemporal_load(xr + r * 256 + 64 * j);
#pragma unroll
    for (int r = 0; r < R; ++r) { s[r] = 0.f;
#pragma unroll
        for (int j = 0; j < 4; ++j) s[r] += (v[r][j].x * v[r][j].x + v[r][j].y * v[r][j].y) + (v[r][j].z * v[r][j].z + v[r][j].w * v[r][j].w); }
#pragma unroll
    for (int o = 1; o < 64; o <<= 1)
#pragma unroll
        for (int r = 0; r < R; ++r) s[r] += __shfl_xor(s[r], o);
    const int ln_ = mk_lane(); GAS unsigned long long* o8 = (GAS unsigned long long*)orow + ln_; GAS unsigned* q8 = (GAS unsigned*)orow8 + ln_;
#pragma unroll
    for (int r = 0; r < R; ++r) { const float rms = sqrtf(s[r] * (1.f / D) + RMS_EPS), rstd = 1.f / rms; if (ln_ == 0) rn[r] = rms;
#pragma unroll
        for (int j = 0; j < 4; ++j) { const f32x4 g = gr[64 * j];
            const f32x4 y = v[r][j] * rstd * g;
            o8[r * 256 + 64 * j] = (unsigned long long)pk2(y.x, y.y) | ((unsigned long long)pk2(y.z, y.w) << 32);
            unsigned t = 0; t = __builtin_amdgcn_cvt_pk_fp8_f32(y.x * pg8::F8_SA, y.y * pg8::F8_SA, t, false); t = __builtin_amdgcn_cvt_pk_fp8_f32(y.z * pg8::F8_SA, y.w * pg8::F8_SA, t, true); q8[r * 256 + 64 * j] = t; } }
}
__device__ __forceinline__ void p0_prologue(Frame& F) {
    LAS float* scr = (LAS float*)(F.lds + RING_OFF + F.wave * 16384);
    const int gw = F.vcu * NWAVES + F.wave, NGW = F.G * NWAVES;
    constexpr int I_IN = (D / 64) * (NQKV / 32), I_O = (D / 64) * (D / 32), I_G = (D / 64) * (FF / 32), I_D = (FF / 64) * (D / 32);
    constexpr int NITEMS = I_IN + I_O + 2 * I_G + I_D;
    for (int it = gw; it < NITEMS; it += NGW) {
        int r = it;
        if (r < I_IN) { p0_item<0>(F.w_in, D, NQKV, F.Wqkv_t, nullptr, nullptr, scr, r, mk_lane()); continue; } r -= I_IN;
        if (r < I_O) { p0_item<1>(F.w_out, D, D, F.Wo_t, F.moba_norm, F.dil_norm, scr, r, mk_lane()); continue; } r -= I_O;
        if (r < I_G) { p0_item<2>(F.w_gate, D, FF, F.Wgu_t, F.ffn_norm, nullptr, scr, r, mk_lane()); continue; } r -= I_G;
        if (r < I_G) { p0_item<3>(F.w_up, D, FF, F.Wgu_t, F.ffn_norm, nullptr, scr, r, mk_lane()); continue; } r -= I_G;
        p0_item<4>(F.w_down, FF, D, F.Wd_t, nullptr, nullptr, scr, r, mk_lane());
    }
    for (int e = (F.vcu * NWAVES * 64) + F.wave * 64 + mk_lane(); e < SEQ * 32; e += F.G * NWAVES * 64) {
        const int s = e >> 5, j = e & 31;
        const float invf = __builtin_amdgcn_exp2f(-(float)j * (13.287712379549449f / 32.0f));
        double rev = (double)s * (double)invf * 0.15915494309189535; rev -= __builtin_floor(rev);
        const float r = (float)rev;
        pg8::f32x2 cs; cs.x = __builtin_amdgcn_cosf(r); cs.y = __builtin_amdgcn_sinf(r);
        *(GAS pg8::f32x2*)((pg8::f32x2*)F.rope + e) = cs;
    }
    for (int m = 4 * gw; m < M; m += 4 * NGW) rms_rows_to_bf16<4>(F, F.x + (size_t)m * D, F.attn_norm, F.XN + (size_t)m * D, F.XN8 + (size_t)m * D, (float*)(F.kpart + 131072) + m);
}

__device__ __forceinline__ void p6_final(Frame& F) {
    const int gw = F.vcu * NWAVES + F.wave, NGW = F.G * NWAVES;
    const GAS f32x4* gr = (const GAS f32x4*)F.final_norm + mk_lane();
    for (int m = gw; m < M; m += NGW) {
        GAS f32x4* xr = (GAS f32x4*)(F.out + (size_t)m * D) + mk_lane();
        const GAS f32x4* sp = (const GAS f32x4*)(F.ssq2 + (size_t)m * 16);
        const f32x4 a = sp[0], b = sp[1], c = sp[2], d = sp[3];
        const float ss = ((a.x + a.y) + (a.z + a.w)) + ((b.x + b.y) + (b.z + b.w)) + ((c.x + c.y) + (c.z + c.w)) + ((d.x + d.y) + (d.z + d.w));
        const float rstd = 1.f / sqrtf(ss * (1.f / D) + RMS_EPS);
#pragma unroll
        for (int j = 0; j < 4; ++j) { const f32x4 v = xr[64 * j], g = gr[64 * j]; xr[64 * j] = v * rstd * g; }
    }
}

struct Args { const float* in[11]; float* out; unsigned char* ws; int ph_lo, ph_hi, li, pad; };
__global__ void __launch_bounds__(NWAVES * 64, 2) mk_fwd(Args args) {
    extern __shared__ __attribute__((aligned(16))) unsigned char lds[];
    Frame F;
    F.lds = (LAS unsigned char*)lds;
    F.MISC = (volatile LAS unsigned*)(F.lds + MISC_OFF);
    F.wave = __builtin_amdgcn_readfirstlane((int)(threadIdx.x >> 6));
    F.G = gridDim.x; { const int bx = blockIdx.x; F.vcu = (F.G % 8 == 0) ? (bx % 8) * (F.G / 8) + bx / 8 : bx; }
#define GRID_BAR(seam) do { if (N_LAUNCHES == PER_PHASE) { if ((F.wave == 0 && mk_lane() == 0)) __hip_atomic_store(F.ctl + CW_TMO, 0xBADBA0u | (unsigned)(seam), RLX_AGENT); } \
    else { xcd_barrier(bar, F.wave, (seam) > 0 && (seam) < 5 && local_ok); if (MK_REPEAT_PHASE == 30) xcd_barrier(bar, F.wave, (seam) > 0 && (seam) < 5 && local_ok); } } while (0)
    unsigned char* ws = args.ws;
    F.ctl = (gu32*)(ws + WS_CTL);
    F.x = args.in[0]; F.attn_norm = args.in[1]; F.w_in = args.in[2]; F.moba_norm = args.in[3]; F.dil_norm = args.in[4]; F.w_out = args.in[5];
    F.ffn_norm = args.in[6]; F.w_gate = args.in[7]; F.w_up = args.in[8]; F.w_down = args.in[9]; F.final_norm = args.in[10]; F.out = args.out;
    F.Wqkv_t = (bf16*)(ws + WS_WQKV); F.Wo_t = (bf16*)(ws + WS_WO); F.Wgu_t = (bf16*)(ws + WS_WGU); F.Wd_t = (bf16*)(ws + WS_WD);
    F.QO = (bf16*)(ws + WS_QO); F.KB = (bf16*)(ws + WS_K); F.VB = (bf16*)(ws + WS_V); F.HB = ws + WS_H; F.XN8 = ws + WS_XN8; F.XN = (bf16*)(ws + WS_XN); F.OB = (bf16*)(ws + WS_O);
    F.rope = (float*)(ws + WS_ROPE); F.kpart = (float*)(ws + WS_KPART); F.ssqa = (float*)(ws + WS_SSQA); F.ssq1 = (float*)(ws + WS_SSQ1); F.ssq2 = (float*)(ws + WS_SSQ2);
    for (int u = F.wave * 64 + mk_lane(); u < (LDS_BYTES - LDSCTL_OFF) / 4; u += NWAVES * 64) ((LAS unsigned*)(F.lds + LDSCTL_OFF))[u] = 0u;
    __syncthreads();
    XcdBarrier bar; bar.bar = (unsigned*)(F.ctl + CW_BAR); bar.x = 0; bar.st = nullptr;
    if (N_LAUNCHES != PER_PHASE) bar = xcd_barrier_post((unsigned*)(F.ctl + CW_BAR), F.MISC + 8, F.wave);
    const int lo = args.ph_lo, hi = args.ph_hi;
    bool local_ok = false;
#define IN(k) (lo <= (k) && (k) < hi)
#define BOTH(k) (IN(k) && IN((k) + 1))

    if (IN(0)) { for (int rp = 0; rp < (MK_REPEAT_PHASE == 0 ? 2 : 1); ++rp) p0_prologue(F); if (BOTH(0)) GRID_BAR(0); }
    if (N_LAUNCHES != PER_PHASE && MK_LOCAL_BAR) {
        if (F.wave == 0 && mk_lane() == 0) { const unsigned mm = xb_ld(bar.bar + XB_MISMATCH); F.MISC[12] = (mm == 0u && F.G == 256 && F.MISC[8] == 32u && F.MISC[9] == 8u) ? 1u : 0u; }
        __syncthreads();
        local_ok = __builtin_amdgcn_readfirstlane((int)F.MISC[12]) != 0;
    }

    if (IN(1)) {
        if (MK_STAG1 > 0 && ((blockIdx.x >> 3) & 1)) { for (int i = 0; i < MK_STAG1; ++i) __builtin_amdgcn_s_sleep(127); }
        { pg8::Gemm g{F.XN, F.Wqkv_t, M, 1024, D}; pg8::StaticOrder S; S.init(M, 1024, F.G, (int)blockIdx.x, MK_REPEAT_PHASE == 1 ? 2 : 1);
          pg8::EpiQKV E{F.QO, (size_t)(WS_K - WS_QO) / 2, F.rope, F.kpart, QSCALE, 1, 1.f};
          pg8::gemm_phase<pg8::EpiQKV, pg8::StaticOrder, true, true>(F.lds + RING_OFF, g, S, E, F.wave); }
        { pg8::Gemm g{(const bf16*)F.XN8, (const bf16*)((const unsigned char*)F.Wqkv_t + QKV8_OFF), M, 2048, D}; pg8::StaticOrder S; S.init(M, 2048, F.G, (int)blockIdx.x, MK_REPEAT_PHASE == 1 ? 2 : 1);
          pg8::EpiQKV E{F.QO, (size_t)(WS_K - WS_QO) / 2, F.rope, F.kpart, QSCALE, 2, 1.f / (pg8::F8_SA * pg8::F8_SW)};
          pg8::gemm_phase<pg8::EpiQKV, pg8::StaticOrder, true, true, true>(F.lds + RING_OFF, g, S, E, F.wave); }
        if (BOTH(1)) GRID_BAR(1);
    }

    if (IN(2)) {
        if (F.G == 256) {
            for (int rp = 0; rp < (MK_REPEAT_PHASE == 2 ? 2 : 1); ++rp) attn_body::attn_phase<8>((char*)lds + RING_OFF, ws, (unsigned*)(F.ctl + CW_FAR), F.vcu, F.G, F.wave);
        }
        if (BOTH(2)) GRID_BAR(2);
    }

    if (IN(3)) {
        pg8::Gemm g{(const bf16*)(ws + WS_O8), F.Wo_t, M, D, D};   pg8::StaticOrder S; S.init(M, D, F.G, (int)blockIdx.x, MK_REPEAT_PHASE == 3 ? 2 : 1);
        pg8::EpiWo E{F.kpart + 131072, F.attn_norm, F.XN, (MK_REPEAT_PHASE == 3) ? (bf16*)(ws + 394 * MiB) : F.XN, (MK_REPEAT_PHASE == 3) ? ws + 458 * MiB : F.XN8, F.ssqa, F.ssq1};
        pg8::gemm_phase<pg8::EpiWo, pg8::StaticOrder, true, true, true>(F.lds + RING_OFF, g, S, E, F.wave);
        if (BOTH(3)) GRID_BAR(3);
    }

    if (IN(4)) {
        pg8::Gemm g{(const bf16*)((MK_REPEAT_PHASE == 3) ? ws + 458 * MiB : F.XN8), F.Wgu_t, M, NGU, D}; pg8::StaticOrder S; S.init(M, NGU, F.G, (int)blockIdx.x, MK_REPEAT_PHASE == 4 ? 2 : 1);
        pg8::EpiGU E{F.ssq1, F.HB};
        if (MK_REPEAT_PHASE == 40) { S.r1 = 6; pg8::gemm_phase<pg8::EpiGU, pg8::StaticOrder, true, true, true>(F.lds + RING_OFF, g, S, E, F.wave); GRID_BAR(9); S.r0 = 6; S.r1 = 1 << 30; }
        pg8::gemm_phase<pg8::EpiGU, pg8::StaticOrder, true, true, true>(F.lds + RING_OFF, g, S, E, F.wave);
        if (BOTH(4)) GRID_BAR(4);
    }

    if (IN(5)) {
        if (MK_STAG5 > 0 && ((blockIdx.x >> 3) & 1)) { for (int i = 0; i < MK_STAG5; ++i) __builtin_amdgcn_s_sleep(127); }
        pg8::Gemm g{(const bf16*)F.HB, F.Wd_t, M, D, FF};   pg8::StaticOrder S; S.init(M, D, F.G, (int)blockIdx.x, MK_REPEAT_PHASE == 5 ? 2 : 1);
#if defined(MK_SPLIT_FINAL)
        pg8::EpiDown E{F.XN, F.out, F.ssq2};
        pg8::gemm_phase<pg8::EpiDown, pg8::StaticOrder, true, true, true>(F.lds + RING_OFF, g, S, E, F.wave);
        if (BOTH(5)) GRID_BAR(5);
#else
        if (F.G == 256) { pg8::EpiDownNorm E{(MK_REPEAT_PHASE == 3) ? (bf16*)(ws + 394 * MiB) : F.XN, F.out, F.ssq2, (unsigned*)(F.ctl + CW_PANEL), F.final_norm};
            pg8::gemm_phase<pg8::EpiDownNorm, pg8::StaticOrder, true, true, true>(F.lds + RING_OFF, g, S, E, F.wave); }
        else { pg8::EpiDown E{F.XN, F.out, F.ssq2}; pg8::gemm_phase<pg8::EpiDown, pg8::StaticOrder, true, true, true>(F.lds + RING_OFF, g, S, E, F.wave); GRID_BAR(5); p6_final(F); }
#endif
    }

#if defined(MK_SPLIT_FINAL)
    if (IN(6)) { p6_final(F); }
#endif
#undef IN
#undef BOTH
}

extern "C" void kernel_launch(void* const* d_in, const int* in_sizes, int n_in, void* d_out, int out_size, void* d_ws, size_t ws_size, hipStream_t stream) {
    static int grid = 0;
    if (grid == 0) {
        if (n_in != 11 || in_sizes[0] != M * D || out_size != M * D || ws_size < WS_END) { fprintf(stderr, "kernel_launch: unexpected shapes (n_in %d, in0 %d, out %d, ws %zu); nothing launched\n", n_in, n_in > 0 ? in_sizes[0] : -1, out_size, ws_size); grid = -1; return; }
        int dev = 0, cus = 0, per_cu = 0;
        if (hipGetDevice(&dev) != hipSuccess || hipDeviceGetAttribute(&cus, hipDeviceAttributeMultiprocessorCount, dev) != hipSuccess) { grid = -1; return; }
        if (hipFuncSetAttribute((const void*)mk_fwd, hipFuncAttributeMaxDynamicSharedMemorySize, LDS_BYTES) != hipSuccess) { fprintf(stderr, "kernel_launch: hipFuncSetAttribute failed\n"); grid = -1; return; }
        if (hipOccupancyMaxActiveBlocksPerMultiprocessor(&per_cu, (const void*)mk_fwd, NWAVES * 64, LDS_BYTES) != hipSuccess || per_cu < 1) { fprintf(stderr, "kernel_launch: occupancy query says %d blocks per CU\n", per_cu); (void)hipGetLastError(); per_cu = 1; }
        grid = cus;
        if (grid > 256) grid = 256;
    }
    if (grid < 0) return;
    if (hipMemsetAsync((char*)d_ws + WS_CTL, 0, CTL_ZERO_BYTES, stream) != hipSuccess) { fprintf(stderr, "kernel_launch: hipMemsetAsync failed\n"); return; }
    Args a{};
    for (int i = 0; i < 11; ++i) a.in[i] = (const float*)d_in[i];
    a.out = (float*)d_out; a.ws = (unsigned char*)d_ws;
    for (int li = 0; li < N_LAUNCHES; ++li) {
        a.ph_lo = (N_LAUNCHES == PER_PHASE) ? li : 0; a.ph_hi = (N_LAUNCHES == PER_PHASE) ? li + 1 : PER_PHASE; a.li = li;
        hipLaunchKernelGGL(mk_fwd, dim3(grid), dim3(NWAVES * 64), LDS_BYTES, stream, a);
        const hipError_t le = hipPeekAtLastError();
        if (le != hipSuccess) { fprintf(stderr, "kernel_launch: launch %d failed: %s\n", li, hipGetErrorName(le)); break; }
    }
}
```
